# Optimizing an MI355X kernel written in HIP

```python
import math
import jax, jax.numpy as jnp
from jax import lax
import numpy as np

D_MODEL = 1024
BATCH = 16
SEQ = 2048
DEPTH = 1

HG_HEADS = 4
HG_DK = 128
HG_DV = 128
HG_KEY_WIDTH = HG_HEADS * HG_DK
HG_WIDTH = HG_HEADS * HG_DV
HG_CHUNK = 64

MB_HEADS = 8
MB_DH = 64
MB_WIDTH = MB_HEADS * MB_DH
MB_BLOCK = 256
MB_TOPK = 3
MB_QCHUNK = 16

REL_BUCKETS = 32
REL_MAX_DIST = 128

N_GROUPS = 4
EXPERTS_PER_GROUP = 8
N_EXPERTS = N_GROUPS * EXPERTS_PER_GROUP
TOP_K = 2
EXPERT_HIDDEN = 512
MOE_BLOCK = 128

DN_ALPHA = (2.0 * DEPTH) ** 0.25
DN_BETA = (8.0 * DEPTH) ** -0.25
NORM_EPS = 1e-5

IN_SIZES = (HG_KEY_WIDTH, HG_KEY_WIDTH, HG_WIDTH, HG_WIDTH, MB_WIDTH, MB_WIDTH, MB_WIDTH, D_MODEL, D_MODEL)
IN_COLS = sum(IN_SIZES)

kernel_name = 'hybrid_hgrn2_moba_hmoe_block'


def layer_norm(x, g, b):
    xf = x.astype(jnp.float32)
    mu = jnp.mean(xf, axis=-1, keepdims=True)
    xc = xf - mu
    var = jnp.mean(xc * xc, axis=-1, keepdims=True)
    return (xc * lax.rsqrt(var + NORM_EPS) * g.astype(jnp.float32) + b.astype(jnp.float32)).astype(x.dtype)


def hgrn2_mixer(q, f_logit, i, g, lb, norm_g):
    B, S, _ = q.shape
    nc = S // HG_CHUNK
    f32 = jnp.float32
    lb = lb.astype(f32)
    z = f_logit.astype(f32)
    log_f = jnp.log(lb + (1.0 - lb) * jax.nn.sigmoid(z))
    k = (1.0 - lb) * jax.nn.sigmoid(-z)
    qf = jax.nn.silu(q.astype(f32))
    vf = i.astype(f32)

    def to_chunks(t, dh):
        return t.reshape(B, nc, HG_CHUNK, HG_HEADS, dh).transpose(1, 0, 3, 2, 4)

    causal = jnp.tril(jnp.ones((HG_CHUNK, HG_CHUNK), dtype=bool))

    def chunk_step(state, inp):
        qc, kc, vc, lfc = inp
        b = jnp.cumsum(lfc, axis=2)
        o_inter = jnp.einsum('bhtk,bhkv->bhtv', qc * jnp.exp(b), state)
        rel = b[:, :, :, None, :] - b[:, :, None, :, :]
        decay = jnp.exp(jnp.where(causal[:, :, None], rel, -jnp.inf))
        scores = jnp.einsum('bhtk,bhtsk,bhsk->bhts', qc, decay, kc)
        o_intra = jnp.einsum('bhts,bhsv->bhtv', scores, vc)
        b_end = b[:, :, -1:, :]
        state = (jnp.exp(b_end[:, :, 0, :])[..., None] * state
                 + jnp.einsum('bhsk,bhsv->bhkv', kc * jnp.exp(b_end - b), vc))
        return state, o_inter + o_intra

    s0 = jnp.zeros((B, HG_HEADS, HG_DK, HG_DV), f32)
    _, o = lax.scan(chunk_step, s0, (to_chunks(qf, HG_DK), to_chunks(k, HG_DK),
                                     to_chunks(vf, HG_DV), to_chunks(log_f, HG_DK)))
    o = o.transpose(1, 0, 3, 2, 4).reshape(B, S, HG_HEADS, HG_DV)
    o = o * lax.rsqrt(jnp.mean(o * o, axis=-1, keepdims=True) + NORM_EPS)
    o = o.reshape(B, S, HG_WIDTH) * norm_g.astype(f32) * jax.nn.silu(g.astype(f32))
    return o.astype(q.dtype)


def t5_bucket(dist):
    max_exact = REL_BUCKETS // 2
    d = jnp.maximum(dist, 1).astype(jnp.float32)
    log_part = max_exact + (jnp.log(d / max_exact) / math.log(REL_MAX_DIST / max_exact)
                            * (REL_BUCKETS - max_exact)).astype(jnp.int32)
    return jnp.where(dist < max_exact, dist, jnp.minimum(log_part, REL_BUCKETS - 1))


def moba_mixer(q, k, v, rel_bias):
    B, S, _ = q.shape
    f32 = jnp.float32
    nb = -(-S // MB_BLOCK)
    s_pad = nb * MB_BLOCK
    k_sel = min(MB_TOPK, nb)
    scale = MB_DH ** -0.5

    def to_heads(t):
        t = jnp.pad(t, ((0, 0), (0, s_pad - S), (0, 0)))
        return t.reshape(B, s_pad, MB_HEADS, MB_DH).transpose(0, 2, 1, 3)

    qh, kh, vh = to_heads(q), to_heads(k), to_heads(v)
    kb = kh.reshape(B, MB_HEADS, nb, MB_BLOCK, MB_DH)
    vb = vh.reshape(B, MB_HEADS, nb, MB_BLOCK, MB_DH)
    k_mean = jnp.mean(kb, axis=3)
    gate = jnp.einsum('bhsd,bhnd->bhsn', qh, k_mean).astype(f32)
    pos = jnp.arange(s_pad)
    fully_past = jnp.arange(nb)[None, :] < (pos // MB_BLOCK)[:, None]
    gate = jnp.where(fully_past, gate, -jnp.inf)
    top_val, top_idx = lax.top_k(gate, k_sel)
    top_ok = jnp.isfinite(top_val)

    rb = rel_bias.astype(f32).T
    b_ix = jnp.arange(B)[:, None, None, None]
    h_ix = jnp.arange(MB_HEADS)[None, :, None, None]

    def attend(c):
        t0 = c * MB_QCHUNK
        tq = t0 + jnp.arange(MB_QCHUNK)
        qc = lax.dynamic_slice_in_dim(qh, t0, MB_QCHUNK, axis=2)
        idx = lax.dynamic_slice_in_dim(top_idx, t0, MB_QCHUNK, axis=2)
        ok = lax.dynamic_slice_in_dim(top_ok, t0, MB_QCHUNK, axis=2)
        kg = kb[b_ix, h_ix, idx]
        vg = vb[b_ix, h_ix, idx]
        kpos = idx[..., None] * MB_BLOCK + jnp.arange(MB_BLOCK)
        bucket = t5_bucket(tq[None, None, :, None, None] - kpos)
        s_past = (jnp.einsum('bhqd,bhqjkd->bhqjk', qc, kg).astype(f32) * scale
                  + rb[h_ix[..., None], bucket])
        s_past = jnp.where(ok[..., None], s_past, -jnp.inf).reshape(B, MB_HEADS, MB_QCHUNK, k_sel * MB_BLOCK)
        j0 = (t0 // MB_BLOCK) * MB_BLOCK
        k_own = lax.dynamic_slice_in_dim(kh, j0, MB_BLOCK, axis=2)
        v_own = lax.dynamic_slice_in_dim(vh, j0, MB_BLOCK, axis=2)
        dist_own = tq[:, None] - (j0 + jnp.arange(MB_BLOCK))[None, :]
        s_own = (jnp.einsum('bhqd,bhkd->bhqk', qc, k_own).astype(f32) * scale
                 + rb[:, t5_bucket(jnp.maximum(dist_own, 0))])
        s_own = jnp.where(dist_own >= 0, s_own, -jnp.inf)
        p = jax.nn.softmax(jnp.concatenate([s_past, s_own], axis=-1), axis=-1)
        p_past = p[..., :k_sel * MB_BLOCK].reshape(B, MB_HEADS, MB_QCHUNK, k_sel, MB_BLOCK).astype(vg.dtype)
        p_own = p[..., k_sel * MB_BLOCK:].astype(v_own.dtype)
        return (jnp.einsum('bhqjk,bhqjkd->bhqd', p_past, vg)
                + jnp.einsum('bhqk,bhkd->bhqd', p_own, v_own))

    o = lax.map(attend, jnp.arange(s_pad // MB_QCHUNK))
    o = o.transpose(1, 0, 3, 2, 4).reshape(B, s_pad, MB_WIDTH)[:, :S]
    return o


def hier_moe(x, w_group, b_group, w_expert, b_expert, w_gate_up, w_down):
    B, S, D = x.shape
    n_tok = B * S
    n_asg = n_tok * TOP_K
    f32 = jnp.float32
    xt = x.reshape(n_tok, D)
    g_logits = (xt @ w_group + b_group).astype(f32)
    grp = jnp.argmax(g_logits, axis=-1)
    p_grp = jnp.take_along_axis(jax.nn.softmax(g_logits, axis=-1), grp[:, None], axis=1)
    e_logits = (xt @ w_expert + b_expert).astype(f32).reshape(n_tok, N_GROUPS, EXPERTS_PER_GROUP)
    e_in_grp = jnp.take_along_axis(e_logits, grp[:, None, None], axis=1)[:, 0]
    top_v, top_i = lax.top_k(e_in_grp, TOP_K)
    weights = (jax.nn.softmax(top_v, axis=-1) * p_grp).reshape(n_asg)
    expert = (grp[:, None] * EXPERTS_PER_GROUP + top_i).reshape(n_asg)
    token = jnp.repeat(jnp.arange(n_tok), TOP_K)
    order = jnp.argsort(expert)
    e_s, tok_s, w_s = expert[order], token[order], weights[order]
    counts = jax.ops.segment_sum(jnp.ones((n_asg,), jnp.int32), expert, num_segments=N_EXPERTS)
    starts = jnp.cumsum(counts) - counts
    padded = (counts + MOE_BLOCK - 1) // MOE_BLOCK * MOE_BLOCK
    pad_end = jnp.cumsum(padded)
    pad_start = pad_end - padded
    dest = pad_start[e_s] + jnp.arange(n_asg) - starts[e_s]
    n_blk = -(-n_asg // MOE_BLOCK) + N_EXPERTS
    n_rows = n_blk * MOE_BLOCK
    x_buf = jnp.zeros((n_rows, D), x.dtype).at[dest].set(xt[tok_s])
    blk_expert = jnp.minimum(jnp.searchsorted(pad_end, jnp.arange(n_blk) * MOE_BLOCK, side='right'),
                             N_EXPERTS - 1)

    def expert_block(args):
        xb, e = args
        gate, up = jnp.split(xb @ w_gate_up[e], 2, axis=-1)
        return (jax.nn.silu(gate) * up) @ w_down[e]

    y_buf = lax.map(expert_block, (x_buf.reshape(n_blk, MOE_BLOCK, D), blk_expert)).reshape(n_rows, D)
    y = jnp.zeros((n_tok, D), x.dtype).at[tok_s].add(y_buf[dest] * w_s[:, None].astype(x.dtype))
    return y.reshape(B, S, D)


def setup_inputs(seed: int = 0) -> dict:
    key = jax.random.key(seed)
    ks = jax.random.split(key, 20)
    f32 = jnp.float32
    L = DEPTH

    def normal(k, shape, std):
        return jax.random.normal(k, shape, f32) * std

    col_scale = jnp.concatenate([jnp.full((n,), s, f32) for n, s in
                                 zip(IN_SIZES, (1.0, 1.0, DN_BETA, 1.0, 1.0, 1.0, DN_BETA, 1.0, 1.0))])
    return {
        'x': normal(ks[0], (BATCH, SEQ, D_MODEL), 1.0),
        'w_in': normal(ks[1], (L, D_MODEL, IN_COLS), D_MODEL ** -0.5) * col_scale,
        'b_in': normal(ks[2], (L, IN_COLS), 0.02),
        'lb_logits': normal(ks[3], (L + 1, HG_KEY_WIDTH), 0.5),
        'hg_norm_g': 1.0 + normal(ks[4], (L, HG_WIDTH), 0.1),
        'rel_bias': normal(ks[5], (REL_BUCKETS, MB_HEADS), 0.5),
        'w_proj_a': normal(ks[6], (L, HG_WIDTH, D_MODEL), DN_BETA * HG_WIDTH ** -0.5),
        'w_proj_b': normal(ks[7], (L, MB_WIDTH, D_MODEL), DN_BETA * MB_WIDTH ** -0.5),
        'w_out': normal(ks[8], (L, D_MODEL, D_MODEL), DN_BETA * D_MODEL ** -0.5),
        'ln1_g': 1.0 + normal(ks[9], (L, D_MODEL), 0.1),
        'ln1_b': normal(ks[10], (L, D_MODEL), 0.02),
        'w_group': normal(ks[11], (L, D_MODEL, N_GROUPS), D_MODEL ** -0.5),
        'b_group': normal(ks[12], (L, N_GROUPS), 0.01),
        'w_expert': normal(ks[13], (L, D_MODEL, N_EXPERTS), D_MODEL ** -0.5),
        'b_expert': normal(ks[14], (L, N_EXPERTS), 0.01),
        'w_gate_up': normal(ks[15], (L, N_EXPERTS, D_MODEL, 2 * EXPERT_HIDDEN), D_MODEL ** -0.5),
        'w_down': normal(ks[16], (L, N_EXPERTS, EXPERT_HIDDEN, D_MODEL), DN_BETA * EXPERT_HIDDEN ** -0.5),
        'ln2_g': 1.0 + normal(ks[17], (L, D_MODEL), 0.1),
        'ln2_b': normal(ks[18], (L, D_MODEL), 0.02),
    }


def reference(x, w_in, b_in, lb_logits, hg_norm_g, rel_bias, w_proj_a, w_proj_b, w_out, ln1_g, ln1_b,
              w_group, b_group, w_expert, b_expert, w_gate_up, w_down, ln2_g, ln2_b):
    split_at = [int(s) for s in np.cumsum(IN_SIZES)[:-1]]
    lower_bounds = jnp.cumsum(jax.nn.softmax(lb_logits.astype(jnp.float32), axis=0), axis=0)
    for l in range(DEPTH):
        h = x
        proj = h @ w_in[l] + b_in[l]
        hg_q, hg_f, hg_i, hg_g, mb_q, mb_k, mb_v, gate_a, gate_b = jnp.split(proj, split_at, axis=-1)
        y_a = hgrn2_mixer(hg_q, hg_f, hg_i, hg_g, lower_bounds[l], hg_norm_g[l]) @ w_proj_a[l]
        y_b = moba_mixer(mb_q, mb_k, mb_v, rel_bias) @ w_proj_b[l]
        mixed = (jax.nn.sigmoid(gate_a) * y_a + jax.nn.sigmoid(gate_b) * y_b) @ w_out[l]
        x = layer_norm(DN_ALPHA * h + mixed, ln1_g[l], ln1_b[l])
        ffn = hier_moe(x, w_group[l], b_group[l], w_expert[l], b_expert[l], w_gate_up[l], w_down[l])
        x = layer_norm(DN_ALPHA * x + ffn, ln2_g[l], ln2_b[l])
    return x
```

```cpp
#include <hip/hip_runtime.h>
#include <cstdio>
#include <cstdint>
#ifndef MK_N_LAUNCHES
#define MK_N_LAUNCHES 1
#endif
#define DI __device__ __forceinline__
#define GAS __attribute__((address_space(1)))
#define LAS __attribute__((address_space(3)))
typedef unsigned short bf16;
typedef unsigned u32x4 __attribute__((ext_vector_type(4)));
typedef unsigned u32x2 __attribute__((ext_vector_type(2)));
typedef float f32x4 __attribute__((ext_vector_type(4)));
typedef float f32x2 __attribute__((ext_vector_type(2)));
typedef float f32x16 __attribute__((ext_vector_type(16)));
typedef short bf16x8 __attribute__((ext_vector_type(8)));
typedef short s16x4 __attribute__((ext_vector_type(4)));
typedef short v4i16_t __attribute__((ext_vector_type(4)));
typedef __bf16 bf16x2_t __attribute__((ext_vector_type(2)));
typedef GAS unsigned gu32;

constexpr int NTOK = 32768, DM = 1024, SEQ = 2048, NBATCH = 16, NIN = 5632;
constexpr int NWAVES = 8, NTHREADS = 512;
constexpr float LN_EPS = 1e-5f, DN_ALPHA = 1.189207115002721f, LOG2E = 1.4426950408889634f;
constexpr int MOE_MAXTILES = 288;

constexpr size_t MiB = 1u << 20;
constexpr size_t WS_CTL = 0, CTL_ZERO_BYTES = 65536;
constexpr size_t WS_WIN = 1 * MiB, WS_WCAT = 12 * MiB, WS_WO = 14 * MiB;
constexpr size_t WS_XB = 16 * MiB;
constexpr size_t WS_R = 80 * MiB;
constexpr size_t WS_GB = 144 * MiB;
constexpr size_t WS_QH = 208 * MiB;
constexpr size_t WS_VH = 240 * MiB;
constexpr size_t WS_GH = 272 * MiB;
constexpr size_t WS_ZF = 304 * MiB;
constexpr size_t WS_QM = 368 * MiB, WS_KM = 400 * MiB;
constexpr size_t WS_VM = 432 * MiB;
constexpr size_t WS_Y = 16 * MiB;
constexpr size_t WS_MISC = 464 * MiB;
constexpr size_t WS_KMEAN = WS_MISC;
constexpr size_t WS_BPERM = WS_MISC + 1 * MiB;
constexpr size_t WS_WRH = WS_MISC + 2 * MiB;
constexpr size_t WS_WRL = WS_WRH + 98304;
constexpr size_t WS_TOKE = WS_MISC + 3 * MiB;
constexpr size_t WS_TOKW = WS_MISC + 4 * MiB;
constexpr size_t WS_TOKD = WS_MISC + 5 * MiB;
constexpr size_t WS_WGCNT = WS_MISC + 6 * MiB;
constexpr size_t WS_ROWTOK = WS_MISC + 7 * MiB;
constexpr size_t WS_TILEE = WS_MISC + 8 * MiB;
constexpr size_t WS_END = 512 * MiB;
constexpr int CW_BAR = 4096, CW_QUEUE = 8192;

constexpr int LDS_BYTES = 163840, MISC_OFF = LDS_BYTES - 256;

DI unsigned cvtpk(float lo, float hi) { f32x2 v = {lo, hi}; bf16x2_t b = __builtin_convertvector(v, bf16x2_t); return __builtin_bit_cast(unsigned, b); }
DI float bflo(unsigned w) { return __uint_as_float(w << 16); }
DI float bfhi(unsigned w) { return __uint_as_float(w & 0xffff0000u); }
DI float bf2f(unsigned short h) { return __uint_as_float((unsigned)h << 16); }
DI float frcp(float x) { return __builtin_amdgcn_rcpf(x); }
DI float fsigmoid(float x) { return frcp(1.f + __expf(-x)); }
DI float wave_sum(float v) {
#pragma unroll
    for (int o = 1; o < 64; o <<= 1) v += __shfl_xor(v, o);
    return v;
}
DI int crow(int r, int hi) { return (r & 3) + 8 * (r >> 2) + 4 * hi; }
#define MFMA32(a, b, c) __builtin_amdgcn_mfma_f32_32x32x16_bf16((a), (b), (c), 0, 0, 0)
#define MFMA16(a, b, c) __builtin_amdgcn_mfma_f32_16x16x32_bf16((a), (b), (c), 0, 0, 0)
DI s16x4 vtr(LAS const char* p) { return __builtin_bit_cast(s16x4, __builtin_amdgcn_ds_read_tr16_b64_v4i16((LAS v4i16_t*)p)); }

#define XB_TMO      128
#define XB_XCNT(j)  (256  + 64 * (j))
#define XB_XSUB(j)  (1280 + 64 * (j))
#define XB_XGEN(j)  (2304 + 64 * (j))
#define XB_TOP      3328
#define XB_TOPGEN   3392
#define XCD_BAR_WORDS 3456
#define XB_SPIN_CAP (1u << 22)
DI unsigned xb_ld(unsigned* p)              { return __hip_atomic_load(p, __ATOMIC_RELAXED, __HIP_MEMORY_SCOPE_AGENT); }
DI unsigned xb_add(unsigned* p, unsigned v) { return __hip_atomic_fetch_add(p, v, __ATOMIC_RELAXED, __HIP_MEMORY_SCOPE_AGENT); }
DI unsigned xb_xcc_id() { return (unsigned)__builtin_amdgcn_s_getreg((3 << 11) | 20) & 0xFu; }
#define XB_SPIN(cond, bar) do { unsigned _sp = 0; while (cond) { __builtin_amdgcn_s_sleep(1); \
    if ((++_sp & 255u) == 0u) { if (xb_ld(&(bar)[XB_TMO])) break; if (_sp > XB_SPIN_CAP) { atomicAdd(&(bar)[XB_TMO], 1u); break; } } } } while (0)
struct XcdBarrier { unsigned* bar; unsigned x; volatile LAS unsigned* st; };
DI XcdBarrier xcd_barrier_post(unsigned* bar, volatile LAS unsigned* st) {
    XcdBarrier b; b.bar = bar; b.x = xb_xcc_id(); b.st = st;
    if (threadIdx.x == 0) (void)xb_add(&bar[XB_XCNT(b.x)], 1u);
    return b;
}
DI void xcd_barrier_complete(unsigned* bar, unsigned x, unsigned& nloc, unsigned& nx) {
    const unsigned G = gridDim.x * gridDim.y * gridDim.z;
    unsigned sum, cnt, mine, sp = 0u;
    for (;;) {
        sum = 0u; cnt = 0u; mine = 0u;
#pragma unroll
        for (unsigned j = 0; j < 16; ++j) { const unsigned c = xb_ld(&bar[XB_XCNT(j)]); sum += c; cnt += (c > 0u) ? 1u : 0u; mine = (j == x) ? c : mine; }
        if (sum == G) break;
        __builtin_amdgcn_s_sleep(1);
        if ((++sp & 255u) == 0u) { if (xb_ld(&bar[XB_TMO])) break; if (sp > XB_SPIN_CAP) { atomicAdd(&bar[XB_TMO], 1u); break; } }
    }
    nloc = mine > 0u ? mine : 1u; nx = cnt > 0u ? cnt : 1u;
}
DI void xcd_barrier(const XcdBarrier& b) {
    asm volatile("s_waitcnt vmcnt(0)" ::: "memory");
    __syncthreads();
    if (threadIdx.x == 0) {
        unsigned* bar = b.bar;
        __builtin_amdgcn_s_waitcnt(0);
        unsigned nloc = b.st[0], nx = b.st[1];
        if (nloc == 0u) { xcd_barrier_complete(bar, b.x, nloc, nx); b.st[0] = nloc; b.st[1] = nx; }
        const unsigned old = xb_add(&bar[XB_XSUB(b.x)], 1u);
        const unsigned gen = old / nloc;
        if (old + 1u == (gen + 1u) * nloc) {
            __builtin_amdgcn_fence(__ATOMIC_RELEASE, "agent");
            asm volatile("s_waitcnt vmcnt(0)" ::: "memory");
            const unsigned og = xb_add(&bar[XB_TOP], 1u);
            const unsigned tg = og / nx;
            if (og + 1u == (tg + 1u) * nx) xb_add(&bar[XB_TOPGEN], 1u);
            else XB_SPIN(xb_ld(&bar[XB_TOPGEN]) == tg, bar);
            __builtin_amdgcn_fence(__ATOMIC_ACQUIRE, "agent");
            xb_add(&bar[XB_XGEN(b.x)], 1u);
            asm volatile("s_waitcnt vmcnt(0)" ::: "memory");
        } else {
            XB_SPIN(xb_ld(&bar[XB_XGEN(b.x)]) == gen, bar);
            __builtin_amdgcn_fence(__ATOMIC_ACQUIRE, "agent");
            asm volatile("s_waitcnt vmcnt(0)" ::: "memory");
        }
    }
    __syncthreads();
}

namespace pg8 {
constexpr int BM = 256, BK = 64, HALF = 128, HTB = HALF * BK * 2, STAGE_BYTES = 8 * HTB, NXCD = 8, WGM = 8;
DI int lds_byte(int r, int c) { const int st = (r >> 4) * 2 + (c >> 5), rr = r & 15, cc = c & 31, ob = rr * 64 + cc * 2; return st * 1024 + (ob ^ (((ob >> 9) & 1) << 5)); }
DI void stage_rc(int b, int& R, int& C) { const int st = b / 1024, sb = b % 1024, swz = sb ^ (((sb >> 9) & 1) << 5); R = (st >> 1) * 16 + swz / 64; C = (st & 1) * 32 + (swz % 64) / 2; }
DI int perm32(int rho) { const int n = rho >> 4, i = rho & 15; return 8 * (i >> 2) + 4 * n + (i & 3); }
struct Unit { int pm, pn, e; };

struct DenseOrder {
    const char* A; const char* Bt; int K, nM, nN, nwg, G, c;
    DI void init(const void* A_, const void* Bt_, int M, int N, int K_, int G_, int c_) { A = (const char*)A_; Bt = (const char*)Bt_; K = K_; nM = M / BM; nN = N / BM; nwg = nM * nN; G = G_; c = c_; }
    DI bool next(int i, Unit& u) const {
        const long L = (long)i * G + c; if (L >= nwg) return false;
        int wgid = (int)L; { const int q = nwg / NXCD, r = nwg % NXCD, xcd = wgid % NXCD, off = wgid / NXCD; wgid = (xcd < r ? xcd * (q + 1) : r * (q + 1) + (xcd - r) * q) + off; }
        const int nig = WGM * nN, gid = wgid / nig, fm = gid * WGM, gsz = (nM - fm) < WGM ? (nM - fm) : WGM;
        u.pm = fm + ((wgid % nig) % gsz); u.pn = (wgid % nig) / gsz; u.e = 0; return true;
    }
    DI const char* a_base(const Unit& u) const { return A + (size_t)u.pm * 512 * K; }
    DI const char* b_base(const Unit& u) const { return Bt + (size_t)u.pn * 512 * K; }
    DI void gather(const Unit&, const int (&)[2], const int (&)[2], unsigned (&)[2][2]) const {}
};
struct MoeOrder {
    const char* A; const char* Bt; const int* row_tok; const int* tile_e; int K, N, nunits, G, c; bool gat;
    DI bool next(int i, Unit& u) const {
        const int L = i * G + c; if (L >= nunits) return false;
        u.pm = L >> 2; u.pn = L & 3;
        u.e = __builtin_amdgcn_readfirstlane(__hip_atomic_load(tile_e + u.pm, __ATOMIC_RELAXED, __HIP_MEMORY_SCOPE_AGENT)); return true;
    }
    DI const char* a_base(const Unit& u) const { return gat ? A : A + (size_t)u.pm * 512 * K; }
    DI const char* b_base(const Unit& u) const { return Bt + ((size_t)u.e * N + (size_t)u.pn * 256) * K * 2; }
    DI void gather(const Unit& u, const int (&Rr)[2], const int (&Cc)[2], unsigned (&o)[2][2]) const {
#pragma unroll
        for (int h = 0; h < 2; ++h)
#pragma unroll
            for (int i = 0; i < 2; ++i) { const int tok = row_tok[u.pm * 256 + h * 128 + Rr[i]]; o[h][i] = (unsigned)(tok * K + Cc[i]) * 2u; }
    }
};

template <class Epi, class Sched, bool GATHER>
DI void gemm_phase(LAS unsigned char* lds, const int K, const Sched& S, const Epi& E) {
    const int tid = threadIdx.x, wid = __builtin_amdgcn_readfirstlane(tid >> 6), lane = tid & 63, wr = wid >> 2, wc = wid & 3, fr = lane & 15, fq = lane >> 4;
    const int nt = K / BK;
    unsigned voffB[2], vA[2][2], nvA[2][2]; int Rr[2], Cc[2];
#pragma unroll
    for (int i = 0; i < 2; ++i) { int R, C; stage_rc(tid * 16 + i * 8192, R, C); Rr[i] = R; Cc[i] = C; const int Rb = (R & ~31) + perm32(R & 31);
        voffB[i] = (unsigned)(Rb * K + C) * 2u; vA[0][i] = (unsigned)(R * K + C) * 2u; vA[1][i] = (unsigned)((R + HALF) * K + C) * 2u; nvA[0][i] = vA[0][i]; nvA[1][i] = vA[1][i]; }
    const size_t kstep = (size_t)(BK * 2);
    const size_t hstep = (size_t)HALF * K * 2;
    const unsigned ldsw = (unsigned)wid * 1024u;
    const int aoff = lds_byte(wr * 64 + fr, fq * 8), boff = lds_byte(wc * 32 + fr, fq * 8);
#define PG8_SA(b, h) (((b) * 2 + (h)) * HTB)
#define PG8_SB(b, h) ((4 + (b) * 2 + (h)) * HTB)
#define PG8_STAGE(bufoff, gbase, voff) do { _Pragma("unroll") for (int _i = 0; _i < 2; ++_i) \
        __builtin_amdgcn_global_load_lds((const unsigned*)((const char*)(gbase) + (voff)[_i]), (LAS unsigned*)(lds + (bufoff) + ldsw + _i * 8192), 16, 0, 0); } while (0)
#define PG8_LDA(dst, b, h) do { _Pragma("unroll") for (int m = 0; m < 4; ++m) _Pragma("unroll") for (int k = 0; k < 2; ++k) dst[m][k] = *(const LAS bf16x8*)(lds + PG8_SA(b, h) + aoff + m * 2048 + k * 1024); } while (0)
#define PG8_LDB(dst, b, h) do { _Pragma("unroll") for (int n = 0; n < 2; ++n) _Pragma("unroll") for (int k = 0; k < 2; ++k) dst[n][k] = *(const LAS bf16x8*)(lds + PG8_SB(b, h) + boff + n * 2048 + k * 1024); } while (0)
#define PG8_MMA(ai, bj, At, Bt) do { __builtin_amdgcn_s_setprio(1); _Pragma("unroll") for (int m = 0; m < 4; ++m) _Pragma("unroll") for (int n = 0; n < 2; ++n) _Pragma("unroll") for (int k = 0; k < 2; ++k) \
        acc[ai][bj][m][n] = __builtin_amdgcn_mfma_f32_16x16x32_bf16(Bt[n][k], At[m][k], acc[ai][bj][m][n], 0, 0, 0); __builtin_amdgcn_s_setprio(0); } while (0)
#define PG8_WAIT_V(n) asm volatile("s_waitcnt vmcnt(" #n ")" ::: "memory")
#define PG8_WAIT_L(n) asm volatile("s_waitcnt lgkmcnt(" #n ")" ::: "memory")
#define PG8_BAR __builtin_amdgcn_s_barrier()
#define PG8_SCHED __builtin_amdgcn_sched_barrier(0)
    Unit cur, nxt; int ui = 0;
    if (!S.next(0, cur)) return;
    if constexpr (GATHER) S.gather(cur, Rr, Cc, vA);
    f32x4 acc[2][2][4][2];
#pragma unroll
    for (int a = 0; a < 2; ++a)
#pragma unroll
        for (int b = 0; b < 2; ++b)
#pragma unroll
            for (int m = 0; m < 4; ++m)
#pragma unroll
                for (int n = 0; n < 2; ++n) acc[a][b][m][n] = (f32x4){0.f, 0.f, 0.f, 0.f};
    bf16x8 At[4][2], B0[2][2], B1[2][2];
    const char* cA = S.a_base(cur); const char* cB = S.b_base(cur);
    PG8_STAGE(PG8_SB(0, 0), cB, voffB); PG8_STAGE(PG8_SB(0, 1), cB + hstep, voffB); PG8_STAGE(PG8_SA(0, 0), cA, vA[0]); PG8_STAGE(PG8_SA(0, 1), cA, vA[1]);
    if (wr == 1) PG8_BAR;
    PG8_WAIT_V(2); PG8_BAR;
    PG8_STAGE(PG8_SB(1, 0), cB + kstep, voffB); PG8_STAGE(PG8_SA(1, 0), cA + kstep, vA[0]); PG8_STAGE(PG8_SB(1, 1), cB + hstep + kstep, voffB);
    PG8_WAIT_V(6); PG8_BAR;
    for (;;) {
        const bool has_next = S.next(ui + 1, nxt);
        const char* nA = has_next ? S.a_base(nxt) : cA; const char* nB = has_next ? S.b_base(nxt) : cB;
        if constexpr (GATHER) {
            if (has_next) S.gather(nxt, Rr, Cc, nvA);
            else {
#pragma unroll
                for (int h = 0; h < 2; ++h) { nvA[h][0] = vA[h][0]; nvA[h][1] = vA[h][1]; } }
        }
        for (int t = 0; t < nt; t += 2) {
            const bool last = (t == nt - 2);
            if constexpr (Epi::HAS_MID) { if (t == (nt >> 1)) E.mid(acc, cur, wr, wc, fr, fq); }
            const char* a1 = cA + (size_t)(t + 1) * kstep;
            const char* a2 = last ? nA : cA + (size_t)(t + 2) * kstep; const char* b2 = last ? nB : cB + (size_t)(t + 2) * kstep;
            const char* a3 = a2 + kstep; const char* b3 = b2 + kstep;
            unsigned o0[2], o1[2];
            if constexpr (GATHER) { o0[0] = last ? nvA[0][0] : vA[0][0]; o0[1] = last ? nvA[0][1] : vA[0][1]; o1[0] = last ? nvA[1][0] : vA[1][0]; o1[1] = last ? nvA[1][1] : vA[1][1]; }
            else { o0[0] = vA[0][0]; o0[1] = vA[0][1]; o1[0] = vA[1][0]; o1[1] = vA[1][1]; }
            PG8_LDB(B0, 0, 0); PG8_LDB(B1, 0, 1); PG8_SCHED; PG8_LDA(At, 0, 0); PG8_STAGE(PG8_SA(1, 1), a1, vA[1]);
            PG8_WAIT_V(8); PG8_WAIT_L(0); PG8_BAR; PG8_MMA(0, 0, At, B0); PG8_MMA(0, 1, At, B1); PG8_BAR; PG8_SCHED;
            PG8_LDA(At, 0, 1); PG8_STAGE(PG8_SB(0, 0), b2, voffB); PG8_STAGE(PG8_SB(0, 1), b2 + hstep, voffB); PG8_STAGE(PG8_SA(0, 0), a2, o0);
            PG8_WAIT_V(8); PG8_WAIT_L(0); PG8_BAR; PG8_MMA(1, 0, At, B0); PG8_MMA(1, 1, At, B1); PG8_BAR; PG8_SCHED;
            PG8_LDB(B0, 1, 0); PG8_LDB(B1, 1, 1); PG8_SCHED; PG8_LDA(At, 1, 0); PG8_STAGE(PG8_SA(0, 1), a2, o1);
            PG8_WAIT_V(8); PG8_WAIT_L(0); PG8_BAR; PG8_MMA(0, 0, At, B0); PG8_MMA(0, 1, At, B1); PG8_BAR; PG8_SCHED;
            PG8_LDA(At, 1, 1); PG8_STAGE(PG8_SB(1, 0), b3, voffB); PG8_STAGE(PG8_SB(1, 1), b3 + hstep, voffB); PG8_STAGE(PG8_SA(1, 0), a3, o0);
            PG8_WAIT_V(8); PG8_WAIT_L(0); PG8_BAR; PG8_MMA(1, 0, At, B0); PG8_MMA(1, 1, At, B1); PG8_BAR; PG8_SCHED;
        }
        if (wr == 0) PG8_BAR;
        E(acc, cur, wr, wc, fr, fq);
        if (!has_next) break;
#pragma unroll
        for (int a = 0; a < 2; ++a)
#pragma unroll
            for (int b = 0; b < 2; ++b)
#pragma unroll
                for (int m = 0; m < 4; ++m)
#pragma unroll
                    for (int n = 0; n < 2; ++n) acc[a][b][m][n] = (f32x4){0.f, 0.f, 0.f, 0.f};
        cur = nxt; cA = nA; cB = nB; ++ui;
        if constexpr (GATHER) {
#pragma unroll
            for (int h = 0; h < 2; ++h) { vA[h][0] = nvA[h][0]; vA[h][1] = nvA[h][1]; } }
        if (wr == 1) PG8_BAR;
    }
    PG8_WAIT_V(0);
    PG8_BAR;
#undef PG8_SA
#undef PG8_SB
#undef PG8_STAGE
#undef PG8_LDA
#undef PG8_LDB
#undef PG8_MMA
#undef PG8_WAIT_V
#undef PG8_WAIT_L
#undef PG8_BAR
#undef PG8_SCHED
}

typedef f32x4 Acc[2][2][4][2];
DI u32x4 pack8(const f32x4 a, const f32x4 b) { u32x4 w; w.x = cvtpk(a[0], a[1]); w.y = cvtpk(a[2], a[3]); w.z = cvtpk(b[0], b[1]); w.w = cvtpk(b[2], b[3]); return w; }
DI f32x4 silu4(const f32x4 v) { f32x4 o; o[0] = v[0] * fsigmoid(v[0]); o[1] = v[1] * fsigmoid(v[1]); o[2] = v[2] * fsigmoid(v[2]); o[3] = v[3] * fsigmoid(v[3]); return o; }

struct EpiIn {
    static constexpr bool HAS_MID = false;
    bf16 *Qh, *Vh, *Gh, *Qm, *Km, *Vm, *Rr, *Gb; float *Zf, *KM; const float* bias;
    DI void operator()(Acc& acc, const Unit& u, int wr, int wc, int fr, int fq) const {
        const int pn = u.pn, row0 = u.pm * BM + wr * 64 + fr, cl = wc * 32 + 8 * fq;
        f32x4 bv[2][2];
#pragma unroll
        for (int bj = 0; bj < 2; ++bj)
#pragma unroll
            for (int n = 0; n < 2; ++n) bv[bj][n] = *(const f32x4*)(bias + pn * 256 + bj * HALF + cl + 4 * n);
        if (pn < 14) {
            const int seg = pn >> 1, c0 = (pn & 1) * 256 + cl;
            if (seg == 1) {
#pragma unroll
                for (int ai = 0; ai < 2; ++ai)
#pragma unroll
                    for (int m = 0; m < 4; ++m) { float* rp = Zf + (size_t)(row0 + ai * HALF + m * 16) * 512 + c0;
#pragma unroll
                        for (int bj = 0; bj < 2; ++bj) { *(f32x4*)(rp + bj * HALF) = acc[ai][bj][m][0] + bv[bj][0]; *(f32x4*)(rp + bj * HALF + 4) = acc[ai][bj][m][1] + bv[bj][1]; }
                        asm volatile("" ::: "memory"); }
            } else {
                bf16* O = seg == 0 ? Qh : seg == 2 ? Vh : seg == 3 ? Gh : seg == 4 ? Qm : seg == 5 ? Km : Vm;
                const int act = (seg == 0 || seg == 3) ? 1 : (seg == 4 ? 2 : 0);
                if (seg == 5) {
#pragma unroll
                    for (int bj = 0; bj < 2; ++bj)
#pragma unroll
                        for (int n = 0; n < 2; ++n) { f32x4 cs = (f32x4){0.f, 0.f, 0.f, 0.f};
#pragma unroll
                            for (int ai = 0; ai < 2; ++ai)
#pragma unroll
                                for (int m = 0; m < 4; ++m) cs += acc[ai][bj][m][n] + bv[bj][n];
#pragma unroll
                            for (int j = 0; j < 4; ++j) { float s = cs[j]; s += __shfl_xor(s, 1); s += __shfl_xor(s, 2); s += __shfl_xor(s, 4); s += __shfl_xor(s, 8); cs[j] = s; }
                            if (fr == 0) *(f32x4*)(KM + (size_t)(u.pm * 2 + wr) * 512 + c0 + bj * HALF + 4 * n) = cs; }
                }
#pragma unroll
                for (int ai = 0; ai < 2; ++ai)
#pragma unroll
                    for (int m = 0; m < 4; ++m) { bf16* rp = O + (size_t)(row0 + ai * HALF + m * 16) * 512 + c0;
#pragma unroll
                        for (int bj = 0; bj < 2; ++bj) { f32x4 v0 = acc[ai][bj][m][0] + bv[bj][0], v1 = acc[ai][bj][m][1] + bv[bj][1];
                            if (act == 1) { v0 = silu4(v0); v1 = silu4(v1); } else if (act == 2) { v0 = v0 * (0.125f * LOG2E); v1 = v1 * (0.125f * LOG2E); }
                            *(u32x4*)(rp + bj * HALF) = pack8(v0, v1); }
                        asm volatile("" ::: "memory"); }
            }
        } else {
            const int c0 = (pn - 14) * 128 + cl;
#pragma unroll
            for (int ai = 0; ai < 2; ++ai)
#pragma unroll
                for (int m = 0; m < 4; ++m) { const size_t off = (size_t)(row0 + ai * HALF + m * 16) * 1024 + c0; f32x4 r[2], g[2];
#pragma unroll
                    for (int n = 0; n < 2; ++n) { const f32x4 a = acc[ai][0][m][n] + bv[0][n], b = acc[ai][1][m][n] + bv[1][n];
#pragma unroll
                        for (int j = 0; j < 4; ++j) { const float ea = __expf(-a[j]), eb = __expf(-b[j]); g[n][j] = frcp(1.f + eb); r[n][j] = (1.f + eb) * frcp(1.f + ea); } }
                    *(u32x4*)(Rr + off) = pack8(r[0], r[1]); *(u32x4*)(Gb + off) = pack8(g[0], g[1]); asm volatile("" ::: "memory"); }
        }
    }
};
struct EpiProj {
    static constexpr bool HAS_MID = true;
    const bf16 *Rr, *Gb; bf16* U;
    DI void scale(Acc& acc, const bf16* G, const Unit& u, int wr, int wc, int fr, int fq) const {
        int row0 = u.pm * BM + wr * 64 + fr, col0 = u.pn * BM + wc * 32 + 8 * fq;
        asm volatile("" : "+v"(row0), "+v"(col0));
#pragma unroll
        for (int ai = 0; ai < 2; ++ai)
#pragma unroll
            for (int mp = 0; mp < 2; ++mp) { u32x4 rv[2][2];
#pragma unroll
            for (int m = 0; m < 2; ++m)
#pragma unroll
                for (int bj = 0; bj < 2; ++bj) rv[m][bj] = *(const u32x4*)(G + (size_t)(row0 + ai * HALF + (2 * mp + m) * 16) * 1024 + col0 + bj * HALF);
#pragma unroll
            for (int m = 0; m < 2; ++m)
#pragma unroll
                for (int bj = 0; bj < 2; ++bj) { const u32x4 w = rv[m][bj];
                    acc[ai][bj][2 * mp + m][0] *= (f32x4){bflo(w.x), bfhi(w.x), bflo(w.y), bfhi(w.y)}; acc[ai][bj][2 * mp + m][1] *= (f32x4){bflo(w.z), bfhi(w.z), bflo(w.w), bfhi(w.w)}; }
            asm volatile("" ::: "memory"); }
    }
    DI void mid(Acc& acc, const Unit& u, int wr, int wc, int fr, int fq) const { scale(acc, Rr, u, wr, wc, fr, fq); }
    DI void operator()(Acc& acc, const Unit& u, int wr, int wc, int fr, int fq) const {
        scale(acc, Gb, u, wr, wc, fr, fq);
        const int row0 = u.pm * BM + wr * 64 + fr, col0 = u.pn * BM + wc * 32 + 8 * fq;
#pragma unroll
        for (int ai = 0; ai < 2; ++ai)
#pragma unroll
            for (int m = 0; m < 4; ++m) { bf16* rp = U + (size_t)(row0 + ai * HALF + m * 16) * 1024 + col0;
#pragma unroll
                for (int bj = 0; bj < 2; ++bj) *(u32x4*)(rp + bj * HALF) = pack8(acc[ai][bj][m][0], acc[ai][bj][m][1]); }
    }
};
struct EpiOut {
    static constexpr bool HAS_MID = false;
    const float* X; float* Pre;
    DI void operator()(Acc& acc, const Unit& u, int wr, int wc, int fr, int fq) const {
        const int row0 = u.pm * BM + wr * 64 + fr, col0 = u.pn * BM + wc * 32 + 8 * fq;
#pragma unroll
        for (int ai = 0; ai < 2; ++ai)
#pragma unroll
            for (int m = 0; m < 4; ++m) { const size_t off = (size_t)(row0 + ai * HALF + m * 16) * 1024 + col0;
#pragma unroll
                for (int bj = 0; bj < 2; ++bj) { const f32x4 x0 = *(const f32x4*)(X + off + bj * HALF), x1 = *(const f32x4*)(X + off + bj * HALF + 4);
                    *(f32x4*)(Pre + off + bj * HALF) = x0 * DN_ALPHA + acc[ai][bj][m][0]; *(f32x4*)(Pre + off + bj * HALF + 4) = x1 * DN_ALPHA + acc[ai][bj][m][1]; }
                if (m & 1) asm volatile("" ::: "memory"); }
    }
};
struct EpiM1 {
    static constexpr bool HAS_MID = false;
    bf16* H;
    DI void operator()(Acc& acc, const Unit& u, int wr, int wc, int fr, int fq) const {
        const int row0 = u.pm * BM + wr * 64 + fr, col0 = u.pn * 128 + wc * 32 + 8 * fq;
#pragma unroll
        for (int ai = 0; ai < 2; ++ai)
#pragma unroll
            for (int m = 0; m < 4; ++m) *(u32x4*)(H + (size_t)(row0 + ai * HALF + m * 16) * 512 + col0) = pack8(silu4(acc[ai][0][m][0]) * acc[ai][1][m][0], silu4(acc[ai][0][m][1]) * acc[ai][1][m][1]);
    }
};
struct EpiM2 {
    static constexpr bool HAS_MID = false;
    bf16* Y;
    DI void operator()(Acc& acc, const Unit& u, int wr, int wc, int fr, int fq) const {
        const int row0 = u.pm * BM + wr * 64 + fr, col0 = u.pn * BM + wc * 32 + 8 * fq;
#pragma unroll
        for (int ai = 0; ai < 2; ++ai)
#pragma unroll
            for (int m = 0; m < 4; ++m) { bf16* rp = Y + (size_t)(row0 + ai * HALF + m * 16) * 1024 + col0;
#pragma unroll
                for (int bj = 0; bj < 2; ++bj) *(u32x4*)(rp + bj * HALF) = pack8(acc[ai][bj][m][0], acc[ai][bj][m][1]); }
    }
};
}

struct Args { const float* in[19]; float* out; unsigned char* ws; int ph_lo, ph_hi; };
enum { I_X = 0, I_WIN, I_BIN, I_LBL, I_HGNG, I_RELB, I_WPA, I_WPB, I_WOUT, I_LN1G, I_LN1B, I_WGRP, I_BGRP, I_WEXP, I_BEXP, I_WGU, I_WDN, I_LN2G, I_LN2B };

struct Ctx {
    LAS unsigned char* lds; volatile LAS unsigned* MISC;
    int tid, lane, wid, G, vcu;
    unsigned char* ws; gu32* ctl;
};

DI void transpose_item(const float* W, int N, bf16* WT, int ldk, int drow, int dk, LAS float* scr, int lane) {
#pragma unroll 8
    for (int i = 0; i < 32; ++i) { const int kk = 2 * i + (lane >> 5); scr[kk * 33 + (lane & 31)] = W[(size_t)kk * N + (lane & 31)]; }
    asm volatile("s_waitcnt lgkmcnt(0)" ::: "memory");
    const int c = lane & 7;
#pragma unroll
    for (int j = 0; j < 4; ++j) { const int n = (lane >> 3) + 8 * j; const LAS float* s = scr + (8 * c) * 33 + n;
        u32x4 o; o.x = cvtpk(s[0 * 33], s[1 * 33]); o.y = cvtpk(s[2 * 33], s[3 * 33]); o.z = cvtpk(s[4 * 33], s[5 * 33]); o.w = cvtpk(s[6 * 33], s[7 * 33]);
        *(u32x4*)(WT + (size_t)(drow + n) * ldk + dk + 8 * c) = o; }
    asm volatile("s_waitcnt lgkmcnt(0)" ::: "memory");
}
DI int win_drow(int n0) { if (n0 < 3584) return n0; if (n0 < 4608) { const int r = n0 - 3584; return 3584 + 256 * (r >> 7) + (r & 127); } const int r = n0 - 4608; return 3584 + 256 * (r >> 7) + 128 + (r & 127); }
DI int wgu_drow(int n0) { if (n0 < 512) return 256 * (n0 >> 7) + (n0 & 127); const int r = n0 - 512; return 256 * (r >> 7) + 128 + (r & 127); }

DI void p0_prologue(const Ctx& C, const Args& a) {
    LAS float* scr = (LAS float*)(C.lds + C.wid * 16384);
    const int gw = C.vcu * NWAVES + C.wid, NGW = C.G * NWAVES;
    bf16* WinT = (bf16*)(C.ws + WS_WIN); bf16* Wcat = (bf16*)(C.ws + WS_WCAT); bf16* WoT = (bf16*)(C.ws + WS_WO);
    constexpr int I_IN = 16 * 176, I_PA = 8 * 32, I_O = 16 * 32, NITEMS = I_IN + 2 * I_PA + I_O;
    for (int it = gw; it < NITEMS; it += NGW) {
        int r = it;
        if (r < I_IN) { const int kb = r / 176, nb = r % 176; transpose_item(a.in[I_WIN] + (size_t)(64 * kb) * NIN + 32 * nb, NIN, WinT, 1024, win_drow(32 * nb), 64 * kb, scr, C.lane); continue; } r -= I_IN;
        if (r < I_PA) { const int kb = r / 32, nb = r % 32; transpose_item(a.in[I_WPA] + (size_t)(64 * kb) * 1024 + 32 * nb, 1024, Wcat, 1024, 32 * nb, 64 * kb, scr, C.lane); continue; } r -= I_PA;
        if (r < I_PA) { const int kb = r / 32, nb = r % 32; transpose_item(a.in[I_WPB] + (size_t)(64 * kb) * 1024 + 32 * nb, 1024, Wcat, 1024, 32 * nb, 512 + 64 * kb, scr, C.lane); continue; } r -= I_PA;
        { const int kb = r / 32, nb = r % 32; transpose_item(a.in[I_WOUT] + (size_t)(64 * kb) * 1024 + 32 * nb, 1024, WoT, 1024, 32 * nb, 64 * kb, scr, C.lane); }
    }
    const int gt = C.vcu * NTHREADS + C.tid, NT = C.G * NTHREADS;
    { const float* x = a.in[I_X]; bf16* Xb = (bf16*)(C.ws + WS_XB);
      for (int i = gt; i < NTOK * DM / 8; i += NT) { const f32x4 v0 = *(const f32x4*)(x + (size_t)i * 8), v1 = *(const f32x4*)(x + (size_t)i * 8 + 4); *(u32x4*)(Xb + (size_t)i * 8) = pg8::pack8(v0, v1); } }
    { float* bp = (float*)(C.ws + WS_BPERM); const float* bin = a.in[I_BIN];
      for (int n = gt; n < NIN; n += NT) bp[win_drow(n & ~31) + (n & 31)] = bin[n]; }
    { bf16* wh = (bf16*)(C.ws + WS_WRH); bf16* wl = (bf16*)(C.ws + WS_WRL); const float* wg = a.in[I_WGRP]; const float* we = a.in[I_WEXP];
      for (int i = gt; i < 48 * 1024; i += NT) { const int j = i >> 10, k = i & 1023; float w = 0.f; if (j < 4) w = wg[k * 4 + j]; else if (j < 36) w = we[k * 32 + (j - 4)];
          const unsigned h = cvtpk(w, 0.f) & 0xffffu; const float r = w - bf2f((unsigned short)h); wh[i] = (bf16)h; wl[i] = (bf16)(cvtpk(r, 0.f) & 0xffffu); } }
}
DI void p4b_convert_moe(const Ctx& C, const Args& a) {
    LAS float* scr = (LAS float*)(C.lds + C.wid * 16384);
    const int gw = C.vcu * NWAVES + C.wid, NGW = C.G * NWAVES;
    bf16* WguT = (bf16*)(C.ws + WS_R); bf16* WdT = (bf16*)(C.ws + WS_VM);
    constexpr int I_GU = 32 * 16 * 32, I_DN = 32 * 8 * 32;
    for (int it = gw; it < I_GU + I_DN; it += NGW) {
        if (it < I_GU) { const int e = it >> 9, r = it & 511, kb = r >> 5, nb = r & 31;
            transpose_item(a.in[I_WGU] + (size_t)e * 1024 * 1024 + (size_t)(64 * kb) * 1024 + 32 * nb, 1024, WguT + (size_t)e * 1024 * 1024, 1024, wgu_drow(32 * nb), 64 * kb, scr, C.lane); }
        else { const int r0 = it - I_GU, e = r0 >> 8, r = r0 & 255, kb = r >> 5, nb = r & 31;
            transpose_item(a.in[I_WDN] + (size_t)e * 512 * 1024 + (size_t)(64 * kb) * 1024 + 32 * nb, 1024, WdT + (size_t)e * 1024 * 512, 512, 32 * nb, 64 * kb, scr, C.lane); }
    }
}

constexpr int HG_QP = 0, HG_QS = 17408, HG_KP = 34816, HG_KPT = 52224, HG_VT = 70656, HG_TT = 89088, HG_OB = 123904, HG_SC = 141312, HG_SEG = 141824;
DI void hgrn_unit(const Ctx& C, const Args& a, int b, int h) {
    LAS unsigned char* L = C.lds;
    const int tid = C.tid, lane = C.lane, wid = C.wid;
    const int ch = tid & 127, seg = tid >> 7, q32 = lane & 31, hi = lane >> 5, dvb = wid & 3, tb = wid >> 2;
    const float* Zf = (const float*)(C.ws + WS_ZF); const bf16* Qh = (const bf16*)(C.ws + WS_QH); const bf16* Vh = (const bf16*)(C.ws + WS_VH); const bf16* Gh = (const bf16*)(C.ws + WS_GH);
    bf16* Ocat = (bf16*)(C.ws + WS_XB);
    float lb; { const float l0 = a.in[I_LBL][h * 128 + ch], l1 = a.in[I_LBL][512 + h * 128 + ch]; lb = 1.f / (1.f + expf(l1 - l0)); }
    const float oml = 1.f - lb;
    const float ng0 = a.in[I_HGNG][h * 128 + 2 * lane], ng1 = a.in[I_HGNG][h * 128 + 2 * lane + 1];
    const size_t rb = (size_t)b * SEQ;
    float z[16]; unsigned short qv[16], vv[16]; float bl[16], kk[16];
    f32x16 T0, T1;
#pragma unroll
    for (int r = 0; r < 16; ++r) { T0[r] = 0.f; T1[r] = 0.f; }
    float carry = 0.f;
#define HG_LOAD(c) do { const size_t r0_ = (rb + (size_t)(c) * 64 + seg * 16) * 512 + h * 128 + ch; _Pragma("unroll") for (int i = 0; i < 16; ++i) { z[i] = Zf[r0_ + (size_t)i * 512]; qv[i] = Qh[r0_ + (size_t)i * 512]; vv[i] = Vh[r0_ + (size_t)i * 512]; } } while (0)
#define HG_PREP1(c) do { float run_ = 0.f; _Pragma("unroll") for (int i = 0; i < 16; ++i) { const float sg_ = frcp(1.f + __expf(-z[i])); const float f_ = lb + oml * sg_; run_ += __logf(f_); bl[i] = run_; kk[i] = oml * (1.f - sg_); } \
        ((LAS float*)(L + HG_SEG))[((c) & 1) * 512 + seg * 128 + ch] = run_; } while (0)
#define HG_PREP2(c) do { const LAS float* sg_ = (const LAS float*)(L + HG_SEG) + ((c) & 1) * 512 + ch; const float s0_ = sg_[0], s1_ = sg_[128], s2_ = sg_[256], s3_ = sg_[384]; \
        const float pre_ = (seg > 0 ? s0_ : 0.f) + (seg > 1 ? s1_ : 0.f) + (seg > 2 ? s2_ : 0.f); const float bmid_ = s0_ + s1_, bend_ = bmid_ + s2_ + s3_; \
        unsigned kp_[8], vp_[8]; \
        _Pragma("unroll") for (int i = 0; i < 16; i += 2) { float q0_, q1_, k0_, k1_; unsigned w_; \
            { const float bb_ = pre_ + bl[i], qq_ = bf2f(qv[i]); q0_ = qq_ * __expf(bb_ - bmid_); k0_ = kk[i] * __expf(bmid_ - bb_); w_ = cvtpk(qq_ * __expf(bb_ + carry), 0.f); *(LAS bf16*)(L + HG_QS + (seg * 16 + i) * 272 + ch * 2) = (bf16)w_; } \
            { const float bb_ = pre_ + bl[i + 1], qq_ = bf2f(qv[i + 1]); q1_ = qq_ * __expf(bb_ - bmid_); k1_ = kk[i + 1] * __expf(bmid_ - bb_); w_ = cvtpk(qq_ * __expf(bb_ + carry), 0.f); *(LAS bf16*)(L + HG_QS + (seg * 16 + i + 1) * 272 + ch * 2) = (bf16)w_; } \
            const unsigned qp_ = cvtpk(q0_, q1_), kq_ = cvtpk(k0_, k1_); \
            *(LAS bf16*)(L + HG_QP + (seg * 16 + i) * 272 + ch * 2) = (bf16)(qp_ & 0xffffu); *(LAS bf16*)(L + HG_QP + (seg * 16 + i + 1) * 272 + ch * 2) = (bf16)(qp_ >> 16); \
            *(LAS bf16*)(L + HG_KP + (seg * 16 + i) * 272 + ch * 2) = (bf16)(kq_ & 0xffffu); *(LAS bf16*)(L + HG_KP + (seg * 16 + i + 1) * 272 + ch * 2) = (bf16)(kq_ >> 16); \
            kp_[i >> 1] = kq_; vp_[i >> 1] = (unsigned)vv[i] | ((unsigned)vv[i + 1] << 16); } \
        *(LAS u32x4*)(L + HG_KPT + ch * 144 + seg * 32) = (u32x4){kp_[0], kp_[1], kp_[2], kp_[3]}; *(LAS u32x4*)(L + HG_KPT + ch * 144 + seg * 32 + 16) = (u32x4){kp_[4], kp_[5], kp_[6], kp_[7]}; \
        *(LAS u32x4*)(L + HG_VT + ch * 144 + seg * 32) = (u32x4){vp_[0], vp_[1], vp_[2], vp_[3]}; *(LAS u32x4*)(L + HG_VT + ch * 144 + seg * 32 + 16) = (u32x4){vp_[4], vp_[5], vp_[6], vp_[7]}; \
        if (seg == 0) ((LAS float*)(L + HG_SC))[ch] = __expf(bmid_ + carry); \
        carry = bend_ - bmid_; } while (0)

    HG_LOAD(0);
    HG_PREP1(0);
    __syncthreads();
    HG_PREP2(0);
    HG_LOAD(1);
    for (int c = 0; c < 32; ++c) {
        __syncthreads();
        bf16x8 qf[8];
#pragma unroll
        for (int ks = 0; ks < 8; ++ks) qf[ks] = *(const LAS bf16x8*)(L + HG_QP + (32 * tb + q32) * 272 + 32 * ks + 16 * hi);
        f32x16 oT;
#pragma unroll
        for (int r = 0; r < 16; ++r) oT[r] = 0.f;
#pragma unroll
        for (int sb = 0; sb < 2; ++sb) {
            if (sb <= tb) {
                f32x16 pT;
#pragma unroll
                for (int r = 0; r < 16; ++r) pT[r] = 0.f;
#pragma unroll
                for (int ks = 0; ks < 8; ++ks) { const bf16x8 ka = *(const LAS bf16x8*)(L + HG_KP + (32 * sb + q32) * 272 + 32 * ks + 16 * hi); pT = MFMA32(ka, qf[ks], pT); }
                if (sb == tb) {
#pragma unroll
                    for (int r = 0; r < 16; ++r) if (crow(r, hi) > q32) pT[r] = 0.f;
                }
#pragma unroll
                for (int s2 = 0; s2 < 2; ++s2) {
                    u32x4 pw; pw.x = cvtpk(pT[8 * s2 + 0], pT[8 * s2 + 1]); pw.y = cvtpk(pT[8 * s2 + 2], pT[8 * s2 + 3]); pw.z = cvtpk(pT[8 * s2 + 4], pT[8 * s2 + 5]); pw.w = cvtpk(pT[8 * s2 + 6], pT[8 * s2 + 7]);
                    const LAS unsigned char* vp = L + HG_VT + (32 * dvb + q32) * 144 + (32 * sb + 16 * s2 + 4 * hi) * 2;
                    const u32x2 v0 = *(const LAS u32x2*)vp, v1 = *(const LAS u32x2*)(vp + 16);
                    const u32x4 va = (u32x4){v0.x, v0.y, v1.x, v1.y};
                    oT = MFMA32(__builtin_bit_cast(bf16x8, va), __builtin_bit_cast(bf16x8, pw), oT);
                }
            }
        }
        if (c > 0) {
#pragma unroll
            for (int ks = 0; ks < 8; ++ks) { const bf16x8 ta = *(const LAS bf16x8*)(L + HG_TT + (32 * dvb + q32) * 272 + 32 * ks + 16 * hi);
                const bf16x8 qs = *(const LAS bf16x8*)(L + HG_QS + (32 * tb + q32) * 272 + 32 * ks + 16 * hi); oT = MFMA32(ta, qs, oT); }
        }
#pragma unroll
        for (int g = 0; g < 4; ++g) { u32x2 w; w.x = cvtpk(oT[4 * g], oT[4 * g + 1]); w.y = cvtpk(oT[4 * g + 2], oT[4 * g + 3]);
            *(LAS u32x2*)(L + HG_OB + (32 * tb + q32) * 272 + (32 * dvb + 8 * g + 4 * hi) * 2) = w; }
        {
#pragma unroll
            for (int g = 0; g < 4; ++g) { const f32x4 s0 = *(const LAS f32x4*)(L + HG_SC + (32 * (2 * tb) + 8 * g + 4 * hi) * 4), s1 = *(const LAS f32x4*)(L + HG_SC + (32 * (2 * tb + 1) + 8 * g + 4 * hi) * 4);
#pragma unroll
                for (int j = 0; j < 4; ++j) { T0[4 * g + j] *= s0[j]; T1[4 * g + j] *= s1[j]; } }
#pragma unroll
            for (int s2 = 0; s2 < 4; ++s2) { const bf16x8 vb = *(const LAS bf16x8*)(L + HG_VT + (32 * dvb + q32) * 144 + 32 * s2 + 16 * hi);
                const bf16x8 k0 = *(const LAS bf16x8*)(L + HG_KPT + (32 * (2 * tb) + q32) * 144 + 32 * s2 + 16 * hi), k1 = *(const LAS bf16x8*)(L + HG_KPT + (32 * (2 * tb + 1) + q32) * 144 + 32 * s2 + 16 * hi);
                T0 = MFMA32(k0, vb, T0); T1 = MFMA32(k1, vb, T1); }
        }
        if (c + 1 < 32) HG_PREP1(c + 1);
        __syncthreads();
#pragma unroll
        for (int g = 0; g < 4; ++g) { u32x2 w0, w1; w0.x = cvtpk(T0[4 * g], T0[4 * g + 1]); w0.y = cvtpk(T0[4 * g + 2], T0[4 * g + 3]); w1.x = cvtpk(T1[4 * g], T1[4 * g + 1]); w1.y = cvtpk(T1[4 * g + 2], T1[4 * g + 3]);
            *(LAS u32x2*)(L + HG_TT + (32 * dvb + q32) * 272 + (32 * (2 * tb) + 8 * g + 4 * hi) * 2) = w0; *(LAS u32x2*)(L + HG_TT + (32 * dvb + q32) * 272 + (32 * (2 * tb + 1) + 8 * g + 4 * hi) * 2) = w1; }
        {
            unsigned gv[8];
#pragma unroll
            for (int i = 0; i < 8; ++i) gv[i] = *(const unsigned*)(Gh + (rb + (size_t)c * 64 + wid * 8 + i) * 512 + h * 128 + 2 * lane);
#pragma unroll
            for (int i = 0; i < 8; ++i) { const unsigned ow = *(const LAS unsigned*)(L + HG_OB + (wid * 8 + i) * 272 + lane * 4); const float o0 = bflo(ow), o1 = bfhi(ow);
                const float ss = wave_sum(o0 * o0 + o1 * o1); const float rs = __builtin_amdgcn_rsqf(ss * (1.f / 128.f) + LN_EPS);
                *(unsigned*)(Ocat + (rb + (size_t)c * 64 + wid * 8 + i) * 1024 + h * 128 + 2 * lane) = cvtpk(o0 * rs * ng0 * bflo(gv[i]), o1 * rs * ng1 * bfhi(gv[i])); }
        }
        if (c + 1 < 32) { HG_PREP2(c + 1); if (c + 2 < 32) HG_LOAD(c + 2); }
    }
    __syncthreads();
#undef HG_LOAD
#undef HG_PREP1
#undef HG_PREP2
}

constexpr int AT_K = 0, AT_V = 18432, AT_KM = 34816, AT_TAB = 36608;
DI int t5_bucket(int d) { if (d < 16) return d; const int v = 16 + (int)(logf((float)d * (1.f / 16.f)) / logf(8.f) * 16.f); return v < 31 ? v : 31; }
DI void attn_unit(const Ctx& C, const Args& a, int b, int h, int jq) {
    LAS unsigned char* L = C.lds;
    const int tid = C.tid, lane = C.lane, wid = C.wid, q32 = lane & 31, hi = lane >> 5;
    const bf16* Qm = (const bf16*)(C.ws + WS_QM); const bf16* Km = (const bf16*)(C.ws + WS_KM); const bf16* Vm = (const bf16*)(C.ws + WS_VM); const float* KM = (const float*)(C.ws + WS_KMEAN);
    bf16* Ocat = (bf16*)(C.ws + WS_XB);
    const int tq = jq * 256 + wid * 32 + q32;
    const size_t rowq = (size_t)b * SEQ + tq;
    bf16x8 qf[4];
#pragma unroll
    for (int ks = 0; ks < 4; ++ks) qf[ks] = *(const bf16x8*)(Qm + rowq * 512 + h * 64 + 16 * ks + 8 * hi);
    LAS float* kml = (LAS float*)(L + AT_KM); LAS float* tab = (LAS float*)(L + AT_TAB);
    if (tid < jq * 64) { const int n = tid >> 6, d = tid & 63; kml[tid] = KM[(size_t)((b * 8 + n) * 2 + 0) * 512 + h * 64 + d] + KM[(size_t)((b * 8 + n) * 2 + 1) * 512 + h * 64 + d]; }
    if (tid < 129) tab[tid] = a.in[I_RELB][t5_bucket(tid) * 8 + h] * LOG2E;
    const int srow = tid >> 3, sch = tid & 7;
    const size_t kvbase = ((size_t)b * SEQ + srow) * 512 + h * 64 + sch * 8;
    const int kdst = srow * 144 + sch * 16, vdst = srow * 128 + ((sch ^ (((srow >> 1) & 1) << 2)) << 4);
    u32x4 kreg = *(const u32x4*)(Km + kvbase), vreg = *(const u32x4*)(Vm + kvbase);
    *(LAS u32x4*)(L + AT_K + kdst) = kreg; *(LAS u32x4*)(L + AT_V + vdst) = vreg;
    __syncthreads();
    unsigned sel = 0;
    {
        float g[7];
#pragma unroll
        for (int n = 0; n < 7; ++n) { g[n] = 0.f;
            if (n < jq) { float s = 0.f;
#pragma unroll
                for (int ks = 0; ks < 4; ++ks)
#pragma unroll
                    for (int j = 0; j < 8; ++j) s += bf2f((unsigned short)qf[ks][j]) * kml[n * 64 + 16 * ks + 8 * hi + j];
                s += __shfl_xor(s, 32); g[n] = s; } }
#pragma unroll
        for (int n = 0; n < 7; ++n) if (n < jq) { int rank = 0;
#pragma unroll
            for (int m = 0; m < 7; ++m) if (m != n && m < jq) rank += (g[m] > g[n] || (g[m] == g[n] && m < n)) ? 1 : 0;
            if (rank < 3) sel |= 1u << n; }
    }
    const float c31 = tab[128];
    float mrun = -INFINITY, lrun = 0.f;
    f32x16 o0, o1;
#pragma unroll
    for (int r = 0; r < 16; ++r) { o0[r] = 0.f; o1[r] = 0.f; }
    const int i16 = lane & 15, qq = i16 >> 2, pp = i16 & 3, dh = (lane >> 4) & 1, xsw = (qq >> 1) & 1;
    const int vb0 = (4 * hi + qq) * 128 + 64 * (0 ^ xsw) + 32 * dh + 8 * pp, vb1 = (4 * hi + qq) * 128 + 64 * (1 ^ xsw) + 32 * dh + 8 * pp;
    const int nt = 4 * jq + 4;
    for (int kt = 0; kt < nt; ++kt) {
        const int cur = kt & 1;
        if (kt + 1 < nt) { kreg = *(const u32x4*)(Km + kvbase + (size_t)(kt + 1) * 64 * 512); vreg = *(const u32x4*)(Vm + kvbase + (size_t)(kt + 1) * 64 * 512); }
        const int blk = kt >> 2; const bool own = (blk == jq);
        const bool active = !own || ((kt & 3) * 64 <= wid * 32 + 31);
        if (active) {
            const LAS unsigned char* Kc = L + AT_K + cur * 9216; const LAS unsigned char* Vc = L + AT_V + cur * 8192;
            f32x16 s0, s1;
#pragma unroll
            for (int r = 0; r < 16; ++r) { s0[r] = 0.f; s1[r] = 0.f; }
#pragma unroll
            for (int ks = 0; ks < 4; ++ks) { const bf16x8 k0 = *(const LAS bf16x8*)(Kc + q32 * 144 + 32 * ks + 16 * hi), k1 = *(const LAS bf16x8*)(Kc + (32 + q32) * 144 + 32 * ks + 16 * hi);
                s0 = MFMA32(k0, qf[ks], s0); s1 = MFMA32(k1, qf[ks], s1); }
            const int dist0 = tq - 64 * kt - 4 * hi;
            const bool near = (jq * 256 + wid * 32 - 64 * kt - 63) < 128;
            if (near) {
#pragma unroll
                for (int r = 0; r < 16; ++r) { const int d0 = dist0 - ((r & 3) + 8 * (r >> 2)), d1 = d0 - 32;
                    const int i0 = d0 < 0 ? 0 : (d0 > 128 ? 128 : d0), i1 = d1 < 0 ? 0 : (d1 > 128 ? 128 : d1);
                    s0[r] = d0 < 0 ? -INFINITY : s0[r] + tab[i0]; s1[r] = d1 < 0 ? -INFINITY : s1[r] + tab[i1]; }
            } else {
#pragma unroll
                for (int r = 0; r < 16; ++r) { s0[r] += c31; s1[r] += c31; }
            }
            if (!own && !((sel >> blk) & 1u)) {
#pragma unroll
                for (int r = 0; r < 16; ++r) { s0[r] = -INFINITY; s1[r] = -INFINITY; }
            }
            float mx = fmaxf(s0[0], s1[0]);
#pragma unroll
            for (int r = 1; r < 16; ++r) mx = fmaxf(mx, fmaxf(s0[r], s1[r]));
            mx = fmaxf(mx, __shfl_xor(mx, 32));
            const float mnew = fmaxf(mrun, mx), msafe = (mnew == -INFINITY) ? 0.f : mnew;
            const float alpha = __builtin_amdgcn_exp2f(mrun - msafe);
            mrun = mnew;
            float ps = 0.f;
#pragma unroll
            for (int r = 0; r < 16; ++r) { s0[r] = __builtin_amdgcn_exp2f(s0[r] - msafe); s1[r] = __builtin_amdgcn_exp2f(s1[r] - msafe); ps += s0[r] + s1[r]; }
            lrun = lrun * alpha + ps;
#pragma unroll
            for (int r = 0; r < 16; ++r) { o0[r] *= alpha; o1[r] *= alpha; }
#pragma unroll
            for (int kb = 0; kb < 2; ++kb)
#pragma unroll
                for (int s2 = 0; s2 < 2; ++s2) {
                    u32x4 pw;
                    if (kb == 0) { pw.x = cvtpk(s0[8 * s2 + 0], s0[8 * s2 + 1]); pw.y = cvtpk(s0[8 * s2 + 2], s0[8 * s2 + 3]); pw.z = cvtpk(s0[8 * s2 + 4], s0[8 * s2 + 5]); pw.w = cvtpk(s0[8 * s2 + 6], s0[8 * s2 + 7]); }
                    else         { pw.x = cvtpk(s1[8 * s2 + 0], s1[8 * s2 + 1]); pw.y = cvtpk(s1[8 * s2 + 2], s1[8 * s2 + 3]); pw.z = cvtpk(s1[8 * s2 + 4], s1[8 * s2 + 5]); pw.w = cvtpk(s1[8 * s2 + 6], s1[8 * s2 + 7]); }
                    const bf16x8 pf = __builtin_bit_cast(bf16x8, pw);
                    const int ro = (32 * kb + 16 * s2) * 128;
                    const s16x4 a0l = vtr((LAS const char*)(Vc + vb0 + ro)), a0h = vtr((LAS const char*)(Vc + vb0 + ro + 8 * 128));
                    const s16x4 a1l = vtr((LAS const char*)(Vc + vb1 + ro)), a1h = vtr((LAS const char*)(Vc + vb1 + ro + 8 * 128));
                    o0 = MFMA32(((bf16x8){a0l[0], a0l[1], a0l[2], a0l[3], a0h[0], a0h[1], a0h[2], a0h[3]}), pf, o0);
                    o1 = MFMA32(((bf16x8){a1l[0], a1l[1], a1l[2], a1l[3], a1h[0], a1h[1], a1h[2], a1h[3]}), pf, o1);
                }
        }
        if (kt + 1 < nt) { *(LAS u32x4*)(L + AT_K + (cur ^ 1) * 9216 + kdst) = kreg; *(LAS u32x4*)(L + AT_V + (cur ^ 1) * 8192 + vdst) = vreg; }
        __syncthreads();
    }
    const float linv = 1.f / (lrun + __shfl_xor(lrun, 32));
    bf16* op = Ocat + rowq * 1024 + 512 + h * 64;
#pragma unroll
    for (int g = 0; g < 4; ++g) { u32x2 w0, w1; w0.x = cvtpk(o0[4 * g] * linv, o0[4 * g + 1] * linv); w0.y = cvtpk(o0[4 * g + 2] * linv, o0[4 * g + 3] * linv);
        w1.x = cvtpk(o1[4 * g] * linv, o1[4 * g + 1] * linv); w1.y = cvtpk(o1[4 * g + 2] * linv, o1[4 * g + 3] * linv);
        *(u32x2*)(op + 8 * g + 4 * hi) = w0; *(u32x2*)(op + 32 + 8 * g + 4 * hi) = w1; }
}

DI void p2_mixers(const Ctx& C, const Args& a) {
    for (int u = blockIdx.x; u < 64; u += C.G) hgrn_unit(C, a, u >> 2, u & 3);
    for (;;) {
        if (C.tid == 0) C.MISC[0] = __hip_atomic_fetch_add((unsigned*)(C.ctl + CW_QUEUE), 1u, __ATOMIC_RELAXED, __HIP_MEMORY_SCOPE_AGENT);
        __syncthreads();
        const int q = (int)C.MISC[0];
        __syncthreads();
        if (q >= 1024) break;
        attn_unit(C, a, (q & 127) >> 3, q & 7, 7 - (q >> 7));
    }
}

DI void r1_phase(const Ctx& C, const Args& a) {
    LAS unsigned char* L = C.lds;
    const int tid = C.tid, lane = C.lane, wid = C.wid;
    LAS float* LG = (LAS float*)L + wid * 16 * 48;
    LAS int* CNT = (LAS int*)(L + 32768);
    float* X1 = (float*)(C.ws + WS_ZF); bf16* X1b = (bf16*)(C.ws + WS_XB);
    const bf16* WrH = (const bf16*)(C.ws + WS_WRH); const bf16* WrL = (const bf16*)(C.ws + WS_WRL);
    unsigned* tokE = (unsigned*)(C.ws + WS_TOKE); float* tokW = (float*)(C.ws + WS_TOKW); int* wgcnt = (int*)(C.ws + WS_WGCNT);
    f32x4 g1[4], b1[4];
#pragma unroll
    for (int j = 0; j < 4; ++j) { g1[j] = *(const f32x4*)(a.in[I_LN1G] + 256 * j + 4 * lane); b1[j] = *(const f32x4*)(a.in[I_LN1B] + 256 * j + 4 * lane); }
    for (int chunk = blockIdx.x; chunk < NTOK / 128; chunk += C.G) {
        if (tid < 32) CNT[tid] = 0;
        __syncthreads();
        const int tok0 = chunk * 128 + wid * 16;
        for (int tt = 0; tt < 16; ++tt) {
            float* xr = X1 + (size_t)(tok0 + tt) * 1024 + 4 * lane;
            f32x4 v[4]; float s = 0.f;
#pragma unroll
            for (int j = 0; j < 4; ++j) { v[j] = *(const f32x4*)(xr + 256 * j); s += (v[j][0] + v[j][1]) + (v[j][2] + v[j][3]); }
            const float mean = wave_sum(s) * (1.f / 1024.f); float s2 = 0.f;
#pragma unroll
            for (int j = 0; j < 4; ++j) { v[j] = v[j] - mean; s2 += (v[j][0] * v[j][0] + v[j][1] * v[j][1]) + (v[j][2] * v[j][2] + v[j][3] * v[j][3]); }
            const float rstd = 1.f / sqrtf(wave_sum(s2) * (1.f / 1024.f) + LN_EPS);
            bf16* xb = X1b + (size_t)(tok0 + tt) * 1024 + 4 * lane;
#pragma unroll
            for (int j = 0; j < 4; ++j) { const f32x4 o = v[j] * rstd * g1[j] + b1[j]; *(f32x4*)(xr + 256 * j) = o; u32x2 w; w.x = cvtpk(o[0], o[1]); w.y = cvtpk(o[2], o[3]); *(u32x2*)(xb + 256 * j) = w; }
        }
        asm volatile("s_waitcnt vmcnt(0)" ::: "memory");
        f32x4 acc[3];
#pragma unroll
        for (int nb = 0; nb < 3; ++nb) acc[nb] = (f32x4){0.f, 0.f, 0.f, 0.f};
        const int m16 = lane & 15, kq = lane >> 4;
        const float* xrow = X1 + (size_t)(tok0 + m16) * 1024 + 8 * kq;
#pragma unroll 2
        for (int k0 = 0; k0 < 1024; k0 += 32) {
            const f32x4 xa = *(const f32x4*)(xrow + k0), xc = *(const f32x4*)(xrow + k0 + 4);
            u32x4 hw; hw.x = cvtpk(xa[0], xa[1]); hw.y = cvtpk(xa[2], xa[3]); hw.z = cvtpk(xc[0], xc[1]); hw.w = cvtpk(xc[2], xc[3]);
            u32x4 lw; lw.x = cvtpk(xa[0] - bflo(hw.x), xa[1] - bfhi(hw.x)); lw.y = cvtpk(xa[2] - bflo(hw.y), xa[3] - bfhi(hw.y)); lw.z = cvtpk(xc[0] - bflo(hw.z), xc[1] - bfhi(hw.z)); lw.w = cvtpk(xc[2] - bflo(hw.w), xc[3] - bfhi(hw.w));
            const bf16x8 xh = __builtin_bit_cast(bf16x8, hw), xl = __builtin_bit_cast(bf16x8, lw);
#pragma unroll
            for (int nb = 0; nb < 3; ++nb) { const size_t wo = (size_t)(nb * 16 + m16) * 1024 + k0 + 8 * kq;
                const bf16x8 wh = *(const bf16x8*)(WrH + wo), wl = *(const bf16x8*)(WrL + wo);
                acc[nb] = MFMA16(wh, xh, acc[nb]); acc[nb] = MFMA16(wl, xh, acc[nb]); acc[nb] = MFMA16(wh, xl, acc[nb]); }
        }
#pragma unroll
        for (int nb = 0; nb < 3; ++nb)
#pragma unroll
            for (int r = 0; r < 4; ++r) LG[m16 * 48 + nb * 16 + 4 * kq + r] = acc[nb][r];
        asm volatile("s_waitcnt lgkmcnt(0)" ::: "memory");
        if (lane < 16) {
            const LAS float* lg = LG + lane * 48;
            float gl[4];
#pragma unroll
            for (int j = 0; j < 4; ++j) gl[j] = lg[j] + a.in[I_BGRP][j];
            int grp = 0; float gm = gl[0];
#pragma unroll
            for (int j = 1; j < 4; ++j) if (gl[j] > gm) { gm = gl[j]; grp = j; }
            float se = 0.f;
#pragma unroll
            for (int j = 0; j < 4; ++j) se += expf(gl[j] - gm);
            const float pg = 1.f / se;
            float el[8];
#pragma unroll
            for (int j = 0; j < 8; ++j) el[j] = lg[4 + grp * 8 + j] + a.in[I_BEXP][grp * 8 + j];
            int i0 = 0; float v0 = el[0];
#pragma unroll
            for (int j = 1; j < 8; ++j) if (el[j] > v0) { v0 = el[j]; i0 = j; }
            int i1 = -1; float v1 = -INFINITY;
#pragma unroll
            for (int j = 0; j < 8; ++j) if (j != i0 && el[j] > v1) { v1 = el[j]; i1 = j; }
            const float w0 = 1.f / (1.f + expf(v1 - v0)), w1 = 1.f - w0;
            const int e0 = grp * 8 + i0, e1 = grp * 8 + i1;
            const int r0 = __hip_atomic_fetch_add(CNT + e0, 1, __ATOMIC_RELAXED, __HIP_MEMORY_SCOPE_WORKGROUP), r1 = __hip_atomic_fetch_add(CNT + e1, 1, __ATOMIC_RELAXED, __HIP_MEMORY_SCOPE_WORKGROUP);
            const int tok = tok0 + lane;
            tokE[tok] = (unsigned)e0 | ((unsigned)e1 << 8) | ((unsigned)r0 << 16) | ((unsigned)r1 << 24);
            tokW[tok * 2] = w0 * pg; tokW[tok * 2 + 1] = w1 * pg;
        }
        __syncthreads();
        if (tid < 32) wgcnt[chunk * 32 + tid] = CNT[tid];
        __syncthreads();
    }
}

DI void r2_phase(const Ctx& C, const Args& a) {
    LAS int* PA = (LAS int*)C.lds;
    LAS int* PB = PA + 512;
    LAS int* TOT = PB + 512; LAS int* BASE = TOT + 32; LAS int* PST = BASE + 32;
    const int tid = C.tid;
    const int* wgcnt = (const int*)(C.ws + WS_WGCNT); const unsigned* tokE = (const unsigned*)(C.ws + WS_TOKE);
    int* tokD = (int*)(C.ws + WS_TOKD); int* rowtok = (int*)(C.ws + WS_ROWTOK); int* tilee = (int*)(C.ws + WS_TILEE);
    for (int chunk = blockIdx.x; chunk < NTOK / 128; chunk += C.G) {
        { const int e = tid & 31, part = tid >> 5; int sa = 0, sb = 0;
          for (int c = part * 16; c < part * 16 + 16; ++c) { const int v = wgcnt[c * 32 + e]; sa += v; sb += (c < chunk) ? v : 0; }
          PA[part * 32 + e] = sa; PB[part * 32 + e] = sb; }
        __syncthreads();
        if (tid < 32) { int sa = 0, sb = 0; for (int p = 0; p < 16; ++p) { sa += PA[p * 32 + tid]; sb += PB[p * 32 + tid]; } TOT[tid] = sa; BASE[tid] = sb; }
        __syncthreads();
        if (tid == 0) { int ps = 0; for (int e = 0; e < 32; ++e) { PST[e] = ps; ps += ((TOT[e] + 255) >> 8) << 8; } PST[32] = ps; }
        __syncthreads();
        if (tid < 128) { const int tok = chunk * 128 + tid; const unsigned w = tokE[tok]; const int e0 = w & 31, e1 = (w >> 8) & 31, r0 = (w >> 16) & 255, r1 = (w >> 24) & 255;
            const int d0 = PST[e0] + BASE[e0] + r0, d1 = PST[e1] + BASE[e1] + r1; rowtok[d0] = tok; rowtok[d1] = tok; tokD[tok * 2] = d0; tokD[tok * 2 + 1] = d1; }
        if (chunk < 32) { const int e = chunk, end = PST[e + 1] - PST[e]; for (int i = TOT[e] + tid; i < end; i += NTHREADS) rowtok[PST[e] + i] = 0; }
        if (chunk == 0) { if (tid < 32) { for (int t = PST[tid] >> 8; t < (PST[tid + 1] >> 8); ++t) tilee[t] = tid; } if (tid == 0) tilee[511] = PST[32] >> 8; }
        __syncthreads();
    }
}

DI void f_phase(const Ctx& C, const Args& a) {
    const int lane = C.lane, gw = C.vcu * NWAVES + C.wid, NGW = C.G * NWAVES;
    const float* X1 = (const float*)(C.ws + WS_ZF); const bf16* Y = (const bf16*)(C.ws + WS_Y); const int* tokD = (const int*)(C.ws + WS_TOKD); const float* tokW = (const float*)(C.ws + WS_TOKW);
    f32x4 g2[4], b2[4];
#pragma unroll
    for (int j = 0; j < 4; ++j) { g2[j] = *(const f32x4*)(a.in[I_LN2G] + 256 * j + 4 * lane); b2[j] = *(const f32x4*)(a.in[I_LN2B] + 256 * j + 4 * lane); }
    for (int tok = gw; tok < NTOK; tok += NGW) {
        const int d0 = tokD[tok * 2], d1 = tokD[tok * 2 + 1]; const float w0 = tokW[tok * 2], w1 = tokW[tok * 2 + 1];
        const float* xr = X1 + (size_t)tok * 1024 + 4 * lane; const bf16* y0 = Y + (size_t)d0 * 1024 + 4 * lane; const bf16* y1 = Y + (size_t)d1 * 1024 + 4 * lane;
        f32x4 v[4]; float s = 0.f;
#pragma unroll
        for (int j = 0; j < 4; ++j) { const f32x4 x = *(const f32x4*)(xr + 256 * j); const u32x2 p0 = *(const u32x2*)(y0 + 256 * j), p1 = *(const u32x2*)(y1 + 256 * j);
            v[j] = x * DN_ALPHA + (f32x4){bflo(p0.x), bfhi(p0.x), bflo(p0.y), bfhi(p0.y)} * w0 + (f32x4){bflo(p1.x), bfhi(p1.x), bflo(p1.y), bfhi(p1.y)} * w1;
            s += (v[j][0] + v[j][1]) + (v[j][2] + v[j][3]); }
        const float mean = wave_sum(s) * (1.f / 1024.f); float s2 = 0.f;
#pragma unroll
        for (int j = 0; j < 4; ++j) { v[j] = v[j] - mean; s2 += (v[j][0] * v[j][0] + v[j][1] * v[j][1]) + (v[j][2] * v[j][2] + v[j][3] * v[j][3]); }
        const float rstd = 1.f / sqrtf(wave_sum(s2) * (1.f / 1024.f) + LN_EPS);
        float* orow = a.out + (size_t)tok * 1024 + 4 * lane;
#pragma unroll
        for (int j = 0; j < 4; ++j) *(f32x4*)(orow + 256 * j) = v[j] * rstd * g2[j] + b2[j];
    }
}

constexpr int NPH = 10;
__global__ void __launch_bounds__(NTHREADS, 2) mk_fwd(Args args) {
    extern __shared__ __attribute__((aligned(16))) unsigned char lds_raw[];
    Ctx C;
    C.lds = (LAS unsigned char*)lds_raw; C.MISC = (volatile LAS unsigned*)(C.lds + MISC_OFF);
    C.tid = threadIdx.x; C.lane = C.tid & 63; C.wid = __builtin_amdgcn_readfirstlane(C.tid >> 6);
    C.G = gridDim.x; { const int bx = blockIdx.x; C.vcu = (C.G % 8 == 0) ? (bx % 8) * (C.G / 8) + bx / 8 : bx; }
    C.ws = args.ws; C.ctl = (gu32*)(args.ws + WS_CTL);
    if (C.tid < 64) C.MISC[C.tid] = 0u;
    __syncthreads();
    XcdBarrier bar; bar.bar = (unsigned*)(C.ctl + CW_BAR); bar.x = 0; bar.st = nullptr;
    if (MK_N_LAUNCHES == 1) bar = xcd_barrier_post((unsigned*)(C.ctl + CW_BAR), C.MISC + 8);
    const int lo = args.ph_lo, hi = args.ph_hi;
#ifndef PH_MASK
#define PH_MASK 0x3ff
#endif
#define IN(k) (((PH_MASK >> (k)) & 1) && lo <= (k) && (k) < hi)
#define SEAM(k) do { if (IN(k) && IN((k) + 1)) xcd_barrier(bar); } while (0)
    unsigned char* ws = args.ws;
    LAS unsigned char* ring = C.lds;

    if (IN(0)) { p0_prologue(C, args); } SEAM(0);

    if (IN(1)) {
        pg8::DenseOrder S; S.init(ws + WS_XB, ws + WS_WIN, NTOK, NIN, 1024, C.G, (int)blockIdx.x);
        pg8::EpiIn E{(bf16*)(ws + WS_QH), (bf16*)(ws + WS_VH), (bf16*)(ws + WS_GH), (bf16*)(ws + WS_QM), (bf16*)(ws + WS_KM), (bf16*)(ws + WS_VM), (bf16*)(ws + WS_R), (bf16*)(ws + WS_GB),
                     (float*)(ws + WS_ZF), (float*)(ws + WS_KMEAN), (const float*)(ws + WS_BPERM)};
        pg8::gemm_phase<pg8::EpiIn, pg8::DenseOrder, false>(ring, 1024, S, E);
    } SEAM(1);

    if (IN(2)) { p2_mixers(C, args); } SEAM(2);

    if (IN(3)) {
        pg8::DenseOrder S; S.init(ws + WS_XB, ws + WS_WCAT, NTOK, 1024, 1024, C.G, (int)blockIdx.x);
        pg8::EpiProj E{(const bf16*)(ws + WS_R), (const bf16*)(ws + WS_GB), (bf16*)(ws + WS_QH)};
        pg8::gemm_phase<pg8::EpiProj, pg8::DenseOrder, false>(ring, 1024, S, E);
    } SEAM(3);

    if (IN(4)) {
        pg8::DenseOrder S; S.init(ws + WS_QH, ws + WS_WO, NTOK, 1024, 1024, C.G, (int)blockIdx.x);
        pg8::EpiOut E{args.in[I_X], (float*)(ws + WS_ZF)};
        pg8::gemm_phase<pg8::EpiOut, pg8::DenseOrder, false>(ring, 1024, S, E);
        __syncthreads();
        p4b_convert_moe(C, args);
    } SEAM(4);

    if (IN(5)) { r1_phase(C, args); } SEAM(5);
    if (IN(6)) { r2_phase(C, args); } SEAM(6);

    if (IN(7)) {
        const int* tilee = (const int*)(ws + WS_TILEE);
        const int ntl = __builtin_amdgcn_readfirstlane(__hip_atomic_load(tilee + 511, __ATOMIC_RELAXED, __HIP_MEMORY_SCOPE_AGENT));
        pg8::MoeOrder S{(const char*)(ws + WS_XB), (const char*)(ws + WS_R), (const int*)(ws + WS_ROWTOK), tilee, 1024, 1024, ntl * 4, C.G, C.vcu, true};
        pg8::EpiM1 E{(bf16*)(ws + WS_QH)};
        pg8::gemm_phase<pg8::EpiM1, pg8::MoeOrder, true>(ring, 1024, S, E);
    } SEAM(7);

    if (IN(8)) {
        const int* tilee = (const int*)(ws + WS_TILEE);
        const int ntl = __builtin_amdgcn_readfirstlane(__hip_atomic_load(tilee + 511, __ATOMIC_RELAXED, __HIP_MEMORY_SCOPE_AGENT));
        pg8::MoeOrder S{(const char*)(ws + WS_QH), (const char*)(ws + WS_VM), (const int*)(ws + WS_ROWTOK), tilee, 512, 1024, ntl * 4, C.G, C.vcu, false};
        pg8::EpiM2 E{(bf16*)(ws + WS_Y)};
        pg8::gemm_phase<pg8::EpiM2, pg8::MoeOrder, false>(ring, 512, S, E);
    } SEAM(8);

    if (IN(9)) { f_phase(C, args); }
#undef IN
#undef SEAM
}

extern "C" void kernel_launch(void* const* d_in, const int* in_sizes, int n_in, void* d_out, int out_size, void* d_ws, size_t ws_size, hipStream_t stream) {
    static int grid = 0;
    if (grid == 0) {
        if (n_in != 19 || in_sizes[0] != NTOK * DM || out_size != NTOK * DM || ws_size < WS_END) { fprintf(stderr, "kernel_launch: unexpected problem shape / workspace; nothing launched\n"); grid = -1; return; }
        int dev = 0, cus = 0, per_cu = 0;
        if (hipGetDevice(&dev) != hipSuccess || hipDeviceGetAttribute(&cus, hipDeviceAttributeMultiprocessorCount, dev) != hipSuccess) { grid = -1; return; }
        if (hipFuncSetAttribute((const void*)mk_fwd, hipFuncAttributeMaxDynamicSharedMemorySize, LDS_BYTES) != hipSuccess) { fprintf(stderr, "kernel_launch: hipFuncSetAttribute failed\n"); grid = -1; return; }
        if (hipOccupancyMaxActiveBlocksPerMultiprocessor(&per_cu, (const void*)mk_fwd, NTHREADS, LDS_BYTES) != hipSuccess || per_cu < 1) { fprintf(stderr, "kernel_launch: occupancy query says %d\n", per_cu); }
        (void)hipGetLastError();
        grid = cus;
    }
    if (grid < 0) return;
    (void)hipMemsetAsync((char*)d_ws + WS_CTL, 0, CTL_ZERO_BYTES, stream);
    Args a{};
    for (int i = 0; i < 19; ++i) a.in[i] = (const float*)d_in[i];
    a.out = (float*)d_out; a.ws = (unsigned char*)d_ws;
    if (MK_N_LAUNCHES == 1) { a.ph_lo = 0; a.ph_hi = NPH; hipLaunchKernelGGL(mk_fwd, dim3(grid), dim3(NTHREADS), LDS_BYTES, stream, a); }
    else for (int p = 0; p < NPH; ++p) { a.ph_lo = p; a.ph_hi = p + 1; hipLaunchKernelGGL(mk_fwd, dim3(grid), dim3(NTHREADS), LDS_BYTES, stream, a); }
}
```

```cpp
#include <hip/hip_runtime.h>
#include <cstdio>
#include <cstdint>
#ifndef MK_N_LAUNCHES
#define MK_N_LAUNCHES 1
#endif
#define DI __device__ __forceinline__
#define GAS __attribute__((address_space(1)))
#define LAS __attribute__((address_space(3)))
typedef unsigned short bf16;
typedef unsigned u32x4 __attribute__((ext_vector_type(4)));
typedef unsigned u32x2 __attribute__((ext_vector_type(2)));
typedef float f32x4 __attribute__((ext_vector_type(4)));
typedef float f32x2 __attribute__((ext_vector_type(2)));
typedef float f32x16 __attribute__((ext_vector_type(16)));
typedef short bf16x8 __attribute__((ext_vector_type(8)));
typedef short s16x4 __attribute__((ext_vector_type(4)));
typedef short v4i16_t __attribute__((ext_vector_type(4)));
typedef __bf16 bf16x2_t __attribute__((ext_vector_type(2)));
typedef GAS unsigned gu32;

constexpr int NTOK = 32768, DM = 1024, SEQ = 2048, NBATCH = 16, NIN = 5632;
constexpr int NWAVES = 8, NTHREADS = 512;
constexpr float LN_EPS = 1e-5f, DN_ALPHA = 1.189207115002721f, LOG2E = 1.4426950408889634f;
constexpr int MOE_MAXTILES = 288;

constexpr size_t MiB = 1u << 20;
constexpr size_t WS_CTL = 0, CTL_ZERO_BYTES = 65536;
constexpr size_t WS_WIN = 1 * MiB, WS_WCAT = 12 * MiB, WS_WO = 14 * MiB;
constexpr size_t WS_XB = 16 * MiB;
constexpr size_t WS_R = 80 * MiB;
constexpr size_t WS_GB = 144 * MiB;
constexpr size_t WS_QH = 208 * MiB;
constexpr size_t WS_VH = 240 * MiB;
constexpr size_t WS_GH = 272 * MiB;
constexpr size_t WS_ZF = 304 * MiB;
constexpr size_t WS_QM = 368 * MiB, WS_KM = 400 * MiB;
constexpr size_t WS_VM = 432 * MiB;
constexpr size_t WS_Y = 16 * MiB;
constexpr size_t WS_MISC = 464 * MiB;
constexpr size_t WS_KMEAN = WS_MISC;
constexpr size_t WS_BPERM = WS_MISC + 1 * MiB;
constexpr size_t WS_WRH = WS_MISC + 2 * MiB;
constexpr size_t WS_WRL = WS_WRH + 98304;
constexpr size_t WS_TOKE = WS_MISC + 3 * MiB;
constexpr size_t WS_TOKW = WS_MISC + 4 * MiB;
constexpr size_t WS_TOKD = WS_MISC + 5 * MiB;
constexpr size_t WS_WGCNT = WS_MISC + 6 * MiB;
constexpr size_t WS_ROWTOK = WS_MISC + 7 * MiB;
constexpr size_t WS_TILEE = WS_MISC + 8 * MiB;
constexpr size_t WS_STATS = WS_MISC + 9 * MiB;
constexpr size_t WS_END = 512 * MiB;
constexpr int CW_BAR = 4096, CW_QUEUE = 8192, CW_QUEUE2 = 8192 + 1024;

constexpr int LDS_BYTES = 163840, MISC_OFF = LDS_BYTES - 256;

DI unsigned cvtpk(float lo, float hi) { f32x2 v = {lo, hi}; bf16x2_t b = __builtin_convertvector(v, bf16x2_t); return __builtin_bit_cast(unsigned, b); }
DI float bflo(unsigned w) { return __uint_as_float(w << 16); }
DI float bfhi(unsigned w) { return __uint_as_float(w & 0xffff0000u); }
DI float bf2f(unsigned short h) { return __uint_as_float((unsigned)h << 16); }
DI float frcp(float x) { return __builtin_amdgcn_rcpf(x); }
DI float fsigmoid(float x) { return frcp(1.f + __expf(-x)); }
DI float wave_sum(float v) {
#pragma unroll
    for (int o = 1; o < 64; o <<= 1) v += __shfl_xor(v, o);
    return v;
}
DI int crow(int r, int hi) { return (r & 3) + 8 * (r >> 2) + 4 * hi; }
#define MFMA32(a, b, c) __builtin_amdgcn_mfma_f32_32x32x16_bf16((a), (b), (c), 0, 0, 0)
#define MFMA16(a, b, c) __builtin_amdgcn_mfma_f32_16x16x32_bf16((a), (b), (c), 0, 0, 0)
DI s16x4 vtr(LAS const char* p) { return __builtin_bit_cast(s16x4, __builtin_amdgcn_ds_read_tr16_b64_v4i16((LAS v4i16_t*)p)); }

#define XB_TMO      128
#define XB_XCNT(j)  (256  + 64 * (j))
#define XB_XSUB(j)  (1280 + 64 * (j))
#define XB_XGEN(j)  (2304 + 64 * (j))
#define XB_TOP      3328
#define XB_TOPGEN   3392
#define XCD_BAR_WORDS 3456
#define XB_SPIN_CAP (1u << 22)
DI unsigned xb_ld(unsigned* p)              { return __hip_atomic_load(p, __ATOMIC_RELAXED, __HIP_MEMORY_SCOPE_AGENT); }
DI unsigned xb_add(unsigned* p, unsigned v) { return __hip_atomic_fetch_add(p, v, __ATOMIC_RELAXED, __HIP_MEMORY_SCOPE_AGENT); }
DI unsigned xb_xcc_id() { return (unsigned)__builtin_amdgcn_s_getreg((3 << 11) | 20) & 0xFu; }
#define XB_SPIN(cond, bar) do { unsigned _sp = 0; while (cond) { __builtin_amdgcn_s_sleep(1); \
    if ((++_sp & 255u) == 0u) { if (xb_ld(&(bar)[XB_TMO])) break; if (_sp > XB_SPIN_CAP) { atomicAdd(&(bar)[XB_TMO], 1u); break; } } } } while (0)
struct XcdBarrier { unsigned* bar; unsigned x; volatile LAS unsigned* st; };
DI XcdBarrier xcd_barrier_post(unsigned* bar, volatile LAS unsigned* st) {
    XcdBarrier b; b.bar = bar; b.x = xb_xcc_id(); b.st = st;
    if (threadIdx.x == 0) (void)xb_add(&bar[XB_XCNT(b.x)], 1u);
    return b;
}
DI void xcd_barrier_complete(unsigned* bar, unsigned x, unsigned& nloc, unsigned& nx) {
    const unsigned G = gridDim.x * gridDim.y * gridDim.z;
    unsigned sum, cnt, mine, sp = 0u;
    for (;;) {
        sum = 0u; cnt = 0u; mine = 0u;
#pragma unroll
        for (unsigned j = 0; j < 16; ++j) { const unsigned c = xb_ld(&bar[XB_XCNT(j)]); sum += c; cnt += (c > 0u) ? 1u : 0u; mine = (j == x) ? c : mine; }
        if (sum == G) break;
        __builtin_amdgcn_s_sleep(1);
        if ((++sp & 255u) == 0u) { if (xb_ld(&bar[XB_TMO])) break; if (sp > XB_SPIN_CAP) { atomicAdd(&bar[XB_TMO], 1u); break; } }
    }
    nloc = mine > 0u ? mine : 1u; nx = cnt > 0u ? cnt : 1u;
}
DI void xcd_barrier(const XcdBarrier& b) {
    asm volatile("s_waitcnt vmcnt(0)" ::: "memory");
    __syncthreads();
    if (threadIdx.x == 0) {
        unsigned* bar = b.bar;
        __builtin_amdgcn_s_waitcnt(0);
        unsigned nloc = b.st[0], nx = b.st[1];
        if (nloc == 0u) { xcd_barrier_complete(bar, b.x, nloc, nx); b.st[0] = nloc; b.st[1] = nx; }
        const unsigned old = xb_add(&bar[XB_XSUB(b.x)], 1u);
        const unsigned gen = old / nloc;
        if (old + 1u == (gen + 1u) * nloc) {
            __builtin_amdgcn_fence(__ATOMIC_RELEASE, "agent");
            asm volatile("s_waitcnt vmcnt(0)" ::: "memory");
            const unsigned og = xb_add(&bar[XB_TOP], 1u);
            const unsigned tg = og / nx;
            if (og + 1u == (tg + 1u) * nx) xb_add(&bar[XB_TOPGEN], 1u);
            else XB_SPIN(xb_ld(&bar[XB_TOPGEN]) == tg, bar);
            __builtin_amdgcn_fence(__ATOMIC_ACQUIRE, "agent");
            xb_add(&bar[XB_XGEN(b.x)], 1u);
            asm volatile("s_waitcnt vmcnt(0)" ::: "memory");
        } else {
            XB_SPIN(xb_ld(&bar[XB_XGEN(b.x)]) == gen, bar);
            __builtin_amdgcn_fence(__ATOMIC_ACQUIRE, "agent");
            asm volatile("s_waitcnt vmcnt(0)" ::: "memory");
        }
    }
    __syncthreads();
}

namespace pg8 {
constexpr int BM = 256, BK = 64, HALF = 128, HTB = HALF * BK * 2, STAGE_BYTES = 8 * HTB, NXCD = 8, WGM = 8;
DI int lds_byte(int r, int c) { const int st = (r >> 4) * 2 + (c >> 5), rr = r & 15, cc = c & 31, ob = rr * 64 + cc * 2; return st * 1024 + (ob ^ (((ob >> 9) & 1) << 5)); }
DI void stage_rc(int b, int& R, int& C) { const int st = b / 1024, sb = b % 1024, swz = sb ^ (((sb >> 9) & 1) << 5); R = (st >> 1) * 16 + swz / 64; C = (st & 1) * 32 + (swz % 64) / 2; }
DI int perm32(int rho) { const int n = rho >> 4, i = rho & 15; return 8 * (i >> 2) + 4 * n + (i & 3); }
struct Unit { int pm, pn, e; };

struct DenseOrder {
    const char* A; const char* Bt; int K, nM, nN, nwg, G, c;
    DI void init(const void* A_, const void* Bt_, int M, int N, int K_, int G_, int c_) { A = (const char*)A_; Bt = (const char*)Bt_; K = K_; nM = M / BM; nN = N / BM; nwg = nM * nN; G = G_; c = c_; }
    DI bool next(int i, Unit& u) const {
        const long L = (long)i * G + c; if (L >= nwg) return false;
        int wgid = (int)L; { const int q = nwg / NXCD, r = nwg % NXCD, xcd = wgid % NXCD, off = wgid / NXCD; wgid = (xcd < r ? xcd * (q + 1) : r * (q + 1) + (xcd - r) * q) + off; }
        const int nig = WGM * nN, gid = wgid / nig, fm = gid * WGM, gsz = (nM - fm) < WGM ? (nM - fm) : WGM;
        u.pm = fm + ((wgid % nig) % gsz); u.pn = (wgid % nig) / gsz; u.e = 0; return true;
    }
    DI const char* a_base(const Unit& u) const { return A + (size_t)u.pm * 512 * K; }
    DI const char* b_base(const Unit& u) const { return Bt + (size_t)u.pn * 512 * K; }
    DI void gather(const Unit&, const int (&)[2], const int (&)[2], unsigned (&)[2][2]) const {}
};
struct MoeOrder {
    const char* A; const char* Bt; const int* row_tok; const int* tile_e; int K, N, nunits, G, c; bool gat;
    DI bool next(int i, Unit& u) const {
        const int L = i * G + c; if (L >= nunits) return false;
        u.pm = L >> 2; u.pn = L & 3;
        u.e = __builtin_amdgcn_readfirstlane(__hip_atomic_load(tile_e + u.pm, __ATOMIC_RELAXED, __HIP_MEMORY_SCOPE_AGENT)); return true;
    }
    DI const char* a_base(const Unit& u) const { return gat ? A : A + (size_t)u.pm * 512 * K; }
    DI const char* b_base(const Unit& u) const { return Bt + ((size_t)u.e * N + (size_t)u.pn * 256) * K * 2; }
    DI void gather(const Unit& u, const int (&Rr)[2], const int (&Cc)[2], unsigned (&o)[2][2]) const {
#pragma unroll
        for (int h = 0; h < 2; ++h)
#pragma unroll
            for (int i = 0; i < 2; ++i) { const int tok = row_tok[u.pm * 256 + h * 128 + Rr[i]]; o[h][i] = (unsigned)(tok * K + Cc[i]) * 2u; }
    }
};

template <class Epi, class Sched, bool GATHER>
DI void gemm_phase(LAS unsigned char* lds, const int K, const Sched& S, const Epi& E) {
    const int tid = threadIdx.x, wid = __builtin_amdgcn_readfirstlane(tid >> 6), lane = tid & 63, wr = wid >> 2, wc = wid & 3, fr = lane & 15, fq = lane >> 4;
    const int nt = K / BK;
    unsigned voffB[2], vA[2][2], nvA[2][2]; int Rr[2], Cc[2];
#pragma unroll
    for (int i = 0; i < 2; ++i) { int R, C; stage_rc(tid * 16 + i * 8192, R, C); Rr[i] = R; Cc[i] = C; const int Rb = (R & ~31) + perm32(R & 31);
        voffB[i] = (unsigned)(Rb * K + C) * 2u; vA[0][i] = (unsigned)(R * K + C) * 2u; vA[1][i] = (unsigned)((R + HALF) * K + C) * 2u; nvA[0][i] = vA[0][i]; nvA[1][i] = vA[1][i]; }
    const size_t kstep = (size_t)(BK * 2);
    const size_t hstep = (size_t)HALF * K * 2;
    const unsigned ldsw = (unsigned)wid * 1024u;
    const int aoff = lds_byte(wr * 64 + fr, fq * 8), boff = lds_byte(wc * 32 + fr, fq * 8);
#define PG8_SA(b, h) (((b) * 2 + (h)) * HTB)
#define PG8_SB(b, h) ((4 + (b) * 2 + (h)) * HTB)
#define PG8_STAGE(bufoff, gbase, voff) do { _Pragma("unroll") for (int _i = 0; _i < 2; ++_i) \
        __builtin_amdgcn_global_load_lds((const unsigned*)((const char*)(gbase) + (voff)[_i]), (LAS unsigned*)(lds + (bufoff) + ldsw + _i * 8192), 16, 0, 0); } while (0)
#define PG8_LDA(dst, b, h) do { _Pragma("unroll") for (int m = 0; m < 4; ++m) _Pragma("unroll") for (int k = 0; k < 2; ++k) dst[m][k] = *(const LAS bf16x8*)(lds + PG8_SA(b, h) + aoff + m * 2048 + k * 1024); } while (0)
#define PG8_LDB(dst, b, h) do { _Pragma("unroll") for (int n = 0; n < 2; ++n) _Pragma("unroll") for (int k = 0; k < 2; ++k) dst[n][k] = *(const LAS bf16x8*)(lds + PG8_SB(b, h) + boff + n * 2048 + k * 1024); } while (0)
#define PG8_MMA(ai, bj, At, Bt) do { __builtin_amdgcn_s_setprio(1); _Pragma("unroll") for (int m = 0; m < 4; ++m) _Pragma("unroll") for (int n = 0; n < 2; ++n) _Pragma("unroll") for (int k = 0; k < 2; ++k) \
        acc[ai][bj][m][n] = __builtin_amdgcn_mfma_f32_16x16x32_bf16(Bt[n][k], At[m][k], acc[ai][bj][m][n], 0, 0, 0); __builtin_amdgcn_s_setprio(0); } while (0)
#define PG8_WAIT_V(n) asm volatile("s_waitcnt vmcnt(" #n ")" ::: "memory")
#define PG8_WAIT_L(n) asm volatile("s_waitcnt lgkmcnt(" #n ")" ::: "memory")
#define PG8_BAR __builtin_amdgcn_s_barrier()
#define PG8_SCHED __builtin_amdgcn_sched_barrier(0)
    Unit cur, nxt; int ui = 0;
    if (!S.next(0, cur)) return;
    if constexpr (GATHER) S.gather(cur, Rr, Cc, vA);
    f32x4 acc[2][2][4][2];
#pragma unroll
    for (int a = 0; a < 2; ++a)
#pragma unroll
        for (int b = 0; b < 2; ++b)
#pragma unroll
            for (int m = 0; m < 4; ++m)
#pragma unroll
                for (int n = 0; n < 2; ++n) acc[a][b][m][n] = (f32x4){0.f, 0.f, 0.f, 0.f};
    bf16x8 At[4][2], B0[2][2], B1[2][2];
    const char* cA = S.a_base(cur); const char* cB = S.b_base(cur);
    PG8_STAGE(PG8_SB(0, 0), cB, voffB); PG8_STAGE(PG8_SB(0, 1), cB + hstep, voffB); PG8_STAGE(PG8_SA(0, 0), cA, vA[0]); PG8_STAGE(PG8_SA(0, 1), cA, vA[1]);
    if (wr == 1) PG8_BAR;
    PG8_WAIT_V(2); PG8_BAR;
    PG8_STAGE(PG8_SB(1, 0), cB + kstep, voffB); PG8_STAGE(PG8_SA(1, 0), cA + kstep, vA[0]); PG8_STAGE(PG8_SB(1, 1), cB + hstep + kstep, voffB);
    PG8_WAIT_V(6); PG8_BAR;
    for (;;) {
        const bool has_next = S.next(ui + 1, nxt);
        const char* nA = has_next ? S.a_base(nxt) : cA; const char* nB = has_next ? S.b_base(nxt) : cB;
        if constexpr (GATHER) {
            if (has_next) S.gather(nxt, Rr, Cc, nvA);
            else {
#pragma unroll
                for (int h = 0; h < 2; ++h) { nvA[h][0] = vA[h][0]; nvA[h][1] = vA[h][1]; } }
        }
        for (int t = 0; t < nt; t += 2) {
            const bool last = (t == nt - 2);
            if constexpr (Epi::HAS_MID) { if (t == (nt >> 1)) E.mid(acc, cur, wr, wc, fr, fq); }
            const char* a1 = cA + (size_t)(t + 1) * kstep;
            const char* a2 = last ? nA : cA + (size_t)(t + 2) * kstep; const char* b2 = last ? nB : cB + (size_t)(t + 2) * kstep;
            const char* a3 = a2 + kstep; const char* b3 = b2 + kstep;
            unsigned o0[2], o1[2];
            if constexpr (GATHER) { o0[0] = last ? nvA[0][0] : vA[0][0]; o0[1] = last ? nvA[0][1] : vA[0][1]; o1[0] = last ? nvA[1][0] : vA[1][0]; o1[1] = last ? nvA[1][1] : vA[1][1]; }
            else { o0[0] = vA[0][0]; o0[1] = vA[0][1]; o1[0] = vA[1][0]; o1[1] = vA[1][1]; }
            PG8_LDB(B0, 0, 0); PG8_LDB(B1, 0, 1); PG8_SCHED; PG8_LDA(At, 0, 0); PG8_STAGE(PG8_SA(1, 1), a1, vA[1]);
            PG8_WAIT_V(8); PG8_WAIT_L(0); PG8_BAR; PG8_MMA(0, 0, At, B0); PG8_MMA(0, 1, At, B1); PG8_BAR; PG8_SCHED;
            PG8_LDA(At, 0, 1); PG8_STAGE(PG8_SB(0, 0), b2, voffB); PG8_STAGE(PG8_SB(0, 1), b2 + hstep, voffB); PG8_STAGE(PG8_SA(0, 0), a2, o0);
            PG8_WAIT_V(8); PG8_WAIT_L(0); PG8_BAR; PG8_MMA(1, 0, At, B0); PG8_MMA(1, 1, At, B1); PG8_BAR; PG8_SCHED;
            PG8_LDB(B0, 1, 0); PG8_LDB(B1, 1, 1); PG8_SCHED; PG8_LDA(At, 1, 0); PG8_STAGE(PG8_SA(0, 1), a2, o1);
            PG8_WAIT_V(8); PG8_WAIT_L(0); PG8_BAR; PG8_MMA(0, 0, At, B0); PG8_MMA(0, 1, At, B1); PG8_BAR; PG8_SCHED;
            PG8_LDA(At, 1, 1); PG8_STAGE(PG8_SB(1, 0), b3, voffB); PG8_STAGE(PG8_SB(1, 1), b3 + hstep, voffB); PG8_STAGE(PG8_SA(1, 0), a3, o0);
            PG8_WAIT_V(8); PG8_WAIT_L(0); PG8_BAR; PG8_MMA(1, 0, At, B0); PG8_MMA(1, 1, At, B1); PG8_BAR; PG8_SCHED;
        }
        if (wr == 0) PG8_BAR;
        E(acc, cur, wr, wc, fr, fq);
        if (!has_next) break;
#pragma unroll
        for (int a = 0; a < 2; ++a)
#pragma unroll
            for (int b = 0; b < 2; ++b)
#pragma unroll
                for (int m = 0; m < 4; ++m)
#pragma unroll
                    for (int n = 0; n < 2; ++n) acc[a][b][m][n] = (f32x4){0.f, 0.f, 0.f, 0.f};
        cur = nxt; cA = nA; cB = nB; ++ui;
        if constexpr (GATHER) {
#pragma unroll
            for (int h = 0; h < 2; ++h) { vA[h][0] = nvA[h][0]; vA[h][1] = nvA[h][1]; } }
        if (wr == 1) PG8_BAR;
    }
    PG8_WAIT_V(0);
    PG8_BAR;
#undef PG8_SA
#undef PG8_SB
#undef PG8_STAGE
#undef PG8_LDA
#undef PG8_LDB
#undef PG8_MMA
#undef PG8_WAIT_V
#undef PG8_WAIT_L
#undef PG8_BAR
#undef PG8_SCHED
}

typedef f32x4 Acc[2][2][4][2];
DI u32x4 pack8(const f32x4 a, const f32x4 b) { u32x4 w; w.x = cvtpk(a[0], a[1]); w.y = cvtpk(a[2], a[3]); w.z = cvtpk(b[0], b[1]); w.w = cvtpk(b[2], b[3]); return w; }
DI f32x4 silu4(const f32x4 v) { f32x4 o; o[0] = v[0] * fsigmoid(v[0]); o[1] = v[1] * fsigmoid(v[1]); o[2] = v[2] * fsigmoid(v[2]); o[3] = v[3] * fsigmoid(v[3]); return o; }

struct EpiIn {
    static constexpr bool HAS_MID = false;
    bf16 *Qh, *Vh, *Gh, *Qm, *Km, *Vm, *Rr, *Gb; float *Zf, *KM; const float* bias;
    DI void operator()(Acc& acc, const Unit& u, int wr, int wc, int fr, int fq) const {
        const int pn = u.pn, row0 = u.pm * BM + wr * 64 + fr, cl = wc * 32 + 8 * fq;
        f32x4 bv[2][2];
#pragma unroll
        for (int bj = 0; bj < 2; ++bj)
#pragma unroll
            for (int n = 0; n < 2; ++n) bv[bj][n] = *(const f32x4*)(bias + pn * 256 + bj * HALF + cl + 4 * n);
        if (pn < 14) {
            const int seg = pn >> 1, c0 = (pn & 1) * 256 + cl;
            if (seg == 1) {
#pragma unroll
                for (int ai = 0; ai < 2; ++ai)
#pragma unroll
                    for (int m = 0; m < 4; ++m) { float* rp = Zf + (size_t)(row0 + ai * HALF + m * 16) * 512 + c0;
#pragma unroll
                        for (int bj = 0; bj < 2; ++bj) { *(f32x4*)(rp + bj * HALF) = acc[ai][bj][m][0] + bv[bj][0]; *(f32x4*)(rp + bj * HALF + 4) = acc[ai][bj][m][1] + bv[bj][1]; }
                        asm volatile("" ::: "memory"); }
            } else {
                bf16* O = seg == 0 ? Qh : seg == 2 ? Vh : seg == 3 ? Gh : seg == 4 ? Qm : seg == 5 ? Km : Vm;
                const int act = (seg == 0 || seg == 3) ? 1 : (seg == 4 ? 2 : 0);
                if (seg == 5) {
#pragma unroll
                    for (int bj = 0; bj < 2; ++bj)
#pragma unroll
                        for (int n = 0; n < 2; ++n) { f32x4 cs = (f32x4){0.f, 0.f, 0.f, 0.f};
#pragma unroll
                            for (int ai = 0; ai < 2; ++ai)
#pragma unroll
                                for (int m = 0; m < 4; ++m) cs += acc[ai][bj][m][n] + bv[bj][n];
#pragma unroll
                            for (int j = 0; j < 4; ++j) { float s = cs[j]; s += __shfl_xor(s, 1); s += __shfl_xor(s, 2); s += __shfl_xor(s, 4); s += __shfl_xor(s, 8); cs[j] = s; }
                            if (fr == 0) *(f32x4*)(KM + (size_t)(u.pm * 2 + wr) * 512 + c0 + bj * HALF + 4 * n) = cs; }
                }
#pragma unroll
                for (int ai = 0; ai < 2; ++ai)
#pragma unroll
                    for (int m = 0; m < 4; ++m) { bf16* rp = O + (size_t)(row0 + ai * HALF + m * 16) * 512 + c0;
#pragma unroll
                        for (int bj = 0; bj < 2; ++bj) { f32x4 v0 = acc[ai][bj][m][0] + bv[bj][0], v1 = acc[ai][bj][m][1] + bv[bj][1];
                            if (act == 1) { v0 = silu4(v0); v1 = silu4(v1); } else if (act == 2) { v0 = v0 * (0.125f * LOG2E); v1 = v1 * (0.125f * LOG2E); }
                            *(u32x4*)(rp + bj * HALF) = pack8(v0, v1); }
                        asm volatile("" ::: "memory"); }
            }
        } else {
            const int c0 = (pn - 14) * 128 + cl;
#pragma unroll
            for (int ai = 0; ai < 2; ++ai)
#pragma unroll
                for (int m = 0; m < 4; ++m) { const size_t off = (size_t)(row0 + ai * HALF + m * 16) * 1024 + c0; f32x4 r[2], g[2];
#pragma unroll
                    for (int n = 0; n < 2; ++n) { const f32x4 a = acc[ai][0][m][n] + bv[0][n], b = acc[ai][1][m][n] + bv[1][n];
#pragma unroll
                        for (int j = 0; j < 4; ++j) { const float ea = __expf(-a[j]), eb = __expf(-b[j]); g[n][j] = frcp(1.f + eb); r[n][j] = (1.f + eb) * frcp(1.f + ea); } }
                    *(u32x4*)(Rr + off) = pack8(r[0], r[1]); *(u32x4*)(Gb + off) = pack8(g[0], g[1]); asm volatile("" ::: "memory"); }
        }
    }
};
struct EpiProj {
    static constexpr bool HAS_MID = true;
    const bf16 *Rr, *Gb; bf16* U;
    DI void scale(Acc& acc, const bf16* G, const Unit& u, int wr, int wc, int fr, int fq) const {
        int row0 = u.pm * BM + wr * 64 + fr, col0 = u.pn * BM + wc * 32 + 8 * fq;
        asm volatile("" : "+v"(row0), "+v"(col0));
#pragma unroll
        for (int ai = 0; ai < 2; ++ai)
#pragma unroll
            for (int mp = 0; mp < 2; ++mp) { u32x4 rv[2][2];
#pragma unroll
            for (int m = 0; m < 2; ++m)
#pragma unroll
                for (int bj = 0; bj < 2; ++bj) rv[m][bj] = *(const u32x4*)(G + (size_t)(row0 + ai * HALF + (2 * mp + m) * 16) * 1024 + col0 + bj * HALF);
#pragma unroll
            for (int m = 0; m < 2; ++m)
#pragma unroll
                for (int bj = 0; bj < 2; ++bj) { const u32x4 w = rv[m][bj];
                    acc[ai][bj][2 * mp + m][0] *= (f32x4){bflo(w.x), bfhi(w.x), bflo(w.y), bfhi(w.y)}; acc[ai][bj][2 * mp + m][1] *= (f32x4){bflo(w.z), bfhi(w.z), bflo(w.w), bfhi(w.w)}; }
            asm volatile("" ::: "memory"); }
    }
    DI void mid(Acc& acc, const Unit& u, int wr, int wc, int fr, int fq) const { scale(acc, Rr, u, wr, wc, fr, fq); }
    DI void operator()(Acc& acc, const Unit& u, int wr, int wc, int fr, int fq) const {
        scale(acc, Gb, u, wr, wc, fr, fq);
        const int row0 = u.pm * BM + wr * 64 + fr, col0 = u.pn * BM + wc * 32 + 8 * fq;
#pragma unroll
        for (int ai = 0; ai < 2; ++ai)
#pragma unroll
            for (int m = 0; m < 4; ++m) { bf16* rp = U + (size_t)(row0 + ai * HALF + m * 16) * 1024 + col0;
#pragma unroll
                for (int bj = 0; bj < 2; ++bj) *(u32x4*)(rp + bj * HALF) = pack8(acc[ai][bj][m][0], acc[ai][bj][m][1]); }
    }
};
struct EpiOut {
    static constexpr bool HAS_MID = false;
    const float* X; float* Pre;
    DI void operator()(Acc& acc, const Unit& u, int wr, int wc, int fr, int fq) const {
        const int row0 = u.pm * BM + wr * 64 + fr, col0 = u.pn * BM + wc * 32 + 8 * fq;
#pragma unroll
        for (int ai = 0; ai < 2; ++ai)
#pragma unroll
            for (int m = 0; m < 4; ++m) { const size_t off = (size_t)(row0 + ai * HALF + m * 16) * 1024 + col0;
#pragma unroll
                for (int bj = 0; bj < 2; ++bj) { const f32x4 x0 = *(const f32x4*)(X + off + bj * HALF), x1 = *(const f32x4*)(X + off + bj * HALF + 4);
                    *(f32x4*)(Pre + off + bj * HALF) = x0 * DN_ALPHA + acc[ai][bj][m][0]; *(f32x4*)(Pre + off + bj * HALF + 4) = x1 * DN_ALPHA + acc[ai][bj][m][1]; }
                if (m & 1) asm volatile("" ::: "memory"); }
    }
};
struct EpiM1 {
    static constexpr bool HAS_MID = false;
    bf16* H;
    DI void operator()(Acc& acc, const Unit& u, int wr, int wc, int fr, int fq) const {
        const int row0 = u.pm * BM + wr * 64 + fr, col0 = u.pn * 128 + wc * 32 + 8 * fq;
#pragma unroll
        for (int ai = 0; ai < 2; ++ai)
#pragma unroll
            for (int m = 0; m < 4; ++m) *(u32x4*)(H + (size_t)(row0 + ai * HALF + m * 16) * 512 + col0) = pack8(silu4(acc[ai][0][m][0]) * acc[ai][1][m][0], silu4(acc[ai][0][m][1]) * acc[ai][1][m][1]);
    }
};
struct EpiM2 {
    static constexpr bool HAS_MID = false;
    bf16* Y;
    DI void operator()(Acc& acc, const Unit& u, int wr, int wc, int fr, int fq) const {
        const int row0 = u.pm * BM + wr * 64 + fr, col0 = u.pn * BM + wc * 32 + 8 * fq;
#pragma unroll
        for (int ai = 0; ai < 2; ++ai)
#pragma unroll
            for (int m = 0; m < 4; ++m) { bf16* rp = Y + (size_t)(row0 + ai * HALF + m * 16) * 1024 + col0;
#pragma unroll
                for (int bj = 0; bj < 2; ++bj) *(u32x4*)(rp + bj * HALF) = pack8(acc[ai][bj][m][0], acc[ai][bj][m][1]); }
    }
};
}

struct Args { const float* in[19]; float* out; unsigned char* ws; int ph_lo, ph_hi; };
enum { I_X = 0, I_WIN, I_BIN, I_LBL, I_HGNG, I_RELB, I_WPA, I_WPB, I_WOUT, I_LN1G, I_LN1B, I_WGRP, I_BGRP, I_WEXP, I_BEXP, I_WGU, I_WDN, I_LN2G, I_LN2B };

struct Ctx {
    LAS unsigned char* lds; volatile LAS unsigned* MISC;
    int tid, lane, wid, G, vcu;
    unsigned char* ws; gu32* ctl;
};

DI void transpose_item(const float* W, int N, bf16* WT, int ldk, int drow, int dk, LAS float* scr, int lane) {
    const int kr = lane >> 4, nq = lane & 15;
    f32x4 v[16];
#pragma unroll
    for (int i = 0; i < 16; ++i) v[i] = *(const f32x4*)(W + (size_t)(4 * i + kr) * N + 4 * nq);
#pragma unroll
    for (int i = 0; i < 16; ++i) { LAS float* p = scr + (4 * i + kr) * 65 + 4 * nq; p[0] = v[i][0]; p[1] = v[i][1]; p[2] = v[i][2]; p[3] = v[i][3]; }
    asm volatile("s_waitcnt lgkmcnt(0)" ::: "memory");
    const int c = lane & 7, nn = lane >> 3;
#pragma unroll
    for (int it = 0; it < 8; ++it) { const int n = 8 * it + nn; const LAS float* s = scr + (8 * c) * 65 + n;
        u32x4 o; o.x = cvtpk(s[0 * 65], s[1 * 65]); o.y = cvtpk(s[2 * 65], s[3 * 65]); o.z = cvtpk(s[4 * 65], s[5 * 65]); o.w = cvtpk(s[6 * 65], s[7 * 65]);
        *(u32x4*)(WT + (size_t)(drow + n) * ldk + dk + 8 * c) = o; }
    asm volatile("s_waitcnt lgkmcnt(0)" ::: "memory");
}
DI int win_drow(int n0) { if (n0 < 3584) return n0; if (n0 < 4608) { const int r = n0 - 3584; return 3584 + 256 * (r >> 7) + (r & 127); } const int r = n0 - 4608; return 3584 + 256 * (r >> 7) + 128 + (r & 127); }
DI int wgu_drow(int n0) { if (n0 < 512) return 256 * (n0 >> 7) + (n0 & 127); const int r = n0 - 512; return 256 * (r >> 7) + 128 + (r & 127); }

DI void p0_prologue(const Ctx& C, const Args& a) {
    LAS float* scr = (LAS float*)(C.lds + C.wid * 16640);
    const int gw = C.vcu * NWAVES + C.wid, NGW = C.G * NWAVES;
    bf16* WinT = (bf16*)(C.ws + WS_WIN); bf16* Wcat = (bf16*)(C.ws + WS_WCAT); bf16* WoT = (bf16*)(C.ws + WS_WO);
    constexpr int I_IN = 16 * 88, I_PA = 8 * 16, I_O = 16 * 16, NITEMS = I_IN + 2 * I_PA + I_O;
    for (int it = gw; it < NITEMS; it += NGW) {
        int r = it;
        if (r < I_IN) { const int kb = r / 88, nb = r % 88; transpose_item(a.in[I_WIN] + (size_t)(64 * kb) * NIN + 64 * nb, NIN, WinT, 1024, win_drow(64 * nb), 64 * kb, scr, C.lane); continue; } r -= I_IN;
        if (r < I_PA) { const int kb = r / 16, nb = r % 16; transpose_item(a.in[I_WPA] + (size_t)(64 * kb) * 1024 + 64 * nb, 1024, Wcat, 1024, 64 * nb, 64 * kb, scr, C.lane); continue; } r -= I_PA;
        if (r < I_PA) { const int kb = r / 16, nb = r % 16; transpose_item(a.in[I_WPB] + (size_t)(64 * kb) * 1024 + 64 * nb, 1024, Wcat, 1024, 64 * nb, 512 + 64 * kb, scr, C.lane); continue; } r -= I_PA;
        { const int kb = r / 16, nb = r % 16; transpose_item(a.in[I_WOUT] + (size_t)(64 * kb) * 1024 + 64 * nb, 1024, WoT, 1024, 64 * nb, 64 * kb, scr, C.lane); }
    }
    const int gt = C.vcu * NTHREADS + C.tid, NT = C.G * NTHREADS;
    { const float* x = a.in[I_X]; bf16* Xb = (bf16*)(C.ws + WS_XB);
      for (int i = gt; i < NTOK * DM / 8; i += NT) { const f32x4 v0 = *(const f32x4*)(x + (size_t)i * 8), v1 = *(const f32x4*)(x + (size_t)i * 8 + 4); *(u32x4*)(Xb + (size_t)i * 8) = pg8::pack8(v0, v1); } }
    { float* bp = (float*)(C.ws + WS_BPERM); const float* bin = a.in[I_BIN];
      for (int n = gt; n < NIN; n += NT) bp[win_drow(n & ~31) + (n & 31)] = bin[n]; }
    { bf16* wh = (bf16*)(C.ws + WS_WRH); bf16* wl = (bf16*)(C.ws + WS_WRL); const float* wg = a.in[I_WGRP]; const float* we = a.in[I_WEXP];
      for (int i = gt; i < 48 * 1024; i += NT) { const int j = i >> 10, k = i & 1023; float w = 0.f; if (j < 4) w = wg[k * 4 + j]; else if (j < 36) w = we[k * 32 + (j - 4)];
          const unsigned h = cvtpk(w, 0.f) & 0xffffu; const float r = w - bf2f((unsigned short)h); wh[i] = (bf16)h; wl[i] = (bf16)(cvtpk(r, 0.f) & 0xffffu); } }
}
constexpr int MOE_CVT_ITEMS = 32 * 16 * 16 + 32 * 8 * 16;
DI void moe_cvt_item(const Args& a, int it, LAS float* scr, int lane) {
    bf16* WguT = (bf16*)a.out; bf16* WdT = (bf16*)((unsigned char*)a.out + 64 * MiB);
    constexpr int I_GU = 32 * 16 * 16;
    if (it < I_GU) { const int e = it >> 8, r = it & 255, kb = r >> 4, nb = r & 15;
        transpose_item(a.in[I_WGU] + (size_t)e * 1024 * 1024 + (size_t)(64 * kb) * 1024 + 64 * nb, 1024, WguT + (size_t)e * 1024 * 1024, 1024, wgu_drow(64 * nb), 64 * kb, scr, lane); }
    else { const int r0 = it - I_GU, e = r0 >> 7, r = r0 & 127, kb = r >> 4, nb = r & 15;
        transpose_item(a.in[I_WDN] + (size_t)e * 512 * 1024 + (size_t)(64 * kb) * 1024 + 64 * nb, 1024, WdT + (size_t)e * 1024 * 512, 512, 64 * nb, 64 * kb, scr, lane); }
}

constexpr int HG_BUF = 67072, HG_QP = 0, HG_KP = 16384, HG_V = 32768, HG_SC = 49152, HG_OB = 49664;
DI int hswz(int row, int ch16) { return 256 * row + 16 * (ch16 ^ (((row & 3) << 2) | ((row >> 2) & 3))); }
DI int htr(int r0, int c0, int lane) { const int i16 = lane & 15, q = i16 >> 2, p = i16 & 3; return hswz(r0 + q, c0 + (p >> 1)) + 8 * (p & 1); }
#define HG_RL(x, l) __int_as_float(__builtin_amdgcn_readlane(__float_as_int(x), (l)))
#define HG_SCAN(v) do { v += __int_as_float(__builtin_amdgcn_update_dpp(0, __float_as_int(v), 0x111, 0xf, 0xf, true)); v += __int_as_float(__builtin_amdgcn_update_dpp(0, __float_as_int(v), 0x112, 0xf, 0xf, true)); \
        v += __int_as_float(__builtin_amdgcn_update_dpp(0, __float_as_int(v), 0x114, 0xf, 0xf, true)); v += __int_as_float(__builtin_amdgcn_update_dpp(0, __float_as_int(v), 0x118, 0xf, 0xf, true)); \
        v += __int_as_float(__builtin_amdgcn_update_dpp(0, __float_as_int(v), 0x142, 0xa, 0xf, false)); v += __int_as_float(__builtin_amdgcn_update_dpp(0, __float_as_int(v), 0x143, 0xc, 0xf, false)); } while (0)
DI void hgrn_unit(const Ctx& C, const Args& a, int b, int h) {
    LAS unsigned char* L = C.lds;
    const int tid = C.tid, lane = C.lane, wid = C.wid;
    const int q32 = lane & 31, hi = lane >> 5, dh = (lane >> 4) & 1, dvb = wid & 3, tb = wid >> 2;
    const float* Zf = (const float*)(C.ws + WS_ZF); const bf16* Qh = (const bf16*)(C.ws + WS_QH); const bf16* Vh = (const bf16*)(C.ws + WS_VH); const bf16* Gh = (const bf16*)(C.ws + WS_GH);
    bf16* Ocat = (bf16*)(C.ws + WS_XB);
    const size_t rb = (size_t)b * SEQ;
    LAS float* LBS = (LAS float*)(L + 2 * HG_BUF); LAS float* CAR = LBS + 128; LAS float* NGS = CAR + 128;
    if (tid < 128) { const float l0 = a.in[I_LBL][h * 128 + tid], l1 = a.in[I_LBL][512 + h * 128 + tid]; LBS[tid] = 1.f / (1.f + expf(l1 - l0)); CAR[tid] = 0.f; NGS[tid] = a.in[I_HGNG][h * 128 + tid]; }
    __syncthreads();
    const int orow = tid >> 3, oseg = tid & 7;
    f32x16 T[4];
#pragma unroll
    for (int i = 0; i < 4; ++i)
#pragma unroll
        for (int r = 0; r < 16; ++r) T[i][r] = 0.f;
    f32x4 zr[4]; u32x4 qr[2], vr[2], gr[2];
#define HG_LOAD(c) do { const size_t r0_ = (rb + (size_t)(c) * 64 + lane) * 512 + h * 128 + 16 * wid; \
        _Pragma("unroll") for (int i = 0; i < 4; ++i) zr[i] = *(const f32x4*)(Zf + r0_ + 4 * i); \
        _Pragma("unroll") for (int i = 0; i < 2; ++i) { qr[i] = *(const u32x4*)(Qh + r0_ + 8 * i); vr[i] = *(const u32x4*)(Vh + r0_ + 8 * i); } } while (0)
#define HG_PREP(c) do { LAS unsigned char* B_ = L + ((c) & 1) * HG_BUF; float bb_[16], kk_[16], lb[16], carry[16]; \
        _Pragma("unroll") for (int i = 0; i < 4; ++i) { const f32x4 l_ = *(const LAS f32x4*)(LBS + 16 * wid + 4 * i), c_ = *(const LAS f32x4*)(CAR + 16 * wid + 4 * i); \
            _Pragma("unroll") for (int j = 0; j < 4; ++j) { lb[4 * i + j] = l_[j]; carry[4 * i + j] = c_[j]; } } \
        _Pragma("unroll") for (int j = 0; j < 16; ++j) { const float z_ = zr[j >> 2][j & 3]; const float sg_ = frcp(1.f + __expf(-z_)); bb_[j] = __logf(lb[j] + (1.f - lb[j]) * sg_); kk_[j] = (1.f - lb[j]) * (1.f - sg_); } \
        _Pragma("unroll") for (int j = 0; j < 16; ++j) HG_SCAN(bb_[j]); \
        float sc_[16]; unsigned qp_[8], kp_[8]; \
        _Pragma("unroll") for (int j = 0; j < 16; j += 2) { \
            const float m0_ = HG_RL(bb_[j], 31), m1_ = HG_RL(bb_[j + 1], 31), e0_ = HG_RL(bb_[j], 63), e1_ = HG_RL(bb_[j + 1], 63); \
            const unsigned qw_ = ((const unsigned*)&qr[j >> 3])[(j >> 1) & 3]; \
            const float x0_ = __expf(bb_[j] - m0_), x1_ = __expf(bb_[j + 1] - m1_); \
            qp_[j >> 1] = cvtpk(bflo(qw_) * x0_, bfhi(qw_) * x1_); kp_[j >> 1] = cvtpk(kk_[j] * frcp(x0_), kk_[j + 1] * frcp(x1_)); \
            sc_[j] = __expf(m0_ + carry[j]); sc_[j + 1] = __expf(m1_ + carry[j + 1]); carry[j] = e0_ - m0_; carry[j + 1] = e1_ - m1_; } \
        *(LAS u32x4*)(B_ + HG_QP + hswz(lane, 2 * wid)) = (u32x4){qp_[0], qp_[1], qp_[2], qp_[3]}; *(LAS u32x4*)(B_ + HG_QP + hswz(lane, 2 * wid + 1)) = (u32x4){qp_[4], qp_[5], qp_[6], qp_[7]}; \
        *(LAS u32x4*)(B_ + HG_KP + hswz(lane, 2 * wid)) = (u32x4){kp_[0], kp_[1], kp_[2], kp_[3]}; *(LAS u32x4*)(B_ + HG_KP + hswz(lane, 2 * wid + 1)) = (u32x4){kp_[4], kp_[5], kp_[6], kp_[7]}; \
        *(LAS u32x4*)(B_ + HG_V + hswz(lane, 2 * wid)) = vr[0]; *(LAS u32x4*)(B_ + HG_V + hswz(lane, 2 * wid + 1)) = vr[1]; \
        if (lane == 0) { _Pragma("unroll") for (int i = 0; i < 4; ++i) { *(LAS f32x4*)(B_ + HG_SC + (16 * wid + 4 * i) * 4) = (f32x4){sc_[4 * i], sc_[4 * i + 1], sc_[4 * i + 2], sc_[4 * i + 3]}; \
            *(LAS f32x4*)(CAR + 16 * wid + 4 * i) = (f32x4){carry[4 * i], carry[4 * i + 1], carry[4 * i + 2], carry[4 * i + 3]}; } } } while (0)

    HG_LOAD(0);
    HG_PREP(0);
    __syncthreads();
    for (int c = 0; c < 32; ++c) {
        const LAS unsigned char* B = L + (c & 1) * HG_BUF;
        if (c + 1 < 32) HG_LOAD(c + 1);
        { const size_t g0 = (rb + (size_t)c * 64 + orow) * 512 + h * 128 + 16 * oseg; gr[0] = *(const u32x4*)(Gh + g0); gr[1] = *(const u32x4*)(Gh + g0 + 8); }
        int q32o = q32, hio = hi, laneo = lane; asm volatile("" : "+v"(q32o), "+v"(hio), "+v"(laneo));
        f32x16 oT;
#pragma unroll
        for (int r = 0; r < 16; ++r) oT[r] = 0.f;
#pragma unroll
        for (int sb = 0; sb < 2; ++sb) {
            if (sb <= tb) {
                f32x16 pT;
#pragma unroll
                for (int r = 0; r < 16; ++r) pT[r] = 0.f;
#pragma unroll
                for (int ks = 0; ks < 8; ++ks) { const bf16x8 ka = *(const LAS bf16x8*)(B + HG_KP + hswz(32 * sb + q32o, 2 * ks + hio)); const bf16x8 qb = *(const LAS bf16x8*)(B + HG_QP + hswz(32 * tb + q32o, 2 * ks + hio)); pT = MFMA32(ka, qb, pT); }
                if (sb == tb) {
#pragma unroll
                    for (int r = 0; r < 16; ++r) if (crow(r, hi) > q32) pT[r] = 0.f;
                }
#pragma unroll
                for (int s2 = 0; s2 < 2; ++s2) { u32x4 pw; pw.x = cvtpk(pT[8 * s2 + 0], pT[8 * s2 + 1]); pw.y = cvtpk(pT[8 * s2 + 2], pT[8 * s2 + 3]); pw.z = cvtpk(pT[8 * s2 + 4], pT[8 * s2 + 5]); pw.w = cvtpk(pT[8 * s2 + 6], pT[8 * s2 + 7]);
                    const int r0 = 32 * sb + 16 * s2 + 4 * hio;
                    const s16x4 lo = vtr((LAS const char*)(B + HG_V + htr(r0, 4 * dvb + 2 * dh, laneo))), hh = vtr((LAS const char*)(B + HG_V + htr(r0 + 8, 4 * dvb + 2 * dh, laneo)));
                    oT = MFMA32(((bf16x8){lo[0], lo[1], lo[2], lo[3], hh[0], hh[1], hh[2], hh[3]}), __builtin_bit_cast(bf16x8, pw), oT); }
            }
        }
#pragma unroll
        for (int i = 0; i < 4; ++i)
#pragma unroll
            for (int g = 0; g < 4; ++g) { const f32x4 sc = *(const LAS f32x4*)(B + HG_SC + (32 * i + 8 * g + 4 * hio) * 4);
#pragma unroll
                for (int j = 0; j < 4; ++j) T[i][4 * g + j] *= sc[j]; }
        if (c > 0) {
#pragma unroll
            for (int i = 0; i < 4; ++i)
#pragma unroll
                for (int s = 0; s < 2; ++s) { u32x4 tw; tw.x = cvtpk(T[i][8 * s + 0], T[i][8 * s + 1]); tw.y = cvtpk(T[i][8 * s + 2], T[i][8 * s + 3]); tw.z = cvtpk(T[i][8 * s + 4], T[i][8 * s + 5]); tw.w = cvtpk(T[i][8 * s + 6], T[i][8 * s + 7]);
                    const u32x2 q0 = *(const LAS u32x2*)(B + HG_QP + hswz(32 * tb + q32o, 4 * i + 2 * s) + 8 * hio), q1 = *(const LAS u32x2*)(B + HG_QP + hswz(32 * tb + q32o, 4 * i + 2 * s + 1) + 8 * hio);
                    const u32x4 qw = (u32x4){q0.x, q0.y, q1.x, q1.y};
                    oT = MFMA32(__builtin_bit_cast(bf16x8, tw), __builtin_bit_cast(bf16x8, qw), oT); }
        }
        { LAS unsigned char* OBp = L + (c & 1) * HG_BUF + HG_OB;
#pragma unroll
          for (int g = 0; g < 4; ++g) { u32x2 w; w.x = cvtpk(oT[4 * g], oT[4 * g + 1]); w.y = cvtpk(oT[4 * g + 2], oT[4 * g + 3]); *(LAS u32x2*)(OBp + (32 * tb + q32o) * 272 + (32 * dvb + 8 * g + 4 * hio) * 2) = w; } }
#pragma unroll
        for (int s2 = 0; s2 < 4; ++s2) { const int r0 = 16 * s2 + 8 * hio;
            const s16x4 vl = vtr((LAS const char*)(B + HG_V + htr(r0, 4 * dvb + 2 * dh, laneo))), vh = vtr((LAS const char*)(B + HG_V + htr(r0 + 4, 4 * dvb + 2 * dh, laneo)));
            const bf16x8 vb = (bf16x8){vl[0], vl[1], vl[2], vl[3], vh[0], vh[1], vh[2], vh[3]};
#pragma unroll
            for (int i = 0; i < 4; ++i) { const s16x4 kl = vtr((LAS const char*)(B + HG_KP + htr(r0, 4 * i + 2 * dh, laneo))), kh = vtr((LAS const char*)(B + HG_KP + htr(r0 + 4, 4 * i + 2 * dh, laneo)));
                T[i] = MFMA32(((bf16x8){kl[0], kl[1], kl[2], kl[3], kh[0], kh[1], kh[2], kh[3]}), vb, T[i]); } }
        if (c + 1 < 32) HG_PREP(c + 1);
        __syncthreads();
        { const LAS unsigned char* OBp = L + (c & 1) * HG_BUF + HG_OB + orow * 272 + oseg * 32;
          const u32x4 o0 = *(const LAS u32x4*)OBp, o1 = *(const LAS u32x4*)(OBp + 16);
          float ov[16];
          ov[0] = bflo(o0.x); ov[1] = bfhi(o0.x); ov[2] = bflo(o0.y); ov[3] = bfhi(o0.y); ov[4] = bflo(o0.z); ov[5] = bfhi(o0.z); ov[6] = bflo(o0.w); ov[7] = bfhi(o0.w);
          ov[8] = bflo(o1.x); ov[9] = bfhi(o1.x); ov[10] = bflo(o1.y); ov[11] = bfhi(o1.y); ov[12] = bflo(o1.z); ov[13] = bfhi(o1.z); ov[14] = bflo(o1.w); ov[15] = bfhi(o1.w);
          float ss = 0.f;
#pragma unroll
          for (int j = 0; j < 16; ++j) ss += ov[j] * ov[j];
          ss += __int_as_float(__builtin_amdgcn_update_dpp(0, __float_as_int(ss), 0xB1, 0xf, 0xf, true));
          ss += __int_as_float(__builtin_amdgcn_update_dpp(0, __float_as_int(ss), 0x4E, 0xf, 0xf, true));
          ss += __int_as_float(__builtin_amdgcn_update_dpp(0, __float_as_int(ss), 0x141, 0xf, 0xf, true));
          const float rs = __builtin_amdgcn_rsqf(ss * (1.f / 128.f) + LN_EPS);
          float ng[16];
#pragma unroll
          for (int i = 0; i < 4; ++i) { const f32x4 n_ = *(const LAS f32x4*)(NGS + 16 * oseg + 4 * i); ng[4 * i] = n_[0]; ng[4 * i + 1] = n_[1]; ng[4 * i + 2] = n_[2]; ng[4 * i + 3] = n_[3]; }
          float gvv[16];
          gvv[0] = bflo(gr[0].x); gvv[1] = bfhi(gr[0].x); gvv[2] = bflo(gr[0].y); gvv[3] = bfhi(gr[0].y); gvv[4] = bflo(gr[0].z); gvv[5] = bfhi(gr[0].z); gvv[6] = bflo(gr[0].w); gvv[7] = bfhi(gr[0].w);
          gvv[8] = bflo(gr[1].x); gvv[9] = bfhi(gr[1].x); gvv[10] = bflo(gr[1].y); gvv[11] = bfhi(gr[1].y); gvv[12] = bflo(gr[1].z); gvv[13] = bfhi(gr[1].z); gvv[14] = bflo(gr[1].w); gvv[15] = bfhi(gr[1].w);
          u32x4 w0, w1;
          w0.x = cvtpk(ov[0] * rs * ng[0] * gvv[0], ov[1] * rs * ng[1] * gvv[1]); w0.y = cvtpk(ov[2] * rs * ng[2] * gvv[2], ov[3] * rs * ng[3] * gvv[3]);
          w0.z = cvtpk(ov[4] * rs * ng[4] * gvv[4], ov[5] * rs * ng[5] * gvv[5]); w0.w = cvtpk(ov[6] * rs * ng[6] * gvv[6], ov[7] * rs * ng[7] * gvv[7]);
          w1.x = cvtpk(ov[8] * rs * ng[8] * gvv[8], ov[9] * rs * ng[9] * gvv[9]); w1.y = cvtpk(ov[10] * rs * ng[10] * gvv[10], ov[11] * rs * ng[11] * gvv[11]);
          w1.z = cvtpk(ov[12] * rs * ng[12] * gvv[12], ov[13] * rs * ng[13] * gvv[13]); w1.w = cvtpk(ov[14] * rs * ng[14] * gvv[14], ov[15] * rs * ng[15] * gvv[15]);
          bf16* op = Ocat + (rb + (size_t)c * 64 + orow) * 1024 + h * 128 + 16 * oseg;
          *(u32x4*)op = w0; *(u32x4*)(op + 8) = w1; }
    }
    __syncthreads();
#undef HG_LOAD
#undef HG_PREP
}

constexpr int AT_K = 0, AT_V = 18432, AT_KM = 34816, AT_TAB = 36608;
DI int t5_bucket(int d) { if (d < 16) return d; const int v = 16 + (int)(logf((float)d * (1.f / 16.f)) / logf(8.f) * 16.f); return v < 31 ? v : 31; }
DI void attn_unit(const Ctx& C, const Args& a, int b, int h, int jq) {
    LAS unsigned char* L = C.lds;
    const int tid = C.tid, lane = C.lane, wid = C.wid, q32 = lane & 31, hi = lane >> 5;
    const bf16* Qm = (const bf16*)(C.ws + WS_QM); const bf16* Km = (const bf16*)(C.ws + WS_KM); const bf16* Vm = (const bf16*)(C.ws + WS_VM); const float* KM = (const float*)(C.ws + WS_KMEAN);
    bf16* Ocat = (bf16*)(C.ws + WS_XB);
    const int tq = jq * 256 + wid * 32 + q32;
    const size_t rowq = (size_t)b * SEQ + tq;
    bf16x8 qf[4];
#pragma unroll
    for (int ks = 0; ks < 4; ++ks) qf[ks] = *(const bf16x8*)(Qm + rowq * 512 + h * 64 + 16 * ks + 8 * hi);
    LAS float* kml = (LAS float*)(L + AT_KM); LAS float* tab = (LAS float*)(L + AT_TAB);
    if (tid < jq * 64) { const int n = tid >> 6, d = tid & 63; kml[tid] = KM[(size_t)((b * 8 + n) * 2 + 0) * 512 + h * 64 + d] + KM[(size_t)((b * 8 + n) * 2 + 1) * 512 + h * 64 + d]; }
    if (tid < 129) tab[tid] = a.in[I_RELB][t5_bucket(tid) * 8 + h] * LOG2E;
    const int srow = tid >> 3, sch = tid & 7;
    const size_t kvbase = ((size_t)b * SEQ + srow) * 512 + h * 64 + sch * 8;
    const int kdst = srow * 144 + sch * 16, vdst = srow * 128 + ((sch ^ (((srow >> 1) & 1) << 2)) << 4);
    u32x4 kreg = *(const u32x4*)(Km + kvbase), vreg = *(const u32x4*)(Vm + kvbase);
    *(LAS u32x4*)(L + AT_K + kdst) = kreg; *(LAS u32x4*)(L + AT_V + vdst) = vreg;
    __syncthreads();
    unsigned sel = 0;
    {
        float g[7];
#pragma unroll
        for (int n = 0; n < 7; ++n) { g[n] = 0.f;
            if (n < jq) { float s = 0.f;
#pragma unroll
                for (int ks = 0; ks < 4; ++ks)
#pragma unroll
                    for (int j = 0; j < 8; ++j) s += bf2f((unsigned short)qf[ks][j]) * kml[n * 64 + 16 * ks + 8 * hi + j];
                s += __shfl_xor(s, 32); g[n] = s; } }
#pragma unroll
        for (int n = 0; n < 7; ++n) if (n < jq) { int rank = 0;
#pragma unroll
            for (int m = 0; m < 7; ++m) if (m != n && m < jq) rank += (g[m] > g[n] || (g[m] == g[n] && m < n)) ? 1 : 0;
            if (rank < 3) sel |= 1u << n; }
    }
    const float c31 = tab[128];
    float mrun = -INFINITY, lrun = 0.f;
    f32x16 o0, o1;
#pragma unroll
    for (int r = 0; r < 16; ++r) { o0[r] = 0.f; o1[r] = 0.f; }
    const int i16 = lane & 15, qq = i16 >> 2, pp = i16 & 3, dh = (lane >> 4) & 1, xsw = (qq >> 1) & 1;
    const int vb0 = (4 * hi + qq) * 128 + 64 * (0 ^ xsw) + 32 * dh + 8 * pp, vb1 = (4 * hi + qq) * 128 + 64 * (1 ^ xsw) + 32 * dh + 8 * pp;
    const int nt = 4 * jq + 4;
    for (int kt = 0; kt < nt; ++kt) {
        const int cur = kt & 1;
        if (kt + 1 < nt) { kreg = *(const u32x4*)(Km + kvbase + (size_t)(kt + 1) * 64 * 512); vreg = *(const u32x4*)(Vm + kvbase + (size_t)(kt + 1) * 64 * 512); }
        const int blk = kt >> 2; const bool own = (blk == jq);
        const bool active = !own || ((kt & 3) * 64 <= wid * 32 + 31);
        if (active) {
            const LAS unsigned char* Kc = L + AT_K + cur * 9216; const LAS unsigned char* Vc = L + AT_V + cur * 8192;
            f32x16 s0, s1;
#pragma unroll
            for (int r = 0; r < 16; ++r) { s0[r] = 0.f; s1[r] = 0.f; }
#pragma unroll
            for (int ks = 0; ks < 4; ++ks) { const bf16x8 k0 = *(const LAS bf16x8*)(Kc + q32 * 144 + 32 * ks + 16 * hi), k1 = *(const LAS bf16x8*)(Kc + (32 + q32) * 144 + 32 * ks + 16 * hi);
                s0 = MFMA32(k0, qf[ks], s0); s1 = MFMA32(k1, qf[ks], s1); }
            const int dist0 = tq - 64 * kt - 4 * hi;
            const bool near = (jq * 256 + wid * 32 - 64 * kt - 63) < 128;
            if (near) {
#pragma unroll
                for (int r = 0; r < 16; ++r) { const int d0 = dist0 - ((r & 3) + 8 * (r >> 2)), d1 = d0 - 32;
                    const int i0 = d0 < 0 ? 0 : (d0 > 128 ? 128 : d0), i1 = d1 < 0 ? 0 : (d1 > 128 ? 128 : d1);
                    s0[r] = d0 < 0 ? -INFINITY : s0[r] + tab[i0]; s1[r] = d1 < 0 ? -INFINITY : s1[r] + tab[i1]; }
            } else {
#pragma unroll
                for (int r = 0; r < 16; ++r) { s0[r] += c31; s1[r] += c31; }
            }
            if (!own && !((sel >> blk) & 1u)) {
#pragma unroll
                for (int r = 0; r < 16; ++r) { s0[r] = -INFINITY; s1[r] = -INFINITY; }
            }
            float mx = fmaxf(s0[0], s1[0]);
#pragma unroll
            for (int r = 1; r < 16; ++r) mx = fmaxf(mx, fmaxf(s0[r], s1[r]));
            mx = fmaxf(mx, __shfl_xor(mx, 32));
            const float mnew = fmaxf(mrun, mx), msafe = (mnew == -INFINITY) ? 0.f : mnew;
            const float alpha = __builtin_amdgcn_exp2f(mrun - msafe);
            mrun = mnew;
            float ps = 0.f;
#pragma unroll
            for (int r = 0; r < 16; ++r) { s0[r] = __builtin_amdgcn_exp2f(s0[r] - msafe); s1[r] = __builtin_amdgcn_exp2f(s1[r] - msafe); ps += s0[r] + s1[r]; }
            lrun = lrun * alpha + ps;
#pragma unroll
            for (int r = 0; r < 16; ++r) { o0[r] *= alpha; o1[r] *= alpha; }
#pragma unroll
            for (int kb = 0; kb < 2; ++kb)
#pragma unroll
                for (int s2 = 0; s2 < 2; ++s2) {
                    u32x4 pw;
                    if (kb == 0) { pw.x = cvtpk(s0[8 * s2 + 0], s0[8 * s2 + 1]); pw.y = cvtpk(s0[8 * s2 + 2], s0[8 * s2 + 3]); pw.z = cvtpk(s0[8 * s2 + 4], s0[8 * s2 + 5]); pw.w = cvtpk(s0[8 * s2 + 6], s0[8 * s2 + 7]); }
                    else         { pw.x = cvtpk(s1[8 * s2 + 0], s1[8 * s2 + 1]); pw.y = cvtpk(s1[8 * s2 + 2], s1[8 * s2 + 3]); pw.z = cvtpk(s1[8 * s2 + 4], s1[8 * s2 + 5]); pw.w = cvtpk(s1[8 * s2 + 6], s1[8 * s2 + 7]); }
                    const bf16x8 pf = __builtin_bit_cast(bf16x8, pw);
                    const int ro = (32 * kb + 16 * s2) * 128;
                    const s16x4 a0l = vtr((LAS const char*)(Vc + vb0 + ro)), a0h = vtr((LAS const char*)(Vc + vb0 + ro + 8 * 128));
                    const s16x4 a1l = vtr((LAS const char*)(Vc + vb1 + ro)), a1h = vtr((LAS const char*)(Vc + vb1 + ro + 8 * 128));
                    o0 = MFMA32(((bf16x8){a0l[0], a0l[1], a0l[2], a0l[3], a0h[0], a0h[1], a0h[2], a0h[3]}), pf, o0);
                    o1 = MFMA32(((bf16x8){a1l[0], a1l[1], a1l[2], a1l[3], a1h[0], a1h[1], a1h[2], a1h[3]}), pf, o1);
                }
        }
        if (kt + 1 < nt) { *(LAS u32x4*)(L + AT_K + (cur ^ 1) * 9216 + kdst) = kreg; *(LAS u32x4*)(L + AT_V + (cur ^ 1) * 8192 + vdst) = vreg; }
        __syncthreads();
    }
    const float linv = 1.f / (lrun + __shfl_xor(lrun, 32));
    bf16* op = Ocat + rowq * 1024 + 512 + h * 64;
#pragma unroll
    for (int g = 0; g < 4; ++g) { u32x2 w0, w1; w0.x = cvtpk(o0[4 * g] * linv, o0[4 * g + 1] * linv); w0.y = cvtpk(o0[4 * g + 2] * linv, o0[4 * g + 3] * linv);
        w1.x = cvtpk(o1[4 * g] * linv, o1[4 * g + 1] * linv); w1.y = cvtpk(o1[4 * g + 2] * linv, o1[4 * g + 3] * linv);
        *(u32x2*)(op + 8 * g + 4 * hi) = w0; *(u32x2*)(op + 32 + 8 * g + 4 * hi) = w1; }
}

#ifndef PROBE_HGX
#define PROBE_HGX 1
#endif
#ifndef PROBE_ATX
#define PROBE_ATX 1
#endif
DI void p2_mixers(const Ctx& C, const Args& a, int rep) {
    for (int hx = 0; hx < PROBE_HGX; ++hx)
    for (int u = blockIdx.x; u < 64; u += C.G) hgrn_unit(C, a, u >> 2, u & 3);
    for (;;) {
        if (C.tid == 0) C.MISC[0] = __hip_atomic_fetch_add((unsigned*)(C.ctl + CW_QUEUE + 64 * rep), 1u, __ATOMIC_RELAXED, __HIP_MEMORY_SCOPE_AGENT);
        __syncthreads();
        const int q0 = (int)C.MISC[0];
        __syncthreads();
        if (q0 >= 1024 * PROBE_ATX) break;
        const int q = q0 / PROBE_ATX;
        attn_unit(C, a, (q & 127) >> 3, q & 7, 7 - (q >> 7));
    }
    for (;;) {
        if (C.tid == 0) C.MISC[0] = __hip_atomic_fetch_add((unsigned*)(C.ctl + CW_QUEUE2 + 64 * rep), 1u, __ATOMIC_RELAXED, __HIP_MEMORY_SCOPE_AGENT);
        __syncthreads();
        const int q0 = (int)C.MISC[0];
        __syncthreads();
        if (q0 * 8 >= MOE_CVT_ITEMS) break;
        moe_cvt_item(a, q0 * 8 + C.wid, (LAS float*)(C.lds + C.wid * 16640), C.lane);
    }
}

DI void r1_phase(const Ctx& C, const Args& a) {
    LAS unsigned char* L = C.lds;
    const int tid = C.tid, lane = C.lane, wid = C.wid;
    LAS float* LG = (LAS float*)L + wid * 16 * 48;
    LAS int* CNT = (LAS int*)(L + 32768);
    LAS float* G1 = (LAS float*)(L + 33024); LAS float* B1 = (LAS float*)(L + 37120);
    const float* Pre = (const float*)(C.ws + WS_ZF); bf16* X1b = (bf16*)(C.ws + WS_XB); f32x2* stats = (f32x2*)(C.ws + WS_STATS);
    const bf16* WrH = (const bf16*)(C.ws + WS_WRH); const bf16* WrL = (const bf16*)(C.ws + WS_WRL);
    unsigned* tokE = (unsigned*)(C.ws + WS_TOKE); float* tokW = (float*)(C.ws + WS_TOKW); int* wgcnt = (int*)(C.ws + WS_WGCNT);
    for (int i = tid; i < 1024; i += NTHREADS) { G1[i] = a.in[I_LN1G][i]; B1[i] = a.in[I_LN1B][i]; }
    const int m16 = lane & 15, kq = lane >> 4;
    for (int chunk = blockIdx.x; chunk < NTOK / 128; chunk += C.G) {
        if (tid < 32) CNT[tid] = 0;
        __syncthreads();
        const int tok0 = chunk * 128 + wid * 16;
        const float* xrow = Pre + (size_t)(tok0 + m16) * 1024 + 8 * kq;
        float s = 0.f, s2 = 0.f;
#pragma unroll 8
        for (int k0 = 0; k0 < 1024; k0 += 32) { const f32x4 xa = *(const f32x4*)(xrow + k0), xc = *(const f32x4*)(xrow + k0 + 4);
            s += (xa[0] + xa[1]) + (xa[2] + xa[3]) + (xc[0] + xc[1]) + (xc[2] + xc[3]);
            s2 += (xa[0] * xa[0] + xa[1] * xa[1]) + (xa[2] * xa[2] + xa[3] * xa[3]) + (xc[0] * xc[0] + xc[1] * xc[1]) + (xc[2] * xc[2] + xc[3] * xc[3]); }
        s += __shfl_xor(s, 16); s += __shfl_xor(s, 32); s2 += __shfl_xor(s2, 16); s2 += __shfl_xor(s2, 32);
        const float mean = s * (1.f / 1024.f); const float var = fmaxf(s2 * (1.f / 1024.f) - mean * mean, 0.f); const float rstd = 1.f / sqrtf(var + LN_EPS);
        if (kq == 0) stats[tok0 + m16] = (f32x2){mean, rstd};
        f32x4 acc[3];
#pragma unroll
        for (int nb = 0; nb < 3; ++nb) acc[nb] = (f32x4){0.f, 0.f, 0.f, 0.f};
        bf16* xb = X1b + (size_t)(tok0 + m16) * 1024 + 8 * kq;
#pragma unroll 2
        for (int k0 = 0; k0 < 1024; k0 += 32) {
            f32x4 xa = *(const f32x4*)(xrow + k0), xc = *(const f32x4*)(xrow + k0 + 4);
            xa = (xa - mean) * rstd * *(const LAS f32x4*)(G1 + k0 + 8 * kq) + *(const LAS f32x4*)(B1 + k0 + 8 * kq);
            xc = (xc - mean) * rstd * *(const LAS f32x4*)(G1 + k0 + 8 * kq + 4) + *(const LAS f32x4*)(B1 + k0 + 8 * kq + 4);
            u32x4 hw; hw.x = cvtpk(xa[0], xa[1]); hw.y = cvtpk(xa[2], xa[3]); hw.z = cvtpk(xc[0], xc[1]); hw.w = cvtpk(xc[2], xc[3]);
            *(u32x4*)(xb + k0) = hw;
            u32x4 lw; lw.x = cvtpk(xa[0] - bflo(hw.x), xa[1] - bfhi(hw.x)); lw.y = cvtpk(xa[2] - bflo(hw.y), xa[3] - bfhi(hw.y)); lw.z = cvtpk(xc[0] - bflo(hw.z), xc[1] - bfhi(hw.z)); lw.w = cvtpk(xc[2] - bflo(hw.w), xc[3] - bfhi(hw.w));
            const bf16x8 xh = __builtin_bit_cast(bf16x8, hw), xl = __builtin_bit_cast(bf16x8, lw);
#pragma unroll
            for (int nb = 0; nb < 3; ++nb) { const size_t wo = (size_t)(nb * 16 + m16) * 1024 + k0 + 8 * kq;
                const bf16x8 wh = *(const bf16x8*)(WrH + wo), wl = *(const bf16x8*)(WrL + wo);
                acc[nb] = MFMA16(wh, xh, acc[nb]); acc[nb] = MFMA16(wl, xh, acc[nb]); acc[nb] = MFMA16(wh, xl, acc[nb]); }
        }
#pragma unroll
        for (int nb = 0; nb < 3; ++nb)
#pragma unroll
            for (int r = 0; r < 4; ++r) LG[m16 * 48 + nb * 16 + 4 * kq + r] = acc[nb][r];
        asm volatile("s_waitcnt lgkmcnt(0)" ::: "memory");
        if (lane < 16) {
            const LAS float* lg = LG + lane * 48;
            float gl[4];
#pragma unroll
            for (int j = 0; j < 4; ++j) gl[j] = lg[j] + a.in[I_BGRP][j];
            int grp = 0; float gm = gl[0];
#pragma unroll
            for (int j = 1; j < 4; ++j) if (gl[j] > gm) { gm = gl[j]; grp = j; }
            float se = 0.f;
#pragma unroll
            for (int j = 0; j < 4; ++j) se += expf(gl[j] - gm);
            const float pg = 1.f / se;
            float el[8];
#pragma unroll
            for (int j = 0; j < 8; ++j) el[j] = lg[4 + grp * 8 + j] + a.in[I_BEXP][grp * 8 + j];
            int i0 = 0; float v0 = el[0];
#pragma unroll
            for (int j = 1; j < 8; ++j) if (el[j] > v0) { v0 = el[j]; i0 = j; }
            int i1 = -1; float v1 = -INFINITY;
#pragma unroll
            for (int j = 0; j < 8; ++j) if (j != i0 && el[j] > v1) { v1 = el[j]; i1 = j; }
            const float w0 = 1.f / (1.f + expf(v1 - v0)), w1 = 1.f - w0;
            const int e0 = grp * 8 + i0, e1 = grp * 8 + i1;
            const int r0 = __hip_atomic_fetch_add(CNT + e0, 1, __ATOMIC_RELAXED, __HIP_MEMORY_SCOPE_WORKGROUP), r1 = __hip_atomic_fetch_add(CNT + e1, 1, __ATOMIC_RELAXED, __HIP_MEMORY_SCOPE_WORKGROUP);
            const int tok = tok0 + lane;
            tokE[tok] = (unsigned)e0 | ((unsigned)e1 << 8) | ((unsigned)r0 << 16) | ((unsigned)r1 << 24);
            tokW[tok * 2] = w0 * pg; tokW[tok * 2 + 1] = w1 * pg;
        }
        __syncthreads();
        if (tid < 32) wgcnt[chunk * 32 + tid] = CNT[tid];
        __syncthreads();
    }
}

DI void r2_phase(const Ctx& C, const Args& a) {
    LAS int* PA = (LAS int*)C.lds;
    LAS int* PB = PA + 512;
    LAS int* TOT = PB + 512; LAS int* BASE = TOT + 32; LAS int* PST = BASE + 32;
    const int tid = C.tid;
    const int* wgcnt = (const int*)(C.ws + WS_WGCNT); const unsigned* tokE = (const unsigned*)(C.ws + WS_TOKE);
    int* tokD = (int*)(C.ws + WS_TOKD); int* rowtok = (int*)(C.ws + WS_ROWTOK); int* tilee = (int*)(C.ws + WS_TILEE);
    for (int chunk = blockIdx.x; chunk < NTOK / 128; chunk += C.G) {
        { const int e = tid & 31, part = tid >> 5; int sa = 0, sb = 0;
          for (int c = part * 16; c < part * 16 + 16; ++c) { const int v = wgcnt[c * 32 + e]; sa += v; sb += (c < chunk) ? v : 0; }
          PA[part * 32 + e] = sa; PB[part * 32 + e] = sb; }
        __syncthreads();
        if (tid < 32) { int sa = 0, sb = 0; for (int p = 0; p < 16; ++p) { sa += PA[p * 32 + tid]; sb += PB[p * 32 + tid]; } TOT[tid] = sa; BASE[tid] = sb; }
        __syncthreads();
        if (tid == 0) { int ps = 0; for (int e = 0; e < 32; ++e) { PST[e] = ps; ps += ((TOT[e] + 255) >> 8) << 8; } PST[32] = ps; }
        __syncthreads();
        if (tid < 128) { const int tok = chunk * 128 + tid; const unsigned w = tokE[tok]; const int e0 = w & 31, e1 = (w >> 8) & 31, r0 = (w >> 16) & 255, r1 = (w >> 24) & 255;
            const int d0 = PST[e0] + BASE[e0] + r0, d1 = PST[e1] + BASE[e1] + r1; rowtok[d0] = tok; rowtok[d1] = tok; tokD[tok * 2] = d0; tokD[tok * 2 + 1] = d1; }
        if (chunk < 32) { const int e = chunk, end = PST[e + 1] - PST[e]; for (int i = TOT[e] + tid; i < end; i += NTHREADS) rowtok[PST[e] + i] = 0; }
        if (chunk == 0) { if (tid < 32) { for (int t = PST[tid] >> 8; t < (PST[tid + 1] >> 8); ++t) tilee[t] = tid; } if (tid == 0) tilee[511] = PST[32] >> 8; }
        __syncthreads();
    }
}

DI void f_phase(const Ctx& C, const Args& a) {
    const int lane = C.lane, gw = C.vcu * NWAVES + C.wid, NGW = C.G * NWAVES;
    const float* Pre = (const float*)(C.ws + WS_ZF); const bf16* Y = (const bf16*)(C.ws + WS_Y); const int* tokD = (const int*)(C.ws + WS_TOKD); const float* tokW = (const float*)(C.ws + WS_TOKW);
    const f32x2* stats = (const f32x2*)(C.ws + WS_STATS);
    f32x4 g2[4], b2[4], g1[4], b1[4];
#pragma unroll
    for (int j = 0; j < 4; ++j) { g2[j] = *(const f32x4*)(a.in[I_LN2G] + 256 * j + 4 * lane); b2[j] = *(const f32x4*)(a.in[I_LN2B] + 256 * j + 4 * lane);
        g1[j] = *(const f32x4*)(a.in[I_LN1G] + 256 * j + 4 * lane) * DN_ALPHA; b1[j] = *(const f32x4*)(a.in[I_LN1B] + 256 * j + 4 * lane) * DN_ALPHA; }
    for (int tok = gw; tok < NTOK; tok += NGW) {
        const int d0 = tokD[tok * 2], d1 = tokD[tok * 2 + 1]; const float w0 = tokW[tok * 2], w1 = tokW[tok * 2 + 1]; const f32x2 st = stats[tok];
        const float* xr = Pre + (size_t)tok * 1024 + 4 * lane; const bf16* y0 = Y + (size_t)d0 * 1024 + 4 * lane; const bf16* y1 = Y + (size_t)d1 * 1024 + 4 * lane;
        f32x4 v[4]; float s = 0.f;
#pragma unroll
        for (int j = 0; j < 4; ++j) { const f32x4 x = *(const f32x4*)(xr + 256 * j); const u32x2 p0 = *(const u32x2*)(y0 + 256 * j), p1 = *(const u32x2*)(y1 + 256 * j);
            v[j] = ((x - st.x) * st.y) * g1[j] + b1[j] + (f32x4){bflo(p0.x), bfhi(p0.x), bflo(p0.y), bfhi(p0.y)} * w0 + (f32x4){bflo(p1.x), bfhi(p1.x), bflo(p1.y), bfhi(p1.y)} * w1;
            s += (v[j][0] + v[j][1]) + (v[j][2] + v[j][3]); }
        const float mean = wave_sum(s) * (1.f / 1024.f); float s2 = 0.f;
#pragma unroll
        for (int j = 0; j < 4; ++j) { v[j] = v[j] - mean; s2 += (v[j][0] * v[j][0] + v[j][1] * v[j][1]) + (v[j][2] * v[j][2] + v[j][3] * v[j][3]); }
        const float rstd = 1.f / sqrtf(wave_sum(s2) * (1.f / 1024.f) + LN_EPS);
        float* orow = a.out + (size_t)tok * 1024 + 4 * lane;
#pragma unroll
        for (int j = 0; j < 4; ++j) *(f32x4*)(orow + 256 * j) = v[j] * rstd * g2[j] + b2[j];
    }
}

constexpr int NPH = 10;
__global__ void __launch_bounds__(NTHREADS, 2) mk_fwd(Args args) {
    extern __shared__ __attribute__((aligned(16))) unsigned char lds_raw[];
    Ctx C;
    C.lds = (LAS unsigned char*)lds_raw; C.MISC = (volatile LAS unsigned*)(C.lds + MISC_OFF);
    C.tid = threadIdx.x; C.lane = C.tid & 63; C.wid = __builtin_amdgcn_readfirstlane(C.tid >> 6);
    C.G = gridDim.x; { const int bx = blockIdx.x; C.vcu = (C.G % 8 == 0) ? (bx % 8) * (C.G / 8) + bx / 8 : bx; }
    C.ws = args.ws; C.ctl = (gu32*)(args.ws + WS_CTL);
    if (C.tid < 64) C.MISC[C.tid] = 0u;
    __syncthreads();
    XcdBarrier bar; bar.bar = (unsigned*)(C.ctl + CW_BAR); bar.x = 0; bar.st = nullptr;
    if (MK_N_LAUNCHES == 1) bar = xcd_barrier_post((unsigned*)(C.ctl + CW_BAR), C.MISC + 8);
    const int lo = args.ph_lo, hi = args.ph_hi;
#ifndef PH_MASK
#define PH_MASK 0x3ff
#endif
#define IN(k) (((PH_MASK >> (k)) & 1) && lo <= (k) && (k) < hi)
#define SEAM(k) do { if (IN(k) && IN((k) + 1)) xcd_barrier(bar); } while (0)
#ifndef PROBE_PHASE
#define PROBE_PHASE -1
#endif
#define REPS(k) ((PROBE_PHASE == (k)) ? 2 : 1)
#define REPSEAM(k) do { if (rep + 1 < REPS(k)) xcd_barrier(bar); } while (0)
    unsigned char* ws = args.ws;
    LAS unsigned char* ring = C.lds;

    if (IN(0)) { _Pragma("unroll") for (int rep = 0; rep < REPS(0); ++rep) { p0_prologue(C, args); REPSEAM(0); } } SEAM(0);

    if (IN(1)) _Pragma("unroll") for (int rep = 0; rep < REPS(1); ++rep) {
        pg8::DenseOrder S; S.init(ws + WS_XB, ws + WS_WIN, NTOK, NIN, 1024, C.G, (int)blockIdx.x);
        pg8::EpiIn E{(bf16*)(ws + WS_QH), (bf16*)(ws + WS_VH), (bf16*)(ws + WS_GH), (bf16*)(ws + WS_QM), (bf16*)(ws + WS_KM), (bf16*)(ws + WS_VM), (bf16*)(ws + WS_R), (bf16*)(ws + WS_GB),
                     (float*)(ws + WS_ZF), (float*)(ws + WS_KMEAN), (const float*)(ws + WS_BPERM)};
        pg8::gemm_phase<pg8::EpiIn, pg8::DenseOrder, false>(ring, 1024, S, E); REPSEAM(1);
    } SEAM(1);

#ifndef PROBE_P2X
#define PROBE_P2X 1
#endif
    if (IN(2)) { for (int rep = 0; rep < PROBE_P2X; ++rep) { p2_mixers(C, args, rep); if (rep + 1 < PROBE_P2X) xcd_barrier(bar); } } SEAM(2);

    if (IN(3)) _Pragma("unroll") for (int rep = 0; rep < REPS(3); ++rep) {
        pg8::DenseOrder S; S.init(ws + WS_XB, ws + WS_WCAT, NTOK, 1024, 1024, C.G, (int)blockIdx.x);
        pg8::EpiProj E{(const bf16*)(ws + WS_R), (const bf16*)(ws + WS_GB), (bf16*)(ws + WS_QH)};
        pg8::gemm_phase<pg8::EpiProj, pg8::DenseOrder, false>(ring, 1024, S, E); REPSEAM(3);
    } SEAM(3);

    if (IN(4)) _Pragma("unroll") for (int rep = 0; rep < REPS(4); ++rep) {
        pg8::DenseOrder S; S.init(ws + WS_QH, ws + WS_WO, NTOK, 1024, 1024, C.G, (int)blockIdx.x);
        pg8::EpiOut E{args.in[I_X], (float*)(ws + WS_ZF)};
        pg8::gemm_phase<pg8::EpiOut, pg8::DenseOrder, false>(ring, 1024, S, E);
        REPSEAM(4);
    } SEAM(4);

    if (IN(5)) { _Pragma("unroll") for (int rep = 0; rep < REPS(5); ++rep) { r1_phase(C, args); REPSEAM(5); } } SEAM(5);
    if (IN(6)) { _Pragma("unroll") for (int rep = 0; rep < REPS(6); ++rep) { r2_phase(C, args); REPSEAM(6); } } SEAM(6);

    if (IN(7)) _Pragma("unroll") for (int rep = 0; rep < REPS(7); ++rep) {
        const int* tilee = (const int*)(ws + WS_TILEE);
        const int ntl = __builtin_amdgcn_readfirstlane(__hip_atomic_load(tilee + 511, __ATOMIC_RELAXED, __HIP_MEMORY_SCOPE_AGENT));
        pg8::MoeOrder S{(const char*)(ws + WS_XB), (const char*)args.out, (const int*)(ws + WS_ROWTOK), tilee, 1024, 1024, ntl * 4, C.G, C.vcu, true};
        pg8::EpiM1 E{(bf16*)(ws + WS_QH)};
        pg8::gemm_phase<pg8::EpiM1, pg8::MoeOrder, true>(ring, 1024, S, E); REPSEAM(7);
    } SEAM(7);

    if (IN(8)) _Pragma("unroll") for (int rep = 0; rep < REPS(8); ++rep) {
        const int* tilee = (const int*)(ws + WS_TILEE);
        const int ntl = __builtin_amdgcn_readfirstlane(__hip_atomic_load(tilee + 511, __ATOMIC_RELAXED, __HIP_MEMORY_SCOPE_AGENT));
        pg8::MoeOrder S{(const char*)(ws + WS_QH), (const char*)args.out + 64 * MiB, (const int*)(ws + WS_ROWTOK), tilee, 512, 1024, ntl * 4, C.G, C.vcu, false};
        pg8::EpiM2 E{(bf16*)(ws + WS_Y)};
        pg8::gemm_phase<pg8::EpiM2, pg8::MoeOrder, false>(ring, 512, S, E); REPSEAM(8);
    } SEAM(8);

    if (IN(9)) { _Pragma("unroll") for (int rep = 0; rep < REPS(9); ++rep) { f_phase(C, args); REPSEAM(9); } }
#undef IN
#undef SEAM
}

extern "C" void kernel_launch(void* const* d_in, const int* in_sizes, int n_in, void* d_out, int out_size, void* d_ws, size_t ws_size, hipStream_t stream) {
    static int grid = 0;
    if (grid == 0) {
        if (n_in != 19 || in_sizes[0] != NTOK * DM || out_size != NTOK * DM || ws_size < WS_END) { fprintf(stderr, "kernel_launch: unexpected problem shape / workspace; nothing launched\n"); grid = -1; return; }
        int dev = 0, cus = 0, per_cu = 0;
        if (hipGetDevice(&dev) != hipSuccess || hipDeviceGetAttribute(&cus, hipDeviceAttributeMultiprocessorCount, dev) != hipSuccess) { grid = -1; return; }
        if (hipFuncSetAttribute((const void*)mk_fwd, hipFuncAttributeMaxDynamicSharedMemorySize, LDS_BYTES) != hipSuccess) { fprintf(stderr, "kernel_launch: hipFuncSetAttribute failed\n"); grid = -1; return; }
        if (hipOccupancyMaxActiveBlocksPerMultiprocessor(&per_cu, (const void*)mk_fwd, NTHREADS, LDS_BYTES) != hipSuccess || per_cu < 1) { fprintf(stderr, "kernel_launch: occupancy query says %d\n", per_cu); }
        (void)hipGetLastError();
        grid = cus;
    }
    if (grid < 0) return;
    (void)hipMemsetAsync((char*)d_ws + WS_CTL, 0, CTL_ZERO_BYTES, stream);
    Args a{};
    for (int i = 0; i < 19; ++i) a.in[i] = (const float*)d_in[i];
    a.out = (float*)d_out; a.ws = (unsigned char*)d_ws;
    if (MK_N_LAUNCHES == 1) { a.ph_lo = 0; a.ph_hi = NPH; hipLaunchKernelGGL(mk_fwd, dim3(grid), dim3(NTHREADS), LDS_BYTES, stream, a); }
    else for (int p = 0; p < NPH; ++p) { a.ph_lo = p; a.ph_hi = p + 1; hipLaunchKernelGGL(mk_fwd, dim3(grid), dim3(NTHREADS), LDS_BYTES, stream, a); }
}
```

```cpp
#include <hip/hip_runtime.h>
#include <cstdio>
#include <cstdint>
#ifndef MK_N_LAUNCHES
#define MK_N_LAUNCHES 1
#endif
#define DI __device__ __forceinline__
#define GAS __attribute__((address_space(1)))
#define LAS __attribute__((address_space(3)))
typedef unsigned short bf16;
typedef unsigned u32x4 __attribute__((ext_vector_type(4)));
typedef unsigned u32x2 __attribute__((ext_vector_type(2)));
typedef float f32x4 __attribute__((ext_vector_type(4)));
typedef float f32x2 __attribute__((ext_vector_type(2)));
typedef float f32x16 __attribute__((ext_vector_type(16)));
typedef short bf16x8 __attribute__((ext_vector_type(8)));
typedef short s16x4 __attribute__((ext_vector_type(4)));
typedef short v4i16_t __attribute__((ext_vector_type(4)));
typedef __bf16 bf16x2_t __attribute__((ext_vector_type(2)));
typedef GAS unsigned gu32;

constexpr int NTOK = 32768, DM = 1024, SEQ = 2048, NBATCH = 16, NIN = 5632;
constexpr int NWAVES = 8, NTHREADS = 512;
constexpr float LN_EPS = 1e-5f, DN_ALPHA = 1.189207115002721f, LOG2E = 1.4426950408889634f;
constexpr int MOE_MAXTILES = 288;

constexpr size_t MiB = 1u << 20;
constexpr size_t WS_CTL = 0, CTL_ZERO_BYTES = 65536;
constexpr size_t WS_WIN = 1 * MiB, WS_WCAT = 12 * MiB, WS_WO = 14 * MiB;
constexpr size_t WS_XB = 16 * MiB;
constexpr size_t WS_R = 80 * MiB;
constexpr size_t WS_GB = 144 * MiB;
constexpr size_t WS_QH = 208 * MiB;
constexpr size_t WS_VH = 240 * MiB;
constexpr size_t WS_GH = 272 * MiB;
constexpr size_t WS_ZF = 304 * MiB;
constexpr size_t WS_QM = 368 * MiB, WS_KM = 400 * MiB;
constexpr size_t WS_VM = 432 * MiB;
constexpr size_t WS_Y = 16 * MiB;
constexpr size_t WS_MISC = 464 * MiB;
constexpr size_t WS_KMEAN = WS_MISC;
constexpr size_t WS_BPERM = WS_MISC + 1 * MiB;
constexpr size_t WS_WRH = WS_MISC + 2 * MiB;
constexpr size_t WS_WRL = WS_WRH + 98304;
constexpr size_t WS_TOKE = WS_MISC + 3 * MiB;
constexpr size_t WS_TOKW = WS_MISC + 4 * MiB;
constexpr size_t WS_TOKD = WS_MISC + 5 * MiB;
constexpr size_t WS_WGCNT = WS_MISC + 6 * MiB;
constexpr size_t WS_ROWTOK = WS_MISC + 7 * MiB;
constexpr size_t WS_TILEE = WS_MISC + 8 * MiB;
constexpr size_t WS_STATS = WS_MISC + 9 * MiB;
constexpr size_t WS_LB = WS_MISC + 10 * MiB;
constexpr size_t WS_KK = WS_MISC + 12 * MiB;
constexpr size_t WS_END = 512 * MiB;
constexpr int CW_BAR = 4096, CW_QUEUE = 8192, CW_QUEUE2 = 8192 + 1024;

constexpr int LDS_BYTES = 163840, MISC_OFF = LDS_BYTES - 256;

DI unsigned cvtpk(float lo, float hi) { f32x2 v = {lo, hi}; bf16x2_t b = __builtin_convertvector(v, bf16x2_t); return __builtin_bit_cast(unsigned, b); }
DI float bflo(unsigned w) { return __uint_as_float(w << 16); }
DI float bfhi(unsigned w) { return __uint_as_float(w & 0xffff0000u); }
DI float bf2f(unsigned short h) { return __uint_as_float((unsigned)h << 16); }
DI float frcp(float x) { return __builtin_amdgcn_rcpf(x); }
DI float fsigmoid(float x) { return frcp(1.f + __expf(-x)); }
DI float wave_sum(float v) {
#pragma unroll
    for (int o = 1; o < 64; o <<= 1) v += __shfl_xor(v, o);
    return v;
}
DI int crow(int r, int hi) { return (r & 3) + 8 * (r >> 2) + 4 * hi; }
#define MFMA32(a, b, c) __builtin_amdgcn_mfma_f32_32x32x16_bf16((a), (b), (c), 0, 0, 0)
#define MFMA16(a, b, c) __builtin_amdgcn_mfma_f32_16x16x32_bf16((a), (b), (c), 0, 0, 0)
DI s16x4 vtr(LAS const char* p) { return __builtin_bit_cast(s16x4, __builtin_amdgcn_ds_read_tr16_b64_v4i16((LAS v4i16_t*)p)); }

#define XB_TMO      128
#define XB_XCNT(j)  (256  + 64 * (j))
#define XB_XSUB(j)  (1280 + 64 * (j))
#define XB_XGEN(j)  (2304 + 64 * (j))
#define XB_TOP      3328
#define XB_TOPGEN   3392
#define XCD_BAR_WORDS 3456
#define XB_SPIN_CAP (1u << 22)
DI unsigned xb_ld(unsigned* p)              { return __hip_atomic_load(p, __ATOMIC_RELAXED, __HIP_MEMORY_SCOPE_AGENT); }
DI unsigned xb_add(unsigned* p, unsigned v) { return __hip_atomic_fetch_add(p, v, __ATOMIC_RELAXED, __HIP_MEMORY_SCOPE_AGENT); }
DI unsigned xb_xcc_id() { return (unsigned)__builtin_amdgcn_s_getreg((3 << 11) | 20) & 0xFu; }
#define XB_SPIN(cond, bar) do { unsigned _sp = 0; while (cond) { __builtin_amdgcn_s_sleep(1); \
    if ((++_sp & 255u) == 0u) { if (xb_ld(&(bar)[XB_TMO])) break; if (_sp > XB_SPIN_CAP) { atomicAdd(&(bar)[XB_TMO], 1u); break; } } } } while (0)
struct XcdBarrier { unsigned* bar; unsigned x; volatile LAS unsigned* st; };
DI XcdBarrier xcd_barrier_post(unsigned* bar, volatile LAS unsigned* st) {
    XcdBarrier b; b.bar = bar; b.x = xb_xcc_id(); b.st = st;
    if (threadIdx.x == 0) (void)xb_add(&bar[XB_XCNT(b.x)], 1u);
    return b;
}
DI void xcd_barrier_complete(unsigned* bar, unsigned x, unsigned& nloc, unsigned& nx) {
    const unsigned G = gridDim.x * gridDim.y * gridDim.z;
    unsigned sum, cnt, mine, sp = 0u;
    for (;;) {
        sum = 0u; cnt = 0u; mine = 0u;
#pragma unroll
        for (unsigned j = 0; j < 16; ++j) { const unsigned c = xb_ld(&bar[XB_XCNT(j)]); sum += c; cnt += (c > 0u) ? 1u : 0u; mine = (j == x) ? c : mine; }
        if (sum == G) break;
        __builtin_amdgcn_s_sleep(1);
        if ((++sp & 255u) == 0u) { if (xb_ld(&bar[XB_TMO])) break; if (sp > XB_SPIN_CAP) { atomicAdd(&bar[XB_TMO], 1u); break; } }
    }
    nloc = mine > 0u ? mine : 1u; nx = cnt > 0u ? cnt : 1u;
}
DI void xcd_barrier(const XcdBarrier& b) {
    asm volatile("s_waitcnt vmcnt(0)" ::: "memory");
    __syncthreads();
    if (threadIdx.x == 0) {
        unsigned* bar = b.bar;
        __builtin_amdgcn_s_waitcnt(0);
        unsigned nloc = b.st[0], nx = b.st[1];
        if (nloc == 0u) { xcd_barrier_complete(bar, b.x, nloc, nx); b.st[0] = nloc; b.st[1] = nx; }
        const unsigned old = xb_add(&bar[XB_XSUB(b.x)], 1u);
        const unsigned gen = old / nloc;
        if (old + 1u == (gen + 1u) * nloc) {
            __builtin_amdgcn_fence(__ATOMIC_RELEASE, "agent");
            asm volatile("s_waitcnt vmcnt(0)" ::: "memory");
            const unsigned og = xb_add(&bar[XB_TOP], 1u);
            const unsigned tg = og / nx;
            if (og + 1u == (tg + 1u) * nx) xb_add(&bar[XB_TOPGEN], 1u);
            else XB_SPIN(xb_ld(&bar[XB_TOPGEN]) == tg, bar);
            __builtin_amdgcn_fence(__ATOMIC_ACQUIRE, "agent");
            xb_add(&bar[XB_XGEN(b.x)], 1u);
            asm volatile("s_waitcnt vmcnt(0)" ::: "memory");
        } else {
            XB_SPIN(xb_ld(&bar[XB_XGEN(b.x)]) == gen, bar);
            __builtin_amdgcn_fence(__ATOMIC_ACQUIRE, "agent");
            asm volatile("s_waitcnt vmcnt(0)" ::: "memory");
        }
    }
    __syncthreads();
}

namespace pg8 {
constexpr int BM = 256, BK = 64, HALF = 128, HTB = HALF * BK * 2, STAGE_BYTES = 8 * HTB, NXCD = 8, WGM = 8;
DI int lds_byte(int r, int c) { const int st = (r >> 4) * 2 + (c >> 5), rr = r & 15, cc = c & 31, ob = rr * 64 + cc * 2; return st * 1024 + (ob ^ (((ob >> 9) & 1) << 5)); }
DI void stage_rc(int b, int& R, int& C) { const int st = b / 1024, sb = b % 1024, swz = sb ^ (((sb >> 9) & 1) << 5); R = (st >> 1) * 16 + swz / 64; C = (st & 1) * 32 + (swz % 64) / 2; }
DI int perm32(int rho) { const int n = rho >> 4, i = rho & 15; return 8 * (i >> 2) + 4 * n + (i & 3); }
struct Unit { int pm, pn, e; };

struct DenseOrder {
    const char* A; const char* Bt; int K, nM, nN, nwg, G, c;
    DI void init(const void* A_, const void* Bt_, int M, int N, int K_, int G_, int c_) { A = (const char*)A_; Bt = (const char*)Bt_; K = K_; nM = M / BM; nN = N / BM; nwg = nM * nN; G = G_; c = c_; }
    DI bool next(int i, Unit& u) const {
        const long L = (long)i * G + c; if (L >= nwg) return false;
        int wgid = (int)L; { const int q = nwg / NXCD, r = nwg % NXCD, xcd = wgid % NXCD, off = wgid / NXCD; wgid = (xcd < r ? xcd * (q + 1) : r * (q + 1) + (xcd - r) * q) + off; }
        const int nig = WGM * nN, gid = wgid / nig, fm = gid * WGM, gsz = (nM - fm) < WGM ? (nM - fm) : WGM;
        u.pm = fm + ((wgid % nig) % gsz); u.pn = (wgid % nig) / gsz; u.e = 0; return true;
    }
    DI const char* a_base(const Unit& u) const { return A + (size_t)u.pm * 512 * K; }
    DI const char* b_base(const Unit& u) const { return Bt + (size_t)u.pn * 512 * K; }
    DI void gather(const Unit&, const int (&)[2], const int (&)[2], unsigned (&)[2][2]) const {}
};
struct MoeOrder {
    const char* A; const char* Bt; const int* row_tok; const int* tile_e; int K, N, nunits, G, c; bool gat;
    DI bool next(int i, Unit& u) const {
        const int L = i * G + c; if (L >= nunits) return false;
        u.pm = L >> 2; u.pn = L & 3;
        u.e = __builtin_amdgcn_readfirstlane(__hip_atomic_load(tile_e + u.pm, __ATOMIC_RELAXED, __HIP_MEMORY_SCOPE_AGENT)); return true;
    }
    DI const char* a_base(const Unit& u) const { return gat ? A : A + (size_t)u.pm * 512 * K; }
    DI const char* b_base(const Unit& u) const { return Bt + ((size_t)u.e * N + (size_t)u.pn * 256) * K * 2; }
    DI void gather(const Unit& u, const int (&Rr)[2], const int (&Cc)[2], unsigned (&o)[2][2]) const {
#pragma unroll
        for (int h = 0; h < 2; ++h)
#pragma unroll
            for (int i = 0; i < 2; ++i) { const int tok = row_tok[u.pm * 256 + h * 128 + Rr[i]]; o[h][i] = (unsigned)(tok * K + Cc[i]) * 2u; }
    }
};

template <class Epi, class Sched, bool GATHER>
DI void gemm_phase(LAS unsigned char* lds, const int K, const Sched& S, const Epi& E) {
    const int tid = threadIdx.x, wid = __builtin_amdgcn_readfirstlane(tid >> 6), lane = tid & 63, wr = wid >> 2, wc = wid & 3, fr = lane & 15, fq = lane >> 4;
    const int nt = K / BK;
    unsigned voffB[2], vA[2][2], nvA[2][2]; int Rr[2], Cc[2];
#pragma unroll
    for (int i = 0; i < 2; ++i) { int R, C; stage_rc(tid * 16 + i * 8192, R, C); Rr[i] = R; Cc[i] = C; const int Rb = (R & ~31) + perm32(R & 31);
        voffB[i] = (unsigned)(Rb * K + C) * 2u; vA[0][i] = (unsigned)(R * K + C) * 2u; vA[1][i] = (unsigned)((R + HALF) * K + C) * 2u; nvA[0][i] = vA[0][i]; nvA[1][i] = vA[1][i]; }
    const size_t kstep = (size_t)(BK * 2);
    const size_t hstep = (size_t)HALF * K * 2;
    const unsigned ldsw = (unsigned)wid * 1024u;
    const int aoff = lds_byte(wr * 64 + fr, fq * 8), boff = lds_byte(wc * 32 + fr, fq * 8);
#define PG8_SA(b, h) (((b) * 2 + (h)) * HTB)
#define PG8_SB(b, h) ((4 + (b) * 2 + (h)) * HTB)
#define PG8_STAGE(bufoff, gbase, voff) do { _Pragma("unroll") for (int _i = 0; _i < 2; ++_i) \
        __builtin_amdgcn_global_load_lds((const unsigned*)((const char*)(gbase) + (voff)[_i]), (LAS unsigned*)(lds + (bufoff) + ldsw + _i * 8192), 16, 0, 0); } while (0)
#define PG8_LDA(dst, b, h) do { _Pragma("unroll") for (int m = 0; m < 4; ++m) _Pragma("unroll") for (int k = 0; k < 2; ++k) dst[m][k] = *(const LAS bf16x8*)(lds + PG8_SA(b, h) + aoff + m * 2048 + k * 1024); } while (0)
#define PG8_LDB(dst, b, h) do { _Pragma("unroll") for (int n = 0; n < 2; ++n) _Pragma("unroll") for (int k = 0; k < 2; ++k) dst[n][k] = *(const LAS bf16x8*)(lds + PG8_SB(b, h) + boff + n * 2048 + k * 1024); } while (0)
#define PG8_MMA(ai, bj, At, Bt) do { __builtin_amdgcn_s_setprio(1); _Pragma("unroll") for (int m = 0; m < 4; ++m) _Pragma("unroll") for (int n = 0; n < 2; ++n) _Pragma("unroll") for (int k = 0; k < 2; ++k) \
        acc[ai][bj][m][n] = __builtin_amdgcn_mfma_f32_16x16x32_bf16(Bt[n][k], At[m][k], acc[ai][bj][m][n], 0, 0, 0); __builtin_amdgcn_s_setprio(0); } while (0)
#define PG8_WAIT_V(n) asm volatile("s_waitcnt vmcnt(" #n ")" ::: "memory")
#define PG8_WAIT_L(n) asm volatile("s_waitcnt lgkmcnt(" #n ")" ::: "memory")
#define PG8_BAR __builtin_amdgcn_s_barrier()
#define PG8_SCHED __builtin_amdgcn_sched_barrier(0)
    Unit cur, nxt; int ui = 0;
    if (!S.next(0, cur)) return;
    if constexpr (GATHER) S.gather(cur, Rr, Cc, vA);
    f32x4 acc[2][2][4][2];
#pragma unroll
    for (int a = 0; a < 2; ++a)
#pragma unroll
        for (int b = 0; b < 2; ++b)
#pragma unroll
            for (int m = 0; m < 4; ++m)
#pragma unroll
                for (int n = 0; n < 2; ++n) acc[a][b][m][n] = (f32x4){0.f, 0.f, 0.f, 0.f};
    bf16x8 At[4][2], B0[2][2], B1[2][2];
    const char* cA = S.a_base(cur); const char* cB = S.b_base(cur);
    PG8_STAGE(PG8_SB(0, 0), cB, voffB); PG8_STAGE(PG8_SB(0, 1), cB + hstep, voffB); PG8_STAGE(PG8_SA(0, 0), cA, vA[0]); PG8_STAGE(PG8_SA(0, 1), cA, vA[1]);
    if (wr == 1) PG8_BAR;
    PG8_WAIT_V(2); PG8_BAR;
    PG8_STAGE(PG8_SB(1, 0), cB + kstep, voffB); PG8_STAGE(PG8_SA(1, 0), cA + kstep, vA[0]); PG8_STAGE(PG8_SB(1, 1), cB + hstep + kstep, voffB);
    PG8_WAIT_V(6); PG8_BAR;
    for (;;) {
        const bool has_next = S.next(ui + 1, nxt);
        const char* nA = has_next ? S.a_base(nxt) : cA; const char* nB = has_next ? S.b_base(nxt) : cB;
        if constexpr (GATHER) {
            if (has_next) S.gather(nxt, Rr, Cc, nvA);
            else {
#pragma unroll
                for (int h = 0; h < 2; ++h) { nvA[h][0] = vA[h][0]; nvA[h][1] = vA[h][1]; } }
        }
        for (int t = 0; t < nt; t += 2) {
            const bool last = (t == nt - 2);
            if constexpr (Epi::HAS_MID) { if (t == (nt >> 1)) E.mid(acc, cur, wr, wc, fr, fq); }
            const char* a1 = cA + (size_t)(t + 1) * kstep;
            const char* a2 = last ? nA : cA + (size_t)(t + 2) * kstep; const char* b2 = last ? nB : cB + (size_t)(t + 2) * kstep;
            const char* a3 = a2 + kstep; const char* b3 = b2 + kstep;
            unsigned o0[2], o1[2];
            if constexpr (GATHER) { o0[0] = last ? nvA[0][0] : vA[0][0]; o0[1] = last ? nvA[0][1] : vA[0][1]; o1[0] = last ? nvA[1][0] : vA[1][0]; o1[1] = last ? nvA[1][1] : vA[1][1]; }
            else { o0[0] = vA[0][0]; o0[1] = vA[0][1]; o1[0] = vA[1][0]; o1[1] = vA[1][1]; }
            PG8_LDB(B0, 0, 0); PG8_LDB(B1, 0, 1); PG8_SCHED; PG8_LDA(At, 0, 0); PG8_STAGE(PG8_SA(1, 1), a1, vA[1]);
            PG8_WAIT_V(8); PG8_WAIT_L(0); PG8_BAR; PG8_MMA(0, 0, At, B0); PG8_MMA(0, 1, At, B1); PG8_BAR; PG8_SCHED;
            PG8_LDA(At, 0, 1); PG8_STAGE(PG8_SB(0, 0), b2, voffB); PG8_STAGE(PG8_SB(0, 1), b2 + hstep, voffB); PG8_STAGE(PG8_SA(0, 0), a2, o0);
            PG8_WAIT_V(8); PG8_WAIT_L(0); PG8_BAR; PG8_MMA(1, 0, At, B0); PG8_MMA(1, 1, At, B1); PG8_BAR; PG8_SCHED;
            PG8_LDB(B0, 1, 0); PG8_LDB(B1, 1, 1); PG8_SCHED; PG8_LDA(At, 1, 0); PG8_STAGE(PG8_SA(0, 1), a2, o1);
            PG8_WAIT_V(8); PG8_WAIT_L(0); PG8_BAR; PG8_MMA(0, 0, At, B0); PG8_MMA(0, 1, At, B1); PG8_BAR; PG8_SCHED;
            PG8_LDA(At, 1, 1); PG8_STAGE(PG8_SB(1, 0), b3, voffB); PG8_STAGE(PG8_SB(1, 1), b3 + hstep, voffB); PG8_STAGE(PG8_SA(1, 0), a3, o0);
            PG8_WAIT_V(8); PG8_WAIT_L(0); PG8_BAR; PG8_MMA(1, 0, At, B0); PG8_MMA(1, 1, At, B1); PG8_BAR; PG8_SCHED;
        }
        if (wr == 0) PG8_BAR;
        E(acc, cur, wr, wc, fr, fq);
        if (!has_next) break;
#pragma unroll
        for (int a = 0; a < 2; ++a)
#pragma unroll
            for (int b = 0; b < 2; ++b)
#pragma unroll
                for (int m = 0; m < 4; ++m)
#pragma unroll
                    for (int n = 0; n < 2; ++n) acc[a][b][m][n] = (f32x4){0.f, 0.f, 0.f, 0.f};
        cur = nxt; cA = nA; cB = nB; ++ui;
        if constexpr (GATHER) {
#pragma unroll
            for (int h = 0; h < 2; ++h) { vA[h][0] = nvA[h][0]; vA[h][1] = nvA[h][1]; } }
        if (wr == 1) PG8_BAR;
    }
    PG8_WAIT_V(0);
    PG8_BAR;
#undef PG8_SA
#undef PG8_SB
#undef PG8_STAGE
#undef PG8_LDA
#undef PG8_LDB
#undef PG8_MMA
#undef PG8_WAIT_V
#undef PG8_WAIT_L
#undef PG8_BAR
#undef PG8_SCHED
}

typedef f32x4 Acc[2][2][4][2];
DI u32x4 pack8(const f32x4 a, const f32x4 b) { u32x4 w; w.x = cvtpk(a[0], a[1]); w.y = cvtpk(a[2], a[3]); w.z = cvtpk(b[0], b[1]); w.w = cvtpk(b[2], b[3]); return w; }
DI f32x4 silu4(const f32x4 v) { f32x4 o; o[0] = v[0] * fsigmoid(v[0]); o[1] = v[1] * fsigmoid(v[1]); o[2] = v[2] * fsigmoid(v[2]); o[3] = v[3] * fsigmoid(v[3]); return o; }

struct EpiIn {
    static constexpr bool HAS_MID = false;
    bf16 *Qh, *Vh, *Gh, *Qm, *Km, *Vm, *Rr, *Gb; float *Zf, *KM; const float* bias; bf16* KK; const float* LB;
    DI void operator()(Acc& acc, const Unit& u, int wr, int wc, int fr, int fq) const {
        const int pn = u.pn, row0 = u.pm * BM + wr * 64 + fr, cl = wc * 32 + 8 * fq;
        f32x4 bv[2][2];
#pragma unroll
        for (int bj = 0; bj < 2; ++bj)
#pragma unroll
            for (int n = 0; n < 2; ++n) bv[bj][n] = *(const f32x4*)(bias + pn * 256 + bj * HALF + cl + 4 * n);
        if (pn < 4) {
#define EI_DPP(v, ctrl) __int_as_float(__builtin_amdgcn_update_dpp(0, __float_as_int(v), ctrl, 0xf, 0xf, true))
            const int chb = pn * 128 + cl;
#pragma unroll
            for (int ai = 0; ai < 2; ++ai)
#pragma unroll
                for (int n = 0; n < 2; ++n) { const f32x4 lbv = *(const f32x4*)(LB + chb + 4 * n); f32x4 run = (f32x4){0.f, 0.f, 0.f, 0.f}, bmid = run; f32x4 bbv[4], kkv[4];
#pragma unroll
                    for (int m = 0; m < 4; ++m) {
#pragma unroll
                        for (int j = 0; j < 4; ++j) { const float z = acc[ai][1][m][n][j] + bv[1][n][j]; const float sg = frcp(1.f + __expf(-z)); const float lf = __logf(lbv[j] + (1.f - lbv[j]) * sg); kkv[m][j] = (1.f - lbv[j]) * (1.f - sg);
                            float t = lf; t += EI_DPP(t, 0xB1); t += EI_DPP(t, 0x4E); t += EI_DPP(t, 0x141); t += EI_DPP(t, 0x140);
                            float s = lf; s += EI_DPP(s, 0x111); s += EI_DPP(s, 0x112); s += EI_DPP(s, 0x114); s += EI_DPP(s, 0x118);
                            bbv[m][j] = s + run[j]; run[j] += t; }
                        if (m == 1) bmid = run; }
#pragma unroll
                    for (int m = 0; m < 4; ++m) { f32x4 qp, kp;
#pragma unroll
                        for (int j = 0; j < 4; ++j) { const float qx = acc[ai][0][m][n][j] + bv[0][n][j]; const float e = __expf(bbv[m][j] - bmid[j]); qp[j] = qx * fsigmoid(qx) * e; kp[j] = kkv[m][j] * frcp(e); }
                        const size_t ro = (size_t)(row0 + ai * HALF + m * 16) * 512 + chb + 4 * n;
                        u32x2 qw, kw; qw.x = cvtpk(qp[0], qp[1]); qw.y = cvtpk(qp[2], qp[3]); kw.x = cvtpk(kp[0], kp[1]); kw.y = cvtpk(kp[2], kp[3]);
                        *(u32x2*)(Qh + ro) = qw; *(u32x2*)(KK + ro) = kw; }
                    if (fr == 0) { const size_t so = (size_t)(u.pm * 4 + ai * 2 + wr) * 512 + chb + 4 * n; *(f32x4*)(Zf + so) = bmid; *(f32x4*)(Zf + 262144 + so) = run; }
                    asm volatile("" ::: "memory"); }
#undef EI_DPP
        } else if (pn < 14) {
            const int seg = pn >> 1, c0 = (pn & 1) * 256 + cl;
            {
                bf16* O = seg == 2 ? Vh : seg == 3 ? Gh : seg == 4 ? Qm : seg == 5 ? Km : Vm;
                const int act = (seg == 3) ? 1 : (seg == 4 ? 2 : 0);
                if (seg == 5) {
#pragma unroll
                    for (int bj = 0; bj < 2; ++bj)
#pragma unroll
                        for (int n = 0; n < 2; ++n) { f32x4 cs = (f32x4){0.f, 0.f, 0.f, 0.f};
#pragma unroll
                            for (int ai = 0; ai < 2; ++ai)
#pragma unroll
                                for (int m = 0; m < 4; ++m) cs += acc[ai][bj][m][n] + bv[bj][n];
#pragma unroll
                            for (int j = 0; j < 4; ++j) { float s = cs[j]; s += __shfl_xor(s, 1); s += __shfl_xor(s, 2); s += __shfl_xor(s, 4); s += __shfl_xor(s, 8); cs[j] = s; }
                            if (fr == 0) *(f32x4*)(KM + (size_t)(u.pm * 2 + wr) * 512 + c0 + bj * HALF + 4 * n) = cs; }
                }
#pragma unroll
                for (int ai = 0; ai < 2; ++ai)
#pragma unroll
                    for (int m = 0; m < 4; ++m) { const int row = row0 + ai * HALF + m * 16;
                        bf16* rp = (seg >= 4) ? O + ((size_t)(row >> 11) * 8 * SEQ + (row & (SEQ - 1))) * 64 + (size_t)(c0 >> 6) * SEQ * 64 + (c0 & 63) : O + (size_t)row * 512 + c0;
                        const size_t bjs = (seg >= 4) ? (size_t)2 * SEQ * 64 : (size_t)HALF;
#pragma unroll
                        for (int bj = 0; bj < 2; ++bj) { f32x4 v0 = acc[ai][bj][m][0] + bv[bj][0], v1 = acc[ai][bj][m][1] + bv[bj][1];
                            if (act == 1) { v0 = silu4(v0); v1 = silu4(v1); } else if (act == 2) { v0 = v0 * (0.125f * LOG2E); v1 = v1 * (0.125f * LOG2E); }
                            *(u32x4*)(rp + bj * bjs) = pack8(v0, v1); }
                        asm volatile("" ::: "memory"); }
            }
        } else {
            const int c0 = (pn - 14) * 128 + cl;
#pragma unroll
            for (int ai = 0; ai < 2; ++ai)
#pragma unroll
                for (int m = 0; m < 4; ++m) { const size_t off = (size_t)(row0 + ai * HALF + m * 16) * 1024 + c0; f32x4 r[2], g[2];
#pragma unroll
                    for (int n = 0; n < 2; ++n) { const f32x4 a = acc[ai][0][m][n] + bv[0][n], b = acc[ai][1][m][n] + bv[1][n];
#pragma unroll
                        for (int j = 0; j < 4; ++j) { const float ea = __expf(-a[j]), eb = __expf(-b[j]); g[n][j] = frcp(1.f + eb); r[n][j] = (1.f + eb) * frcp(1.f + ea); } }
                    *(u32x4*)(Rr + off) = pack8(r[0], r[1]); *(u32x4*)(Gb + off) = pack8(g[0], g[1]); asm volatile("" ::: "memory"); }
        }
    }
};
struct EpiProj {
    static constexpr bool HAS_MID = true;
    const bf16 *Rr, *Gb; bf16* U;
    DI void scale(Acc& acc, const bf16* G, const Unit& u, int wr, int wc, int fr, int fq) const {
        int row0 = u.pm * BM + wr * 64 + fr, col0 = u.pn * BM + wc * 32 + 8 * fq;
        asm volatile("" : "+v"(row0), "+v"(col0));
#pragma unroll
        for (int ai = 0; ai < 2; ++ai)
#pragma unroll
            for (int mp = 0; mp < 2; ++mp) { u32x4 rv[2][2];
#pragma unroll
            for (int m = 0; m < 2; ++m)
#pragma unroll
                for (int bj = 0; bj < 2; ++bj) rv[m][bj] = *(const u32x4*)(G + (size_t)(row0 + ai * HALF + (2 * mp + m) * 16) * 1024 + col0 + bj * HALF);
#pragma unroll
            for (int m = 0; m < 2; ++m)
#pragma unroll
                for (int bj = 0; bj < 2; ++bj) { const u32x4 w = rv[m][bj];
                    acc[ai][bj][2 * mp + m][0] *= (f32x4){bflo(w.x), bfhi(w.x), bflo(w.y), bfhi(w.y)}; acc[ai][bj][2 * mp + m][1] *= (f32x4){bflo(w.z), bfhi(w.z), bflo(w.w), bfhi(w.w)}; }
            asm volatile("" ::: "memory"); }
    }
    DI void mid(Acc& acc, const Unit& u, int wr, int wc, int fr, int fq) const { scale(acc, Rr, u, wr, wc, fr, fq); }
    DI void operator()(Acc& acc, const Unit& u, int wr, int wc, int fr, int fq) const {
        scale(acc, Gb, u, wr, wc, fr, fq);
        const int row0 = u.pm * BM + wr * 64 + fr, col0 = u.pn * BM + wc * 32 + 8 * fq;
#pragma unroll
        for (int ai = 0; ai < 2; ++ai)
#pragma unroll
            for (int m = 0; m < 4; ++m) { bf16* rp = U + (size_t)(row0 + ai * HALF + m * 16) * 1024 + col0;
#pragma unroll
                for (int bj = 0; bj < 2; ++bj) *(u32x4*)(rp + bj * HALF) = pack8(acc[ai][bj][m][0], acc[ai][bj][m][1]); }
    }
};
struct EpiOut {
    static constexpr bool HAS_MID = false;
    const float* X; float* Pre;
    DI void operator()(Acc& acc, const Unit& u, int wr, int wc, int fr, int fq) const {
        const int row0 = u.pm * BM + wr * 64 + fr, col0 = u.pn * BM + wc * 32 + 8 * fq;
#pragma unroll
        for (int ai = 0; ai < 2; ++ai)
#pragma unroll
            for (int m = 0; m < 4; ++m) { const size_t off = (size_t)(row0 + ai * HALF + m * 16) * 1024 + col0;
#pragma unroll
                for (int bj = 0; bj < 2; ++bj) { const f32x4 x0 = *(const f32x4*)(X + off + bj * HALF), x1 = *(const f32x4*)(X + off + bj * HALF + 4);
                    *(f32x4*)(Pre + off + bj * HALF) = x0 * DN_ALPHA + acc[ai][bj][m][0]; *(f32x4*)(Pre + off + bj * HALF + 4) = x1 * DN_ALPHA + acc[ai][bj][m][1]; }
                if (m & 1) asm volatile("" ::: "memory"); }
    }
};
struct EpiM1 {
    static constexpr bool HAS_MID = false;
    bf16* H;
    DI void operator()(Acc& acc, const Unit& u, int wr, int wc, int fr, int fq) const {
        const int row0 = u.pm * BM + wr * 64 + fr, col0 = u.pn * 128 + wc * 32 + 8 * fq;
#pragma unroll
        for (int ai = 0; ai < 2; ++ai)
#pragma unroll
            for (int m = 0; m < 4; ++m) *(u32x4*)(H + (size_t)(row0 + ai * HALF + m * 16) * 512 + col0) = pack8(silu4(acc[ai][0][m][0]) * acc[ai][1][m][0], silu4(acc[ai][0][m][1]) * acc[ai][1][m][1]);
    }
};
struct EpiM2 {
    static constexpr bool HAS_MID = false;
    bf16* Y;
    DI void operator()(Acc& acc, const Unit& u, int wr, int wc, int fr, int fq) const {
        const int row0 = u.pm * BM + wr * 64 + fr, col0 = u.pn * BM + wc * 32 + 8 * fq;
#pragma unroll
        for (int ai = 0; ai < 2; ++ai)
#pragma unroll
            for (int m = 0; m < 4; ++m) { bf16* rp = Y + (size_t)(row0 + ai * HALF + m * 16) * 1024 + col0;
#pragma unroll
                for (int bj = 0; bj < 2; ++bj) *(u32x4*)(rp + bj * HALF) = pack8(acc[ai][bj][m][0], acc[ai][bj][m][1]); }
    }
};
}

struct Args { const float* in[19]; float* out; unsigned char* ws; int ph_lo, ph_hi; };
enum { I_X = 0, I_WIN, I_BIN, I_LBL, I_HGNG, I_RELB, I_WPA, I_WPB, I_WOUT, I_LN1G, I_LN1B, I_WGRP, I_BGRP, I_WEXP, I_BEXP, I_WGU, I_WDN, I_LN2G, I_LN2B };

struct Ctx {
    LAS unsigned char* lds; volatile LAS unsigned* MISC;
    int tid, lane, wid, G, vcu;
    unsigned char* ws; gu32* ctl;
};

DI int win_drow(int n0) { if (n0 < 512) return 256 * (n0 >> 7) + (n0 & 127); if (n0 < 1024) { const int r = n0 - 512; return 256 * (r >> 7) + 128 + (r & 127); }
    if (n0 < 3584) return n0; if (n0 < 4608) { const int r = n0 - 3584; return 3584 + 256 * (r >> 7) + (r & 127); } const int r = n0 - 4608; return 3584 + 256 * (r >> 7) + 128 + (r & 127); }
DI int wgu_drow(int n0) { if (n0 < 512) return 256 * (n0 >> 7) + (n0 & 127); const int r = n0 - 512; return 256 * (r >> 7) + 128 + (r & 127); }
DI int hswz(int row, int ch16) { return 256 * row + 16 * (ch16 ^ (((row & 3) << 2) | ((row >> 2) & 3))); }
DI int htr(int r0, int c0, int lane) { const int i16 = lane & 15, q = i16 >> 2, p = i16 & 3; return hswz(r0 + q, c0 + (p >> 1)) + 8 * (p & 1); }
DI void transpose_tile256(const float* W, int N, bf16* WT, int ldk, int n0, int mode, int dk, LAS unsigned char* lds, int lane, int wid) {
    asm volatile("" : "+v"(lane));
#pragma unroll
    for (int half = 0; half < 2; ++half) { f32x4 v[16];
#pragma unroll
        for (int i = 0; i < 16; ++i) v[i] = *(const f32x4*)(W + (size_t)(128 * half + 8 * i + wid) * N + 4 * lane);
#pragma unroll
        for (int i = 0; i < 16; ++i) { const int k = 128 * half + 8 * i + wid; u32x2 w; w.x = cvtpk(v[i][0], v[i][1]); w.y = cvtpk(v[i][2], v[i][3]);
            *(LAS u32x2*)(lds + (lane >> 5) * 65536 + hswz(k, (lane & 31) >> 1) + 8 * (lane & 1)) = w; } }
    __syncthreads();
    const int g = lane >> 4, i16 = lane & 15;
#pragma unroll
    for (int nb = 0; nb < 2; ++nb) { const int nl = 32 * wid + 16 * nb + i16, n = n0 + nl; const int dr = (mode == 0) ? n : (mode == 1 ? win_drow(n) : wgu_drow(n));
        bf16* orow = WT + (size_t)dr * ldk + dk + 8 * g; const LAS unsigned char* img = lds + (wid >> 2) * 65536;
#pragma unroll
        for (int s = 0; s < 8; ++s) { const int r0 = 32 * s + 8 * g, c0 = 4 * (wid & 3) + 2 * nb;
            const s16x4 lo = vtr((LAS const char*)(img + htr(r0, c0, lane))), hh = vtr((LAS const char*)(img + htr(r0 + 4, c0, lane)));
            *(bf16x8*)(orow + 32 * s) = (bf16x8){lo[0], lo[1], lo[2], lo[3], hh[0], hh[1], hh[2], hh[3]}; } }
    __syncthreads();
}
constexpr int MOE_CVT_TILES = 32 * 16 + 32 * 8;
DI void moe_cvt_tile(const Ctx& C, const Args& a, int it) {
    bf16* WguT = (bf16*)a.out; bf16* WdT = (bf16*)((unsigned char*)a.out + 64 * MiB);
    if (it < 512) { const int e = it >> 4, kt = (it >> 2) & 3, nt = it & 3;
        transpose_tile256(a.in[I_WGU] + (size_t)e * 1024 * 1024 + (size_t)(256 * kt) * 1024 + 256 * nt, 1024, WguT + (size_t)e * 1024 * 1024, 1024, 256 * nt, 2, 256 * kt, C.lds, C.lane, C.wid); }
    else { const int r = it - 512, e = r >> 3, kt = (r >> 2) & 1, nt = r & 3;
        transpose_tile256(a.in[I_WDN] + (size_t)e * 512 * 1024 + (size_t)(256 * kt) * 1024 + 256 * nt, 1024, WdT + (size_t)e * 1024 * 512, 512, 256 * nt, 0, 256 * kt, C.lds, C.lane, C.wid); }
}
DI void p0_prologue(const Ctx& C, const Args& a) {
    bf16* WinT = (bf16*)(C.ws + WS_WIN); bf16* Wcat = (bf16*)(C.ws + WS_WCAT); bf16* WoT = (bf16*)(C.ws + WS_WO);
    constexpr int I_IN = 4 * 22, I_PA = 2 * 4, I_O = 4 * 4, NITEMS = I_IN + 2 * I_PA + I_O;
    for (int it = C.vcu; it < NITEMS; it += C.G) {
        int r = it;
        if (r < I_IN) { const int kt = r / 22, nt = r % 22; transpose_tile256(a.in[I_WIN] + (size_t)(256 * kt) * NIN + 256 * nt, NIN, WinT, 1024, 256 * nt, 1, 256 * kt, C.lds, C.lane, C.wid); continue; } r -= I_IN;
        if (r < I_PA) { const int kt = r / 4, nt = r % 4; transpose_tile256(a.in[I_WPA] + (size_t)(256 * kt) * 1024 + 256 * nt, 1024, Wcat, 1024, 256 * nt, 0, 256 * kt, C.lds, C.lane, C.wid); continue; } r -= I_PA;
        if (r < I_PA) { const int kt = r / 4, nt = r % 4; transpose_tile256(a.in[I_WPB] + (size_t)(256 * kt) * 1024 + 256 * nt, 1024, Wcat, 1024, 256 * nt, 0, 512 + 256 * kt, C.lds, C.lane, C.wid); continue; } r -= I_PA;
        { const int kt = r / 4, nt = r % 4; transpose_tile256(a.in[I_WOUT] + (size_t)(256 * kt) * 1024 + 256 * nt, 1024, WoT, 1024, 256 * nt, 0, 256 * kt, C.lds, C.lane, C.wid); }
    }
    const int gw = C.vcu * NWAVES + C.wid, NGW = C.G * NWAVES; (void)gw; (void)NGW;
    const int gt = C.vcu * NTHREADS + C.tid, NT = C.G * NTHREADS;
    { const float* x = a.in[I_X]; bf16* Xb = (bf16*)(C.ws + WS_XB);
      for (int i = gt; i < NTOK * DM / 8; i += NT) { const f32x4 v0 = *(const f32x4*)(x + (size_t)i * 8), v1 = *(const f32x4*)(x + (size_t)i * 8 + 4); *(u32x4*)(Xb + (size_t)i * 8) = pg8::pack8(v0, v1); } }
    { float* lbp = (float*)(C.ws + WS_LB); for (int n = gt; n < 512; n += NT) lbp[n] = 1.f / (1.f + expf(a.in[I_LBL][512 + n] - a.in[I_LBL][n])); }
    { float* bp = (float*)(C.ws + WS_BPERM); const float* bin = a.in[I_BIN];
      for (int n = gt; n < NIN; n += NT) bp[win_drow(n & ~31) + (n & 31)] = bin[n]; }
    { bf16* wh = (bf16*)(C.ws + WS_WRH); bf16* wl = (bf16*)(C.ws + WS_WRL); const float* wg = a.in[I_WGRP]; const float* we = a.in[I_WEXP];
      for (int i = gt; i < 48 * 1024; i += NT) { const int j = i >> 10, k = i & 1023; float w = 0.f; if (j < 4) w = wg[k * 4 + j]; else if (j < 36) w = we[k * 32 + (j - 4)];
          const unsigned h = cvtpk(w, 0.f) & 0xffffu; const float r = w - bf2f((unsigned short)h); wh[i] = (bf16)h; wl[i] = (bf16)(cvtpk(r, 0.f) & 0xffffu); } }
}
constexpr int HG_BUF = 67072, HG_QP = 0, HG_KP = 16384, HG_V = 32768, HG_SC = 49152, HG_OB = 49664;
DI void hgrn_unit(const Ctx& C, const Args& a, int b, int h) {
    LAS unsigned char* L = C.lds;
    const int tid = C.tid, lane = C.lane, wid = C.wid;
    const int q32 = lane & 31, hi = lane >> 5, dh = (lane >> 4) & 1, dvb = wid & 3, tb = wid >> 2;
    const float* BM = (const float*)(C.ws + WS_ZF); const float* BE = BM + 262144;
    const bf16* Qh = (const bf16*)(C.ws + WS_QH); const bf16* Kh = (const bf16*)(C.ws + WS_KK); const bf16* Vh = (const bf16*)(C.ws + WS_VH); const bf16* Gh = (const bf16*)(C.ws + WS_GH);
    bf16* Ocat = (bf16*)(C.ws + WS_XB);
    const size_t rb = (size_t)b * SEQ;
    LAS float* NGS = (LAS float*)(L + 2 * HG_BUF);
    if (tid < 128) NGS[tid] = a.in[I_HGNG][h * 128 + tid];
    const int orow = tid >> 3, oseg = tid & 7;
    f32x16 T[4];
#pragma unroll
    for (int i = 0; i < 4; ++i)
#pragma unroll
        for (int r = 0; r < 16; ++r) T[i][r] = 0.f;
    u32x4 gr[2];
    const int drow = 8 * wid + (lane >> 4), dch = lane & 15;
#define HG_DMA(c) do { _Pragma("unroll") for (int p = 0; p < 2; ++p) { const int r_ = drow + 4 * p; const int sc_ = dch ^ (((r_ & 3) << 2) | ((r_ >> 2) & 3)); \
            const size_t g_ = (rb + (size_t)(c) * 64 + r_) * 512 + h * 128 + 8 * sc_; LAS unsigned char* d_ = L + ((c) & 1) * HG_BUF + (8 * wid + 4 * p) * 256; \
            __builtin_amdgcn_global_load_lds((const unsigned*)(Qh + g_), (LAS unsigned*)(d_ + HG_QP), 16, 0, 0); \
            __builtin_amdgcn_global_load_lds((const unsigned*)(Kh + g_), (LAS unsigned*)(d_ + HG_KP), 16, 0, 0); \
            __builtin_amdgcn_global_load_lds((const unsigned*)(Vh + g_), (LAS unsigned*)(d_ + HG_V), 16, 0, 0); } } while (0)
    float sm = 0.f, spe = 0.f, spm = 0.f;
#define HG_SCLOAD(c) do { if (tid < 128) { const size_t s_ = (size_t)(b * 32 + (c)) * 512 + h * 128 + tid; sm = BM[s_]; if ((c) > 0) { spe = BE[s_ - 512]; spm = BM[s_ - 512]; } } } while (0)
#define HG_SCALE(c) do { if (tid < 128) ((LAS float*)(L + ((c) & 1) * HG_BUF + HG_SC))[tid] = __expf(sm + (spe - spm)); } while (0)
    HG_DMA(0);
    HG_SCLOAD(0);
    HG_SCALE(0);
    asm volatile("s_waitcnt vmcnt(0)" ::: "memory");
    __syncthreads();
    for (int c = 0; c < 32; ++c) {
        const LAS unsigned char* B = L + (c & 1) * HG_BUF;
        if (c + 1 < 32) { HG_DMA(c + 1); HG_SCLOAD(c + 1); }
        int q32o = q32, hio = hi, laneo = lane; asm volatile("" : "+v"(q32o), "+v"(hio), "+v"(laneo));
        f32x16 oT;
#pragma unroll
        for (int r = 0; r < 16; ++r) oT[r] = 0.f;
        bf16x8 qb[8];
#pragma unroll
        for (int ks = 0; ks < 8; ++ks) qb[ks] = *(const LAS bf16x8*)(B + HG_QP + hswz(32 * tb + q32o, 2 * ks + hio));
#pragma unroll
        for (int sb = 0; sb < 2; ++sb) {
            if (sb <= tb) {
                bf16x8 ka[8];
#pragma unroll
                for (int ks = 0; ks < 8; ++ks) ka[ks] = *(const LAS bf16x8*)(B + HG_KP + hswz(32 * sb + q32o, 2 * ks + hio));
                s16x4 vl[2], vh[2];
#pragma unroll
                for (int s2 = 0; s2 < 2; ++s2) { const int r0 = 32 * sb + 16 * s2 + 4 * hio; vl[s2] = vtr((LAS const char*)(B + HG_V + htr(r0, 4 * dvb + 2 * dh, laneo))); vh[s2] = vtr((LAS const char*)(B + HG_V + htr(r0 + 8, 4 * dvb + 2 * dh, laneo))); }
                __builtin_amdgcn_sched_barrier(0);
                f32x16 pT;
#pragma unroll
                for (int r = 0; r < 16; ++r) pT[r] = 0.f;
#pragma unroll
                for (int ks = 0; ks < 8; ++ks) pT = MFMA32(ka[ks], qb[ks], pT);
                if (sb == tb) {
#pragma unroll
                    for (int r = 0; r < 16; ++r) if (crow(r, hi) > q32) pT[r] = 0.f;
                }
#pragma unroll
                for (int s2 = 0; s2 < 2; ++s2) { u32x4 pw; pw.x = cvtpk(pT[8 * s2 + 0], pT[8 * s2 + 1]); pw.y = cvtpk(pT[8 * s2 + 2], pT[8 * s2 + 3]); pw.z = cvtpk(pT[8 * s2 + 4], pT[8 * s2 + 5]); pw.w = cvtpk(pT[8 * s2 + 6], pT[8 * s2 + 7]);
                    oT = MFMA32(((bf16x8){vl[s2][0], vl[s2][1], vl[s2][2], vl[s2][3], vh[s2][0], vh[s2][1], vh[s2][2], vh[s2][3]}), __builtin_bit_cast(bf16x8, pw), oT); }
                __builtin_amdgcn_sched_barrier(0);
            }
        }
        { const size_t g0 = (rb + (size_t)c * 64 + orow) * 512 + h * 128 + 16 * oseg; gr[0] = *(const u32x4*)(Gh + g0); gr[1] = *(const u32x4*)(Gh + g0 + 8); }
        {
            u32x2 qq0[8], qq1[8];
            if (c > 0) {
#pragma unroll
                for (int i = 0; i < 4; ++i)
#pragma unroll
                    for (int s = 0; s < 2; ++s) { qq0[2 * i + s] = *(const LAS u32x2*)(B + HG_QP + hswz(32 * tb + q32o, 4 * i + 2 * s) + 8 * hio); qq1[2 * i + s] = *(const LAS u32x2*)(B + HG_QP + hswz(32 * tb + q32o, 4 * i + 2 * s + 1) + 8 * hio); }
            }
#pragma unroll
            for (int i = 0; i < 4; ++i)
#pragma unroll
                for (int g = 0; g < 4; ++g) { const f32x4 sc = *(const LAS f32x4*)(B + HG_SC + (32 * i + 8 * g + 4 * hio) * 4);
#pragma unroll
                    for (int j = 0; j < 4; ++j) T[i][4 * g + j] *= sc[j]; }
            __builtin_amdgcn_sched_barrier(0);
            if (c > 0) {
#pragma unroll
                for (int i = 0; i < 4; ++i)
#pragma unroll
                    for (int s = 0; s < 2; ++s) { u32x4 tw; tw.x = cvtpk(T[i][8 * s + 0], T[i][8 * s + 1]); tw.y = cvtpk(T[i][8 * s + 2], T[i][8 * s + 3]); tw.z = cvtpk(T[i][8 * s + 4], T[i][8 * s + 5]); tw.w = cvtpk(T[i][8 * s + 6], T[i][8 * s + 7]);
                        const u32x4 qw = (u32x4){qq0[2 * i + s].x, qq0[2 * i + s].y, qq1[2 * i + s].x, qq1[2 * i + s].y};
                        oT = MFMA32(__builtin_bit_cast(bf16x8, tw), __builtin_bit_cast(bf16x8, qw), oT); }
            }
        }
        { LAS unsigned char* OBp = L + (c & 1) * HG_BUF + HG_OB;
#pragma unroll
          for (int g = 0; g < 4; ++g) { u32x2 w; w.x = cvtpk(oT[4 * g], oT[4 * g + 1]); w.y = cvtpk(oT[4 * g + 2], oT[4 * g + 3]); *(LAS u32x2*)(OBp + (32 * tb + q32o) * 272 + (32 * dvb + 8 * g + 4 * hio) * 2) = w; } }
#pragma unroll
        for (int sp = 0; sp < 2; ++sp) {
            s16x4 vl[2], vh[2], kl[2][4], kh[2][4];
#pragma unroll
            for (int u = 0; u < 2; ++u) { const int r0 = 16 * (2 * sp + u) + 8 * hio;
                vl[u] = vtr((LAS const char*)(B + HG_V + htr(r0, 4 * dvb + 2 * dh, laneo))); vh[u] = vtr((LAS const char*)(B + HG_V + htr(r0 + 4, 4 * dvb + 2 * dh, laneo)));
#pragma unroll
                for (int i = 0; i < 4; ++i) { kl[u][i] = vtr((LAS const char*)(B + HG_KP + htr(r0, 4 * i + 2 * dh, laneo))); kh[u][i] = vtr((LAS const char*)(B + HG_KP + htr(r0 + 4, 4 * i + 2 * dh, laneo))); } }
            __builtin_amdgcn_sched_barrier(0);
#pragma unroll
            for (int u = 0; u < 2; ++u) { const bf16x8 vb = (bf16x8){vl[u][0], vl[u][1], vl[u][2], vl[u][3], vh[u][0], vh[u][1], vh[u][2], vh[u][3]};
#pragma unroll
                for (int i = 0; i < 4; ++i) T[i] = MFMA32(((bf16x8){kl[u][i][0], kl[u][i][1], kl[u][i][2], kl[u][i][3], kh[u][i][0], kh[u][i][1], kh[u][i][2], kh[u][i][3]}), vb, T[i]); }
            __builtin_amdgcn_sched_barrier(0);
        }
        if (c + 1 < 32) HG_SCALE(c + 1);
        asm volatile("s_waitcnt vmcnt(0)" ::: "memory");
        __syncthreads();
        { const LAS unsigned char* OBp = L + (c & 1) * HG_BUF + HG_OB + orow * 272 + oseg * 32;
          const u32x4 o0 = *(const LAS u32x4*)OBp, o1 = *(const LAS u32x4*)(OBp + 16);
          float ov[16];
          ov[0] = bflo(o0.x); ov[1] = bfhi(o0.x); ov[2] = bflo(o0.y); ov[3] = bfhi(o0.y); ov[4] = bflo(o0.z); ov[5] = bfhi(o0.z); ov[6] = bflo(o0.w); ov[7] = bfhi(o0.w);
          ov[8] = bflo(o1.x); ov[9] = bfhi(o1.x); ov[10] = bflo(o1.y); ov[11] = bfhi(o1.y); ov[12] = bflo(o1.z); ov[13] = bfhi(o1.z); ov[14] = bflo(o1.w); ov[15] = bfhi(o1.w);
          float ss = 0.f;
#pragma unroll
          for (int j = 0; j < 16; ++j) ss += ov[j] * ov[j];
          ss += __int_as_float(__builtin_amdgcn_update_dpp(0, __float_as_int(ss), 0xB1, 0xf, 0xf, true));
          ss += __int_as_float(__builtin_amdgcn_update_dpp(0, __float_as_int(ss), 0x4E, 0xf, 0xf, true));
          ss += __int_as_float(__builtin_amdgcn_update_dpp(0, __float_as_int(ss), 0x141, 0xf, 0xf, true));
          const float rs = __builtin_amdgcn_rsqf(ss * (1.f / 128.f) + LN_EPS);
          float ng[16];
#pragma unroll
          for (int i = 0; i < 4; ++i) { const f32x4 n_ = *(const LAS f32x4*)(NGS + 16 * oseg + 4 * i); ng[4 * i] = n_[0]; ng[4 * i + 1] = n_[1]; ng[4 * i + 2] = n_[2]; ng[4 * i + 3] = n_[3]; }
          float gvv[16];
          gvv[0] = bflo(gr[0].x); gvv[1] = bfhi(gr[0].x); gvv[2] = bflo(gr[0].y); gvv[3] = bfhi(gr[0].y); gvv[4] = bflo(gr[0].z); gvv[5] = bfhi(gr[0].z); gvv[6] = bflo(gr[0].w); gvv[7] = bfhi(gr[0].w);
          gvv[8] = bflo(gr[1].x); gvv[9] = bfhi(gr[1].x); gvv[10] = bflo(gr[1].y); gvv[11] = bfhi(gr[1].y); gvv[12] = bflo(gr[1].z); gvv[13] = bfhi(gr[1].z); gvv[14] = bflo(gr[1].w); gvv[15] = bfhi(gr[1].w);
          u32x4 w0, w1;
          w0.x = cvtpk(ov[0] * rs * ng[0] * gvv[0], ov[1] * rs * ng[1] * gvv[1]); w0.y = cvtpk(ov[2] * rs * ng[2] * gvv[2], ov[3] * rs * ng[3] * gvv[3]);
          w0.z = cvtpk(ov[4] * rs * ng[4] * gvv[4], ov[5] * rs * ng[5] * gvv[5]); w0.w = cvtpk(ov[6] * rs * ng[6] * gvv[6], ov[7] * rs * ng[7] * gvv[7]);
          w1.x = cvtpk(ov[8] * rs * ng[8] * gvv[8], ov[9] * rs * ng[9] * gvv[9]); w1.y = cvtpk(ov[10] * rs * ng[10] * gvv[10], ov[11] * rs * ng[11] * gvv[11]);
          w1.z = cvtpk(ov[12] * rs * ng[12] * gvv[12], ov[13] * rs * ng[13] * gvv[13]); w1.w = cvtpk(ov[14] * rs * ng[14] * gvv[14], ov[15] * rs * ng[15] * gvv[15]);
          bf16* op = Ocat + (rb + (size_t)c * 64 + orow) * 1024 + h * 128 + 16 * oseg;
          *(u32x4*)op = w0; *(u32x4*)(op + 8) = w1; }
    }
    __syncthreads();
#undef HG_DMA
#undef HG_SCALE
#undef HG_SCLOAD
}

constexpr int AT_NST = 4, AT_K = 0, AT_V = AT_NST * 8192, AT_KM = 2 * AT_NST * 8192, AT_TAB = AT_KM + 1792;
DI int t5_bucket(int d) { if (d < 16) return d; const int v = 16 + (int)(logf((float)d * (1.f / 16.f)) / logf(8.f) * 16.f); return v < 31 ? v : 31; }
DI void glds16(const void* gsrc, unsigned lds_dst) { unsigned keep;
    asm volatile("s_mov_b32 %0, m0\n\ts_mov_b32 m0, %2\n\ts_nop 0\n\tglobal_load_lds_dwordx4 %1, off\n\ts_mov_b32 m0, %0" : "=&s"(keep) : "v"(gsrc), "s"(lds_dst) : "memory"); }
DI void attn_unit(const Ctx& C, const Args& a, int b, int h, int jq) {
    LAS unsigned char* L = C.lds;
    const int tid = C.tid, lane = C.lane, wid = C.wid, q32 = lane & 31, hi = lane >> 5;
    const bf16* Qm = (const bf16*)(C.ws + WS_QM); const bf16* Km = (const bf16*)(C.ws + WS_KM); const bf16* Vm = (const bf16*)(C.ws + WS_VM); const float* KM = (const float*)(C.ws + WS_KMEAN);
    bf16* Ocat = (bf16*)(C.ws + WS_XB);
    const int tq = jq * 256 + wid * 32 + q32;
    const size_t hb = (size_t)(b * 8 + h) * SEQ;
    bf16x8 qf[4];
#pragma unroll
    for (int ks = 0; ks < 4; ++ks) qf[ks] = *(const bf16x8*)(Qm + (hb + tq) * 64 + 16 * ks + 8 * hi);
    LAS float* kml = (LAS float*)(L + AT_KM); LAS float* tab = (LAS float*)(L + AT_TAB);
    if (tid < jq * 64) { const int n = tid >> 6, d = tid & 63; kml[tid] = KM[(size_t)((b * 8 + n) * 2 + 0) * 512 + h * 64 + d] + KM[(size_t)((b * 8 + n) * 2 + 1) * 512 + h * 64 + d]; }
    if (tid < 129) tab[tid] = (a.in[I_RELB][t5_bucket(tid) * 8 + h] - a.in[I_RELB][31 * 8 + h]) * LOG2E;
    const int drow = 8 * wid + (lane >> 3), dch = lane & 7;
    const bf16* ksrc = Km + (hb + drow) * 64 + 8 * (dch ^ ((drow >> 1) & 7));
    const bf16* vsrc = Vm + (hb + drow) * 64 + 8 * (dch ^ (((drow >> 1) & 1) << 2));
    const unsigned kdst = (unsigned)__builtin_amdgcn_readfirstlane((int)(unsigned)(size_t)(L + AT_K + wid * 1024)), vdst = (unsigned)__builtin_amdgcn_readfirstlane((int)(unsigned)(size_t)(L + AT_V + wid * 1024));
    const int nt = 4 * jq + 4;
#define AT_ISSUE(t) do { glds16(ksrc + (size_t)(t) * 4096, kdst + ((t) & 3) * 8192); glds16(vsrc + (size_t)(t) * 4096, vdst + ((t) & 3) * 8192); } while (0)
    AT_ISSUE(0); AT_ISSUE(1); AT_ISSUE(2);
    __syncthreads();
    unsigned sel = 0;
    {
        float g[7];
#pragma unroll
        for (int n = 0; n < 7; ++n) { g[n] = 0.f;
            if (n < jq) { float s = 0.f;
#pragma unroll
                for (int ks = 0; ks < 4; ++ks)
#pragma unroll
                    for (int j = 0; j < 8; ++j) s += bf2f((unsigned short)qf[ks][j]) * kml[n * 64 + 16 * ks + 8 * hi + j];
                s += __shfl_xor(s, 32); g[n] = s; } }
#pragma unroll
        for (int n = 0; n < 7; ++n) if (n < jq) { int rank = 0;
#pragma unroll
            for (int m = 0; m < 7; ++m) if (m != n && m < jq) rank += (g[m] > g[n] || (g[m] == g[n] && m < n)) ? 1 : 0;
            if (rank < 3) sel |= 1u << n; }
    }
    const float c31 = a.in[I_RELB][31 * 8 + h] * LOG2E;
    float lrun = 0.f;
    f32x16 negm;
#pragma unroll
    for (int r = 0; r < 16; ++r) negm[r] = c31;
    f32x16 o0, o1;
#pragma unroll
    for (int r = 0; r < 16; ++r) { o0[r] = 0.f; o1[r] = 0.f; }
    const int i16 = lane & 15, qq = i16 >> 2, pp = i16 & 3, dh = (lane >> 4) & 1, xsw = (qq >> 1) & 1;
    const int vb0 = (4 * hi + qq) * 128 + 64 * (0 ^ xsw) + 32 * dh + 8 * pp, vb1 = (4 * hi + qq) * 128 + 64 * (1 ^ xsw) + 32 * dh + 8 * pp;
    const int kxs = (q32 >> 1) & 7;
    for (int kt = 0; kt < nt; ++kt) {
        if (kt + 2 < nt) asm volatile("s_waitcnt vmcnt(4)" ::: "memory"); else if (kt + 1 < nt) asm volatile("s_waitcnt vmcnt(2)" ::: "memory"); else asm volatile("s_waitcnt vmcnt(0)" ::: "memory");
        __builtin_amdgcn_s_barrier();
        asm volatile("" ::: "memory");
        if (kt + 3 < nt) AT_ISSUE(kt + 3);
        const int blk = kt >> 2; const bool own = (blk == jq);
        const bool active = !own || ((kt & 3) * 64 <= wid * 32 + 31);
        if (active) {
            const LAS unsigned char* Kc = L + AT_K + (kt & 3) * 8192; const LAS unsigned char* Vc = L + AT_V + (kt & 3) * 8192;
            bf16x8 kf[8];
#pragma unroll
            for (int ks = 0; ks < 4; ++ks) { const int ko = (((2 * ks + hi) ^ kxs) << 4); kf[2 * ks] = *(const LAS bf16x8*)(Kc + q32 * 128 + ko); kf[2 * ks + 1] = *(const LAS bf16x8*)(Kc + (32 + q32) * 128 + ko); }
            __builtin_amdgcn_sched_barrier(0);
            f32x16 s0 = negm, s1 = negm;
#pragma unroll
            for (int ks = 0; ks < 4; ++ks) { s0 = MFMA32(kf[2 * ks], qf[ks], s0); s1 = MFMA32(kf[2 * ks + 1], qf[ks], s1); }
            __builtin_amdgcn_sched_barrier(0);
            s16x4 vf[2][4][2];
#pragma unroll
            for (int j = 0; j < 4; ++j) { const int ro = 16 * j * 128;
                vf[0][j][0] = vtr((LAS const char*)(Vc + vb0 + ro)); vf[0][j][1] = vtr((LAS const char*)(Vc + vb0 + ro + 8 * 128));
                vf[1][j][0] = vtr((LAS const char*)(Vc + vb1 + ro)); vf[1][j][1] = vtr((LAS const char*)(Vc + vb1 + ro + 8 * 128)); }
            __builtin_amdgcn_sched_barrier(0);
            const bool near = (jq * 256 + wid * 32 - 64 * kt - 63) < 128;
            if (near) {
                const int dist0 = tq - 64 * kt - 4 * hi;
#pragma unroll
                for (int r = 0; r < 16; ++r) { const int d0 = dist0 - ((r & 3) + 8 * (r >> 2)), d1 = d0 - 32;
                    const int i0 = d0 < 0 ? 0 : (d0 > 128 ? 128 : d0), i1 = d1 < 0 ? 0 : (d1 > 128 ? 128 : d1);
                    const float t0 = tab[i0], t1 = tab[i1]; s0[r] += t0; s1[r] += t1; s0[r] = d0 < 0 ? -INFINITY : s0[r]; s1[r] = d1 < 0 ? -INFINITY : s1[r]; }
            }
            const bool lsel = own || ((sel >> blk) & 1u);
            float mx = fmaxf(fmaxf(s0[0], s1[0]), fmaxf(s0[1], s1[1]));
#pragma unroll
            for (int r = 2; r < 16; r += 2) mx = fmaxf(mx, fmaxf(fmaxf(s0[r], s1[r]), fmaxf(s0[r + 1], s1[r + 1])));
            mx = lsel ? mx : -INFINITY;
            mx = fmaxf(mx, __shfl_xor(mx, 32));
            if (__any(mx > 4.0f)) {
                const float delta = fmaxf(mx, 0.f), alpha = __builtin_amdgcn_exp2f(-delta);
                lrun *= alpha;
#pragma unroll
                for (int r = 0; r < 16; ++r) { o0[r] *= alpha; o1[r] *= alpha; negm[r] -= delta; s0[r] -= delta; s1[r] -= delta; }
            }
            float ps = 0.f;
#pragma unroll
            for (int r = 0; r < 16; ++r) { s0[r] = __builtin_amdgcn_exp2f(s0[r]); s1[r] = __builtin_amdgcn_exp2f(s1[r]); ps += s0[r] + s1[r]; }
            lrun += lsel ? ps : 0.f;
            const unsigned pmask = lsel ? 0xffffffffu : 0u;
#pragma unroll
            for (int kb = 0; kb < 2; ++kb)
#pragma unroll
                for (int s2 = 0; s2 < 2; ++s2) {
                    u32x4 pw;
                    if (kb == 0) { pw.x = cvtpk(s0[8 * s2 + 0], s0[8 * s2 + 1]); pw.y = cvtpk(s0[8 * s2 + 2], s0[8 * s2 + 3]); pw.z = cvtpk(s0[8 * s2 + 4], s0[8 * s2 + 5]); pw.w = cvtpk(s0[8 * s2 + 6], s0[8 * s2 + 7]); }
                    else         { pw.x = cvtpk(s1[8 * s2 + 0], s1[8 * s2 + 1]); pw.y = cvtpk(s1[8 * s2 + 2], s1[8 * s2 + 3]); pw.z = cvtpk(s1[8 * s2 + 4], s1[8 * s2 + 5]); pw.w = cvtpk(s1[8 * s2 + 6], s1[8 * s2 + 7]); }
                    pw.x &= pmask; pw.y &= pmask; pw.z &= pmask; pw.w &= pmask;
                    const bf16x8 pf = __builtin_bit_cast(bf16x8, pw);
                    const s16x4 a0l = vf[0][2 * kb + s2][0], a0h = vf[0][2 * kb + s2][1], a1l = vf[1][2 * kb + s2][0], a1h = vf[1][2 * kb + s2][1];
                    o0 = MFMA32(((bf16x8){a0l[0], a0l[1], a0l[2], a0l[3], a0h[0], a0h[1], a0h[2], a0h[3]}), pf, o0);
                    o1 = MFMA32(((bf16x8){a1l[0], a1l[1], a1l[2], a1l[3], a1h[0], a1h[1], a1h[2], a1h[3]}), pf, o1);
                }
        }
    }
    const float linv = 1.f / (lrun + __shfl_xor(lrun, 32));
    bf16* op = Ocat + ((size_t)b * SEQ + tq) * 1024 + 512 + h * 64;
#pragma unroll
    for (int g = 0; g < 4; ++g) { u32x2 w0, w1; w0.x = cvtpk(o0[4 * g] * linv, o0[4 * g + 1] * linv); w0.y = cvtpk(o0[4 * g + 2] * linv, o0[4 * g + 3] * linv);
        w1.x = cvtpk(o1[4 * g] * linv, o1[4 * g + 1] * linv); w1.y = cvtpk(o1[4 * g + 2] * linv, o1[4 * g + 3] * linv);
        *(u32x2*)(op + 8 * g + 4 * hi) = w0; *(u32x2*)(op + 32 + 8 * g + 4 * hi) = w1; }
    __syncthreads();
#undef AT_ISSUE
}

#ifndef PROBE_HGX
#define PROBE_HGX 1
#endif
#ifndef PROBE_ATX
#define PROBE_ATX 1
#endif
#ifndef STAMP_SEL
#define STAMP_SEL -1
#endif
#define STAMP(i) do { if (STAMP_SEL >= 0 && blockIdx.x == 0 && C.tid == 0) { const unsigned long long t_ = __builtin_amdgcn_s_memrealtime(); C.MISC[16 + 2 * (i)] = (unsigned)t_; C.MISC[17 + 2 * (i)] = (unsigned)(t_ >> 32); } } while (0)
DI void p2_mixers(const Ctx& C, const Args& a, int rep) {
    for (int hx = 0; hx < PROBE_HGX; ++hx)
    for (int u = blockIdx.x; u < 64; u += C.G) hgrn_unit(C, a, u >> 2, u & 3);
    STAMP(11);
    unsigned* QA = (unsigned*)(C.ctl + CW_QUEUE + 64 * rep); unsigned* QC = (unsigned*)(C.ctl + CW_QUEUE2 + 64 * rep);
    constexpr int NA = 1024 * PROBE_ATX, NC = MOE_CVT_TILES;
    if (C.tid == 0) { C.MISC[0] = __hip_atomic_fetch_add(QA, 1u, __ATOMIC_RELAXED, __HIP_MEMORY_SCOPE_AGENT); C.MISC[1] = (rep == 0) ? __hip_atomic_fetch_add(QC, 1u, __ATOMIC_RELAXED, __HIP_MEMORY_SCOPE_AGENT) : (unsigned)NC; }
    __syncthreads();
    int qa = (int)C.MISC[0], qc = (int)C.MISC[1];
    __syncthreads();
    for (;;) {
        const bool doa = qa < NA, doc = qc < NC;
        if (!doa && !doc) break;
        unsigned na = (unsigned)NA, nc = (unsigned)NC;
        if (C.tid == 0) { if (doa) na = __hip_atomic_fetch_add(QA, 1u, __ATOMIC_RELAXED, __HIP_MEMORY_SCOPE_AGENT); if (doc) nc = __hip_atomic_fetch_add(QC, 1u, __ATOMIC_RELAXED, __HIP_MEMORY_SCOPE_AGENT); }
#ifdef STAMP_ACC
        unsigned long long ta_ = 0, tb_ = 0, tc_ = 0; if (C.tid == 0) ta_ = __builtin_amdgcn_s_memrealtime();
#endif
        if (doa) { const int q = qa / PROBE_ATX; attn_unit(C, a, (q & 127) >> 3, q & 7, 7 - (q >> 7)); }
#ifdef STAMP_ACC
        if (C.tid == 0) tb_ = __builtin_amdgcn_s_memrealtime();
#endif
        if (doc) moe_cvt_tile(C, a, qc);
#ifdef STAMP_ACC
        if (C.tid == 0 && blockIdx.x == 100) { tc_ = __builtin_amdgcn_s_memrealtime(); const unsigned long long d_ = (STAMP_ACC == 0) ? (tb_ - ta_) : (tc_ - tb_);
            const unsigned long long o_ = ((unsigned long long)C.MISC[45] << 32) | C.MISC[44]; const unsigned long long n_ = o_ + d_; C.MISC[44] = (unsigned)n_; C.MISC[45] = (unsigned)(n_ >> 32); }
#endif
        if (C.tid == 0) { C.MISC[0] = na; C.MISC[1] = nc; }
        __syncthreads();
        qa = (int)C.MISC[0]; qc = (int)C.MISC[1];
        __syncthreads();
    }
    STAMP(12);
#ifdef STAMP_ACC
    if (C.tid == 0 && blockIdx.x == 100) { const unsigned long long n_ = ((unsigned long long)C.MISC[45] << 32) | C.MISC[44]; const unsigned long long w0 = __builtin_amdgcn_s_memrealtime(); while (__builtin_amdgcn_s_memrealtime() - w0 < 4ull * n_) __builtin_amdgcn_s_sleep(8); }
#endif
}

DI void r1_phase(const Ctx& C, const Args& a) {
    LAS unsigned char* L = C.lds;
    const int tid = C.tid, lane = C.lane, wid = C.wid;
    LAS float* LG = (LAS float*)L + wid * 16 * 48;
    LAS int* CNT = (LAS int*)(L + 32768);
    LAS float* G1 = (LAS float*)(L + 33024); LAS float* B1 = (LAS float*)(L + 37120);
    const float* Pre = (const float*)(C.ws + WS_ZF); bf16* X1b = (bf16*)(C.ws + WS_XB); f32x2* stats = (f32x2*)(C.ws + WS_STATS);
    const bf16* WrH = (const bf16*)(C.ws + WS_WRH); const bf16* WrL = (const bf16*)(C.ws + WS_WRL);
    unsigned* tokE = (unsigned*)(C.ws + WS_TOKE); float* tokW = (float*)(C.ws + WS_TOKW); int* wgcnt = (int*)(C.ws + WS_WGCNT);
    for (int i = tid; i < 1024; i += NTHREADS) { G1[i] = a.in[I_LN1G][i]; B1[i] = a.in[I_LN1B][i]; }
    const int m16 = lane & 15, kq = lane >> 4;
    for (int chunk = blockIdx.x; chunk < NTOK / 128; chunk += C.G) {
        if (tid < 32) CNT[tid] = 0;
        __syncthreads();
        const int tok0 = chunk * 128 + wid * 16;
        const float* xrow = Pre + (size_t)(tok0 + m16) * 1024 + 8 * kq;
        float s = 0.f, s2 = 0.f;
#pragma unroll 8
        for (int k0 = 0; k0 < 1024; k0 += 32) { const f32x4 xa = *(const f32x4*)(xrow + k0), xc = *(const f32x4*)(xrow + k0 + 4);
            s += (xa[0] + xa[1]) + (xa[2] + xa[3]) + (xc[0] + xc[1]) + (xc[2] + xc[3]);
            s2 += (xa[0] * xa[0] + xa[1] * xa[1]) + (xa[2] * xa[2] + xa[3] * xa[3]) + (xc[0] * xc[0] + xc[1] * xc[1]) + (xc[2] * xc[2] + xc[3] * xc[3]); }
        s += __shfl_xor(s, 16); s += __shfl_xor(s, 32); s2 += __shfl_xor(s2, 16); s2 += __shfl_xor(s2, 32);
        const float mean = s * (1.f / 1024.f); const float var = fmaxf(s2 * (1.f / 1024.f) - mean * mean, 0.f); const float rstd = 1.f / sqrtf(var + LN_EPS);
        if (kq == 0) stats[tok0 + m16] = (f32x2){mean, rstd};
        f32x4 acc[3];
#pragma unroll
        for (int nb = 0; nb < 3; ++nb) acc[nb] = (f32x4){0.f, 0.f, 0.f, 0.f};
        bf16* xb = X1b + (size_t)(tok0 + m16) * 1024 + 8 * kq;
#pragma unroll 2
        for (int k0 = 0; k0 < 1024; k0 += 32) {
            f32x4 xa = *(const f32x4*)(xrow + k0), xc = *(const f32x4*)(xrow + k0 + 4);
            xa = (xa - mean) * rstd * *(const LAS f32x4*)(G1 + k0 + 8 * kq) + *(const LAS f32x4*)(B1 + k0 + 8 * kq);
            xc = (xc - mean) * rstd * *(const LAS f32x4*)(G1 + k0 + 8 * kq + 4) + *(const LAS f32x4*)(B1 + k0 + 8 * kq + 4);
            u32x4 hw; hw.x = cvtpk(xa[0], xa[1]); hw.y = cvtpk(xa[2], xa[3]); hw.z = cvtpk(xc[0], xc[1]); hw.w = cvtpk(xc[2], xc[3]);
            *(u32x4*)(xb + k0) = hw;
            u32x4 lw; lw.x = cvtpk(xa[0] - bflo(hw.x), xa[1] - bfhi(hw.x)); lw.y = cvtpk(xa[2] - bflo(hw.y), xa[3] - bfhi(hw.y)); lw.z = cvtpk(xc[0] - bflo(hw.z), xc[1] - bfhi(hw.z)); lw.w = cvtpk(xc[2] - bflo(hw.w), xc[3] - bfhi(hw.w));
            const bf16x8 xh = __builtin_bit_cast(bf16x8, hw), xl = __builtin_bit_cast(bf16x8, lw);
#pragma unroll
            for (int nb = 0; nb < 3; ++nb) { const size_t wo = (size_t)(nb * 16 + m16) * 1024 + k0 + 8 * kq;
                const bf16x8 wh = *(const bf16x8*)(WrH + wo), wl = *(const bf16x8*)(WrL + wo);
                acc[nb] = MFMA16(wh, xh, acc[nb]); acc[nb] = MFMA16(wl, xh, acc[nb]); acc[nb] = MFMA16(wh, xl, acc[nb]); }
        }
#pragma unroll
        for (int nb = 0; nb < 3; ++nb)
#pragma unroll
            for (int r = 0; r < 4; ++r) LG[m16 * 48 + nb * 16 + 4 * kq + r] = acc[nb][r];
        asm volatile("s_waitcnt lgkmcnt(0)" ::: "memory");
        if (lane < 16) {
            const LAS float* lg = LG + lane * 48;
            float gl[4];
#pragma unroll
            for (int j = 0; j < 4; ++j) gl[j] = lg[j] + a.in[I_BGRP][j];
            int grp = 0; float gm = gl[0];
#pragma unroll
            for (int j = 1; j < 4; ++j) if (gl[j] > gm) { gm = gl[j]; grp = j; }
            float se = 0.f;
#pragma unroll
            for (int j = 0; j < 4; ++j) se += expf(gl[j] - gm);
            const float pg = 1.f / se;
            float el[8];
#pragma unroll
            for (int j = 0; j < 8; ++j) el[j] = lg[4 + grp * 8 + j] + a.in[I_BEXP][grp * 8 + j];
            int i0 = 0; float v0 = el[0];
#pragma unroll
            for (int j = 1; j < 8; ++j) if (el[j] > v0) { v0 = el[j]; i0 = j; }
            int i1 = -1; float v1 = -INFINITY;
#pragma unroll
            for (int j = 0; j < 8; ++j) if (j != i0 && el[j] > v1) { v1 = el[j]; i1 = j; }
            const float w0 = 1.f / (1.f + expf(v1 - v0)), w1 = 1.f - w0;
            const int e0 = grp * 8 + i0, e1 = grp * 8 + i1;
            const int r0 = __hip_atomic_fetch_add(CNT + e0, 1, __ATOMIC_RELAXED, __HIP_MEMORY_SCOPE_WORKGROUP), r1 = __hip_atomic_fetch_add(CNT + e1, 1, __ATOMIC_RELAXED, __HIP_MEMORY_SCOPE_WORKGROUP);
            const int tok = tok0 + lane;
            tokE[tok] = (unsigned)e0 | ((unsigned)e1 << 8) | ((unsigned)r0 << 16) | ((unsigned)r1 << 24);
            tokW[tok * 2] = w0 * pg; tokW[tok * 2 + 1] = w1 * pg;
        }
        __syncthreads();
        if (tid < 32) wgcnt[chunk * 32 + tid] = CNT[tid];
        __syncthreads();
    }
}

DI void r2_phase(const Ctx& C, const Args& a) {
    LAS int* PA = (LAS int*)C.lds;
    LAS int* PB = PA + 512;
    LAS int* TOT = PB + 512; LAS int* BASE = TOT + 32; LAS int* PST = BASE + 32;
    const int tid = C.tid;
    const int* wgcnt = (const int*)(C.ws + WS_WGCNT); const unsigned* tokE = (const unsigned*)(C.ws + WS_TOKE);
    int* tokD = (int*)(C.ws + WS_TOKD); int* rowtok = (int*)(C.ws + WS_ROWTOK); int* tilee = (int*)(C.ws + WS_TILEE);
    for (int chunk = blockIdx.x; chunk < NTOK / 128; chunk += C.G) {
        { const int e = tid & 31, part = tid >> 5; int sa = 0, sb = 0;
          for (int c = part * 16; c < part * 16 + 16; ++c) { const int v = wgcnt[c * 32 + e]; sa += v; sb += (c < chunk) ? v : 0; }
          PA[part * 32 + e] = sa; PB[part * 32 + e] = sb; }
        __syncthreads();
        if (tid < 32) { int sa = 0, sb = 0; for (int p = 0; p < 16; ++p) { sa += PA[p * 32 + tid]; sb += PB[p * 32 + tid]; } TOT[tid] = sa; BASE[tid] = sb; }
        __syncthreads();
        if (tid == 0) { int ps = 0; for (int e = 0; e < 32; ++e) { PST[e] = ps; ps += ((TOT[e] + 255) >> 8) << 8; } PST[32] = ps; }
        __syncthreads();
        if (tid < 128) { const int tok = chunk * 128 + tid; const unsigned w = tokE[tok]; const int e0 = w & 31, e1 = (w >> 8) & 31, r0 = (w >> 16) & 255, r1 = (w >> 24) & 255;
            const int d0 = PST[e0] + BASE[e0] + r0, d1 = PST[e1] + BASE[e1] + r1; rowtok[d0] = tok; rowtok[d1] = tok; tokD[tok * 2] = d0; tokD[tok * 2 + 1] = d1; }
        if (chunk < 32) { const int e = chunk, end = PST[e + 1] - PST[e]; for (int i = TOT[e] + tid; i < end; i += NTHREADS) rowtok[PST[e] + i] = 0; }
        if (chunk == 0) { if (tid < 32) { for (int t = PST[tid] >> 8; t < (PST[tid + 1] >> 8); ++t) tilee[t] = tid; } if (tid == 0) tilee[511] = PST[32] >> 8; }
        __syncthreads();
    }
}

DI void f_phase(const Ctx& C, const Args& a) {
    const int lane = C.lane, gw = C.vcu * NWAVES + C.wid, NGW = C.G * NWAVES;
    const float* Pre = (const float*)(C.ws + WS_ZF); const bf16* Y = (const bf16*)(C.ws + WS_Y); const int* tokD = (const int*)(C.ws + WS_TOKD); const float* tokW = (const float*)(C.ws + WS_TOKW);
    const f32x2* stats = (const f32x2*)(C.ws + WS_STATS);
    f32x4 g2[4], b2[4], g1[4], b1[4];
#pragma unroll
    for (int j = 0; j < 4; ++j) { g2[j] = *(const f32x4*)(a.in[I_LN2G] + 256 * j + 4 * lane); b2[j] = *(const f32x4*)(a.in[I_LN2B] + 256 * j + 4 * lane);
        g1[j] = *(const f32x4*)(a.in[I_LN1G] + 256 * j + 4 * lane) * DN_ALPHA; b1[j] = *(const f32x4*)(a.in[I_LN1B] + 256 * j + 4 * lane) * DN_ALPHA; }
    for (int tok = gw; tok < NTOK; tok += NGW) {
        const int d0 = tokD[tok * 2], d1 = tokD[tok * 2 + 1]; const float w0 = tokW[tok * 2], w1 = tokW[tok * 2 + 1]; const f32x2 st = stats[tok];
        const float* xr = Pre + (size_t)tok * 1024 + 4 * lane; const bf16* y0 = Y + (size_t)d0 * 1024 + 4 * lane; const bf16* y1 = Y + (size_t)d1 * 1024 + 4 * lane;
        f32x4 v[4]; float s = 0.f;
#pragma unroll
        for (int j = 0; j < 4; ++j) { const f32x4 x = *(const f32x4*)(xr + 256 * j); const u32x2 p0 = *(const u32x2*)(y0 + 256 * j), p1 = *(const u32x2*)(y1 + 256 * j);
            v[j] = ((x - st.x) * st.y) * g1[j] + b1[j] + (f32x4){bflo(p0.x), bfhi(p0.x), bflo(p0.y), bfhi(p0.y)} * w0 + (f32x4){bflo(p1.x), bfhi(p1.x), bflo(p1.y), bfhi(p1.y)} * w1;
            s += (v[j][0] + v[j][1]) + (v[j][2] + v[j][3]); }
        const float mean = wave_sum(s) * (1.f / 1024.f); float s2 = 0.f;
#pragma unroll
        for (int j = 0; j < 4; ++j) { v[j] = v[j] - mean; s2 += (v[j][0] * v[j][0] + v[j][1] * v[j][1]) + (v[j][2] * v[j][2] + v[j][3] * v[j][3]); }
        const float rstd = 1.f / sqrtf(wave_sum(s2) * (1.f / 1024.f) + LN_EPS);
        float* orow = a.out + (size_t)tok * 1024 + 4 * lane;
#pragma unroll
        for (int j = 0; j < 4; ++j) *(f32x4*)(orow + 256 * j) = v[j] * rstd * g2[j] + b2[j];
    }
}

constexpr int NPH = 10;
__global__ void __launch_bounds__(NTHREADS, 2) mk_fwd(Args args) {
    extern __shared__ __attribute__((aligned(16))) unsigned char lds_raw[];
    Ctx C;
    C.lds = (LAS unsigned char*)lds_raw; C.MISC = (volatile LAS unsigned*)(C.lds + MISC_OFF);
    C.tid = threadIdx.x; C.lane = C.tid & 63; C.wid = __builtin_amdgcn_readfirstlane(C.tid >> 6);
    C.G = gridDim.x; { const int bx = blockIdx.x; C.vcu = (C.G % 8 == 0) ? (bx % 8) * (C.G / 8) + bx / 8 : bx; }
    C.ws = args.ws; C.ctl = (gu32*)(args.ws + WS_CTL);
    if (C.tid < 64) C.MISC[C.tid] = 0u;
    __syncthreads();
    XcdBarrier bar; bar.bar = (unsigned*)(C.ctl + CW_BAR); bar.x = 0; bar.st = nullptr;
    if (MK_N_LAUNCHES == 1) bar = xcd_barrier_post((unsigned*)(C.ctl + CW_BAR), C.MISC + 8);
    const int lo = args.ph_lo, hi = args.ph_hi;
#ifndef PH_MASK
#define PH_MASK 0x3ff
#endif
#define IN(k) (((PH_MASK >> (k)) & 1) && lo <= (k) && (k) < hi)
#ifndef STAMP_SEL
#define STAMP_SEL -1
#endif
#ifndef STAMP_T0
#define STAMP_T0 STAMP_SEL
#define STAMP_T1 (STAMP_SEL + 1)
#endif
#define SEAM(k) do { if (IN(k) && IN((k) + 1)) xcd_barrier(bar); STAMP((k) + 1); } while (0)
#ifndef PROBE_PHASE
#define PROBE_PHASE -1
#endif
#define REPS(k) ((PROBE_PHASE == (k)) ? 2 : 1)
#define REPSEAM(k) do { if (rep + 1 < REPS(k)) xcd_barrier(bar); } while (0)
    unsigned char* ws = args.ws;
    LAS unsigned char* ring = C.lds;

    STAMP(0);
    if (IN(0)) { _Pragma("unroll") for (int rep = 0; rep < REPS(0); ++rep) { p0_prologue(C, args); REPSEAM(0); } } SEAM(0);

    if (IN(1)) _Pragma("unroll") for (int rep = 0; rep < REPS(1); ++rep) {
        pg8::DenseOrder S; S.init(ws + WS_XB, ws + WS_WIN, NTOK, NIN, 1024, C.G, (int)blockIdx.x);
        pg8::EpiIn E{(bf16*)(ws + WS_QH), (bf16*)(ws + WS_VH), (bf16*)(ws + WS_GH), (bf16*)(ws + WS_QM), (bf16*)(ws + WS_KM), (bf16*)(ws + WS_VM), (bf16*)(ws + WS_R), (bf16*)(ws + WS_GB),
                     (float*)(ws + WS_ZF), (float*)(ws + WS_KMEAN), (const float*)(ws + WS_BPERM), (bf16*)(ws + WS_KK), (const float*)(ws + WS_LB)};
        pg8::gemm_phase<pg8::EpiIn, pg8::DenseOrder, false>(ring, 1024, S, E); REPSEAM(1);
    } SEAM(1);

#ifndef PROBE_P2X
#define PROBE_P2X 1
#endif
    if (IN(2)) { for (int rep = 0; rep < PROBE_P2X; ++rep) { p2_mixers(C, args, rep); if (rep + 1 < PROBE_P2X) xcd_barrier(bar); } } SEAM(2);

    if (IN(3)) _Pragma("unroll") for (int rep = 0; rep < REPS(3); ++rep) {
        pg8::DenseOrder S; S.init(ws + WS_XB, ws + WS_WCAT, NTOK, 1024, 1024, C.G, (int)blockIdx.x);
        pg8::EpiProj E{(const bf16*)(ws + WS_R), (const bf16*)(ws + WS_GB), (bf16*)(ws + WS_QH)};
        pg8::gemm_phase<pg8::EpiProj, pg8::DenseOrder, false>(ring, 1024, S, E); REPSEAM(3);
    } SEAM(3);

    if (IN(4)) _Pragma("unroll") for (int rep = 0; rep < REPS(4); ++rep) {
        pg8::DenseOrder S; S.init(ws + WS_QH, ws + WS_WO, NTOK, 1024, 1024, C.G, (int)blockIdx.x);
        pg8::EpiOut E{args.in[I_X], (float*)(ws + WS_ZF)};
        pg8::gemm_phase<pg8::EpiOut, pg8::DenseOrder, false>(ring, 1024, S, E);
        REPSEAM(4);
    } SEAM(4);

    if (IN(5)) { _Pragma("unroll") for (int rep = 0; rep < REPS(5); ++rep) { r1_phase(C, args); REPSEAM(5); } } SEAM(5);
    if (IN(6)) { _Pragma("unroll") for (int rep = 0; rep < REPS(6); ++rep) { r2_phase(C, args); REPSEAM(6); } } SEAM(6);

    if (IN(7)) _Pragma("unroll") for (int rep = 0; rep < REPS(7); ++rep) {
        const int* tilee = (const int*)(ws + WS_TILEE);
        const int ntl = __builtin_amdgcn_readfirstlane(__hip_atomic_load(tilee + 511, __ATOMIC_RELAXED, __HIP_MEMORY_SCOPE_AGENT));
        pg8::MoeOrder S{(const char*)(ws + WS_XB), (const char*)args.out, (const int*)(ws + WS_ROWTOK), tilee, 1024, 1024, ntl * 4, C.G, C.vcu, true};
        pg8::EpiM1 E{(bf16*)(ws + WS_QH)};
        pg8::gemm_phase<pg8::EpiM1, pg8::MoeOrder, true>(ring, 1024, S, E); REPSEAM(7);
    } SEAM(7);

    if (IN(8)) _Pragma("unroll") for (int rep = 0; rep < REPS(8); ++rep) {
        const int* tilee = (const int*)(ws + WS_TILEE);
        const int ntl = __builtin_amdgcn_readfirstlane(__hip_atomic_load(tilee + 511, __ATOMIC_RELAXED, __HIP_MEMORY_SCOPE_AGENT));
        pg8::MoeOrder S{(const char*)(ws + WS_QH), (const char*)args.out + 64 * MiB, (const int*)(ws + WS_ROWTOK), tilee, 512, 1024, ntl * 4, C.G, C.vcu, false};
        pg8::EpiM2 E{(bf16*)(ws + WS_Y)};
        pg8::gemm_phase<pg8::EpiM2, pg8::MoeOrder, false>(ring, 512, S, E); REPSEAM(8);
    } SEAM(8);

    if (IN(9)) { _Pragma("unroll") for (int rep = 0; rep < REPS(9); ++rep) { f_phase(C, args); REPSEAM(9); } }
    STAMP(10);
    if (STAMP_SEL >= 0 && blockIdx.x == 0 && C.tid == 0) {
        const unsigned long long t0 = ((unsigned long long)C.MISC[17 + 2 * (STAMP_T0)] << 32) | C.MISC[16 + 2 * (STAMP_T0)], t1 = ((unsigned long long)C.MISC[17 + 2 * (STAMP_T1)] << 32) | C.MISC[16 + 2 * (STAMP_T1)];
        const unsigned long long w0 = __builtin_amdgcn_s_memrealtime(); while (__builtin_amdgcn_s_memrealtime() - w0 < 4ull * (t1 - t0)) __builtin_amdgcn_s_sleep(8); }
#undef IN
#undef SEAM
}

extern "C" void kernel_launch(void* const* d_in, const int* in_sizes, int n_in, void* d_out, int out_size, void* d_ws, size_t ws_size, hipStream_t stream) {
    static int grid = 0;
    if (grid == 0) {
        if (n_in != 19 || in_sizes[0] != NTOK * DM || out_size != NTOK * DM || ws_size < WS_END) { fprintf(stderr, "kernel_launch: unexpected problem shape / workspace; nothing launched\n"); grid = -1; return; }
        int dev = 0, cus = 0, per_cu = 0;
        if (hipGetDevice(&dev) != hipSuccess || hipDeviceGetAttribute(&cus, hipDeviceAttributeMultiprocessorCount, dev) != hipSuccess) { grid = -1; return; }
        if (hipFuncSetAttribute((const void*)mk_fwd, hipFuncAttributeMaxDynamicSharedMemorySize, LDS_BYTES) != hipSuccess) { fprintf(stderr, "kernel_launch: hipFuncSetAttribute failed\n"); grid = -1; return; }
        if (hipOccupancyMaxActiveBlocksPerMultiprocessor(&per_cu, (const void*)mk_fwd, NTHREADS, LDS_BYTES) != hipSuccess || per_cu < 1) { fprintf(stderr, "kernel_launch: occupancy query says %d\n", per_cu); }
        (void)hipGetLastError();
        grid = cus;
    }
    if (grid < 0) return;
    (void)hipMemsetAsync((char*)d_ws + WS_CTL, 0, CTL_ZERO_BYTES, stream);
    Args a{};
    for (int i = 0; i < 19; ++i) a.in[i] = (const float*)d_in[i];
    a.out = (float*)d_out; a.ws = (unsigned char*)d_ws;
    if (MK_N_LAUNCHES == 1) { a.ph_lo = 0; a.ph_hi = NPH; hipLaunchKernelGGL(mk_fwd, dim3(grid), dim3(NTHREADS), LDS_BYTES, stream, a); }
    else for (int p = 0; p < NPH; ++p) { a.ph_lo = p; a.ph_hi = p + 1; hipLaunchKernelGGL(mk_fwd, dim3(grid), dim3(NTHREADS), LDS_BYTES, stream, a); }
}
```

```cpp
#include <hip/hip_runtime.h>
#include <cstdio>
#include <cstdint>
#ifndef MK_N_LAUNCHES
#define MK_N_LAUNCHES 1
#endif
#define DI __device__ __forceinline__
#define GAS __attribute__((address_space(1)))
#define LAS __attribute__((address_space(3)))
typedef unsigned short bf16;
typedef unsigned u32x4 __attribute__((ext_vector_type(4)));
typedef unsigned u32x2 __attribute__((ext_vector_type(2)));
typedef float f32x4 __attribute__((ext_vector_type(4)));
typedef float f32x2 __attribute__((ext_vector_type(2)));
typedef float f32x16 __attribute__((ext_vector_type(16)));
typedef short bf16x8 __attribute__((ext_vector_type(8)));
typedef short s16x4 __attribute__((ext_vector_type(4)));
typedef short v4i16_t __attribute__((ext_vector_type(4)));
typedef __bf16 bf16x2_t __attribute__((ext_vector_type(2)));
typedef GAS unsigned gu32;

constexpr int NTOK = 32768, DM = 1024, SEQ = 2048, NBATCH = 16, NIN = 5632;
constexpr int NWAVES = 8, NTHREADS = 512;
constexpr float LN_EPS = 1e-5f, DN_ALPHA = 1.189207115002721f, LOG2E = 1.4426950408889634f;
constexpr int MOE_MAXTILES = 288;

constexpr size_t MiB = 1u << 20;
constexpr size_t WS_CTL = 0, CTL_ZERO_BYTES = 65536;
constexpr size_t WS_WIN = 1 * MiB, WS_WCAT = 12 * MiB, WS_WO = 14 * MiB;
constexpr size_t WS_XB = 16 * MiB;
constexpr size_t WS_R = 80 * MiB;
constexpr size_t WS_GB = 144 * MiB;
constexpr size_t WS_QH = 208 * MiB;
constexpr size_t WS_VH = 240 * MiB;
constexpr size_t WS_GH = 272 * MiB;
constexpr size_t WS_ZF = 304 * MiB;
constexpr size_t WS_QM = 368 * MiB, WS_KM = 400 * MiB;
constexpr size_t WS_VM = 432 * MiB;
constexpr size_t WS_Y = 16 * MiB;
constexpr size_t WS_MISC = 464 * MiB;
constexpr size_t WS_KMEAN = WS_MISC;
constexpr size_t WS_BPERM = WS_MISC + 1 * MiB;
constexpr size_t WS_WRH = WS_MISC + 2 * MiB;
constexpr size_t WS_WRL = WS_WRH + 98304;
constexpr size_t WS_TOKE = WS_MISC + 3 * MiB;
constexpr size_t WS_TOKW = WS_MISC + 4 * MiB;
constexpr size_t WS_TOKD = WS_MISC + 5 * MiB;
constexpr size_t WS_WGCNT = WS_MISC + 6 * MiB;
constexpr size_t WS_ROWTOK = WS_MISC + 7 * MiB;
constexpr size_t WS_TILEE = WS_MISC + 8 * MiB;
constexpr size_t WS_STATS = WS_MISC + 9 * MiB;
constexpr size_t WS_LB = WS_MISC + 10 * MiB;
constexpr size_t WS_KK = WS_MISC + 12 * MiB;
constexpr size_t WS_END = 512 * MiB;
constexpr int CW_BAR = 4096, CW_QUEUE = 8192, CW_QUEUE2 = 8192 + 1024;

constexpr int LDS_BYTES = 163840, MISC_OFF = LDS_BYTES - 256;

DI unsigned cvtpk(float lo, float hi) { f32x2 v = {lo, hi}; bf16x2_t b = __builtin_convertvector(v, bf16x2_t); return __builtin_bit_cast(unsigned, b); }
DI float bflo(unsigned w) { return __uint_as_float(w << 16); }
DI float bfhi(unsigned w) { return __uint_as_float(w & 0xffff0000u); }
DI float bf2f(unsigned short h) { return __uint_as_float((unsigned)h << 16); }
DI float frcp(float x) { return __builtin_amdgcn_rcpf(x); }
DI float fsigmoid(float x) { return frcp(1.f + __expf(-x)); }
DI float wave_sum(float v) {
#pragma unroll
    for (int o = 1; o < 64; o <<= 1) v += __shfl_xor(v, o);
    return v;
}
typedef int v8i __attribute__((ext_vector_type(8)));
typedef int v4i __attribute__((ext_vector_type(4)));
DI unsigned cvt4_fp8(float a, float b, float c, float d) { a = __builtin_amdgcn_fmed3f(a, -448.f, 448.f); b = __builtin_amdgcn_fmed3f(b, -448.f, 448.f); c = __builtin_amdgcn_fmed3f(c, -448.f, 448.f); d = __builtin_amdgcn_fmed3f(d, -448.f, 448.f);
    int w = 0; w = __builtin_amdgcn_cvt_pk_fp8_f32(a, b, w, false); w = __builtin_amdgcn_cvt_pk_fp8_f32(c, d, w, true); return (unsigned)w; }
constexpr float FP8_SX = 8.f, FP8_SW = 32.f, FP8_SH = 4.f;
DI int crow(int r, int hi) { return (r & 3) + 8 * (r >> 2) + 4 * hi; }
#define MFMA32(a, b, c) __builtin_amdgcn_mfma_f32_32x32x16_bf16((a), (b), (c), 0, 0, 0)
#define MFMA16(a, b, c) __builtin_amdgcn_mfma_f32_16x16x32_bf16((a), (b), (c), 0, 0, 0)
DI s16x4 vtr(LAS const char* p) { return __builtin_bit_cast(s16x4, __builtin_amdgcn_ds_read_tr16_b64_v4i16((LAS v4i16_t*)p)); }

#define XB_TMO      128
#define XB_XCNT(j)  (256  + 64 * (j))
#define XB_XSUB(j)  (1280 + 64 * (j))
#define XB_XGEN(j)  (2304 + 64 * (j))
#define XB_TOP      3328
#define XB_TOPGEN   3392
#define XCD_BAR_WORDS 3456
#define XB_SPIN_CAP (1u << 22)
DI unsigned xb_ld(unsigned* p)              { return __hip_atomic_load(p, __ATOMIC_RELAXED, __HIP_MEMORY_SCOPE_AGENT); }
DI unsigned xb_add(unsigned* p, unsigned v) { return __hip_atomic_fetch_add(p, v, __ATOMIC_RELAXED, __HIP_MEMORY_SCOPE_AGENT); }
DI unsigned xb_xcc_id() { return (unsigned)__builtin_amdgcn_s_getreg((3 << 11) | 20) & 0xFu; }
#define XB_SPIN(cond, bar) do { unsigned _sp = 0; while (cond) { __builtin_amdgcn_s_sleep(1); \
    if ((++_sp & 255u) == 0u) { if (xb_ld(&(bar)[XB_TMO])) break; if (_sp > XB_SPIN_CAP) { atomicAdd(&(bar)[XB_TMO], 1u); break; } } } } while (0)
struct XcdBarrier { unsigned* bar; unsigned x; volatile LAS unsigned* st; };
DI XcdBarrier xcd_barrier_post(unsigned* bar, volatile LAS unsigned* st) {
    XcdBarrier b; b.bar = bar; b.x = xb_xcc_id(); b.st = st;
    if (threadIdx.x == 0) (void)xb_add(&bar[XB_XCNT(b.x)], 1u);
    return b;
}
DI void xcd_barrier_complete(unsigned* bar, unsigned x, unsigned& nloc, unsigned& nx) {
    const unsigned G = gridDim.x * gridDim.y * gridDim.z;
    unsigned sum, cnt, mine, sp = 0u;
    for (;;) {
        sum = 0u; cnt = 0u; mine = 0u;
#pragma unroll
        for (unsigned j = 0; j < 16; ++j) { const unsigned c = xb_ld(&bar[XB_XCNT(j)]); sum += c; cnt += (c > 0u) ? 1u : 0u; mine = (j == x) ? c : mine; }
        if (sum == G) break;
        __builtin_amdgcn_s_sleep(1);
        if ((++sp & 255u) == 0u) { if (xb_ld(&bar[XB_TMO])) break; if (sp > XB_SPIN_CAP) { atomicAdd(&bar[XB_TMO], 1u); break; } }
    }
    nloc = mine > 0u ? mine : 1u; nx = cnt > 0u ? cnt : 1u;
}
DI void xcd_barrier(const XcdBarrier& b) {
    asm volatile("s_waitcnt vmcnt(0)" ::: "memory");
    __syncthreads();
    if (threadIdx.x == 0) {
        unsigned* bar = b.bar;
        __builtin_amdgcn_s_waitcnt(0);
        unsigned nloc = b.st[0], nx = b.st[1];
        if (nloc == 0u) { xcd_barrier_complete(bar, b.x, nloc, nx); b.st[0] = nloc; b.st[1] = nx; }
        const unsigned old = xb_add(&bar[XB_XSUB(b.x)], 1u);
        const unsigned gen = old / nloc;
        if (old + 1u == (gen + 1u) * nloc) {
            __builtin_amdgcn_fence(__ATOMIC_RELEASE, "agent");
            asm volatile("s_waitcnt vmcnt(0)" ::: "memory");
            const unsigned og = xb_add(&bar[XB_TOP], 1u);
            const unsigned tg = og / nx;
            if (og + 1u == (tg + 1u) * nx) xb_add(&bar[XB_TOPGEN], 1u);
            else XB_SPIN(xb_ld(&bar[XB_TOPGEN]) == tg, bar);
            __builtin_amdgcn_fence(__ATOMIC_ACQUIRE, "agent");
            xb_add(&bar[XB_XGEN(b.x)], 1u);
            asm volatile("s_waitcnt vmcnt(0)" ::: "memory");
        } else {
            XB_SPIN(xb_ld(&bar[XB_XGEN(b.x)]) == gen, bar);
            __builtin_amdgcn_fence(__ATOMIC_ACQUIRE, "agent");
            asm volatile("s_waitcnt vmcnt(0)" ::: "memory");
        }
    }
    __syncthreads();
}

namespace pg8 {
constexpr int BM = 256, BK = 64, HALF = 128, HTB = HALF * BK * 2, STAGE_BYTES = 8 * HTB, NXCD = 8, WGM = 8;
DI int lds_byte(int r, int c) { const int st = (r >> 4) * 2 + (c >> 5), rr = r & 15, cc = c & 31, ob = rr * 64 + cc * 2; return st * 1024 + (ob ^ (((ob >> 9) & 1) << 5)); }
DI void stage_rc(int b, int& R, int& C) { const int st = b / 1024, sb = b % 1024, swz = sb ^ (((sb >> 9) & 1) << 5); R = (st >> 1) * 16 + swz / 64; C = (st & 1) * 32 + (swz % 64) / 2; }
DI int perm32(int rho) { const int n = rho >> 4, i = rho & 15; return 8 * (i >> 2) + 4 * n + (i & 3); }
struct Unit { int pm, pn, e; };

struct DenseOrder {
    const char* A; const char* Bt; int K, nM, nN, nwg, G, c;
    DI void init(const void* A_, const void* Bt_, int M, int N, int K_, int G_, int c_) { A = (const char*)A_; Bt = (const char*)Bt_; K = K_; nM = M / BM; nN = N / BM; nwg = nM * nN; G = G_; c = c_; }
    DI bool next(int i, Unit& u) const {
        const long L = (long)i * G + c; if (L >= nwg) return false;
        int wgid = (int)L; { const int q = nwg / NXCD, r = nwg % NXCD, xcd = wgid % NXCD, off = wgid / NXCD; wgid = (xcd < r ? xcd * (q + 1) : r * (q + 1) + (xcd - r) * q) + off; }
        const int nig = WGM * nN, gid = wgid / nig, fm = gid * WGM, gsz = (nM - fm) < WGM ? (nM - fm) : WGM;
        u.pm = fm + ((wgid % nig) % gsz); u.pn = (wgid % nig) / gsz; u.e = 0; return true;
    }
    DI const char* a_base(const Unit& u) const { return A + (size_t)u.pm * 512 * K; }
    DI const char* b_base(const Unit& u) const { return Bt + (size_t)u.pn * 512 * K; }
    DI void gather(const Unit&, const int (&)[2], const int (&)[2], unsigned (&)[2][2]) const {}
};
struct MoeOrder {
    const char* A; const char* Bt; const int* row_tok; const int* tile_e; int K, N, nunits, G, c; bool gat;
    DI bool next(int i, Unit& u) const {
        const int L = i * G + c; if (L >= nunits) return false;
        u.pm = L >> 2; u.pn = L & 3;
        u.e = __builtin_amdgcn_readfirstlane(__hip_atomic_load(tile_e + u.pm, __ATOMIC_RELAXED, __HIP_MEMORY_SCOPE_AGENT)); return true;
    }
    DI const char* a_base(const Unit& u) const { return gat ? A : A + (size_t)u.pm * 512 * K; }
    DI const char* b_base(const Unit& u) const { return Bt + ((size_t)u.e * N + (size_t)u.pn * 256) * K * 2; }
    DI void gather(const Unit& u, const int (&Rr)[2], const int (&Cc)[2], unsigned (&o)[2][2]) const {
#pragma unroll
        for (int h = 0; h < 2; ++h)
#pragma unroll
            for (int i = 0; i < 2; ++i) { const int tok = row_tok[u.pm * 256 + h * 128 + Rr[i]]; o[h][i] = (unsigned)(tok * K + Cc[i]) * 2u; }
    }
};

template <class Epi, class Sched, bool GATHER, bool FP8 = false>
DI void gemm_phase(LAS unsigned char* lds, const int K, const Sched& S, const Epi& E) {
    const int tid = threadIdx.x, wid = __builtin_amdgcn_readfirstlane(tid >> 6), lane = tid & 63, wr = wid >> 2, wc = wid & 3, fr = lane & 15, fq = lane >> 4;
    const int nt = K / BK;
    unsigned voffB[2], vA[2][2], nvA[2][2]; int Rr[2], Cc[2];
#pragma unroll
    for (int i = 0; i < 2; ++i) { int R, C; stage_rc(tid * 16 + i * 8192, R, C); Rr[i] = R; Cc[i] = C; const int Rb = (R & ~31) + perm32(R & 31);
        voffB[i] = (unsigned)(Rb * K + C) * 2u; vA[0][i] = (unsigned)(R * K + C) * 2u; vA[1][i] = (unsigned)((R + HALF) * K + C) * 2u; nvA[0][i] = vA[0][i]; nvA[1][i] = vA[1][i]; }
    const size_t kstep = (size_t)(BK * 2);
    const size_t hstep = (size_t)HALF * K * 2;
    const unsigned ldsw = (unsigned)wid * 1024u;
    const int aoff = lds_byte(wr * 64 + fr, fq * 8), boff = lds_byte(wc * 32 + fr, fq * 8);
#define PG8_SA(b, h) (((b) * 2 + (h)) * HTB)
#define PG8_SB(b, h) ((4 + (b) * 2 + (h)) * HTB)
#define PG8_STAGE(bufoff, gbase, voff) do { _Pragma("unroll") for (int _i = 0; _i < 2; ++_i) \
        __builtin_amdgcn_global_load_lds((const unsigned*)((const char*)(gbase) + (voff)[_i]), (LAS unsigned*)(lds + (bufoff) + ldsw + _i * 8192), 16, 0, 0); } while (0)
#define PG8_LDA(dst, b, h) do { if constexpr (FP8) { _Pragma("unroll") for (int m = 0; m < 4; ++m) dst##8[m] = __builtin_shufflevector(*(const LAS v4i*)(lds + PG8_SA(b, h) + aoff + m * 2048), *(const LAS v4i*)(lds + PG8_SA(b, h) + aoff + m * 2048 + 1024), 0, 1, 2, 3, 4, 5, 6, 7); } \
        else { _Pragma("unroll") for (int m = 0; m < 4; ++m) _Pragma("unroll") for (int k = 0; k < 2; ++k) dst[m][k] = *(const LAS bf16x8*)(lds + PG8_SA(b, h) + aoff + m * 2048 + k * 1024); } } while (0)
#define PG8_LDB(dst, b, h) do { if constexpr (FP8) { _Pragma("unroll") for (int n = 0; n < 2; ++n) dst##8[n] = __builtin_shufflevector(*(const LAS v4i*)(lds + PG8_SB(b, h) + boff + n * 2048), *(const LAS v4i*)(lds + PG8_SB(b, h) + boff + n * 2048 + 1024), 0, 1, 2, 3, 4, 5, 6, 7); } \
        else { _Pragma("unroll") for (int n = 0; n < 2; ++n) _Pragma("unroll") for (int k = 0; k < 2; ++k) dst[n][k] = *(const LAS bf16x8*)(lds + PG8_SB(b, h) + boff + n * 2048 + k * 1024); } } while (0)
#define PG8_CAT(x, y) __builtin_shufflevector(__builtin_bit_cast(v4i, (x)), __builtin_bit_cast(v4i, (y)), 0, 1, 2, 3, 4, 5, 6, 7)
#define PG8_MMA(ai, bj, At, Bt) do { __builtin_amdgcn_s_setprio(1); if constexpr (FP8) { _Pragma("unroll") for (int m = 0; m < 4; ++m) _Pragma("unroll") for (int n = 0; n < 2; ++n) \
        asm volatile("v_mfma_scale_f32_16x16x128_f8f6f4 %0, %1, %2, %0, %3, %3 op_sel_hi:[0,0,0]" : "+v"(acc[ai][bj][m][n]) : "v"(Bt##8[n]), "v"(At##8[m]), "v"(fp8_unit_scale)); } else { \
        _Pragma("unroll") for (int m = 0; m < 4; ++m) _Pragma("unroll") for (int n = 0; n < 2; ++n) _Pragma("unroll") for (int k = 0; k < 2; ++k) \
        acc[ai][bj][m][n] = __builtin_amdgcn_mfma_f32_16x16x32_bf16(Bt[n][k], At[m][k], acc[ai][bj][m][n], 0, 0, 0); } __builtin_amdgcn_s_setprio(0); } while (0)
#define PG8_WAIT_V(n) asm volatile("s_waitcnt vmcnt(" #n ")" ::: "memory")
#define PG8_WAIT_L(n) asm volatile("s_waitcnt lgkmcnt(" #n ")" ::: "memory")
#define PG8_BAR __builtin_amdgcn_s_barrier()
#define PG8_SCHED __builtin_amdgcn_sched_barrier(0)
    Unit cur, nxt; int ui = 0;
    if (!S.next(0, cur)) return;
    if constexpr (GATHER) S.gather(cur, Rr, Cc, vA);
    f32x4 acc[2][2][4][2];
#pragma unroll
    for (int a = 0; a < 2; ++a)
#pragma unroll
        for (int b = 0; b < 2; ++b)
#pragma unroll
            for (int m = 0; m < 4; ++m)
#pragma unroll
                for (int n = 0; n < 2; ++n) acc[a][b][m][n] = (f32x4){0.f, 0.f, 0.f, 0.f};
    bf16x8 At[4][2], B0[2][2], B1[2][2]; v8i At8[4], B08[2], B18[2]; const int fp8_unit_scale = 0x7f7f7f7f;
    const char* cA = S.a_base(cur); const char* cB = S.b_base(cur);
    PG8_STAGE(PG8_SB(0, 0), cB, voffB); PG8_STAGE(PG8_SB(0, 1), cB + hstep, voffB); PG8_STAGE(PG8_SA(0, 0), cA, vA[0]); PG8_STAGE(PG8_SA(0, 1), cA, vA[1]);
    if (wr == 1) PG8_BAR;
    PG8_WAIT_V(2); PG8_BAR;
    PG8_STAGE(PG8_SB(1, 0), cB + kstep, voffB); PG8_STAGE(PG8_SA(1, 0), cA + kstep, vA[0]); PG8_STAGE(PG8_SB(1, 1), cB + hstep + kstep, voffB);
    PG8_WAIT_V(6); PG8_BAR;
    for (;;) {
        const bool has_next = S.next(ui + 1, nxt);
        const char* nA = has_next ? S.a_base(nxt) : cA; const char* nB = has_next ? S.b_base(nxt) : cB;
        if constexpr (GATHER) {
            if (has_next) S.gather(nxt, Rr, Cc, nvA);
            else {
#pragma unroll
                for (int h = 0; h < 2; ++h) { nvA[h][0] = vA[h][0]; nvA[h][1] = vA[h][1]; } }
        }
#pragma unroll 1
        for (int t = 0; t < nt; t += 2) {
            const bool last = (t == nt - 2);
            if constexpr (Epi::HAS_MID) { if (t == (nt >> 1)) E.mid(acc, cur, wr, wc, fr, fq); }
            const char* a1 = cA + (size_t)(t + 1) * kstep;
            const char* a2 = last ? nA : cA + (size_t)(t + 2) * kstep; const char* b2 = last ? nB : cB + (size_t)(t + 2) * kstep;
            const char* a3 = a2 + kstep; const char* b3 = b2 + kstep;
            unsigned o0[2], o1[2];
            if constexpr (GATHER) { o0[0] = last ? nvA[0][0] : vA[0][0]; o0[1] = last ? nvA[0][1] : vA[0][1]; o1[0] = last ? nvA[1][0] : vA[1][0]; o1[1] = last ? nvA[1][1] : vA[1][1]; }
            else { o0[0] = vA[0][0]; o0[1] = vA[0][1]; o1[0] = vA[1][0]; o1[1] = vA[1][1]; }
            PG8_LDB(B0, 0, 0); PG8_LDB(B1, 0, 1); PG8_SCHED; PG8_LDA(At, 0, 0); PG8_STAGE(PG8_SA(1, 1), a1, vA[1]);
            PG8_WAIT_V(8); PG8_WAIT_L(0); PG8_BAR; PG8_MMA(0, 0, At, B0); PG8_MMA(0, 1, At, B1); PG8_BAR; PG8_SCHED;
            PG8_LDA(At, 0, 1); PG8_STAGE(PG8_SB(0, 0), b2, voffB); PG8_STAGE(PG8_SB(0, 1), b2 + hstep, voffB); PG8_STAGE(PG8_SA(0, 0), a2, o0);
            PG8_WAIT_V(8); PG8_WAIT_L(0); PG8_BAR; PG8_MMA(1, 0, At, B0); PG8_MMA(1, 1, At, B1); PG8_BAR; PG8_SCHED;
            PG8_LDB(B0, 1, 0); PG8_LDB(B1, 1, 1); PG8_SCHED; PG8_LDA(At, 1, 0); PG8_STAGE(PG8_SA(0, 1), a2, o1);
            PG8_WAIT_V(8); PG8_WAIT_L(0); PG8_BAR; PG8_MMA(0, 0, At, B0); PG8_MMA(0, 1, At, B1); PG8_BAR; PG8_SCHED;
            PG8_LDA(At, 1, 1); PG8_STAGE(PG8_SB(1, 0), b3, voffB); PG8_STAGE(PG8_SB(1, 1), b3 + hstep, voffB); PG8_STAGE(PG8_SA(1, 0), a3, o0);
            PG8_WAIT_V(8); PG8_WAIT_L(0); PG8_BAR; PG8_MMA(1, 0, At, B0); PG8_MMA(1, 1, At, B1); PG8_BAR; PG8_SCHED;
        }
        if (wr == 0) PG8_BAR;
        if constexpr (FP8) asm volatile("s_nop 15\n\ts_nop 15" ::: "memory");
        E(acc, cur, wr, wc, fr, fq);
        if (!has_next) break;
#pragma unroll
        for (int a = 0; a < 2; ++a)
#pragma unroll
            for (int b = 0; b < 2; ++b)
#pragma unroll
                for (int m = 0; m < 4; ++m)
#pragma unroll
                    for (int n = 0; n < 2; ++n) acc[a][b][m][n] = (f32x4){0.f, 0.f, 0.f, 0.f};
        cur = nxt; cA = nA; cB = nB; ++ui;
        if constexpr (GATHER) {
#pragma unroll
            for (int h = 0; h < 2; ++h) { vA[h][0] = nvA[h][0]; vA[h][1] = nvA[h][1]; } }
        if (wr == 1) PG8_BAR;
    }
    PG8_WAIT_V(0);
    PG8_BAR;
#undef PG8_SA
#undef PG8_SB
#undef PG8_STAGE
#undef PG8_LDA
#undef PG8_LDB
#undef PG8_MMA
#undef PG8_CAT
#undef PG8_WAIT_V
#undef PG8_WAIT_L
#undef PG8_BAR
#undef PG8_SCHED
}

typedef f32x4 Acc[2][2][4][2];
DI u32x4 pack8(const f32x4 a, const f32x4 b) { u32x4 w; w.x = cvtpk(a[0], a[1]); w.y = cvtpk(a[2], a[3]); w.z = cvtpk(b[0], b[1]); w.w = cvtpk(b[2], b[3]); return w; }
DI f32x4 silu4(const f32x4 v) { f32x4 o; o[0] = v[0] * fsigmoid(v[0]); o[1] = v[1] * fsigmoid(v[1]); o[2] = v[2] * fsigmoid(v[2]); o[3] = v[3] * fsigmoid(v[3]); return o; }

struct EpiIn {
    static constexpr bool HAS_MID = false;
    bf16 *Qh, *Vh, *Gh, *Qm, *Km, *Vm, *Rr, *Gb; float *Zf, *KM; const float* bias; bf16* KK; const float* LB;
    DI void operator()(Acc& acc, const Unit& u, int wr, int wc, int fr, int fq) const {
        const int pn = u.pn, row0 = u.pm * BM + wr * 64 + fr, cl = wc * 32 + 8 * fq;
        f32x4 bv[2][2];
#pragma unroll
        for (int bj = 0; bj < 2; ++bj)
#pragma unroll
            for (int n = 0; n < 2; ++n) bv[bj][n] = *(const f32x4*)(bias + pn * 256 + bj * HALF + cl + 4 * n);
        if (pn < 4) {
#define EI_DPP(v, ctrl) __int_as_float(__builtin_amdgcn_update_dpp(0, __float_as_int(v), ctrl, 0xf, 0xf, true))
            const int chb = pn * 128 + cl;
#pragma unroll
            for (int ai = 0; ai < 2; ++ai)
#pragma unroll
                for (int n = 0; n < 2; ++n) { const f32x4 lbv = *(const f32x4*)(LB + chb + 4 * n); f32x4 run = (f32x4){0.f, 0.f, 0.f, 0.f}, bmid = run; f32x4 bbv[4], kkv[4];
#pragma unroll
                    for (int m = 0; m < 4; ++m) {
#pragma unroll
                        for (int j = 0; j < 4; ++j) { const float z = acc[ai][1][m][n][j] + bv[1][n][j]; const float sg = frcp(1.f + __expf(-z)); const float lf = __logf(lbv[j] + (1.f - lbv[j]) * sg); kkv[m][j] = (1.f - lbv[j]) * (1.f - sg);
                            float t = lf; t += EI_DPP(t, 0xB1); t += EI_DPP(t, 0x4E); t += EI_DPP(t, 0x141); t += EI_DPP(t, 0x140);
                            float s = lf; s += EI_DPP(s, 0x111); s += EI_DPP(s, 0x112); s += EI_DPP(s, 0x114); s += EI_DPP(s, 0x118);
                            bbv[m][j] = s + run[j]; run[j] += t; }
                        if (m == 1) bmid = run; }
#pragma unroll
                    for (int m = 0; m < 4; ++m) { f32x4 qp, kp;
#pragma unroll
                        for (int j = 0; j < 4; ++j) { const float qx = acc[ai][0][m][n][j] + bv[0][n][j]; const float e = __expf(bbv[m][j] - bmid[j]); qp[j] = qx * fsigmoid(qx) * e; kp[j] = kkv[m][j] * frcp(e); }
                        const size_t ro = (size_t)(row0 + ai * HALF + m * 16) * 512 + chb + 4 * n;
                        u32x2 qw, kw; qw.x = cvtpk(qp[0], qp[1]); qw.y = cvtpk(qp[2], qp[3]); kw.x = cvtpk(kp[0], kp[1]); kw.y = cvtpk(kp[2], kp[3]);
                        *(u32x2*)(Qh + ro) = qw; *(u32x2*)(KK + ro) = kw; }
                    if (fr == 0) { const size_t so = (size_t)(u.pm * 4 + ai * 2 + wr) * 512 + chb + 4 * n; *(f32x4*)(Zf + so) = bmid; *(f32x4*)(Zf + 262144 + so) = run; }
                    asm volatile("" ::: "memory"); }
#undef EI_DPP
        } else if (pn < 14) {
            const int seg = pn >> 1, c0 = (pn & 1) * 256 + cl;
            {
                bf16* O = seg == 2 ? Vh : seg == 3 ? Gh : seg == 4 ? Qm : seg == 5 ? Km : Vm;
                const int act = (seg == 3) ? 1 : (seg == 4 ? 2 : 0);
                if (seg == 5) {
#pragma unroll
                    for (int bj = 0; bj < 2; ++bj)
#pragma unroll
                        for (int n = 0; n < 2; ++n) { f32x4 cs = (f32x4){0.f, 0.f, 0.f, 0.f};
#pragma unroll
                            for (int ai = 0; ai < 2; ++ai)
#pragma unroll
                                for (int m = 0; m < 4; ++m) cs += acc[ai][bj][m][n] + bv[bj][n];
#pragma unroll
                            for (int j = 0; j < 4; ++j) { float s = cs[j]; s += __shfl_xor(s, 1); s += __shfl_xor(s, 2); s += __shfl_xor(s, 4); s += __shfl_xor(s, 8); cs[j] = s; }
                            if (fr == 0) *(f32x4*)(KM + (size_t)(u.pm * 2 + wr) * 512 + c0 + bj * HALF + 4 * n) = cs; }
                }
#pragma unroll
                for (int ai = 0; ai < 2; ++ai)
#pragma unroll
                    for (int m = 0; m < 4; ++m) { const int row = row0 + ai * HALF + m * 16;
                        bf16* rp = (seg >= 4) ? O + ((size_t)(row >> 11) * 8 * SEQ + (row & (SEQ - 1))) * 64 + (size_t)(c0 >> 6) * SEQ * 64 + (c0 & 63) : O + (size_t)row * 512 + c0;
                        const size_t bjs = (seg >= 4) ? (size_t)2 * SEQ * 64 : (size_t)HALF;
#pragma unroll
                        for (int bj = 0; bj < 2; ++bj) { f32x4 v0 = acc[ai][bj][m][0] + bv[bj][0], v1 = acc[ai][bj][m][1] + bv[bj][1];
                            if (act == 1) { v0 = silu4(v0); v1 = silu4(v1); } else if (act == 2) { v0 = v0 * (0.125f * LOG2E); v1 = v1 * (0.125f * LOG2E); }
                            *(u32x4*)(rp + bj * bjs) = pack8(v0, v1); }
                        asm volatile("" ::: "memory"); }
            }
        } else {
            const int c0 = (pn - 14) * 128 + cl;
#pragma unroll
            for (int ai = 0; ai < 2; ++ai)
#pragma unroll
                for (int m = 0; m < 4; ++m) { const size_t off = (size_t)(row0 + ai * HALF + m * 16) * 1024 + c0; f32x4 r[2], g[2];
#pragma unroll
                    for (int n = 0; n < 2; ++n) { const f32x4 a = acc[ai][0][m][n] + bv[0][n], b = acc[ai][1][m][n] + bv[1][n];
#pragma unroll
                        for (int j = 0; j < 4; ++j) { const float ea = __expf(-a[j]), eb = __expf(-b[j]); g[n][j] = frcp(1.f + eb); r[n][j] = (1.f + eb) * frcp(1.f + ea); } }
                    *(u32x4*)(Rr + off) = pack8(r[0], r[1]); *(u32x4*)(Gb + off) = pack8(g[0], g[1]); asm volatile("" ::: "memory"); }
        }
    }
};
struct EpiProj {
    static constexpr bool HAS_MID = true;
    const bf16 *Rr, *Gb; bf16* U;
    DI void scale(Acc& acc, const bf16* G, const Unit& u, int wr, int wc, int fr, int fq) const {
        int row0 = u.pm * BM + wr * 64 + fr, col0 = u.pn * BM + wc * 32 + 8 * fq;
        asm volatile("" : "+v"(row0), "+v"(col0));
#pragma unroll
        for (int ai = 0; ai < 2; ++ai)
#pragma unroll
            for (int mp = 0; mp < 2; ++mp) { u32x4 rv[2][2];
#pragma unroll
            for (int m = 0; m < 2; ++m)
#pragma unroll
                for (int bj = 0; bj < 2; ++bj) rv[m][bj] = *(const u32x4*)(G + (size_t)(row0 + ai * HALF + (2 * mp + m) * 16) * 1024 + col0 + bj * HALF);
#pragma unroll
            for (int m = 0; m < 2; ++m)
#pragma unroll
                for (int bj = 0; bj < 2; ++bj) { const u32x4 w = rv[m][bj];
                    acc[ai][bj][2 * mp + m][0] *= (f32x4){bflo(w.x), bfhi(w.x), bflo(w.y), bfhi(w.y)}; acc[ai][bj][2 * mp + m][1] *= (f32x4){bflo(w.z), bfhi(w.z), bflo(w.w), bfhi(w.w)}; }
            asm volatile("" ::: "memory"); }
    }
    DI void mid(Acc& acc, const Unit& u, int wr, int wc, int fr, int fq) const { scale(acc, Rr, u, wr, wc, fr, fq); }
    DI void operator()(Acc& acc, const Unit& u, int wr, int wc, int fr, int fq) const {
        scale(acc, Gb, u, wr, wc, fr, fq);
        const int row0 = u.pm * BM + wr * 64 + fr, col0 = u.pn * BM + wc * 32 + 8 * fq;
#pragma unroll
        for (int ai = 0; ai < 2; ++ai)
#pragma unroll
            for (int m = 0; m < 4; ++m) { bf16* rp = U + (size_t)(row0 + ai * HALF + m * 16) * 1024 + col0;
#pragma unroll
                for (int bj = 0; bj < 2; ++bj) *(u32x4*)(rp + bj * HALF) = pack8(acc[ai][bj][m][0], acc[ai][bj][m][1]); }
    }
};
struct EpiOut {
    static constexpr bool HAS_MID = false;
    const float* X; float* Pre;
    DI void operator()(Acc& acc, const Unit& u, int wr, int wc, int fr, int fq) const {
        const int row0 = u.pm * BM + wr * 64 + fr, col0 = u.pn * BM + wc * 32 + 8 * fq;
#pragma unroll
        for (int ai = 0; ai < 2; ++ai)
#pragma unroll
            for (int m = 0; m < 4; ++m) { const size_t off = (size_t)(row0 + ai * HALF + m * 16) * 1024 + col0;
#pragma unroll
                for (int bj = 0; bj < 2; ++bj) { const f32x4 x0 = *(const f32x4*)(X + off + bj * HALF), x1 = *(const f32x4*)(X + off + bj * HALF + 4);
                    *(f32x4*)(Pre + off + bj * HALF) = x0 * DN_ALPHA + acc[ai][bj][m][0]; *(f32x4*)(Pre + off + bj * HALF + 4) = x1 * DN_ALPHA + acc[ai][bj][m][1]; }
                if (m & 1) asm volatile("" ::: "memory"); }
    }
};
struct EpiM1 {
    static constexpr bool HAS_MID = false;
    unsigned char* H;
    DI void operator()(Acc& acc, const Unit& u, int wr, int wc, int fr, int fq) const {
        const int row0 = u.pm * BM + wr * 64 + fr, col0 = u.pn * 128 + wc * 32 + 8 * fq;
        constexpr float inv = 1.f / (FP8_SX * FP8_SW);
#pragma unroll
        for (int ai = 0; ai < 2; ++ai)
#pragma unroll
            for (int m = 0; m < 4; ++m) { const f32x4 h0 = silu4(acc[ai][0][m][0] * inv) * (acc[ai][1][m][0] * (inv * FP8_SH)), h1 = silu4(acc[ai][0][m][1] * inv) * (acc[ai][1][m][1] * (inv * FP8_SH));
                u32x2 w; w.x = cvt4_fp8(h0[0], h0[1], h0[2], h0[3]); w.y = cvt4_fp8(h1[0], h1[1], h1[2], h1[3]);
                *(u32x2*)(H + (size_t)(row0 + ai * HALF + m * 16) * 512 + col0) = w; }
    }
};
struct EpiM2 {
    static constexpr bool HAS_MID = false;
    bf16* Y;
    DI void operator()(Acc& acc, const Unit& u, int wr, int wc, int fr, int fq) const {
        const int row0 = u.pm * BM + wr * 64 + fr, col0 = u.pn * BM + wc * 32 + 8 * fq;
        constexpr float inv = 1.f / (FP8_SH * FP8_SW);
#pragma unroll
        for (int ai = 0; ai < 2; ++ai)
#pragma unroll
            for (int m = 0; m < 4; ++m) { bf16* rp = Y + (size_t)(row0 + ai * HALF + m * 16) * 1024 + col0;
#pragma unroll
                for (int bj = 0; bj < 2; ++bj) *(u32x4*)(rp + bj * HALF) = pack8(acc[ai][bj][m][0] * inv, acc[ai][bj][m][1] * inv); }
    }
};
}

struct Args { const float* in[19]; float* out; unsigned char* ws; int ph_lo, ph_hi; };
enum { I_X = 0, I_WIN, I_BIN, I_LBL, I_HGNG, I_RELB, I_WPA, I_WPB, I_WOUT, I_LN1G, I_LN1B, I_WGRP, I_BGRP, I_WEXP, I_BEXP, I_WGU, I_WDN, I_LN2G, I_LN2B };

struct Ctx {
    LAS unsigned char* lds; volatile LAS unsigned* MISC;
    int tid, lane, wid, G, vcu;
    unsigned char* ws; gu32* ctl;
};

DI int win_drow(int n0) { if (n0 < 512) return 256 * (n0 >> 7) + (n0 & 127); if (n0 < 1024) { const int r = n0 - 512; return 256 * (r >> 7) + 128 + (r & 127); }
    if (n0 < 3584) return n0; if (n0 < 4608) { const int r = n0 - 3584; return 3584 + 256 * (r >> 7) + (r & 127); } const int r = n0 - 4608; return 3584 + 256 * (r >> 7) + 128 + (r & 127); }
DI int wgu_drow(int n0) { if (n0 < 512) return 256 * (n0 >> 7) + (n0 & 127); const int r = n0 - 512; return 256 * (r >> 7) + 128 + (r & 127); }
DI int hswz(int row, int ch16) { return 256 * row + 16 * (ch16 ^ (((row & 3) << 2) | ((row >> 2) & 3))); }
DI int htr(int r0, int c0, int lane) { const int i16 = lane & 15, q = i16 >> 2, p = i16 & 3; return hswz(r0 + q, c0 + (p >> 1)) + 8 * (p & 1); }
DI void transpose_tile256(const float* W, int N, bf16* WT, int ldk, int n0, int mode, int dk, LAS unsigned char* lds, int lane, int wid, bool f8 = false) {
    asm volatile("" : "+v"(lane));
#pragma unroll
    for (int half = 0; half < 2; ++half) { f32x4 v[16];
#pragma unroll
        for (int i = 0; i < 16; ++i) v[i] = *(const f32x4*)(W + (size_t)(128 * half + 8 * i + wid) * N + 4 * lane);
#pragma unroll
        for (int i = 0; i < 16; ++i) { const int k = 128 * half + 8 * i + wid; u32x2 w; w.x = cvtpk(v[i][0], v[i][1]); w.y = cvtpk(v[i][2], v[i][3]);
            *(LAS u32x2*)(lds + (lane >> 5) * 65536 + hswz(k, (lane & 31) >> 1) + 8 * (lane & 1)) = w; } }
    __syncthreads();
    const int g = lane >> 4, i16 = lane & 15;
#pragma unroll
    for (int nb = 0; nb < 2; ++nb) { const int nl = 32 * wid + 16 * nb + i16, n = n0 + nl; const int dr = (mode == 0) ? n : (mode == 1 ? win_drow(n) : wgu_drow(n));
        bf16* orow = WT + (size_t)dr * ldk + dk + 8 * g; const LAS unsigned char* img = lds + (wid >> 2) * 65536;
#pragma unroll
        for (int s = 0; s < 8; ++s) { const int r0 = 32 * s + 8 * g, c0 = 4 * (wid & 3) + 2 * nb;
            const s16x4 lo = vtr((LAS const char*)(img + htr(r0, c0, lane))), hh = vtr((LAS const char*)(img + htr(r0 + 4, c0, lane)));
            if (f8) { u32x2 w; w.x = cvt4_fp8(bf2f((unsigned short)lo[0]) * FP8_SW, bf2f((unsigned short)lo[1]) * FP8_SW, bf2f((unsigned short)lo[2]) * FP8_SW, bf2f((unsigned short)lo[3]) * FP8_SW);
                w.y = cvt4_fp8(bf2f((unsigned short)hh[0]) * FP8_SW, bf2f((unsigned short)hh[1]) * FP8_SW, bf2f((unsigned short)hh[2]) * FP8_SW, bf2f((unsigned short)hh[3]) * FP8_SW);
                *(u32x2*)((unsigned char*)WT + (size_t)dr * ldk + dk + 8 * g + 32 * s) = w; }
            else *(bf16x8*)(orow + 32 * s) = (bf16x8){lo[0], lo[1], lo[2], lo[3], hh[0], hh[1], hh[2], hh[3]}; } }
    __syncthreads();
}
constexpr int MOE_CVT_TILES = 32 * 16 + 32 * 8;
DI void moe_cvt_tile(const Ctx& C, const Args& a, int it) {
    unsigned char* WguT = (unsigned char*)a.out; unsigned char* WdT = (unsigned char*)a.out + 32 * MiB;
    if (it < 512) { const int e = it >> 4, kt = (it >> 2) & 3, nt = it & 3;
        transpose_tile256(a.in[I_WGU] + (size_t)e * 1024 * 1024 + (size_t)(256 * kt) * 1024 + 256 * nt, 1024, (bf16*)(WguT + (size_t)e * 1024 * 1024), 1024, 256 * nt, 2, 256 * kt, C.lds, C.lane, C.wid, true); }
    else { const int r = it - 512, e = r >> 3, kt = (r >> 2) & 1, nt = r & 3;
        transpose_tile256(a.in[I_WDN] + (size_t)e * 512 * 1024 + (size_t)(256 * kt) * 1024 + 256 * nt, 1024, (bf16*)(WdT + (size_t)e * 1024 * 512), 512, 256 * nt, 0, 256 * kt, C.lds, C.lane, C.wid, true); }
}
DI void p0_prologue(const Ctx& C, const Args& a) {
    bf16* WinT = (bf16*)(C.ws + WS_WIN); bf16* Wcat = (bf16*)(C.ws + WS_WCAT); bf16* WoT = (bf16*)(C.ws + WS_WO);
    constexpr int I_IN = 4 * 22, I_PA = 2 * 4, I_O = 4 * 4, NITEMS = I_IN + 2 * I_PA + I_O;
    for (int it = C.vcu; it < NITEMS; it += C.G) {
        int r = it;
        if (r < I_IN) { const int kt = r / 22, nt = r % 22; transpose_tile256(a.in[I_WIN] + (size_t)(256 * kt) * NIN + 256 * nt, NIN, WinT, 1024, 256 * nt, 1, 256 * kt, C.lds, C.lane, C.wid); continue; } r -= I_IN;
        if (r < I_PA) { const int kt = r / 4, nt = r % 4; transpose_tile256(a.in[I_WPA] + (size_t)(256 * kt) * 1024 + 256 * nt, 1024, Wcat, 1024, 256 * nt, 0, 256 * kt, C.lds, C.lane, C.wid); continue; } r -= I_PA;
        if (r < I_PA) { const int kt = r / 4, nt = r % 4; transpose_tile256(a.in[I_WPB] + (size_t)(256 * kt) * 1024 + 256 * nt, 1024, Wcat, 1024, 256 * nt, 0, 512 + 256 * kt, C.lds, C.lane, C.wid); continue; } r -= I_PA;
        { const int kt = r / 4, nt = r % 4; transpose_tile256(a.in[I_WOUT] + (size_t)(256 * kt) * 1024 + 256 * nt, 1024, WoT, 1024, 256 * nt, 0, 256 * kt, C.lds, C.lane, C.wid); }
    }
    const int gw = C.vcu * NWAVES + C.wid, NGW = C.G * NWAVES; (void)gw; (void)NGW;
    const int gt = C.vcu * NTHREADS + C.tid, NT = C.G * NTHREADS;
    { const float* x = a.in[I_X]; bf16* Xb = (bf16*)(C.ws + WS_XB);
      for (int i = gt; i < NTOK * DM / 8; i += NT) { const f32x4 v0 = *(const f32x4*)(x + (size_t)i * 8), v1 = *(const f32x4*)(x + (size_t)i * 8 + 4); *(u32x4*)(Xb + (size_t)i * 8) = pg8::pack8(v0, v1); } }
    { float* lbp = (float*)(C.ws + WS_LB); for (int n = gt; n < 512; n += NT) lbp[n] = 1.f / (1.f + expf(a.in[I_LBL][512 + n] - a.in[I_LBL][n])); }
    { float* bp = (float*)(C.ws + WS_BPERM); const float* bin = a.in[I_BIN];
      for (int n = gt; n < NIN; n += NT) bp[win_drow(n & ~31) + (n & 31)] = bin[n]; }
    { bf16* wh = (bf16*)(C.ws + WS_WRH); bf16* wl = (bf16*)(C.ws + WS_WRL); const float* wg = a.in[I_WGRP]; const float* we = a.in[I_WEXP];
      for (int i = gt; i < 48 * 1024; i += NT) { const int j = i >> 10, k = i & 1023; float w = 0.f; if (j < 4) w = wg[k * 4 + j]; else if (j < 36) w = we[k * 32 + (j - 4)];
          const unsigned h = cvtpk(w, 0.f) & 0xffffu; const float r = w - bf2f((unsigned short)h); wh[i] = (bf16)h; wl[i] = (bf16)(cvtpk(r, 0.f) & 0xffffu); } }
}
constexpr int HG_BUF = 67072, HG_QP = 0, HG_KP = 16384, HG_V = 32768, HG_SC = 49152, HG_OB = 49664;
DI void hgrn_unit(const Ctx& C, const Args& a, int b, int h) {
    LAS unsigned char* L = C.lds;
    const int tid = C.tid, lane = C.lane, wid = C.wid;
    const int q32 = lane & 31, hi = lane >> 5, dh = (lane >> 4) & 1, dvb = wid & 3, tb = wid >> 2;
    const float* BM = (const float*)(C.ws + WS_ZF); const float* BE = BM + 262144;
    const bf16* Qh = (const bf16*)(C.ws + WS_QH); const bf16* Kh = (const bf16*)(C.ws + WS_KK); const bf16* Vh = (const bf16*)(C.ws + WS_VH); const bf16* Gh = (const bf16*)(C.ws + WS_GH);
    bf16* Ocat = (bf16*)(C.ws + WS_XB);
    const size_t rb = (size_t)b * SEQ;
    LAS float* NGS = (LAS float*)(L + 2 * HG_BUF);
    if (tid < 128) NGS[tid] = a.in[I_HGNG][h * 128 + tid];
    const int orow = tid >> 3, oseg = tid & 7;
    f32x16 T[4];
#pragma unroll
    for (int i = 0; i < 4; ++i)
#pragma unroll
        for (int r = 0; r < 16; ++r) T[i][r] = 0.f;
    u32x4 gr[2];
    const int drow = 8 * wid + (lane >> 4), dch = lane & 15;
#define HG_DMA(c) do { _Pragma("unroll") for (int p = 0; p < 2; ++p) { const int r_ = drow + 4 * p; const int sc_ = dch ^ (((r_ & 3) << 2) | ((r_ >> 2) & 3)); \
            const size_t g_ = (rb + (size_t)(c) * 64 + r_) * 512 + h * 128 + 8 * sc_; LAS unsigned char* d_ = L + ((c) & 1) * HG_BUF + (8 * wid + 4 * p) * 256; \
            __builtin_amdgcn_global_load_lds((const unsigned*)(Qh + g_), (LAS unsigned*)(d_ + HG_QP), 16, 0, 0); \
            __builtin_amdgcn_global_load_lds((const unsigned*)(Kh + g_), (LAS unsigned*)(d_ + HG_KP), 16, 0, 0); \
            __builtin_amdgcn_global_load_lds((const unsigned*)(Vh + g_), (LAS unsigned*)(d_ + HG_V), 16, 0, 0); } } while (0)
    float sm = 0.f, spe = 0.f, spm = 0.f;
#define HG_SCLOAD(c) do { if (tid < 128) { const size_t s_ = (size_t)(b * 32 + (c)) * 512 + h * 128 + tid; sm = BM[s_]; if ((c) > 0) { spe = BE[s_ - 512]; spm = BM[s_ - 512]; } } } while (0)
#define HG_SCALE(c) do { if (tid < 128) ((LAS float*)(L + ((c) & 1) * HG_BUF + HG_SC))[tid] = __expf(sm + (spe - spm)); } while (0)
    HG_DMA(0);
    HG_SCLOAD(0);
    HG_SCALE(0);
    asm volatile("s_waitcnt vmcnt(0)" ::: "memory");
    __syncthreads();
    for (int c = 0; c < 32; ++c) {
        const LAS unsigned char* B = L + (c & 1) * HG_BUF;
        if (c + 1 < 32) { HG_DMA(c + 1); HG_SCLOAD(c + 1); }
        int q32o = q32, hio = hi, laneo = lane; asm volatile("" : "+v"(q32o), "+v"(hio), "+v"(laneo));
        f32x16 oT;
#pragma unroll
        for (int r = 0; r < 16; ++r) oT[r] = 0.f;
        bf16x8 qb[8];
#pragma unroll
        for (int ks = 0; ks < 8; ++ks) qb[ks] = *(const LAS bf16x8*)(B + HG_QP + hswz(32 * tb + q32o, 2 * ks + hio));
#pragma unroll
        for (int sb = 0; sb < 2; ++sb) {
            if (sb <= tb) {
                bf16x8 ka[8];
#pragma unroll
                for (int ks = 0; ks < 8; ++ks) ka[ks] = *(const LAS bf16x8*)(B + HG_KP + hswz(32 * sb + q32o, 2 * ks + hio));
                s16x4 vl[2], vh[2];
#pragma unroll
                for (int s2 = 0; s2 < 2; ++s2) { const int r0 = 32 * sb + 16 * s2 + 4 * hio; vl[s2] = vtr((LAS const char*)(B + HG_V + htr(r0, 4 * dvb + 2 * dh, laneo))); vh[s2] = vtr((LAS const char*)(B + HG_V + htr(r0 + 8, 4 * dvb + 2 * dh, laneo))); }
                __builtin_amdgcn_sched_barrier(0);
                f32x16 pT;
#pragma unroll
                for (int r = 0; r < 16; ++r) pT[r] = 0.f;
#pragma unroll
                for (int ks = 0; ks < 8; ++ks) pT = MFMA32(ka[ks], qb[ks], pT);
                if (sb == tb) {
#pragma unroll
                    for (int r = 0; r < 16; ++r) if (crow(r, hi) > q32) pT[r] = 0.f;
                }
#pragma unroll
                for (int s2 = 0; s2 < 2; ++s2) { u32x4 pw; pw.x = cvtpk(pT[8 * s2 + 0], pT[8 * s2 + 1]); pw.y = cvtpk(pT[8 * s2 + 2], pT[8 * s2 + 3]); pw.z = cvtpk(pT[8 * s2 + 4], pT[8 * s2 + 5]); pw.w = cvtpk(pT[8 * s2 + 6], pT[8 * s2 + 7]);
                    oT = MFMA32(((bf16x8){vl[s2][0], vl[s2][1], vl[s2][2], vl[s2][3], vh[s2][0], vh[s2][1], vh[s2][2], vh[s2][3]}), __builtin_bit_cast(bf16x8, pw), oT); }
                __builtin_amdgcn_sched_barrier(0);
            }
        }
        { const size_t g0 = (rb + (size_t)c * 64 + orow) * 512 + h * 128 + 16 * oseg; gr[0] = *(const u32x4*)(Gh + g0); gr[1] = *(const u32x4*)(Gh + g0 + 8); }
        {
            u32x2 qq0[8], qq1[8];
            if (c > 0) {
#pragma unroll
                for (int i = 0; i < 4; ++i)
#pragma unroll
                    for (int s = 0; s < 2; ++s) { qq0[2 * i + s] = *(const LAS u32x2*)(B + HG_QP + hswz(32 * tb + q32o, 4 * i + 2 * s) + 8 * hio); qq1[2 * i + s] = *(const LAS u32x2*)(B + HG_QP + hswz(32 * tb + q32o, 4 * i + 2 * s + 1) + 8 * hio); }
            }
#pragma unroll
            for (int i = 0; i < 4; ++i)
#pragma unroll
                for (int g = 0; g < 4; ++g) { const f32x4 sc = *(const LAS f32x4*)(B + HG_SC + (32 * i + 8 * g + 4 * hio) * 4);
#pragma unroll
                    for (int j = 0; j < 4; ++j) T[i][4 * g + j] *= sc[j]; }
            __builtin_amdgcn_sched_barrier(0);
            if (c > 0) {
#pragma unroll
                for (int i = 0; i < 4; ++i)
#pragma unroll
                    for (int s = 0; s < 2; ++s) { u32x4 tw; tw.x = cvtpk(T[i][8 * s + 0], T[i][8 * s + 1]); tw.y = cvtpk(T[i][8 * s + 2], T[i][8 * s + 3]); tw.z = cvtpk(T[i][8 * s + 4], T[i][8 * s + 5]); tw.w = cvtpk(T[i][8 * s + 6], T[i][8 * s + 7]);
                        const u32x4 qw = (u32x4){qq0[2 * i + s].x, qq0[2 * i + s].y, qq1[2 * i + s].x, qq1[2 * i + s].y};
                        oT = MFMA32(__builtin_bit_cast(bf16x8, tw), __builtin_bit_cast(bf16x8, qw), oT); }
            }
        }
        { LAS unsigned char* OBp = L + (c & 1) * HG_BUF + HG_OB;
#pragma unroll
          for (int g = 0; g < 4; ++g) { u32x2 w; w.x = cvtpk(oT[4 * g], oT[4 * g + 1]); w.y = cvtpk(oT[4 * g + 2], oT[4 * g + 3]); *(LAS u32x2*)(OBp + (32 * tb + q32o) * 272 + (32 * dvb + 8 * g + 4 * hio) * 2) = w; } }
#pragma unroll
        for (int sp = 0; sp < 2; ++sp) {
            s16x4 vl[2], vh[2], kl[2][4], kh[2][4];
#pragma unroll
            for (int u = 0; u < 2; ++u) { const int r0 = 16 * (2 * sp + u) + 8 * hio;
                vl[u] = vtr((LAS const char*)(B + HG_V + htr(r0, 4 * dvb + 2 * dh, laneo))); vh[u] = vtr((LAS const char*)(B + HG_V + htr(r0 + 4, 4 * dvb + 2 * dh, laneo)));
#pragma unroll
                for (int i = 0; i < 4; ++i) { kl[u][i] = vtr((LAS const char*)(B + HG_KP + htr(r0, 4 * i + 2 * dh, laneo))); kh[u][i] = vtr((LAS const char*)(B + HG_KP + htr(r0 + 4, 4 * i + 2 * dh, laneo))); } }
            __builtin_amdgcn_sched_barrier(0);
#pragma unroll
            for (int u = 0; u < 2; ++u) { const bf16x8 vb = (bf16x8){vl[u][0], vl[u][1], vl[u][2], vl[u][3], vh[u][0], vh[u][1], vh[u][2], vh[u][3]};
#pragma unroll
                for (int i = 0; i < 4; ++i) T[i] = MFMA32(((bf16x8){kl[u][i][0], kl[u][i][1], kl[u][i][2], kl[u][i][3], kh[u][i][0], kh[u][i][1], kh[u][i][2], kh[u][i][3]}), vb, T[i]); }
            __builtin_amdgcn_sched_barrier(0);
        }
        if (c + 1 < 32) HG_SCALE(c + 1);
        asm volatile("s_waitcnt vmcnt(0)" ::: "memory");
        __syncthreads();
        { const LAS unsigned char* OBp = L + (c & 1) * HG_BUF + HG_OB + orow * 272 + oseg * 32;
          const u32x4 o0 = *(const LAS u32x4*)OBp, o1 = *(const LAS u32x4*)(OBp + 16);
          float ov[16];
          ov[0] = bflo(o0.x); ov[1] = bfhi(o0.x); ov[2] = bflo(o0.y); ov[3] = bfhi(o0.y); ov[4] = bflo(o0.z); ov[5] = bfhi(o0.z); ov[6] = bflo(o0.w); ov[7] = bfhi(o0.w);
          ov[8] = bflo(o1.x); ov[9] = bfhi(o1.x); ov[10] = bflo(o1.y); ov[11] = bfhi(o1.y); ov[12] = bflo(o1.z); ov[13] = bfhi(o1.z); ov[14] = bflo(o1.w); ov[15] = bfhi(o1.w);
          float ss = 0.f;
#pragma unroll
          for (int j = 0; j < 16; ++j) ss += ov[j] * ov[j];
          ss += __int_as_float(__builtin_amdgcn_update_dpp(0, __float_as_int(ss), 0xB1, 0xf, 0xf, true));
          ss += __int_as_float(__builtin_amdgcn_update_dpp(0, __float_as_int(ss), 0x4E, 0xf, 0xf, true));
          ss += __int_as_float(__builtin_amdgcn_update_dpp(0, __float_as_int(ss), 0x141, 0xf, 0xf, true));
          const float rs = __builtin_amdgcn_rsqf(ss * (1.f / 128.f) + LN_EPS);
          float ng[16];
#pragma unroll
          for (int i = 0; i < 4; ++i) { const f32x4 n_ = *(const LAS f32x4*)(NGS + 16 * oseg + 4 * i); ng[4 * i] = n_[0]; ng[4 * i + 1] = n_[1]; ng[4 * i + 2] = n_[2]; ng[4 * i + 3] = n_[3]; }
          float gvv[16];
          gvv[0] = bflo(gr[0].x); gvv[1] = bfhi(gr[0].x); gvv[2] = bflo(gr[0].y); gvv[3] = bfhi(gr[0].y); gvv[4] = bflo(gr[0].z); gvv[5] = bfhi(gr[0].z); gvv[6] = bflo(gr[0].w); gvv[7] = bfhi(gr[0].w);
          gvv[8] = bflo(gr[1].x); gvv[9] = bfhi(gr[1].x); gvv[10] = bflo(gr[1].y); gvv[11] = bfhi(gr[1].y); gvv[12] = bflo(gr[1].z); gvv[13] = bfhi(gr[1].z); gvv[14] = bflo(gr[1].w); gvv[15] = bfhi(gr[1].w);
          u32x4 w0, w1;
          w0.x = cvtpk(ov[0] * rs * ng[0] * gvv[0], ov[1] * rs * ng[1] * gvv[1]); w0.y = cvtpk(ov[2] * rs * ng[2] * gvv[2], ov[3] * rs * ng[3] * gvv[3]);
          w0.z = cvtpk(ov[4] * rs * ng[4] * gvv[4], ov[5] * rs * ng[5] * gvv[5]); w0.w = cvtpk(ov[6] * rs * ng[6] * gvv[6], ov[7] * rs * ng[7] * gvv[7]);
          w1.x = cvtpk(ov[8] * rs * ng[8] * gvv[8], ov[9] * rs * ng[9] * gvv[9]); w1.y = cvtpk(ov[10] * rs * ng[10] * gvv[10], ov[11] * rs * ng[11] * gvv[11]);
          w1.z = cvtpk(ov[12] * rs * ng[12] * gvv[12], ov[13] * rs * ng[13] * gvv[13]); w1.w = cvtpk(ov[14] * rs * ng[14] * gvv[14], ov[15] * rs * ng[15] * gvv[15]);
          bf16* op = Ocat + (rb + (size_t)c * 64 + orow) * 1024 + h * 128 + 16 * oseg;
          *(u32x4*)op = w0; *(u32x4*)(op + 8) = w1; }
    }
    __syncthreads();
#undef HG_DMA
#undef HG_SCALE
#undef HG_SCLOAD
}

constexpr int AT_NST = 4, AT_K = 0, AT_V = AT_NST * 8192, AT_KM = 2 * AT_NST * 8192, AT_TAB = AT_KM + 1792;
DI int t5_bucket(int d) { if (d < 16) return d; const int v = 16 + (int)(logf((float)d * (1.f / 16.f)) / logf(8.f) * 16.f); return v < 31 ? v : 31; }
DI void glds16(const void* gsrc, unsigned lds_dst) { unsigned keep;
    asm volatile("s_mov_b32 %0, m0\n\ts_mov_b32 m0, %2\n\ts_nop 0\n\tglobal_load_lds_dwordx4 %1, off\n\ts_mov_b32 m0, %0" : "=&s"(keep) : "v"(gsrc), "s"(lds_dst) : "memory"); }
DI void attn_unit(const Ctx& C, const Args& a, int b, int h, int jq) {
    LAS unsigned char* L = C.lds;
    const int tid = C.tid, lane = C.lane, wid = C.wid, q32 = lane & 31, hi = lane >> 5;
    const bf16* Qm = (const bf16*)(C.ws + WS_QM); const bf16* Km = (const bf16*)(C.ws + WS_KM); const bf16* Vm = (const bf16*)(C.ws + WS_VM); const float* KM = (const float*)(C.ws + WS_KMEAN);
    bf16* Ocat = (bf16*)(C.ws + WS_XB);
    const int tq = jq * 256 + wid * 32 + q32;
    const size_t hb = (size_t)(b * 8 + h) * SEQ;
    bf16x8 qf[4];
#pragma unroll
    for (int ks = 0; ks < 4; ++ks) qf[ks] = *(const bf16x8*)(Qm + (hb + tq) * 64 + 16 * ks + 8 * hi);
    LAS float* kml = (LAS float*)(L + AT_KM); LAS float* tab = (LAS float*)(L + AT_TAB);
    if (tid < jq * 64) { const int n = tid >> 6, d = tid & 63; kml[tid] = KM[(size_t)((b * 8 + n) * 2 + 0) * 512 + h * 64 + d] + KM[(size_t)((b * 8 + n) * 2 + 1) * 512 + h * 64 + d]; }
    if (tid < 129) tab[tid] = (a.in[I_RELB][t5_bucket(tid) * 8 + h] - a.in[I_RELB][31 * 8 + h]) * LOG2E;
    const int drow = 8 * wid + (lane >> 3), dch = lane & 7;
    const bf16* ksrc = Km + (hb + drow) * 64 + 8 * (dch ^ ((drow >> 1) & 7));
    const bf16* vsrc = Vm + (hb + drow) * 64 + 8 * (dch ^ (((drow >> 1) & 1) << 2));
    const unsigned kdst = (unsigned)__builtin_amdgcn_readfirstlane((int)(unsigned)(size_t)(L + AT_K + wid * 1024)), vdst = (unsigned)__builtin_amdgcn_readfirstlane((int)(unsigned)(size_t)(L + AT_V + wid * 1024));
    const int nt = 4 * jq + 4;
#define AT_ISSUE(t) do { glds16(ksrc + (size_t)(t) * 4096, kdst + ((t) & 3) * 8192); glds16(vsrc + (size_t)(t) * 4096, vdst + ((t) & 3) * 8192); } while (0)
    AT_ISSUE(0); AT_ISSUE(1); AT_ISSUE(2);
    __syncthreads();
    unsigned sel = 0;
    {
        float g[7];
#pragma unroll
        for (int n = 0; n < 7; ++n) { g[n] = 0.f;
            if (n < jq) { float s = 0.f;
#pragma unroll
                for (int ks = 0; ks < 4; ++ks)
#pragma unroll
                    for (int j = 0; j < 8; ++j) s += bf2f((unsigned short)qf[ks][j]) * kml[n * 64 + 16 * ks + 8 * hi + j];
                s += __shfl_xor(s, 32); g[n] = s; } }
#pragma unroll
        for (int n = 0; n < 7; ++n) if (n < jq) { int rank = 0;
#pragma unroll
            for (int m = 0; m < 7; ++m) if (m != n && m < jq) rank += (g[m] > g[n] || (g[m] == g[n] && m < n)) ? 1 : 0;
            if (rank < 3) sel |= 1u << n; }
    }
    const float c31 = a.in[I_RELB][31 * 8 + h] * LOG2E;
    float lrun = 0.f;
    f32x16 negm;
#pragma unroll
    for (int r = 0; r < 16; ++r) negm[r] = c31;
    f32x16 o0, o1;
#pragma unroll
    for (int r = 0; r < 16; ++r) { o0[r] = 0.f; o1[r] = 0.f; }
    const int i16 = lane & 15, qq = i16 >> 2, pp = i16 & 3, dh = (lane >> 4) & 1, xsw = (qq >> 1) & 1;
    const int vb0 = (4 * hi + qq) * 128 + 64 * (0 ^ xsw) + 32 * dh + 8 * pp, vb1 = (4 * hi + qq) * 128 + 64 * (1 ^ xsw) + 32 * dh + 8 * pp;
    const int kxs = (q32 >> 1) & 7;
    for (int kt = 0; kt < nt; ++kt) {
        if (kt + 2 < nt) asm volatile("s_waitcnt vmcnt(4)" ::: "memory"); else if (kt + 1 < nt) asm volatile("s_waitcnt vmcnt(2)" ::: "memory"); else asm volatile("s_waitcnt vmcnt(0)" ::: "memory");
        __builtin_amdgcn_s_barrier();
        asm volatile("" ::: "memory");
        if (kt + 3 < nt) AT_ISSUE(kt + 3);
        const int blk = kt >> 2; const bool own = (blk == jq);
        const bool active = !own || ((kt & 3) * 64 <= wid * 32 + 31);
        if (active) {
            const LAS unsigned char* Kc = L + AT_K + (kt & 3) * 8192; const LAS unsigned char* Vc = L + AT_V + (kt & 3) * 8192;
            bf16x8 kf[8];
#pragma unroll
            for (int ks = 0; ks < 4; ++ks) { const int ko = (((2 * ks + hi) ^ kxs) << 4); kf[2 * ks] = *(const LAS bf16x8*)(Kc + q32 * 128 + ko); kf[2 * ks + 1] = *(const LAS bf16x8*)(Kc + (32 + q32) * 128 + ko); }
            __builtin_amdgcn_sched_barrier(0);
            f32x16 s0 = negm, s1 = negm;
#pragma unroll
            for (int ks = 0; ks < 4; ++ks) { s0 = MFMA32(kf[2 * ks], qf[ks], s0); s1 = MFMA32(kf[2 * ks + 1], qf[ks], s1); }
            __builtin_amdgcn_sched_barrier(0);
            s16x4 vf[2][4][2];
#pragma unroll
            for (int j = 0; j < 4; ++j) { const int ro = 16 * j * 128;
                vf[0][j][0] = vtr((LAS const char*)(Vc + vb0 + ro)); vf[0][j][1] = vtr((LAS const char*)(Vc + vb0 + ro + 8 * 128));
                vf[1][j][0] = vtr((LAS const char*)(Vc + vb1 + ro)); vf[1][j][1] = vtr((LAS const char*)(Vc + vb1 + ro + 8 * 128)); }
            __builtin_amdgcn_sched_barrier(0);
            const bool near = (jq * 256 + wid * 32 - 64 * kt - 63) < 128;
            if (near) {
                const int dist0 = tq - 64 * kt - 4 * hi;
#pragma unroll
                for (int r = 0; r < 16; ++r) { const int d0 = dist0 - ((r & 3) + 8 * (r >> 2)), d1 = d0 - 32;
                    const int i0 = d0 < 0 ? 0 : (d0 > 128 ? 128 : d0), i1 = d1 < 0 ? 0 : (d1 > 128 ? 128 : d1);
                    const float t0 = tab[i0], t1 = tab[i1]; s0[r] += t0; s1[r] += t1; s0[r] = d0 < 0 ? -INFINITY : s0[r]; s1[r] = d1 < 0 ? -INFINITY : s1[r]; }
            }
            const bool lsel = own || ((sel >> blk) & 1u);
            float mx = fmaxf(fmaxf(s0[0], s1[0]), fmaxf(s0[1], s1[1]));
#pragma unroll
            for (int r = 2; r < 16; r += 2) mx = fmaxf(mx, fmaxf(fmaxf(s0[r], s1[r]), fmaxf(s0[r + 1], s1[r + 1])));
            mx = lsel ? mx : -INFINITY;
            mx = fmaxf(mx, __shfl_xor(mx, 32));
            if (__any(mx > 4.0f)) {
                const float delta = fmaxf(mx, 0.f), alpha = __builtin_amdgcn_exp2f(-delta);
                lrun *= alpha;
#pragma unroll
                for (int r = 0; r < 16; ++r) { o0[r] *= alpha; o1[r] *= alpha; negm[r] -= delta; s0[r] -= delta; s1[r] -= delta; }
            }
            float ps = 0.f;
#pragma unroll
            for (int r = 0; r < 16; ++r) { s0[r] = __builtin_amdgcn_exp2f(s0[r]); s1[r] = __builtin_amdgcn_exp2f(s1[r]); ps += s0[r] + s1[r]; }
            lrun += lsel ? ps : 0.f;
            const unsigned pmask = lsel ? 0xffffffffu : 0u;
#pragma unroll
            for (int kb = 0; kb < 2; ++kb)
#pragma unroll
                for (int s2 = 0; s2 < 2; ++s2) {
                    u32x4 pw;
                    if (kb == 0) { pw.x = cvtpk(s0[8 * s2 + 0], s0[8 * s2 + 1]); pw.y = cvtpk(s0[8 * s2 + 2], s0[8 * s2 + 3]); pw.z = cvtpk(s0[8 * s2 + 4], s0[8 * s2 + 5]); pw.w = cvtpk(s0[8 * s2 + 6], s0[8 * s2 + 7]); }
                    else         { pw.x = cvtpk(s1[8 * s2 + 0], s1[8 * s2 + 1]); pw.y = cvtpk(s1[8 * s2 + 2], s1[8 * s2 + 3]); pw.z = cvtpk(s1[8 * s2 + 4], s1[8 * s2 + 5]); pw.w = cvtpk(s1[8 * s2 + 6], s1[8 * s2 + 7]); }
                    pw.x &= pmask; pw.y &= pmask; pw.z &= pmask; pw.w &= pmask;
                    const bf16x8 pf = __builtin_bit_cast(bf16x8, pw);
                    const s16x4 a0l = vf[0][2 * kb + s2][0], a0h = vf[0][2 * kb + s2][1], a1l = vf[1][2 * kb + s2][0], a1h = vf[1][2 * kb + s2][1];
                    o0 = MFMA32(((bf16x8){a0l[0], a0l[1], a0l[2], a0l[3], a0h[0], a0h[1], a0h[2], a0h[3]}), pf, o0);
                    o1 = MFMA32(((bf16x8){a1l[0], a1l[1], a1l[2], a1l[3], a1h[0], a1h[1], a1h[2], a1h[3]}), pf, o1);
                }
        }
    }
    const float linv = 1.f / (lrun + __shfl_xor(lrun, 32));
    bf16* op = Ocat + ((size_t)b * SEQ + tq) * 1024 + 512 + h * 64;
#pragma unroll
    for (int g = 0; g < 4; ++g) { u32x2 w0, w1; w0.x = cvtpk(o0[4 * g] * linv, o0[4 * g + 1] * linv); w0.y = cvtpk(o0[4 * g + 2] * linv, o0[4 * g + 3] * linv);
        w1.x = cvtpk(o1[4 * g] * linv, o1[4 * g + 1] * linv); w1.y = cvtpk(o1[4 * g + 2] * linv, o1[4 * g + 3] * linv);
        *(u32x2*)(op + 8 * g + 4 * hi) = w0; *(u32x2*)(op + 32 + 8 * g + 4 * hi) = w1; }
    __syncthreads();
#undef AT_ISSUE
}

#ifndef PROBE_HGX
#define PROBE_HGX 1
#endif
#ifndef PROBE_ATX
#define PROBE_ATX 1
#endif
#ifndef STAMP_SEL
#define STAMP_SEL -1
#endif
#define STAMP(i) do { if (STAMP_SEL >= 0 && blockIdx.x == 0 && C.tid == 0) { const unsigned long long t_ = __builtin_amdgcn_s_memrealtime(); C.MISC[16 + 2 * (i)] = (unsigned)t_; C.MISC[17 + 2 * (i)] = (unsigned)(t_ >> 32); } } while (0)
DI void p2_mixers(const Ctx& C, const Args& a, int rep) {
    for (int hx = 0; hx < PROBE_HGX; ++hx)
    for (int u = blockIdx.x; u < 64; u += C.G) hgrn_unit(C, a, u >> 2, u & 3);
    STAMP(11);
    unsigned* QA = (unsigned*)(C.ctl + CW_QUEUE + 64 * rep); unsigned* QC = (unsigned*)(C.ctl + CW_QUEUE2 + 64 * rep);
    constexpr int NA = 1024 * PROBE_ATX, NC = MOE_CVT_TILES;
    if (C.tid == 0) { C.MISC[0] = __hip_atomic_fetch_add(QA, 1u, __ATOMIC_RELAXED, __HIP_MEMORY_SCOPE_AGENT); C.MISC[1] = (rep == 0) ? __hip_atomic_fetch_add(QC, 1u, __ATOMIC_RELAXED, __HIP_MEMORY_SCOPE_AGENT) : (unsigned)NC; }
    __syncthreads();
    int qa = (int)C.MISC[0], qc = (int)C.MISC[1];
    __syncthreads();
    for (;;) {
        const bool doa = qa < NA, doc = qc < NC;
        if (!doa && !doc) break;
        unsigned na = (unsigned)NA, nc = (unsigned)NC;
        if (C.tid == 0) { if (doa) na = __hip_atomic_fetch_add(QA, 1u, __ATOMIC_RELAXED, __HIP_MEMORY_SCOPE_AGENT); if (doc) nc = __hip_atomic_fetch_add(QC, 1u, __ATOMIC_RELAXED, __HIP_MEMORY_SCOPE_AGENT); }
#ifdef STAMP_ACC
        unsigned long long ta_ = 0, tb_ = 0, tc_ = 0; if (C.tid == 0) ta_ = __builtin_amdgcn_s_memrealtime();
#endif
        if (doa) { const int q = qa / PROBE_ATX; attn_unit(C, a, (q & 127) >> 3, q & 7, 7 - (q >> 7)); }
#ifdef STAMP_ACC
        if (C.tid == 0) tb_ = __builtin_amdgcn_s_memrealtime();
#endif
        if (doc) moe_cvt_tile(C, a, qc);
#ifdef STAMP_ACC
        if (C.tid == 0 && blockIdx.x == 100) { tc_ = __builtin_amdgcn_s_memrealtime(); const unsigned long long d_ = (STAMP_ACC == 0) ? (tb_ - ta_) : (tc_ - tb_);
            const unsigned long long o_ = ((unsigned long long)C.MISC[45] << 32) | C.MISC[44]; const unsigned long long n_ = o_ + d_; C.MISC[44] = (unsigned)n_; C.MISC[45] = (unsigned)(n_ >> 32); }
#endif
        if (C.tid == 0) { C.MISC[0] = na; C.MISC[1] = nc; }
        __syncthreads();
        qa = (int)C.MISC[0]; qc = (int)C.MISC[1];
        __syncthreads();
    }
    STAMP(12);
#ifdef STAMP_ACC
    if (C.tid == 0 && blockIdx.x == 100) { const unsigned long long n_ = ((unsigned long long)C.MISC[45] << 32) | C.MISC[44]; const unsigned long long w0 = __builtin_amdgcn_s_memrealtime(); while (__builtin_amdgcn_s_memrealtime() - w0 < 4ull * n_) __builtin_amdgcn_s_sleep(8); }
#endif
}

DI void r1_phase(const Ctx& C, const Args& a) {
    LAS unsigned char* L = C.lds;
    const int tid = C.tid, lane = C.lane, wid = C.wid;
    LAS float* LG = (LAS float*)L + wid * 16 * 48;
    LAS int* CNT = (LAS int*)(L + 32768);
    LAS float* G1 = (LAS float*)(L + 33024); LAS float* B1 = (LAS float*)(L + 37120);
    const float* Pre = (const float*)(C.ws + WS_ZF); unsigned char* X1q = (unsigned char*)(C.ws + WS_XB); f32x2* stats = (f32x2*)(C.ws + WS_STATS);
    const bf16* WrH = (const bf16*)(C.ws + WS_WRH); const bf16* WrL = (const bf16*)(C.ws + WS_WRL);
    unsigned* tokE = (unsigned*)(C.ws + WS_TOKE); float* tokW = (float*)(C.ws + WS_TOKW); int* wgcnt = (int*)(C.ws + WS_WGCNT);
    for (int i = tid; i < 1024; i += NTHREADS) { G1[i] = a.in[I_LN1G][i]; B1[i] = a.in[I_LN1B][i]; }
    const int m16 = lane & 15, kq = lane >> 4;
    for (int chunk = blockIdx.x; chunk < NTOK / 128; chunk += C.G) {
        if (tid < 32) CNT[tid] = 0;
        __syncthreads();
        const int tok0 = chunk * 128 + wid * 16;
        const float* xrow = Pre + (size_t)(tok0 + m16) * 1024 + 8 * kq;
        float s = 0.f, s2 = 0.f;
#pragma unroll 8
        for (int k0 = 0; k0 < 1024; k0 += 32) { const f32x4 xa = *(const f32x4*)(xrow + k0), xc = *(const f32x4*)(xrow + k0 + 4);
            s += (xa[0] + xa[1]) + (xa[2] + xa[3]) + (xc[0] + xc[1]) + (xc[2] + xc[3]);
            s2 += (xa[0] * xa[0] + xa[1] * xa[1]) + (xa[2] * xa[2] + xa[3] * xa[3]) + (xc[0] * xc[0] + xc[1] * xc[1]) + (xc[2] * xc[2] + xc[3] * xc[3]); }
        s += __shfl_xor(s, 16); s += __shfl_xor(s, 32); s2 += __shfl_xor(s2, 16); s2 += __shfl_xor(s2, 32);
        const float mean = s * (1.f / 1024.f); const float var = fmaxf(s2 * (1.f / 1024.f) - mean * mean, 0.f); const float rstd = 1.f / sqrtf(var + LN_EPS);
        if (kq == 0) stats[tok0 + m16] = (f32x2){mean, rstd};
        f32x4 acc[3];
#pragma unroll
        for (int nb = 0; nb < 3; ++nb) acc[nb] = (f32x4){0.f, 0.f, 0.f, 0.f};
        unsigned char* xb = X1q + (size_t)(tok0 + m16) * 1024 + 8 * kq;
        const bf16* wrh = WrH + (size_t)m16 * 1024 + 8 * kq; const bf16* wrl = WrL + (size_t)m16 * 1024 + 8 * kq;
        bf16x8 wh[2][3], wl[2][3];
#pragma unroll
        for (int nb = 0; nb < 3; ++nb) { wh[0][nb] = *(const bf16x8*)(wrh + (size_t)nb * 16 * 1024); wl[0][nb] = *(const bf16x8*)(wrl + (size_t)nb * 16 * 1024); }
#pragma unroll 1
        for (int kb = 0; kb < 4; ++kb) {
            f32x4 xa[8], xc[8];
#pragma unroll
            for (int j = 0; j < 8; ++j) { xa[j] = *(const f32x4*)(xrow + kb * 256 + 32 * j); xc[j] = *(const f32x4*)(xrow + kb * 256 + 32 * j + 4); }
#pragma unroll
            for (int j = 0; j < 8; ++j) { const int k0 = kb * 256 + 32 * j, cur = j & 1;
                if (k0 + 32 < 1024) {
#pragma unroll
                    for (int nb = 0; nb < 3; ++nb) { wh[cur ^ 1][nb] = *(const bf16x8*)(wrh + (size_t)nb * 16 * 1024 + k0 + 32); wl[cur ^ 1][nb] = *(const bf16x8*)(wrl + (size_t)nb * 16 * 1024 + k0 + 32); } }
                const f32x4 ya = (xa[j] - mean) * rstd * *(const LAS f32x4*)(G1 + k0 + 8 * kq) + *(const LAS f32x4*)(B1 + k0 + 8 * kq);
                const f32x4 yc = (xc[j] - mean) * rstd * *(const LAS f32x4*)(G1 + k0 + 8 * kq + 4) + *(const LAS f32x4*)(B1 + k0 + 8 * kq + 4);
                u32x4 hw; hw.x = cvtpk(ya[0], ya[1]); hw.y = cvtpk(ya[2], ya[3]); hw.z = cvtpk(yc[0], yc[1]); hw.w = cvtpk(yc[2], yc[3]);
                { u32x2 qw; qw.x = cvt4_fp8(ya[0] * FP8_SX, ya[1] * FP8_SX, ya[2] * FP8_SX, ya[3] * FP8_SX); qw.y = cvt4_fp8(yc[0] * FP8_SX, yc[1] * FP8_SX, yc[2] * FP8_SX, yc[3] * FP8_SX); *(u32x2*)(xb + k0) = qw; }
                u32x4 lw; lw.x = cvtpk(ya[0] - bflo(hw.x), ya[1] - bfhi(hw.x)); lw.y = cvtpk(ya[2] - bflo(hw.y), ya[3] - bfhi(hw.y)); lw.z = cvtpk(yc[0] - bflo(hw.z), yc[1] - bfhi(hw.z)); lw.w = cvtpk(yc[2] - bflo(hw.w), yc[3] - bfhi(hw.w));
                const bf16x8 xh = __builtin_bit_cast(bf16x8, hw), xl = __builtin_bit_cast(bf16x8, lw);
#pragma unroll
                for (int nb = 0; nb < 3; ++nb) { acc[nb] = MFMA16(wh[cur][nb], xh, acc[nb]); acc[nb] = MFMA16(wl[cur][nb], xh, acc[nb]); acc[nb] = MFMA16(wh[cur][nb], xl, acc[nb]); }
            }
        }
#pragma unroll
        for (int nb = 0; nb < 3; ++nb)
#pragma unroll
            for (int r = 0; r < 4; ++r) LG[m16 * 48 + nb * 16 + 4 * kq + r] = acc[nb][r];
        asm volatile("s_waitcnt lgkmcnt(0)" ::: "memory");
        if (lane < 16) {
            const LAS float* lg = LG + lane * 48;
            float gl[4];
#pragma unroll
            for (int j = 0; j < 4; ++j) gl[j] = lg[j] + a.in[I_BGRP][j];
            int grp = 0; float gm = gl[0];
#pragma unroll
            for (int j = 1; j < 4; ++j) if (gl[j] > gm) { gm = gl[j]; grp = j; }
            float se = 0.f;
#pragma unroll
            for (int j = 0; j < 4; ++j) se += expf(gl[j] - gm);
            const float pg = 1.f / se;
            float el[8];
#pragma unroll
            for (int j = 0; j < 8; ++j) el[j] = lg[4 + grp * 8 + j] + a.in[I_BEXP][grp * 8 + j];
            int i0 = 0; float v0 = el[0];
#pragma unroll
            for (int j = 1; j < 8; ++j) if (el[j] > v0) { v0 = el[j]; i0 = j; }
            int i1 = -1; float v1 = -INFINITY;
#pragma unroll
            for (int j = 0; j < 8; ++j) if (j != i0 && el[j] > v1) { v1 = el[j]; i1 = j; }
            const float w0 = 1.f / (1.f + expf(v1 - v0)), w1 = 1.f - w0;
            const int e0 = grp * 8 + i0, e1 = grp * 8 + i1;
            const int r0 = __hip_atomic_fetch_add(CNT + e0, 1, __ATOMIC_RELAXED, __HIP_MEMORY_SCOPE_WORKGROUP), r1 = __hip_atomic_fetch_add(CNT + e1, 1, __ATOMIC_RELAXED, __HIP_MEMORY_SCOPE_WORKGROUP);
            const int tok = tok0 + lane;
            tokE[tok] = (unsigned)e0 | ((unsigned)e1 << 8) | ((unsigned)r0 << 16) | ((unsigned)r1 << 24);
            tokW[tok * 2] = w0 * pg; tokW[tok * 2 + 1] = w1 * pg;
        }
        __syncthreads();
        if (tid < 32) wgcnt[chunk * 32 + tid] = CNT[tid];
        __syncthreads();
    }
}

DI void r2_phase(const Ctx& C, const Args& a) {
    LAS int* PA = (LAS int*)C.lds;
    LAS int* PB = PA + 512;
    LAS int* TOT = PB + 512; LAS int* BASE = TOT + 32; LAS int* PST = BASE + 32;
    const int tid = C.tid;
    const int* wgcnt = (const int*)(C.ws + WS_WGCNT); const unsigned* tokE = (const unsigned*)(C.ws + WS_TOKE);
    int* tokD = (int*)(C.ws + WS_TOKD); int* rowtok = (int*)(C.ws + WS_ROWTOK); int* tilee = (int*)(C.ws + WS_TILEE);
    for (int chunk = blockIdx.x; chunk < NTOK / 128; chunk += C.G) {
        { const int e = tid & 31, part = tid >> 5; int sa = 0, sb = 0;
          for (int c = part * 16; c < part * 16 + 16; ++c) { const int v = wgcnt[c * 32 + e]; sa += v; sb += (c < chunk) ? v : 0; }
          PA[part * 32 + e] = sa; PB[part * 32 + e] = sb; }
        __syncthreads();
        if (tid < 32) { int sa = 0, sb = 0; for (int p = 0; p < 16; ++p) { sa += PA[p * 32 + tid]; sb += PB[p * 32 + tid]; } TOT[tid] = sa; BASE[tid] = sb; }
        __syncthreads();
        if (tid == 0) { int ps = 0; for (int e = 0; e < 32; ++e) { PST[e] = ps; ps += ((TOT[e] + 255) >> 8) << 8; } PST[32] = ps; }
        __syncthreads();
        if (tid < 128) { const int tok = chunk * 128 + tid; const unsigned w = tokE[tok]; const int e0 = w & 31, e1 = (w >> 8) & 31, r0 = (w >> 16) & 255, r1 = (w >> 24) & 255;
            const int d0 = PST[e0] + BASE[e0] + r0, d1 = PST[e1] + BASE[e1] + r1; rowtok[d0] = tok; rowtok[d1] = tok; tokD[tok * 2] = d0; tokD[tok * 2 + 1] = d1; }
        if (chunk < 32) { const int e = chunk, end = PST[e + 1] - PST[e]; for (int i = TOT[e] + tid; i < end; i += NTHREADS) rowtok[PST[e] + i] = 0; }
        if (chunk == 0) { if (tid < 32) { for (int t = PST[tid] >> 8; t < (PST[tid + 1] >> 8); ++t) tilee[t] = tid; } if (tid == 0) tilee[511] = PST[32] >> 8; }
        __syncthreads();
    }
}

DI void f_phase(const Ctx& C, const Args& a) {
    const int lane = C.lane, gw = C.vcu * NWAVES + C.wid, NGW = C.G * NWAVES;
    const float* Pre = (const float*)(C.ws + WS_ZF); const bf16* Y = (const bf16*)(C.ws + WS_Y); const int* tokD = (const int*)(C.ws + WS_TOKD); const float* tokW = (const float*)(C.ws + WS_TOKW);
    const f32x2* stats = (const f32x2*)(C.ws + WS_STATS);
    f32x4 g2[4], b2[4], g1[4], b1[4];
#pragma unroll
    for (int j = 0; j < 4; ++j) { g2[j] = *(const f32x4*)(a.in[I_LN2G] + 256 * j + 4 * lane); b2[j] = *(const f32x4*)(a.in[I_LN2B] + 256 * j + 4 * lane);
        g1[j] = *(const f32x4*)(a.in[I_LN1G] + 256 * j + 4 * lane) * DN_ALPHA; b1[j] = *(const f32x4*)(a.in[I_LN1B] + 256 * j + 4 * lane) * DN_ALPHA; }
    for (int tok = gw; tok < NTOK; tok += NGW) {
        const int d0 = tokD[tok * 2], d1 = tokD[tok * 2 + 1]; const float w0 = tokW[tok * 2], w1 = tokW[tok * 2 + 1]; const f32x2 st = stats[tok];
        const float* xr = Pre + (size_t)tok * 1024 + 4 * lane; const bf16* y0 = Y + (size_t)d0 * 1024 + 4 * lane; const bf16* y1 = Y + (size_t)d1 * 1024 + 4 * lane;
        f32x4 v[4]; float s = 0.f;
#pragma unroll
        for (int j = 0; j < 4; ++j) { const f32x4 x = *(const f32x4*)(xr + 256 * j); const u32x2 p0 = *(const u32x2*)(y0 + 256 * j), p1 = *(const u32x2*)(y1 + 256 * j);
            v[j] = ((x - st.x) * st.y) * g1[j] + b1[j] + (f32x4){bflo(p0.x), bfhi(p0.x), bflo(p0.y), bfhi(p0.y)} * w0 + (f32x4){bflo(p1.x), bfhi(p1.x), bflo(p1.y), bfhi(p1.y)} * w1;
            s += (v[j][0] + v[j][1]) + (v[j][2] + v[j][3]); }
        const float mean = wave_sum(s) * (1.f / 1024.f); float s2 = 0.f;
#pragma unroll
        for (int j = 0; j < 4; ++j) { v[j] = v[j] - mean; s2 += (v[j][0] * v[j][0] + v[j][1] * v[j][1]) + (v[j][2] * v[j][2] + v[j][3] * v[j][3]); }
        const float rstd = 1.f / sqrtf(wave_sum(s2) * (1.f / 1024.f) + LN_EPS);
        float* orow = a.out + (size_t)tok * 1024 + 4 * lane;
#pragma unroll
        for (int j = 0; j < 4; ++j) *(f32x4*)(orow + 256 * j) = v[j] * rstd * g2[j] + b2[j];
    }
}

constexpr int NPH = 10;
__global__ void __launch_bounds__(NTHREADS, 2) mk_fwd(Args args) {
    extern __shared__ __attribute__((aligned(16))) unsigned char lds_raw[];
    Ctx C;
    C.lds = (LAS unsigned char*)lds_raw; C.MISC = (volatile LAS unsigned*)(C.lds + MISC_OFF);
    C.tid = threadIdx.x; C.lane = C.tid & 63; C.wid = __builtin_amdgcn_readfirstlane(C.tid >> 6);
    C.G = gridDim.x; { const int bx = blockIdx.x; C.vcu = (C.G % 8 == 0) ? (bx % 8) * (C.G / 8) + bx / 8 : bx; }
    C.ws = args.ws; C.ctl = (gu32*)(args.ws + WS_CTL);
    if (C.tid < 64) C.MISC[C.tid] = 0u;
    __syncthreads();
    XcdBarrier bar; bar.bar = (unsigned*)(C.ctl + CW_BAR); bar.x = 0; bar.st = nullptr;
    if (MK_N_LAUNCHES == 1) bar = xcd_barrier_post((unsigned*)(C.ctl + CW_BAR), C.MISC + 8);
    const int lo = args.ph_lo, hi = args.ph_hi;
#ifndef PH_MASK
#define PH_MASK 0x3ff
#endif
#define IN(k) (((PH_MASK >> (k)) & 1) && lo <= (k) && (k) < hi)
#ifndef STAMP_SEL
#define STAMP_SEL -1
#endif
#ifndef STAMP_T0
#define STAMP_T0 STAMP_SEL
#define STAMP_T1 (STAMP_SEL + 1)
#endif
#define SEAM(k) do { if (IN(k) && IN((k) + 1)) xcd_barrier(bar); STAMP((k) + 1); } while (0)
#ifndef PROBE_PHASE
#define PROBE_PHASE -1
#endif
#define REPS(k) ((PROBE_PHASE == (k)) ? 2 : 1)
#define REPSEAM(k) do { if (rep + 1 < REPS(k)) xcd_barrier(bar); } while (0)
    unsigned char* ws = args.ws;
    LAS unsigned char* ring = C.lds;

    STAMP(0);
    if (IN(0)) { _Pragma("unroll") for (int rep = 0; rep < REPS(0); ++rep) { p0_prologue(C, args); REPSEAM(0); } } SEAM(0);

    if (IN(1)) _Pragma("unroll") for (int rep = 0; rep < REPS(1); ++rep) {
        pg8::DenseOrder S; S.init(ws + WS_XB, ws + WS_WIN, NTOK, NIN, 1024, C.G, (int)blockIdx.x);
        pg8::EpiIn E{(bf16*)(ws + WS_QH), (bf16*)(ws + WS_VH), (bf16*)(ws + WS_GH), (bf16*)(ws + WS_QM), (bf16*)(ws + WS_KM), (bf16*)(ws + WS_VM), (bf16*)(ws + WS_R), (bf16*)(ws + WS_GB),
                     (float*)(ws + WS_ZF), (float*)(ws + WS_KMEAN), (const float*)(ws + WS_BPERM), (bf16*)(ws + WS_KK), (const float*)(ws + WS_LB)};
        pg8::gemm_phase<pg8::EpiIn, pg8::DenseOrder, false>(ring, 1024, S, E); REPSEAM(1);
    } SEAM(1);

#ifndef PROBE_P2X
#define PROBE_P2X 1
#endif
    if (IN(2)) { for (int rep = 0; rep < PROBE_P2X; ++rep) { p2_mixers(C, args, rep); if (rep + 1 < PROBE_P2X) xcd_barrier(bar); } } SEAM(2);

    if (IN(3)) _Pragma("unroll") for (int rep = 0; rep < REPS(3); ++rep) {
        pg8::DenseOrder S; S.init(ws + WS_XB, ws + WS_WCAT, NTOK, 1024, 1024, C.G, (int)blockIdx.x);
        pg8::EpiProj E{(const bf16*)(ws + WS_R), (const bf16*)(ws + WS_GB), (bf16*)(ws + WS_QH)};
        pg8::gemm_phase<pg8::EpiProj, pg8::DenseOrder, false>(ring, 1024, S, E); REPSEAM(3);
    } SEAM(3);

    if (IN(4)) _Pragma("unroll") for (int rep = 0; rep < REPS(4); ++rep) {
        pg8::DenseOrder S; S.init(ws + WS_QH, ws + WS_WO, NTOK, 1024, 1024, C.G, (int)blockIdx.x);
        pg8::EpiOut E{args.in[I_X], (float*)(ws + WS_ZF)};
        pg8::gemm_phase<pg8::EpiOut, pg8::DenseOrder, false>(ring, 1024, S, E);
        REPSEAM(4);
    } SEAM(4);

    if (IN(5)) { _Pragma("unroll") for (int rep = 0; rep < REPS(5); ++rep) { r1_phase(C, args); REPSEAM(5); } } SEAM(5);
    if (IN(6)) { _Pragma("unroll") for (int rep = 0; rep < REPS(6); ++rep) { r2_phase(C, args); REPSEAM(6); } } SEAM(6);

    if (IN(7)) _Pragma("unroll") for (int rep = 0; rep < REPS(7); ++rep) {
        const int* tilee = (const int*)(ws + WS_TILEE);
        const int ntl = __builtin_amdgcn_readfirstlane(__hip_atomic_load(tilee + 511, __ATOMIC_RELAXED, __HIP_MEMORY_SCOPE_AGENT));
        pg8::MoeOrder S{(const char*)(ws + WS_XB), (const char*)args.out, (const int*)(ws + WS_ROWTOK), tilee, 512, 1024, ntl * 4, C.G, C.vcu, true};
        pg8::EpiM1 E{(unsigned char*)(ws + WS_QH)};
        pg8::gemm_phase<pg8::EpiM1, pg8::MoeOrder, true, true>(ring, 512, S, E); REPSEAM(7);
    } SEAM(7);

    if (IN(8)) _Pragma("unroll") for (int rep = 0; rep < REPS(8); ++rep) {
        const int* tilee = (const int*)(ws + WS_TILEE);
        const int ntl = __builtin_amdgcn_readfirstlane(__hip_atomic_load(tilee + 511, __ATOMIC_RELAXED, __HIP_MEMORY_SCOPE_AGENT));
        pg8::MoeOrder S{(const char*)(ws + WS_QH), (const char*)args.out + 32 * MiB, (const int*)(ws + WS_ROWTOK), tilee, 256, 1024, ntl * 4, C.G, C.vcu, false};
        pg8::EpiM2 E{(bf16*)(ws + WS_Y)};
        pg8::gemm_phase<pg8::EpiM2, pg8::MoeOrder, false, true>(ring, 256, S, E); REPSEAM(8);
    } SEAM(8);

    if (IN(9)) { _Pragma("unroll") for (int rep = 0; rep < REPS(9); ++rep) { f_phase(C, args); REPSEAM(9); } }
    STAMP(10);
    if (STAMP_SEL >= 0 && blockIdx.x == 0 && C.tid == 0) {
        const unsigned long long t0 = ((unsigned long long)C.MISC[17 + 2 * (STAMP_T0)] << 32) | C.MISC[16 + 2 * (STAMP_T0)], t1 = ((unsigned long long)C.MISC[17 + 2 * (STAMP_T1)] << 32) | C.MISC[16 + 2 * (STAMP_T1)];
        const unsigned long long w0 = __builtin_amdgcn_s_memrealtime(); while (__builtin_amdgcn_s_memrealtime() - w0 < 4ull * (t1 - t0)) __builtin_amdgcn_s_sleep(8); }
#undef IN
#undef SEAM
}

extern "C" void kernel_launch(void* const* d_in, const int* in_sizes, int n_in, void* d_out, int out_size, void* d_ws, size_t ws_size, hipStream_t stream) {
    static int grid = 0;
    if (grid == 0) {
        if (n_in != 19 || in_sizes[0] != NTOK * DM || out_size != NTOK * DM || ws_size < WS_END) { fprintf(stderr, "kernel_launch: unexpected problem shape / workspace; nothing launched\n"); grid = -1; return; }
        int dev = 0, cus = 0, per_cu = 0;
        if (hipGetDevice(&dev) != hipSuccess || hipDeviceGetAttribute(&cus, hipDeviceAttributeMultiprocessorCount, dev) != hipSuccess) { grid = -1; return; }
        if (hipFuncSetAttribute((const void*)mk_fwd, hipFuncAttributeMaxDynamicSharedMemorySize, LDS_BYTES) != hipSuccess) { fprintf(stderr, "kernel_launch: hipFuncSetAttribute failed\n"); grid = -1; return; }
        if (hipOccupancyMaxActiveBlocksPerMultiprocessor(&per_cu, (const void*)mk_fwd, NTHREADS, LDS_BYTES) != hipSuccess || per_cu < 1) { fprintf(stderr, "kernel_launch: occupancy query says %d\n", per_cu); }
        (void)hipGetLastError();
        grid = cus;
    }
    if (grid < 0) return;
    (void)hipMemsetAsync((char*)d_ws + WS_CTL, 0, CTL_ZERO_BYTES, stream);
    Args a{};
    for (int i = 0; i < 19; ++i) a.in[i] = (const float*)d_in[i];
    a.out = (float*)d_out; a.ws = (unsigned char*)d_ws;
    if (MK_N_LAUNCHES == 1) { a.ph_lo = 0; a.ph_hi = NPH; hipLaunchKernelGGL(mk_fwd, dim3(grid), dim3(NTHREADS), LDS_BYTES, stream, a); }
    else for (int p = 0; p < NPH; ++p) { a.ph_lo = p; a.ph_hi = p + 1; hipLaunchKernelGGL(mk_fwd, dim3(grid), dim3(NTHREADS), LDS_BYTES, stream, a); }
}
```

```cpp
#include <hip/hip_runtime.h>
#include <cstdio>
#include <cstdint>
#ifndef MK_N_LAUNCHES
#define MK_N_LAUNCHES 1
#endif
#define DI __device__ __forceinline__
#define GAS __attribute__((address_space(1)))
#define LAS __attribute__((address_space(3)))
typedef unsigned short bf16;
typedef unsigned u32x4 __attribute__((ext_vector_type(4)));
typedef unsigned u32x2 __attribute__((ext_vector_type(2)));
typedef float f32x4 __attribute__((ext_vector_type(4)));
typedef float f32x2 __attribute__((ext_vector_type(2)));
typedef float f32x16 __attribute__((ext_vector_type(16)));
typedef short bf16x8 __attribute__((ext_vector_type(8)));
typedef short s16x4 __attribute__((ext_vector_type(4)));
typedef short v4i16_t __attribute__((ext_vector_type(4)));
typedef __bf16 bf16x2_t __attribute__((ext_vector_type(2)));
typedef GAS unsigned gu32;

constexpr int NTOK = 32768, DM = 1024, SEQ = 2048, NBATCH = 16, NIN = 5632;
constexpr int NWAVES = 8, NTHREADS = 512;
constexpr float LN_EPS = 1e-5f, DN_ALPHA = 1.189207115002721f, LOG2E = 1.4426950408889634f;
constexpr int MOE_MAXTILES = 288;

constexpr size_t MiB = 1u << 20;
constexpr size_t WS_CTL = 0, CTL_ZERO_BYTES = 65536;
constexpr size_t WS_WIN = 1 * MiB, WS_WCAT = 12 * MiB, WS_WO = 14 * MiB;
constexpr size_t WS_XB = 16 * MiB;
constexpr size_t WS_R = 80 * MiB;
constexpr size_t WS_GB = 144 * MiB;
constexpr size_t WS_QH = 208 * MiB;
constexpr size_t WS_VH = 240 * MiB;
constexpr size_t WS_GH = 272 * MiB;
constexpr size_t WS_ZF = 304 * MiB;
constexpr size_t WS_QM = 368 * MiB, WS_KM = 400 * MiB;
constexpr size_t WS_VM = 432 * MiB;
constexpr size_t WS_Y = 16 * MiB;
constexpr size_t WS_MISC = 464 * MiB;
constexpr size_t WS_KMEAN = WS_MISC;
constexpr size_t WS_BPERM = WS_MISC + 1 * MiB;
constexpr size_t WS_WRH = WS_MISC + 2 * MiB;
constexpr size_t WS_WRL = WS_WRH + 98304;
constexpr size_t WS_TOKE = WS_MISC + 3 * MiB;
constexpr size_t WS_TOKW = WS_MISC + 4 * MiB;
constexpr size_t WS_TOKD = WS_MISC + 5 * MiB;
constexpr size_t WS_WGCNT = WS_MISC + 6 * MiB;
constexpr size_t WS_ROWTOK = WS_MISC + 7 * MiB;
constexpr size_t WS_TILEE = WS_MISC + 8 * MiB;
constexpr size_t WS_STATS = WS_MISC + 9 * MiB;
constexpr size_t WS_LB = WS_MISC + 10 * MiB;
constexpr size_t WS_KK = WS_MISC + 12 * MiB;
constexpr size_t WS_END = 512 * MiB;
constexpr int CW_BAR = 4096, CW_QUEUE = 8192, CW_QUEUE2 = 8192 + 1024;

constexpr int LDS_BYTES = 163840, MISC_OFF = LDS_BYTES - 256;

DI unsigned cvtpk(float lo, float hi) { f32x2 v = {lo, hi}; bf16x2_t b = __builtin_convertvector(v, bf16x2_t); return __builtin_bit_cast(unsigned, b); }
DI float bflo(unsigned w) { return __uint_as_float(w << 16); }
DI float bfhi(unsigned w) { return __uint_as_float(w & 0xffff0000u); }
DI float bf2f(unsigned short h) { return __uint_as_float((unsigned)h << 16); }
DI float frcp(float x) { return __builtin_amdgcn_rcpf(x); }
DI float fsigmoid(float x) { return frcp(1.f + __expf(-x)); }
DI float wave_sum(float v) {
#pragma unroll
    for (int o = 1; o < 64; o <<= 1) v += __shfl_xor(v, o);
    return v;
}
typedef int v8i __attribute__((ext_vector_type(8)));
typedef int v4i __attribute__((ext_vector_type(4)));
DI unsigned cvt4_fp8(float a, float b, float c, float d) { a = __builtin_amdgcn_fmed3f(a, -448.f, 448.f); b = __builtin_amdgcn_fmed3f(b, -448.f, 448.f); c = __builtin_amdgcn_fmed3f(c, -448.f, 448.f); d = __builtin_amdgcn_fmed3f(d, -448.f, 448.f);
    int w = 0; w = __builtin_amdgcn_cvt_pk_fp8_f32(a, b, w, false); w = __builtin_amdgcn_cvt_pk_fp8_f32(c, d, w, true); return (unsigned)w; }
constexpr float FP8_SX = 8.f, FP8_SW = 32.f, FP8_SH = 4.f, FP8_SO = 4.f, FP8_SU = 32.f;
DI int crow(int r, int hi) { return (r & 3) + 8 * (r >> 2) + 4 * hi; }
#define MFMA32(a, b, c) __builtin_amdgcn_mfma_f32_32x32x16_bf16((a), (b), (c), 0, 0, 0)
#define MFMA16(a, b, c) __builtin_amdgcn_mfma_f32_16x16x32_bf16((a), (b), (c), 0, 0, 0)
DI s16x4 vtr(LAS const char* p) { return __builtin_bit_cast(s16x4, __builtin_amdgcn_ds_read_tr16_b64_v4i16((LAS v4i16_t*)p)); }

#define XB_TMO      128
#define XB_XCNT(j)  (256  + 64 * (j))
#define XB_XSUB(j)  (1280 + 64 * (j))
#define XB_XGEN(j)  (2304 + 64 * (j))
#define XB_TOP      3328
#define XB_TOPGEN   3392
#define XCD_BAR_WORDS 3456
#define XB_SPIN_CAP (1u << 22)
DI unsigned xb_ld(unsigned* p)              { return __hip_atomic_load(p, __ATOMIC_RELAXED, __HIP_MEMORY_SCOPE_AGENT); }
DI unsigned xb_add(unsigned* p, unsigned v) { return __hip_atomic_fetch_add(p, v, __ATOMIC_RELAXED, __HIP_MEMORY_SCOPE_AGENT); }
DI unsigned xb_xcc_id() { return (unsigned)__builtin_amdgcn_s_getreg((3 << 11) | 20) & 0xFu; }
#define XB_SPIN(cond, bar) do { unsigned _sp = 0; while (cond) { __builtin_amdgcn_s_sleep(1); \
    if ((++_sp & 255u) == 0u) { if (xb_ld(&(bar)[XB_TMO])) break; if (_sp > XB_SPIN_CAP) { atomicAdd(&(bar)[XB_TMO], 1u); break; } } } } while (0)
struct XcdBarrier { unsigned* bar; unsigned x; volatile LAS unsigned* st; };
DI XcdBarrier xcd_barrier_post(unsigned* bar, volatile LAS unsigned* st) {
    XcdBarrier b; b.bar = bar; b.x = xb_xcc_id(); b.st = st;
    if (threadIdx.x == 0) (void)xb_add(&bar[XB_XCNT(b.x)], 1u);
    return b;
}
DI void xcd_barrier_complete(unsigned* bar, unsigned x, unsigned& nloc, unsigned& nx) {
    const unsigned G = gridDim.x * gridDim.y * gridDim.z;
    unsigned sum, cnt, mine, sp = 0u;
    for (;;) {
        sum = 0u; cnt = 0u; mine = 0u;
#pragma unroll
        for (unsigned j = 0; j < 16; ++j) { const unsigned c = xb_ld(&bar[XB_XCNT(j)]); sum += c; cnt += (c > 0u) ? 1u : 0u; mine = (j == x) ? c : mine; }
        if (sum == G) break;
        __builtin_amdgcn_s_sleep(1);
        if ((++sp & 255u) == 0u) { if (xb_ld(&bar[XB_TMO])) break; if (sp > XB_SPIN_CAP) { atomicAdd(&bar[XB_TMO], 1u); break; } }
    }
    nloc = mine > 0u ? mine : 1u; nx = cnt > 0u ? cnt : 1u;
}
DI void xcd_barrier(const XcdBarrier& b) {
    asm volatile("s_waitcnt vmcnt(0)" ::: "memory");
    __syncthreads();
    if (threadIdx.x == 0) {
        unsigned* bar = b.bar;
        __builtin_amdgcn_s_waitcnt(0);
        unsigned nloc = b.st[0], nx = b.st[1];
        if (nloc == 0u) { xcd_barrier_complete(bar, b.x, nloc, nx); b.st[0] = nloc; b.st[1] = nx; }
        const unsigned old = xb_add(&bar[XB_XSUB(b.x)], 1u);
        const unsigned gen = old / nloc;
        if (old + 1u == (gen + 1u) * nloc) {
            __builtin_amdgcn_fence(__ATOMIC_RELEASE, "agent");
            asm volatile("s_waitcnt vmcnt(0)" ::: "memory");
            const unsigned og = xb_add(&bar[XB_TOP], 1u);
            const unsigned tg = og / nx;
            if (og + 1u == (tg + 1u) * nx) xb_add(&bar[XB_TOPGEN], 1u);
            else XB_SPIN(xb_ld(&bar[XB_TOPGEN]) == tg, bar);
            __builtin_amdgcn_fence(__ATOMIC_ACQUIRE, "agent");
            xb_add(&bar[XB_XGEN(b.x)], 1u);
            asm volatile("s_waitcnt vmcnt(0)" ::: "memory");
        } else {
            XB_SPIN(xb_ld(&bar[XB_XGEN(b.x)]) == gen, bar);
            __builtin_amdgcn_fence(__ATOMIC_ACQUIRE, "agent");
            asm volatile("s_waitcnt vmcnt(0)" ::: "memory");
        }
    }
    __syncthreads();
}

namespace pg8 {
constexpr int BM = 256, BK = 64, HALF = 128, HTB = HALF * BK * 2, STAGE_BYTES = 8 * HTB, NXCD = 8, WGM = 8;
DI int lds_byte(int r, int c) { const int st = (r >> 4) * 2 + (c >> 5), rr = r & 15, cc = c & 31, ob = rr * 64 + cc * 2; return st * 1024 + (ob ^ (((ob >> 9) & 1) << 5)); }
DI void stage_rc(int b, int& R, int& C) { const int st = b / 1024, sb = b % 1024, swz = sb ^ (((sb >> 9) & 1) << 5); R = (st >> 1) * 16 + swz / 64; C = (st & 1) * 32 + (swz % 64) / 2; }
DI int perm32(int rho) { const int n = rho >> 4, i = rho & 15; return 8 * (i >> 2) + 4 * n + (i & 3); }
struct Unit { int pm, pn, e; };

struct DenseOrder {
    const char* A; const char* Bt; int K, nM, nN, nwg, G, c;
    DI void init(const void* A_, const void* Bt_, int M, int N, int K_, int G_, int c_) { A = (const char*)A_; Bt = (const char*)Bt_; K = K_; nM = M / BM; nN = N / BM; nwg = nM * nN; G = G_; c = c_; }
    DI bool next(int i, Unit& u) const {
        const long L = (long)i * G + c; if (L >= nwg) return false;
        int wgid = (int)L; { const int q = nwg / NXCD, r = nwg % NXCD, xcd = wgid % NXCD, off = wgid / NXCD; wgid = (xcd < r ? xcd * (q + 1) : r * (q + 1) + (xcd - r) * q) + off; }
        const int nig = WGM * nN, gid = wgid / nig, fm = gid * WGM, gsz = (nM - fm) < WGM ? (nM - fm) : WGM;
        u.pm = fm + ((wgid % nig) % gsz); u.pn = (wgid % nig) / gsz; u.e = 0; return true;
    }
    DI const char* a_base(const Unit& u) const { return A + (size_t)u.pm * 512 * K; }
    DI const char* b_base(const Unit& u) const { return Bt + (size_t)u.pn * 512 * K; }
    DI void gather(const Unit&, const int (&)[2], const int (&)[2], unsigned (&)[2][2]) const {}
};
struct MoeOrder {
    const char* A; const char* Bt; const int* row_tok; const int* tile_e; int K, N, nunits, G, c; bool gat;
    DI bool next(int i, Unit& u) const {
        const int L = i * G + c; if (L >= nunits) return false;
        u.pm = L >> 2; u.pn = L & 3;
        u.e = __builtin_amdgcn_readfirstlane(__hip_atomic_load(tile_e + u.pm, __ATOMIC_RELAXED, __HIP_MEMORY_SCOPE_AGENT)); return true;
    }
    DI const char* a_base(const Unit& u) const { return gat ? A : A + (size_t)u.pm * 512 * K; }
    DI const char* b_base(const Unit& u) const { return Bt + ((size_t)u.e * N + (size_t)u.pn * 256) * K * 2; }
    DI void gather(const Unit& u, const int (&Rr)[2], const int (&Cc)[2], unsigned (&o)[2][2]) const {
#pragma unroll
        for (int h = 0; h < 2; ++h)
#pragma unroll
            for (int i = 0; i < 2; ++i) { const int tok = row_tok[u.pm * 256 + h * 128 + Rr[i]]; o[h][i] = (unsigned)(tok * K + Cc[i]) * 2u; }
    }
};

template <class Epi, class Sched, bool GATHER, bool FP8 = false>
DI void gemm_phase(LAS unsigned char* lds, const int K, const Sched& S, const Epi& E) {
    const int tid = threadIdx.x, wid = __builtin_amdgcn_readfirstlane(tid >> 6), lane = tid & 63, wr = wid >> 2, wc = wid & 3, fr = lane & 15, fq = lane >> 4;
    const int nt = K / BK;
    unsigned voffB[2], vA[2][2], nvA[2][2]; int Rr[2], Cc[2];
#pragma unroll
    for (int i = 0; i < 2; ++i) { int R, C; stage_rc(tid * 16 + i * 8192, R, C); Rr[i] = R; Cc[i] = C; const int Rb = (R & ~31) + perm32(R & 31);
        voffB[i] = (unsigned)(Rb * K + C) * 2u; vA[0][i] = (unsigned)(R * K + C) * 2u; vA[1][i] = (unsigned)((R + HALF) * K + C) * 2u; nvA[0][i] = vA[0][i]; nvA[1][i] = vA[1][i]; }
    const size_t kstep = (size_t)(BK * 2);
    const size_t hstep = (size_t)HALF * K * 2;
    const unsigned ldsw = (unsigned)wid * 1024u;
    const int aoff = lds_byte(wr * 64 + fr, fq * 8), boff = lds_byte(wc * 32 + fr, fq * 8);
#define PG8_SA(b, h) (((b) * 2 + (h)) * HTB)
#define PG8_SB(b, h) ((4 + (b) * 2 + (h)) * HTB)
#define PG8_STAGE(bufoff, gbase, voff) do { _Pragma("unroll") for (int _i = 0; _i < 2; ++_i) \
        __builtin_amdgcn_global_load_lds((const unsigned*)((const char*)(gbase) + (voff)[_i]), (LAS unsigned*)(lds + (bufoff) + ldsw + _i * 8192), 16, 0, 0); } while (0)
#define PG8_LDA(dst, b, h) do { if constexpr (FP8) { _Pragma("unroll") for (int m = 0; m < 4; ++m) dst##8[m] = __builtin_shufflevector(*(const LAS v4i*)(lds + PG8_SA(b, h) + aoff + m * 2048), *(const LAS v4i*)(lds + PG8_SA(b, h) + aoff + m * 2048 + 1024), 0, 1, 2, 3, 4, 5, 6, 7); } \
        else { _Pragma("unroll") for (int m = 0; m < 4; ++m) _Pragma("unroll") for (int k = 0; k < 2; ++k) dst[m][k] = *(const LAS bf16x8*)(lds + PG8_SA(b, h) + aoff + m * 2048 + k * 1024); } } while (0)
#define PG8_LDB(dst, b, h) do { if constexpr (FP8) { _Pragma("unroll") for (int n = 0; n < 2; ++n) dst##8[n] = __builtin_shufflevector(*(const LAS v4i*)(lds + PG8_SB(b, h) + boff + n * 2048), *(const LAS v4i*)(lds + PG8_SB(b, h) + boff + n * 2048 + 1024), 0, 1, 2, 3, 4, 5, 6, 7); } \
        else { _Pragma("unroll") for (int n = 0; n < 2; ++n) _Pragma("unroll") for (int k = 0; k < 2; ++k) dst[n][k] = *(const LAS bf16x8*)(lds + PG8_SB(b, h) + boff + n * 2048 + k * 1024); } } while (0)
#define PG8_CAT(x, y) __builtin_shufflevector(__builtin_bit_cast(v4i, (x)), __builtin_bit_cast(v4i, (y)), 0, 1, 2, 3, 4, 5, 6, 7)
#define PG8_MMA(ai, bj, At, Bt) do { __builtin_amdgcn_s_setprio(1); if constexpr (FP8) { _Pragma("unroll") for (int m = 0; m < 4; ++m) _Pragma("unroll") for (int n = 0; n < 2; ++n) \
        asm volatile("v_mfma_scale_f32_16x16x128_f8f6f4 %0, %1, %2, %0, %3, %3 op_sel_hi:[0,0,0]" : "+v"(acc[ai][bj][m][n]) : "v"(Bt##8[n]), "v"(At##8[m]), "v"(fp8_unit_scale)); } else { \
        _Pragma("unroll") for (int m = 0; m < 4; ++m) _Pragma("unroll") for (int n = 0; n < 2; ++n) _Pragma("unroll") for (int k = 0; k < 2; ++k) \
        acc[ai][bj][m][n] = __builtin_amdgcn_mfma_f32_16x16x32_bf16(Bt[n][k], At[m][k], acc[ai][bj][m][n], 0, 0, 0); } __builtin_amdgcn_s_setprio(0); } while (0)
#define PG8_WAIT_V(n) asm volatile("s_waitcnt vmcnt(" #n ")" ::: "memory")
#define PG8_WAIT_L(n) asm volatile("s_waitcnt lgkmcnt(" #n ")" ::: "memory")
#define PG8_BAR __builtin_amdgcn_s_barrier()
#define PG8_SCHED __builtin_amdgcn_sched_barrier(0)
    Unit cur, nxt; int ui = 0;
    if (!S.next(0, cur)) return;
    if constexpr (GATHER) S.gather(cur, Rr, Cc, vA);
    f32x4 acc[2][2][4][2];
#pragma unroll
    for (int a = 0; a < 2; ++a)
#pragma unroll
        for (int b = 0; b < 2; ++b)
#pragma unroll
            for (int m = 0; m < 4; ++m)
#pragma unroll
                for (int n = 0; n < 2; ++n) acc[a][b][m][n] = (f32x4){0.f, 0.f, 0.f, 0.f};
    bf16x8 At[4][2], B0[2][2], B1[2][2]; v8i At8[4], B08[2], B18[2]; const int fp8_unit_scale = 0x7f7f7f7f;
    const char* cA = S.a_base(cur); const char* cB = S.b_base(cur);
    PG8_STAGE(PG8_SB(0, 0), cB, voffB); PG8_STAGE(PG8_SB(0, 1), cB + hstep, voffB); PG8_STAGE(PG8_SA(0, 0), cA, vA[0]); PG8_STAGE(PG8_SA(0, 1), cA, vA[1]);
    if (wr == 1) PG8_BAR;
    PG8_WAIT_V(2); PG8_BAR;
    PG8_STAGE(PG8_SB(1, 0), cB + kstep, voffB); PG8_STAGE(PG8_SA(1, 0), cA + kstep, vA[0]); PG8_STAGE(PG8_SB(1, 1), cB + hstep + kstep, voffB);
    PG8_WAIT_V(6); PG8_BAR;
    for (;;) {
        const bool has_next = S.next(ui + 1, nxt);
        const char* nA = has_next ? S.a_base(nxt) : cA; const char* nB = has_next ? S.b_base(nxt) : cB;
        if constexpr (GATHER) {
            if (has_next) S.gather(nxt, Rr, Cc, nvA);
            else {
#pragma unroll
                for (int h = 0; h < 2; ++h) { nvA[h][0] = vA[h][0]; nvA[h][1] = vA[h][1]; } }
        }
#pragma unroll 1
        for (int t = 0; t < nt; t += 2) {
            const bool last = (t == nt - 2);
            if constexpr (Epi::HAS_MID) { if (t == (nt >> 1)) { if constexpr (FP8) asm volatile("s_nop 15\n\ts_nop 15" ::: "memory"); E.mid(acc, cur, wr, wc, fr, fq); if constexpr (FP8) asm volatile("s_nop 7" ::: "memory"); } }
            const char* a1 = cA + (size_t)(t + 1) * kstep;
            const char* a2 = last ? nA : cA + (size_t)(t + 2) * kstep; const char* b2 = last ? nB : cB + (size_t)(t + 2) * kstep;
            const char* a3 = a2 + kstep; const char* b3 = b2 + kstep;
            unsigned o0[2], o1[2];
            if constexpr (GATHER) { o0[0] = last ? nvA[0][0] : vA[0][0]; o0[1] = last ? nvA[0][1] : vA[0][1]; o1[0] = last ? nvA[1][0] : vA[1][0]; o1[1] = last ? nvA[1][1] : vA[1][1]; }
            else { o0[0] = vA[0][0]; o0[1] = vA[0][1]; o1[0] = vA[1][0]; o1[1] = vA[1][1]; }
            PG8_LDB(B0, 0, 0); PG8_LDB(B1, 0, 1); PG8_SCHED; PG8_LDA(At, 0, 0); PG8_STAGE(PG8_SA(1, 1), a1, vA[1]);
            PG8_WAIT_V(8); PG8_WAIT_L(0); PG8_BAR; PG8_MMA(0, 0, At, B0); PG8_MMA(0, 1, At, B1); PG8_BAR; PG8_SCHED;
            PG8_LDA(At, 0, 1); PG8_STAGE(PG8_SB(0, 0), b2, voffB); PG8_STAGE(PG8_SB(0, 1), b2 + hstep, voffB); PG8_STAGE(PG8_SA(0, 0), a2, o0);
            PG8_WAIT_V(8); PG8_WAIT_L(0); PG8_BAR; PG8_MMA(1, 0, At, B0); PG8_MMA(1, 1, At, B1); PG8_BAR; PG8_SCHED;
            PG8_LDB(B0, 1, 0); PG8_LDB(B1, 1, 1); PG8_SCHED; PG8_LDA(At, 1, 0); PG8_STAGE(PG8_SA(0, 1), a2, o1);
            PG8_WAIT_V(8); PG8_WAIT_L(0); PG8_BAR; PG8_MMA(0, 0, At, B0); PG8_MMA(0, 1, At, B1); PG8_BAR; PG8_SCHED;
            PG8_LDA(At, 1, 1); PG8_STAGE(PG8_SB(1, 0), b3, voffB); PG8_STAGE(PG8_SB(1, 1), b3 + hstep, voffB); PG8_STAGE(PG8_SA(1, 0), a3, o0);
            PG8_WAIT_V(8); PG8_WAIT_L(0); PG8_BAR; PG8_MMA(1, 0, At, B0); PG8_MMA(1, 1, At, B1); PG8_BAR; PG8_SCHED;
        }
        if (wr == 0) PG8_BAR;
        if constexpr (FP8) asm volatile("s_nop 15\n\ts_nop 15" ::: "memory");
        E(acc, cur, wr, wc, fr, fq);
        if (!has_next) break;
#pragma unroll
        for (int a = 0; a < 2; ++a)
#pragma unroll
            for (int b = 0; b < 2; ++b)
#pragma unroll
                for (int m = 0; m < 4; ++m)
#pragma unroll
                    for (int n = 0; n < 2; ++n) acc[a][b][m][n] = (f32x4){0.f, 0.f, 0.f, 0.f};
        cur = nxt; cA = nA; cB = nB; ++ui;
        if constexpr (GATHER) {
#pragma unroll
            for (int h = 0; h < 2; ++h) { vA[h][0] = nvA[h][0]; vA[h][1] = nvA[h][1]; } }
        if (wr == 1) PG8_BAR;
    }
    PG8_WAIT_V(0);
    PG8_BAR;
#undef PG8_SA
#undef PG8_SB
#undef PG8_STAGE
#undef PG8_LDA
#undef PG8_LDB
#undef PG8_MMA
#undef PG8_CAT
#undef PG8_WAIT_V
#undef PG8_WAIT_L
#undef PG8_BAR
#undef PG8_SCHED
}

typedef f32x4 Acc[2][2][4][2];
DI u32x4 pack8(const f32x4 a, const f32x4 b) { u32x4 w; w.x = cvtpk(a[0], a[1]); w.y = cvtpk(a[2], a[3]); w.z = cvtpk(b[0], b[1]); w.w = cvtpk(b[2], b[3]); return w; }
DI f32x4 silu4(const f32x4 v) { f32x4 o; o[0] = v[0] * fsigmoid(v[0]); o[1] = v[1] * fsigmoid(v[1]); o[2] = v[2] * fsigmoid(v[2]); o[3] = v[3] * fsigmoid(v[3]); return o; }

struct EpiIn {
    static constexpr bool HAS_MID = false;
    bf16 *Qh, *Vh, *Gh, *Qm, *Km, *Vm, *Rr, *Gb; float *Zf, *KM; const float* bias; bf16* KK; const float* LB;
    DI void operator()(Acc& acc, const Unit& u, int wr, int wc, int fr, int fq) const {
        const int pn = u.pn, row0 = u.pm * BM + wr * 64 + fr, cl = wc * 32 + 8 * fq;
        f32x4 bv[2][2];
#pragma unroll
        for (int bj = 0; bj < 2; ++bj)
#pragma unroll
            for (int n = 0; n < 2; ++n) bv[bj][n] = *(const f32x4*)(bias + pn * 256 + bj * HALF + cl + 4 * n);
        if (pn < 4) {
#define EI_DPP(v, ctrl) __int_as_float(__builtin_amdgcn_update_dpp(0, __float_as_int(v), ctrl, 0xf, 0xf, true))
            const int chb = pn * 128 + cl;
#pragma unroll
            for (int ai = 0; ai < 2; ++ai)
#pragma unroll
                for (int n = 0; n < 2; ++n) { const f32x4 lbv = *(const f32x4*)(LB + chb + 4 * n); f32x4 run = (f32x4){0.f, 0.f, 0.f, 0.f}, bmid = run; f32x4 bbv[4], kkv[4];
#pragma unroll
                    for (int m = 0; m < 4; ++m) {
#pragma unroll
                        for (int j = 0; j < 4; ++j) { const float z = acc[ai][1][m][n][j] + bv[1][n][j]; const float sg = frcp(1.f + __expf(-z)); const float lf = __logf(lbv[j] + (1.f - lbv[j]) * sg); kkv[m][j] = (1.f - lbv[j]) * (1.f - sg);
                            float t = lf; t += EI_DPP(t, 0xB1); t += EI_DPP(t, 0x4E); t += EI_DPP(t, 0x141); t += EI_DPP(t, 0x140);
                            float s = lf; s += EI_DPP(s, 0x111); s += EI_DPP(s, 0x112); s += EI_DPP(s, 0x114); s += EI_DPP(s, 0x118);
                            bbv[m][j] = s + run[j]; run[j] += t; }
                        if (m == 1) bmid = run; }
#pragma unroll
                    for (int m = 0; m < 4; ++m) { f32x4 qp, kp;
#pragma unroll
                        for (int j = 0; j < 4; ++j) { const float qx = acc[ai][0][m][n][j] + bv[0][n][j]; const float e = __expf(bbv[m][j] - bmid[j]); qp[j] = qx * fsigmoid(qx) * e; kp[j] = kkv[m][j] * frcp(e); }
                        const size_t ro = (size_t)(row0 + ai * HALF + m * 16) * 512 + chb + 4 * n;
                        u32x2 qw, kw; qw.x = cvtpk(qp[0], qp[1]); qw.y = cvtpk(qp[2], qp[3]); kw.x = cvtpk(kp[0], kp[1]); kw.y = cvtpk(kp[2], kp[3]);
                        *(u32x2*)(Qh + ro) = qw; *(u32x2*)(KK + ro) = kw; }
                    if (fr == 0) { const size_t so = (size_t)(u.pm * 4 + ai * 2 + wr) * 512 + chb + 4 * n; *(f32x4*)(Zf + so) = bmid; *(f32x4*)(Zf + 262144 + so) = run; }
                    asm volatile("" ::: "memory"); }
#undef EI_DPP
        } else if (pn < 14) {
            const int seg = pn >> 1, c0 = (pn & 1) * 256 + cl;
            {
                bf16* O = seg == 2 ? Vh : seg == 3 ? Gh : seg == 4 ? Qm : seg == 5 ? Km : Vm;
                const int act = (seg == 3) ? 1 : (seg == 4 ? 2 : 0);
                if (seg == 5) {
#pragma unroll
                    for (int bj = 0; bj < 2; ++bj)
#pragma unroll
                        for (int n = 0; n < 2; ++n) { f32x4 cs = (f32x4){0.f, 0.f, 0.f, 0.f};
#pragma unroll
                            for (int ai = 0; ai < 2; ++ai)
#pragma unroll
                                for (int m = 0; m < 4; ++m) cs += acc[ai][bj][m][n] + bv[bj][n];
#pragma unroll
                            for (int j = 0; j < 4; ++j) { float s = cs[j]; s += __shfl_xor(s, 1); s += __shfl_xor(s, 2); s += __shfl_xor(s, 4); s += __shfl_xor(s, 8); cs[j] = s; }
                            if (fr == 0) *(f32x4*)(KM + (size_t)(u.pm * 2 + wr) * 512 + c0 + bj * HALF + 4 * n) = cs; }
                }
#pragma unroll
                for (int ai = 0; ai < 2; ++ai)
#pragma unroll
                    for (int m = 0; m < 4; ++m) { const int row = row0 + ai * HALF + m * 16;
                        bf16* rp = (seg >= 4) ? O + ((size_t)(row >> 11) * 8 * SEQ + (row & (SEQ - 1))) * 64 + (size_t)(c0 >> 6) * SEQ * 64 + (c0 & 63) : O + (size_t)row * 512 + c0;
                        const size_t bjs = (seg >= 4) ? (size_t)2 * SEQ * 64 : (size_t)HALF;
#pragma unroll
                        for (int bj = 0; bj < 2; ++bj) { f32x4 v0 = acc[ai][bj][m][0] + bv[bj][0], v1 = acc[ai][bj][m][1] + bv[bj][1];
                            if (act == 1) { v0 = silu4(v0); v1 = silu4(v1); } else if (act == 2) { v0 = v0 * (0.125f * LOG2E); v1 = v1 * (0.125f * LOG2E); }
                            *(u32x4*)(rp + bj * bjs) = pack8(v0, v1); }
                        asm volatile("" ::: "memory"); }
            }
        } else {
            const int c0 = (pn - 14) * 128 + cl;
#pragma unroll
            for (int ai = 0; ai < 2; ++ai)
#pragma unroll
                for (int m = 0; m < 4; ++m) { const size_t off = (size_t)(row0 + ai * HALF + m * 16) * 1024 + c0; f32x4 r[2], g[2];
#pragma unroll
                    for (int n = 0; n < 2; ++n) { const f32x4 a = acc[ai][0][m][n] + bv[0][n], b = acc[ai][1][m][n] + bv[1][n];
#pragma unroll
                        for (int j = 0; j < 4; ++j) { const float ea = __expf(-a[j]), eb = __expf(-b[j]); g[n][j] = frcp(1.f + eb); r[n][j] = (1.f + eb) * frcp(1.f + ea); } }
                    *(u32x4*)(Rr + off) = pack8(r[0], r[1]); *(u32x4*)(Gb + off) = pack8(g[0], g[1]); asm volatile("" ::: "memory"); }
        }
    }
};
struct EpiProj {
    static constexpr bool HAS_MID = true;
    const bf16 *Rr, *Gb; unsigned char* U;
    DI void scale(Acc& acc, const bf16* G, const Unit& u, int wr, int wc, int fr, int fq) const {
        int row0 = u.pm * BM + wr * 64 + fr, col0 = u.pn * BM + wc * 32 + 8 * fq;
        asm volatile("" : "+v"(row0), "+v"(col0));
#pragma unroll
        for (int ai = 0; ai < 2; ++ai)
#pragma unroll
            for (int mp = 0; mp < 2; ++mp) { u32x4 rv[2][2];
#pragma unroll
            for (int m = 0; m < 2; ++m)
#pragma unroll
                for (int bj = 0; bj < 2; ++bj) rv[m][bj] = *(const u32x4*)(G + (size_t)(row0 + ai * HALF + (2 * mp + m) * 16) * 1024 + col0 + bj * HALF);
#pragma unroll
            for (int m = 0; m < 2; ++m)
#pragma unroll
                for (int bj = 0; bj < 2; ++bj) { const u32x4 w = rv[m][bj];
                    acc[ai][bj][2 * mp + m][0] *= (f32x4){bflo(w.x), bfhi(w.x), bflo(w.y), bfhi(w.y)}; acc[ai][bj][2 * mp + m][1] *= (f32x4){bflo(w.z), bfhi(w.z), bflo(w.w), bfhi(w.w)}; }
            asm volatile("" ::: "memory"); }
    }
    DI void mid(Acc& acc, const Unit& u, int wr, int wc, int fr, int fq) const { scale(acc, Rr, u, wr, wc, fr, fq); }
    DI void operator()(Acc& acc, const Unit& u, int wr, int wc, int fr, int fq) const {
        scale(acc, Gb, u, wr, wc, fr, fq);
        const int row0 = u.pm * BM + wr * 64 + fr, col0 = u.pn * BM + wc * 32 + 8 * fq;
        constexpr float inv = FP8_SU / (FP8_SO * FP8_SW);
#pragma unroll
        for (int ai = 0; ai < 2; ++ai)
#pragma unroll
            for (int m = 0; m < 4; ++m) { unsigned char* rp = U + (size_t)(row0 + ai * HALF + m * 16) * 1024 + col0;
#pragma unroll
                for (int bj = 0; bj < 2; ++bj) { const f32x4 v0 = acc[ai][bj][m][0] * inv, v1 = acc[ai][bj][m][1] * inv; u32x2 w; w.x = cvt4_fp8(v0[0], v0[1], v0[2], v0[3]); w.y = cvt4_fp8(v1[0], v1[1], v1[2], v1[3]); *(u32x2*)(rp + bj * HALF) = w; } }
    }
};
struct EpiOut {
    static constexpr bool HAS_MID = false;
    const float* X; float* Pre;
    DI void operator()(Acc& acc, const Unit& u, int wr, int wc, int fr, int fq) const {
        const int row0 = u.pm * BM + wr * 64 + fr, col0 = u.pn * BM + wc * 32 + 8 * fq;
#pragma unroll
        for (int ai = 0; ai < 2; ++ai)
#pragma unroll
            for (int m = 0; m < 4; ++m) { const size_t off = (size_t)(row0 + ai * HALF + m * 16) * 1024 + col0;
#pragma unroll
                for (int bj = 0; bj < 2; ++bj) { const f32x4 x0 = *(const f32x4*)(X + off + bj * HALF), x1 = *(const f32x4*)(X + off + bj * HALF + 4);
                    *(f32x4*)(Pre + off + bj * HALF) = x0 * DN_ALPHA + acc[ai][bj][m][0] * (1.f / (FP8_SU * FP8_SW)); *(f32x4*)(Pre + off + bj * HALF + 4) = x1 * DN_ALPHA + acc[ai][bj][m][1] * (1.f / (FP8_SU * FP8_SW)); }
                if (m & 1) asm volatile("" ::: "memory"); }
    }
};
struct EpiM1 {
    static constexpr bool HAS_MID = false;
    unsigned char* H;
    DI void operator()(Acc& acc, const Unit& u, int wr, int wc, int fr, int fq) const {
        const int row0 = u.pm * BM + wr * 64 + fr, col0 = u.pn * 128 + wc * 32 + 8 * fq;
        constexpr float inv = 1.f / (FP8_SX * FP8_SW);
#pragma unroll
        for (int ai = 0; ai < 2; ++ai)
#pragma unroll
            for (int m = 0; m < 4; ++m) { const f32x4 h0 = silu4(acc[ai][0][m][0] * inv) * (acc[ai][1][m][0] * (inv * FP8_SH)), h1 = silu4(acc[ai][0][m][1] * inv) * (acc[ai][1][m][1] * (inv * FP8_SH));
                u32x2 w; w.x = cvt4_fp8(h0[0], h0[1], h0[2], h0[3]); w.y = cvt4_fp8(h1[0], h1[1], h1[2], h1[3]);
                *(u32x2*)(H + (size_t)(row0 + ai * HALF + m * 16) * 512 + col0) = w; }
    }
};
struct EpiM2 {
    static constexpr bool HAS_MID = false;
    bf16* Y;
    DI void operator()(Acc& acc, const Unit& u, int wr, int wc, int fr, int fq) const {
        const int row0 = u.pm * BM + wr * 64 + fr, col0 = u.pn * BM + wc * 32 + 8 * fq;
        constexpr float inv = 1.f / (FP8_SH * FP8_SW);
#pragma unroll
        for (int ai = 0; ai < 2; ++ai)
#pragma unroll
            for (int m = 0; m < 4; ++m) { bf16* rp = Y + (size_t)(row0 + ai * HALF + m * 16) * 1024 + col0;
#pragma unroll
                for (int bj = 0; bj < 2; ++bj) *(u32x4*)(rp + bj * HALF) = pack8(acc[ai][bj][m][0] * inv, acc[ai][bj][m][1] * inv); }
    }
};
}

struct Args { const float* in[19]; float* out; unsigned char* ws; int ph_lo, ph_hi; };
enum { I_X = 0, I_WIN, I_BIN, I_LBL, I_HGNG, I_RELB, I_WPA, I_WPB, I_WOUT, I_LN1G, I_LN1B, I_WGRP, I_BGRP, I_WEXP, I_BEXP, I_WGU, I_WDN, I_LN2G, I_LN2B };

struct Ctx {
    LAS unsigned char* lds; volatile LAS unsigned* MISC;
    int tid, lane, wid, G, vcu;
    unsigned char* ws; gu32* ctl;
};

DI int win_drow(int n0) { if (n0 < 512) return 256 * (n0 >> 7) + (n0 & 127); if (n0 < 1024) { const int r = n0 - 512; return 256 * (r >> 7) + 128 + (r & 127); }
    if (n0 < 3584) return n0; if (n0 < 4608) { const int r = n0 - 3584; return 3584 + 256 * (r >> 7) + (r & 127); } const int r = n0 - 4608; return 3584 + 256 * (r >> 7) + 128 + (r & 127); }
DI int wgu_drow(int n0) { if (n0 < 512) return 256 * (n0 >> 7) + (n0 & 127); const int r = n0 - 512; return 256 * (r >> 7) + 128 + (r & 127); }
DI int hswz(int row, int ch16) { return 256 * row + 16 * (ch16 ^ (((row & 3) << 2) | ((row >> 2) & 3))); }
DI int htr(int r0, int c0, int lane) { const int i16 = lane & 15, q = i16 >> 2, p = i16 & 3; return hswz(r0 + q, c0 + (p >> 1)) + 8 * (p & 1); }
DI void transpose_tile256(const float* W, int N, bf16* WT, int ldk, int n0, int mode, int dk, LAS unsigned char* lds, int lane, int wid, bool f8 = false) {
    asm volatile("" : "+v"(lane));
#pragma unroll
    for (int half = 0; half < 2; ++half) { f32x4 v[16];
#pragma unroll
        for (int i = 0; i < 16; ++i) v[i] = *(const f32x4*)(W + (size_t)(128 * half + 8 * i + wid) * N + 4 * lane);
#pragma unroll
        for (int i = 0; i < 16; ++i) { const int k = 128 * half + 8 * i + wid; u32x2 w; w.x = cvtpk(v[i][0], v[i][1]); w.y = cvtpk(v[i][2], v[i][3]);
            *(LAS u32x2*)(lds + (lane >> 5) * 65536 + hswz(k, (lane & 31) >> 1) + 8 * (lane & 1)) = w; } }
    __syncthreads();
    const int g = lane >> 4, i16 = lane & 15;
#pragma unroll
    for (int nb = 0; nb < 2; ++nb) { const int nl = 32 * wid + 16 * nb + i16, n = n0 + nl; const int dr = (mode == 0) ? n : (mode == 1 ? win_drow(n) : wgu_drow(n));
        bf16* orow = WT + (size_t)dr * ldk + dk + 8 * g; const LAS unsigned char* img = lds + (wid >> 2) * 65536;
#pragma unroll
        for (int s = 0; s < 8; ++s) { const int r0 = 32 * s + 8 * g, c0 = 4 * (wid & 3) + 2 * nb;
            const s16x4 lo = vtr((LAS const char*)(img + htr(r0, c0, lane))), hh = vtr((LAS const char*)(img + htr(r0 + 4, c0, lane)));
            if (f8) { u32x2 w; w.x = cvt4_fp8(bf2f((unsigned short)lo[0]) * FP8_SW, bf2f((unsigned short)lo[1]) * FP8_SW, bf2f((unsigned short)lo[2]) * FP8_SW, bf2f((unsigned short)lo[3]) * FP8_SW);
                w.y = cvt4_fp8(bf2f((unsigned short)hh[0]) * FP8_SW, bf2f((unsigned short)hh[1]) * FP8_SW, bf2f((unsigned short)hh[2]) * FP8_SW, bf2f((unsigned short)hh[3]) * FP8_SW);
                *(u32x2*)((unsigned char*)WT + (size_t)dr * ldk + dk + 8 * g + 32 * s) = w; }
            else *(bf16x8*)(orow + 32 * s) = (bf16x8){lo[0], lo[1], lo[2], lo[3], hh[0], hh[1], hh[2], hh[3]}; } }
    __syncthreads();
}
constexpr int MOE_CVT_TILES = 32 * 16 + 32 * 8;
DI void moe_cvt_tile(const Ctx& C, const Args& a, int it) {
    unsigned char* WguT = (unsigned char*)a.out; unsigned char* WdT = (unsigned char*)a.out + 32 * MiB;
    if (it < 512) { const int e = it >> 4, kt = (it >> 2) & 3, nt = it & 3;
        transpose_tile256(a.in[I_WGU] + (size_t)e * 1024 * 1024 + (size_t)(256 * kt) * 1024 + 256 * nt, 1024, (bf16*)(WguT + (size_t)e * 1024 * 1024), 1024, 256 * nt, 2, 256 * kt, C.lds, C.lane, C.wid, true); }
    else { const int r = it - 512, e = r >> 3, kt = (r >> 2) & 1, nt = r & 3;
        transpose_tile256(a.in[I_WDN] + (size_t)e * 512 * 1024 + (size_t)(256 * kt) * 1024 + 256 * nt, 1024, (bf16*)(WdT + (size_t)e * 1024 * 512), 512, 256 * nt, 0, 256 * kt, C.lds, C.lane, C.wid, true); }
}
DI void p0_prologue(const Ctx& C, const Args& a) {
    bf16* WinT = (bf16*)(C.ws + WS_WIN); bf16* Wcat = (bf16*)(C.ws + WS_WCAT); bf16* WoT = (bf16*)(C.ws + WS_WO);
    constexpr int I_IN = 4 * 22, I_PA = 2 * 4, I_O = 4 * 4, NITEMS = I_IN + 2 * I_PA + I_O;
    for (int it = C.vcu; it < NITEMS; it += C.G) {
        int r = it;
        if (r < I_IN) { const int kt = r / 22, nt = r % 22; transpose_tile256(a.in[I_WIN] + (size_t)(256 * kt) * NIN + 256 * nt, NIN, WinT, 1024, 256 * nt, 1, 256 * kt, C.lds, C.lane, C.wid); continue; } r -= I_IN;
        if (r < I_PA) { const int kt = r / 4, nt = r % 4; transpose_tile256(a.in[I_WPA] + (size_t)(256 * kt) * 1024 + 256 * nt, 1024, Wcat, 1024, 256 * nt, 0, 256 * kt, C.lds, C.lane, C.wid, true); continue; } r -= I_PA;
        if (r < I_PA) { const int kt = r / 4, nt = r % 4; transpose_tile256(a.in[I_WPB] + (size_t)(256 * kt) * 1024 + 256 * nt, 1024, Wcat, 1024, 256 * nt, 0, 512 + 256 * kt, C.lds, C.lane, C.wid, true); continue; } r -= I_PA;
        { const int kt = r / 4, nt = r % 4; transpose_tile256(a.in[I_WOUT] + (size_t)(256 * kt) * 1024 + 256 * nt, 1024, WoT, 1024, 256 * nt, 0, 256 * kt, C.lds, C.lane, C.wid, true); }
    }
    const int gw = C.vcu * NWAVES + C.wid, NGW = C.G * NWAVES; (void)gw; (void)NGW;
    const int gt = C.vcu * NTHREADS + C.tid, NT = C.G * NTHREADS;
    { const float* x = a.in[I_X]; bf16* Xb = (bf16*)(C.ws + WS_XB);
      for (int i = gt; i < NTOK * DM / 8; i += NT) { const f32x4 v0 = *(const f32x4*)(x + (size_t)i * 8), v1 = *(const f32x4*)(x + (size_t)i * 8 + 4); *(u32x4*)(Xb + (size_t)i * 8) = pg8::pack8(v0, v1); } }
    { float* lbp = (float*)(C.ws + WS_LB); for (int n = gt; n < 512; n += NT) lbp[n] = 1.f / (1.f + expf(a.in[I_LBL][512 + n] - a.in[I_LBL][n])); }
    { float* bp = (float*)(C.ws + WS_BPERM); const float* bin = a.in[I_BIN];
      for (int n = gt; n < NIN; n += NT) bp[win_drow(n & ~31) + (n & 31)] = bin[n]; }
    { bf16* wh = (bf16*)(C.ws + WS_WRH); bf16* wl = (bf16*)(C.ws + WS_WRL); const float* wg = a.in[I_WGRP]; const float* we = a.in[I_WEXP];
      for (int i = gt; i < 48 * 1024; i += NT) { const int j = i >> 10, k = i & 1023; float w = 0.f; if (j < 4) w = wg[k * 4 + j]; else if (j < 36) w = we[k * 32 + (j - 4)];
          const unsigned h = cvtpk(w, 0.f) & 0xffffu; const float r = w - bf2f((unsigned short)h); wh[i] = (bf16)h; wl[i] = (bf16)(cvtpk(r, 0.f) & 0xffffu); } }
}
constexpr int HG_BUF = 67072, HG_QP = 0, HG_KP = 16384, HG_V = 32768, HG_SC = 49152, HG_OB = 49664;
DI void hgrn_unit(const Ctx& C, const Args& a, int b, int h) {
    LAS unsigned char* L = C.lds;
    const int tid = C.tid, lane = C.lane, wid = C.wid;
    const int q32 = lane & 31, hi = lane >> 5, dh = (lane >> 4) & 1, dvb = wid & 3, tb = wid >> 2;
    const float* BM = (const float*)(C.ws + WS_ZF); const float* BE = BM + 262144;
    const bf16* Qh = (const bf16*)(C.ws + WS_QH); const bf16* Kh = (const bf16*)(C.ws + WS_KK); const bf16* Vh = (const bf16*)(C.ws + WS_VH); const bf16* Gh = (const bf16*)(C.ws + WS_GH);
    bf16* Ocat = (bf16*)(C.ws + WS_XB);
    const size_t rb = (size_t)b * SEQ;
    LAS float* NGS = (LAS float*)(L + 2 * HG_BUF);
    if (tid < 128) NGS[tid] = a.in[I_HGNG][h * 128 + tid];
    const int orow = tid >> 3, oseg = tid & 7;
    f32x16 T[4];
#pragma unroll
    for (int i = 0; i < 4; ++i)
#pragma unroll
        for (int r = 0; r < 16; ++r) T[i][r] = 0.f;
    u32x4 gr[2];
    const int drow = 8 * wid + (lane >> 4), dch = lane & 15;
#define HG_DMA(c) do { _Pragma("unroll") for (int p = 0; p < 2; ++p) { const int r_ = drow + 4 * p; const int sc_ = dch ^ (((r_ & 3) << 2) | ((r_ >> 2) & 3)); \
            const size_t g_ = (rb + (size_t)(c) * 64 + r_) * 512 + h * 128 + 8 * sc_; LAS unsigned char* d_ = L + ((c) & 1) * HG_BUF + (8 * wid + 4 * p) * 256; \
            __builtin_amdgcn_global_load_lds((const unsigned*)(Qh + g_), (LAS unsigned*)(d_ + HG_QP), 16, 0, 0); \
            __builtin_amdgcn_global_load_lds((const unsigned*)(Kh + g_), (LAS unsigned*)(d_ + HG_KP), 16, 0, 0); \
            __builtin_amdgcn_global_load_lds((const unsigned*)(Vh + g_), (LAS unsigned*)(d_ + HG_V), 16, 0, 0); } } while (0)
    float sm = 0.f, spe = 0.f, spm = 0.f;
#define HG_SCLOAD(c) do { if (tid < 128) { const size_t s_ = (size_t)(b * 32 + (c)) * 512 + h * 128 + tid; sm = BM[s_]; if ((c) > 0) { spe = BE[s_ - 512]; spm = BM[s_ - 512]; } } } while (0)
#define HG_SCALE(c) do { if (tid < 128) ((LAS float*)(L + ((c) & 1) * HG_BUF + HG_SC))[tid] = __expf(sm + (spe - spm)); } while (0)
    HG_DMA(0);
    HG_SCLOAD(0);
    HG_SCALE(0);
    asm volatile("s_waitcnt vmcnt(0)" ::: "memory");
    __syncthreads();
    for (int c = 0; c < 32; ++c) {
        const LAS unsigned char* B = L + (c & 1) * HG_BUF;
        if (c + 1 < 32) { HG_DMA(c + 1); HG_SCLOAD(c + 1); }
        int q32o = q32, hio = hi, laneo = lane; asm volatile("" : "+v"(q32o), "+v"(hio), "+v"(laneo));
        f32x16 oT;
#pragma unroll
        for (int r = 0; r < 16; ++r) oT[r] = 0.f;
        bf16x8 qb[8];
#pragma unroll
        for (int ks = 0; ks < 8; ++ks) qb[ks] = *(const LAS bf16x8*)(B + HG_QP + hswz(32 * tb + q32o, 2 * ks + hio));
#pragma unroll
        for (int sb = 0; sb < 2; ++sb) {
            if (sb <= tb) {
                bf16x8 ka[8];
#pragma unroll
                for (int ks = 0; ks < 8; ++ks) ka[ks] = *(const LAS bf16x8*)(B + HG_KP + hswz(32 * sb + q32o, 2 * ks + hio));
                s16x4 vl[2], vh[2];
#pragma unroll
                for (int s2 = 0; s2 < 2; ++s2) { const int r0 = 32 * sb + 16 * s2 + 4 * hio; vl[s2] = vtr((LAS const char*)(B + HG_V + htr(r0, 4 * dvb + 2 * dh, laneo))); vh[s2] = vtr((LAS const char*)(B + HG_V + htr(r0 + 8, 4 * dvb + 2 * dh, laneo))); }
                __builtin_amdgcn_sched_barrier(0);
                f32x16 pT;
#pragma unroll
                for (int r = 0; r < 16; ++r) pT[r] = 0.f;
#pragma unroll
                for (int ks = 0; ks < 8; ++ks) pT = MFMA32(ka[ks], qb[ks], pT);
                if (sb == tb) {
#pragma unroll
                    for (int r = 0; r < 16; ++r) if (crow(r, hi) > q32) pT[r] = 0.f;
                }
#pragma unroll
                for (int s2 = 0; s2 < 2; ++s2) { u32x4 pw; pw.x = cvtpk(pT[8 * s2 + 0], pT[8 * s2 + 1]); pw.y = cvtpk(pT[8 * s2 + 2], pT[8 * s2 + 3]); pw.z = cvtpk(pT[8 * s2 + 4], pT[8 * s2 + 5]); pw.w = cvtpk(pT[8 * s2 + 6], pT[8 * s2 + 7]);
                    oT = MFMA32(((bf16x8){vl[s2][0], vl[s2][1], vl[s2][2], vl[s2][3], vh[s2][0], vh[s2][1], vh[s2][2], vh[s2][3]}), __builtin_bit_cast(bf16x8, pw), oT); }
                __builtin_amdgcn_sched_barrier(0);
            }
        }
        { const size_t g0 = (rb + (size_t)c * 64 + orow) * 512 + h * 128 + 16 * oseg; gr[0] = *(const u32x4*)(Gh + g0); gr[1] = *(const u32x4*)(Gh + g0 + 8); }
        {
            u32x2 qq0[8], qq1[8];
            if (c > 0) {
#pragma unroll
                for (int i = 0; i < 4; ++i)
#pragma unroll
                    for (int s = 0; s < 2; ++s) { qq0[2 * i + s] = *(const LAS u32x2*)(B + HG_QP + hswz(32 * tb + q32o, 4 * i + 2 * s) + 8 * hio); qq1[2 * i + s] = *(const LAS u32x2*)(B + HG_QP + hswz(32 * tb + q32o, 4 * i + 2 * s + 1) + 8 * hio); }
            }
#pragma unroll
            for (int i = 0; i < 4; ++i)
#pragma unroll
                for (int g = 0; g < 4; ++g) { const f32x4 sc = *(const LAS f32x4*)(B + HG_SC + (32 * i + 8 * g + 4 * hio) * 4);
#pragma unroll
                    for (int j = 0; j < 4; ++j) T[i][4 * g + j] *= sc[j]; }
            __builtin_amdgcn_sched_barrier(0);
            if (c > 0) {
#pragma unroll
                for (int i = 0; i < 4; ++i)
#pragma unroll
                    for (int s = 0; s < 2; ++s) { u32x4 tw; tw.x = cvtpk(T[i][8 * s + 0], T[i][8 * s + 1]); tw.y = cvtpk(T[i][8 * s + 2], T[i][8 * s + 3]); tw.z = cvtpk(T[i][8 * s + 4], T[i][8 * s + 5]); tw.w = cvtpk(T[i][8 * s + 6], T[i][8 * s + 7]);
                        const u32x4 qw = (u32x4){qq0[2 * i + s].x, qq0[2 * i + s].y, qq1[2 * i + s].x, qq1[2 * i + s].y};
                        oT = MFMA32(__builtin_bit_cast(bf16x8, tw), __builtin_bit_cast(bf16x8, qw), oT); }
            }
        }
        { LAS unsigned char* OBp = L + (c & 1) * HG_BUF + HG_OB;
#pragma unroll
          for (int g = 0; g < 4; ++g) { u32x2 w; w.x = cvtpk(oT[4 * g], oT[4 * g + 1]); w.y = cvtpk(oT[4 * g + 2], oT[4 * g + 3]); *(LAS u32x2*)(OBp + (32 * tb + q32o) * 272 + (32 * dvb + 8 * g + 4 * hio) * 2) = w; } }
#pragma unroll
        for (int sp = 0; sp < 2; ++sp) {
            s16x4 vl[2], vh[2], kl[2][4], kh[2][4];
#pragma unroll
            for (int u = 0; u < 2; ++u) { const int r0 = 16 * (2 * sp + u) + 8 * hio;
                vl[u] = vtr((LAS const char*)(B + HG_V + htr(r0, 4 * dvb + 2 * dh, laneo))); vh[u] = vtr((LAS const char*)(B + HG_V + htr(r0 + 4, 4 * dvb + 2 * dh, laneo)));
#pragma unroll
                for (int i = 0; i < 4; ++i) { kl[u][i] = vtr((LAS const char*)(B + HG_KP + htr(r0, 4 * i + 2 * dh, laneo))); kh[u][i] = vtr((LAS const char*)(B + HG_KP + htr(r0 + 4, 4 * i + 2 * dh, laneo))); } }
            __builtin_amdgcn_sched_barrier(0);
#pragma unroll
            for (int u = 0; u < 2; ++u) { const bf16x8 vb = (bf16x8){vl[u][0], vl[u][1], vl[u][2], vl[u][3], vh[u][0], vh[u][1], vh[u][2], vh[u][3]};
#pragma unroll
                for (int i = 0; i < 4; ++i) T[i] = MFMA32(((bf16x8){kl[u][i][0], kl[u][i][1], kl[u][i][2], kl[u][i][3], kh[u][i][0], kh[u][i][1], kh[u][i][2], kh[u][i][3]}), vb, T[i]); }
            __builtin_amdgcn_sched_barrier(0);
        }
        if (c + 1 < 32) HG_SCALE(c + 1);
        asm volatile("s_waitcnt vmcnt(0)" ::: "memory");
        __syncthreads();
        { const LAS unsigned char* OBp = L + (c & 1) * HG_BUF + HG_OB + orow * 272 + oseg * 32;
          const u32x4 o0 = *(const LAS u32x4*)OBp, o1 = *(const LAS u32x4*)(OBp + 16);
          float ov[16];
          ov[0] = bflo(o0.x); ov[1] = bfhi(o0.x); ov[2] = bflo(o0.y); ov[3] = bfhi(o0.y); ov[4] = bflo(o0.z); ov[5] = bfhi(o0.z); ov[6] = bflo(o0.w); ov[7] = bfhi(o0.w);
          ov[8] = bflo(o1.x); ov[9] = bfhi(o1.x); ov[10] = bflo(o1.y); ov[11] = bfhi(o1.y); ov[12] = bflo(o1.z); ov[13] = bfhi(o1.z); ov[14] = bflo(o1.w); ov[15] = bfhi(o1.w);
          float ss = 0.f;
#pragma unroll
          for (int j = 0; j < 16; ++j) ss += ov[j] * ov[j];
          ss += __int_as_float(__builtin_amdgcn_update_dpp(0, __float_as_int(ss), 0xB1, 0xf, 0xf, true));
          ss += __int_as_float(__builtin_amdgcn_update_dpp(0, __float_as_int(ss), 0x4E, 0xf, 0xf, true));
          ss += __int_as_float(__builtin_amdgcn_update_dpp(0, __float_as_int(ss), 0x141, 0xf, 0xf, true));
          const float rs = __builtin_amdgcn_rsqf(ss * (1.f / 128.f) + LN_EPS);
          float ng[16];
#pragma unroll
          for (int i = 0; i < 4; ++i) { const f32x4 n_ = *(const LAS f32x4*)(NGS + 16 * oseg + 4 * i); ng[4 * i] = n_[0]; ng[4 * i + 1] = n_[1]; ng[4 * i + 2] = n_[2]; ng[4 * i + 3] = n_[3]; }
          float gvv[16];
          gvv[0] = bflo(gr[0].x); gvv[1] = bfhi(gr[0].x); gvv[2] = bflo(gr[0].y); gvv[3] = bfhi(gr[0].y); gvv[4] = bflo(gr[0].z); gvv[5] = bfhi(gr[0].z); gvv[6] = bflo(gr[0].w); gvv[7] = bfhi(gr[0].w);
          gvv[8] = bflo(gr[1].x); gvv[9] = bfhi(gr[1].x); gvv[10] = bflo(gr[1].y); gvv[11] = bfhi(gr[1].y); gvv[12] = bflo(gr[1].z); gvv[13] = bfhi(gr[1].z); gvv[14] = bflo(gr[1].w); gvv[15] = bfhi(gr[1].w);
          float rv[16];
#pragma unroll
          for (int j = 0; j < 16; ++j) rv[j] = ov[j] * (rs * FP8_SO) * ng[j] * gvv[j];
          u32x4 w0; w0.x = cvt4_fp8(rv[0], rv[1], rv[2], rv[3]); w0.y = cvt4_fp8(rv[4], rv[5], rv[6], rv[7]); w0.z = cvt4_fp8(rv[8], rv[9], rv[10], rv[11]); w0.w = cvt4_fp8(rv[12], rv[13], rv[14], rv[15]);
          unsigned char* op = (unsigned char*)Ocat + (rb + (size_t)c * 64 + orow) * 1024 + h * 128 + 16 * oseg;
          *(u32x4*)op = w0; }
    }
    __syncthreads();
#undef HG_DMA
#undef HG_SCALE
#undef HG_SCLOAD
}

constexpr int AT_NST = 4, AT_K = 0, AT_V = AT_NST * 8192, AT_KM = 2 * AT_NST * 8192, AT_TAB = AT_KM + 1792;
DI int t5_bucket(int d) { if (d < 16) return d; const int v = 16 + (int)(logf((float)d * (1.f / 16.f)) / logf(8.f) * 16.f); return v < 31 ? v : 31; }
DI void glds16(const void* gsrc, unsigned lds_dst) { unsigned keep;
    asm volatile("s_mov_b32 %0, m0\n\ts_mov_b32 m0, %2\n\ts_nop 0\n\tglobal_load_lds_dwordx4 %1, off\n\ts_mov_b32 m0, %0" : "=&s"(keep) : "v"(gsrc), "s"(lds_dst) : "memory"); }
DI void attn_unit(const Ctx& C, const Args& a, int b, int h, int jq) {
    LAS unsigned char* L = C.lds;
    const int tid = C.tid, lane = C.lane, wid = C.wid, q32 = lane & 31, hi = lane >> 5;
    const bf16* Qm = (const bf16*)(C.ws + WS_QM); const bf16* Km = (const bf16*)(C.ws + WS_KM); const bf16* Vm = (const bf16*)(C.ws + WS_VM); const float* KM = (const float*)(C.ws + WS_KMEAN);
    bf16* Ocat = (bf16*)(C.ws + WS_XB);
    const int tq = jq * 256 + wid * 32 + q32;
    const size_t hb = (size_t)(b * 8 + h) * SEQ;
    bf16x8 qf[4];
#pragma unroll
    for (int ks = 0; ks < 4; ++ks) qf[ks] = *(const bf16x8*)(Qm + (hb + tq) * 64 + 16 * ks + 8 * hi);
    LAS float* kml = (LAS float*)(L + AT_KM); LAS float* tab = (LAS float*)(L + AT_TAB);
    if (tid < jq * 64) { const int n = tid >> 6, d = tid & 63; kml[tid] = KM[(size_t)((b * 8 + n) * 2 + 0) * 512 + h * 64 + d] + KM[(size_t)((b * 8 + n) * 2 + 1) * 512 + h * 64 + d]; }
    if (tid < 129) tab[tid] = (a.in[I_RELB][t5_bucket(tid) * 8 + h] - a.in[I_RELB][31 * 8 + h]) * LOG2E;
    const int drow = 8 * wid + (lane >> 3), dch = lane & 7;
    const bf16* ksrc = Km + (hb + drow) * 64 + 8 * (dch ^ ((drow >> 1) & 7));
    const bf16* vsrc = Vm + (hb + drow) * 64 + 8 * (dch ^ (((drow >> 1) & 1) << 2));
    const unsigned kdst = (unsigned)__builtin_amdgcn_readfirstlane((int)(unsigned)(size_t)(L + AT_K + wid * 1024)), vdst = (unsigned)__builtin_amdgcn_readfirstlane((int)(unsigned)(size_t)(L + AT_V + wid * 1024));
    const int nt = 4 * jq + 4;
#define AT_ISSUE(t) do { glds16(ksrc + (size_t)(t) * 4096, kdst + ((t) & 3) * 8192); glds16(vsrc + (size_t)(t) * 4096, vdst + ((t) & 3) * 8192); } while (0)
    AT_ISSUE(0); AT_ISSUE(1); AT_ISSUE(2);
    __syncthreads();
    unsigned sel = 0;
    {
        float g[7];
#pragma unroll
        for (int n = 0; n < 7; ++n) { g[n] = 0.f;
            if (n < jq) { float s = 0.f;
#pragma unroll
                for (int ks = 0; ks < 4; ++ks)
#pragma unroll
                    for (int j = 0; j < 8; ++j) s += bf2f((unsigned short)qf[ks][j]) * kml[n * 64 + 16 * ks + 8 * hi + j];
                s += __shfl_xor(s, 32); g[n] = s; } }
#pragma unroll
        for (int n = 0; n < 7; ++n) if (n < jq) { int rank = 0;
#pragma unroll
            for (int m = 0; m < 7; ++m) if (m != n && m < jq) rank += (g[m] > g[n] || (g[m] == g[n] && m < n)) ? 1 : 0;
            if (rank < 3) sel |= 1u << n; }
    }
    const float c31 = a.in[I_RELB][31 * 8 + h] * LOG2E;
    float lrun = 0.f;
    f32x16 negm;
#pragma unroll
    for (int r = 0; r < 16; ++r) negm[r] = c31;
    f32x16 o0, o1;
#pragma unroll
    for (int r = 0; r < 16; ++r) { o0[r] = 0.f; o1[r] = 0.f; }
    const int i16 = lane & 15, qq = i16 >> 2, pp = i16 & 3, dh = (lane >> 4) & 1, xsw = (qq >> 1) & 1;
    const int vb0 = (4 * hi + qq) * 128 + 64 * (0 ^ xsw) + 32 * dh + 8 * pp, vb1 = (4 * hi + qq) * 128 + 64 * (1 ^ xsw) + 32 * dh + 8 * pp;
    const int kxs = (q32 >> 1) & 7;
    for (int kt = 0; kt < nt; ++kt) {
        if (kt + 2 < nt) asm volatile("s_waitcnt vmcnt(4)" ::: "memory"); else if (kt + 1 < nt) asm volatile("s_waitcnt vmcnt(2)" ::: "memory"); else asm volatile("s_waitcnt vmcnt(0)" ::: "memory");
        __builtin_amdgcn_s_barrier();
        asm volatile("" ::: "memory");
        if (kt + 3 < nt) AT_ISSUE(kt + 3);
        const int blk = kt >> 2; const bool own = (blk == jq);
        const bool active = !own || ((kt & 3) * 64 <= wid * 32 + 31);
        if (active) {
            const LAS unsigned char* Kc = L + AT_K + (kt & 3) * 8192; const LAS unsigned char* Vc = L + AT_V + (kt & 3) * 8192;
            bf16x8 kf[8];
#pragma unroll
            for (int ks = 0; ks < 4; ++ks) { const int ko = (((2 * ks + hi) ^ kxs) << 4); kf[2 * ks] = *(const LAS bf16x8*)(Kc + q32 * 128 + ko); kf[2 * ks + 1] = *(const LAS bf16x8*)(Kc + (32 + q32) * 128 + ko); }
            __builtin_amdgcn_sched_barrier(0);
            f32x16 s0 = negm, s1 = negm;
#pragma unroll
            for (int ks = 0; ks < 4; ++ks) { s0 = MFMA32(kf[2 * ks], qf[ks], s0); s1 = MFMA32(kf[2 * ks + 1], qf[ks], s1); }
            __builtin_amdgcn_sched_barrier(0);
            s16x4 vf[2][4][2];
#pragma unroll
            for (int j = 0; j < 4; ++j) { const int ro = 16 * j * 128;
                vf[0][j][0] = vtr((LAS const char*)(Vc + vb0 + ro)); vf[0][j][1] = vtr((LAS const char*)(Vc + vb0 + ro + 8 * 128));
                vf[1][j][0] = vtr((LAS const char*)(Vc + vb1 + ro)); vf[1][j][1] = vtr((LAS const char*)(Vc + vb1 + ro + 8 * 128)); }
            __builtin_amdgcn_sched_barrier(0);
            const bool near = (jq * 256 + wid * 32 - 64 * kt - 63) < 128;
            if (near) {
                const int dist0 = tq - 64 * kt - 4 * hi;
#pragma unroll
                for (int r = 0; r < 16; ++r) { const int d0 = dist0 - ((r & 3) + 8 * (r >> 2)), d1 = d0 - 32;
                    const int i0 = d0 < 0 ? 0 : (d0 > 128 ? 128 : d0), i1 = d1 < 0 ? 0 : (d1 > 128 ? 128 : d1);
                    const float t0 = tab[i0], t1 = tab[i1]; s0[r] += t0; s1[r] += t1; s0[r] = d0 < 0 ? -INFINITY : s0[r]; s1[r] = d1 < 0 ? -INFINITY : s1[r]; }
            }
            const bool lsel = own || ((sel >> blk) & 1u);
            float mx = fmaxf(fmaxf(s0[0], s1[0]), fmaxf(s0[1], s1[1]));
#pragma unroll
            for (int r = 2; r < 16; r += 2) mx = fmaxf(mx, fmaxf(fmaxf(s0[r], s1[r]), fmaxf(s0[r + 1], s1[r + 1])));
            mx = lsel ? mx : -INFINITY;
            mx = fmaxf(mx, __shfl_xor(mx, 32));
            if (__any(mx > 4.0f)) {
                const float delta = fmaxf(mx, 0.f), alpha = __builtin_amdgcn_exp2f(-delta);
                lrun *= alpha;
#pragma unroll
                for (int r = 0; r < 16; ++r) { o0[r] *= alpha; o1[r] *= alpha; negm[r] -= delta; s0[r] -= delta; s1[r] -= delta; }
            }
            float ps = 0.f;
#pragma unroll
            for (int r = 0; r < 16; ++r) { s0[r] = __builtin_amdgcn_exp2f(s0[r]); s1[r] = __builtin_amdgcn_exp2f(s1[r]); ps += s0[r] + s1[r]; }
            lrun += lsel ? ps : 0.f;
            const unsigned pmask = lsel ? 0xffffffffu : 0u;
#pragma unroll
            for (int kb = 0; kb < 2; ++kb)
#pragma unroll
                for (int s2 = 0; s2 < 2; ++s2) {
                    u32x4 pw;
                    if (kb == 0) { pw.x = cvtpk(s0[8 * s2 + 0], s0[8 * s2 + 1]); pw.y = cvtpk(s0[8 * s2 + 2], s0[8 * s2 + 3]); pw.z = cvtpk(s0[8 * s2 + 4], s0[8 * s2 + 5]); pw.w = cvtpk(s0[8 * s2 + 6], s0[8 * s2 + 7]); }
                    else         { pw.x = cvtpk(s1[8 * s2 + 0], s1[8 * s2 + 1]); pw.y = cvtpk(s1[8 * s2 + 2], s1[8 * s2 + 3]); pw.z = cvtpk(s1[8 * s2 + 4], s1[8 * s2 + 5]); pw.w = cvtpk(s1[8 * s2 + 6], s1[8 * s2 + 7]); }
                    pw.x &= pmask; pw.y &= pmask; pw.z &= pmask; pw.w &= pmask;
                    const bf16x8 pf = __builtin_bit_cast(bf16x8, pw);
                    const s16x4 a0l = vf[0][2 * kb + s2][0], a0h = vf[0][2 * kb + s2][1], a1l = vf[1][2 * kb + s2][0], a1h = vf[1][2 * kb + s2][1];
                    o0 = MFMA32(((bf16x8){a0l[0], a0l[1], a0l[2], a0l[3], a0h[0], a0h[1], a0h[2], a0h[3]}), pf, o0);
                    o1 = MFMA32(((bf16x8){a1l[0], a1l[1], a1l[2], a1l[3], a1h[0], a1h[1], a1h[2], a1h[3]}), pf, o1);
                }
        }
    }
    const float linv = 1.f / (lrun + __shfl_xor(lrun, 32));
    unsigned char* op = (unsigned char*)Ocat + ((size_t)b * SEQ + tq) * 1024 + 512 + h * 64;
    const float lsc = linv * FP8_SO;
#pragma unroll
    for (int g = 0; g < 4; ++g) { *(unsigned*)(op + 8 * g + 4 * hi) = cvt4_fp8(o0[4 * g] * lsc, o0[4 * g + 1] * lsc, o0[4 * g + 2] * lsc, o0[4 * g + 3] * lsc);
        *(unsigned*)(op + 32 + 8 * g + 4 * hi) = cvt4_fp8(o1[4 * g] * lsc, o1[4 * g + 1] * lsc, o1[4 * g + 2] * lsc, o1[4 * g + 3] * lsc); }
    __syncthreads();
#undef AT_ISSUE
}

#ifndef PROBE_HGX
#define PROBE_HGX 1
#endif
#ifndef PROBE_ATX
#define PROBE_ATX 1
#endif
#ifndef STAMP_SEL
#define STAMP_SEL -1
#endif
#define STAMP(i) do { if (STAMP_SEL >= 0 && blockIdx.x == 0 && C.tid == 0) { const unsigned long long t_ = __builtin_amdgcn_s_memrealtime(); C.MISC[16 + 2 * (i)] = (unsigned)t_; C.MISC[17 + 2 * (i)] = (unsigned)(t_ >> 32); } } while (0)
DI void p2_mixers(const Ctx& C, const Args& a, int rep) {
    for (int hx = 0; hx < PROBE_HGX; ++hx)
    for (int u = blockIdx.x; u < 64; u += C.G) hgrn_unit(C, a, u >> 2, u & 3);
    STAMP(11);
    unsigned* QA = (unsigned*)(C.ctl + CW_QUEUE + 64 * rep); unsigned* QC = (unsigned*)(C.ctl + CW_QUEUE2 + 64 * rep);
    constexpr int NA = 1024 * PROBE_ATX, NC = MOE_CVT_TILES;
    if (C.tid == 0) { C.MISC[0] = __hip_atomic_fetch_add(QA, 1u, __ATOMIC_RELAXED, __HIP_MEMORY_SCOPE_AGENT); C.MISC[1] = (rep == 0) ? __hip_atomic_fetch_add(QC, 1u, __ATOMIC_RELAXED, __HIP_MEMORY_SCOPE_AGENT) : (unsigned)NC; }
    __syncthreads();
    int qa = (int)C.MISC[0], qc = (int)C.MISC[1];
    __syncthreads();
    for (;;) {
        const bool doa = qa < NA, doc = qc < NC;
        if (!doa && !doc) break;
        unsigned na = (unsigned)NA, nc = (unsigned)NC;
        if (C.tid == 0) { if (doa) na = __hip_atomic_fetch_add(QA, 1u, __ATOMIC_RELAXED, __HIP_MEMORY_SCOPE_AGENT); if (doc) nc = __hip_atomic_fetch_add(QC, 1u, __ATOMIC_RELAXED, __HIP_MEMORY_SCOPE_AGENT); }
#ifdef STAMP_ACC
        unsigned long long ta_ = 0, tb_ = 0, tc_ = 0; if (C.tid == 0) ta_ = __builtin_amdgcn_s_memrealtime();
#endif
        if (doa) { const int q = qa / PROBE_ATX; attn_unit(C, a, (q & 127) >> 3, q & 7, 7 - (q >> 7)); }
#ifdef STAMP_ACC
        if (C.tid == 0) tb_ = __builtin_amdgcn_s_memrealtime();
#endif
        if (doc) moe_cvt_tile(C, a, qc);
#ifdef STAMP_ACC
        if (C.tid == 0 && blockIdx.x == 100) { tc_ = __builtin_amdgcn_s_memrealtime(); const unsigned long long d_ = (STAMP_ACC == 0) ? (tb_ - ta_) : (tc_ - tb_);
            const unsigned long long o_ = ((unsigned long long)C.MISC[45] << 32) | C.MISC[44]; const unsigned long long n_ = o_ + d_; C.MISC[44] = (unsigned)n_; C.MISC[45] = (unsigned)(n_ >> 32); }
#endif
        if (C.tid == 0) { C.MISC[0] = na; C.MISC[1] = nc; }
        __syncthreads();
        qa = (int)C.MISC[0]; qc = (int)C.MISC[1];
        __syncthreads();
    }
    STAMP(12);
#ifdef STAMP_ACC
    if (C.tid == 0 && blockIdx.x == 100) { const unsigned long long n_ = ((unsigned long long)C.MISC[45] << 32) | C.MISC[44]; const unsigned long long w0 = __builtin_amdgcn_s_memrealtime(); while (__builtin_amdgcn_s_memrealtime() - w0 < 4ull * n_) __builtin_amdgcn_s_sleep(8); }
#endif
}

DI void r1_phase(const Ctx& C, const Args& a) {
    LAS unsigned char* L = C.lds;
    const int tid = C.tid, lane = C.lane, wid = C.wid;
    LAS float* LG = (LAS float*)L + wid * 16 * 48;
    LAS int* CNT = (LAS int*)(L + 32768);
    LAS float* G1 = (LAS float*)(L + 33024); LAS float* B1 = (LAS float*)(L + 37120);
    const float* Pre = (const float*)(C.ws + WS_ZF); unsigned char* X1q = (unsigned char*)(C.ws + WS_XB); f32x2* stats = (f32x2*)(C.ws + WS_STATS);
    const bf16* WrH = (const bf16*)(C.ws + WS_WRH); const bf16* WrL = (const bf16*)(C.ws + WS_WRL);
    unsigned* tokE = (unsigned*)(C.ws + WS_TOKE); float* tokW = (float*)(C.ws + WS_TOKW); int* wgcnt = (int*)(C.ws + WS_WGCNT);
    for (int i = tid; i < 1024; i += NTHREADS) { G1[i] = a.in[I_LN1G][i]; B1[i] = a.in[I_LN1B][i]; }
    const int m16 = lane & 15, kq = lane >> 4;
    for (int chunk = blockIdx.x; chunk < NTOK / 128; chunk += C.G) {
        if (tid < 32) CNT[tid] = 0;
        __syncthreads();
        const int tok0 = chunk * 128 + wid * 16;
        const float* xrow = Pre + (size_t)(tok0 + m16) * 1024 + 8 * kq;
        float s = 0.f, s2 = 0.f;
#pragma unroll 8
        for (int k0 = 0; k0 < 1024; k0 += 32) { const f32x4 xa = *(const f32x4*)(xrow + k0), xc = *(const f32x4*)(xrow + k0 + 4);
            s += (xa[0] + xa[1]) + (xa[2] + xa[3]) + (xc[0] + xc[1]) + (xc[2] + xc[3]);
            s2 += (xa[0] * xa[0] + xa[1] * xa[1]) + (xa[2] * xa[2] + xa[3] * xa[3]) + (xc[0] * xc[0] + xc[1] * xc[1]) + (xc[2] * xc[2] + xc[3] * xc[3]); }
        s += __shfl_xor(s, 16); s += __shfl_xor(s, 32); s2 += __shfl_xor(s2, 16); s2 += __shfl_xor(s2, 32);
        const float mean = s * (1.f / 1024.f); const float var = fmaxf(s2 * (1.f / 1024.f) - mean * mean, 0.f); const float rstd = 1.f / sqrtf(var + LN_EPS);
        if (kq == 0) stats[tok0 + m16] = (f32x2){mean, rstd};
        f32x4 acc[3];
#pragma unroll
        for (int nb = 0; nb < 3; ++nb) acc[nb] = (f32x4){0.f, 0.f, 0.f, 0.f};
        unsigned char* xb = X1q + (size_t)(tok0 + m16) * 1024 + 8 * kq;
        const bf16* wrh = WrH + (size_t)m16 * 1024 + 8 * kq; const bf16* wrl = WrL + (size_t)m16 * 1024 + 8 * kq;
        bf16x8 wh[2][3], wl[2][3];
#pragma unroll
        for (int nb = 0; nb < 3; ++nb) { wh[0][nb] = *(const bf16x8*)(wrh + (size_t)nb * 16 * 1024); wl[0][nb] = *(const bf16x8*)(wrl + (size_t)nb * 16 * 1024); }
#pragma unroll 1
        for (int kb = 0; kb < 4; ++kb) {
            f32x4 xa[8], xc[8];
#pragma unroll
            for (int j = 0; j < 8; ++j) { xa[j] = *(const f32x4*)(xrow + kb * 256 + 32 * j); xc[j] = *(const f32x4*)(xrow + kb * 256 + 32 * j + 4); }
#pragma unroll
            for (int j = 0; j < 8; ++j) { const int k0 = kb * 256 + 32 * j, cur = j & 1;
                if (k0 + 32 < 1024) {
#pragma unroll
                    for (int nb = 0; nb < 3; ++nb) { wh[cur ^ 1][nb] = *(const bf16x8*)(wrh + (size_t)nb * 16 * 1024 + k0 + 32); wl[cur ^ 1][nb] = *(const bf16x8*)(wrl + (size_t)nb * 16 * 1024 + k0 + 32); } }
                const f32x4 ya = (xa[j] - mean) * rstd * *(const LAS f32x4*)(G1 + k0 + 8 * kq) + *(const LAS f32x4*)(B1 + k0 + 8 * kq);
                const f32x4 yc = (xc[j] - mean) * rstd * *(const LAS f32x4*)(G1 + k0 + 8 * kq + 4) + *(const LAS f32x4*)(B1 + k0 + 8 * kq + 4);
                u32x4 hw; hw.x = cvtpk(ya[0], ya[1]); hw.y = cvtpk(ya[2], ya[3]); hw.z = cvtpk(yc[0], yc[1]); hw.w = cvtpk(yc[2], yc[3]);
                { u32x2 qw; qw.x = cvt4_fp8(ya[0] * FP8_SX, ya[1] * FP8_SX, ya[2] * FP8_SX, ya[3] * FP8_SX); qw.y = cvt4_fp8(yc[0] * FP8_SX, yc[1] * FP8_SX, yc[2] * FP8_SX, yc[3] * FP8_SX); *(u32x2*)(xb + k0) = qw; }
                u32x4 lw; lw.x = cvtpk(ya[0] - bflo(hw.x), ya[1] - bfhi(hw.x)); lw.y = cvtpk(ya[2] - bflo(hw.y), ya[3] - bfhi(hw.y)); lw.z = cvtpk(yc[0] - bflo(hw.z), yc[1] - bfhi(hw.z)); lw.w = cvtpk(yc[2] - bflo(hw.w), yc[3] - bfhi(hw.w));
                const bf16x8 xh = __builtin_bit_cast(bf16x8, hw), xl = __builtin_bit_cast(bf16x8, lw);
#pragma unroll
                for (int nb = 0; nb < 3; ++nb) { acc[nb] = MFMA16(wh[cur][nb], xh, acc[nb]); acc[nb] = MFMA16(wl[cur][nb], xh, acc[nb]); acc[nb] = MFMA16(wh[cur][nb], xl, acc[nb]); }
            }
        }
#pragma unroll
        for (int nb = 0; nb < 3; ++nb)
#pragma unroll
            for (int r = 0; r < 4; ++r) LG[m16 * 48 + nb * 16 + 4 * kq + r] = acc[nb][r];
        asm volatile("s_waitcnt lgkmcnt(0)" ::: "memory");
        if (lane < 16) {
            const LAS float* lg = LG + lane * 48;
            float gl[4];
#pragma unroll
            for (int j = 0; j < 4; ++j) gl[j] = lg[j] + a.in[I_BGRP][j];
            int grp = 0; float gm = gl[0];
#pragma unroll
            for (int j = 1; j < 4; ++j) if (gl[j] > gm) { gm = gl[j]; grp = j; }
            float se = 0.f;
#pragma unroll
            for (int j = 0; j < 4; ++j) se += expf(gl[j] - gm);
            const float pg = 1.f / se;
            float el[8];
#pragma unroll
            for (int j = 0; j < 8; ++j) el[j] = lg[4 + grp * 8 + j] + a.in[I_BEXP][grp * 8 + j];
            int i0 = 0; float v0 = el[0];
#pragma unroll
            for (int j = 1; j < 8; ++j) if (el[j] > v0) { v0 = el[j]; i0 = j; }
            int i1 = -1; float v1 = -INFINITY;
#pragma unroll
            for (int j = 0; j < 8; ++j) if (j != i0 && el[j] > v1) { v1 = el[j]; i1 = j; }
            const float w0 = 1.f / (1.f + expf(v1 - v0)), w1 = 1.f - w0;
            const int e0 = grp * 8 + i0, e1 = grp * 8 + i1;
            const int r0 = __hip_atomic_fetch_add(CNT + e0, 1, __ATOMIC_RELAXED, __HIP_MEMORY_SCOPE_WORKGROUP), r1 = __hip_atomic_fetch_add(CNT + e1, 1, __ATOMIC_RELAXED, __HIP_MEMORY_SCOPE_WORKGROUP);
            const int tok = tok0 + lane;
            tokE[tok] = (unsigned)e0 | ((unsigned)e1 << 8) | ((unsigned)r0 << 16) | ((unsigned)r1 << 24);
            tokW[tok * 2] = w0 * pg; tokW[tok * 2 + 1] = w1 * pg;
        }
        __syncthreads();
        if (tid < 32) wgcnt[chunk * 32 + tid] = CNT[tid];
        __syncthreads();
    }
}

DI void r2_phase(const Ctx& C, const Args& a) {
    LAS int* PA = (LAS int*)C.lds;
    LAS int* PB = PA + 512;
    LAS int* TOT = PB + 512; LAS int* BASE = TOT + 32; LAS int* PST = BASE + 32;
    const int tid = C.tid;
    const int* wgcnt = (const int*)(C.ws + WS_WGCNT); const unsigned* tokE = (const unsigned*)(C.ws + WS_TOKE);
    int* tokD = (int*)(C.ws + WS_TOKD); int* rowtok = (int*)(C.ws + WS_ROWTOK); int* tilee = (int*)(C.ws + WS_TILEE);
    for (int chunk = blockIdx.x; chunk < NTOK / 128; chunk += C.G) {
        { const int e = tid & 31, part = tid >> 5; int sa = 0, sb = 0;
          for (int c = part * 16; c < part * 16 + 16; ++c) { const int v = wgcnt[c * 32 + e]; sa += v; sb += (c < chunk) ? v : 0; }
          PA[part * 32 + e] = sa; PB[part * 32 + e] = sb; }
        __syncthreads();
        if (tid < 32) { int sa = 0, sb = 0; for (int p = 0; p < 16; ++p) { sa += PA[p * 32 + tid]; sb += PB[p * 32 + tid]; } TOT[tid] = sa; BASE[tid] = sb; }
        __syncthreads();
        if (tid == 0) { int ps = 0; for (int e = 0; e < 32; ++e) { PST[e] = ps; ps += ((TOT[e] + 255) >> 8) << 8; } PST[32] = ps; }
        __syncthreads();
        if (tid < 128) { const int tok = chunk * 128 + tid; const unsigned w = tokE[tok]; const int e0 = w & 31, e1 = (w >> 8) & 31, r0 = (w >> 16) & 255, r1 = (w >> 24) & 255;
            const int d0 = PST[e0] + BASE[e0] + r0, d1 = PST[e1] + BASE[e1] + r1; rowtok[d0] = tok; rowtok[d1] = tok; tokD[tok * 2] = d0; tokD[tok * 2 + 1] = d1; }
        if (chunk < 32) { const int e = chunk, end = PST[e + 1] - PST[e]; for (int i = TOT[e] + tid; i < end; i += NTHREADS) rowtok[PST[e] + i] = 0; }
        if (chunk == 0) { if (tid < 32) { for (int t = PST[tid] >> 8; t < (PST[tid + 1] >> 8); ++t) tilee[t] = tid; } if (tid == 0) tilee[511] = PST[32] >> 8; }
        __syncthreads();
    }
}

DI void f_phase(const Ctx& C, const Args& a) {
    const int lane = C.lane, gw = C.vcu * NWAVES + C.wid, NGW = C.G * NWAVES;
    const float* Pre = (const float*)(C.ws + WS_ZF); const bf16* Y = (const bf16*)(C.ws + WS_Y); const int* tokD = (const int*)(C.ws + WS_TOKD); const float* tokW = (const float*)(C.ws + WS_TOKW);
    const f32x2* stats = (const f32x2*)(C.ws + WS_STATS);
    f32x4 g2[4], b2[4], g1[4], b1[4];
#pragma unroll
    for (int j = 0; j < 4; ++j) { g2[j] = *(const f32x4*)(a.in[I_LN2G] + 256 * j + 4 * lane); b2[j] = *(const f32x4*)(a.in[I_LN2B] + 256 * j + 4 * lane);
        g1[j] = *(const f32x4*)(a.in[I_LN1G] + 256 * j + 4 * lane) * DN_ALPHA; b1[j] = *(const f32x4*)(a.in[I_LN1B] + 256 * j + 4 * lane) * DN_ALPHA; }
    for (int tok = gw; tok < NTOK; tok += NGW) {
        const int d0 = tokD[tok * 2], d1 = tokD[tok * 2 + 1]; const float w0 = tokW[tok * 2], w1 = tokW[tok * 2 + 1]; const f32x2 st = stats[tok];
        const float* xr = Pre + (size_t)tok * 1024 + 4 * lane; const bf16* y0 = Y + (size_t)d0 * 1024 + 4 * lane; const bf16* y1 = Y + (size_t)d1 * 1024 + 4 * lane;
        f32x4 v[4]; float s = 0.f;
#pragma unroll
        for (int j = 0; j < 4; ++j) { const f32x4 x = *(const f32x4*)(xr + 256 * j); const u32x2 p0 = *(const u32x2*)(y0 + 256 * j), p1 = *(const u32x2*)(y1 + 256 * j);
            v[j] = ((x - st.x) * st.y) * g1[j] + b1[j] + (f32x4){bflo(p0.x), bfhi(p0.x), bflo(p0.y), bfhi(p0.y)} * w0 + (f32x4){bflo(p1.x), bfhi(p1.x), bflo(p1.y), bfhi(p1.y)} * w1;
            s += (v[j][0] + v[j][1]) + (v[j][2] + v[j][3]); }
        const float mean = wave_sum(s) * (1.f / 1024.f); float s2 = 0.f;
#pragma unroll
        for (int j = 0; j < 4; ++j) { v[j] = v[j] - mean; s2 += (v[j][0] * v[j][0] + v[j][1] * v[j][1]) + (v[j][2] * v[j][2] + v[j][3] * v[j][3]); }
        const float rstd = 1.f / sqrtf(wave_sum(s2) * (1.f / 1024.f) + LN_EPS);
        float* orow = a.out + (size_t)tok * 1024 + 4 * lane;
#pragma unroll
        for (int j = 0; j < 4; ++j) *(f32x4*)(orow + 256 * j) = v[j] * rstd * g2[j] + b2[j];
    }
}

constexpr int NPH = 10;
__global__ void __launch_bounds__(NTHREADS, 2) mk_fwd(Args args) {
    extern __shared__ __attribute__((aligned(16))) unsigned char lds_raw[];
    Ctx C;
    C.lds = (LAS unsigned char*)lds_raw; C.MISC = (volatile LAS unsigned*)(C.lds + MISC_OFF);
    C.tid = threadIdx.x; C.lane = C.tid & 63; C.wid = __builtin_amdgcn_readfirstlane(C.tid >> 6);
    C.G = gridDim.x; { const int bx = blockIdx.x; C.vcu = (C.G % 8 == 0) ? (bx % 8) * (C.G / 8) + bx / 8 : bx; }
    C.ws = args.ws; C.ctl = (gu32*)(args.ws + WS_CTL);
    if (C.tid < 64) C.MISC[C.tid] = 0u;
    __syncthreads();
    XcdBarrier bar; bar.bar = (unsigned*)(C.ctl + CW_BAR); bar.x = 0; bar.st = nullptr;
    if (MK_N_LAUNCHES == 1) bar = xcd_barrier_post((unsigned*)(C.ctl + CW_BAR), C.MISC + 8);
    const int lo = args.ph_lo, hi = args.ph_hi;
#ifndef PH_MASK
#define PH_MASK 0x3ff
#endif
#define IN(k) (((PH_MASK >> (k)) & 1) && lo <= (k) && (k) < hi)
#ifndef STAMP_SEL
#define STAMP_SEL -1
#endif
#ifndef STAMP_T0
#define STAMP_T0 STAMP_SEL
#define STAMP_T1 (STAMP_SEL + 1)
#endif
#define SEAM(k) do { if (IN(k) && IN((k) + 1)) xcd_barrier(bar); STAMP((k) + 1); } while (0)
#ifndef PROBE_PHASE
#define PROBE_PHASE -1
#endif
#define REPS(k) ((PROBE_PHASE == (k)) ? 2 : 1)
#define REPSEAM(k) do { if (rep + 1 < REPS(k)) xcd_barrier(bar); } while (0)
    unsigned char* ws = args.ws;
    LAS unsigned char* ring = C.lds;

    STAMP(0);
    if (IN(0)) { _Pragma("unroll") for (int rep = 0; rep < REPS(0); ++rep) { p0_prologue(C, args); REPSEAM(0); } } SEAM(0);

    if (IN(1)) _Pragma("unroll") for (int rep = 0; rep < REPS(1); ++rep) {
        pg8::DenseOrder S; S.init(ws + WS_XB, ws + WS_WIN, NTOK, NIN, 1024, C.G, (int)blockIdx.x);
        pg8::EpiIn E{(bf16*)(ws + WS_QH), (bf16*)(ws + WS_VH), (bf16*)(ws + WS_GH), (bf16*)(ws + WS_QM), (bf16*)(ws + WS_KM), (bf16*)(ws + WS_VM), (bf16*)(ws + WS_R), (bf16*)(ws + WS_GB),
                     (float*)(ws + WS_ZF), (float*)(ws + WS_KMEAN), (const float*)(ws + WS_BPERM), (bf16*)(ws + WS_KK), (const float*)(ws + WS_LB)};
        pg8::gemm_phase<pg8::EpiIn, pg8::DenseOrder, false>(ring, 1024, S, E); REPSEAM(1);
    } SEAM(1);

#ifndef PROBE_P2X
#define PROBE_P2X 1
#endif
    if (IN(2)) { for (int rep = 0; rep < PROBE_P2X; ++rep) { p2_mixers(C, args, rep); if (rep + 1 < PROBE_P2X) xcd_barrier(bar); } } SEAM(2);

    if (IN(3)) _Pragma("unroll") for (int rep = 0; rep < REPS(3); ++rep) {
        pg8::DenseOrder S; S.init(ws + WS_XB, ws + WS_WCAT, NTOK, 1024, 512, C.G, (int)blockIdx.x);
        pg8::EpiProj E{(const bf16*)(ws + WS_R), (const bf16*)(ws + WS_GB), (unsigned char*)(ws + WS_QH)};
        pg8::gemm_phase<pg8::EpiProj, pg8::DenseOrder, false, true>(ring, 512, S, E); REPSEAM(3);
    } SEAM(3);

    if (IN(4)) _Pragma("unroll") for (int rep = 0; rep < REPS(4); ++rep) {
        pg8::DenseOrder S; S.init(ws + WS_QH, ws + WS_WO, NTOK, 1024, 512, C.G, (int)blockIdx.x);
        pg8::EpiOut E{args.in[I_X], (float*)(ws + WS_ZF)};
        pg8::gemm_phase<pg8::EpiOut, pg8::DenseOrder, false, true>(ring, 512, S, E);
        REPSEAM(4);
    } SEAM(4);

    if (IN(5)) { _Pragma("unroll") for (int rep = 0; rep < REPS(5); ++rep) { r1_phase(C, args); REPSEAM(5); } } SEAM(5);
    if (IN(6)) { _Pragma("unroll") for (int rep = 0; rep < REPS(6); ++rep) { r2_phase(C, args); REPSEAM(6); } } SEAM(6);

    if (IN(7)) _Pragma("unroll") for (int rep = 0; rep < REPS(7); ++rep) {
        const int* tilee = (const int*)(ws + WS_TILEE);
        const int ntl = __builtin_amdgcn_readfirstlane(__hip_atomic_load(tilee + 511, __ATOMIC_RELAXED, __HIP_MEMORY_SCOPE_AGENT));
        pg8::MoeOrder S{(const char*)(ws + WS_XB), (const char*)args.out, (const int*)(ws + WS_ROWTOK), tilee, 512, 1024, ntl * 4, C.G, C.vcu, true};
        pg8::EpiM1 E{(unsigned char*)(ws + WS_QH)};
        pg8::gemm_phase<pg8::EpiM1, pg8::MoeOrder, true, true>(ring, 512, S, E); REPSEAM(7);
    } SEAM(7);

    if (IN(8)) _Pragma("unroll") for (int rep = 0; rep < REPS(8); ++rep) {
        const int* tilee = (const int*)(ws + WS_TILEE);
        const int ntl = __builtin_amdgcn_readfirstlane(__hip_atomic_load(tilee + 511, __ATOMIC_RELAXED, __HIP_MEMORY_SCOPE_AGENT));
        pg8::MoeOrder S{(const char*)(ws + WS_QH), (const char*)args.out + 32 * MiB, (const int*)(ws + WS_ROWTOK), tilee, 256, 1024, ntl * 4, C.G, C.vcu, false};
        pg8::EpiM2 E{(bf16*)(ws + WS_Y)};
        pg8::gemm_phase<pg8::EpiM2, pg8::MoeOrder, false, true>(ring, 256, S, E); REPSEAM(8);
    } SEAM(8);

    if (IN(9)) { _Pragma("unroll") for (int rep = 0; rep < REPS(9); ++rep) { f_phase(C, args); REPSEAM(9); } }
    STAMP(10);
    if (STAMP_SEL >= 0 && blockIdx.x == 0 && C.tid == 0) {
        const unsigned long long t0 = ((unsigned long long)C.MISC[17 + 2 * (STAMP_T0)] << 32) | C.MISC[16 + 2 * (STAMP_T0)], t1 = ((unsigned long long)C.MISC[17 + 2 * (STAMP_T1)] << 32) | C.MISC[16 + 2 * (STAMP_T1)];
        const unsigned long long w0 = __builtin_amdgcn_s_memrealtime(); while (__builtin_amdgcn_s_memrealtime() - w0 < 4ull * (t1 - t0)) __builtin_amdgcn_s_sleep(8); }
#undef IN
#undef SEAM
}

extern "C" void kernel_launch(void* const* d_in, const int* in_sizes, int n_in, void* d_out, int out_size, void* d_ws, size_t ws_size, hipStream_t stream) {
    static int grid = 0;
    if (grid == 0) {
        if (n_in != 19 || in_sizes[0] != NTOK * DM || out_size != NTOK * DM || ws_size < WS_END) { fprintf(stderr, "kernel_launch: unexpected problem shape / workspace; nothing launched\n"); grid = -1; return; }
        int dev = 0, cus = 0, per_cu = 0;
        if (hipGetDevice(&dev) != hipSuccess || hipDeviceGetAttribute(&cus, hipDeviceAttributeMultiprocessorCount, dev) != hipSuccess) { grid = -1; return; }
        if (hipFuncSetAttribute((const void*)mk_fwd, hipFuncAttributeMaxDynamicSharedMemorySize, LDS_BYTES) != hipSuccess) { fprintf(stderr, "kernel_launch: hipFuncSetAttribute failed\n"); grid = -1; return; }
        if (hipOccupancyMaxActiveBlocksPerMultiprocessor(&per_cu, (const void*)mk_fwd, NTHREADS, LDS_BYTES) != hipSuccess || per_cu < 1) { fprintf(stderr, "kernel_launch: occupancy query says %d\n", per_cu); }
        (void)hipGetLastError();
        grid = cus;
    }
    if (grid < 0) return;
    (void)hipMemsetAsync((char*)d_ws + WS_CTL, 0, CTL_ZERO_BYTES, stream);
    Args a{};
    for (int i = 0; i < 19; ++i) a.in[i] = (const float*)d_in[i];
    a.out = (float*)d_out; a.ws = (unsigned char*)d_ws;
    if (MK_N_LAUNCHES == 1) { a.ph_lo = 0; a.ph_hi = NPH; hipLaunchKernelGGL(mk_fwd, dim3(grid), dim3(NTHREADS), LDS_BYTES, stream, a); }
    else for (int p = 0; p < NPH; ++p) { a.ph_lo = p; a.ph_hi = p + 1; hipLaunchKernelGGL(mk_fwd, dim3(grid), dim3(NTHREADS), LDS_BYTES, stream, a); }
}
```

```cpp
#include <hip/hip_runtime.h>
#include <cstdio>
#include <cstdint>
#ifndef MK_N_LAUNCHES
#define MK_N_LAUNCHES 1
#endif
#define DI __device__ __forceinline__
#define GAS __attribute__((address_space(1)))
#define LAS __attribute__((address_space(3)))
typedef unsigned short bf16;
typedef unsigned u32x4 __attribute__((ext_vector_type(4)));
typedef unsigned u32x2 __attribute__((ext_vector_type(2)));
typedef float f32x4 __attribute__((ext_vector_type(4)));
typedef float f32x2 __attribute__((ext_vector_type(2)));
typedef float f32x16 __attribute__((ext_vector_type(16)));
typedef short bf16x8 __attribute__((ext_vector_type(8)));
typedef short s16x4 __attribute__((ext_vector_type(4)));
typedef short v4i16_t __attribute__((ext_vector_type(4)));
typedef __bf16 bf16x2_t __attribute__((ext_vector_type(2)));
typedef GAS unsigned gu32;

constexpr int NTOK = 32768, DM = 1024, SEQ = 2048, NBATCH = 16, NIN = 5632;
constexpr int NWAVES = 8, NTHREADS = 512;
constexpr float LN_EPS = 1e-5f, DN_ALPHA = 1.189207115002721f, LOG2E = 1.4426950408889634f;
constexpr int MOE_MAXTILES = 288;

constexpr size_t MiB = 1u << 20;
constexpr size_t WS_CTL = 0, CTL_ZERO_BYTES = 65536;
constexpr size_t WS_WIN = 1 * MiB, WS_WCAT = 12 * MiB, WS_WO = 14 * MiB;
constexpr size_t WS_XB = 16 * MiB;
constexpr size_t WS_R = 80 * MiB;
constexpr size_t WS_GB = 144 * MiB;
constexpr size_t WS_QH = 208 * MiB;
constexpr size_t WS_VH = 240 * MiB;
constexpr size_t WS_GH = 272 * MiB;
constexpr size_t WS_ZF = 304 * MiB;
constexpr size_t WS_QM = 368 * MiB, WS_KM = 400 * MiB;
constexpr size_t WS_VM = 432 * MiB;
constexpr size_t WS_Y = 16 * MiB;
constexpr size_t WS_MISC = 464 * MiB;
constexpr size_t WS_KMEAN = WS_MISC;
constexpr size_t WS_BPERM = WS_MISC + 1 * MiB;
constexpr size_t WS_WRH = WS_MISC + 2 * MiB;
constexpr size_t WS_WRL = WS_WRH + 98304;
constexpr size_t WS_TOKE = WS_MISC + 3 * MiB;
constexpr size_t WS_TOKW = WS_MISC + 4 * MiB;
constexpr size_t WS_TOKD = WS_MISC + 5 * MiB;
constexpr size_t WS_WGCNT = WS_MISC + 6 * MiB;
constexpr size_t WS_ROWTOK = WS_MISC + 7 * MiB;
constexpr size_t WS_TILEE = WS_MISC + 8 * MiB;
constexpr size_t WS_STATS = WS_MISC + 9 * MiB;
constexpr size_t WS_LB = WS_MISC + 10 * MiB;
constexpr size_t WS_KK = WS_MISC + 12 * MiB;
constexpr size_t WS_END = 512 * MiB;
constexpr int CW_BAR = 4096, CW_QUEUE = 8192, CW_QUEUE2 = 8192 + 1024;

constexpr int LDS_BYTES = 163840, MISC_OFF = LDS_BYTES - 256;

DI unsigned cvtpk(float lo, float hi) { f32x2 v = {lo, hi}; bf16x2_t b = __builtin_convertvector(v, bf16x2_t); return __builtin_bit_cast(unsigned, b); }
DI float bflo(unsigned w) { return __uint_as_float(w << 16); }
DI float bfhi(unsigned w) { return __uint_as_float(w & 0xffff0000u); }
DI float bf2f(unsigned short h) { return __uint_as_float((unsigned)h << 16); }
DI float frcp(float x) { return __builtin_amdgcn_rcpf(x); }
DI float fsigmoid(float x) { return frcp(1.f + __expf(-x)); }
DI float wave_sum(float v) {
#pragma unroll
    for (int o = 1; o < 64; o <<= 1) v += __shfl_xor(v, o);
    return v;
}
typedef int v8i __attribute__((ext_vector_type(8)));
typedef int v4i __attribute__((ext_vector_type(4)));
DI unsigned cvt4_fp8(float a, float b, float c, float d) { a = __builtin_amdgcn_fmed3f(a, -448.f, 448.f); b = __builtin_amdgcn_fmed3f(b, -448.f, 448.f); c = __builtin_amdgcn_fmed3f(c, -448.f, 448.f); d = __builtin_amdgcn_fmed3f(d, -448.f, 448.f);
    int w = 0; w = __builtin_amdgcn_cvt_pk_fp8_f32(a, b, w, false); w = __builtin_amdgcn_cvt_pk_fp8_f32(c, d, w, true); return (unsigned)w; }
constexpr float FP8_SXI = 8.f, FP8_SX = 8.f, FP8_SW = 32.f, FP8_SH = 4.f, FP8_SO = 4.f, FP8_SU = 32.f;
DI int crow(int r, int hi) { return (r & 3) + 8 * (r >> 2) + 4 * hi; }
#define MFMA32(a, b, c) __builtin_amdgcn_mfma_f32_32x32x16_bf16((a), (b), (c), 0, 0, 0)
#define MFMA16(a, b, c) __builtin_amdgcn_mfma_f32_16x16x32_bf16((a), (b), (c), 0, 0, 0)
DI s16x4 vtr(LAS const char* p) { return __builtin_bit_cast(s16x4, __builtin_amdgcn_ds_read_tr16_b64_v4i16((LAS v4i16_t*)p)); }

#define XB_TMO      128
#define XB_XCNT(j)  (256  + 64 * (j))
#define XB_XSUB(j)  (1280 + 64 * (j))
#define XB_XGEN(j)  (2304 + 64 * (j))
#define XB_TOP      3328
#define XB_TOPGEN   3392
#define XCD_BAR_WORDS 3456
#define XB_SPIN_CAP (1u << 22)
DI unsigned xb_ld(unsigned* p)              { return __hip_atomic_load(p, __ATOMIC_RELAXED, __HIP_MEMORY_SCOPE_AGENT); }
DI unsigned xb_add(unsigned* p, unsigned v) { return __hip_atomic_fetch_add(p, v, __ATOMIC_RELAXED, __HIP_MEMORY_SCOPE_AGENT); }
DI unsigned xb_xcc_id() { return (unsigned)__builtin_amdgcn_s_getreg((3 << 11) | 20) & 0xFu; }
#define XB_SPIN(cond, bar) do { unsigned _sp = 0; while (cond) { __builtin_amdgcn_s_sleep(1); \
    if ((++_sp & 255u) == 0u) { if (xb_ld(&(bar)[XB_TMO])) break; if (_sp > XB_SPIN_CAP) { atomicAdd(&(bar)[XB_TMO], 1u); break; } } } } while (0)
struct XcdBarrier { unsigned* bar; unsigned x; volatile LAS unsigned* st; };
DI XcdBarrier xcd_barrier_post(unsigned* bar, volatile LAS unsigned* st) {
    XcdBarrier b; b.bar = bar; b.x = xb_xcc_id(); b.st = st;
    if (threadIdx.x == 0) (void)xb_add(&bar[XB_XCNT(b.x)], 1u);
    return b;
}
DI void xcd_barrier_complete(unsigned* bar, unsigned x, unsigned& nloc, unsigned& nx) {
    const unsigned G = gridDim.x * gridDim.y * gridDim.z;
    unsigned sum, cnt, mine, sp = 0u;
    for (;;) {
        sum = 0u; cnt = 0u; mine = 0u;
#pragma unroll
        for (unsigned j = 0; j < 16; ++j) { const unsigned c = xb_ld(&bar[XB_XCNT(j)]); sum += c; cnt += (c > 0u) ? 1u : 0u; mine = (j == x) ? c : mine; }
        if (sum == G) break;
        __builtin_amdgcn_s_sleep(1);
        if ((++sp & 255u) == 0u) { if (xb_ld(&bar[XB_TMO])) break; if (sp > XB_SPIN_CAP) { atomicAdd(&bar[XB_TMO], 1u); break; } }
    }
    nloc = mine > 0u ? mine : 1u; nx = cnt > 0u ? cnt : 1u;
}
DI void xcd_barrier(const XcdBarrier& b) {
    asm volatile("s_waitcnt vmcnt(0)" ::: "memory");
    __syncthreads();
    if (threadIdx.x == 0) {
        unsigned* bar = b.bar;
        __builtin_amdgcn_s_waitcnt(0);
        unsigned nloc = b.st[0], nx = b.st[1];
        if (nloc == 0u) { xcd_barrier_complete(bar, b.x, nloc, nx); b.st[0] = nloc; b.st[1] = nx; }
        const unsigned old = xb_add(&bar[XB_XSUB(b.x)], 1u);
        const unsigned gen = old / nloc;
        if (old + 1u == (gen + 1u) * nloc) {
            __builtin_amdgcn_fence(__ATOMIC_RELEASE, "agent");
            asm volatile("s_waitcnt vmcnt(0)" ::: "memory");
            const unsigned og = xb_add(&bar[XB_TOP], 1u);
            const unsigned tg = og / nx;
            if (og + 1u == (tg + 1u) * nx) xb_add(&bar[XB_TOPGEN], 1u);
            else XB_SPIN(xb_ld(&bar[XB_TOPGEN]) == tg, bar);
            __builtin_amdgcn_fence(__ATOMIC_ACQUIRE, "agent");
            xb_add(&bar[XB_XGEN(b.x)], 1u);
            asm volatile("s_waitcnt vmcnt(0)" ::: "memory");
        } else {
            XB_SPIN(xb_ld(&bar[XB_XGEN(b.x)]) == gen, bar);
            __builtin_amdgcn_fence(__ATOMIC_ACQUIRE, "agent");
            asm volatile("s_waitcnt vmcnt(0)" ::: "memory");
        }
    }
    __syncthreads();
}

namespace pg8 {
constexpr int BM = 256, BK = 64, HALF = 128, HTB = HALF * BK * 2, STAGE_BYTES = 8 * HTB, NXCD = 8, WGM = 8;
DI int lds_byte(int r, int c) { const int st = (r >> 4) * 2 + (c >> 5), rr = r & 15, cc = c & 31, ob = rr * 64 + cc * 2; return st * 1024 + (ob ^ (((ob >> 9) & 1) << 5)); }
DI void stage_rc(int b, int& R, int& C) { const int st = b / 1024, sb = b % 1024, swz = sb ^ (((sb >> 9) & 1) << 5); R = (st >> 1) * 16 + swz / 64; C = (st & 1) * 32 + (swz % 64) / 2; }
DI int perm32(int rho) { const int n = rho >> 4, i = rho & 15; return 8 * (i >> 2) + 4 * n + (i & 3); }
struct Unit { int pm, pn, e; };

struct DenseOrder {
    const char* A; const char* Bt; int K, nM, nN, nwg, G, c;
    DI void init(const void* A_, const void* Bt_, int M, int N, int K_, int G_, int c_) { A = (const char*)A_; Bt = (const char*)Bt_; K = K_; nM = M / BM; nN = N / BM; nwg = nM * nN; G = G_; c = c_; }
    DI bool next(int i, Unit& u) const {
        const long L = (long)i * G + c; if (L >= nwg) return false;
        int wgid = (int)L; { const int q = nwg / NXCD, r = nwg % NXCD, xcd = wgid % NXCD, off = wgid / NXCD; wgid = (xcd < r ? xcd * (q + 1) : r * (q + 1) + (xcd - r) * q) + off; }
        const int nig = WGM * nN, gid = wgid / nig, fm = gid * WGM, gsz = (nM - fm) < WGM ? (nM - fm) : WGM;
        u.pm = fm + ((wgid % nig) % gsz); u.pn = (wgid % nig) / gsz; u.e = 0; return true;
    }
    DI const char* a_base(const Unit& u) const { return A + (size_t)u.pm * 512 * K; }
    DI const char* b_base(const Unit& u) const { return Bt + (size_t)u.pn * 512 * K; }
    DI void gather(const Unit&, const int (&)[2], const int (&)[2], unsigned (&)[2][2]) const {}
};
struct MoeOrder {
    const char* A; const char* Bt; const int* row_tok; const int* tile_e; int K, N, nunits, G, c; bool gat;
    DI bool next(int i, Unit& u) const {
        const int L = i * G + c; if (L >= nunits) return false;
        u.pm = L >> 2; u.pn = L & 3;
        u.e = __builtin_amdgcn_readfirstlane(__hip_atomic_load(tile_e + u.pm, __ATOMIC_RELAXED, __HIP_MEMORY_SCOPE_AGENT)); return true;
    }
    DI const char* a_base(const Unit& u) const { return gat ? A : A + (size_t)u.pm * 512 * K; }
    DI const char* b_base(const Unit& u) const { return Bt + ((size_t)u.e * N + (size_t)u.pn * 256) * K * 2; }
    DI void gather(const Unit& u, const int (&Rr)[2], const int (&Cc)[2], unsigned (&o)[2][2]) const {
#pragma unroll
        for (int h = 0; h < 2; ++h)
#pragma unroll
            for (int i = 0; i < 2; ++i) { const int tok = row_tok[u.pm * 256 + h * 128 + Rr[i]]; o[h][i] = (unsigned)(tok * K + Cc[i]) * 2u; }
    }
};

template <class Epi, class Sched, bool GATHER, bool FP8 = false>
DI void gemm_phase(LAS unsigned char* lds, const int K, const Sched& S, const Epi& E) {
    const int tid = threadIdx.x, wid = __builtin_amdgcn_readfirstlane(tid >> 6), lane = tid & 63, wr = wid >> 2, wc = wid & 3, fr = lane & 15, fq = lane >> 4;
    const int nt = K / BK;
    unsigned voffB[2], vA[2][2], nvA[2][2]; int Rr[2], Cc[2];
#pragma unroll
    for (int i = 0; i < 2; ++i) { int R, C; stage_rc(tid * 16 + i * 8192, R, C); Rr[i] = R; Cc[i] = C; const int Rb = (R & ~31) + perm32(R & 31);
        voffB[i] = (unsigned)(Rb * K + C) * 2u; vA[0][i] = (unsigned)(R * K + C) * 2u; vA[1][i] = (unsigned)((R + HALF) * K + C) * 2u; nvA[0][i] = vA[0][i]; nvA[1][i] = vA[1][i]; }
    const size_t kstep = (size_t)(BK * 2);
    const size_t hstep = (size_t)HALF * K * 2;
    const unsigned ldsw = (unsigned)wid * 1024u;
    const int aoff = lds_byte(wr * 64 + fr, fq * 8), boff = lds_byte(wc * 32 + fr, fq * 8);
#define PG8_SA(b, h) (((b) * 2 + (h)) * HTB)
#define PG8_SB(b, h) ((4 + (b) * 2 + (h)) * HTB)
#define PG8_STAGE(bufoff, gbase, voff) do { _Pragma("unroll") for (int _i = 0; _i < 2; ++_i) \
        __builtin_amdgcn_global_load_lds((const unsigned*)((const char*)(gbase) + (voff)[_i]), (LAS unsigned*)(lds + (bufoff) + ldsw + _i * 8192), 16, 0, 0); } while (0)
#define PG8_LDA(dst, b, h) do { if constexpr (FP8) { _Pragma("unroll") for (int m = 0; m < 4; ++m) dst##8[m] = __builtin_shufflevector(*(const LAS v4i*)(lds + PG8_SA(b, h) + aoff + m * 2048), *(const LAS v4i*)(lds + PG8_SA(b, h) + aoff + m * 2048 + 1024), 0, 1, 2, 3, 4, 5, 6, 7); } \
        else { _Pragma("unroll") for (int m = 0; m < 4; ++m) _Pragma("unroll") for (int k = 0; k < 2; ++k) dst[m][k] = *(const LAS bf16x8*)(lds + PG8_SA(b, h) + aoff + m * 2048 + k * 1024); } } while (0)
#define PG8_LDB(dst, b, h) do { if constexpr (FP8) { _Pragma("unroll") for (int n = 0; n < 2; ++n) dst##8[n] = __builtin_shufflevector(*(const LAS v4i*)(lds + PG8_SB(b, h) + boff + n * 2048), *(const LAS v4i*)(lds + PG8_SB(b, h) + boff + n * 2048 + 1024), 0, 1, 2, 3, 4, 5, 6, 7); } \
        else { _Pragma("unroll") for (int n = 0; n < 2; ++n) _Pragma("unroll") for (int k = 0; k < 2; ++k) dst[n][k] = *(const LAS bf16x8*)(lds + PG8_SB(b, h) + boff + n * 2048 + k * 1024); } } while (0)
#define PG8_CAT(x, y) __builtin_shufflevector(__builtin_bit_cast(v4i, (x)), __builtin_bit_cast(v4i, (y)), 0, 1, 2, 3, 4, 5, 6, 7)
#define PG8_MMA(ai, bj, At, Bt) do { __builtin_amdgcn_s_setprio(1); if constexpr (FP8) { _Pragma("unroll") for (int m = 0; m < 4; ++m) _Pragma("unroll") for (int n = 0; n < 2; ++n) \
        asm volatile("v_mfma_scale_f32_16x16x128_f8f6f4 %0, %1, %2, %0, %3, %3 op_sel_hi:[0,0,0]" : "+v"(acc[ai][bj][m][n]) : "v"(Bt##8[n]), "v"(At##8[m]), "v"(fp8_unit_scale)); } else { \
        _Pragma("unroll") for (int m = 0; m < 4; ++m) _Pragma("unroll") for (int n = 0; n < 2; ++n) _Pragma("unroll") for (int k = 0; k < 2; ++k) \
        acc[ai][bj][m][n] = __builtin_amdgcn_mfma_f32_16x16x32_bf16(Bt[n][k], At[m][k], acc[ai][bj][m][n], 0, 0, 0); } __builtin_amdgcn_s_setprio(0); } while (0)
#define PG8_WAIT_V(n) asm volatile("s_waitcnt vmcnt(" #n ")" ::: "memory")
#define PG8_WAIT_L(n) asm volatile("s_waitcnt lgkmcnt(" #n ")" ::: "memory")
#define PG8_BAR __builtin_amdgcn_s_barrier()
#define PG8_SCHED __builtin_amdgcn_sched_barrier(0)
    Unit cur, nxt; int ui = 0;
    if (!S.next(0, cur)) return;
    if constexpr (GATHER) S.gather(cur, Rr, Cc, vA);
    f32x4 acc[2][2][4][2];
#pragma unroll
    for (int a = 0; a < 2; ++a)
#pragma unroll
        for (int b = 0; b < 2; ++b)
#pragma unroll
            for (int m = 0; m < 4; ++m)
#pragma unroll
                for (int n = 0; n < 2; ++n) acc[a][b][m][n] = (f32x4){0.f, 0.f, 0.f, 0.f};
    bf16x8 At[4][2], B0[2][2], B1[2][2]; v8i At8[4], B08[2], B18[2]; const int fp8_unit_scale = 0x7f7f7f7f;
    const char* cA = S.a_base(cur); const char* cB = S.b_base(cur);
    PG8_STAGE(PG8_SB(0, 0), cB, voffB); PG8_STAGE(PG8_SB(0, 1), cB + hstep, voffB); PG8_STAGE(PG8_SA(0, 0), cA, vA[0]); PG8_STAGE(PG8_SA(0, 1), cA, vA[1]);
    if (wr == 1) PG8_BAR;
    PG8_WAIT_V(2); PG8_BAR;
    PG8_STAGE(PG8_SB(1, 0), cB + kstep, voffB); PG8_STAGE(PG8_SA(1, 0), cA + kstep, vA[0]); PG8_STAGE(PG8_SB(1, 1), cB + hstep + kstep, voffB);
    PG8_WAIT_V(6); PG8_BAR;
    for (;;) {
        const bool has_next = S.next(ui + 1, nxt);
        const char* nA = has_next ? S.a_base(nxt) : cA; const char* nB = has_next ? S.b_base(nxt) : cB;
        if constexpr (GATHER) {
            if (has_next) S.gather(nxt, Rr, Cc, nvA);
            else {
#pragma unroll
                for (int h = 0; h < 2; ++h) { nvA[h][0] = vA[h][0]; nvA[h][1] = vA[h][1]; } }
        }
#pragma unroll 1
        for (int t = 0; t < nt; t += 2) {
            const bool last = (t == nt - 2);
            if constexpr (Epi::HAS_MID) { if (t == (nt >> 1)) { if constexpr (FP8) asm volatile("s_nop 15\n\ts_nop 15" ::: "memory"); E.mid(acc, cur, wr, wc, fr, fq); if constexpr (FP8) asm volatile("s_nop 7" ::: "memory"); } }
            const char* a1 = cA + (size_t)(t + 1) * kstep;
            const char* a2 = last ? nA : cA + (size_t)(t + 2) * kstep; const char* b2 = last ? nB : cB + (size_t)(t + 2) * kstep;
            const char* a3 = a2 + kstep; const char* b3 = b2 + kstep;
            unsigned o0[2], o1[2];
            if constexpr (GATHER) { o0[0] = last ? nvA[0][0] : vA[0][0]; o0[1] = last ? nvA[0][1] : vA[0][1]; o1[0] = last ? nvA[1][0] : vA[1][0]; o1[1] = last ? nvA[1][1] : vA[1][1]; }
            else { o0[0] = vA[0][0]; o0[1] = vA[0][1]; o1[0] = vA[1][0]; o1[1] = vA[1][1]; }
            PG8_LDB(B0, 0, 0); PG8_LDB(B1, 0, 1); PG8_SCHED; PG8_LDA(At, 0, 0); PG8_STAGE(PG8_SA(1, 1), a1, vA[1]);
            PG8_WAIT_V(8); PG8_WAIT_L(0); PG8_BAR; PG8_MMA(0, 0, At, B0); PG8_MMA(0, 1, At, B1); PG8_BAR; PG8_SCHED;
            PG8_LDA(At, 0, 1); PG8_STAGE(PG8_SB(0, 0), b2, voffB); PG8_STAGE(PG8_SB(0, 1), b2 + hstep, voffB); PG8_STAGE(PG8_SA(0, 0), a2, o0);
            PG8_WAIT_V(8); PG8_WAIT_L(0); PG8_BAR; PG8_MMA(1, 0, At, B0); PG8_MMA(1, 1, At, B1); PG8_BAR; PG8_SCHED;
            PG8_LDB(B0, 1, 0); PG8_LDB(B1, 1, 1); PG8_SCHED; PG8_LDA(At, 1, 0); PG8_STAGE(PG8_SA(0, 1), a2, o1);
            PG8_WAIT_V(8); PG8_WAIT_L(0); PG8_BAR; PG8_MMA(0, 0, At, B0); PG8_MMA(0, 1, At, B1); PG8_BAR; PG8_SCHED;
            PG8_LDA(At, 1, 1); PG8_STAGE(PG8_SB(1, 0), b3, voffB); PG8_STAGE(PG8_SB(1, 1), b3 + hstep, voffB); PG8_STAGE(PG8_SA(1, 0), a3, o0);
            PG8_WAIT_V(8); PG8_WAIT_L(0); PG8_BAR; PG8_MMA(1, 0, At, B0); PG8_MMA(1, 1, At, B1); PG8_BAR; PG8_SCHED;
        }
        if (wr == 0) PG8_BAR;
        if constexpr (FP8) asm volatile("s_nop 15\n\ts_nop 15" ::: "memory");
        E(acc, cur, wr, wc, fr, fq);
        if (!has_next) break;
#pragma unroll
        for (int a = 0; a < 2; ++a)
#pragma unroll
            for (int b = 0; b < 2; ++b)
#pragma unroll
                for (int m = 0; m < 4; ++m)
#pragma unroll
                    for (int n = 0; n < 2; ++n) acc[a][b][m][n] = (f32x4){0.f, 0.f, 0.f, 0.f};
        cur = nxt; cA = nA; cB = nB; ++ui;
        if constexpr (GATHER) {
#pragma unroll
            for (int h = 0; h < 2; ++h) { vA[h][0] = nvA[h][0]; vA[h][1] = nvA[h][1]; } }
        if (wr == 1) PG8_BAR;
    }
    PG8_WAIT_V(0);
    PG8_BAR;
#undef PG8_SA
#undef PG8_SB
#undef PG8_STAGE
#undef PG8_LDA
#undef PG8_LDB
#undef PG8_MMA
#undef PG8_CAT
#undef PG8_WAIT_V
#undef PG8_WAIT_L
#undef PG8_BAR
#undef PG8_SCHED
}

typedef f32x4 Acc[2][2][4][2];
DI u32x4 pack8(const f32x4 a, const f32x4 b) { u32x4 w; w.x = cvtpk(a[0], a[1]); w.y = cvtpk(a[2], a[3]); w.z = cvtpk(b[0], b[1]); w.w = cvtpk(b[2], b[3]); return w; }
DI f32x4 silu4(const f32x4 v) { f32x4 o; o[0] = v[0] * fsigmoid(v[0]); o[1] = v[1] * fsigmoid(v[1]); o[2] = v[2] * fsigmoid(v[2]); o[3] = v[3] * fsigmoid(v[3]); return o; }

struct EpiIn {
    static constexpr bool HAS_MID = false;
    bf16 *Qh, *Vh, *Gh, *Qm, *Km, *Vm, *Rr, *Gb; float *Zf, *KM; const float* bias; bf16* KK; const float* LB; int pn_off;
    DI void operator()(Acc& acc, const Unit& u, int wr, int wc, int fr, int fq) const {
        const int pn = u.pn + pn_off, row0 = u.pm * BM + wr * 64 + fr, cl = wc * 32 + 8 * fq;
        if (pn_off) {
#pragma unroll
            for (int ai = 0; ai < 2; ++ai)
#pragma unroll
                for (int bj = 0; bj < 2; ++bj)
#pragma unroll
                    for (int m = 0; m < 4; ++m) { acc[ai][bj][m][0] *= (1.f / (FP8_SXI * FP8_SW)); acc[ai][bj][m][1] *= (1.f / (FP8_SXI * FP8_SW)); } }
        f32x4 bv[2][2];
#pragma unroll
        for (int bj = 0; bj < 2; ++bj)
#pragma unroll
            for (int n = 0; n < 2; ++n) bv[bj][n] = *(const f32x4*)(bias + pn * 256 + bj * HALF + cl + 4 * n);
        if (pn < 4) {
#define EI_DPP(v, ctrl) __int_as_float(__builtin_amdgcn_update_dpp(0, __float_as_int(v), ctrl, 0xf, 0xf, true))
            const int chb = pn * 128 + cl;
#pragma unroll
            for (int ai = 0; ai < 2; ++ai)
#pragma unroll
                for (int n = 0; n < 2; ++n) { const f32x4 lbv = *(const f32x4*)(LB + chb + 4 * n); f32x4 run = (f32x4){0.f, 0.f, 0.f, 0.f}, bmid = run; f32x4 bbv[4], kkv[4];
#pragma unroll
                    for (int m = 0; m < 4; ++m) {
#pragma unroll
                        for (int j = 0; j < 4; ++j) { const float z = acc[ai][1][m][n][j] + bv[1][n][j]; const float sg = frcp(1.f + __expf(-z)); const float lf = __logf(lbv[j] + (1.f - lbv[j]) * sg); kkv[m][j] = (1.f - lbv[j]) * (1.f - sg);
                            float t = lf; t += EI_DPP(t, 0xB1); t += EI_DPP(t, 0x4E); t += EI_DPP(t, 0x141); t += EI_DPP(t, 0x140);
                            float s = lf; s += EI_DPP(s, 0x111); s += EI_DPP(s, 0x112); s += EI_DPP(s, 0x114); s += EI_DPP(s, 0x118);
                            bbv[m][j] = s + run[j]; run[j] += t; }
                        if (m == 1) bmid = run; }
#pragma unroll
                    for (int m = 0; m < 4; ++m) { f32x4 qp, kp;
#pragma unroll
                        for (int j = 0; j < 4; ++j) { const float qx = acc[ai][0][m][n][j] + bv[0][n][j]; const float e = __expf(bbv[m][j] - bmid[j]); qp[j] = qx * fsigmoid(qx) * e; kp[j] = kkv[m][j] * frcp(e); }
                        const size_t ro = (size_t)(row0 + ai * HALF + m * 16) * 512 + chb + 4 * n;
                        u32x2 qw, kw; qw.x = cvtpk(qp[0], qp[1]); qw.y = cvtpk(qp[2], qp[3]); kw.x = cvtpk(kp[0], kp[1]); kw.y = cvtpk(kp[2], kp[3]);
                        *(u32x2*)(Qh + ro) = qw; *(u32x2*)(KK + ro) = kw; }
                    if (fr == 0) { const size_t so = (size_t)(u.pm * 4 + ai * 2 + wr) * 512 + chb + 4 * n; *(f32x4*)(Zf + so) = bmid; *(f32x4*)(Zf + 262144 + so) = run; }
                    asm volatile("" ::: "memory"); }
#undef EI_DPP
        } else if (pn < 14) {
            const int seg = pn >> 1, c0 = (pn & 1) * 256 + cl;
            {
                bf16* O = seg == 2 ? Vh : seg == 3 ? Gh : seg == 4 ? Qm : seg == 5 ? Km : Vm;
                const int act = (seg == 3) ? 1 : (seg == 4 ? 2 : 0);
                if (seg == 5) {
#pragma unroll
                    for (int bj = 0; bj < 2; ++bj)
#pragma unroll
                        for (int n = 0; n < 2; ++n) { f32x4 cs = (f32x4){0.f, 0.f, 0.f, 0.f};
#pragma unroll
                            for (int ai = 0; ai < 2; ++ai)
#pragma unroll
                                for (int m = 0; m < 4; ++m) cs += acc[ai][bj][m][n] + bv[bj][n];
#pragma unroll
                            for (int j = 0; j < 4; ++j) { float s = cs[j]; s += __shfl_xor(s, 1); s += __shfl_xor(s, 2); s += __shfl_xor(s, 4); s += __shfl_xor(s, 8); cs[j] = s; }
                            if (fr == 0) *(f32x4*)(KM + (size_t)(u.pm * 2 + wr) * 512 + c0 + bj * HALF + 4 * n) = cs; }
                }
#pragma unroll
                for (int ai = 0; ai < 2; ++ai)
#pragma unroll
                    for (int m = 0; m < 4; ++m) { const int row = row0 + ai * HALF + m * 16;
                        bf16* rp = (seg >= 4) ? O + ((size_t)(row >> 11) * 8 * SEQ + (row & (SEQ - 1))) * 64 + (size_t)(c0 >> 6) * SEQ * 64 + (c0 & 63) : O + (size_t)row * 512 + c0;
                        const size_t bjs = (seg >= 4) ? (size_t)2 * SEQ * 64 : (size_t)HALF;
#pragma unroll
                        for (int bj = 0; bj < 2; ++bj) { f32x4 v0 = acc[ai][bj][m][0] + bv[bj][0], v1 = acc[ai][bj][m][1] + bv[bj][1];
                            if (act == 1) { v0 = silu4(v0); v1 = silu4(v1); } else if (act == 2) { v0 = v0 * (0.125f * LOG2E); v1 = v1 * (0.125f * LOG2E); }
                            *(u32x4*)(rp + bj * bjs) = pack8(v0, v1); }
                        asm volatile("" ::: "memory"); }
            }
        } else {
            const int c0 = (pn - 14) * 128 + cl;
#pragma unroll
            for (int ai = 0; ai < 2; ++ai)
#pragma unroll
                for (int m = 0; m < 4; ++m) { const size_t off = (size_t)(row0 + ai * HALF + m * 16) * 1024 + c0; f32x4 r[2], g[2];
#pragma unroll
                    for (int n = 0; n < 2; ++n) { const f32x4 a = acc[ai][0][m][n] + bv[0][n], b = acc[ai][1][m][n] + bv[1][n];
#pragma unroll
                        for (int j = 0; j < 4; ++j) { const float ea = __expf(-a[j]), eb = __expf(-b[j]); g[n][j] = frcp(1.f + eb); r[n][j] = (1.f + eb) * frcp(1.f + ea); } }
                    *(u32x4*)(Rr + off) = pack8(r[0], r[1]); *(u32x4*)(Gb + off) = pack8(g[0], g[1]); asm volatile("" ::: "memory"); }
        }
    }
};
struct EpiProj {
    static constexpr bool HAS_MID = true;
    const bf16 *Rr, *Gb; unsigned char* U;
    DI void scale(Acc& acc, const bf16* G, const Unit& u, int wr, int wc, int fr, int fq) const {
        int row0 = u.pm * BM + wr * 64 + fr, col0 = u.pn * BM + wc * 32 + 8 * fq;
        asm volatile("" : "+v"(row0), "+v"(col0));
#pragma unroll
        for (int ai = 0; ai < 2; ++ai)
#pragma unroll
            for (int mp = 0; mp < 2; ++mp) { u32x4 rv[2][2];
#pragma unroll
            for (int m = 0; m < 2; ++m)
#pragma unroll
                for (int bj = 0; bj < 2; ++bj) rv[m][bj] = *(const u32x4*)(G + (size_t)(row0 + ai * HALF + (2 * mp + m) * 16) * 1024 + col0 + bj * HALF);
#pragma unroll
            for (int m = 0; m < 2; ++m)
#pragma unroll
                for (int bj = 0; bj < 2; ++bj) { const u32x4 w = rv[m][bj];
                    acc[ai][bj][2 * mp + m][0] *= (f32x4){bflo(w.x), bfhi(w.x), bflo(w.y), bfhi(w.y)}; acc[ai][bj][2 * mp + m][1] *= (f32x4){bflo(w.z), bfhi(w.z), bflo(w.w), bfhi(w.w)}; }
            asm volatile("" ::: "memory"); }
    }
    DI void mid(Acc& acc, const Unit& u, int wr, int wc, int fr, int fq) const { scale(acc, Rr, u, wr, wc, fr, fq); }
    DI void operator()(Acc& acc, const Unit& u, int wr, int wc, int fr, int fq) const {
        scale(acc, Gb, u, wr, wc, fr, fq);
        const int row0 = u.pm * BM + wr * 64 + fr, col0 = u.pn * BM + wc * 32 + 8 * fq;
        constexpr float inv = FP8_SU / (FP8_SO * FP8_SW);
#pragma unroll
        for (int ai = 0; ai < 2; ++ai)
#pragma unroll
            for (int m = 0; m < 4; ++m) { unsigned char* rp = U + (size_t)(row0 + ai * HALF + m * 16) * 1024 + col0;
#pragma unroll
                for (int bj = 0; bj < 2; ++bj) { const f32x4 v0 = acc[ai][bj][m][0] * inv, v1 = acc[ai][bj][m][1] * inv; u32x2 w; w.x = cvt4_fp8(v0[0], v0[1], v0[2], v0[3]); w.y = cvt4_fp8(v1[0], v1[1], v1[2], v1[3]); *(u32x2*)(rp + bj * HALF) = w; } }
    }
};
struct EpiOut {
    static constexpr bool HAS_MID = false;
    const float* X; float* Pre;
    DI void operator()(Acc& acc, const Unit& u, int wr, int wc, int fr, int fq) const {
        const int row0 = u.pm * BM + wr * 64 + fr, col0 = u.pn * BM + wc * 32 + 8 * fq;
#pragma unroll
        for (int ai = 0; ai < 2; ++ai)
#pragma unroll
            for (int m = 0; m < 4; ++m) { const size_t off = (size_t)(row0 + ai * HALF + m * 16) * 1024 + col0;
#pragma unroll
                for (int bj = 0; bj < 2; ++bj) { const f32x4 x0 = *(const f32x4*)(X + off + bj * HALF), x1 = *(const f32x4*)(X + off + bj * HALF + 4);
                    *(f32x4*)(Pre + off + bj * HALF) = x0 * DN_ALPHA + acc[ai][bj][m][0] * (1.f / (FP8_SU * FP8_SW)); *(f32x4*)(Pre + off + bj * HALF + 4) = x1 * DN_ALPHA + acc[ai][bj][m][1] * (1.f / (FP8_SU * FP8_SW)); }
                if (m & 1) asm volatile("" ::: "memory"); }
    }
};
struct EpiM1 {
    static constexpr bool HAS_MID = false;
    unsigned char* H;
    DI void operator()(Acc& acc, const Unit& u, int wr, int wc, int fr, int fq) const {
        const int row0 = u.pm * BM + wr * 64 + fr, col0 = u.pn * 128 + wc * 32 + 8 * fq;
        constexpr float inv = 1.f / (FP8_SX * FP8_SW);
#pragma unroll
        for (int ai = 0; ai < 2; ++ai)
#pragma unroll
            for (int m = 0; m < 4; ++m) { const f32x4 h0 = silu4(acc[ai][0][m][0] * inv) * (acc[ai][1][m][0] * (inv * FP8_SH)), h1 = silu4(acc[ai][0][m][1] * inv) * (acc[ai][1][m][1] * (inv * FP8_SH));
                u32x2 w; w.x = cvt4_fp8(h0[0], h0[1], h0[2], h0[3]); w.y = cvt4_fp8(h1[0], h1[1], h1[2], h1[3]);
                *(u32x2*)(H + (size_t)(row0 + ai * HALF + m * 16) * 512 + col0) = w; }
    }
};
struct EpiM2 {
    static constexpr bool HAS_MID = false;
    bf16* Y;
    DI void operator()(Acc& acc, const Unit& u, int wr, int wc, int fr, int fq) const {
        const int row0 = u.pm * BM + wr * 64 + fr, col0 = u.pn * BM + wc * 32 + 8 * fq;
        constexpr float inv = 1.f / (FP8_SH * FP8_SW);
#pragma unroll
        for (int ai = 0; ai < 2; ++ai)
#pragma unroll
            for (int m = 0; m < 4; ++m) { bf16* rp = Y + (size_t)(row0 + ai * HALF + m * 16) * 1024 + col0;
#pragma unroll
                for (int bj = 0; bj < 2; ++bj) *(u32x4*)(rp + bj * HALF) = pack8(acc[ai][bj][m][0] * inv, acc[ai][bj][m][1] * inv); }
    }
};
}

struct Args { const float* in[19]; float* out; unsigned char* ws; int ph_lo, ph_hi; };
enum { I_X = 0, I_WIN, I_BIN, I_LBL, I_HGNG, I_RELB, I_WPA, I_WPB, I_WOUT, I_LN1G, I_LN1B, I_WGRP, I_BGRP, I_WEXP, I_BEXP, I_WGU, I_WDN, I_LN2G, I_LN2B };

struct Ctx {
    LAS unsigned char* lds; volatile LAS unsigned* MISC;
    int tid, lane, wid, G, vcu;
    unsigned char* ws; gu32* ctl;
};

DI int win_drow(int n0) { if (n0 < 512) return 256 * (n0 >> 7) + (n0 & 127); if (n0 < 1024) { const int r = n0 - 512; return 256 * (r >> 7) + 128 + (r & 127); }
    if (n0 < 3584) return n0; if (n0 < 4608) { const int r = n0 - 3584; return 3584 + 256 * (r >> 7) + (r & 127); } const int r = n0 - 4608; return 3584 + 256 * (r >> 7) + 128 + (r & 127); }
DI int wgu_drow(int n0) { if (n0 < 512) return 256 * (n0 >> 7) + (n0 & 127); const int r = n0 - 512; return 256 * (r >> 7) + 128 + (r & 127); }
DI int hswz(int row, int ch16) { return 256 * row + 16 * (ch16 ^ (((row & 3) << 2) | ((row >> 2) & 3))); }
DI int htr(int r0, int c0, int lane) { const int i16 = lane & 15, q = i16 >> 2, p = i16 & 3; return hswz(r0 + q, c0 + (p >> 1)) + 8 * (p & 1); }
DI void transpose_tile256(const float* W, int N, bf16* WT, int ldk, int n0, int mode, int dk, LAS unsigned char* lds, int lane, int wid, bool f8 = false) {
    asm volatile("" : "+v"(lane));
#pragma unroll
    for (int half = 0; half < 2; ++half) { f32x4 v[16];
#pragma unroll
        for (int i = 0; i < 16; ++i) v[i] = *(const f32x4*)(W + (size_t)(128 * half + 8 * i + wid) * N + 4 * lane);
#pragma unroll
        for (int i = 0; i < 16; ++i) { const int k = 128 * half + 8 * i + wid; u32x2 w; w.x = cvtpk(v[i][0], v[i][1]); w.y = cvtpk(v[i][2], v[i][3]);
            *(LAS u32x2*)(lds + (lane >> 5) * 65536 + hswz(k, (lane & 31) >> 1) + 8 * (lane & 1)) = w; } }
    __syncthreads();
    const int g = lane >> 4, i16 = lane & 15;
#pragma unroll
    for (int nb = 0; nb < 2; ++nb) { const int nl = 32 * wid + 16 * nb + i16, n = n0 + nl; const int dr = (mode == 0) ? n : (mode == 1 ? win_drow(n) : wgu_drow(n));
        bf16* orow = WT + (size_t)dr * ldk + dk + 8 * g; const LAS unsigned char* img = lds + (wid >> 2) * 65536;
#pragma unroll
        for (int s = 0; s < 8; ++s) { const int r0 = 32 * s + 8 * g, c0 = 4 * (wid & 3) + 2 * nb;
            const s16x4 lo = vtr((LAS const char*)(img + htr(r0, c0, lane))), hh = vtr((LAS const char*)(img + htr(r0 + 4, c0, lane)));
            if (f8) { u32x2 w; w.x = cvt4_fp8(bf2f((unsigned short)lo[0]) * FP8_SW, bf2f((unsigned short)lo[1]) * FP8_SW, bf2f((unsigned short)lo[2]) * FP8_SW, bf2f((unsigned short)lo[3]) * FP8_SW);
                w.y = cvt4_fp8(bf2f((unsigned short)hh[0]) * FP8_SW, bf2f((unsigned short)hh[1]) * FP8_SW, bf2f((unsigned short)hh[2]) * FP8_SW, bf2f((unsigned short)hh[3]) * FP8_SW);
                *(u32x2*)((unsigned char*)WT + (size_t)dr * ldk + dk + 8 * g + 32 * s) = w; }
            else *(bf16x8*)(orow + 32 * s) = (bf16x8){lo[0], lo[1], lo[2], lo[3], hh[0], hh[1], hh[2], hh[3]}; } }
    __syncthreads();
}
constexpr int MOE_CVT_TILES = 32 * 16 + 32 * 8;
DI void moe_cvt_tile(const Ctx& C, const Args& a, int it) {
    unsigned char* WguT = (unsigned char*)a.out; unsigned char* WdT = (unsigned char*)a.out + 32 * MiB;
    if (it < 512) { const int e = it >> 4, kt = (it >> 2) & 3, nt = it & 3;
        transpose_tile256(a.in[I_WGU] + (size_t)e * 1024 * 1024 + (size_t)(256 * kt) * 1024 + 256 * nt, 1024, (bf16*)(WguT + (size_t)e * 1024 * 1024), 1024, 256 * nt, 2, 256 * kt, C.lds, C.lane, C.wid, true); }
    else { const int r = it - 512, e = r >> 3, kt = (r >> 2) & 1, nt = r & 3;
        transpose_tile256(a.in[I_WDN] + (size_t)e * 512 * 1024 + (size_t)(256 * kt) * 1024 + 256 * nt, 1024, (bf16*)(WdT + (size_t)e * 1024 * 512), 512, 256 * nt, 0, 256 * kt, C.lds, C.lane, C.wid, true); }
}
DI void p0_prologue(const Ctx& C, const Args& a) {
    bf16* WinT = (bf16*)(C.ws + WS_WIN); bf16* Wcat = (bf16*)(C.ws + WS_WCAT); bf16* WoT = (bf16*)(C.ws + WS_WO);
    constexpr int I_IN = 4 * 22, I_PA = 2 * 4, I_O = 4 * 4, NITEMS = I_IN + 2 * I_PA + I_O;
    for (int it = C.vcu; it < NITEMS; it += C.G) {
        int r = it;
        if (r < I_IN) { const int kt = r / 22, nt = r % 22;
            if (nt < 8) transpose_tile256(a.in[I_WIN] + (size_t)(256 * kt) * NIN + 256 * nt, NIN, WinT, 1024, 256 * nt, 1, 256 * kt, C.lds, C.lane, C.wid);
            else transpose_tile256(a.in[I_WIN] + (size_t)(256 * kt) * NIN + 256 * nt, NIN, (bf16*)(C.ws + WS_WIN + 4 * MiB - (size_t)2048 * 1024), 1024, 256 * nt, 1, 256 * kt, C.lds, C.lane, C.wid, true);
            continue; } r -= I_IN;
        if (r < I_PA) { const int kt = r / 4, nt = r % 4; transpose_tile256(a.in[I_WPA] + (size_t)(256 * kt) * 1024 + 256 * nt, 1024, Wcat, 1024, 256 * nt, 0, 256 * kt, C.lds, C.lane, C.wid, true); continue; } r -= I_PA;
        if (r < I_PA) { const int kt = r / 4, nt = r % 4; transpose_tile256(a.in[I_WPB] + (size_t)(256 * kt) * 1024 + 256 * nt, 1024, Wcat, 1024, 256 * nt, 0, 512 + 256 * kt, C.lds, C.lane, C.wid, true); continue; } r -= I_PA;
        { const int kt = r / 4, nt = r % 4; transpose_tile256(a.in[I_WOUT] + (size_t)(256 * kt) * 1024 + 256 * nt, 1024, WoT, 1024, 256 * nt, 0, 256 * kt, C.lds, C.lane, C.wid, true); }
    }
    const int gw = C.vcu * NWAVES + C.wid, NGW = C.G * NWAVES; (void)gw; (void)NGW;
    const int gt = C.vcu * NTHREADS + C.tid, NT = C.G * NTHREADS;
    { const float* x = a.in[I_X]; bf16* Xb = (bf16*)(C.ws + WS_XB);
      unsigned char* Xq = (unsigned char*)a.out + 64 * MiB;
      for (int i = gt; i < NTOK * DM / 8; i += NT) { const f32x4 v0 = *(const f32x4*)(x + (size_t)i * 8), v1 = *(const f32x4*)(x + (size_t)i * 8 + 4); *(u32x4*)(Xb + (size_t)i * 8) = pg8::pack8(v0, v1);
          u32x2 q; q.x = cvt4_fp8(v0[0] * FP8_SXI, v0[1] * FP8_SXI, v0[2] * FP8_SXI, v0[3] * FP8_SXI); q.y = cvt4_fp8(v1[0] * FP8_SXI, v1[1] * FP8_SXI, v1[2] * FP8_SXI, v1[3] * FP8_SXI); *(u32x2*)(Xq + (size_t)i * 8) = q; } }
    { float* lbp = (float*)(C.ws + WS_LB); for (int n = gt; n < 512; n += NT) lbp[n] = 1.f / (1.f + expf(a.in[I_LBL][512 + n] - a.in[I_LBL][n])); }
    { float* bp = (float*)(C.ws + WS_BPERM); const float* bin = a.in[I_BIN];
      for (int n = gt; n < NIN; n += NT) bp[win_drow(n & ~31) + (n & 31)] = bin[n]; }
    { bf16* wh = (bf16*)(C.ws + WS_WRH); bf16* wl = (bf16*)(C.ws + WS_WRL); const float* wg = a.in[I_WGRP]; const float* we = a.in[I_WEXP];
      for (int i = gt; i < 48 * 1024; i += NT) { const int j = i >> 10, k = i & 1023; float w = 0.f; if (j < 4) w = wg[k * 4 + j]; else if (j < 36) w = we[k * 32 + (j - 4)];
          const unsigned h = cvtpk(w, 0.f) & 0xffffu; const float r = w - bf2f((unsigned short)h); wh[i] = (bf16)h; wl[i] = (bf16)(cvtpk(r, 0.f) & 0xffffu); } }
}
constexpr int HG_BUF = 67072, HG_QP = 0, HG_KP = 16384, HG_V = 32768, HG_SC = 49152, HG_OB = 49664;
DI void hgrn_unit(const Ctx& C, const Args& a, int b, int h) {
    LAS unsigned char* L = C.lds;
    const int tid = C.tid, lane = C.lane, wid = C.wid;
    const int q32 = lane & 31, hi = lane >> 5, dh = (lane >> 4) & 1, dvb = wid & 3, tb = wid >> 2;
    const float* BM = (const float*)(C.ws + WS_ZF); const float* BE = BM + 262144;
    const bf16* Qh = (const bf16*)(C.ws + WS_QH); const bf16* Kh = (const bf16*)(C.ws + WS_KK); const bf16* Vh = (const bf16*)(C.ws + WS_VH); const bf16* Gh = (const bf16*)(C.ws + WS_GH);
    bf16* Ocat = (bf16*)(C.ws + WS_XB);
    const size_t rb = (size_t)b * SEQ;
    LAS float* NGS = (LAS float*)(L + 2 * HG_BUF);
    if (tid < 128) NGS[tid] = a.in[I_HGNG][h * 128 + tid];
    const int orow = tid >> 3, oseg = tid & 7;
    f32x16 T[4];
#pragma unroll
    for (int i = 0; i < 4; ++i)
#pragma unroll
        for (int r = 0; r < 16; ++r) T[i][r] = 0.f;
    u32x4 gr[2];
    const int drow = 8 * wid + (lane >> 4), dch = lane & 15;
#define HG_DMA(c) do { _Pragma("unroll") for (int p = 0; p < 2; ++p) { const int r_ = drow + 4 * p; const int sc_ = dch ^ (((r_ & 3) << 2) | ((r_ >> 2) & 3)); \
            const size_t g_ = (rb + (size_t)(c) * 64 + r_) * 512 + h * 128 + 8 * sc_; LAS unsigned char* d_ = L + ((c) & 1) * HG_BUF + (8 * wid + 4 * p) * 256; \
            __builtin_amdgcn_global_load_lds((const unsigned*)(Qh + g_), (LAS unsigned*)(d_ + HG_QP), 16, 0, 0); \
            __builtin_amdgcn_global_load_lds((const unsigned*)(Kh + g_), (LAS unsigned*)(d_ + HG_KP), 16, 0, 0); \
            __builtin_amdgcn_global_load_lds((const unsigned*)(Vh + g_), (LAS unsigned*)(d_ + HG_V), 16, 0, 0); } } while (0)
    float sm = 0.f, spe = 0.f, spm = 0.f;
#define HG_SCLOAD(c) do { if (tid < 128) { const size_t s_ = (size_t)(b * 32 + (c)) * 512 + h * 128 + tid; sm = BM[s_]; if ((c) > 0) { spe = BE[s_ - 512]; spm = BM[s_ - 512]; } } } while (0)
#define HG_SCALE(c) do { if (tid < 128) ((LAS float*)(L + ((c) & 1) * HG_BUF + HG_SC))[tid] = __expf(sm + (spe - spm)); } while (0)
    HG_DMA(0);
    HG_SCLOAD(0);
    HG_SCALE(0);
    asm volatile("s_waitcnt vmcnt(0)" ::: "memory");
    __syncthreads();
    for (int c = 0; c < 32; ++c) {
        const LAS unsigned char* B = L + (c & 1) * HG_BUF;
        if (c + 1 < 32) { HG_DMA(c + 1); HG_SCLOAD(c + 1); }
        int q32o = q32, hio = hi, laneo = lane; asm volatile("" : "+v"(q32o), "+v"(hio), "+v"(laneo));
        f32x16 oT;
#pragma unroll
        for (int r = 0; r < 16; ++r) oT[r] = 0.f;
        bf16x8 qb[8];
#pragma unroll
        for (int ks = 0; ks < 8; ++ks) qb[ks] = *(const LAS bf16x8*)(B + HG_QP + hswz(32 * tb + q32o, 2 * ks + hio));
#pragma unroll
        for (int sb = 0; sb < 2; ++sb) {
            if (sb <= tb) {
                bf16x8 ka[8];
#pragma unroll
                for (int ks = 0; ks < 8; ++ks) ka[ks] = *(const LAS bf16x8*)(B + HG_KP + hswz(32 * sb + q32o, 2 * ks + hio));
                s16x4 vl[2], vh[2];
#pragma unroll
                for (int s2 = 0; s2 < 2; ++s2) { const int r0 = 32 * sb + 16 * s2 + 4 * hio; vl[s2] = vtr((LAS const char*)(B + HG_V + htr(r0, 4 * dvb + 2 * dh, laneo))); vh[s2] = vtr((LAS const char*)(B + HG_V + htr(r0 + 8, 4 * dvb + 2 * dh, laneo))); }
                __builtin_amdgcn_sched_barrier(0);
                f32x16 pT;
#pragma unroll
                for (int r = 0; r < 16; ++r) pT[r] = 0.f;
#pragma unroll
                for (int ks = 0; ks < 8; ++ks) pT = MFMA32(ka[ks], qb[ks], pT);
                if (sb == tb) {
#pragma unroll
                    for (int r = 0; r < 16; ++r) if (crow(r, hi) > q32) pT[r] = 0.f;
                }
#pragma unroll
                for (int s2 = 0; s2 < 2; ++s2) { u32x4 pw; pw.x = cvtpk(pT[8 * s2 + 0], pT[8 * s2 + 1]); pw.y = cvtpk(pT[8 * s2 + 2], pT[8 * s2 + 3]); pw.z = cvtpk(pT[8 * s2 + 4], pT[8 * s2 + 5]); pw.w = cvtpk(pT[8 * s2 + 6], pT[8 * s2 + 7]);
                    oT = MFMA32(((bf16x8){vl[s2][0], vl[s2][1], vl[s2][2], vl[s2][3], vh[s2][0], vh[s2][1], vh[s2][2], vh[s2][3]}), __builtin_bit_cast(bf16x8, pw), oT); }
                __builtin_amdgcn_sched_barrier(0);
            }
        }
        { const size_t g0 = (rb + (size_t)c * 64 + orow) * 512 + h * 128 + 16 * oseg; gr[0] = *(const u32x4*)(Gh + g0); gr[1] = *(const u32x4*)(Gh + g0 + 8); }
        {
            u32x2 qq0[8], qq1[8];
            if (c > 0) {
#pragma unroll
                for (int i = 0; i < 4; ++i)
#pragma unroll
                    for (int s = 0; s < 2; ++s) { qq0[2 * i + s] = *(const LAS u32x2*)(B + HG_QP + hswz(32 * tb + q32o, 4 * i + 2 * s) + 8 * hio); qq1[2 * i + s] = *(const LAS u32x2*)(B + HG_QP + hswz(32 * tb + q32o, 4 * i + 2 * s + 1) + 8 * hio); }
            }
#pragma unroll
            for (int i = 0; i < 4; ++i)
#pragma unroll
                for (int g = 0; g < 4; ++g) { const f32x4 sc = *(const LAS f32x4*)(B + HG_SC + (32 * i + 8 * g + 4 * hio) * 4);
#pragma unroll
                    for (int j = 0; j < 4; ++j) T[i][4 * g + j] *= sc[j]; }
            __builtin_amdgcn_sched_barrier(0);
            if (c > 0) {
#pragma unroll
                for (int i = 0; i < 4; ++i)
#pragma unroll
                    for (int s = 0; s < 2; ++s) { u32x4 tw; tw.x = cvtpk(T[i][8 * s + 0], T[i][8 * s + 1]); tw.y = cvtpk(T[i][8 * s + 2], T[i][8 * s + 3]); tw.z = cvtpk(T[i][8 * s + 4], T[i][8 * s + 5]); tw.w = cvtpk(T[i][8 * s + 6], T[i][8 * s + 7]);
                        const u32x4 qw = (u32x4){qq0[2 * i + s].x, qq0[2 * i + s].y, qq1[2 * i + s].x, qq1[2 * i + s].y};
                        oT = MFMA32(__builtin_bit_cast(bf16x8, tw), __builtin_bit_cast(bf16x8, qw), oT); }
            }
        }
        { LAS unsigned char* OBp = L + (c & 1) * HG_BUF + HG_OB;
#pragma unroll
          for (int g = 0; g < 4; ++g) { u32x2 w; w.x = cvtpk(oT[4 * g], oT[4 * g + 1]); w.y = cvtpk(oT[4 * g + 2], oT[4 * g + 3]); *(LAS u32x2*)(OBp + (32 * tb + q32o) * 272 + (32 * dvb + 8 * g + 4 * hio) * 2) = w; } }
#pragma unroll
        for (int sp = 0; sp < 2; ++sp) {
            s16x4 vl[2], vh[2], kl[2][4], kh[2][4];
#pragma unroll
            for (int u = 0; u < 2; ++u) { const int r0 = 16 * (2 * sp + u) + 8 * hio;
                vl[u] = vtr((LAS const char*)(B + HG_V + htr(r0, 4 * dvb + 2 * dh, laneo))); vh[u] = vtr((LAS const char*)(B + HG_V + htr(r0 + 4, 4 * dvb + 2 * dh, laneo)));
#pragma unroll
                for (int i = 0; i < 4; ++i) { kl[u][i] = vtr((LAS const char*)(B + HG_KP + htr(r0, 4 * i + 2 * dh, laneo))); kh[u][i] = vtr((LAS const char*)(B + HG_KP + htr(r0 + 4, 4 * i + 2 * dh, laneo))); } }
            __builtin_amdgcn_sched_barrier(0);
#pragma unroll
            for (int u = 0; u < 2; ++u) { const bf16x8 vb = (bf16x8){vl[u][0], vl[u][1], vl[u][2], vl[u][3], vh[u][0], vh[u][1], vh[u][2], vh[u][3]};
#pragma unroll
                for (int i = 0; i < 4; ++i) T[i] = MFMA32(((bf16x8){kl[u][i][0], kl[u][i][1], kl[u][i][2], kl[u][i][3], kh[u][i][0], kh[u][i][1], kh[u][i][2], kh[u][i][3]}), vb, T[i]); }
            __builtin_amdgcn_sched_barrier(0);
        }
        if (c + 1 < 32) HG_SCALE(c + 1);
        asm volatile("s_waitcnt vmcnt(0)" ::: "memory");
        __syncthreads();
        { const LAS unsigned char* OBp = L + (c & 1) * HG_BUF + HG_OB + orow * 272 + oseg * 32;
          const u32x4 o0 = *(const LAS u32x4*)OBp, o1 = *(const LAS u32x4*)(OBp + 16);
          float ov[16];
          ov[0] = bflo(o0.x); ov[1] = bfhi(o0.x); ov[2] = bflo(o0.y); ov[3] = bfhi(o0.y); ov[4] = bflo(o0.z); ov[5] = bfhi(o0.z); ov[6] = bflo(o0.w); ov[7] = bfhi(o0.w);
          ov[8] = bflo(o1.x); ov[9] = bfhi(o1.x); ov[10] = bflo(o1.y); ov[11] = bfhi(o1.y); ov[12] = bflo(o1.z); ov[13] = bfhi(o1.z); ov[14] = bflo(o1.w); ov[15] = bfhi(o1.w);
          float ss = 0.f;
#pragma unroll
          for (int j = 0; j < 16; ++j) ss += ov[j] * ov[j];
          ss += __int_as_float(__builtin_amdgcn_update_dpp(0, __float_as_int(ss), 0xB1, 0xf, 0xf, true));
          ss += __int_as_float(__builtin_amdgcn_update_dpp(0, __float_as_int(ss), 0x4E, 0xf, 0xf, true));
          ss += __int_as_float(__builtin_amdgcn_update_dpp(0, __float_as_int(ss), 0x141, 0xf, 0xf, true));
          const float rs = __builtin_amdgcn_rsqf(ss * (1.f / 128.f) + LN_EPS);
          float ng[16];
#pragma unroll
          for (int i = 0; i < 4; ++i) { const f32x4 n_ = *(const LAS f32x4*)(NGS + 16 * oseg + 4 * i); ng[4 * i] = n_[0]; ng[4 * i + 1] = n_[1]; ng[4 * i + 2] = n_[2]; ng[4 * i + 3] = n_[3]; }
          float gvv[16];
          gvv[0] = bflo(gr[0].x); gvv[1] = bfhi(gr[0].x); gvv[2] = bflo(gr[0].y); gvv[3] = bfhi(gr[0].y); gvv[4] = bflo(gr[0].z); gvv[5] = bfhi(gr[0].z); gvv[6] = bflo(gr[0].w); gvv[7] = bfhi(gr[0].w);
          gvv[8] = bflo(gr[1].x); gvv[9] = bfhi(gr[1].x); gvv[10] = bflo(gr[1].y); gvv[11] = bfhi(gr[1].y); gvv[12] = bflo(gr[1].z); gvv[13] = bfhi(gr[1].z); gvv[14] = bflo(gr[1].w); gvv[15] = bfhi(gr[1].w);
          float rv[16];
#pragma unroll
          for (int j = 0; j < 16; ++j) rv[j] = ov[j] * (rs * FP8_SO) * ng[j] * gvv[j];
          u32x4 w0; w0.x = cvt4_fp8(rv[0], rv[1], rv[2], rv[3]); w0.y = cvt4_fp8(rv[4], rv[5], rv[6], rv[7]); w0.z = cvt4_fp8(rv[8], rv[9], rv[10], rv[11]); w0.w = cvt4_fp8(rv[12], rv[13], rv[14], rv[15]);
          unsigned char* op = (unsigned char*)Ocat + (rb + (size_t)c * 64 + orow) * 1024 + h * 128 + 16 * oseg;
          *(u32x4*)op = w0; }
    }
    __syncthreads();
#undef HG_DMA
#undef HG_SCALE
#undef HG_SCLOAD
}

constexpr int AT_NST = 4, AT_K = 0, AT_V = AT_NST * 8192, AT_KM = 2 * AT_NST * 8192, AT_TAB = AT_KM + 1792;
DI int t5_bucket(int d) { if (d < 16) return d; const int v = 16 + (int)(logf((float)d * (1.f / 16.f)) / logf(8.f) * 16.f); return v < 31 ? v : 31; }
DI void glds16(const void* gsrc, unsigned lds_dst) { unsigned keep;
    asm volatile("s_mov_b32 %0, m0\n\ts_mov_b32 m0, %2\n\ts_nop 0\n\tglobal_load_lds_dwordx4 %1, off\n\ts_mov_b32 m0, %0" : "=&s"(keep) : "v"(gsrc), "s"(lds_dst) : "memory"); }
DI void attn_unit(const Ctx& C, const Args& a, int b, int h, int jq) {
    LAS unsigned char* L = C.lds;
    const int tid = C.tid, lane = C.lane, wid = C.wid, q32 = lane & 31, hi = lane >> 5;
    const bf16* Qm = (const bf16*)(C.ws + WS_QM); const bf16* Km = (const bf16*)(C.ws + WS_KM); const bf16* Vm = (const bf16*)(C.ws + WS_VM); const float* KM = (const float*)(C.ws + WS_KMEAN);
    bf16* Ocat = (bf16*)(C.ws + WS_XB);
    const int tq = jq * 256 + wid * 32 + q32;
    const size_t hb = (size_t)(b * 8 + h) * SEQ;
    bf16x8 qf[4];
#pragma unroll
    for (int ks = 0; ks < 4; ++ks) qf[ks] = *(const bf16x8*)(Qm + (hb + tq) * 64 + 16 * ks + 8 * hi);
    LAS float* kml = (LAS float*)(L + AT_KM); LAS float* tab = (LAS float*)(L + AT_TAB);
    if (tid < jq * 64) { const int n = tid >> 6, d = tid & 63; kml[tid] = KM[(size_t)((b * 8 + n) * 2 + 0) * 512 + h * 64 + d] + KM[(size_t)((b * 8 + n) * 2 + 1) * 512 + h * 64 + d]; }
    if (tid < 129) tab[tid] = (a.in[I_RELB][t5_bucket(tid) * 8 + h] - a.in[I_RELB][31 * 8 + h]) * LOG2E;
    const int drow = 8 * wid + (lane >> 3), dch = lane & 7;
    const bf16* ksrc = Km + (hb + drow) * 64 + 8 * (dch ^ ((drow >> 1) & 7));
    const bf16* vsrc = Vm + (hb + drow) * 64 + 8 * (dch ^ (((drow >> 1) & 1) << 2));
    const unsigned kdst = (unsigned)__builtin_amdgcn_readfirstlane((int)(unsigned)(size_t)(L + AT_K + wid * 1024)), vdst = (unsigned)__builtin_amdgcn_readfirstlane((int)(unsigned)(size_t)(L + AT_V + wid * 1024));
    const int nt = 4 * jq + 4;
#define AT_ISSUE(t) do { glds16(ksrc + (size_t)(t) * 4096, kdst + ((t) & 3) * 8192); glds16(vsrc + (size_t)(t) * 4096, vdst + ((t) & 3) * 8192); } while (0)
    AT_ISSUE(0); AT_ISSUE(1); AT_ISSUE(2);
    __syncthreads();
    unsigned sel = 0;
    {
        float g[7];
#pragma unroll
        for (int n = 0; n < 7; ++n) { g[n] = 0.f;
            if (n < jq) { float s = 0.f;
#pragma unroll
                for (int ks = 0; ks < 4; ++ks)
#pragma unroll
                    for (int j = 0; j < 8; ++j) s += bf2f((unsigned short)qf[ks][j]) * kml[n * 64 + 16 * ks + 8 * hi + j];
                s += __shfl_xor(s, 32); g[n] = s; } }
#pragma unroll
        for (int n = 0; n < 7; ++n) if (n < jq) { int rank = 0;
#pragma unroll
            for (int m = 0; m < 7; ++m) if (m != n && m < jq) rank += (g[m] > g[n] || (g[m] == g[n] && m < n)) ? 1 : 0;
            if (rank < 3) sel |= 1u << n; }
    }
    const float c31 = a.in[I_RELB][31 * 8 + h] * LOG2E;
    float lrun = 0.f;
    f32x16 negm;
#pragma unroll
    for (int r = 0; r < 16; ++r) negm[r] = c31;
    f32x16 o0, o1;
#pragma unroll
    for (int r = 0; r < 16; ++r) { o0[r] = 0.f; o1[r] = 0.f; }
    const int i16 = lane & 15, qq = i16 >> 2, pp = i16 & 3, dh = (lane >> 4) & 1, xsw = (qq >> 1) & 1;
    const int vb0 = (4 * hi + qq) * 128 + 64 * (0 ^ xsw) + 32 * dh + 8 * pp, vb1 = (4 * hi + qq) * 128 + 64 * (1 ^ xsw) + 32 * dh + 8 * pp;
    const int kxs = (q32 >> 1) & 7;
    for (int kt = 0; kt < nt; ++kt) {
        if (kt + 2 < nt) asm volatile("s_waitcnt vmcnt(4)" ::: "memory"); else if (kt + 1 < nt) asm volatile("s_waitcnt vmcnt(2)" ::: "memory"); else asm volatile("s_waitcnt vmcnt(0)" ::: "memory");
        __builtin_amdgcn_s_barrier();
        asm volatile("" ::: "memory");
        if (kt + 3 < nt) AT_ISSUE(kt + 3);
        const int blk = kt >> 2; const bool own = (blk == jq);
        const bool active = !own || ((kt & 3) * 64 <= wid * 32 + 31);
        if (active) {
            const LAS unsigned char* Kc = L + AT_K + (kt & 3) * 8192; const LAS unsigned char* Vc = L + AT_V + (kt & 3) * 8192;
            bf16x8 kf[8];
#pragma unroll
            for (int ks = 0; ks < 4; ++ks) { const int ko = (((2 * ks + hi) ^ kxs) << 4); kf[2 * ks] = *(const LAS bf16x8*)(Kc + q32 * 128 + ko); kf[2 * ks + 1] = *(const LAS bf16x8*)(Kc + (32 + q32) * 128 + ko); }
            __builtin_amdgcn_sched_barrier(0);
            f32x16 s0 = negm, s1 = negm;
#pragma unroll
            for (int ks = 0; ks < 4; ++ks) { s0 = MFMA32(kf[2 * ks], qf[ks], s0); s1 = MFMA32(kf[2 * ks + 1], qf[ks], s1); }
            __builtin_amdgcn_sched_barrier(0);
            s16x4 vf[2][4][2];
#pragma unroll
            for (int j = 0; j < 4; ++j) { const int ro = 16 * j * 128;
                vf[0][j][0] = vtr((LAS const char*)(Vc + vb0 + ro)); vf[0][j][1] = vtr((LAS const char*)(Vc + vb0 + ro + 8 * 128));
                vf[1][j][0] = vtr((LAS const char*)(Vc + vb1 + ro)); vf[1][j][1] = vtr((LAS const char*)(Vc + vb1 + ro + 8 * 128)); }
            __builtin_amdgcn_sched_barrier(0);
            const bool near = (jq * 256 + wid * 32 - 64 * kt - 63) < 128;
            if (near) {
                const int dist0 = tq - 64 * kt - 4 * hi;
#pragma unroll
                for (int r = 0; r < 16; ++r) { const int d0 = dist0 - ((r & 3) + 8 * (r >> 2)), d1 = d0 - 32;
                    const int i0 = d0 < 0 ? 0 : (d0 > 128 ? 128 : d0), i1 = d1 < 0 ? 0 : (d1 > 128 ? 128 : d1);
                    const float t0 = tab[i0], t1 = tab[i1]; s0[r] += t0; s1[r] += t1; s0[r] = d0 < 0 ? -INFINITY : s0[r]; s1[r] = d1 < 0 ? -INFINITY : s1[r]; }
            }
            const bool lsel = own || ((sel >> blk) & 1u);
            float mx = fmaxf(fmaxf(s0[0], s1[0]), fmaxf(s0[1], s1[1]));
#pragma unroll
            for (int r = 2; r < 16; r += 2) mx = fmaxf(mx, fmaxf(fmaxf(s0[r], s1[r]), fmaxf(s0[r + 1], s1[r + 1])));
            mx = lsel ? mx : -INFINITY;
            mx = fmaxf(mx, __shfl_xor(mx, 32));
            if (__any(mx > 4.0f)) {
                const float delta = fmaxf(mx, 0.f), alpha = __builtin_amdgcn_exp2f(-delta);
                lrun *= alpha;
#pragma unroll
                for (int r = 0; r < 16; ++r) { o0[r] *= alpha; o1[r] *= alpha; negm[r] -= delta; s0[r] -= delta; s1[r] -= delta; }
            }
            float ps = 0.f;
#pragma unroll
            for (int r = 0; r < 16; ++r) { s0[r] = __builtin_amdgcn_exp2f(s0[r]); s1[r] = __builtin_amdgcn_exp2f(s1[r]); ps += s0[r] + s1[r]; }
            lrun += lsel ? ps : 0.f;
            const unsigned pmask = lsel ? 0xffffffffu : 0u;
#pragma unroll
            for (int kb = 0; kb < 2; ++kb)
#pragma unroll
                for (int s2 = 0; s2 < 2; ++s2) {
                    u32x4 pw;
                    if (kb == 0) { pw.x = cvtpk(s0[8 * s2 + 0], s0[8 * s2 + 1]); pw.y = cvtpk(s0[8 * s2 + 2], s0[8 * s2 + 3]); pw.z = cvtpk(s0[8 * s2 + 4], s0[8 * s2 + 5]); pw.w = cvtpk(s0[8 * s2 + 6], s0[8 * s2 + 7]); }
                    else         { pw.x = cvtpk(s1[8 * s2 + 0], s1[8 * s2 + 1]); pw.y = cvtpk(s1[8 * s2 + 2], s1[8 * s2 + 3]); pw.z = cvtpk(s1[8 * s2 + 4], s1[8 * s2 + 5]); pw.w = cvtpk(s1[8 * s2 + 6], s1[8 * s2 + 7]); }
                    pw.x &= pmask; pw.y &= pmask; pw.z &= pmask; pw.w &= pmask;
                    const bf16x8 pf = __builtin_bit_cast(bf16x8, pw);
                    const s16x4 a0l = vf[0][2 * kb + s2][0], a0h = vf[0][2 * kb + s2][1], a1l = vf[1][2 * kb + s2][0], a1h = vf[1][2 * kb + s2][1];
                    o0 = MFMA32(((bf16x8){a0l[0], a0l[1], a0l[2], a0l[3], a0h[0], a0h[1], a0h[2], a0h[3]}), pf, o0);
                    o1 = MFMA32(((bf16x8){a1l[0], a1l[1], a1l[2], a1l[3], a1h[0], a1h[1], a1h[2], a1h[3]}), pf, o1);
                }
        }
    }
    const float linv = 1.f / (lrun + __shfl_xor(lrun, 32));
    unsigned char* op = (unsigned char*)Ocat + ((size_t)b * SEQ + tq) * 1024 + 512 + h * 64;
    const float lsc = linv * FP8_SO;
#pragma unroll
    for (int g = 0; g < 4; ++g) { *(unsigned*)(op + 8 * g + 4 * hi) = cvt4_fp8(o0[4 * g] * lsc, o0[4 * g + 1] * lsc, o0[4 * g + 2] * lsc, o0[4 * g + 3] * lsc);
        *(unsigned*)(op + 32 + 8 * g + 4 * hi) = cvt4_fp8(o1[4 * g] * lsc, o1[4 * g + 1] * lsc, o1[4 * g + 2] * lsc, o1[4 * g + 3] * lsc); }
    __syncthreads();
#undef AT_ISSUE
}

#ifndef PROBE_HGX
#define PROBE_HGX 1
#endif
#ifndef PROBE_ATX
#define PROBE_ATX 1
#endif
#ifndef STAMP_SEL
#define STAMP_SEL -1
#endif
#define STAMP(i) do { if (STAMP_SEL >= 0 && blockIdx.x == 0 && C.tid == 0) { const unsigned long long t_ = __builtin_amdgcn_s_memrealtime(); C.MISC[16 + 2 * (i)] = (unsigned)t_; C.MISC[17 + 2 * (i)] = (unsigned)(t_ >> 32); } } while (0)
DI void p2_mixers(const Ctx& C, const Args& a, int rep) {
    for (int hx = 0; hx < PROBE_HGX; ++hx)
    for (int u = blockIdx.x; u < 64; u += C.G) hgrn_unit(C, a, u >> 2, u & 3);
    STAMP(11);
    unsigned* QA = (unsigned*)(C.ctl + CW_QUEUE + 64 * rep); unsigned* QC = (unsigned*)(C.ctl + CW_QUEUE2 + 64 * rep);
    constexpr int NA = 1024 * PROBE_ATX, NC = MOE_CVT_TILES;
    if (C.tid == 0) { C.MISC[0] = __hip_atomic_fetch_add(QA, 1u, __ATOMIC_RELAXED, __HIP_MEMORY_SCOPE_AGENT); C.MISC[1] = (rep == 0) ? __hip_atomic_fetch_add(QC, 1u, __ATOMIC_RELAXED, __HIP_MEMORY_SCOPE_AGENT) : (unsigned)NC; }
    __syncthreads();
    int qa = (int)C.MISC[0], qc = (int)C.MISC[1];
    __syncthreads();
    for (;;) {
        const bool doa = qa < NA, doc = qc < NC;
        if (!doa && !doc) break;
        unsigned na = (unsigned)NA, nc = (unsigned)NC;
        if (C.tid == 0) { if (doa) na = __hip_atomic_fetch_add(QA, 1u, __ATOMIC_RELAXED, __HIP_MEMORY_SCOPE_AGENT); if (doc) nc = __hip_atomic_fetch_add(QC, 1u, __ATOMIC_RELAXED, __HIP_MEMORY_SCOPE_AGENT); }
#ifdef STAMP_ACC
        unsigned long long ta_ = 0, tb_ = 0, tc_ = 0; if (C.tid == 0) ta_ = __builtin_amdgcn_s_memrealtime();
#endif
        if (doa) { const int q = qa / PROBE_ATX; attn_unit(C, a, (q & 127) >> 3, q & 7, 7 - (q >> 7)); }
#ifdef STAMP_ACC
        if (C.tid == 0) tb_ = __builtin_amdgcn_s_memrealtime();
#endif
        if (doc) moe_cvt_tile(C, a, qc);
#ifdef STAMP_ACC
        if (C.tid == 0 && blockIdx.x == 100) { tc_ = __builtin_amdgcn_s_memrealtime(); const unsigned long long d_ = (STAMP_ACC == 0) ? (tb_ - ta_) : (tc_ - tb_);
            const unsigned long long o_ = ((unsigned long long)C.MISC[45] << 32) | C.MISC[44]; const unsigned long long n_ = o_ + d_; C.MISC[44] = (unsigned)n_; C.MISC[45] = (unsigned)(n_ >> 32); }
#endif
        if (C.tid == 0) { C.MISC[0] = na; C.MISC[1] = nc; }
        __syncthreads();
        qa = (int)C.MISC[0]; qc = (int)C.MISC[1];
        __syncthreads();
    }
    STAMP(12);
#ifdef STAMP_ACC
    if (C.tid == 0 && blockIdx.x == 100) { const unsigned long long n_ = ((unsigned long long)C.MISC[45] << 32) | C.MISC[44]; const unsigned long long w0 = __builtin_amdgcn_s_memrealtime(); while (__builtin_amdgcn_s_memrealtime() - w0 < 4ull * n_) __builtin_amdgcn_s_sleep(8); }
#endif
}

DI void r1_phase(const Ctx& C, const Args& a) {
    LAS unsigned char* L = C.lds;
    const int tid = C.tid, lane = C.lane, wid = C.wid;
    LAS float* LG = (LAS float*)L + wid * 16 * 48;
    LAS int* CNT = (LAS int*)(L + 32768);
    LAS float* G1 = (LAS float*)(L + 33024); LAS float* B1 = (LAS float*)(L + 37120);
    const float* Pre = (const float*)(C.ws + WS_ZF); unsigned char* X1q = (unsigned char*)(C.ws + WS_XB); f32x2* stats = (f32x2*)(C.ws + WS_STATS);
    const bf16* WrH = (const bf16*)(C.ws + WS_WRH); const bf16* WrL = (const bf16*)(C.ws + WS_WRL);
    unsigned* tokE = (unsigned*)(C.ws + WS_TOKE); float* tokW = (float*)(C.ws + WS_TOKW); int* wgcnt = (int*)(C.ws + WS_WGCNT);
    for (int i = tid; i < 1024; i += NTHREADS) { G1[i] = a.in[I_LN1G][i]; B1[i] = a.in[I_LN1B][i]; }
    const int m16 = lane & 15, kq = lane >> 4;
    for (int chunk = blockIdx.x; chunk < NTOK / 128; chunk += C.G) {
        if (tid < 32) CNT[tid] = 0;
        __syncthreads();
        const int tok0 = chunk * 128 + wid * 16;
        const float* xrow = Pre + (size_t)(tok0 + m16) * 1024 + 8 * kq;
        float s = 0.f, s2 = 0.f;
#pragma unroll 8
        for (int k0 = 0; k0 < 1024; k0 += 32) { const f32x4 xa = *(const f32x4*)(xrow + k0), xc = *(const f32x4*)(xrow + k0 + 4);
            s += (xa[0] + xa[1]) + (xa[2] + xa[3]) + (xc[0] + xc[1]) + (xc[2] + xc[3]);
            s2 += (xa[0] * xa[0] + xa[1] * xa[1]) + (xa[2] * xa[2] + xa[3] * xa[3]) + (xc[0] * xc[0] + xc[1] * xc[1]) + (xc[2] * xc[2] + xc[3] * xc[3]); }
        s += __shfl_xor(s, 16); s += __shfl_xor(s, 32); s2 += __shfl_xor(s2, 16); s2 += __shfl_xor(s2, 32);
        const float mean = s * (1.f / 1024.f); const float var = fmaxf(s2 * (1.f / 1024.f) - mean * mean, 0.f); const float rstd = 1.f / sqrtf(var + LN_EPS);
        if (kq == 0) stats[tok0 + m16] = (f32x2){mean, rstd};
        f32x4 acc[3];
#pragma unroll
        for (int nb = 0; nb < 3; ++nb) acc[nb] = (f32x4){0.f, 0.f, 0.f, 0.f};
        unsigned char* xb = X1q + (size_t)(tok0 + m16) * 1024 + 8 * kq;
        const bf16* wrh = WrH + (size_t)m16 * 1024 + 8 * kq; const bf16* wrl = WrL + (size_t)m16 * 1024 + 8 * kq;
        bf16x8 wh[2][3], wl[2][3];
#pragma unroll
        for (int nb = 0; nb < 3; ++nb) { wh[0][nb] = *(const bf16x8*)(wrh + (size_t)nb * 16 * 1024); wl[0][nb] = *(const bf16x8*)(wrl + (size_t)nb * 16 * 1024); }
#pragma unroll 1
        for (int kb = 0; kb < 4; ++kb) {
            f32x4 xa[8], xc[8];
#pragma unroll
            for (int j = 0; j < 8; ++j) { xa[j] = *(const f32x4*)(xrow + kb * 256 + 32 * j); xc[j] = *(const f32x4*)(xrow + kb * 256 + 32 * j + 4); }
#pragma unroll
            for (int j = 0; j < 8; ++j) { const int k0 = kb * 256 + 32 * j, cur = j & 1;
                if (k0 + 32 < 1024) {
#pragma unroll
                    for (int nb = 0; nb < 3; ++nb) { wh[cur ^ 1][nb] = *(const bf16x8*)(wrh + (size_t)nb * 16 * 1024 + k0 + 32); wl[cur ^ 1][nb] = *(const bf16x8*)(wrl + (size_t)nb * 16 * 1024 + k0 + 32); } }
                const f32x4 ya = (xa[j] - mean) * rstd * *(const LAS f32x4*)(G1 + k0 + 8 * kq) + *(const LAS f32x4*)(B1 + k0 + 8 * kq);
                const f32x4 yc = (xc[j] - mean) * rstd * *(const LAS f32x4*)(G1 + k0 + 8 * kq + 4) + *(const LAS f32x4*)(B1 + k0 + 8 * kq + 4);
                u32x4 hw; hw.x = cvtpk(ya[0], ya[1]); hw.y = cvtpk(ya[2], ya[3]); hw.z = cvtpk(yc[0], yc[1]); hw.w = cvtpk(yc[2], yc[3]);
                { u32x2 qw; qw.x = cvt4_fp8(ya[0] * FP8_SX, ya[1] * FP8_SX, ya[2] * FP8_SX, ya[3] * FP8_SX); qw.y = cvt4_fp8(yc[0] * FP8_SX, yc[1] * FP8_SX, yc[2] * FP8_SX, yc[3] * FP8_SX); *(u32x2*)(xb + k0) = qw; }
                u32x4 lw; lw.x = cvtpk(ya[0] - bflo(hw.x), ya[1] - bfhi(hw.x)); lw.y = cvtpk(ya[2] - bflo(hw.y), ya[3] - bfhi(hw.y)); lw.z = cvtpk(yc[0] - bflo(hw.z), yc[1] - bfhi(hw.z)); lw.w = cvtpk(yc[2] - bflo(hw.w), yc[3] - bfhi(hw.w));
                const bf16x8 xh = __builtin_bit_cast(bf16x8, hw), xl = __builtin_bit_cast(bf16x8, lw);
#pragma unroll
                for (int nb = 0; nb < 3; ++nb) { acc[nb] = MFMA16(wh[cur][nb], xh, acc[nb]); acc[nb] = MFMA16(wl[cur][nb], xh, acc[nb]); acc[nb] = MFMA16(wh[cur][nb], xl, acc[nb]); }
            }
        }
#pragma unroll
        for (int nb = 0; nb < 3; ++nb)
#pragma unroll
            for (int r = 0; r < 4; ++r) LG[m16 * 48 + nb * 16 + 4 * kq + r] = acc[nb][r];
        asm volatile("s_waitcnt lgkmcnt(0)" ::: "memory");
        if (lane < 16) {
            const LAS float* lg = LG + lane * 48;
            float gl[4];
#pragma unroll
            for (int j = 0; j < 4; ++j) gl[j] = lg[j] + a.in[I_BGRP][j];
            int grp = 0; float gm = gl[0];
#pragma unroll
            for (int j = 1; j < 4; ++j) if (gl[j] > gm) { gm = gl[j]; grp = j; }
            float se = 0.f;
#pragma unroll
            for (int j = 0; j < 4; ++j) se += expf(gl[j] - gm);
            const float pg = 1.f / se;
            float el[8];
#pragma unroll
            for (int j = 0; j < 8; ++j) el[j] = lg[4 + grp * 8 + j] + a.in[I_BEXP][grp * 8 + j];
            int i0 = 0; float v0 = el[0];
#pragma unroll
            for (int j = 1; j < 8; ++j) if (el[j] > v0) { v0 = el[j]; i0 = j; }
            int i1 = -1; float v1 = -INFINITY;
#pragma unroll
            for (int j = 0; j < 8; ++j) if (j != i0 && el[j] > v1) { v1 = el[j]; i1 = j; }
            const float w0 = 1.f / (1.f + expf(v1 - v0)), w1 = 1.f - w0;
            const int e0 = grp * 8 + i0, e1 = grp * 8 + i1;
            const int r0 = __hip_atomic_fetch_add(CNT + e0, 1, __ATOMIC_RELAXED, __HIP_MEMORY_SCOPE_WORKGROUP), r1 = __hip_atomic_fetch_add(CNT + e1, 1, __ATOMIC_RELAXED, __HIP_MEMORY_SCOPE_WORKGROUP);
            const int tok = tok0 + lane;
            tokE[tok] = (unsigned)e0 | ((unsigned)e1 << 8) | ((unsigned)r0 << 16) | ((unsigned)r1 << 24);
            tokW[tok * 2] = w0 * pg; tokW[tok * 2 + 1] = w1 * pg;
        }
        __syncthreads();
        if (tid < 32) wgcnt[chunk * 32 + tid] = CNT[tid];
        __syncthreads();
    }
}

DI void r2_phase(const Ctx& C, const Args& a) {
    LAS int* PA = (LAS int*)C.lds;
    LAS int* PB = PA + 512;
    LAS int* TOT = PB + 512; LAS int* BASE = TOT + 32; LAS int* PST = BASE + 32;
    const int tid = C.tid;
    const int* wgcnt = (const int*)(C.ws + WS_WGCNT); const unsigned* tokE = (const unsigned*)(C.ws + WS_TOKE);
    int* tokD = (int*)(C.ws + WS_TOKD); int* rowtok = (int*)(C.ws + WS_ROWTOK); int* tilee = (int*)(C.ws + WS_TILEE);
    for (int chunk = blockIdx.x; chunk < NTOK / 128; chunk += C.G) {
        { const int e = tid & 31, part = tid >> 5; int sa = 0, sb = 0;
          for (int c = part * 16; c < part * 16 + 16; ++c) { const int v = wgcnt[c * 32 + e]; sa += v; sb += (c < chunk) ? v : 0; }
          PA[part * 32 + e] = sa; PB[part * 32 + e] = sb; }
        __syncthreads();
        if (tid < 32) { int sa = 0, sb = 0; for (int p = 0; p < 16; ++p) { sa += PA[p * 32 + tid]; sb += PB[p * 32 + tid]; } TOT[tid] = sa; BASE[tid] = sb; }
        __syncthreads();
        if (tid == 0) { int ps = 0; for (int e = 0; e < 32; ++e) { PST[e] = ps; ps += ((TOT[e] + 255) >> 8) << 8; } PST[32] = ps; }
        __syncthreads();
        if (tid < 128) { const int tok = chunk * 128 + tid; const unsigned w = tokE[tok]; const int e0 = w & 31, e1 = (w >> 8) & 31, r0 = (w >> 16) & 255, r1 = (w >> 24) & 255;
            const int d0 = PST[e0] + BASE[e0] + r0, d1 = PST[e1] + BASE[e1] + r1; rowtok[d0] = tok; rowtok[d1] = tok; tokD[tok * 2] = d0; tokD[tok * 2 + 1] = d1; }
        if (chunk < 32) { const int e = chunk, end = PST[e + 1] - PST[e]; for (int i = TOT[e] + tid; i < end; i += NTHREADS) rowtok[PST[e] + i] = 0; }
        if (chunk == 0) { if (tid < 32) { for (int t = PST[tid] >> 8; t < (PST[tid + 1] >> 8); ++t) tilee[t] = tid; } if (tid == 0) tilee[511] = PST[32] >> 8; }
        __syncthreads();
    }
}

DI void f_phase(const Ctx& C, const Args& a) {
    const int lane = C.lane, gw = C.vcu * NWAVES + C.wid, NGW = C.G * NWAVES;
    const float* Pre = (const float*)(C.ws + WS_ZF); const bf16* Y = (const bf16*)(C.ws + WS_Y); const int* tokD = (const int*)(C.ws + WS_TOKD); const float* tokW = (const float*)(C.ws + WS_TOKW);
    const f32x2* stats = (const f32x2*)(C.ws + WS_STATS);
    f32x4 g2[4], b2[4], g1[4], b1[4];
#pragma unroll
    for (int j = 0; j < 4; ++j) { g2[j] = *(const f32x4*)(a.in[I_LN2G] + 256 * j + 4 * lane); b2[j] = *(const f32x4*)(a.in[I_LN2B] + 256 * j + 4 * lane);
        g1[j] = *(const f32x4*)(a.in[I_LN1G] + 256 * j + 4 * lane) * DN_ALPHA; b1[j] = *(const f32x4*)(a.in[I_LN1B] + 256 * j + 4 * lane) * DN_ALPHA; }
    for (int tok = gw; tok < NTOK; tok += NGW) {
        const int d0 = tokD[tok * 2], d1 = tokD[tok * 2 + 1]; const float w0 = tokW[tok * 2], w1 = tokW[tok * 2 + 1]; const f32x2 st = stats[tok];
        const float* xr = Pre + (size_t)tok * 1024 + 4 * lane; const bf16* y0 = Y + (size_t)d0 * 1024 + 4 * lane; const bf16* y1 = Y + (size_t)d1 * 1024 + 4 * lane;
        f32x4 v[4]; float s = 0.f;
#pragma unroll
        for (int j = 0; j < 4; ++j) { const f32x4 x = *(const f32x4*)(xr + 256 * j); const u32x2 p0 = *(const u32x2*)(y0 + 256 * j), p1 = *(const u32x2*)(y1 + 256 * j);
            v[j] = ((x - st.x) * st.y) * g1[j] + b1[j] + (f32x4){bflo(p0.x), bfhi(p0.x), bflo(p0.y), bfhi(p0.y)} * w0 + (f32x4){bflo(p1.x), bfhi(p1.x), bflo(p1.y), bfhi(p1.y)} * w1;
            s += (v[j][0] + v[j][1]) + (v[j][2] + v[j][3]); }
        const float mean = wave_sum(s) * (1.f / 1024.f); float s2 = 0.f;
#pragma unroll
        for (int j = 0; j < 4; ++j) { v[j] = v[j] - mean; s2 += (v[j][0] * v[j][0] + v[j][1] * v[j][1]) + (v[j][2] * v[j][2] + v[j][3] * v[j][3]); }
        const float rstd = 1.f / sqrtf(wave_sum(s2) * (1.f / 1024.f) + LN_EPS);
        float* orow = a.out + (size_t)tok * 1024 + 4 * lane;
#pragma unroll
        for (int j = 0; j < 4; ++j) *(f32x4*)(orow + 256 * j) = v[j] * rstd * g2[j] + b2[j];
    }
}

constexpr int NPH = 10;
__global__ void __launch_bounds__(NTHREADS, 2) mk_fwd(Args args) {
    extern __shared__ __attribute__((aligned(16))) unsigned char lds_raw[];
    Ctx C;
    C.lds = (LAS unsigned char*)lds_raw; C.MISC = (volatile LAS unsigned*)(C.lds + MISC_OFF);
    C.tid = threadIdx.x; C.lane = C.tid & 63; C.wid = __builtin_amdgcn_readfirstlane(C.tid >> 6);
    C.G = gridDim.x; { const int bx = blockIdx.x; C.vcu = (C.G % 8 == 0) ? (bx % 8) * (C.G / 8) + bx / 8 : bx; }
    C.ws = args.ws; C.ctl = (gu32*)(args.ws + WS_CTL);
    if (C.tid < 64) C.MISC[C.tid] = 0u;
    __syncthreads();
    XcdBarrier bar; bar.bar = (unsigned*)(C.ctl + CW_BAR); bar.x = 0; bar.st = nullptr;
    if (MK_N_LAUNCHES == 1) bar = xcd_barrier_post((unsigned*)(C.ctl + CW_BAR), C.MISC + 8);
    const int lo = args.ph_lo, hi = args.ph_hi;
#ifndef PH_MASK
#define PH_MASK 0x3ff
#endif
#define IN(k) (((PH_MASK >> (k)) & 1) && lo <= (k) && (k) < hi)
#ifndef STAMP_SEL
#define STAMP_SEL -1
#endif
#ifndef STAMP_T0
#define STAMP_T0 STAMP_SEL
#define STAMP_T1 (STAMP_SEL + 1)
#endif
#define SEAM(k) do { if (IN(k) && IN((k) + 1)) xcd_barrier(bar); STAMP((k) + 1); } while (0)
#ifndef PROBE_PHASE
#define PROBE_PHASE -1
#endif
#define REPS(k) ((PROBE_PHASE == (k)) ? 2 : 1)
#define REPSEAM(k) do { if (rep + 1 < REPS(k)) xcd_barrier(bar); } while (0)
    unsigned char* ws = args.ws;
    LAS unsigned char* ring = C.lds;

    STAMP(0);
    if (IN(0)) { _Pragma("unroll") for (int rep = 0; rep < REPS(0); ++rep) { p0_prologue(C, args); REPSEAM(0); } } SEAM(0);

    if (IN(1)) _Pragma("unroll") for (int rep = 0; rep < REPS(1); ++rep) {
        pg8::EpiIn E{(bf16*)(ws + WS_QH), (bf16*)(ws + WS_VH), (bf16*)(ws + WS_GH), (bf16*)(ws + WS_QM), (bf16*)(ws + WS_KM), (bf16*)(ws + WS_VM), (bf16*)(ws + WS_R), (bf16*)(ws + WS_GB),
                     (float*)(ws + WS_ZF), (float*)(ws + WS_KMEAN), (const float*)(ws + WS_BPERM), (bf16*)(ws + WS_KK), (const float*)(ws + WS_LB), 0};
        { pg8::DenseOrder S; S.init(ws + WS_XB, ws + WS_WIN, NTOK, 2048, 1024, C.G, (int)blockIdx.x);
          pg8::gemm_phase<pg8::EpiIn, pg8::DenseOrder, false>(ring, 1024, S, E); }
        { E.pn_off = 8; pg8::DenseOrder S; S.init((unsigned char*)args.out + 64 * MiB, ws + WS_WIN + 4 * MiB, NTOK, 3584, 512, C.G, (int)blockIdx.x);
          pg8::gemm_phase<pg8::EpiIn, pg8::DenseOrder, false, true>(ring, 512, S, E); }
        REPSEAM(1);
    } SEAM(1);

#ifndef PROBE_P2X
#define PROBE_P2X 1
#endif
    if (IN(2)) { for (int rep = 0; rep < PROBE_P2X; ++rep) { p2_mixers(C, args, rep); if (rep + 1 < PROBE_P2X) xcd_barrier(bar); } } SEAM(2);

    if (IN(3)) _Pragma("unroll") for (int rep = 0; rep < REPS(3); ++rep) {
        pg8::DenseOrder S; S.init(ws + WS_XB, ws + WS_WCAT, NTOK, 1024, 512, C.G, (int)blockIdx.x);
        pg8::EpiProj E{(const bf16*)(ws + WS_R), (const bf16*)(ws + WS_GB), (unsigned char*)(ws + WS_QH)};
        pg8::gemm_phase<pg8::EpiProj, pg8::DenseOrder, false, true>(ring, 512, S, E); REPSEAM(3);
    } SEAM(3);

    if (IN(4)) _Pragma("unroll") for (int rep = 0; rep < REPS(4); ++rep) {
        pg8::DenseOrder S; S.init(ws + WS_QH, ws + WS_WO, NTOK, 1024, 512, C.G, (int)blockIdx.x);
        pg8::EpiOut E{args.in[I_X], (float*)(ws + WS_ZF)};
        pg8::gemm_phase<pg8::EpiOut, pg8::DenseOrder, false, true>(ring, 512, S, E);
        REPSEAM(4);
    } SEAM(4);

    if (IN(5)) { _Pragma("unroll") for (int rep = 0; rep < REPS(5); ++rep) { r1_phase(C, args); REPSEAM(5); } } SEAM(5);
    if (IN(6)) { _Pragma("unroll") for (int rep = 0; rep < REPS(6); ++rep) { r2_phase(C, args); REPSEAM(6); } } SEAM(6);

    if (IN(7)) _Pragma("unroll") for (int rep = 0; rep < REPS(7); ++rep) {
        const int* tilee = (const int*)(ws + WS_TILEE);
        const int ntl = __builtin_amdgcn_readfirstlane(__hip_atomic_load(tilee + 511, __ATOMIC_RELAXED, __HIP_MEMORY_SCOPE_AGENT));
        pg8::MoeOrder S{(const char*)(ws + WS_XB), (const char*)args.out, (const int*)(ws + WS_ROWTOK), tilee, 512, 1024, ntl * 4, C.G, C.vcu, true};
        pg8::EpiM1 E{(unsigned char*)(ws + WS_QH)};
        pg8::gemm_phase<pg8::EpiM1, pg8::MoeOrder, true, true>(ring, 512, S, E); REPSEAM(7);
    } SEAM(7);

    if (IN(8)) _Pragma("unroll") for (int rep = 0; rep < REPS(8); ++rep) {
        const int* tilee = (const int*)(ws + WS_TILEE);
        const int ntl = __builtin_amdgcn_readfirstlane(__hip_atomic_load(tilee + 511, __ATOMIC_RELAXED, __HIP_MEMORY_SCOPE_AGENT));
        pg8::MoeOrder S{(const char*)(ws + WS_QH), (const char*)args.out + 32 * MiB, (const int*)(ws + WS_ROWTOK), tilee, 256, 1024, ntl * 4, C.G, C.vcu, false};
        pg8::EpiM2 E{(bf16*)(ws + WS_Y)};
        pg8::gemm_phase<pg8::EpiM2, pg8::MoeOrder, false, true>(ring, 256, S, E); REPSEAM(8);
    } SEAM(8);

    if (IN(9)) { _Pragma("unroll") for (int rep = 0; rep < REPS(9); ++rep) { f_phase(C, args); REPSEAM(9); } }
    STAMP(10);
    if (STAMP_SEL >= 0 && blockIdx.x == 0 && C.tid == 0) {
        const unsigned long long t0 = ((unsigned long long)C.MISC[17 + 2 * (STAMP_T0)] << 32) | C.MISC[16 + 2 * (STAMP_T0)], t1 = ((unsigned long long)C.MISC[17 + 2 * (STAMP_T1)] << 32) | C.MISC[16 + 2 * (STAMP_T1)];
        const unsigned long long w0 = __builtin_amdgcn_s_memrealtime(); while (__builtin_amdgcn_s_memrealtime() - w0 < 4ull * (t1 - t0)) __builtin_amdgcn_s_sleep(8); }
#undef IN
#undef SEAM
}

extern "C" void kernel_launch(void* const* d_in, const int* in_sizes, int n_in, void* d_out, int out_size, void* d_ws, size_t ws_size, hipStream_t stream) {
    static int grid = 0;
    if (grid == 0) {
        if (n_in != 19 || in_sizes[0] != NTOK * DM || out_size != NTOK * DM || ws_size < WS_END) { fprintf(stderr, "kernel_launch: unexpected problem shape / workspace; nothing launched\n"); grid = -1; return; }
        int dev = 0, cus = 0, per_cu = 0;
        if (hipGetDevice(&dev) != hipSuccess || hipDeviceGetAttribute(&cus, hipDeviceAttributeMultiprocessorCount, dev) != hipSuccess) { grid = -1; return; }
        if (hipFuncSetAttribute((const void*)mk_fwd, hipFuncAttributeMaxDynamicSharedMemorySize, LDS_BYTES) != hipSuccess) { fprintf(stderr, "kernel_launch: hipFuncSetAttribute failed\n"); grid = -1; return; }
        if (hipOccupancyMaxActiveBlocksPerMultiprocessor(&per_cu, (const void*)mk_fwd, NTHREADS, LDS_BYTES) != hipSuccess || per_cu < 1) { fprintf(stderr, "kernel_launch: occupancy query says %d\n", per_cu); }
        (void)hipGetLastError();
        grid = cus;
    }
    if (grid < 0) return;
    (void)hipMemsetAsync((char*)d_ws + WS_CTL, 0, CTL_ZERO_BYTES, stream);
    Args a{};
    for (int i = 0; i < 19; ++i) a.in[i] = (const float*)d_in[i];
    a.out = (float*)d_out; a.ws = (unsigned char*)d_ws;
    if (MK_N_LAUNCHES == 1) { a.ph_lo = 0; a.ph_hi = NPH; hipLaunchKernelGGL(mk_fwd, dim3(grid), dim3(NTHREADS), LDS_BYTES, stream, a); }
    else for (int p = 0; p < NPH; ++p) { a.ph_lo = p; a.ph_hi = p + 1; hipLaunchKernelGGL(mk_fwd, dim3(grid), dim3(NTHREADS), LDS_BYTES, stream, a); }
}
```

```cpp
#include <hip/hip_runtime.h>
#include <cstdio>
#include <cstdint>
#ifndef MK_N_LAUNCHES
#define MK_N_LAUNCHES 1
#endif
#define DI __device__ __forceinline__
#define GAS __attribute__((address_space(1)))
#define LAS __attribute__((address_space(3)))
typedef unsigned short bf16;
typedef unsigned u32x4 __attribute__((ext_vector_type(4)));
typedef unsigned u32x2 __attribute__((ext_vector_type(2)));
typedef float f32x4 __attribute__((ext_vector_type(4)));
typedef float f32x2 __attribute__((ext_vector_type(2)));
typedef float f32x16 __attribute__((ext_vector_type(16)));
typedef short bf16x8 __attribute__((ext_vector_type(8)));
typedef short s16x4 __attribute__((ext_vector_type(4)));
typedef short v4i16_t __attribute__((ext_vector_type(4)));
typedef __bf16 bf16x2_t __attribute__((ext_vector_type(2)));
typedef GAS unsigned gu32;

constexpr int NTOK = 32768, DM = 1024, SEQ = 2048, NBATCH = 16, NIN = 5632;
constexpr int NWAVES = 8, NTHREADS = 512;
constexpr float LN_EPS = 1e-5f, DN_ALPHA = 1.189207115002721f, LOG2E = 1.4426950408889634f;
constexpr int MOE_MAXTILES = 288;

constexpr size_t MiB = 1u << 20;
constexpr size_t WS_CTL = 0, CTL_ZERO_BYTES = 65536;
constexpr size_t WS_WIN = 1 * MiB, WS_WCAT = 12 * MiB, WS_WO = 14 * MiB;
constexpr size_t WS_XB = 16 * MiB;
constexpr size_t WS_R = 80 * MiB;
constexpr size_t WS_GB = 144 * MiB;
constexpr size_t WS_QH = 208 * MiB;
constexpr size_t WS_VH = 240 * MiB;
constexpr size_t WS_GH = 272 * MiB;
constexpr size_t WS_ZF = 304 * MiB;
constexpr size_t WS_QM = 368 * MiB, WS_KM = 400 * MiB;
constexpr size_t WS_VM = 432 * MiB;
constexpr size_t WS_Y = 16 * MiB;
constexpr size_t WS_MISC = 464 * MiB;
constexpr size_t WS_KMEAN = WS_MISC;
constexpr size_t WS_BPERM = WS_MISC + 1 * MiB;
constexpr size_t WS_WRH = WS_MISC + 2 * MiB;
constexpr size_t WS_WRL = WS_WRH + 98304;
constexpr size_t WS_TOKE = WS_MISC + 3 * MiB;
constexpr size_t WS_TOKW = WS_MISC + 4 * MiB;
constexpr size_t WS_TOKD = WS_MISC + 5 * MiB;
constexpr size_t WS_WGCNT = WS_MISC + 6 * MiB;
constexpr size_t WS_ROWTOK = WS_MISC + 7 * MiB;
constexpr size_t WS_TILEE = WS_MISC + 8 * MiB;
constexpr size_t WS_STATS = WS_MISC + 9 * MiB;
constexpr size_t WS_LB = WS_MISC + 10 * MiB;
constexpr size_t WS_KK = WS_MISC + 12 * MiB;
constexpr size_t WS_END = 512 * MiB;
constexpr int CW_BAR = 4096, CW_QUEUE = 8192, CW_QUEUE2 = 8192 + 1024;

constexpr int LDS_BYTES = 163840, MISC_OFF = LDS_BYTES - 256;

DI unsigned cvtpk(float lo, float hi) { f32x2 v = {lo, hi}; bf16x2_t b = __builtin_convertvector(v, bf16x2_t); return __builtin_bit_cast(unsigned, b); }
DI float bflo(unsigned w) { return __uint_as_float(w << 16); }
DI float bfhi(unsigned w) { return __uint_as_float(w & 0xffff0000u); }
DI float bf2f(unsigned short h) { return __uint_as_float((unsigned)h << 16); }
DI float frcp(float x) { return __builtin_amdgcn_rcpf(x); }
DI float fsigmoid(float x) { return frcp(1.f + __expf(-x)); }
DI float wave_sum(float v) {
#pragma unroll
    for (int o = 1; o < 64; o <<= 1) v += __shfl_xor(v, o);
    return v;
}
typedef int v8i __attribute__((ext_vector_type(8)));
typedef int v4i __attribute__((ext_vector_type(4)));
DI unsigned cvt4_fp8(float a, float b, float c, float d) { a = __builtin_amdgcn_fmed3f(a, -448.f, 448.f); b = __builtin_amdgcn_fmed3f(b, -448.f, 448.f); c = __builtin_amdgcn_fmed3f(c, -448.f, 448.f); d = __builtin_amdgcn_fmed3f(d, -448.f, 448.f);
    int w = 0; w = __builtin_amdgcn_cvt_pk_fp8_f32(a, b, w, false); w = __builtin_amdgcn_cvt_pk_fp8_f32(c, d, w, true); return (unsigned)w; }
DI f32x4 fp8x4_to_f32(unsigned w) { const f32x2 lo = __builtin_amdgcn_cvt_pk_f32_fp8((int)w, false), hi = __builtin_amdgcn_cvt_pk_f32_fp8((int)w, true); return (f32x4){lo[0], lo[1], hi[0], hi[1]}; }
constexpr float FP8_SXI = 8.f, FP8_SX = 8.f, FP8_SW = 32.f, FP8_SH = 4.f, FP8_SO = 4.f, FP8_SU = 32.f, FP8_SY = 64.f;
DI int crow(int r, int hi) { return (r & 3) + 8 * (r >> 2) + 4 * hi; }
#define MFMA32(a, b, c) __builtin_amdgcn_mfma_f32_32x32x16_bf16((a), (b), (c), 0, 0, 0)
#define MFMA16(a, b, c) __builtin_amdgcn_mfma_f32_16x16x32_bf16((a), (b), (c), 0, 0, 0)
DI s16x4 vtr(LAS const char* p) { return __builtin_bit_cast(s16x4, __builtin_amdgcn_ds_read_tr16_b64_v4i16((LAS v4i16_t*)p)); }

#define XB_TMO      128
#define XB_XCNT(j)  (256  + 64 * (j))
#define XB_XSUB(j)  (1280 + 64 * (j))
#define XB_XGEN(j)  (2304 + 64 * (j))
#define XB_TOP      3328
#define XB_TOPGEN   3392
#define XCD_BAR_WORDS 3456
#define XB_SPIN_CAP (1u << 22)
DI unsigned xb_ld(unsigned* p)              { return __hip_atomic_load(p, __ATOMIC_RELAXED, __HIP_MEMORY_SCOPE_AGENT); }
DI unsigned xb_add(unsigned* p, unsigned v) { return __hip_atomic_fetch_add(p, v, __ATOMIC_RELAXED, __HIP_MEMORY_SCOPE_AGENT); }
DI unsigned xb_xcc_id() { return (unsigned)__builtin_amdgcn_s_getreg((3 << 11) | 20) & 0xFu; }
#define XB_SPIN(cond, bar) do { unsigned _sp = 0; while (cond) { __builtin_amdgcn_s_sleep(1); \
    if ((++_sp & 255u) == 0u) { if (xb_ld(&(bar)[XB_TMO])) break; if (_sp > XB_SPIN_CAP) { atomicAdd(&(bar)[XB_TMO], 1u); break; } } } } while (0)
struct XcdBarrier { unsigned* bar; unsigned x; volatile LAS unsigned* st; };
DI XcdBarrier xcd_barrier_post(unsigned* bar, volatile LAS unsigned* st) {
    XcdBarrier b; b.bar = bar; b.x = xb_xcc_id(); b.st = st;
    if (threadIdx.x == 0) (void)xb_add(&bar[XB_XCNT(b.x)], 1u);
    return b;
}
DI void xcd_barrier_complete(unsigned* bar, unsigned x, unsigned& nloc, unsigned& nx) {
    const unsigned G = gridDim.x * gridDim.y * gridDim.z;
    unsigned sum, cnt, mine, sp = 0u;
    for (;;) {
        sum = 0u; cnt = 0u; mine = 0u;
#pragma unroll
        for (unsigned j = 0; j < 16; ++j) { const unsigned c = xb_ld(&bar[XB_XCNT(j)]); sum += c; cnt += (c > 0u) ? 1u : 0u; mine = (j == x) ? c : mine; }
        if (sum == G) break;
        __builtin_amdgcn_s_sleep(1);
        if ((++sp & 255u) == 0u) { if (xb_ld(&bar[XB_TMO])) break; if (sp > XB_SPIN_CAP) { atomicAdd(&bar[XB_TMO], 1u); break; } }
    }
    nloc = mine > 0u ? mine : 1u; nx = cnt > 0u ? cnt : 1u;
}
DI void xcd_barrier(const XcdBarrier& b) {
    asm volatile("s_waitcnt vmcnt(0)" ::: "memory");
    __syncthreads();
    if (threadIdx.x == 0) {
        unsigned* bar = b.bar;
        __builtin_amdgcn_s_waitcnt(0);
        unsigned nloc = b.st[0], nx = b.st[1];
        if (nloc == 0u) { xcd_barrier_complete(bar, b.x, nloc, nx); b.st[0] = nloc; b.st[1] = nx; }
        const unsigned old = xb_add(&bar[XB_XSUB(b.x)], 1u);
        const unsigned gen = old / nloc;
        if (old + 1u == (gen + 1u) * nloc) {
            __builtin_amdgcn_fence(__ATOMIC_RELEASE, "agent");
            asm volatile("s_waitcnt vmcnt(0)" ::: "memory");
            const unsigned og = xb_add(&bar[XB_TOP], 1u);
            const unsigned tg = og / nx;
            if (og + 1u == (tg + 1u) * nx) xb_add(&bar[XB_TOPGEN], 1u);
            else XB_SPIN(xb_ld(&bar[XB_TOPGEN]) == tg, bar);
            __builtin_amdgcn_fence(__ATOMIC_ACQUIRE, "agent");
            xb_add(&bar[XB_XGEN(b.x)], 1u);
            asm volatile("s_waitcnt vmcnt(0)" ::: "memory");
        } else {
            XB_SPIN(xb_ld(&bar[XB_XGEN(b.x)]) == gen, bar);
            __builtin_amdgcn_fence(__ATOMIC_ACQUIRE, "agent");
            asm volatile("s_waitcnt vmcnt(0)" ::: "memory");
        }
    }
    __syncthreads();
}

namespace pg8 {
constexpr int BM = 256, BK = 64, HALF = 128, HTB = HALF * BK * 2, STAGE_BYTES = 8 * HTB, NXCD = 8, WGM = 8;
DI int lds_byte(int r, int c) { const int st = (r >> 4) * 2 + (c >> 5), rr = r & 15, cc = c & 31, ob = rr * 64 + cc * 2; return st * 1024 + (ob ^ (((ob >> 9) & 1) << 5)); }
DI void stage_rc(int b, int& R, int& C) { const int st = b / 1024, sb = b % 1024, swz = sb ^ (((sb >> 9) & 1) << 5); R = (st >> 1) * 16 + swz / 64; C = (st & 1) * 32 + (swz % 64) / 2; }
DI int perm32(int rho) { const int n = rho >> 4, i = rho & 15; return 8 * (i >> 2) + 4 * n + (i & 3); }
struct Unit { int pm, pn, e; };

struct DenseOrder {
    const char* A; const char* Bt; int K, nM, nN, nwg, G, c;
    DI void init(const void* A_, const void* Bt_, int M, int N, int K_, int G_, int c_) { A = (const char*)A_; Bt = (const char*)Bt_; K = K_; nM = M / BM; nN = N / BM; nwg = nM * nN; G = G_; c = c_; }
    DI bool next(int i, Unit& u) const {
        const long L = (long)i * G + c; if (L >= nwg) return false;
        int wgid = (int)L; { const int q = nwg / NXCD, r = nwg % NXCD, xcd = wgid % NXCD, off = wgid / NXCD; wgid = (xcd < r ? xcd * (q + 1) : r * (q + 1) + (xcd - r) * q) + off; }
        const int nig = WGM * nN, gid = wgid / nig, fm = gid * WGM, gsz = (nM - fm) < WGM ? (nM - fm) : WGM;
        u.pm = fm + ((wgid % nig) % gsz); u.pn = (wgid % nig) / gsz; u.e = 0; return true;
    }
    DI const char* a_base(const Unit& u) const { return A + (size_t)u.pm * 512 * K; }
    DI const char* b_base(const Unit& u) const { return Bt + (size_t)u.pn * 512 * K; }
    DI void gather(const Unit&, const int (&)[2], const int (&)[2], unsigned (&)[2][2]) const {}
};
struct MoeOrder {
    const char* A; const char* Bt; const int* row_tok; const int* tile_e; int K, N, nunits, G, c; bool gat;
    DI bool next(int i, Unit& u) const {
        const int L = i * G + c; if (L >= nunits) return false;
        u.pm = L >> 2; u.pn = L & 3;
        u.e = __builtin_amdgcn_readfirstlane(__hip_atomic_load(tile_e + u.pm, __ATOMIC_RELAXED, __HIP_MEMORY_SCOPE_AGENT)); return true;
    }
    DI const char* a_base(const Unit& u) const { return gat ? A : A + (size_t)u.pm * 512 * K; }
    DI const char* b_base(const Unit& u) const { return Bt + ((size_t)u.e * N + (size_t)u.pn * 256) * K * 2; }
    DI void gather(const Unit& u, const int (&Rr)[2], const int (&Cc)[2], unsigned (&o)[2][2]) const {
#pragma unroll
        for (int h = 0; h < 2; ++h)
#pragma unroll
            for (int i = 0; i < 2; ++i) { const int tok = row_tok[u.pm * 256 + h * 128 + Rr[i]]; o[h][i] = (unsigned)(tok * K + Cc[i]) * 2u; }
    }
};

template <class Epi, class Sched, bool GATHER, bool FP8 = false>
DI void gemm_phase(LAS unsigned char* lds, const int K, const Sched& S, const Epi& E) {
    const int tid = threadIdx.x, wid = __builtin_amdgcn_readfirstlane(tid >> 6), lane = tid & 63, wr = wid >> 2, wc = wid & 3, fr = lane & 15, fq = lane >> 4;
    const int nt = K / BK;
    unsigned voffB[2], vA[2][2], nvA[2][2]; int Rr[2], Cc[2];
#pragma unroll
    for (int i = 0; i < 2; ++i) { int R, C; stage_rc(tid * 16 + i * 8192, R, C); Rr[i] = R; Cc[i] = C; const int Rb = (R & ~31) + perm32(R & 31);
        voffB[i] = (unsigned)(Rb * K + C) * 2u; vA[0][i] = (unsigned)(R * K + C) * 2u; vA[1][i] = (unsigned)((R + HALF) * K + C) * 2u; nvA[0][i] = vA[0][i]; nvA[1][i] = vA[1][i]; }
    const size_t kstep = (size_t)(BK * 2);
    const size_t hstep = (size_t)HALF * K * 2;
    const unsigned ldsw = (unsigned)wid * 1024u;
    const int aoff = lds_byte(wr * 64 + fr, fq * 8), boff = lds_byte(wc * 32 + fr, fq * 8);
#define PG8_SA(b, h) (((b) * 2 + (h)) * HTB)
#define PG8_SB(b, h) ((4 + (b) * 2 + (h)) * HTB)
#define PG8_STAGE(bufoff, gbase, voff) do { _Pragma("unroll") for (int _i = 0; _i < 2; ++_i) \
        __builtin_amdgcn_global_load_lds((const unsigned*)((const char*)(gbase) + (voff)[_i]), (LAS unsigned*)(lds + (bufoff) + ldsw + _i * 8192), 16, 0, 0); } while (0)
#define PG8_LDA(dst, b, h) do { if constexpr (FP8) { _Pragma("unroll") for (int m = 0; m < 4; ++m) dst##8[m] = __builtin_shufflevector(*(const LAS v4i*)(lds + PG8_SA(b, h) + aoff + m * 2048), *(const LAS v4i*)(lds + PG8_SA(b, h) + aoff + m * 2048 + 1024), 0, 1, 2, 3, 4, 5, 6, 7); } \
        else { _Pragma("unroll") for (int m = 0; m < 4; ++m) _Pragma("unroll") for (int k = 0; k < 2; ++k) dst[m][k] = *(const LAS bf16x8*)(lds + PG8_SA(b, h) + aoff + m * 2048 + k * 1024); } } while (0)
#define PG8_LDB(dst, b, h) do { if constexpr (FP8) { _Pragma("unroll") for (int n = 0; n < 2; ++n) dst##8[n] = __builtin_shufflevector(*(const LAS v4i*)(lds + PG8_SB(b, h) + boff + n * 2048), *(const LAS v4i*)(lds + PG8_SB(b, h) + boff + n * 2048 + 1024), 0, 1, 2, 3, 4, 5, 6, 7); } \
        else { _Pragma("unroll") for (int n = 0; n < 2; ++n) _Pragma("unroll") for (int k = 0; k < 2; ++k) dst[n][k] = *(const LAS bf16x8*)(lds + PG8_SB(b, h) + boff + n * 2048 + k * 1024); } } while (0)
#define PG8_CAT(x, y) __builtin_shufflevector(__builtin_bit_cast(v4i, (x)), __builtin_bit_cast(v4i, (y)), 0, 1, 2, 3, 4, 5, 6, 7)
#define PG8_MMA(ai, bj, At, Bt) do { __builtin_amdgcn_s_setprio(1); if constexpr (FP8) { _Pragma("unroll") for (int m = 0; m < 4; ++m) _Pragma("unroll") for (int n = 0; n < 2; ++n) \
        asm volatile("v_mfma_scale_f32_16x16x128_f8f6f4 %0, %1, %2, %0, %3, %3 op_sel_hi:[0,0,0]" : "+v"(acc[ai][bj][m][n]) : "v"(Bt##8[n]), "v"(At##8[m]), "v"(fp8_unit_scale)); } else { \
        _Pragma("unroll") for (int m = 0; m < 4; ++m) _Pragma("unroll") for (int n = 0; n < 2; ++n) _Pragma("unroll") for (int k = 0; k < 2; ++k) \
        acc[ai][bj][m][n] = __builtin_amdgcn_mfma_f32_16x16x32_bf16(Bt[n][k], At[m][k], acc[ai][bj][m][n], 0, 0, 0); } __builtin_amdgcn_s_setprio(0); } while (0)
#define PG8_WAIT_V(n) asm volatile("s_waitcnt vmcnt(" #n ")" ::: "memory")
#define PG8_WAIT_L(n) asm volatile("s_waitcnt lgkmcnt(" #n ")" ::: "memory")
#define PG8_BAR __builtin_amdgcn_s_barrier()
#define PG8_SCHED __builtin_amdgcn_sched_barrier(0)
    Unit cur, nxt; int ui = 0;
    if (!S.next(0, cur)) return;
    if constexpr (GATHER) S.gather(cur, Rr, Cc, vA);
    f32x4 acc[2][2][4][2];
#pragma unroll
    for (int a = 0; a < 2; ++a)
#pragma unroll
        for (int b = 0; b < 2; ++b)
#pragma unroll
            for (int m = 0; m < 4; ++m)
#pragma unroll
                for (int n = 0; n < 2; ++n) acc[a][b][m][n] = (f32x4){0.f, 0.f, 0.f, 0.f};
    bf16x8 At[4][2], B0[2][2], B1[2][2]; v8i At8[4], B08[2], B18[2]; const int fp8_unit_scale = 0x7f7f7f7f;
    const char* cA = S.a_base(cur); const char* cB = S.b_base(cur);
    PG8_STAGE(PG8_SB(0, 0), cB, voffB); PG8_STAGE(PG8_SB(0, 1), cB + hstep, voffB); PG8_STAGE(PG8_SA(0, 0), cA, vA[0]); PG8_STAGE(PG8_SA(0, 1), cA, vA[1]);
    if (wr == 1) PG8_BAR;
    PG8_WAIT_V(2); PG8_BAR;
    PG8_STAGE(PG8_SB(1, 0), cB + kstep, voffB); PG8_STAGE(PG8_SA(1, 0), cA + kstep, vA[0]); PG8_STAGE(PG8_SB(1, 1), cB + hstep + kstep, voffB);
    PG8_WAIT_V(6); PG8_BAR;
    for (;;) {
        const bool has_next = S.next(ui + 1, nxt);
        const char* nA = has_next ? S.a_base(nxt) : cA; const char* nB = has_next ? S.b_base(nxt) : cB;
        if constexpr (GATHER) {
            if (has_next) S.gather(nxt, Rr, Cc, nvA);
            else {
#pragma unroll
                for (int h = 0; h < 2; ++h) { nvA[h][0] = vA[h][0]; nvA[h][1] = vA[h][1]; } }
        }
#pragma unroll 1
        for (int t = 0; t < nt; t += 2) {
            const bool last = (t == nt - 2);
            if constexpr (Epi::HAS_MID) { if (t == (nt >> 1)) { if constexpr (FP8) asm volatile("s_nop 15\n\ts_nop 15" ::: "memory"); E.mid(acc, cur, wr, wc, fr, fq); if constexpr (FP8) asm volatile("s_nop 7" ::: "memory"); } }
            const char* a1 = cA + (size_t)(t + 1) * kstep;
            const char* a2 = last ? nA : cA + (size_t)(t + 2) * kstep; const char* b2 = last ? nB : cB + (size_t)(t + 2) * kstep;
            const char* a3 = a2 + kstep; const char* b3 = b2 + kstep;
            unsigned o0[2], o1[2];
            if constexpr (GATHER) { o0[0] = last ? nvA[0][0] : vA[0][0]; o0[1] = last ? nvA[0][1] : vA[0][1]; o1[0] = last ? nvA[1][0] : vA[1][0]; o1[1] = last ? nvA[1][1] : vA[1][1]; }
            else { o0[0] = vA[0][0]; o0[1] = vA[0][1]; o1[0] = vA[1][0]; o1[1] = vA[1][1]; }
            PG8_LDB(B0, 0, 0); PG8_LDB(B1, 0, 1); PG8_SCHED; PG8_LDA(At, 0, 0); PG8_STAGE(PG8_SA(1, 1), a1, vA[1]);
            PG8_WAIT_V(8); PG8_WAIT_L(0); PG8_BAR; PG8_MMA(0, 0, At, B0); PG8_MMA(0, 1, At, B1); PG8_BAR; PG8_SCHED;
            PG8_LDA(At, 0, 1); PG8_STAGE(PG8_SB(0, 0), b2, voffB); PG8_STAGE(PG8_SB(0, 1), b2 + hstep, voffB); PG8_STAGE(PG8_SA(0, 0), a2, o0);
            PG8_WAIT_V(8); PG8_WAIT_L(0); PG8_BAR; PG8_MMA(1, 0, At, B0); PG8_MMA(1, 1, At, B1); PG8_BAR; PG8_SCHED;
            PG8_LDB(B0, 1, 0); PG8_LDB(B1, 1, 1); PG8_SCHED; PG8_LDA(At, 1, 0); PG8_STAGE(PG8_SA(0, 1), a2, o1);
            PG8_WAIT_V(8); PG8_WAIT_L(0); PG8_BAR; PG8_MMA(0, 0, At, B0); PG8_MMA(0, 1, At, B1); PG8_BAR; PG8_SCHED;
            PG8_LDA(At, 1, 1); PG8_STAGE(PG8_SB(1, 0), b3, voffB); PG8_STAGE(PG8_SB(1, 1), b3 + hstep, voffB); PG8_STAGE(PG8_SA(1, 0), a3, o0);
            PG8_WAIT_V(8); PG8_WAIT_L(0); PG8_BAR; PG8_MMA(1, 0, At, B0); PG8_MMA(1, 1, At, B1); PG8_BAR; PG8_SCHED;
        }
        if (wr == 0) PG8_BAR;
        if constexpr (FP8) asm volatile("s_nop 15\n\ts_nop 15" ::: "memory");
        E(acc, cur, wr, wc, fr, fq);
        if (!has_next) break;
#pragma unroll
        for (int a = 0; a < 2; ++a)
#pragma unroll
            for (int b = 0; b < 2; ++b)
#pragma unroll
                for (int m = 0; m < 4; ++m)
#pragma unroll
                    for (int n = 0; n < 2; ++n) acc[a][b][m][n] = (f32x4){0.f, 0.f, 0.f, 0.f};
        cur = nxt; cA = nA; cB = nB; ++ui;
        if constexpr (GATHER) {
#pragma unroll
            for (int h = 0; h < 2; ++h) { vA[h][0] = nvA[h][0]; vA[h][1] = nvA[h][1]; } }
        if (wr == 1) PG8_BAR;
    }
    PG8_WAIT_V(0);
    PG8_BAR;
#undef PG8_SA
#undef PG8_SB
#undef PG8_STAGE
#undef PG8_LDA
#undef PG8_LDB
#undef PG8_MMA
#undef PG8_CAT
#undef PG8_WAIT_V
#undef PG8_WAIT_L
#undef PG8_BAR
#undef PG8_SCHED
}

typedef f32x4 Acc[2][2][4][2];
DI u32x4 pack8(const f32x4 a, const f32x4 b) { u32x4 w; w.x = cvtpk(a[0], a[1]); w.y = cvtpk(a[2], a[3]); w.z = cvtpk(b[0], b[1]); w.w = cvtpk(b[2], b[3]); return w; }
DI f32x4 silu4(const f32x4 v) { f32x4 o; o[0] = v[0] * fsigmoid(v[0]); o[1] = v[1] * fsigmoid(v[1]); o[2] = v[2] * fsigmoid(v[2]); o[3] = v[3] * fsigmoid(v[3]); return o; }

struct EpiIn {
    static constexpr bool HAS_MID = false;
    bf16 *Qh, *Vh, *Gh, *Qm, *Km, *Vm, *Rr, *Gb; float *Zf, *KM; const float* bias; bf16* KK; const float* LB; int pn_off;
    DI void operator()(Acc& acc, const Unit& u, int wr, int wc, int fr, int fq) const {
        const int pn = u.pn + pn_off, row0 = u.pm * BM + wr * 64 + fr, cl = wc * 32 + 8 * fq;
        if (pn_off) {
#pragma unroll
            for (int ai = 0; ai < 2; ++ai)
#pragma unroll
                for (int bj = 0; bj < 2; ++bj)
#pragma unroll
                    for (int m = 0; m < 4; ++m) { acc[ai][bj][m][0] *= (1.f / (FP8_SXI * FP8_SW)); acc[ai][bj][m][1] *= (1.f / (FP8_SXI * FP8_SW)); } }
        f32x4 bv[2][2];
#pragma unroll
        for (int bj = 0; bj < 2; ++bj)
#pragma unroll
            for (int n = 0; n < 2; ++n) bv[bj][n] = *(const f32x4*)(bias + pn * 256 + bj * HALF + cl + 4 * n);
        if (pn < 4) {
#define EI_DPP(v, ctrl) __int_as_float(__builtin_amdgcn_update_dpp(0, __float_as_int(v), ctrl, 0xf, 0xf, true))
            const int chb = pn * 128 + cl;
#pragma unroll
            for (int ai = 0; ai < 2; ++ai)
#pragma unroll
                for (int n = 0; n < 2; ++n) { const f32x4 lbv = *(const f32x4*)(LB + chb + 4 * n); f32x4 run = (f32x4){0.f, 0.f, 0.f, 0.f}, bmid = run; f32x4 bbv[4], kkv[4];
#pragma unroll
                    for (int m = 0; m < 4; ++m) {
#pragma unroll
                        for (int j = 0; j < 4; ++j) { const float z = acc[ai][1][m][n][j] + bv[1][n][j]; const float sg = frcp(1.f + __expf(-z)); const float lf = __logf(lbv[j] + (1.f - lbv[j]) * sg); kkv[m][j] = (1.f - lbv[j]) * (1.f - sg);
                            float t = lf; t += EI_DPP(t, 0xB1); t += EI_DPP(t, 0x4E); t += EI_DPP(t, 0x141); t += EI_DPP(t, 0x140);
                            float s = lf; s += EI_DPP(s, 0x111); s += EI_DPP(s, 0x112); s += EI_DPP(s, 0x114); s += EI_DPP(s, 0x118);
                            bbv[m][j] = s + run[j]; run[j] += t; }
                        if (m == 1) bmid = run; }
#pragma unroll
                    for (int m = 0; m < 4; ++m) { f32x4 qp, kp;
#pragma unroll
                        for (int j = 0; j < 4; ++j) { const float qx = acc[ai][0][m][n][j] + bv[0][n][j]; const float e = __expf(bbv[m][j] - bmid[j]); qp[j] = qx * fsigmoid(qx) * e; kp[j] = kkv[m][j] * frcp(e); }
                        const size_t ro = (size_t)(row0 + ai * HALF + m * 16) * 512 + chb + 4 * n;
                        u32x2 qw, kw; qw.x = cvtpk(qp[0], qp[1]); qw.y = cvtpk(qp[2], qp[3]); kw.x = cvtpk(kp[0], kp[1]); kw.y = cvtpk(kp[2], kp[3]);
                        *(u32x2*)(Qh + ro) = qw; *(u32x2*)(KK + ro) = kw; }
                    if (fr == 0) { const size_t so = (size_t)(u.pm * 4 + ai * 2 + wr) * 512 + chb + 4 * n; *(f32x4*)(Zf + so) = bmid; *(f32x4*)(Zf + 262144 + so) = run; }
                    asm volatile("" ::: "memory"); }
#undef EI_DPP
        } else if (pn < 14) {
            const int seg = pn >> 1, c0 = (pn & 1) * 256 + cl;
            {
                bf16* O = seg == 2 ? Vh : seg == 3 ? Gh : seg == 4 ? Qm : seg == 5 ? Km : Vm;
                const int act = (seg == 3) ? 1 : (seg == 4 ? 2 : 0);
                if (seg == 5) {
#pragma unroll
                    for (int bj = 0; bj < 2; ++bj)
#pragma unroll
                        for (int n = 0; n < 2; ++n) { f32x4 cs = (f32x4){0.f, 0.f, 0.f, 0.f};
#pragma unroll
                            for (int ai = 0; ai < 2; ++ai)
#pragma unroll
                                for (int m = 0; m < 4; ++m) cs += acc[ai][bj][m][n] + bv[bj][n];
#pragma unroll
                            for (int j = 0; j < 4; ++j) { float s = cs[j]; s += __shfl_xor(s, 1); s += __shfl_xor(s, 2); s += __shfl_xor(s, 4); s += __shfl_xor(s, 8); cs[j] = s; }
                            if (fr == 0) *(f32x4*)(KM + (size_t)(u.pm * 2 + wr) * 512 + c0 + bj * HALF + 4 * n) = cs; }
                }
#pragma unroll
                for (int ai = 0; ai < 2; ++ai)
#pragma unroll
                    for (int m = 0; m < 4; ++m) { const int row = row0 + ai * HALF + m * 16;
                        bf16* rp = (seg >= 4) ? O + ((size_t)(row >> 11) * 8 * SEQ + (row & (SEQ - 1))) * 64 + (size_t)(c0 >> 6) * SEQ * 64 + (c0 & 63) : O + (size_t)row * 512 + c0;
                        const size_t bjs = (seg >= 4) ? (size_t)2 * SEQ * 64 : (size_t)HALF;
#pragma unroll
                        for (int bj = 0; bj < 2; ++bj) { f32x4 v0 = acc[ai][bj][m][0] + bv[bj][0], v1 = acc[ai][bj][m][1] + bv[bj][1];
                            if (act == 1) { v0 = silu4(v0); v1 = silu4(v1); } else if (act == 2) { v0 = v0 * (0.125f * LOG2E); v1 = v1 * (0.125f * LOG2E); }
                            *(u32x4*)(rp + bj * bjs) = pack8(v0, v1); }
                        asm volatile("" ::: "memory"); }
            }
        } else {
            const int c0 = (pn - 14) * 128 + cl;
#pragma unroll
            for (int ai = 0; ai < 2; ++ai)
#pragma unroll
                for (int m = 0; m < 4; ++m) { const size_t off = (size_t)(row0 + ai * HALF + m * 16) * 1024 + c0; f32x4 r[2], g[2];
#pragma unroll
                    for (int n = 0; n < 2; ++n) { const f32x4 a = acc[ai][0][m][n] + bv[0][n], b = acc[ai][1][m][n] + bv[1][n];
#pragma unroll
                        for (int j = 0; j < 4; ++j) { const float ea = __expf(-a[j]), eb = __expf(-b[j]); g[n][j] = frcp(1.f + eb); r[n][j] = (1.f + eb) * frcp(1.f + ea); } }
                    *(u32x4*)(Rr + off) = pack8(r[0], r[1]); *(u32x4*)(Gb + off) = pack8(g[0], g[1]); asm volatile("" ::: "memory"); }
        }
    }
};
struct EpiProj {
    static constexpr bool HAS_MID = true;
    const bf16 *Rr, *Gb; unsigned char* U;
    DI void scale(Acc& acc, const bf16* G, const Unit& u, int wr, int wc, int fr, int fq) const {
        int row0 = u.pm * BM + wr * 64 + fr, col0 = u.pn * BM + wc * 32 + 8 * fq;
        asm volatile("" : "+v"(row0), "+v"(col0));
#pragma unroll
        for (int ai = 0; ai < 2; ++ai)
#pragma unroll
            for (int mp = 0; mp < 2; ++mp) { u32x4 rv[2][2];
#pragma unroll
            for (int m = 0; m < 2; ++m)
#pragma unroll
                for (int bj = 0; bj < 2; ++bj) rv[m][bj] = *(const u32x4*)(G + (size_t)(row0 + ai * HALF + (2 * mp + m) * 16) * 1024 + col0 + bj * HALF);
#pragma unroll
            for (int m = 0; m < 2; ++m)
#pragma unroll
                for (int bj = 0; bj < 2; ++bj) { const u32x4 w = rv[m][bj];
                    acc[ai][bj][2 * mp + m][0] *= (f32x4){bflo(w.x), bfhi(w.x), bflo(w.y), bfhi(w.y)}; acc[ai][bj][2 * mp + m][1] *= (f32x4){bflo(w.z), bfhi(w.z), bflo(w.w), bfhi(w.w)}; }
            asm volatile("" ::: "memory"); }
    }
    DI void mid(Acc& acc, const Unit& u, int wr, int wc, int fr, int fq) const { scale(acc, Rr, u, wr, wc, fr, fq); }
    DI void operator()(Acc& acc, const Unit& u, int wr, int wc, int fr, int fq) const {
        scale(acc, Gb, u, wr, wc, fr, fq);
        const int row0 = u.pm * BM + wr * 64 + fr, col0 = u.pn * BM + wc * 32 + 8 * fq;
        constexpr float inv = FP8_SU / (FP8_SO * FP8_SW);
#pragma unroll
        for (int ai = 0; ai < 2; ++ai)
#pragma unroll
            for (int m = 0; m < 4; ++m) { unsigned char* rp = U + (size_t)(row0 + ai * HALF + m * 16) * 1024 + col0;
#pragma unroll
                for (int bj = 0; bj < 2; ++bj) { const f32x4 v0 = acc[ai][bj][m][0] * inv, v1 = acc[ai][bj][m][1] * inv; u32x2 w; w.x = cvt4_fp8(v0[0], v0[1], v0[2], v0[3]); w.y = cvt4_fp8(v1[0], v1[1], v1[2], v1[3]); *(u32x2*)(rp + bj * HALF) = w; } }
    }
};
struct EpiOut {
    static constexpr bool HAS_MID = false;
    const float* X; float* Pre;
    DI void operator()(Acc& acc, const Unit& u, int wr, int wc, int fr, int fq) const {
        const int row0 = u.pm * BM + wr * 64 + fr, col0 = u.pn * BM + wc * 32 + 8 * fq;
#pragma unroll
        for (int ai = 0; ai < 2; ++ai)
#pragma unroll
            for (int m = 0; m < 4; ++m) { const size_t off = (size_t)(row0 + ai * HALF + m * 16) * 1024 + col0;
#pragma unroll
                for (int bj = 0; bj < 2; ++bj) { const f32x4 x0 = *(const f32x4*)(X + off + bj * HALF), x1 = *(const f32x4*)(X + off + bj * HALF + 4);
                    *(f32x4*)(Pre + off + bj * HALF) = x0 * DN_ALPHA + acc[ai][bj][m][0] * (1.f / (FP8_SU * FP8_SW)); *(f32x4*)(Pre + off + bj * HALF + 4) = x1 * DN_ALPHA + acc[ai][bj][m][1] * (1.f / (FP8_SU * FP8_SW)); }
                if (m & 1) asm volatile("" ::: "memory"); }
    }
};
struct EpiM1 {
    static constexpr bool HAS_MID = false;
    unsigned char* H;
    DI void operator()(Acc& acc, const Unit& u, int wr, int wc, int fr, int fq) const {
        const int row0 = u.pm * BM + wr * 64 + fr, col0 = u.pn * 128 + wc * 32 + 8 * fq;
        constexpr float inv = 1.f / (FP8_SX * FP8_SW);
#pragma unroll
        for (int ai = 0; ai < 2; ++ai)
#pragma unroll
            for (int m = 0; m < 4; ++m) { const f32x4 h0 = silu4(acc[ai][0][m][0] * inv) * (acc[ai][1][m][0] * (inv * FP8_SH)), h1 = silu4(acc[ai][0][m][1] * inv) * (acc[ai][1][m][1] * (inv * FP8_SH));
                u32x2 w; w.x = cvt4_fp8(h0[0], h0[1], h0[2], h0[3]); w.y = cvt4_fp8(h1[0], h1[1], h1[2], h1[3]);
                *(u32x2*)(H + (size_t)(row0 + ai * HALF + m * 16) * 512 + col0) = w; }
    }
};
struct EpiM2 {
    static constexpr bool HAS_MID = false;
    unsigned char* Y;
    DI void operator()(Acc& acc, const Unit& u, int wr, int wc, int fr, int fq) const {
        const int row0 = u.pm * BM + wr * 64 + fr, col0 = u.pn * BM + wc * 32 + 8 * fq;
        constexpr float inv = FP8_SY / (FP8_SH * FP8_SW);
#pragma unroll
        for (int ai = 0; ai < 2; ++ai)
#pragma unroll
            for (int m = 0; m < 4; ++m) { unsigned char* rp = Y + (size_t)(row0 + ai * HALF + m * 16) * 1024 + col0;
#pragma unroll
                for (int bj = 0; bj < 2; ++bj) { const f32x4 v0 = acc[ai][bj][m][0] * inv, v1 = acc[ai][bj][m][1] * inv; u32x2 w; w.x = cvt4_fp8(v0[0], v0[1], v0[2], v0[3]); w.y = cvt4_fp8(v1[0], v1[1], v1[2], v1[3]); *(u32x2*)(rp + bj * HALF) = w; } }
    }
};
}

struct Args { const float* in[19]; float* out; unsigned char* ws; int ph_lo, ph_hi; };
enum { I_X = 0, I_WIN, I_BIN, I_LBL, I_HGNG, I_RELB, I_WPA, I_WPB, I_WOUT, I_LN1G, I_LN1B, I_WGRP, I_BGRP, I_WEXP, I_BEXP, I_WGU, I_WDN, I_LN2G, I_LN2B };

struct Ctx {
    LAS unsigned char* lds; volatile LAS unsigned* MISC;
    int tid, lane, wid, G, vcu;
    unsigned char* ws; gu32* ctl;
};

DI int win_drow(int n0) { if (n0 < 512) return 256 * (n0 >> 7) + (n0 & 127); if (n0 < 1024) { const int r = n0 - 512; return 256 * (r >> 7) + 128 + (r & 127); }
    if (n0 < 3584) return n0; if (n0 < 4608) { const int r = n0 - 3584; return 3584 + 256 * (r >> 7) + (r & 127); } const int r = n0 - 4608; return 3584 + 256 * (r >> 7) + 128 + (r & 127); }
DI int wgu_drow(int n0) { if (n0 < 512) return 256 * (n0 >> 7) + (n0 & 127); const int r = n0 - 512; return 256 * (r >> 7) + 128 + (r & 127); }
DI int hswz(int row, int ch16) { return 256 * row + 16 * (ch16 ^ (((row & 3) << 2) | ((row >> 2) & 3))); }
DI int htr(int r0, int c0, int lane) { const int i16 = lane & 15, q = i16 >> 2, p = i16 & 3; return hswz(r0 + q, c0 + (p >> 1)) + 8 * (p & 1); }
DI void transpose_tile256(const float* W, int N, bf16* WT, int ldk, int n0, int mode, int dk, LAS unsigned char* lds, int lane, int wid, bool f8 = false) {
    asm volatile("" : "+v"(lane));
#pragma unroll
    for (int half = 0; half < 2; ++half) { f32x4 v[16];
#pragma unroll
        for (int i = 0; i < 16; ++i) v[i] = *(const f32x4*)(W + (size_t)(128 * half + 8 * i + wid) * N + 4 * lane);
#pragma unroll
        for (int i = 0; i < 16; ++i) { const int k = 128 * half + 8 * i + wid; u32x2 w; w.x = cvtpk(v[i][0], v[i][1]); w.y = cvtpk(v[i][2], v[i][3]);
            *(LAS u32x2*)(lds + (lane >> 5) * 65536 + hswz(k, (lane & 31) >> 1) + 8 * (lane & 1)) = w; } }
    __syncthreads();
    const int g = lane >> 4, i16 = lane & 15;
#pragma unroll
    for (int nb = 0; nb < 2; ++nb) { const int nl = 32 * wid + 16 * nb + i16, n = n0 + nl; const int dr = (mode == 0) ? n : (mode == 1 ? win_drow(n) : wgu_drow(n));
        bf16* orow = WT + (size_t)dr * ldk + dk + 8 * g; const LAS unsigned char* img = lds + (wid >> 2) * 65536;
#pragma unroll
        for (int s = 0; s < 8; ++s) { const int r0 = 32 * s + 8 * g, c0 = 4 * (wid & 3) + 2 * nb;
            const s16x4 lo = vtr((LAS const char*)(img + htr(r0, c0, lane))), hh = vtr((LAS const char*)(img + htr(r0 + 4, c0, lane)));
            if (f8) { u32x2 w; w.x = cvt4_fp8(bf2f((unsigned short)lo[0]) * FP8_SW, bf2f((unsigned short)lo[1]) * FP8_SW, bf2f((unsigned short)lo[2]) * FP8_SW, bf2f((unsigned short)lo[3]) * FP8_SW);
                w.y = cvt4_fp8(bf2f((unsigned short)hh[0]) * FP8_SW, bf2f((unsigned short)hh[1]) * FP8_SW, bf2f((unsigned short)hh[2]) * FP8_SW, bf2f((unsigned short)hh[3]) * FP8_SW);
                *(u32x2*)((unsigned char*)WT + (size_t)dr * ldk + dk + 8 * g + 32 * s) = w; }
            else *(bf16x8*)(orow + 32 * s) = (bf16x8){lo[0], lo[1], lo[2], lo[3], hh[0], hh[1], hh[2], hh[3]}; } }
    __syncthreads();
}
constexpr int MOE_CVT_TILES = 32 * 16 + 32 * 8;
DI void moe_cvt_tile(const Ctx& C, const Args& a, int it) {
    unsigned char* WguT = (unsigned char*)a.out; unsigned char* WdT = (unsigned char*)a.out + 32 * MiB;
    if (it < 512) { const int e = it >> 4, kt = (it >> 2) & 3, nt = it & 3;
        transpose_tile256(a.in[I_WGU] + (size_t)e * 1024 * 1024 + (size_t)(256 * kt) * 1024 + 256 * nt, 1024, (bf16*)(WguT + (size_t)e * 1024 * 1024), 1024, 256 * nt, 2, 256 * kt, C.lds, C.lane, C.wid, true); }
    else { const int r = it - 512, e = r >> 3, kt = (r >> 2) & 1, nt = r & 3;
        transpose_tile256(a.in[I_WDN] + (size_t)e * 512 * 1024 + (size_t)(256 * kt) * 1024 + 256 * nt, 1024, (bf16*)(WdT + (size_t)e * 1024 * 512), 512, 256 * nt, 0, 256 * kt, C.lds, C.lane, C.wid, true); }
}
DI void p0_prologue(const Ctx& C, const Args& a) {
    bf16* WinT = (bf16*)(C.ws + WS_WIN); bf16* Wcat = (bf16*)(C.ws + WS_WCAT); bf16* WoT = (bf16*)(C.ws + WS_WO);
    constexpr int I_IN = 4 * 22, I_PA = 2 * 4, I_O = 4 * 4, NITEMS = I_IN + 2 * I_PA + I_O;
    for (int it = C.vcu; it < NITEMS; it += C.G) {
        int r = it;
        if (r < I_IN) { const int kt = r / 22, nt = r % 22;
            if (nt < 8) transpose_tile256(a.in[I_WIN] + (size_t)(256 * kt) * NIN + 256 * nt, NIN, WinT, 1024, 256 * nt, 1, 256 * kt, C.lds, C.lane, C.wid);
            else transpose_tile256(a.in[I_WIN] + (size_t)(256 * kt) * NIN + 256 * nt, NIN, (bf16*)(C.ws + WS_WIN + 4 * MiB - (size_t)2048 * 1024), 1024, 256 * nt, 1, 256 * kt, C.lds, C.lane, C.wid, true);
            continue; } r -= I_IN;
        if (r < I_PA) { const int kt = r / 4, nt = r % 4; transpose_tile256(a.in[I_WPA] + (size_t)(256 * kt) * 1024 + 256 * nt, 1024, Wcat, 1024, 256 * nt, 0, 256 * kt, C.lds, C.lane, C.wid, true); continue; } r -= I_PA;
        if (r < I_PA) { const int kt = r / 4, nt = r % 4; transpose_tile256(a.in[I_WPB] + (size_t)(256 * kt) * 1024 + 256 * nt, 1024, Wcat, 1024, 256 * nt, 0, 512 + 256 * kt, C.lds, C.lane, C.wid, true); continue; } r -= I_PA;
        { const int kt = r / 4, nt = r % 4; transpose_tile256(a.in[I_WOUT] + (size_t)(256 * kt) * 1024 + 256 * nt, 1024, WoT, 1024, 256 * nt, 0, 256 * kt, C.lds, C.lane, C.wid, true); }
    }
    const int gw = C.vcu * NWAVES + C.wid, NGW = C.G * NWAVES; (void)gw; (void)NGW;
    const int gt = C.vcu * NTHREADS + C.tid, NT = C.G * NTHREADS;
    { const float* x = a.in[I_X]; bf16* Xb = (bf16*)(C.ws + WS_XB);
      unsigned char* Xq = (unsigned char*)a.out + 64 * MiB;
      for (int i = gt; i < NTOK * DM / 8; i += NT) { const f32x4 v0 = *(const f32x4*)(x + (size_t)i * 8), v1 = *(const f32x4*)(x + (size_t)i * 8 + 4); *(u32x4*)(Xb + (size_t)i * 8) = pg8::pack8(v0, v1);
          u32x2 q; q.x = cvt4_fp8(v0[0] * FP8_SXI, v0[1] * FP8_SXI, v0[2] * FP8_SXI, v0[3] * FP8_SXI); q.y = cvt4_fp8(v1[0] * FP8_SXI, v1[1] * FP8_SXI, v1[2] * FP8_SXI, v1[3] * FP8_SXI); *(u32x2*)(Xq + (size_t)i * 8) = q; } }
    { float* lbp = (float*)(C.ws + WS_LB); for (int n = gt; n < 512; n += NT) lbp[n] = 1.f / (1.f + expf(a.in[I_LBL][512 + n] - a.in[I_LBL][n])); }
    { float* bp = (float*)(C.ws + WS_BPERM); const float* bin = a.in[I_BIN];
      for (int n = gt; n < NIN; n += NT) bp[win_drow(n & ~31) + (n & 31)] = bin[n]; }
    { bf16* wh = (bf16*)(C.ws + WS_WRH); bf16* wl = (bf16*)(C.ws + WS_WRL); const float* wg = a.in[I_WGRP]; const float* we = a.in[I_WEXP];
      for (int i = gt; i < 48 * 1024; i += NT) { const int j = i >> 10, k = i & 1023; float w = 0.f; if (j < 4) w = wg[k * 4 + j]; else if (j < 36) w = we[k * 32 + (j - 4)];
          const unsigned h = cvtpk(w, 0.f) & 0xffffu; const float r = w - bf2f((unsigned short)h); wh[i] = (bf16)h; wl[i] = (bf16)(cvtpk(r, 0.f) & 0xffffu); } }
}
constexpr int HG_BUF = 67072, HG_QP = 0, HG_KP = 16384, HG_V = 32768, HG_SC = 49152, HG_OB = 49664;
DI void hgrn_unit(const Ctx& C, const Args& a, int b, int h) {
    LAS unsigned char* L = C.lds;
    const int tid = C.tid, lane = C.lane, wid = C.wid;
    const int q32 = lane & 31, hi = lane >> 5, dh = (lane >> 4) & 1, dvb = wid & 3, tb = wid >> 2;
    const float* BM = (const float*)(C.ws + WS_ZF); const float* BE = BM + 262144;
    const bf16* Qh = (const bf16*)(C.ws + WS_QH); const bf16* Kh = (const bf16*)(C.ws + WS_KK); const bf16* Vh = (const bf16*)(C.ws + WS_VH); const bf16* Gh = (const bf16*)(C.ws + WS_GH);
    bf16* Ocat = (bf16*)(C.ws + WS_XB);
    const size_t rb = (size_t)b * SEQ;
    LAS float* NGS = (LAS float*)(L + 2 * HG_BUF);
    if (tid < 128) NGS[tid] = a.in[I_HGNG][h * 128 + tid];
    const int orow = tid >> 3, oseg = tid & 7;
    f32x16 T[4];
#pragma unroll
    for (int i = 0; i < 4; ++i)
#pragma unroll
        for (int r = 0; r < 16; ++r) T[i][r] = 0.f;
    u32x4 gr[2];
    const int drow = 8 * wid + (lane >> 4), dch = lane & 15;
#define HG_DMA(c) do { _Pragma("unroll") for (int p = 0; p < 2; ++p) { const int r_ = drow + 4 * p; const int sc_ = dch ^ (((r_ & 3) << 2) | ((r_ >> 2) & 3)); \
            const size_t g_ = (rb + (size_t)(c) * 64 + r_) * 512 + h * 128 + 8 * sc_; LAS unsigned char* d_ = L + ((c) & 1) * HG_BUF + (8 * wid + 4 * p) * 256; \
            __builtin_amdgcn_global_load_lds((const unsigned*)(Qh + g_), (LAS unsigned*)(d_ + HG_QP), 16, 0, 0); \
            __builtin_amdgcn_global_load_lds((const unsigned*)(Kh + g_), (LAS unsigned*)(d_ + HG_KP), 16, 0, 0); \
            __builtin_amdgcn_global_load_lds((const unsigned*)(Vh + g_), (LAS unsigned*)(d_ + HG_V), 16, 0, 0); } } while (0)
    float sm = 0.f, spe = 0.f, spm = 0.f;
#define HG_SCLOAD(c) do { if (tid < 128) { const size_t s_ = (size_t)(b * 32 + (c)) * 512 + h * 128 + tid; sm = BM[s_]; if ((c) > 0) { spe = BE[s_ - 512]; spm = BM[s_ - 512]; } } } while (0)
#define HG_SCALE(c) do { if (tid < 128) ((LAS float*)(L + ((c) & 1) * HG_BUF + HG_SC))[tid] = __expf(sm + (spe - spm)); } while (0)
    HG_DMA(0);
    HG_SCLOAD(0);
    HG_SCALE(0);
    asm volatile("s_waitcnt vmcnt(0)" ::: "memory");
    __syncthreads();
    for (int c = 0; c < 32; ++c) {
        const LAS unsigned char* B = L + (c & 1) * HG_BUF;
        if (c + 1 < 32) { HG_DMA(c + 1); HG_SCLOAD(c + 1); }
        int q32o = q32, hio = hi, laneo = lane; asm volatile("" : "+v"(q32o), "+v"(hio), "+v"(laneo));
        f32x16 oT;
#pragma unroll
        for (int r = 0; r < 16; ++r) oT[r] = 0.f;
        bf16x8 qb[8];
#pragma unroll
        for (int ks = 0; ks < 8; ++ks) qb[ks] = *(const LAS bf16x8*)(B + HG_QP + hswz(32 * tb + q32o, 2 * ks + hio));
#pragma unroll
        for (int sb = 0; sb < 2; ++sb) {
            if (sb <= tb) {
                bf16x8 ka[8];
#pragma unroll
                for (int ks = 0; ks < 8; ++ks) ka[ks] = *(const LAS bf16x8*)(B + HG_KP + hswz(32 * sb + q32o, 2 * ks + hio));
                s16x4 vl[2], vh[2];
#pragma unroll
                for (int s2 = 0; s2 < 2; ++s2) { const int r0 = 32 * sb + 16 * s2 + 4 * hio; vl[s2] = vtr((LAS const char*)(B + HG_V + htr(r0, 4 * dvb + 2 * dh, laneo))); vh[s2] = vtr((LAS const char*)(B + HG_V + htr(r0 + 8, 4 * dvb + 2 * dh, laneo))); }
                __builtin_amdgcn_sched_barrier(0);
                f32x16 pT;
#pragma unroll
                for (int r = 0; r < 16; ++r) pT[r] = 0.f;
#pragma unroll
                for (int ks = 0; ks < 8; ++ks) pT = MFMA32(ka[ks], qb[ks], pT);
                if (sb == tb) {
#pragma unroll
                    for (int r = 0; r < 16; ++r) if (crow(r, hi) > q32) pT[r] = 0.f;
                }
#pragma unroll
                for (int s2 = 0; s2 < 2; ++s2) { u32x4 pw; pw.x = cvtpk(pT[8 * s2 + 0], pT[8 * s2 + 1]); pw.y = cvtpk(pT[8 * s2 + 2], pT[8 * s2 + 3]); pw.z = cvtpk(pT[8 * s2 + 4], pT[8 * s2 + 5]); pw.w = cvtpk(pT[8 * s2 + 6], pT[8 * s2 + 7]);
                    oT = MFMA32(((bf16x8){vl[s2][0], vl[s2][1], vl[s2][2], vl[s2][3], vh[s2][0], vh[s2][1], vh[s2][2], vh[s2][3]}), __builtin_bit_cast(bf16x8, pw), oT); }
                __builtin_amdgcn_sched_barrier(0);
            }
        }
        { const size_t g0 = (rb + (size_t)c * 64 + orow) * 512 + h * 128 + 16 * oseg; gr[0] = *(const u32x4*)(Gh + g0); gr[1] = *(const u32x4*)(Gh + g0 + 8); }
        {
            u32x2 qq0[8], qq1[8];
            if (c > 0) {
#pragma unroll
                for (int i = 0; i < 4; ++i)
#pragma unroll
                    for (int s = 0; s < 2; ++s) { qq0[2 * i + s] = *(const LAS u32x2*)(B + HG_QP + hswz(32 * tb + q32o, 4 * i + 2 * s) + 8 * hio); qq1[2 * i + s] = *(const LAS u32x2*)(B + HG_QP + hswz(32 * tb + q32o, 4 * i + 2 * s + 1) + 8 * hio); }
            }
#pragma unroll
            for (int i = 0; i < 4; ++i)
#pragma unroll
                for (int g = 0; g < 4; ++g) { const f32x4 sc = *(const LAS f32x4*)(B + HG_SC + (32 * i + 8 * g + 4 * hio) * 4);
#pragma unroll
                    for (int j = 0; j < 4; ++j) T[i][4 * g + j] *= sc[j]; }
            __builtin_amdgcn_sched_barrier(0);
            if (c > 0) {
#pragma unroll
                for (int i = 0; i < 4; ++i)
#pragma unroll
                    for (int s = 0; s < 2; ++s) { u32x4 tw; tw.x = cvtpk(T[i][8 * s + 0], T[i][8 * s + 1]); tw.y = cvtpk(T[i][8 * s + 2], T[i][8 * s + 3]); tw.z = cvtpk(T[i][8 * s + 4], T[i][8 * s + 5]); tw.w = cvtpk(T[i][8 * s + 6], T[i][8 * s + 7]);
                        const u32x4 qw = (u32x4){qq0[2 * i + s].x, qq0[2 * i + s].y, qq1[2 * i + s].x, qq1[2 * i + s].y};
                        oT = MFMA32(__builtin_bit_cast(bf16x8, tw), __builtin_bit_cast(bf16x8, qw), oT); }
            }
        }
        { LAS unsigned char* OBp = L + (c & 1) * HG_BUF + HG_OB;
#pragma unroll
          for (int g = 0; g < 4; ++g) { u32x2 w; w.x = cvtpk(oT[4 * g], oT[4 * g + 1]); w.y = cvtpk(oT[4 * g + 2], oT[4 * g + 3]); *(LAS u32x2*)(OBp + (32 * tb + q32o) * 272 + (32 * dvb + 8 * g + 4 * hio) * 2) = w; } }
#pragma unroll
        for (int sp = 0; sp < 2; ++sp) {
            s16x4 vl[2], vh[2], kl[2][4], kh[2][4];
#pragma unroll
            for (int u = 0; u < 2; ++u) { const int r0 = 16 * (2 * sp + u) + 8 * hio;
                vl[u] = vtr((LAS const char*)(B + HG_V + htr(r0, 4 * dvb + 2 * dh, laneo))); vh[u] = vtr((LAS const char*)(B + HG_V + htr(r0 + 4, 4 * dvb + 2 * dh, laneo)));
#pragma unroll
                for (int i = 0; i < 4; ++i) { kl[u][i] = vtr((LAS const char*)(B + HG_KP + htr(r0, 4 * i + 2 * dh, laneo))); kh[u][i] = vtr((LAS const char*)(B + HG_KP + htr(r0 + 4, 4 * i + 2 * dh, laneo))); } }
            __builtin_amdgcn_sched_barrier(0);
#pragma unroll
            for (int u = 0; u < 2; ++u) { const bf16x8 vb = (bf16x8){vl[u][0], vl[u][1], vl[u][2], vl[u][3], vh[u][0], vh[u][1], vh[u][2], vh[u][3]};
#pragma unroll
                for (int i = 0; i < 4; ++i) T[i] = MFMA32(((bf16x8){kl[u][i][0], kl[u][i][1], kl[u][i][2], kl[u][i][3], kh[u][i][0], kh[u][i][1], kh[u][i][2], kh[u][i][3]}), vb, T[i]); }
            __builtin_amdgcn_sched_barrier(0);
        }
        if (c + 1 < 32) HG_SCALE(c + 1);
        asm volatile("s_waitcnt vmcnt(0)" ::: "memory");
        __syncthreads();
        { const LAS unsigned char* OBp = L + (c & 1) * HG_BUF + HG_OB + orow * 272 + oseg * 32;
          const u32x4 o0 = *(const LAS u32x4*)OBp, o1 = *(const LAS u32x4*)(OBp + 16);
          float ov[16];
          ov[0] = bflo(o0.x); ov[1] = bfhi(o0.x); ov[2] = bflo(o0.y); ov[3] = bfhi(o0.y); ov[4] = bflo(o0.z); ov[5] = bfhi(o0.z); ov[6] = bflo(o0.w); ov[7] = bfhi(o0.w);
          ov[8] = bflo(o1.x); ov[9] = bfhi(o1.x); ov[10] = bflo(o1.y); ov[11] = bfhi(o1.y); ov[12] = bflo(o1.z); ov[13] = bfhi(o1.z); ov[14] = bflo(o1.w); ov[15] = bfhi(o1.w);
          float ss = 0.f;
#pragma unroll
          for (int j = 0; j < 16; ++j) ss += ov[j] * ov[j];
          ss += __int_as_float(__builtin_amdgcn_update_dpp(0, __float_as_int(ss), 0xB1, 0xf, 0xf, true));
          ss += __int_as_float(__builtin_amdgcn_update_dpp(0, __float_as_int(ss), 0x4E, 0xf, 0xf, true));
          ss += __int_as_float(__builtin_amdgcn_update_dpp(0, __float_as_int(ss), 0x141, 0xf, 0xf, true));
          const float rs = __builtin_amdgcn_rsqf(ss * (1.f / 128.f) + LN_EPS);
          float ng[16];
#pragma unroll
          for (int i = 0; i < 4; ++i) { const f32x4 n_ = *(const LAS f32x4*)(NGS + 16 * oseg + 4 * i); ng[4 * i] = n_[0]; ng[4 * i + 1] = n_[1]; ng[4 * i + 2] = n_[2]; ng[4 * i + 3] = n_[3]; }
          float gvv[16];
          gvv[0] = bflo(gr[0].x); gvv[1] = bfhi(gr[0].x); gvv[2] = bflo(gr[0].y); gvv[3] = bfhi(gr[0].y); gvv[4] = bflo(gr[0].z); gvv[5] = bfhi(gr[0].z); gvv[6] = bflo(gr[0].w); gvv[7] = bfhi(gr[0].w);
          gvv[8] = bflo(gr[1].x); gvv[9] = bfhi(gr[1].x); gvv[10] = bflo(gr[1].y); gvv[11] = bfhi(gr[1].y); gvv[12] = bflo(gr[1].z); gvv[13] = bfhi(gr[1].z); gvv[14] = bflo(gr[1].w); gvv[15] = bfhi(gr[1].w);
          float rv[16];
#pragma unroll
          for (int j = 0; j < 16; ++j) rv[j] = ov[j] * (rs * FP8_SO) * ng[j] * gvv[j];
          u32x4 w0; w0.x = cvt4_fp8(rv[0], rv[1], rv[2], rv[3]); w0.y = cvt4_fp8(rv[4], rv[5], rv[6], rv[7]); w0.z = cvt4_fp8(rv[8], rv[9], rv[10], rv[11]); w0.w = cvt4_fp8(rv[12], rv[13], rv[14], rv[15]);
          unsigned char* op = (unsigned char*)Ocat + (rb + (size_t)c * 64 + orow) * 1024 + h * 128 + 16 * oseg;
          *(u32x4*)op = w0; }
    }
    __syncthreads();
#undef HG_DMA
#undef HG_SCALE
#undef HG_SCLOAD
}

constexpr int AT_NST = 4, AT_K = 0, AT_V = AT_NST * 8192, AT_KM = 2 * AT_NST * 8192, AT_TAB = AT_KM + 1792;
DI int t5_bucket(int d) { if (d < 16) return d; const int v = 16 + (int)(logf((float)d * (1.f / 16.f)) / logf(8.f) * 16.f); return v < 31 ? v : 31; }
DI void glds16(const void* gsrc, unsigned lds_dst) { unsigned keep;
    asm volatile("s_mov_b32 %0, m0\n\ts_mov_b32 m0, %2\n\ts_nop 0\n\tglobal_load_lds_dwordx4 %1, off\n\ts_mov_b32 m0, %0" : "=&s"(keep) : "v"(gsrc), "s"(lds_dst) : "memory"); }
DI void attn_unit(const Ctx& C, const Args& a, int b, int h, int jq) {
    LAS unsigned char* L = C.lds;
    const int tid = C.tid, lane = C.lane, wid = C.wid, q32 = lane & 31, hi = lane >> 5;
    const bf16* Qm = (const bf16*)(C.ws + WS_QM); const bf16* Km = (const bf16*)(C.ws + WS_KM); const bf16* Vm = (const bf16*)(C.ws + WS_VM); const float* KM = (const float*)(C.ws + WS_KMEAN);
    bf16* Ocat = (bf16*)(C.ws + WS_XB);
    const int tq = jq * 256 + wid * 32 + q32;
    const size_t hb = (size_t)(b * 8 + h) * SEQ;
    bf16x8 qf[4];
#pragma unroll
    for (int ks = 0; ks < 4; ++ks) qf[ks] = *(const bf16x8*)(Qm + (hb + tq) * 64 + 16 * ks + 8 * hi);
    LAS float* kml = (LAS float*)(L + AT_KM); LAS float* tab = (LAS float*)(L + AT_TAB);
    if (tid < jq * 64) { const int n = tid >> 6, d = tid & 63; kml[tid] = KM[(size_t)((b * 8 + n) * 2 + 0) * 512 + h * 64 + d] + KM[(size_t)((b * 8 + n) * 2 + 1) * 512 + h * 64 + d]; }
    if (tid < 129) tab[tid] = (a.in[I_RELB][t5_bucket(tid) * 8 + h] - a.in[I_RELB][31 * 8 + h]) * LOG2E;
    const int drow = 8 * wid + (lane >> 3), dch = lane & 7;
    const bf16* ksrc = Km + (hb + drow) * 64 + 8 * (dch ^ ((drow >> 1) & 7));
    const bf16* vsrc = Vm + (hb + drow) * 64 + 8 * (dch ^ (((drow >> 1) & 1) << 2));
    const unsigned kdst = (unsigned)__builtin_amdgcn_readfirstlane((int)(unsigned)(size_t)(L + AT_K + wid * 1024)), vdst = (unsigned)__builtin_amdgcn_readfirstlane((int)(unsigned)(size_t)(L + AT_V + wid * 1024));
    const int nt = 4 * jq + 4;
#define AT_ISSUE(t) do { glds16(ksrc + (size_t)(t) * 4096, kdst + ((t) & 3) * 8192); glds16(vsrc + (size_t)(t) * 4096, vdst + ((t) & 3) * 8192); } while (0)
    AT_ISSUE(0); AT_ISSUE(1); AT_ISSUE(2);
    __syncthreads();
    unsigned sel = 0;
    {
        float g[7];
#pragma unroll
        for (int n = 0; n < 7; ++n) { g[n] = 0.f;
            if (n < jq) { float s = 0.f;
#pragma unroll
                for (int ks = 0; ks < 4; ++ks)
#pragma unroll
                    for (int j = 0; j < 8; ++j) s += bf2f((unsigned short)qf[ks][j]) * kml[n * 64 + 16 * ks + 8 * hi + j];
                s += __shfl_xor(s, 32); g[n] = s; } }
#pragma unroll
        for (int n = 0; n < 7; ++n) if (n < jq) { int rank = 0;
#pragma unroll
            for (int m = 0; m < 7; ++m) if (m != n && m < jq) rank += (g[m] > g[n] || (g[m] == g[n] && m < n)) ? 1 : 0;
            if (rank < 3) sel |= 1u << n; }
    }
    const float c31 = a.in[I_RELB][31 * 8 + h] * LOG2E;
    float lrun = 0.f;
    f32x16 negm;
#pragma unroll
    for (int r = 0; r < 16; ++r) negm[r] = c31;
    f32x16 o0, o1;
#pragma unroll
    for (int r = 0; r < 16; ++r) { o0[r] = 0.f; o1[r] = 0.f; }
    const int i16 = lane & 15, qq = i16 >> 2, pp = i16 & 3, dh = (lane >> 4) & 1, xsw = (qq >> 1) & 1;
    const int vb0 = (4 * hi + qq) * 128 + 64 * (0 ^ xsw) + 32 * dh + 8 * pp, vb1 = (4 * hi + qq) * 128 + 64 * (1 ^ xsw) + 32 * dh + 8 * pp;
    const int kxs = (q32 >> 1) & 7;
    for (int kt = 0; kt < nt; ++kt) {
        if (kt + 2 < nt) asm volatile("s_waitcnt vmcnt(4)" ::: "memory"); else if (kt + 1 < nt) asm volatile("s_waitcnt vmcnt(2)" ::: "memory"); else asm volatile("s_waitcnt vmcnt(0)" ::: "memory");
        __builtin_amdgcn_s_barrier();
        asm volatile("" ::: "memory");
        if (kt + 3 < nt) AT_ISSUE(kt + 3);
        const int blk = kt >> 2; const bool own = (blk == jq);
        const bool active = !own || ((kt & 3) * 64 <= wid * 32 + 31);
        if (active) {
            const LAS unsigned char* Kc = L + AT_K + (kt & 3) * 8192; const LAS unsigned char* Vc = L + AT_V + (kt & 3) * 8192;
            bf16x8 kf[8];
#pragma unroll
            for (int ks = 0; ks < 4; ++ks) { const int ko = (((2 * ks + hi) ^ kxs) << 4); kf[2 * ks] = *(const LAS bf16x8*)(Kc + q32 * 128 + ko); kf[2 * ks + 1] = *(const LAS bf16x8*)(Kc + (32 + q32) * 128 + ko); }
            __builtin_amdgcn_sched_barrier(0);
            f32x16 s0 = negm, s1 = negm;
#pragma unroll
            for (int ks = 0; ks < 4; ++ks) { s0 = MFMA32(kf[2 * ks], qf[ks], s0); s1 = MFMA32(kf[2 * ks + 1], qf[ks], s1); }
            __builtin_amdgcn_sched_barrier(0);
            s16x4 vf[2][4][2];
#pragma unroll
            for (int j = 0; j < 4; ++j) { const int ro = 16 * j * 128;
                vf[0][j][0] = vtr((LAS const char*)(Vc + vb0 + ro)); vf[0][j][1] = vtr((LAS const char*)(Vc + vb0 + ro + 8 * 128));
                vf[1][j][0] = vtr((LAS const char*)(Vc + vb1 + ro)); vf[1][j][1] = vtr((LAS const char*)(Vc + vb1 + ro + 8 * 128)); }
            __builtin_amdgcn_sched_barrier(0);
            const bool near = (jq * 256 + wid * 32 - 64 * kt - 63) < 128;
            if (near) {
                const int dist0 = tq - 64 * kt - 4 * hi;
#pragma unroll
                for (int r = 0; r < 16; ++r) { const int d0 = dist0 - ((r & 3) + 8 * (r >> 2)), d1 = d0 - 32;
                    const int i0 = d0 < 0 ? 0 : (d0 > 128 ? 128 : d0), i1 = d1 < 0 ? 0 : (d1 > 128 ? 128 : d1);
                    const float t0 = tab[i0], t1 = tab[i1]; s0[r] += t0; s1[r] += t1; s0[r] = d0 < 0 ? -INFINITY : s0[r]; s1[r] = d1 < 0 ? -INFINITY : s1[r]; }
            }
            const bool lsel = own || ((sel >> blk) & 1u);
            float mx = fmaxf(fmaxf(s0[0], s1[0]), fmaxf(s0[1], s1[1]));
#pragma unroll
            for (int r = 2; r < 16; r += 2) mx = fmaxf(mx, fmaxf(fmaxf(s0[r], s1[r]), fmaxf(s0[r + 1], s1[r + 1])));
            mx = lsel ? mx : -INFINITY;
            mx = fmaxf(mx, __shfl_xor(mx, 32));
            if (__any(mx > 4.0f)) {
                const float delta = fmaxf(mx, 0.f), alpha = __builtin_amdgcn_exp2f(-delta);
                lrun *= alpha;
#pragma unroll
                for (int r = 0; r < 16; ++r) { o0[r] *= alpha; o1[r] *= alpha; negm[r] -= delta; s0[r] -= delta; s1[r] -= delta; }
            }
            float ps = 0.f;
#pragma unroll
            for (int r = 0; r < 16; ++r) { s0[r] = __builtin_amdgcn_exp2f(s0[r]); s1[r] = __builtin_amdgcn_exp2f(s1[r]); ps += s0[r] + s1[r]; }
            lrun += lsel ? ps : 0.f;
            const unsigned pmask = lsel ? 0xffffffffu : 0u;
#pragma unroll
            for (int kb = 0; kb < 2; ++kb)
#pragma unroll
                for (int s2 = 0; s2 < 2; ++s2) {
                    u32x4 pw;
                    if (kb == 0) { pw.x = cvtpk(s0[8 * s2 + 0], s0[8 * s2 + 1]); pw.y = cvtpk(s0[8 * s2 + 2], s0[8 * s2 + 3]); pw.z = cvtpk(s0[8 * s2 + 4], s0[8 * s2 + 5]); pw.w = cvtpk(s0[8 * s2 + 6], s0[8 * s2 + 7]); }
                    else         { pw.x = cvtpk(s1[8 * s2 + 0], s1[8 * s2 + 1]); pw.y = cvtpk(s1[8 * s2 + 2], s1[8 * s2 + 3]); pw.z = cvtpk(s1[8 * s2 + 4], s1[8 * s2 + 5]); pw.w = cvtpk(s1[8 * s2 + 6], s1[8 * s2 + 7]); }
                    pw.x &= pmask; pw.y &= pmask; pw.z &= pmask; pw.w &= pmask;
                    const bf16x8 pf = __builtin_bit_cast(bf16x8, pw);
                    const s16x4 a0l = vf[0][2 * kb + s2][0], a0h = vf[0][2 * kb + s2][1], a1l = vf[1][2 * kb + s2][0], a1h = vf[1][2 * kb + s2][1];
                    o0 = MFMA32(((bf16x8){a0l[0], a0l[1], a0l[2], a0l[3], a0h[0], a0h[1], a0h[2], a0h[3]}), pf, o0);
                    o1 = MFMA32(((bf16x8){a1l[0], a1l[1], a1l[2], a1l[3], a1h[0], a1h[1], a1h[2], a1h[3]}), pf, o1);
                }
        }
    }
    const float linv = 1.f / (lrun + __shfl_xor(lrun, 32));
    unsigned char* op = (unsigned char*)Ocat + ((size_t)b * SEQ + tq) * 1024 + 512 + h * 64;
    const float lsc = linv * FP8_SO;
#pragma unroll
    for (int g = 0; g < 4; ++g) { *(unsigned*)(op + 8 * g + 4 * hi) = cvt4_fp8(o0[4 * g] * lsc, o0[4 * g + 1] * lsc, o0[4 * g + 2] * lsc, o0[4 * g + 3] * lsc);
        *(unsigned*)(op + 32 + 8 * g + 4 * hi) = cvt4_fp8(o1[4 * g] * lsc, o1[4 * g + 1] * lsc, o1[4 * g + 2] * lsc, o1[4 * g + 3] * lsc); }
    __syncthreads();
#undef AT_ISSUE
}

#ifndef PROBE_HGX
#define PROBE_HGX 1
#endif
#ifndef PROBE_ATX
#define PROBE_ATX 1
#endif
#ifndef STAMP_SEL
#define STAMP_SEL -1
#endif
#define STAMP(i) do { if (STAMP_SEL >= 0 && blockIdx.x == 0 && C.tid == 0) { const unsigned long long t_ = __builtin_amdgcn_s_memrealtime(); C.MISC[16 + 2 * (i)] = (unsigned)t_; C.MISC[17 + 2 * (i)] = (unsigned)(t_ >> 32); } } while (0)
DI void p2_mixers(const Ctx& C, const Args& a, int rep) {
    for (int hx = 0; hx < PROBE_HGX; ++hx)
    for (int u = blockIdx.x; u < 64; u += C.G) hgrn_unit(C, a, u >> 2, u & 3);
    STAMP(11);
    unsigned* QA = (unsigned*)(C.ctl + CW_QUEUE + 64 * rep); unsigned* QC = (unsigned*)(C.ctl + CW_QUEUE2 + 64 * rep);
    constexpr int NA = 1024 * PROBE_ATX, NC = MOE_CVT_TILES;
    if (C.tid == 0) { C.MISC[0] = __hip_atomic_fetch_add(QA, 1u, __ATOMIC_RELAXED, __HIP_MEMORY_SCOPE_AGENT); C.MISC[1] = (rep == 0) ? __hip_atomic_fetch_add(QC, 1u, __ATOMIC_RELAXED, __HIP_MEMORY_SCOPE_AGENT) : (unsigned)NC; }
    __syncthreads();
    int qa = (int)C.MISC[0], qc = (int)C.MISC[1];
    __syncthreads();
    for (;;) {
        const bool doa = qa < NA, doc = qc < NC;
        if (!doa && !doc) break;
        unsigned na = (unsigned)NA, nc = (unsigned)NC;
        if (C.tid == 0) { if (doa) na = __hip_atomic_fetch_add(QA, 1u, __ATOMIC_RELAXED, __HIP_MEMORY_SCOPE_AGENT); if (doc) nc = __hip_atomic_fetch_add(QC, 1u, __ATOMIC_RELAXED, __HIP_MEMORY_SCOPE_AGENT); }
#ifdef STAMP_ACC
        unsigned long long ta_ = 0, tb_ = 0, tc_ = 0; if (C.tid == 0) ta_ = __builtin_amdgcn_s_memrealtime();
#endif
        if (doa) { const int q = qa / PROBE_ATX; attn_unit(C, a, (q & 127) >> 3, q & 7, 7 - (q >> 7)); }
#ifdef STAMP_ACC
        if (C.tid == 0) tb_ = __builtin_amdgcn_s_memrealtime();
#endif
        if (doc) moe_cvt_tile(C, a, qc);
#ifdef STAMP_ACC
        if (C.tid == 0 && blockIdx.x == 100) { tc_ = __builtin_amdgcn_s_memrealtime(); const unsigned long long d_ = (STAMP_ACC == 0) ? (tb_ - ta_) : (tc_ - tb_);
            const unsigned long long o_ = ((unsigned long long)C.MISC[45] << 32) | C.MISC[44]; const unsigned long long n_ = o_ + d_; C.MISC[44] = (unsigned)n_; C.MISC[45] = (unsigned)(n_ >> 32); }
#endif
        if (C.tid == 0) { C.MISC[0] = na; C.MISC[1] = nc; }
        __syncthreads();
        qa = (int)C.MISC[0]; qc = (int)C.MISC[1];
        __syncthreads();
    }
    STAMP(12);
#ifdef STAMP_ACC
    if (C.tid == 0 && blockIdx.x == 100) { const unsigned long long n_ = ((unsigned long long)C.MISC[45] << 32) | C.MISC[44]; const unsigned long long w0 = __builtin_amdgcn_s_memrealtime(); while (__builtin_amdgcn_s_memrealtime() - w0 < 4ull * n_) __builtin_amdgcn_s_sleep(8); }
#endif
}

DI void r1_phase(const Ctx& C, const Args& a) {
    LAS unsigned char* L = C.lds;
    const int tid = C.tid, lane = C.lane, wid = C.wid;
    LAS float* LG = (LAS float*)L + wid * 16 * 48;
    LAS int* CNT = (LAS int*)(L + 32768);
    LAS float* G1 = (LAS float*)(L + 33024); LAS float* B1 = (LAS float*)(L + 37120);
    const float* Pre = (const float*)(C.ws + WS_ZF); unsigned char* X1q = (unsigned char*)(C.ws + WS_XB); f32x2* stats = (f32x2*)(C.ws + WS_STATS);
    const bf16* WrH = (const bf16*)(C.ws + WS_WRH); const bf16* WrL = (const bf16*)(C.ws + WS_WRL);
    unsigned* tokE = (unsigned*)(C.ws + WS_TOKE); float* tokW = (float*)(C.ws + WS_TOKW); int* wgcnt = (int*)(C.ws + WS_WGCNT);
    for (int i = tid; i < 1024; i += NTHREADS) { G1[i] = a.in[I_LN1G][i]; B1[i] = a.in[I_LN1B][i]; }
    LAS unsigned char* WL = L + 45056;
    for (int i = tid; i < 48 * 128; i += NTHREADS) { const int r = i >> 7, c = i & 127; *(LAS u32x4*)(WL + r * 2064 + c * 16) = *(const u32x4*)(WrH + (size_t)r * 1024 + c * 8); }
    LAS float* RB = (LAS float*)(L + 41216);
    if (tid < 4) RB[tid] = a.in[I_BGRP][tid]; else if (tid < 36) RB[tid] = a.in[I_BEXP][tid - 4];
    const int m16 = lane & 15, kq = lane >> 4;
    for (int chunk = blockIdx.x; chunk < NTOK / 128; chunk += C.G) {
        if (tid < 32) CNT[tid] = 0;
        __syncthreads();
        const int tok0 = chunk * 128 + wid * 16;
        const float* xrow = Pre + (size_t)(tok0 + m16) * 1024 + 8 * kq;
        float s = 0.f, s2 = 0.f;
#pragma unroll 8
        for (int k0 = 0; k0 < 1024; k0 += 32) { const f32x4 xa = *(const f32x4*)(xrow + k0), xc = *(const f32x4*)(xrow + k0 + 4);
            s += (xa[0] + xa[1]) + (xa[2] + xa[3]) + (xc[0] + xc[1]) + (xc[2] + xc[3]);
            s2 += (xa[0] * xa[0] + xa[1] * xa[1]) + (xa[2] * xa[2] + xa[3] * xa[3]) + (xc[0] * xc[0] + xc[1] * xc[1]) + (xc[2] * xc[2] + xc[3] * xc[3]); }
        s += __shfl_xor(s, 16); s += __shfl_xor(s, 32); s2 += __shfl_xor(s2, 16); s2 += __shfl_xor(s2, 32);
        const float mean = s * (1.f / 1024.f); const float var = fmaxf(s2 * (1.f / 1024.f) - mean * mean, 0.f); const float rstd = 1.f / sqrtf(var + LN_EPS);
        if (kq == 0) stats[tok0 + m16] = (f32x2){mean, rstd};
        STAMP(13);
        f32x4 acc[3];
#pragma unroll
        for (int nb = 0; nb < 3; ++nb) acc[nb] = (f32x4){0.f, 0.f, 0.f, 0.f};
        unsigned char* xb = X1q + (size_t)(tok0 + m16) * 1024 + 8 * kq;
        const LAS unsigned char* wlp = WL + m16 * 2064 + 16 * kq;
#pragma unroll 1
        for (int kb = 0; kb < 4; ++kb) {
            f32x4 xa[8], xc[8];
#pragma unroll
            for (int j = 0; j < 8; ++j) { xa[j] = *(const f32x4*)(xrow + kb * 256 + 32 * j); xc[j] = *(const f32x4*)(xrow + kb * 256 + 32 * j + 4); }
#pragma unroll
            for (int j = 0; j < 8; ++j) { const int k0 = kb * 256 + 32 * j;
                bf16x8 wh[3];
#pragma unroll
                for (int nb = 0; nb < 3; ++nb) wh[nb] = *(const LAS bf16x8*)(wlp + nb * 16 * 2064 + k0 * 2);
                const f32x4 ya = (xa[j] - mean) * rstd * *(const LAS f32x4*)(G1 + k0 + 8 * kq) + *(const LAS f32x4*)(B1 + k0 + 8 * kq);
                const f32x4 yc = (xc[j] - mean) * rstd * *(const LAS f32x4*)(G1 + k0 + 8 * kq + 4) + *(const LAS f32x4*)(B1 + k0 + 8 * kq + 4);
                u32x4 hw; hw.x = cvtpk(ya[0], ya[1]); hw.y = cvtpk(ya[2], ya[3]); hw.z = cvtpk(yc[0], yc[1]); hw.w = cvtpk(yc[2], yc[3]);
                { u32x2 qw; qw.x = cvt4_fp8(ya[0] * FP8_SX, ya[1] * FP8_SX, ya[2] * FP8_SX, ya[3] * FP8_SX); qw.y = cvt4_fp8(yc[0] * FP8_SX, yc[1] * FP8_SX, yc[2] * FP8_SX, yc[3] * FP8_SX); *(u32x2*)(xb + k0) = qw; }
                u32x4 lw; lw.x = cvtpk(ya[0] - bflo(hw.x), ya[1] - bfhi(hw.x)); lw.y = cvtpk(ya[2] - bflo(hw.y), ya[3] - bfhi(hw.y)); lw.z = cvtpk(yc[0] - bflo(hw.z), yc[1] - bfhi(hw.z)); lw.w = cvtpk(yc[2] - bflo(hw.w), yc[3] - bfhi(hw.w));
                const bf16x8 xh = __builtin_bit_cast(bf16x8, hw), xl = __builtin_bit_cast(bf16x8, lw);
#pragma unroll
                for (int nb = 0; nb < 3; ++nb) { acc[nb] = MFMA16(wh[nb], xh, acc[nb]); acc[nb] = MFMA16(wh[nb], xl, acc[nb]); }
            }
        }
        STAMP(14);
#pragma unroll
        for (int nb = 0; nb < 3; ++nb)
#pragma unroll
            for (int r = 0; r < 4; ++r) LG[m16 * 48 + nb * 16 + 4 * kq + r] = acc[nb][r];
        asm volatile("s_waitcnt lgkmcnt(0)" ::: "memory");
        if (lane < 16) {
            const LAS float* lg = LG + lane * 48;
            float gl[4];
#pragma unroll
            for (int j = 0; j < 4; ++j) gl[j] = lg[j] + RB[j];
            int grp = 0; float gm = gl[0];
#pragma unroll
            for (int j = 1; j < 4; ++j) if (gl[j] > gm) { gm = gl[j]; grp = j; }
            float se = 0.f;
#pragma unroll
            for (int j = 0; j < 4; ++j) se += __expf(gl[j] - gm);
            const float pg = 1.f / se;
            float el[8];
#pragma unroll
            for (int j = 0; j < 8; ++j) el[j] = lg[4 + grp * 8 + j] + RB[4 + grp * 8 + j];
            int i0 = 0; float v0 = el[0];
#pragma unroll
            for (int j = 1; j < 8; ++j) if (el[j] > v0) { v0 = el[j]; i0 = j; }
            int i1 = -1; float v1 = -INFINITY;
#pragma unroll
            for (int j = 0; j < 8; ++j) if (j != i0 && el[j] > v1) { v1 = el[j]; i1 = j; }
            const float w0 = 1.f / (1.f + __expf(v1 - v0)), w1 = 1.f - w0;
            const int e0 = grp * 8 + i0, e1 = grp * 8 + i1;
            const int r0 = __hip_atomic_fetch_add(CNT + e0, 1, __ATOMIC_RELAXED, __HIP_MEMORY_SCOPE_WORKGROUP), r1 = __hip_atomic_fetch_add(CNT + e1, 1, __ATOMIC_RELAXED, __HIP_MEMORY_SCOPE_WORKGROUP);
            const int tok = tok0 + lane;
            tokE[tok] = (unsigned)e0 | ((unsigned)e1 << 8) | ((unsigned)r0 << 16) | ((unsigned)r1 << 24);
            tokW[tok * 2] = w0 * pg; tokW[tok * 2 + 1] = w1 * pg;
        }
        __syncthreads();
        if (tid < 32) wgcnt[chunk * 32 + tid] = CNT[tid];
        __syncthreads();
    }
}

DI void r2_phase(const Ctx& C, const Args& a) {
    LAS int* PA = (LAS int*)C.lds;
    LAS int* PB = PA + 512;
    LAS int* TOT = PB + 512; LAS int* BASE = TOT + 32; LAS int* PST = BASE + 32;
    const int tid = C.tid;
    const int* wgcnt = (const int*)(C.ws + WS_WGCNT); const unsigned* tokE = (const unsigned*)(C.ws + WS_TOKE);
    int* tokD = (int*)(C.ws + WS_TOKD); int* rowtok = (int*)(C.ws + WS_ROWTOK); int* tilee = (int*)(C.ws + WS_TILEE);
    for (int chunk = blockIdx.x; chunk < NTOK / 128; chunk += C.G) {
        { const int e = tid & 31, part = tid >> 5; int sa = 0, sb = 0;
          for (int c = part * 16; c < part * 16 + 16; ++c) { const int v = wgcnt[c * 32 + e]; sa += v; sb += (c < chunk) ? v : 0; }
          PA[part * 32 + e] = sa; PB[part * 32 + e] = sb; }
        __syncthreads();
        if (tid < 32) { int sa = 0, sb = 0; for (int p = 0; p < 16; ++p) { sa += PA[p * 32 + tid]; sb += PB[p * 32 + tid]; } TOT[tid] = sa; BASE[tid] = sb; }
        __syncthreads();
        if (tid == 0) { int ps = 0; for (int e = 0; e < 32; ++e) { PST[e] = ps; ps += ((TOT[e] + 255) >> 8) << 8; } PST[32] = ps; }
        __syncthreads();
        if (tid < 128) { const int tok = chunk * 128 + tid; const unsigned w = tokE[tok]; const int e0 = w & 31, e1 = (w >> 8) & 31, r0 = (w >> 16) & 255, r1 = (w >> 24) & 255;
            const int d0 = PST[e0] + BASE[e0] + r0, d1 = PST[e1] + BASE[e1] + r1; rowtok[d0] = tok; rowtok[d1] = tok; tokD[tok * 2] = d0; tokD[tok * 2 + 1] = d1; }
        if (chunk < 32) { const int e = chunk, end = PST[e + 1] - PST[e]; for (int i = TOT[e] + tid; i < end; i += NTHREADS) rowtok[PST[e] + i] = 0; }
        if (chunk == 0) { if (tid < 32) { for (int t = PST[tid] >> 8; t < (PST[tid + 1] >> 8); ++t) tilee[t] = tid; } if (tid == 0) tilee[511] = PST[32] >> 8; }
        __syncthreads();
    }
}

DI void f_phase(const Ctx& C, const Args& a) {
    const int lane = C.lane, gw = C.vcu * NWAVES + C.wid, NGW = C.G * NWAVES;
    const float* Pre = (const float*)(C.ws + WS_ZF); const unsigned char* Y = (const unsigned char*)(C.ws + WS_Y); const int* tokD = (const int*)(C.ws + WS_TOKD); const float* tokW = (const float*)(C.ws + WS_TOKW);
    const f32x2* stats = (const f32x2*)(C.ws + WS_STATS);
    f32x4 g2[4], b2[4], g1[4], b1[4];
#pragma unroll
    for (int j = 0; j < 4; ++j) { g2[j] = *(const f32x4*)(a.in[I_LN2G] + 256 * j + 4 * lane); b2[j] = *(const f32x4*)(a.in[I_LN2B] + 256 * j + 4 * lane);
        g1[j] = *(const f32x4*)(a.in[I_LN1G] + 256 * j + 4 * lane) * DN_ALPHA; b1[j] = *(const f32x4*)(a.in[I_LN1B] + 256 * j + 4 * lane) * DN_ALPHA; }
    for (int tok = gw; tok < NTOK; tok += NGW) {
        const int d0 = tokD[tok * 2], d1 = tokD[tok * 2 + 1]; const float w0 = tokW[tok * 2] * (1.f / FP8_SY), w1 = tokW[tok * 2 + 1] * (1.f / FP8_SY); const f32x2 st = stats[tok];
        const float* xr = Pre + (size_t)tok * 1024 + 4 * lane; const unsigned char* y0 = Y + (size_t)d0 * 1024 + 4 * lane; const unsigned char* y1 = Y + (size_t)d1 * 1024 + 4 * lane;
        f32x4 v[4]; float s = 0.f;
#pragma unroll
        for (int j = 0; j < 4; ++j) { const f32x4 x = *(const f32x4*)(xr + 256 * j); const unsigned p0 = *(const unsigned*)(y0 + 256 * j), p1 = *(const unsigned*)(y1 + 256 * j);
            v[j] = ((x - st.x) * st.y) * g1[j] + b1[j] + fp8x4_to_f32(p0) * w0 + fp8x4_to_f32(p1) * w1;
            s += (v[j][0] + v[j][1]) + (v[j][2] + v[j][3]); }
        const float mean = wave_sum(s) * (1.f / 1024.f); float s2 = 0.f;
#pragma unroll
        for (int j = 0; j < 4; ++j) { v[j] = v[j] - mean; s2 += (v[j][0] * v[j][0] + v[j][1] * v[j][1]) + (v[j][2] * v[j][2] + v[j][3] * v[j][3]); }
        const float rstd = 1.f / sqrtf(wave_sum(s2) * (1.f / 1024.f) + LN_EPS);
        float* orow = a.out + (size_t)tok * 1024 + 4 * lane;
#pragma unroll
        for (int j = 0; j < 4; ++j) *(f32x4*)(orow + 256 * j) = v[j] * rstd * g2[j] + b2[j];
    }
}

constexpr int NPH = 10;
__global__ void __launch_bounds__(NTHREADS, 2) mk_fwd(Args args) {
    extern __shared__ __attribute__((aligned(16))) unsigned char lds_raw[];
    Ctx C;
    C.lds = (LAS unsigned char*)lds_raw; C.MISC = (volatile LAS unsigned*)(C.lds + MISC_OFF);
    C.tid = threadIdx.x; C.lane = C.tid & 63; C.wid = __builtin_amdgcn_readfirstlane(C.tid >> 6);
    C.G = gridDim.x; { const int bx = blockIdx.x; C.vcu = (C.G % 8 == 0) ? (bx % 8) * (C.G / 8) + bx / 8 : bx; }
    C.ws = args.ws; C.ctl = (gu32*)(args.ws + WS_CTL);
    if (C.tid < 64) C.MISC[C.tid] = 0u;
    __syncthreads();
    XcdBarrier bar; bar.bar = (unsigned*)(C.ctl + CW_BAR); bar.x = 0; bar.st = nullptr;
    if (MK_N_LAUNCHES == 1) bar = xcd_barrier_post((unsigned*)(C.ctl + CW_BAR), C.MISC + 8);
    const int lo = args.ph_lo, hi = args.ph_hi;
#ifndef PH_MASK
#define PH_MASK 0x3ff
#endif
#define IN(k) (((PH_MASK >> (k)) & 1) && lo <= (k) && (k) < hi)
#ifndef STAMP_SEL
#define STAMP_SEL -1
#endif
#ifndef STAMP_T0
#define STAMP_T0 STAMP_SEL
#define STAMP_T1 (STAMP_SEL + 1)
#endif
#define SEAM(k) do { if (IN(k) && IN((k) + 1)) xcd_barrier(bar); STAMP((k) + 1); } while (0)
#ifndef PROBE_PHASE
#define PROBE_PHASE -1
#endif
#define REPS(k) ((PROBE_PHASE == (k)) ? 2 : 1)
#define REPSEAM(k) do { if (rep + 1 < REPS(k)) xcd_barrier(bar); } while (0)
    unsigned char* ws = args.ws;
    LAS unsigned char* ring = C.lds;

    STAMP(0);
    if (IN(0)) { _Pragma("unroll") for (int rep = 0; rep < REPS(0); ++rep) { p0_prologue(C, args); REPSEAM(0); } } SEAM(0);

    if (IN(1)) _Pragma("unroll") for (int rep = 0; rep < REPS(1); ++rep) {
        pg8::EpiIn E{(bf16*)(ws + WS_QH), (bf16*)(ws + WS_VH), (bf16*)(ws + WS_GH), (bf16*)(ws + WS_QM), (bf16*)(ws + WS_KM), (bf16*)(ws + WS_VM), (bf16*)(ws + WS_R), (bf16*)(ws + WS_GB),
                     (float*)(ws + WS_ZF), (float*)(ws + WS_KMEAN), (const float*)(ws + WS_BPERM), (bf16*)(ws + WS_KK), (const float*)(ws + WS_LB), 0};
        { pg8::DenseOrder S; S.init(ws + WS_XB, ws + WS_WIN, NTOK, 2048, 1024, C.G, (int)blockIdx.x);
          pg8::gemm_phase<pg8::EpiIn, pg8::DenseOrder, false>(ring, 1024, S, E); }
        { E.pn_off = 8; pg8::DenseOrder S; S.init((unsigned char*)args.out + 64 * MiB, ws + WS_WIN + 4 * MiB, NTOK, 3584, 512, C.G, (int)blockIdx.x);
          pg8::gemm_phase<pg8::EpiIn, pg8::DenseOrder, false, true>(ring, 512, S, E); }
        REPSEAM(1);
    } SEAM(1);

#ifndef PROBE_P2X
#define PROBE_P2X 1
#endif
    if (IN(2)) { for (int rep = 0; rep < PROBE_P2X; ++rep) { p2_mixers(C, args, rep); if (rep + 1 < PROBE_P2X) xcd_barrier(bar); } } SEAM(2);

    if (IN(3)) _Pragma("unroll") for (int rep = 0; rep < REPS(3); ++rep) {
        pg8::DenseOrder S; S.init(ws + WS_XB, ws + WS_WCAT, NTOK, 1024, 512, C.G, (int)blockIdx.x);
        pg8::EpiProj E{(const bf16*)(ws + WS_R), (const bf16*)(ws + WS_GB), (unsigned char*)(ws + WS_QH)};
        pg8::gemm_phase<pg8::EpiProj, pg8::DenseOrder, false, true>(ring, 512, S, E); REPSEAM(3);
    } SEAM(3);

    if (IN(4)) _Pragma("unroll") for (int rep = 0; rep < REPS(4); ++rep) {
        pg8::DenseOrder S; S.init(ws + WS_QH, ws + WS_WO, NTOK, 1024, 512, C.G, (int)blockIdx.x);
        pg8::EpiOut E{args.in[I_X], (float*)(ws + WS_ZF)};
        pg8::gemm_phase<pg8::EpiOut, pg8::DenseOrder, false, true>(ring, 512, S, E);
        REPSEAM(4);
    } SEAM(4);

    if (IN(5)) { _Pragma("unroll") for (int rep = 0; rep < REPS(5); ++rep) { r1_phase(C, args); REPSEAM(5); } } STAMP(15); SEAM(5);
    if (IN(6)) { _Pragma("unroll") for (int rep = 0; rep < REPS(6); ++rep) { r2_phase(C, args); REPSEAM(6); } } SEAM(6);

    if (IN(7)) _Pragma("unroll") for (int rep = 0; rep < REPS(7); ++rep) {
        const int* tilee = (const int*)(ws + WS_TILEE);
        const int ntl = __builtin_amdgcn_readfirstlane(__hip_atomic_load(tilee + 511, __ATOMIC_RELAXED, __HIP_MEMORY_SCOPE_AGENT));
        pg8::MoeOrder S{(const char*)(ws + WS_XB), (const char*)args.out, (const int*)(ws + WS_ROWTOK), tilee, 512, 1024, ntl * 4, C.G, C.vcu, true};
        pg8::EpiM1 E{(unsigned char*)(ws + WS_QH)};
        pg8::gemm_phase<pg8::EpiM1, pg8::MoeOrder, true, true>(ring, 512, S, E); REPSEAM(7);
    } SEAM(7);

    if (IN(8)) _Pragma("unroll") for (int rep = 0; rep < REPS(8); ++rep) {
        const int* tilee = (const int*)(ws + WS_TILEE);
        const int ntl = __builtin_amdgcn_readfirstlane(__hip_atomic_load(tilee + 511, __ATOMIC_RELAXED, __HIP_MEMORY_SCOPE_AGENT));
        pg8::MoeOrder S{(const char*)(ws + WS_QH), (const char*)args.out + 32 * MiB, (const int*)(ws + WS_ROWTOK), tilee, 256, 1024, ntl * 4, C.G, C.vcu, false};
        pg8::EpiM2 E{(unsigned char*)(ws + WS_Y)};
        pg8::gemm_phase<pg8::EpiM2, pg8::MoeOrder, false, true>(ring, 256, S, E); REPSEAM(8);
    } SEAM(8);

    if (IN(9)) { _Pragma("unroll") for (int rep = 0; rep < REPS(9); ++rep) { f_phase(C, args); REPSEAM(9); } }
    STAMP(10);
    if (STAMP_SEL >= 0 && blockIdx.x == 0 && C.tid == 0) {
        const unsigned long long t0 = ((unsigned long long)C.MISC[17 + 2 * (STAMP_T0)] << 32) | C.MISC[16 + 2 * (STAMP_T0)], t1 = ((unsigned long long)C.MISC[17 + 2 * (STAMP_T1)] << 32) | C.MISC[16 + 2 * (STAMP_T1)];
        const unsigned long long w0 = __builtin_amdgcn_s_memrealtime(); while (__builtin_amdgcn_s_memrealtime() - w0 < 4ull * (t1 - t0)) __builtin_amdgcn_s_sleep(8); }
#undef IN
#undef SEAM
}

extern "C" void kernel_launch(void* const* d_in, const int* in_sizes, int n_in, void* d_out, int out_size, void* d_ws, size_t ws_size, hipStream_t stream) {
    static int grid = 0;
    if (grid == 0) {
        if (n_in != 19 || in_sizes[0] != NTOK * DM || out_size != NTOK * DM || ws_size < WS_END) { fprintf(stderr, "kernel_launch: unexpected problem shape / workspace; nothing launched\n"); grid = -1; return; }
        int dev = 0, cus = 0, per_cu = 0;
        if (hipGetDevice(&dev) != hipSuccess || hipDeviceGetAttribute(&cus, hipDeviceAttributeMultiprocessorCount, dev) != hipSuccess) { grid = -1; return; }
        if (hipFuncSetAttribute((const void*)mk_fwd, hipFuncAttributeMaxDynamicSharedMemorySize, LDS_BYTES) != hipSuccess) { fprintf(stderr, "kernel_launch: hipFuncSetAttribute failed\n"); grid = -1; return; }
        if (hipOccupancyMaxActiveBlocksPerMultiprocessor(&per_cu, (const void*)mk_fwd, NTHREADS, LDS_BYTES) != hipSuccess || per_cu < 1) { fprintf(stderr, "kernel_launch: occupancy query says %d\n", per_cu); }
        (void)hipGetLastError();
        grid = cus;
    }
    if (grid < 0) return;
    (void)hipMemsetAsync((char*)d_ws + WS_CTL, 0, CTL_ZERO_BYTES, stream);
    Args a{};
    for (int i = 0; i < 19; ++i) a.in[i] = (const float*)d_in[i];
    a.out = (float*)d_out; a.ws = (unsigned char*)d_ws;
    if (MK_N_LAUNCHES == 1) { a.ph_lo = 0; a.ph_hi = NPH; hipLaunchKernelGGL(mk_fwd, dim3(grid), dim3(NTHREADS), LDS_BYTES, stream, a); }
    else for (int p = 0; p < NPH; ++p) { a.ph_lo = p; a.ph_hi = p + 1; hipLaunchKernelGGL(mk_fwd, dim3(grid), dim3(NTHREADS), LDS_BYTES, stream, a); }
}
```

```cpp
#include <hip/hip_runtime.h>
#include <cstdio>
#include <cstdint>
#ifndef MK_N_LAUNCHES
#define MK_N_LAUNCHES 1
#endif
#define DI __device__ __forceinline__
#define GAS __attribute__((address_space(1)))
#define LAS __attribute__((address_space(3)))
typedef unsigned short bf16;
typedef unsigned u32x4 __attribute__((ext_vector_type(4)));
typedef unsigned u32x2 __attribute__((ext_vector_type(2)));
typedef float f32x4 __attribute__((ext_vector_type(4)));
typedef float f32x2 __attribute__((ext_vector_type(2)));
typedef float f32x16 __attribute__((ext_vector_type(16)));
typedef short bf16x8 __attribute__((ext_vector_type(8)));
typedef short s16x4 __attribute__((ext_vector_type(4)));
typedef short v4i16_t __attribute__((ext_vector_type(4)));
typedef __bf16 bf16x2_t __attribute__((ext_vector_type(2)));
typedef GAS unsigned gu32;

constexpr int NTOK = 32768, DM = 1024, SEQ = 2048, NBATCH = 16, NIN = 5632;
constexpr int NWAVES = 8, NTHREADS = 512;
constexpr float LN_EPS = 1e-5f, DN_ALPHA = 1.189207115002721f, LOG2E = 1.4426950408889634f;
constexpr int MOE_MAXTILES = 288;

constexpr size_t MiB = 1u << 20;
constexpr size_t WS_CTL = 0, CTL_ZERO_BYTES = 65536;
constexpr size_t WS_WIN = 1 * MiB, WS_WCAT = 12 * MiB, WS_WO = 14 * MiB;
constexpr size_t WS_XB = 16 * MiB;
constexpr size_t WS_R = 80 * MiB;
constexpr size_t WS_GB = 144 * MiB;
constexpr size_t WS_QH = 208 * MiB;
constexpr size_t WS_VH = 240 * MiB;
constexpr size_t WS_GH = 272 * MiB;
constexpr size_t WS_ZF = 304 * MiB;
constexpr size_t WS_OCAT = 306 * MiB;
constexpr size_t WS_QM = 368 * MiB, WS_KM = 400 * MiB;
constexpr size_t WS_VM = 432 * MiB;
constexpr size_t WS_Y = 16 * MiB;
constexpr size_t WS_MISC = 464 * MiB;
constexpr size_t WS_KMEAN = WS_MISC;
constexpr size_t WS_BPERM = WS_MISC + 1 * MiB;
constexpr size_t WS_WRH = WS_MISC + 2 * MiB;
constexpr size_t WS_WRL = WS_WRH + 98304;
constexpr size_t WS_TOKE = WS_MISC + 3 * MiB;
constexpr size_t WS_TOKW = WS_MISC + 4 * MiB;
constexpr size_t WS_TOKD = WS_MISC + 5 * MiB;
constexpr size_t WS_WGCNT = WS_MISC + 6 * MiB;
constexpr size_t WS_ROWTOK = WS_MISC + 7 * MiB;
constexpr size_t WS_TILEE = WS_MISC + 8 * MiB;
constexpr size_t WS_STATS = WS_MISC + 9 * MiB;
constexpr size_t WS_LB = WS_MISC + 10 * MiB;
constexpr size_t WS_KK = WS_MISC + 12 * MiB;
constexpr size_t WS_END = 512 * MiB;
constexpr int CW_BAR = 4096, CW_QUEUE = 8192, CW_QUEUE2 = 8192 + 1024;

constexpr int LDS_BYTES = 163840, MISC_OFF = LDS_BYTES - 256;

DI unsigned cvtpk(float lo, float hi) { f32x2 v = {lo, hi}; bf16x2_t b = __builtin_convertvector(v, bf16x2_t); return __builtin_bit_cast(unsigned, b); }
DI float bflo(unsigned w) { return __uint_as_float(w << 16); }
DI float bfhi(unsigned w) { return __uint_as_float(w & 0xffff0000u); }
DI float bf2f(unsigned short h) { return __uint_as_float((unsigned)h << 16); }
DI float frcp(float x) { return __builtin_amdgcn_rcpf(x); }
DI float fsigmoid(float x) { return frcp(1.f + __expf(-x)); }
DI float wave_sum(float v) {
#pragma unroll
    for (int o = 1; o < 64; o <<= 1) v += __shfl_xor(v, o);
    return v;
}
typedef int v8i __attribute__((ext_vector_type(8)));
typedef int v4i __attribute__((ext_vector_type(4)));
DI unsigned cvt4_fp8(float a, float b, float c, float d) { a = __builtin_amdgcn_fmed3f(a, -448.f, 448.f); b = __builtin_amdgcn_fmed3f(b, -448.f, 448.f); c = __builtin_amdgcn_fmed3f(c, -448.f, 448.f); d = __builtin_amdgcn_fmed3f(d, -448.f, 448.f);
    int w = 0; w = __builtin_amdgcn_cvt_pk_fp8_f32(a, b, w, false); w = __builtin_amdgcn_cvt_pk_fp8_f32(c, d, w, true); return (unsigned)w; }
DI f32x4 fp8x4_to_f32(unsigned w) { const f32x2 lo = __builtin_amdgcn_cvt_pk_f32_fp8((int)w, false), hi = __builtin_amdgcn_cvt_pk_f32_fp8((int)w, true); return (f32x4){lo[0], lo[1], hi[0], hi[1]}; }
constexpr float FP8_SXI = 8.f, FP8_SX = 8.f, FP8_SW = 32.f, FP8_SH = 4.f, FP8_SO = 4.f, FP8_SU = 32.f, FP8_SY = 64.f;
DI int crow(int r, int hi) { return (r & 3) + 8 * (r >> 2) + 4 * hi; }
#define MFMA32(a, b, c) __builtin_amdgcn_mfma_f32_32x32x16_bf16((a), (b), (c), 0, 0, 0)
#define MFMA16(a, b, c) __builtin_amdgcn_mfma_f32_16x16x32_bf16((a), (b), (c), 0, 0, 0)
DI s16x4 vtr(LAS const char* p) { return __builtin_bit_cast(s16x4, __builtin_amdgcn_ds_read_tr16_b64_v4i16((LAS v4i16_t*)p)); }

#define XB_TMO      128
#define XB_XCNT(j)  (256  + 64 * (j))
#define XB_XSUB(j)  (1280 + 64 * (j))
#define XB_XGEN(j)  (2304 + 64 * (j))
#define XB_TOP      3328
#define XB_TOPGEN   3392
#define XCD_BAR_WORDS 3456
#define XB_SPIN_CAP (1u << 22)
DI unsigned xb_ld(unsigned* p)              { return __hip_atomic_load(p, __ATOMIC_RELAXED, __HIP_MEMORY_SCOPE_AGENT); }
DI unsigned xb_add(unsigned* p, unsigned v) { return __hip_atomic_fetch_add(p, v, __ATOMIC_RELAXED, __HIP_MEMORY_SCOPE_AGENT); }
DI unsigned xb_xcc_id() { return (unsigned)__builtin_amdgcn_s_getreg((3 << 11) | 20) & 0xFu; }
#define XB_SPIN(cond, bar) do { unsigned _sp = 0; while (cond) { __builtin_amdgcn_s_sleep(1); \
    if ((++_sp & 255u) == 0u) { if (xb_ld(&(bar)[XB_TMO])) break; if (_sp > XB_SPIN_CAP) { atomicAdd(&(bar)[XB_TMO], 1u); break; } } } } while (0)
struct XcdBarrier { unsigned* bar; unsigned x; volatile LAS unsigned* st; };
DI XcdBarrier xcd_barrier_post(unsigned* bar, volatile LAS unsigned* st) {
    XcdBarrier b; b.bar = bar; b.x = xb_xcc_id(); b.st = st;
    if (threadIdx.x == 0) (void)xb_add(&bar[XB_XCNT(b.x)], 1u);
    return b;
}
DI void xcd_barrier_complete(unsigned* bar, unsigned x, unsigned& nloc, unsigned& nx) {
    const unsigned G = gridDim.x * gridDim.y * gridDim.z;
    unsigned sum, cnt, mine, sp = 0u;
    for (;;) {
        sum = 0u; cnt = 0u; mine = 0u;
#pragma unroll
        for (unsigned j = 0; j < 16; ++j) { const unsigned c = xb_ld(&bar[XB_XCNT(j)]); sum += c; cnt += (c > 0u) ? 1u : 0u; mine = (j == x) ? c : mine; }
        if (sum == G) break;
        __builtin_amdgcn_s_sleep(1);
        if ((++sp & 255u) == 0u) { if (xb_ld(&bar[XB_TMO])) break; if (sp > XB_SPIN_CAP) { atomicAdd(&bar[XB_TMO], 1u); break; } }
    }
    nloc = mine > 0u ? mine : 1u; nx = cnt > 0u ? cnt : 1u;
}
DI void xcd_barrier(const XcdBarrier& b) {
    asm volatile("s_waitcnt vmcnt(0)" ::: "memory");
    __syncthreads();
    if (threadIdx.x == 0) {
        unsigned* bar = b.bar;
        __builtin_amdgcn_s_waitcnt(0);
        unsigned nloc = b.st[0], nx = b.st[1];
        if (nloc == 0u) { xcd_barrier_complete(bar, b.x, nloc, nx); b.st[0] = nloc; b.st[1] = nx; }
        const unsigned old = xb_add(&bar[XB_XSUB(b.x)], 1u);
        const unsigned gen = old / nloc;
        if (old + 1u == (gen + 1u) * nloc) {
            __builtin_amdgcn_fence(__ATOMIC_RELEASE, "agent");
            asm volatile("s_waitcnt vmcnt(0)" ::: "memory");
            const unsigned og = xb_add(&bar[XB_TOP], 1u);
            const unsigned tg = og / nx;
            if (og + 1u == (tg + 1u) * nx) xb_add(&bar[XB_TOPGEN], 1u);
            else XB_SPIN(xb_ld(&bar[XB_TOPGEN]) == tg, bar);
            __builtin_amdgcn_fence(__ATOMIC_ACQUIRE, "agent");
            xb_add(&bar[XB_XGEN(b.x)], 1u);
            asm volatile("s_waitcnt vmcnt(0)" ::: "memory");
        } else {
            XB_SPIN(xb_ld(&bar[XB_XGEN(b.x)]) == gen, bar);
            __builtin_amdgcn_fence(__ATOMIC_ACQUIRE, "agent");
            asm volatile("s_waitcnt vmcnt(0)" ::: "memory");
        }
    }
    __syncthreads();
}

namespace pg8 {
constexpr int BM = 256, BK = 64, HALF = 128, HTB = HALF * BK * 2, STAGE_BYTES = 8 * HTB, NXCD = 8, WGM = 8;
DI int lds_byte(int r, int c) { const int st = (r >> 4) * 2 + (c >> 5), rr = r & 15, cc = c & 31, ob = rr * 64 + cc * 2; return st * 1024 + (ob ^ (((ob >> 9) & 1) << 5)); }
DI void stage_rc(int b, int& R, int& C) { const int st = b / 1024, sb = b % 1024, swz = sb ^ (((sb >> 9) & 1) << 5); R = (st >> 1) * 16 + swz / 64; C = (st & 1) * 32 + (swz % 64) / 2; }
DI int perm32(int rho) { const int n = rho >> 4, i = rho & 15; return 8 * (i >> 2) + 4 * n + (i & 3); }
struct Unit { int pm, pn, e; };

struct DenseOrder {
    const char* A; const char* Bt; int K, nM, nN, nwg, G, c;
    DI void init(const void* A_, const void* Bt_, int M, int N, int K_, int G_, int c_) { A = (const char*)A_; Bt = (const char*)Bt_; K = K_; nM = M / BM; nN = N / BM; nwg = nM * nN; G = G_; c = c_; }
    DI bool next(int i, Unit& u) const {
        const long L = (long)i * G + c; if (L >= nwg) return false;
        int wgid = (int)L; { const int q = nwg / NXCD, r = nwg % NXCD, xcd = wgid % NXCD, off = wgid / NXCD; wgid = (xcd < r ? xcd * (q + 1) : r * (q + 1) + (xcd - r) * q) + off; }
        const int nig = WGM * nN, gid = wgid / nig, fm = gid * WGM, gsz = (nM - fm) < WGM ? (nM - fm) : WGM;
        u.pm = fm + ((wgid % nig) % gsz); u.pn = (wgid % nig) / gsz; u.e = 0; return true;
    }
    DI const char* a_base(const Unit& u) const { return A + (size_t)u.pm * 512 * K; }
    DI const char* b_base(const Unit& u) const { return Bt + (size_t)u.pn * 512 * K; }
    DI void gather(const Unit&, const int (&)[2], const int (&)[2], unsigned (&)[2][2]) const {}
};
struct MoeOrder {
    const char* A; const char* Bt; const int* row_tok; const int* tile_e; int K, N, nunits, G, c; bool gat;
    DI bool next(int i, Unit& u) const {
        const int L = i * G + c; if (L >= nunits) return false;
        u.pm = L >> 2; u.pn = L & 3;
        u.e = __builtin_amdgcn_readfirstlane(__hip_atomic_load(tile_e + u.pm, __ATOMIC_RELAXED, __HIP_MEMORY_SCOPE_AGENT)); return true;
    }
    DI const char* a_base(const Unit& u) const { return gat ? A : A + (size_t)u.pm * 512 * K; }
    DI const char* b_base(const Unit& u) const { return Bt + ((size_t)u.e * N + (size_t)u.pn * 256) * K * 2; }
    DI void gather(const Unit& u, const int (&Rr)[2], const int (&Cc)[2], unsigned (&o)[2][2]) const {
#pragma unroll
        for (int h = 0; h < 2; ++h)
#pragma unroll
            for (int i = 0; i < 2; ++i) { const int tok = row_tok[u.pm * 256 + h * 128 + Rr[i]]; o[h][i] = (unsigned)(tok * K + Cc[i]) * 2u; }
    }
};

template <class Epi, class Sched, bool GATHER, bool FP8 = false>
DI void gemm_phase(LAS unsigned char* lds, const int K, const Sched& S, const Epi& E) {
    const int tid = threadIdx.x, wid = __builtin_amdgcn_readfirstlane(tid >> 6), lane = tid & 63, wr = wid >> 2, wc = wid & 3, fr = lane & 15, fq = lane >> 4;
    const int nt = K / BK;
    unsigned voffB[2], vA[2][2], nvA[2][2]; int Rr[2], Cc[2];
#pragma unroll
    for (int i = 0; i < 2; ++i) { int R, C; stage_rc(tid * 16 + i * 8192, R, C); Rr[i] = R; Cc[i] = C; const int Rb = (R & ~31) + perm32(R & 31);
        voffB[i] = (unsigned)(Rb * K + C) * 2u; vA[0][i] = (unsigned)(R * K + C) * 2u; vA[1][i] = (unsigned)((R + HALF) * K + C) * 2u; nvA[0][i] = vA[0][i]; nvA[1][i] = vA[1][i]; }
    const size_t kstep = (size_t)(BK * 2);
    const size_t hstep = (size_t)HALF * K * 2;
    const unsigned ldsw = (unsigned)wid * 1024u;
    const int aoff = lds_byte(wr * 64 + fr, fq * 8), boff = lds_byte(wc * 32 + fr, fq * 8);
#define PG8_SA(b, h) (((b) * 2 + (h)) * HTB)
#define PG8_SB(b, h) ((4 + (b) * 2 + (h)) * HTB)
#define PG8_STAGE(bufoff, gbase, voff) do { _Pragma("unroll") for (int _i = 0; _i < 2; ++_i) \
        __builtin_amdgcn_global_load_lds((const unsigned*)((const char*)(gbase) + (voff)[_i]), (LAS unsigned*)(lds + (bufoff) + ldsw + _i * 8192), 16, 0, 0); } while (0)
#define PG8_LDA(dst, b, h) do { if constexpr (FP8) { _Pragma("unroll") for (int m = 0; m < 4; ++m) dst##8[m] = __builtin_shufflevector(*(const LAS v4i*)(lds + PG8_SA(b, h) + aoff + m * 2048), *(const LAS v4i*)(lds + PG8_SA(b, h) + aoff + m * 2048 + 1024), 0, 1, 2, 3, 4, 5, 6, 7); } \
        else { _Pragma("unroll") for (int m = 0; m < 4; ++m) _Pragma("unroll") for (int k = 0; k < 2; ++k) dst[m][k] = *(const LAS bf16x8*)(lds + PG8_SA(b, h) + aoff + m * 2048 + k * 1024); } } while (0)
#define PG8_LDB(dst, b, h) do { if constexpr (FP8) { _Pragma("unroll") for (int n = 0; n < 2; ++n) dst##8[n] = __builtin_shufflevector(*(const LAS v4i*)(lds + PG8_SB(b, h) + boff + n * 2048), *(const LAS v4i*)(lds + PG8_SB(b, h) + boff + n * 2048 + 1024), 0, 1, 2, 3, 4, 5, 6, 7); } \
        else { _Pragma("unroll") for (int n = 0; n < 2; ++n) _Pragma("unroll") for (int k = 0; k < 2; ++k) dst[n][k] = *(const LAS bf16x8*)(lds + PG8_SB(b, h) + boff + n * 2048 + k * 1024); } } while (0)
#define PG8_CAT(x, y) __builtin_shufflevector(__builtin_bit_cast(v4i, (x)), __builtin_bit_cast(v4i, (y)), 0, 1, 2, 3, 4, 5, 6, 7)
#define PG8_MMA(ai, bj, At, Bt) do { __builtin_amdgcn_s_setprio(1); if constexpr (FP8) { _Pragma("unroll") for (int m = 0; m < 4; ++m) _Pragma("unroll") for (int n = 0; n < 2; ++n) \
        asm volatile("v_mfma_scale_f32_16x16x128_f8f6f4 %0, %1, %2, %0, %3, %3 op_sel_hi:[0,0,0]" : "+v"(acc[ai][bj][m][n]) : "v"(Bt##8[n]), "v"(At##8[m]), "v"(fp8_unit_scale)); } else { \
        _Pragma("unroll") for (int m = 0; m < 4; ++m) _Pragma("unroll") for (int n = 0; n < 2; ++n) _Pragma("unroll") for (int k = 0; k < 2; ++k) \
        acc[ai][bj][m][n] = __builtin_amdgcn_mfma_f32_16x16x32_bf16(Bt[n][k], At[m][k], acc[ai][bj][m][n], 0, 0, 0); } __builtin_amdgcn_s_setprio(0); } while (0)
#define PG8_WAIT_V(n) asm volatile("s_waitcnt vmcnt(" #n ")" ::: "memory")
#define PG8_WAIT_L(n) asm volatile("s_waitcnt lgkmcnt(" #n ")" ::: "memory")
#define PG8_BAR __builtin_amdgcn_s_barrier()
#define PG8_SCHED __builtin_amdgcn_sched_barrier(0)
    Unit cur, nxt; int ui = 0;
    if (!S.next(0, cur)) return;
    if constexpr (GATHER) S.gather(cur, Rr, Cc, vA);
    f32x4 acc[2][2][4][2];
#pragma unroll
    for (int a = 0; a < 2; ++a)
#pragma unroll
        for (int b = 0; b < 2; ++b)
#pragma unroll
            for (int m = 0; m < 4; ++m)
#pragma unroll
                for (int n = 0; n < 2; ++n) acc[a][b][m][n] = (f32x4){0.f, 0.f, 0.f, 0.f};
    bf16x8 At[4][2], B0[2][2], B1[2][2]; v8i At8[4], B08[2], B18[2]; const int fp8_unit_scale = 0x7f7f7f7f;
    const char* cA = S.a_base(cur); const char* cB = S.b_base(cur);
    PG8_STAGE(PG8_SB(0, 0), cB, voffB); PG8_STAGE(PG8_SB(0, 1), cB + hstep, voffB); PG8_STAGE(PG8_SA(0, 0), cA, vA[0]); PG8_STAGE(PG8_SA(0, 1), cA, vA[1]);
    if (wr == 1) PG8_BAR;
    PG8_WAIT_V(2); PG8_BAR;
    PG8_STAGE(PG8_SB(1, 0), cB + kstep, voffB); PG8_STAGE(PG8_SA(1, 0), cA + kstep, vA[0]); PG8_STAGE(PG8_SB(1, 1), cB + hstep + kstep, voffB);
    PG8_WAIT_V(6); PG8_BAR;
    for (;;) {
        const bool has_next = S.next(ui + 1, nxt);
        const char* nA = has_next ? S.a_base(nxt) : cA; const char* nB = has_next ? S.b_base(nxt) : cB;
        if constexpr (GATHER) {
            if (has_next) S.gather(nxt, Rr, Cc, nvA);
            else {
#pragma unroll
                for (int h = 0; h < 2; ++h) { nvA[h][0] = vA[h][0]; nvA[h][1] = vA[h][1]; } }
        }
#pragma unroll 1
        for (int t = 0; t < nt; t += 2) {
            const bool last = (t == nt - 2);
            if constexpr (Epi::HAS_MID) { if (t == (nt >> 1)) { if constexpr (FP8) asm volatile("s_nop 15\n\ts_nop 15" ::: "memory"); E.mid(acc, cur, wr, wc, fr, fq); if constexpr (FP8) asm volatile("s_nop 7" ::: "memory"); } }
            const char* a1 = cA + (size_t)(t + 1) * kstep;
            const char* a2 = last ? nA : cA + (size_t)(t + 2) * kstep; const char* b2 = last ? nB : cB + (size_t)(t + 2) * kstep;
            const char* a3 = a2 + kstep; const char* b3 = b2 + kstep;
            unsigned o0[2], o1[2];
            if constexpr (GATHER) { o0[0] = last ? nvA[0][0] : vA[0][0]; o0[1] = last ? nvA[0][1] : vA[0][1]; o1[0] = last ? nvA[1][0] : vA[1][0]; o1[1] = last ? nvA[1][1] : vA[1][1]; }
            else { o0[0] = vA[0][0]; o0[1] = vA[0][1]; o1[0] = vA[1][0]; o1[1] = vA[1][1]; }
            PG8_LDB(B0, 0, 0); PG8_LDB(B1, 0, 1); PG8_SCHED; PG8_LDA(At, 0, 0); PG8_STAGE(PG8_SA(1, 1), a1, vA[1]);
            PG8_WAIT_V(8); PG8_WAIT_L(0); PG8_BAR; PG8_MMA(0, 0, At, B0); PG8_MMA(0, 1, At, B1); PG8_BAR; PG8_SCHED;
            PG8_LDA(At, 0, 1); PG8_STAGE(PG8_SB(0, 0), b2, voffB); PG8_STAGE(PG8_SB(0, 1), b2 + hstep, voffB); PG8_STAGE(PG8_SA(0, 0), a2, o0);
            PG8_WAIT_V(8); PG8_WAIT_L(0); PG8_BAR; PG8_MMA(1, 0, At, B0); PG8_MMA(1, 1, At, B1); PG8_BAR; PG8_SCHED;
            PG8_LDB(B0, 1, 0); PG8_LDB(B1, 1, 1); PG8_SCHED; PG8_LDA(At, 1, 0); PG8_STAGE(PG8_SA(0, 1), a2, o1);
            PG8_WAIT_V(8); PG8_WAIT_L(0); PG8_BAR; PG8_MMA(0, 0, At, B0); PG8_MMA(0, 1, At, B1); PG8_BAR; PG8_SCHED;
            PG8_LDA(At, 1, 1); PG8_STAGE(PG8_SB(1, 0), b3, voffB); PG8_STAGE(PG8_SB(1, 1), b3 + hstep, voffB); PG8_STAGE(PG8_SA(1, 0), a3, o0);
            PG8_WAIT_V(8); PG8_WAIT_L(0); PG8_BAR; PG8_MMA(1, 0, At, B0); PG8_MMA(1, 1, At, B1); PG8_BAR; PG8_SCHED;
        }
        if (wr == 0) PG8_BAR;
        if constexpr (FP8) asm volatile("s_nop 15\n\ts_nop 15" ::: "memory");
        E(acc, cur, wr, wc, fr, fq);
        if (!has_next) break;
#pragma unroll
        for (int a = 0; a < 2; ++a)
#pragma unroll
            for (int b = 0; b < 2; ++b)
#pragma unroll
                for (int m = 0; m < 4; ++m)
#pragma unroll
                    for (int n = 0; n < 2; ++n) acc[a][b][m][n] = (f32x4){0.f, 0.f, 0.f, 0.f};
        cur = nxt; cA = nA; cB = nB; ++ui;
        if constexpr (GATHER) {
#pragma unroll
            for (int h = 0; h < 2; ++h) { vA[h][0] = nvA[h][0]; vA[h][1] = nvA[h][1]; } }
        if (wr == 1) PG8_BAR;
    }
    PG8_WAIT_V(0);
    PG8_BAR;
#undef PG8_SA
#undef PG8_SB
#undef PG8_STAGE
#undef PG8_LDA
#undef PG8_LDB
#undef PG8_MMA
#undef PG8_CAT
#undef PG8_WAIT_V
#undef PG8_WAIT_L
#undef PG8_BAR
#undef PG8_SCHED
}

typedef f32x4 Acc[2][2][4][2];
DI u32x4 pack8(const f32x4 a, const f32x4 b) { u32x4 w; w.x = cvtpk(a[0], a[1]); w.y = cvtpk(a[2], a[3]); w.z = cvtpk(b[0], b[1]); w.w = cvtpk(b[2], b[3]); return w; }
DI f32x4 silu4(const f32x4 v) { f32x4 o; o[0] = v[0] * fsigmoid(v[0]); o[1] = v[1] * fsigmoid(v[1]); o[2] = v[2] * fsigmoid(v[2]); o[3] = v[3] * fsigmoid(v[3]); return o; }

struct EpiIn {
    static constexpr bool HAS_MID = false;
    bf16 *Qh, *Vh, *Gh, *Qm, *Km, *Vm, *Rr, *Gb; float *Zf, *KM; const float* bias; bf16* KK; const float* LB; int pn_off;
    DI void operator()(Acc& acc, const Unit& u, int wr, int wc, int fr, int fq) const {
        const int pn = u.pn + pn_off, row0 = u.pm * BM + wr * 64 + fr, cl = wc * 32 + 8 * fq;
        if (pn_off) {
#pragma unroll
            for (int ai = 0; ai < 2; ++ai)
#pragma unroll
                for (int bj = 0; bj < 2; ++bj)
#pragma unroll
                    for (int m = 0; m < 4; ++m) { acc[ai][bj][m][0] *= (1.f / (FP8_SXI * FP8_SW)); acc[ai][bj][m][1] *= (1.f / (FP8_SXI * FP8_SW)); } }
        f32x4 bv[2][2];
#pragma unroll
        for (int bj = 0; bj < 2; ++bj)
#pragma unroll
            for (int n = 0; n < 2; ++n) bv[bj][n] = *(const f32x4*)(bias + pn * 256 + bj * HALF + cl + 4 * n);
        if (pn < 4) {
#define EI_DPP(v, ctrl) __int_as_float(__builtin_amdgcn_update_dpp(0, __float_as_int(v), ctrl, 0xf, 0xf, true))
            const int chb = pn * 128 + cl;
#pragma unroll
            for (int ai = 0; ai < 2; ++ai)
#pragma unroll
                for (int n = 0; n < 2; ++n) { const f32x4 lbv = *(const f32x4*)(LB + chb + 4 * n); f32x4 run = (f32x4){0.f, 0.f, 0.f, 0.f}, bmid = run; f32x4 bbv[4], kkv[4];
#pragma unroll
                    for (int m = 0; m < 4; ++m) {
#pragma unroll
                        for (int j = 0; j < 4; ++j) { const float z = acc[ai][1][m][n][j] + bv[1][n][j]; const float sg = frcp(1.f + __expf(-z)); const float lf = __logf(lbv[j] + (1.f - lbv[j]) * sg); kkv[m][j] = (1.f - lbv[j]) * (1.f - sg);
                            float t = lf; t += EI_DPP(t, 0xB1); t += EI_DPP(t, 0x4E); t += EI_DPP(t, 0x141); t += EI_DPP(t, 0x140);
                            float s = lf; s += EI_DPP(s, 0x111); s += EI_DPP(s, 0x112); s += EI_DPP(s, 0x114); s += EI_DPP(s, 0x118);
                            bbv[m][j] = s + run[j]; run[j] += t; }
                        if (m == 1) bmid = run; }
#pragma unroll
                    for (int m = 0; m < 4; ++m) { f32x4 qp, kp;
#pragma unroll
                        for (int j = 0; j < 4; ++j) { const float qx = acc[ai][0][m][n][j] + bv[0][n][j]; const float e = __expf(bbv[m][j] - bmid[j]); qp[j] = qx * fsigmoid(qx) * e; kp[j] = kkv[m][j] * frcp(e); }
                        const size_t ro = (size_t)(row0 + ai * HALF + m * 16) * 512 + chb + 4 * n;
                        u32x2 qw, kw; qw.x = cvtpk(qp[0], qp[1]); qw.y = cvtpk(qp[2], qp[3]); kw.x = cvtpk(kp[0], kp[1]); kw.y = cvtpk(kp[2], kp[3]);
                        *(u32x2*)(Qh + ro) = qw; *(u32x2*)(KK + ro) = kw; }
                    if (fr == 0) { const size_t so = (size_t)(u.pm * 4 + ai * 2 + wr) * 512 + chb + 4 * n; *(f32x4*)(Zf + so) = bmid; *(f32x4*)(Zf + 262144 + so) = run; }
                    asm volatile("" ::: "memory"); }
#undef EI_DPP
        } else if (pn < 14) {
            const int seg = pn >> 1, c0 = (pn & 1) * 256 + cl;
            {
                bf16* O = seg == 2 ? Vh : seg == 3 ? Gh : seg == 4 ? Qm : seg == 5 ? Km : Vm;
                const int act = (seg == 3) ? 1 : (seg == 4 ? 2 : 0);
                if (seg == 5) {
#pragma unroll
                    for (int bj = 0; bj < 2; ++bj)
#pragma unroll
                        for (int n = 0; n < 2; ++n) { f32x4 cs = (f32x4){0.f, 0.f, 0.f, 0.f};
#pragma unroll
                            for (int ai = 0; ai < 2; ++ai)
#pragma unroll
                                for (int m = 0; m < 4; ++m) cs += acc[ai][bj][m][n] + bv[bj][n];
#pragma unroll
                            for (int j = 0; j < 4; ++j) { float s = cs[j]; s += __shfl_xor(s, 1); s += __shfl_xor(s, 2); s += __shfl_xor(s, 4); s += __shfl_xor(s, 8); cs[j] = s; }
                            if (fr == 0) *(f32x4*)(KM + (size_t)(u.pm * 2 + wr) * 512 + c0 + bj * HALF + 4 * n) = cs; }
                }
#pragma unroll
                for (int ai = 0; ai < 2; ++ai)
#pragma unroll
                    for (int m = 0; m < 4; ++m) { const int row = row0 + ai * HALF + m * 16;
                        bf16* rp = (seg >= 4) ? O + ((size_t)(row >> 11) * 8 * SEQ + (row & (SEQ - 1))) * 64 + (size_t)(c0 >> 6) * SEQ * 64 + (c0 & 63) : O + (size_t)row * 512 + c0;
                        const size_t bjs = (seg >= 4) ? (size_t)2 * SEQ * 64 : (size_t)HALF;
#pragma unroll
                        for (int bj = 0; bj < 2; ++bj) { f32x4 v0 = acc[ai][bj][m][0] + bv[bj][0], v1 = acc[ai][bj][m][1] + bv[bj][1];
                            if (act == 1) { v0 = silu4(v0); v1 = silu4(v1); } else if (act == 2) { v0 = v0 * (0.125f * LOG2E); v1 = v1 * (0.125f * LOG2E); }
                            *(u32x4*)(rp + bj * bjs) = pack8(v0, v1); }
                        asm volatile("" ::: "memory"); }
            }
        } else {
            const int c0 = (pn - 14) * 128 + cl;
#pragma unroll
            for (int ai = 0; ai < 2; ++ai)
#pragma unroll
                for (int m = 0; m < 4; ++m) { const size_t off = (size_t)(row0 + ai * HALF + m * 16) * 1024 + c0; f32x4 r[2], g[2];
#pragma unroll
                    for (int n = 0; n < 2; ++n) { const f32x4 a = acc[ai][0][m][n] + bv[0][n], b = acc[ai][1][m][n] + bv[1][n];
#pragma unroll
                        for (int j = 0; j < 4; ++j) { const float ea = __expf(-a[j]), eb = __expf(-b[j]); g[n][j] = frcp(1.f + eb); r[n][j] = (1.f + eb) * frcp(1.f + ea); } }
                    *(u32x4*)(Rr + off) = pack8(r[0], r[1]); *(u32x4*)(Gb + off) = pack8(g[0], g[1]); asm volatile("" ::: "memory"); }
        }
    }
};
struct EpiProj {
    static constexpr bool HAS_MID = true;
    const bf16 *Rr, *Gb; unsigned char* U;
    DI void scale(Acc& acc, const bf16* G, const Unit& u, int wr, int wc, int fr, int fq) const {
        int row0 = u.pm * BM + wr * 64 + fr, col0 = u.pn * BM + wc * 32 + 8 * fq;
        asm volatile("" : "+v"(row0), "+v"(col0));
#pragma unroll
        for (int ai = 0; ai < 2; ++ai)
#pragma unroll
            for (int mp = 0; mp < 2; ++mp) { u32x4 rv[2][2];
#pragma unroll
            for (int m = 0; m < 2; ++m)
#pragma unroll
                for (int bj = 0; bj < 2; ++bj) rv[m][bj] = *(const u32x4*)(G + (size_t)(row0 + ai * HALF + (2 * mp + m) * 16) * 1024 + col0 + bj * HALF);
#pragma unroll
            for (int m = 0; m < 2; ++m)
#pragma unroll
                for (int bj = 0; bj < 2; ++bj) { const u32x4 w = rv[m][bj];
                    acc[ai][bj][2 * mp + m][0] *= (f32x4){bflo(w.x), bfhi(w.x), bflo(w.y), bfhi(w.y)}; acc[ai][bj][2 * mp + m][1] *= (f32x4){bflo(w.z), bfhi(w.z), bflo(w.w), bfhi(w.w)}; }
            asm volatile("" ::: "memory"); }
    }
    DI void mid(Acc& acc, const Unit& u, int wr, int wc, int fr, int fq) const { scale(acc, Rr, u, wr, wc, fr, fq); }
    DI void operator()(Acc& acc, const Unit& u, int wr, int wc, int fr, int fq) const {
        scale(acc, Gb, u, wr, wc, fr, fq);
        const int row0 = u.pm * BM + wr * 64 + fr, col0 = u.pn * BM + wc * 32 + 8 * fq;
        constexpr float inv = FP8_SU / (FP8_SO * FP8_SW);
#pragma unroll
        for (int ai = 0; ai < 2; ++ai)
#pragma unroll
            for (int m = 0; m < 4; ++m) { unsigned char* rp = U + (size_t)(row0 + ai * HALF + m * 16) * 1024 + col0;
#pragma unroll
                for (int bj = 0; bj < 2; ++bj) { const f32x4 v0 = acc[ai][bj][m][0] * inv, v1 = acc[ai][bj][m][1] * inv; u32x2 w; w.x = cvt4_fp8(v0[0], v0[1], v0[2], v0[3]); w.y = cvt4_fp8(v1[0], v1[1], v1[2], v1[3]); *(u32x2*)(rp + bj * HALF) = w; } }
    }
};
struct EpiOut {
    static constexpr bool HAS_MID = false;
    const bf16* X; bf16* Pre;
    DI void operator()(Acc& acc, const Unit& u, int wr, int wc, int fr, int fq) const {
        int row0 = u.pm * BM + wr * 64 + fr, col0 = u.pn * BM + wc * 32 + 8 * fq;
        asm volatile("" : "+v"(row0), "+v"(col0));
        constexpr float inv = 1.f / (FP8_SU * FP8_SW);
#pragma unroll
        for (int ai = 0; ai < 2; ++ai) { u32x4 xv[4][2];
#pragma unroll
            for (int m = 0; m < 4; ++m)
#pragma unroll
                for (int bj = 0; bj < 2; ++bj) xv[m][bj] = *(const u32x4*)(X + (size_t)(row0 + ai * HALF + m * 16) * 1024 + col0 + bj * HALF);
#pragma unroll
            for (int m = 0; m < 4; ++m)
#pragma unroll
                for (int bj = 0; bj < 2; ++bj) { const u32x4 w = xv[m][bj];
                    const f32x4 v0 = (f32x4){bflo(w.x), bfhi(w.x), bflo(w.y), bfhi(w.y)} * DN_ALPHA + acc[ai][bj][m][0] * inv, v1 = (f32x4){bflo(w.z), bfhi(w.z), bflo(w.w), bfhi(w.w)} * DN_ALPHA + acc[ai][bj][m][1] * inv;
                    *(u32x4*)(Pre + (size_t)(row0 + ai * HALF + m * 16) * 1024 + col0 + bj * HALF) = pack8(v0, v1); }
            asm volatile("" ::: "memory"); }
    }
};
struct EpiM1 {
    static constexpr bool HAS_MID = false;
    unsigned char* H;
    DI void operator()(Acc& acc, const Unit& u, int wr, int wc, int fr, int fq) const {
        const int row0 = u.pm * BM + wr * 64 + fr, col0 = u.pn * 128 + wc * 32 + 8 * fq;
        constexpr float inv = 1.f / (FP8_SX * FP8_SW);
#pragma unroll
        for (int ai = 0; ai < 2; ++ai)
#pragma unroll
            for (int m = 0; m < 4; ++m) { const f32x4 h0 = silu4(acc[ai][0][m][0] * inv) * (acc[ai][1][m][0] * (inv * FP8_SH)), h1 = silu4(acc[ai][0][m][1] * inv) * (acc[ai][1][m][1] * (inv * FP8_SH));
                u32x2 w; w.x = cvt4_fp8(h0[0], h0[1], h0[2], h0[3]); w.y = cvt4_fp8(h1[0], h1[1], h1[2], h1[3]);
                *(u32x2*)(H + (size_t)(row0 + ai * HALF + m * 16) * 512 + col0) = w; }
    }
};
struct EpiM2 {
    static constexpr bool HAS_MID = false;
    unsigned char* Y;
    DI void operator()(Acc& acc, const Unit& u, int wr, int wc, int fr, int fq) const {
        const int row0 = u.pm * BM + wr * 64 + fr, col0 = u.pn * BM + wc * 32 + 8 * fq;
        constexpr float inv = FP8_SY / (FP8_SH * FP8_SW);
#pragma unroll
        for (int ai = 0; ai < 2; ++ai)
#pragma unroll
            for (int m = 0; m < 4; ++m) { unsigned char* rp = Y + (size_t)(row0 + ai * HALF + m * 16) * 1024 + col0;
#pragma unroll
                for (int bj = 0; bj < 2; ++bj) { const f32x4 v0 = acc[ai][bj][m][0] * inv, v1 = acc[ai][bj][m][1] * inv; u32x2 w; w.x = cvt4_fp8(v0[0], v0[1], v0[2], v0[3]); w.y = cvt4_fp8(v1[0], v1[1], v1[2], v1[3]); *(u32x2*)(rp + bj * HALF) = w; } }
    }
};
}

struct Args { const float* in[19]; float* out; unsigned char* ws; int ph_lo, ph_hi; };
enum { I_X = 0, I_WIN, I_BIN, I_LBL, I_HGNG, I_RELB, I_WPA, I_WPB, I_WOUT, I_LN1G, I_LN1B, I_WGRP, I_BGRP, I_WEXP, I_BEXP, I_WGU, I_WDN, I_LN2G, I_LN2B };

struct Ctx {
    LAS unsigned char* lds; volatile LAS unsigned* MISC;
    int tid, lane, wid, G, vcu;
    unsigned char* ws; gu32* ctl;
};

DI int win_drow(int n0) { if (n0 < 512) return 256 * (n0 >> 7) + (n0 & 127); if (n0 < 1024) { const int r = n0 - 512; return 256 * (r >> 7) + 128 + (r & 127); }
    if (n0 < 3584) return n0; if (n0 < 4608) { const int r = n0 - 3584; return 3584 + 256 * (r >> 7) + (r & 127); } const int r = n0 - 4608; return 3584 + 256 * (r >> 7) + 128 + (r & 127); }
DI int wgu_drow(int n0) { if (n0 < 512) return 256 * (n0 >> 7) + (n0 & 127); const int r = n0 - 512; return 256 * (r >> 7) + 128 + (r & 127); }
DI int hswz(int row, int ch16) { return 256 * row + 16 * (ch16 ^ (((row & 3) << 2) | ((row >> 2) & 3))); }
DI int htr(int r0, int c0, int lane) { const int i16 = lane & 15, q = i16 >> 2, p = i16 & 3; return hswz(r0 + q, c0 + (p >> 1)) + 8 * (p & 1); }
DI void transpose_tile256(const float* W, int N, bf16* WT, int ldk, int n0, int mode, int dk, LAS unsigned char* lds, int lane, int wid, bool f8 = false) {
    asm volatile("" : "+v"(lane));
#pragma unroll
    for (int half = 0; half < 2; ++half) { f32x4 v[16];
#pragma unroll
        for (int i = 0; i < 16; ++i) v[i] = *(const f32x4*)(W + (size_t)(128 * half + 8 * i + wid) * N + 4 * lane);
#pragma unroll
        for (int i = 0; i < 16; ++i) { const int k = 128 * half + 8 * i + wid; u32x2 w; w.x = cvtpk(v[i][0], v[i][1]); w.y = cvtpk(v[i][2], v[i][3]);
            *(LAS u32x2*)(lds + (lane >> 5) * 65536 + hswz(k, (lane & 31) >> 1) + 8 * (lane & 1)) = w; } }
    __syncthreads();
    const int g = lane >> 4, i16 = lane & 15;
#pragma unroll
    for (int nb = 0; nb < 2; ++nb) { const int nl = 32 * wid + 16 * nb + i16, n = n0 + nl; const int dr = (mode == 0) ? n : (mode == 1 ? win_drow(n) : wgu_drow(n));
        bf16* orow = WT + (size_t)dr * ldk + dk + 8 * g; const LAS unsigned char* img = lds + (wid >> 2) * 65536;
#pragma unroll
        for (int s = 0; s < 8; ++s) { const int r0 = 32 * s + 8 * g, c0 = 4 * (wid & 3) + 2 * nb;
            const s16x4 lo = vtr((LAS const char*)(img + htr(r0, c0, lane))), hh = vtr((LAS const char*)(img + htr(r0 + 4, c0, lane)));
            if (f8) { u32x2 w; w.x = cvt4_fp8(bf2f((unsigned short)lo[0]) * FP8_SW, bf2f((unsigned short)lo[1]) * FP8_SW, bf2f((unsigned short)lo[2]) * FP8_SW, bf2f((unsigned short)lo[3]) * FP8_SW);
                w.y = cvt4_fp8(bf2f((unsigned short)hh[0]) * FP8_SW, bf2f((unsigned short)hh[1]) * FP8_SW, bf2f((unsigned short)hh[2]) * FP8_SW, bf2f((unsigned short)hh[3]) * FP8_SW);
                *(u32x2*)((unsigned char*)WT + (size_t)dr * ldk + dk + 8 * g + 32 * s) = w; }
            else *(bf16x8*)(orow + 32 * s) = (bf16x8){lo[0], lo[1], lo[2], lo[3], hh[0], hh[1], hh[2], hh[3]}; } }
    __syncthreads();
}
constexpr int MOE_CVT_TILES = 32 * 16 + 32 * 8;
DI void moe_cvt_tile(const Ctx& C, const Args& a, int it) {
    unsigned char* WguT = (unsigned char*)a.out; unsigned char* WdT = (unsigned char*)a.out + 32 * MiB;
    if (it < 512) { const int e = it >> 4, kt = (it >> 2) & 3, nt = it & 3;
        transpose_tile256(a.in[I_WGU] + (size_t)e * 1024 * 1024 + (size_t)(256 * kt) * 1024 + 256 * nt, 1024, (bf16*)(WguT + (size_t)e * 1024 * 1024), 1024, 256 * nt, 2, 256 * kt, C.lds, C.lane, C.wid, true); }
    else { const int r = it - 512, e = r >> 3, kt = (r >> 2) & 1, nt = r & 3;
        transpose_tile256(a.in[I_WDN] + (size_t)e * 512 * 1024 + (size_t)(256 * kt) * 1024 + 256 * nt, 1024, (bf16*)(WdT + (size_t)e * 1024 * 512), 512, 256 * nt, 0, 256 * kt, C.lds, C.lane, C.wid, true); }
}
DI void p0_prologue(const Ctx& C, const Args& a) {
    bf16* WinT = (bf16*)(C.ws + WS_WIN); bf16* Wcat = (bf16*)(C.ws + WS_WCAT); bf16* WoT = (bf16*)(C.ws + WS_WO);
    constexpr int I_IN = 4 * 22, I_PA = 2 * 4, I_O = 4 * 4, NITEMS = I_IN + 2 * I_PA + I_O;
    for (int it = C.vcu; it < NITEMS; it += C.G) {
        int r = it;
        if (r < I_IN) { const int kt = r / 22, nt = r % 22;
            if (nt < 8) transpose_tile256(a.in[I_WIN] + (size_t)(256 * kt) * NIN + 256 * nt, NIN, WinT, 1024, 256 * nt, 1, 256 * kt, C.lds, C.lane, C.wid);
            else transpose_tile256(a.in[I_WIN] + (size_t)(256 * kt) * NIN + 256 * nt, NIN, (bf16*)(C.ws + WS_WIN + 4 * MiB - (size_t)2048 * 1024), 1024, 256 * nt, 1, 256 * kt, C.lds, C.lane, C.wid, true);
            continue; } r -= I_IN;
        if (r < I_PA) { const int kt = r / 4, nt = r % 4; transpose_tile256(a.in[I_WPA] + (size_t)(256 * kt) * 1024 + 256 * nt, 1024, Wcat, 1024, 256 * nt, 0, 256 * kt, C.lds, C.lane, C.wid, true); continue; } r -= I_PA;
        if (r < I_PA) { const int kt = r / 4, nt = r % 4; transpose_tile256(a.in[I_WPB] + (size_t)(256 * kt) * 1024 + 256 * nt, 1024, Wcat, 1024, 256 * nt, 0, 512 + 256 * kt, C.lds, C.lane, C.wid, true); continue; } r -= I_PA;
        { const int kt = r / 4, nt = r % 4; transpose_tile256(a.in[I_WOUT] + (size_t)(256 * kt) * 1024 + 256 * nt, 1024, WoT, 1024, 256 * nt, 0, 256 * kt, C.lds, C.lane, C.wid, true); }
    }
    const int gw = C.vcu * NWAVES + C.wid, NGW = C.G * NWAVES; (void)gw; (void)NGW;
    const int gt = C.vcu * NTHREADS + C.tid, NT = C.G * NTHREADS;
    { const float* x = a.in[I_X]; bf16* Xb = (bf16*)(C.ws + WS_XB);
      unsigned char* Xq = (unsigned char*)a.out + 64 * MiB;
      for (int i = gt; i < NTOK * DM / 8; i += NT) { const f32x4 v0 = *(const f32x4*)(x + (size_t)i * 8), v1 = *(const f32x4*)(x + (size_t)i * 8 + 4); *(u32x4*)(Xb + (size_t)i * 8) = pg8::pack8(v0, v1);
          u32x2 q; q.x = cvt4_fp8(v0[0] * FP8_SXI, v0[1] * FP8_SXI, v0[2] * FP8_SXI, v0[3] * FP8_SXI); q.y = cvt4_fp8(v1[0] * FP8_SXI, v1[1] * FP8_SXI, v1[2] * FP8_SXI, v1[3] * FP8_SXI); *(u32x2*)(Xq + (size_t)i * 8) = q; } }
    { float* lbp = (float*)(C.ws + WS_LB); for (int n = gt; n < 512; n += NT) lbp[n] = 1.f / (1.f + expf(a.in[I_LBL][512 + n] - a.in[I_LBL][n])); }
    { float* bp = (float*)(C.ws + WS_BPERM); const float* bin = a.in[I_BIN];
      for (int n = gt; n < NIN; n += NT) bp[win_drow(n & ~31) + (n & 31)] = bin[n]; }
    { bf16* wh = (bf16*)(C.ws + WS_WRH); bf16* wl = (bf16*)(C.ws + WS_WRL); const float* wg = a.in[I_WGRP]; const float* we = a.in[I_WEXP];
      for (int i = gt; i < 48 * 1024; i += NT) { const int j = i >> 10, k = i & 1023; float w = 0.f; if (j < 4) w = wg[k * 4 + j]; else if (j < 36) w = we[k * 32 + (j - 4)];
          const unsigned h = cvtpk(w, 0.f) & 0xffffu; const float r = w - bf2f((unsigned short)h); wh[i] = (bf16)h; wl[i] = (bf16)(cvtpk(r, 0.f) & 0xffffu); } }
}
constexpr int HG_BUF = 67072, HG_QP = 0, HG_KP = 16384, HG_V = 32768, HG_SC = 49152, HG_OB = 49664;
DI void hgrn_unit(const Ctx& C, const Args& a, int b, int h) {
    LAS unsigned char* L = C.lds;
    const int tid = C.tid, lane = C.lane, wid = C.wid;
    const int q32 = lane & 31, hi = lane >> 5, dh = (lane >> 4) & 1, dvb = wid & 3, tb = wid >> 2;
    const float* BM = (const float*)(C.ws + WS_ZF); const float* BE = BM + 262144;
    const bf16* Qh = (const bf16*)(C.ws + WS_QH); const bf16* Kh = (const bf16*)(C.ws + WS_KK); const bf16* Vh = (const bf16*)(C.ws + WS_VH); const bf16* Gh = (const bf16*)(C.ws + WS_GH);
    bf16* Ocat = (bf16*)(C.ws + WS_OCAT);
    const size_t rb = (size_t)b * SEQ;
    LAS float* NGS = (LAS float*)(L + 2 * HG_BUF);
    if (tid < 128) NGS[tid] = a.in[I_HGNG][h * 128 + tid];
    const int orow = tid >> 3, oseg = tid & 7;
    f32x16 T[4];
#pragma unroll
    for (int i = 0; i < 4; ++i)
#pragma unroll
        for (int r = 0; r < 16; ++r) T[i][r] = 0.f;
    u32x4 gr[2];
    const int drow = 8 * wid + (lane >> 4), dch = lane & 15;
#define HG_DMA(c) do { _Pragma("unroll") for (int p = 0; p < 2; ++p) { const int r_ = drow + 4 * p; const int sc_ = dch ^ (((r_ & 3) << 2) | ((r_ >> 2) & 3)); \
            const size_t g_ = (rb + (size_t)(c) * 64 + r_) * 512 + h * 128 + 8 * sc_; LAS unsigned char* d_ = L + ((c) & 1) * HG_BUF + (8 * wid + 4 * p) * 256; \
            __builtin_amdgcn_global_load_lds((const unsigned*)(Qh + g_), (LAS unsigned*)(d_ + HG_QP), 16, 0, 0); \
            __builtin_amdgcn_global_load_lds((const unsigned*)(Kh + g_), (LAS unsigned*)(d_ + HG_KP), 16, 0, 0); \
            __builtin_amdgcn_global_load_lds((const unsigned*)(Vh + g_), (LAS unsigned*)(d_ + HG_V), 16, 0, 0); } } while (0)
    float sm = 0.f, spe = 0.f, spm = 0.f;
#define HG_SCLOAD(c) do { if (tid < 128) { const size_t s_ = (size_t)(b * 32 + (c)) * 512 + h * 128 + tid; sm = BM[s_]; if ((c) > 0) { spe = BE[s_ - 512]; spm = BM[s_ - 512]; } } } while (0)
#define HG_SCALE(c) do { if (tid < 128) ((LAS float*)(L + ((c) & 1) * HG_BUF + HG_SC))[tid] = __expf(sm + (spe - spm)); } while (0)
    HG_DMA(0);
    HG_SCLOAD(0);
    HG_SCALE(0);
    asm volatile("s_waitcnt vmcnt(0)" ::: "memory");
    __syncthreads();
    for (int c = 0; c < 32; ++c) {
        const LAS unsigned char* B = L + (c & 1) * HG_BUF;
        if (c + 1 < 32) { HG_DMA(c + 1); HG_SCLOAD(c + 1); }
        int q32o = q32, hio = hi, laneo = lane; asm volatile("" : "+v"(q32o), "+v"(hio), "+v"(laneo));
        f32x16 oT;
#pragma unroll
        for (int r = 0; r < 16; ++r) oT[r] = 0.f;
        bf16x8 qb[8];
#pragma unroll
        for (int ks = 0; ks < 8; ++ks) qb[ks] = *(const LAS bf16x8*)(B + HG_QP + hswz(32 * tb + q32o, 2 * ks + hio));
#pragma unroll
        for (int sb = 0; sb < 2; ++sb) {
            if (sb <= tb) {
                bf16x8 ka[8];
#pragma unroll
                for (int ks = 0; ks < 8; ++ks) ka[ks] = *(const LAS bf16x8*)(B + HG_KP + hswz(32 * sb + q32o, 2 * ks + hio));
                s16x4 vl[2], vh[2];
#pragma unroll
                for (int s2 = 0; s2 < 2; ++s2) { const int r0 = 32 * sb + 16 * s2 + 4 * hio; vl[s2] = vtr((LAS const char*)(B + HG_V + htr(r0, 4 * dvb + 2 * dh, laneo))); vh[s2] = vtr((LAS const char*)(B + HG_V + htr(r0 + 8, 4 * dvb + 2 * dh, laneo))); }
                __builtin_amdgcn_sched_barrier(0);
                f32x16 pT;
#pragma unroll
                for (int r = 0; r < 16; ++r) pT[r] = 0.f;
#pragma unroll
                for (int ks = 0; ks < 8; ++ks) pT = MFMA32(ka[ks], qb[ks], pT);
                if (sb == tb) {
#pragma unroll
                    for (int r = 0; r < 16; ++r) if (crow(r, hi) > q32) pT[r] = 0.f;
                }
#pragma unroll
                for (int s2 = 0; s2 < 2; ++s2) { u32x4 pw; pw.x = cvtpk(pT[8 * s2 + 0], pT[8 * s2 + 1]); pw.y = cvtpk(pT[8 * s2 + 2], pT[8 * s2 + 3]); pw.z = cvtpk(pT[8 * s2 + 4], pT[8 * s2 + 5]); pw.w = cvtpk(pT[8 * s2 + 6], pT[8 * s2 + 7]);
                    oT = MFMA32(((bf16x8){vl[s2][0], vl[s2][1], vl[s2][2], vl[s2][3], vh[s2][0], vh[s2][1], vh[s2][2], vh[s2][3]}), __builtin_bit_cast(bf16x8, pw), oT); }
                __builtin_amdgcn_sched_barrier(0);
            }
        }
        { const size_t g0 = (rb + (size_t)c * 64 + orow) * 512 + h * 128 + 16 * oseg; gr[0] = *(const u32x4*)(Gh + g0); gr[1] = *(const u32x4*)(Gh + g0 + 8); }
        {
            u32x2 qq0[8], qq1[8];
            if (c > 0) {
#pragma unroll
                for (int i = 0; i < 4; ++i)
#pragma unroll
                    for (int s = 0; s < 2; ++s) { qq0[2 * i + s] = *(const LAS u32x2*)(B + HG_QP + hswz(32 * tb + q32o, 4 * i + 2 * s) + 8 * hio); qq1[2 * i + s] = *(const LAS u32x2*)(B + HG_QP + hswz(32 * tb + q32o, 4 * i + 2 * s + 1) + 8 * hio); }
            }
#pragma unroll
            for (int i = 0; i < 4; ++i)
#pragma unroll
                for (int g = 0; g < 4; ++g) { const f32x4 sc = *(const LAS f32x4*)(B + HG_SC + (32 * i + 8 * g + 4 * hio) * 4);
#pragma unroll
                    for (int j = 0; j < 4; ++j) T[i][4 * g + j] *= sc[j]; }
            __builtin_amdgcn_sched_barrier(0);
            if (c > 0) {
#pragma unroll
                for (int i = 0; i < 4; ++i)
#pragma unroll
                    for (int s = 0; s < 2; ++s) { u32x4 tw; tw.x = cvtpk(T[i][8 * s + 0], T[i][8 * s + 1]); tw.y = cvtpk(T[i][8 * s + 2], T[i][8 * s + 3]); tw.z = cvtpk(T[i][8 * s + 4], T[i][8 * s + 5]); tw.w = cvtpk(T[i][8 * s + 6], T[i][8 * s + 7]);
                        const u32x4 qw = (u32x4){qq0[2 * i + s].x, qq0[2 * i + s].y, qq1[2 * i + s].x, qq1[2 * i + s].y};
                        oT = MFMA32(__builtin_bit_cast(bf16x8, tw), __builtin_bit_cast(bf16x8, qw), oT); }
            }
        }
        { LAS unsigned char* OBp = L + (c & 1) * HG_BUF + HG_OB;
#pragma unroll
          for (int g = 0; g < 4; ++g) { u32x2 w; w.x = cvtpk(oT[4 * g], oT[4 * g + 1]); w.y = cvtpk(oT[4 * g + 2], oT[4 * g + 3]); *(LAS u32x2*)(OBp + (32 * tb + q32o) * 272 + (32 * dvb + 8 * g + 4 * hio) * 2) = w; } }
#pragma unroll
        for (int sp = 0; sp < 2; ++sp) {
            s16x4 vl[2], vh[2], kl[2][4], kh[2][4];
#pragma unroll
            for (int u = 0; u < 2; ++u) { const int r0 = 16 * (2 * sp + u) + 8 * hio;
                vl[u] = vtr((LAS const char*)(B + HG_V + htr(r0, 4 * dvb + 2 * dh, laneo))); vh[u] = vtr((LAS const char*)(B + HG_V + htr(r0 + 4, 4 * dvb + 2 * dh, laneo)));
#pragma unroll
                for (int i = 0; i < 4; ++i) { kl[u][i] = vtr((LAS const char*)(B + HG_KP + htr(r0, 4 * i + 2 * dh, laneo))); kh[u][i] = vtr((LAS const char*)(B + HG_KP + htr(r0 + 4, 4 * i + 2 * dh, laneo))); } }
            __builtin_amdgcn_sched_barrier(0);
#pragma unroll
            for (int u = 0; u < 2; ++u) { const bf16x8 vb = (bf16x8){vl[u][0], vl[u][1], vl[u][2], vl[u][3], vh[u][0], vh[u][1], vh[u][2], vh[u][3]};
#pragma unroll
                for (int i = 0; i < 4; ++i) T[i] = MFMA32(((bf16x8){kl[u][i][0], kl[u][i][1], kl[u][i][2], kl[u][i][3], kh[u][i][0], kh[u][i][1], kh[u][i][2], kh[u][i][3]}), vb, T[i]); }
            __builtin_amdgcn_sched_barrier(0);
        }
        if (c + 1 < 32) HG_SCALE(c + 1);
        asm volatile("s_waitcnt vmcnt(0)" ::: "memory");
        __syncthreads();
        { const LAS unsigned char* OBp = L + (c & 1) * HG_BUF + HG_OB + orow * 272 + oseg * 32;
          const u32x4 o0 = *(const LAS u32x4*)OBp, o1 = *(const LAS u32x4*)(OBp + 16);
          float ov[16];
          ov[0] = bflo(o0.x); ov[1] = bfhi(o0.x); ov[2] = bflo(o0.y); ov[3] = bfhi(o0.y); ov[4] = bflo(o0.z); ov[5] = bfhi(o0.z); ov[6] = bflo(o0.w); ov[7] = bfhi(o0.w);
          ov[8] = bflo(o1.x); ov[9] = bfhi(o1.x); ov[10] = bflo(o1.y); ov[11] = bfhi(o1.y); ov[12] = bflo(o1.z); ov[13] = bfhi(o1.z); ov[14] = bflo(o1.w); ov[15] = bfhi(o1.w);
          float ss = 0.f;
#pragma unroll
          for (int j = 0; j < 16; ++j) ss += ov[j] * ov[j];
          ss += __int_as_float(__builtin_amdgcn_update_dpp(0, __float_as_int(ss), 0xB1, 0xf, 0xf, true));
          ss += __int_as_float(__builtin_amdgcn_update_dpp(0, __float_as_int(ss), 0x4E, 0xf, 0xf, true));
          ss += __int_as_float(__builtin_amdgcn_update_dpp(0, __float_as_int(ss), 0x141, 0xf, 0xf, true));
          const float rs = __builtin_amdgcn_rsqf(ss * (1.f / 128.f) + LN_EPS);
          float ng[16];
#pragma unroll
          for (int i = 0; i < 4; ++i) { const f32x4 n_ = *(const LAS f32x4*)(NGS + 16 * oseg + 4 * i); ng[4 * i] = n_[0]; ng[4 * i + 1] = n_[1]; ng[4 * i + 2] = n_[2]; ng[4 * i + 3] = n_[3]; }
          float gvv[16];
          gvv[0] = bflo(gr[0].x); gvv[1] = bfhi(gr[0].x); gvv[2] = bflo(gr[0].y); gvv[3] = bfhi(gr[0].y); gvv[4] = bflo(gr[0].z); gvv[5] = bfhi(gr[0].z); gvv[6] = bflo(gr[0].w); gvv[7] = bfhi(gr[0].w);
          gvv[8] = bflo(gr[1].x); gvv[9] = bfhi(gr[1].x); gvv[10] = bflo(gr[1].y); gvv[11] = bfhi(gr[1].y); gvv[12] = bflo(gr[1].z); gvv[13] = bfhi(gr[1].z); gvv[14] = bflo(gr[1].w); gvv[15] = bfhi(gr[1].w);
          float rv[16];
#pragma unroll
          for (int j = 0; j < 16; ++j) rv[j] = ov[j] * (rs * FP8_SO) * ng[j] * gvv[j];
          u32x4 w0; w0.x = cvt4_fp8(rv[0], rv[1], rv[2], rv[3]); w0.y = cvt4_fp8(rv[4], rv[5], rv[6], rv[7]); w0.z = cvt4_fp8(rv[8], rv[9], rv[10], rv[11]); w0.w = cvt4_fp8(rv[12], rv[13], rv[14], rv[15]);
          unsigned char* op = (unsigned char*)Ocat + (rb + (size_t)c * 64 + orow) * 1024 + h * 128 + 16 * oseg;
          *(u32x4*)op = w0; }
    }
    __syncthreads();
#undef HG_DMA
#undef HG_SCALE
#undef HG_SCLOAD
}

constexpr int AT_NST = 4, AT_K = 0, AT_V = AT_NST * 8192, AT_KM = 2 * AT_NST * 8192, AT_TAB = AT_KM + 1792;
DI int t5_bucket(int d) { if (d < 16) return d; const int v = 16 + (int)(logf((float)d * (1.f / 16.f)) / logf(8.f) * 16.f); return v < 31 ? v : 31; }
DI void glds16(const void* gsrc, unsigned lds_dst) { unsigned keep;
    asm volatile("s_mov_b32 %0, m0\n\ts_mov_b32 m0, %2\n\ts_nop 0\n\tglobal_load_lds_dwordx4 %1, off\n\ts_mov_b32 m0, %0" : "=&s"(keep) : "v"(gsrc), "s"(lds_dst) : "memory"); }
DI void attn_unit(const Ctx& C, const Args& a, int b, int h, int jq) {
    LAS unsigned char* L = C.lds;
    const int tid = C.tid, lane = C.lane, wid = C.wid, q32 = lane & 31, hi = lane >> 5;
    const bf16* Qm = (const bf16*)(C.ws + WS_QM); const bf16* Km = (const bf16*)(C.ws + WS_KM); const bf16* Vm = (const bf16*)(C.ws + WS_VM); const float* KM = (const float*)(C.ws + WS_KMEAN);
    bf16* Ocat = (bf16*)(C.ws + WS_OCAT);
    const int tq = jq * 256 + wid * 32 + q32;
    const size_t hb = (size_t)(b * 8 + h) * SEQ;
    bf16x8 qf[4];
#pragma unroll
    for (int ks = 0; ks < 4; ++ks) qf[ks] = *(const bf16x8*)(Qm + (hb + tq) * 64 + 16 * ks + 8 * hi);
    LAS float* kml = (LAS float*)(L + AT_KM); LAS float* tab = (LAS float*)(L + AT_TAB);
    if (tid < jq * 64) { const int n = tid >> 6, d = tid & 63; kml[tid] = KM[(size_t)((b * 8 + n) * 2 + 0) * 512 + h * 64 + d] + KM[(size_t)((b * 8 + n) * 2 + 1) * 512 + h * 64 + d]; }
    if (tid < 129) tab[tid] = (a.in[I_RELB][t5_bucket(tid) * 8 + h] - a.in[I_RELB][31 * 8 + h]) * LOG2E;
    const int drow = 8 * wid + (lane >> 3), dch = lane & 7;
    const bf16* ksrc = Km + (hb + drow) * 64 + 8 * (dch ^ ((drow >> 1) & 7));
    const bf16* vsrc = Vm + (hb + drow) * 64 + 8 * (dch ^ (((drow >> 1) & 1) << 2));
    const unsigned kdst = (unsigned)__builtin_amdgcn_readfirstlane((int)(unsigned)(size_t)(L + AT_K + wid * 1024)), vdst = (unsigned)__builtin_amdgcn_readfirstlane((int)(unsigned)(size_t)(L + AT_V + wid * 1024));
    const int nt = 4 * jq + 4;
#define AT_ISSUE(t) do { glds16(ksrc + (size_t)(t) * 4096, kdst + ((t) & 3) * 8192); glds16(vsrc + (size_t)(t) * 4096, vdst + ((t) & 3) * 8192); } while (0)
    AT_ISSUE(0); AT_ISSUE(1); AT_ISSUE(2);
    __syncthreads();
    unsigned sel = 0;
    {
        float g[7];
#pragma unroll
        for (int n = 0; n < 7; ++n) { g[n] = 0.f;
            if (n < jq) { float s = 0.f;
#pragma unroll
                for (int ks = 0; ks < 4; ++ks)
#pragma unroll
                    for (int j = 0; j < 8; ++j) s += bf2f((unsigned short)qf[ks][j]) * kml[n * 64 + 16 * ks + 8 * hi + j];
                s += __shfl_xor(s, 32); g[n] = s; } }
#pragma unroll
        for (int n = 0; n < 7; ++n) if (n < jq) { int rank = 0;
#pragma unroll
            for (int m = 0; m < 7; ++m) if (m != n && m < jq) rank += (g[m] > g[n] || (g[m] == g[n] && m < n)) ? 1 : 0;
            if (rank < 3) sel |= 1u << n; }
    }
    const float c31 = a.in[I_RELB][31 * 8 + h] * LOG2E;
    float lrun = 0.f;
    f32x16 negm;
#pragma unroll
    for (int r = 0; r < 16; ++r) negm[r] = c31;
    f32x16 o0, o1;
#pragma unroll
    for (int r = 0; r < 16; ++r) { o0[r] = 0.f; o1[r] = 0.f; }
    const int i16 = lane & 15, qq = i16 >> 2, pp = i16 & 3, dh = (lane >> 4) & 1, xsw = (qq >> 1) & 1;
    const int vb0 = (4 * hi + qq) * 128 + 64 * (0 ^ xsw) + 32 * dh + 8 * pp, vb1 = (4 * hi + qq) * 128 + 64 * (1 ^ xsw) + 32 * dh + 8 * pp;
    const int kxs = (q32 >> 1) & 7;
    for (int kt = 0; kt < nt; ++kt) {
        if (kt + 2 < nt) asm volatile("s_waitcnt vmcnt(4)" ::: "memory"); else if (kt + 1 < nt) asm volatile("s_waitcnt vmcnt(2)" ::: "memory"); else asm volatile("s_waitcnt vmcnt(0)" ::: "memory");
        __builtin_amdgcn_s_barrier();
        asm volatile("" ::: "memory");
        if (kt + 3 < nt) AT_ISSUE(kt + 3);
        const int blk = kt >> 2; const bool own = (blk == jq);
        const bool active = !own || ((kt & 3) * 64 <= wid * 32 + 31);
        if (active) {
            const LAS unsigned char* Kc = L + AT_K + (kt & 3) * 8192; const LAS unsigned char* Vc = L + AT_V + (kt & 3) * 8192;
            bf16x8 kf[8];
#pragma unroll
            for (int ks = 0; ks < 4; ++ks) { const int ko = (((2 * ks + hi) ^ kxs) << 4); kf[2 * ks] = *(const LAS bf16x8*)(Kc + q32 * 128 + ko); kf[2 * ks + 1] = *(const LAS bf16x8*)(Kc + (32 + q32) * 128 + ko); }
            __builtin_amdgcn_sched_barrier(0);
            f32x16 s0 = negm, s1 = negm;
#pragma unroll
            for (int ks = 0; ks < 4; ++ks) { s0 = MFMA32(kf[2 * ks], qf[ks], s0); s1 = MFMA32(kf[2 * ks + 1], qf[ks], s1); }
            __builtin_amdgcn_sched_barrier(0);
            s16x4 vf[2][4][2];
#pragma unroll
            for (int j = 0; j < 4; ++j) { const int ro = 16 * j * 128;
                vf[0][j][0] = vtr((LAS const char*)(Vc + vb0 + ro)); vf[0][j][1] = vtr((LAS const char*)(Vc + vb0 + ro + 8 * 128));
                vf[1][j][0] = vtr((LAS const char*)(Vc + vb1 + ro)); vf[1][j][1] = vtr((LAS const char*)(Vc + vb1 + ro + 8 * 128)); }
            __builtin_amdgcn_sched_barrier(0);
            const bool near = (jq * 256 + wid * 32 - 64 * kt - 63) < 128;
            if (near) {
                const int dist0 = tq - 64 * kt - 4 * hi;
#pragma unroll
                for (int r = 0; r < 16; ++r) { const int d0 = dist0 - ((r & 3) + 8 * (r >> 2)), d1 = d0 - 32;
                    const int i0 = d0 < 0 ? 0 : (d0 > 128 ? 128 : d0), i1 = d1 < 0 ? 0 : (d1 > 128 ? 128 : d1);
                    const float t0 = tab[i0], t1 = tab[i1]; s0[r] += t0; s1[r] += t1; s0[r] = d0 < 0 ? -INFINITY : s0[r]; s1[r] = d1 < 0 ? -INFINITY : s1[r]; }
            }
            const bool lsel = own || ((sel >> blk) & 1u);
            float mx = fmaxf(fmaxf(s0[0], s1[0]), fmaxf(s0[1], s1[1]));
#pragma unroll
            for (int r = 2; r < 16; r += 2) mx = fmaxf(mx, fmaxf(fmaxf(s0[r], s1[r]), fmaxf(s0[r + 1], s1[r + 1])));
            mx = lsel ? mx : -INFINITY;
            mx = fmaxf(mx, __shfl_xor(mx, 32));
            if (__any(mx > 4.0f)) {
                const float delta = fmaxf(mx, 0.f), alpha = __builtin_amdgcn_exp2f(-delta);
                lrun *= alpha;
#pragma unroll
                for (int r = 0; r < 16; ++r) { o0[r] *= alpha; o1[r] *= alpha; negm[r] -= delta; s0[r] -= delta; s1[r] -= delta; }
            }
            float ps = 0.f;
#pragma unroll
            for (int r = 0; r < 16; ++r) { s0[r] = __builtin_amdgcn_exp2f(s0[r]); s1[r] = __builtin_amdgcn_exp2f(s1[r]); ps += s0[r] + s1[r]; }
            lrun += lsel ? ps : 0.f;
            const unsigned pmask = lsel ? 0xffffffffu : 0u;
#pragma unroll
            for (int kb = 0; kb < 2; ++kb)
#pragma unroll
                for (int s2 = 0; s2 < 2; ++s2) {
                    u32x4 pw;
                    if (kb == 0) { pw.x = cvtpk(s0[8 * s2 + 0], s0[8 * s2 + 1]); pw.y = cvtpk(s0[8 * s2 + 2], s0[8 * s2 + 3]); pw.z = cvtpk(s0[8 * s2 + 4], s0[8 * s2 + 5]); pw.w = cvtpk(s0[8 * s2 + 6], s0[8 * s2 + 7]); }
                    else         { pw.x = cvtpk(s1[8 * s2 + 0], s1[8 * s2 + 1]); pw.y = cvtpk(s1[8 * s2 + 2], s1[8 * s2 + 3]); pw.z = cvtpk(s1[8 * s2 + 4], s1[8 * s2 + 5]); pw.w = cvtpk(s1[8 * s2 + 6], s1[8 * s2 + 7]); }
                    pw.x &= pmask; pw.y &= pmask; pw.z &= pmask; pw.w &= pmask;
                    const bf16x8 pf = __builtin_bit_cast(bf16x8, pw);
                    const s16x4 a0l = vf[0][2 * kb + s2][0], a0h = vf[0][2 * kb + s2][1], a1l = vf[1][2 * kb + s2][0], a1h = vf[1][2 * kb + s2][1];
                    o0 = MFMA32(((bf16x8){a0l[0], a0l[1], a0l[2], a0l[3], a0h[0], a0h[1], a0h[2], a0h[3]}), pf, o0);
                    o1 = MFMA32(((bf16x8){a1l[0], a1l[1], a1l[2], a1l[3], a1h[0], a1h[1], a1h[2], a1h[3]}), pf, o1);
                }
        }
    }
    const float linv = 1.f / (lrun + __shfl_xor(lrun, 32));
    unsigned char* op = (unsigned char*)Ocat + ((size_t)b * SEQ + tq) * 1024 + 512 + h * 64;
    const float lsc = linv * FP8_SO;
#pragma unroll
    for (int g = 0; g < 4; ++g) { *(unsigned*)(op + 8 * g + 4 * hi) = cvt4_fp8(o0[4 * g] * lsc, o0[4 * g + 1] * lsc, o0[4 * g + 2] * lsc, o0[4 * g + 3] * lsc);
        *(unsigned*)(op + 32 + 8 * g + 4 * hi) = cvt4_fp8(o1[4 * g] * lsc, o1[4 * g + 1] * lsc, o1[4 * g + 2] * lsc, o1[4 * g + 3] * lsc); }
    __syncthreads();
#undef AT_ISSUE
}

#ifndef PROBE_HGX
#define PROBE_HGX 1
#endif
#ifndef PROBE_ATX
#define PROBE_ATX 1
#endif
#ifndef STAMP_SEL
#define STAMP_SEL -1
#endif
#define STAMP(i) do { if (STAMP_SEL >= 0 && blockIdx.x == 0 && C.tid == 0) { const unsigned long long t_ = __builtin_amdgcn_s_memrealtime(); C.MISC[16 + 2 * (i)] = (unsigned)t_; C.MISC[17 + 2 * (i)] = (unsigned)(t_ >> 32); } } while (0)
DI void p2_mixers(const Ctx& C, const Args& a, int rep) {
    for (int hx = 0; hx < PROBE_HGX; ++hx)
    for (int u = blockIdx.x; u < 64; u += C.G) hgrn_unit(C, a, u >> 2, u & 3);
    STAMP(11);
    unsigned* QA = (unsigned*)(C.ctl + CW_QUEUE + 64 * rep); unsigned* QC = (unsigned*)(C.ctl + CW_QUEUE2 + 64 * rep);
    constexpr int NA = 1024 * PROBE_ATX, NC = MOE_CVT_TILES;
    if (C.tid == 0) { C.MISC[0] = __hip_atomic_fetch_add(QA, 1u, __ATOMIC_RELAXED, __HIP_MEMORY_SCOPE_AGENT); C.MISC[1] = (rep == 0) ? __hip_atomic_fetch_add(QC, 1u, __ATOMIC_RELAXED, __HIP_MEMORY_SCOPE_AGENT) : (unsigned)NC; }
    __syncthreads();
    int qa = (int)C.MISC[0], qc = (int)C.MISC[1];
    __syncthreads();
    for (;;) {
        const bool doa = qa < NA, doc = qc < NC;
        if (!doa && !doc) break;
        unsigned na = (unsigned)NA, nc = (unsigned)NC;
        if (C.tid == 0) { if (doa) na = __hip_atomic_fetch_add(QA, 1u, __ATOMIC_RELAXED, __HIP_MEMORY_SCOPE_AGENT); if (doc) nc = __hip_atomic_fetch_add(QC, 1u, __ATOMIC_RELAXED, __HIP_MEMORY_SCOPE_AGENT); }
#ifdef STAMP_ACC
        unsigned long long ta_ = 0, tb_ = 0, tc_ = 0; if (C.tid == 0) ta_ = __builtin_amdgcn_s_memrealtime();
#endif
        if (doa) { const int q = qa / PROBE_ATX; attn_unit(C, a, (q & 127) >> 3, q & 7, 7 - (q >> 7)); }
#ifdef STAMP_ACC
        if (C.tid == 0) tb_ = __builtin_amdgcn_s_memrealtime();
#endif
        if (doc) moe_cvt_tile(C, a, qc);
#ifdef STAMP_ACC
        if (C.tid == 0 && blockIdx.x == 100) { tc_ = __builtin_amdgcn_s_memrealtime(); const unsigned long long d_ = (STAMP_ACC == 0) ? (tb_ - ta_) : (tc_ - tb_);
            const unsigned long long o_ = ((unsigned long long)C.MISC[45] << 32) | C.MISC[44]; const unsigned long long n_ = o_ + d_; C.MISC[44] = (unsigned)n_; C.MISC[45] = (unsigned)(n_ >> 32); }
#endif
        if (C.tid == 0) { C.MISC[0] = na; C.MISC[1] = nc; }
        __syncthreads();
        qa = (int)C.MISC[0]; qc = (int)C.MISC[1];
        __syncthreads();
    }
    STAMP(12);
#ifdef STAMP_ACC
    if (C.tid == 0 && blockIdx.x == 100) { const unsigned long long n_ = ((unsigned long long)C.MISC[45] << 32) | C.MISC[44]; const unsigned long long w0 = __builtin_amdgcn_s_memrealtime(); while (__builtin_amdgcn_s_memrealtime() - w0 < 4ull * n_) __builtin_amdgcn_s_sleep(8); }
#endif
}

DI void r1_phase(const Ctx& C, const Args& a) {
    LAS unsigned char* L = C.lds;
    const int tid = C.tid, lane = C.lane, wid = C.wid;
    LAS float* LG = (LAS float*)L + wid * 16 * 48;
    LAS int* CNT = (LAS int*)(L + 32768);
    LAS float* G1 = (LAS float*)(L + 33024); LAS float* B1 = (LAS float*)(L + 37120);
    const bf16* Pre = (const bf16*)(C.ws + WS_ZF); unsigned char* X1q = (unsigned char*)(C.ws + WS_R); f32x2* stats = (f32x2*)(C.ws + WS_STATS);
    const bf16* WrH = (const bf16*)(C.ws + WS_WRH); const bf16* WrL = (const bf16*)(C.ws + WS_WRL);
    unsigned* tokE = (unsigned*)(C.ws + WS_TOKE); float* tokW = (float*)(C.ws + WS_TOKW); int* wgcnt = (int*)(C.ws + WS_WGCNT);
    for (int i = tid; i < 1024; i += NTHREADS) { G1[i] = a.in[I_LN1G][i]; B1[i] = a.in[I_LN1B][i]; }
    LAS unsigned char* WL = L + 45056;
    for (int i = tid; i < 48 * 128; i += NTHREADS) { const int r = i >> 7, c = i & 127; *(LAS u32x4*)(WL + r * 2064 + c * 16) = *(const u32x4*)(WrH + (size_t)r * 1024 + c * 8); }
    LAS float* RB = (LAS float*)(L + 41216);
    if (tid < 4) RB[tid] = a.in[I_BGRP][tid]; else if (tid < 36) RB[tid] = a.in[I_BEXP][tid - 4];
    const int m16 = lane & 15, kq = lane >> 4;
    for (int chunk = blockIdx.x; chunk < NTOK / 128; chunk += C.G) {
        if (tid < 32) CNT[tid] = 0;
        __syncthreads();
        const int tok0 = chunk * 128 + wid * 16;
        const bf16* xrow = Pre + (size_t)(tok0 + m16) * 1024 + 8 * kq;
        float s = 0.f, s2 = 0.f;
#pragma unroll 8
        for (int k0 = 0; k0 < 1024; k0 += 32) { const u32x4 w = *(const u32x4*)(xrow + k0); const f32x4 xa = (f32x4){bflo(w.x), bfhi(w.x), bflo(w.y), bfhi(w.y)}, xc = (f32x4){bflo(w.z), bfhi(w.z), bflo(w.w), bfhi(w.w)};
            s += (xa[0] + xa[1]) + (xa[2] + xa[3]) + (xc[0] + xc[1]) + (xc[2] + xc[3]);
            s2 += (xa[0] * xa[0] + xa[1] * xa[1]) + (xa[2] * xa[2] + xa[3] * xa[3]) + (xc[0] * xc[0] + xc[1] * xc[1]) + (xc[2] * xc[2] + xc[3] * xc[3]); }
        s += __shfl_xor(s, 16); s += __shfl_xor(s, 32); s2 += __shfl_xor(s2, 16); s2 += __shfl_xor(s2, 32);
        const float mean = s * (1.f / 1024.f); const float var = fmaxf(s2 * (1.f / 1024.f) - mean * mean, 0.f); const float rstd = 1.f / sqrtf(var + LN_EPS);
        if (kq == 0) stats[tok0 + m16] = (f32x2){mean, rstd};
        STAMP(13);
        f32x4 acc[3];
#pragma unroll
        for (int nb = 0; nb < 3; ++nb) acc[nb] = (f32x4){0.f, 0.f, 0.f, 0.f};
        unsigned char* xb = X1q + (size_t)(tok0 + m16) * 1024 + 8 * kq;
        const LAS unsigned char* wlp = WL + m16 * 2064 + 16 * kq;
#pragma unroll 1
        for (int kb = 0; kb < 4; ++kb) {
            u32x4 xw[8];
#pragma unroll
            for (int j = 0; j < 8; ++j) xw[j] = *(const u32x4*)(xrow + kb * 256 + 32 * j);
#pragma unroll
            for (int j = 0; j < 8; ++j) { const int k0 = kb * 256 + 32 * j;
                bf16x8 wh[3];
#pragma unroll
                for (int nb = 0; nb < 3; ++nb) wh[nb] = *(const LAS bf16x8*)(wlp + nb * 16 * 2064 + k0 * 2);
                const f32x4 xaj = (f32x4){bflo(xw[j].x), bfhi(xw[j].x), bflo(xw[j].y), bfhi(xw[j].y)}, xcj = (f32x4){bflo(xw[j].z), bfhi(xw[j].z), bflo(xw[j].w), bfhi(xw[j].w)};
                const f32x4 ya = (xaj - mean) * rstd * *(const LAS f32x4*)(G1 + k0 + 8 * kq) + *(const LAS f32x4*)(B1 + k0 + 8 * kq);
                const f32x4 yc = (xcj - mean) * rstd * *(const LAS f32x4*)(G1 + k0 + 8 * kq + 4) + *(const LAS f32x4*)(B1 + k0 + 8 * kq + 4);
                u32x4 hw; hw.x = cvtpk(ya[0], ya[1]); hw.y = cvtpk(ya[2], ya[3]); hw.z = cvtpk(yc[0], yc[1]); hw.w = cvtpk(yc[2], yc[3]);
                { u32x2 qw; qw.x = cvt4_fp8(ya[0] * FP8_SX, ya[1] * FP8_SX, ya[2] * FP8_SX, ya[3] * FP8_SX); qw.y = cvt4_fp8(yc[0] * FP8_SX, yc[1] * FP8_SX, yc[2] * FP8_SX, yc[3] * FP8_SX); *(u32x2*)(xb + k0) = qw; }
                u32x4 lw; lw.x = cvtpk(ya[0] - bflo(hw.x), ya[1] - bfhi(hw.x)); lw.y = cvtpk(ya[2] - bflo(hw.y), ya[3] - bfhi(hw.y)); lw.z = cvtpk(yc[0] - bflo(hw.z), yc[1] - bfhi(hw.z)); lw.w = cvtpk(yc[2] - bflo(hw.w), yc[3] - bfhi(hw.w));
                const bf16x8 xh = __builtin_bit_cast(bf16x8, hw), xl = __builtin_bit_cast(bf16x8, lw);
#pragma unroll
                for (int nb = 0; nb < 3; ++nb) { acc[nb] = MFMA16(wh[nb], xh, acc[nb]); acc[nb] = MFMA16(wh[nb], xl, acc[nb]); }
            }
        }
        STAMP(14);
#pragma unroll
        for (int nb = 0; nb < 3; ++nb)
#pragma unroll
            for (int r = 0; r < 4; ++r) LG[m16 * 48 + nb * 16 + 4 * kq + r] = acc[nb][r];
        asm volatile("s_waitcnt lgkmcnt(0)" ::: "memory");
        if (lane < 16) {
            const LAS float* lg = LG + lane * 48;
            float gl[4];
#pragma unroll
            for (int j = 0; j < 4; ++j) gl[j] = lg[j] + RB[j];
            int grp = 0; float gm = gl[0];
#pragma unroll
            for (int j = 1; j < 4; ++j) if (gl[j] > gm) { gm = gl[j]; grp = j; }
            float se = 0.f;
#pragma unroll
            for (int j = 0; j < 4; ++j) se += __expf(gl[j] - gm);
            const float pg = 1.f / se;
            float el[8];
#pragma unroll
            for (int j = 0; j < 8; ++j) el[j] = lg[4 + grp * 8 + j] + RB[4 + grp * 8 + j];
            int i0 = 0; float v0 = el[0];
#pragma unroll
            for (int j = 1; j < 8; ++j) if (el[j] > v0) { v0 = el[j]; i0 = j; }
            int i1 = -1; float v1 = -INFINITY;
#pragma unroll
            for (int j = 0; j < 8; ++j) if (j != i0 && el[j] > v1) { v1 = el[j]; i1 = j; }
            const float w0 = 1.f / (1.f + __expf(v1 - v0)), w1 = 1.f - w0;
            const int e0 = grp * 8 + i0, e1 = grp * 8 + i1;
            const int r0 = __hip_atomic_fetch_add(CNT + e0, 1, __ATOMIC_RELAXED, __HIP_MEMORY_SCOPE_WORKGROUP), r1 = __hip_atomic_fetch_add(CNT + e1, 1, __ATOMIC_RELAXED, __HIP_MEMORY_SCOPE_WORKGROUP);
            const int tok = tok0 + lane;
            tokE[tok] = (unsigned)e0 | ((unsigned)e1 << 8) | ((unsigned)r0 << 16) | ((unsigned)r1 << 24);
            tokW[tok * 2] = w0 * pg; tokW[tok * 2 + 1] = w1 * pg;
        }
        __syncthreads();
        if (tid < 32) wgcnt[chunk * 32 + tid] = CNT[tid];
        __syncthreads();
    }
}

DI void r2_phase(const Ctx& C, const Args& a) {
    LAS int* PA = (LAS int*)C.lds;
    LAS int* PB = PA + 512;
    LAS int* TOT = PB + 512; LAS int* BASE = TOT + 32; LAS int* PST = BASE + 32;
    const int tid = C.tid;
    const int* wgcnt = (const int*)(C.ws + WS_WGCNT); const unsigned* tokE = (const unsigned*)(C.ws + WS_TOKE);
    int* tokD = (int*)(C.ws + WS_TOKD); int* rowtok = (int*)(C.ws + WS_ROWTOK); int* tilee = (int*)(C.ws + WS_TILEE);
    for (int chunk = blockIdx.x; chunk < NTOK / 128; chunk += C.G) {
        { const int e = tid & 31, part = tid >> 5; int sa = 0, sb = 0;
          for (int c = part * 16; c < part * 16 + 16; ++c) { const int v = wgcnt[c * 32 + e]; sa += v; sb += (c < chunk) ? v : 0; }
          PA[part * 32 + e] = sa; PB[part * 32 + e] = sb; }
        __syncthreads();
        if (tid < 32) { int sa = 0, sb = 0; for (int p = 0; p < 16; ++p) { sa += PA[p * 32 + tid]; sb += PB[p * 32 + tid]; } TOT[tid] = sa; BASE[tid] = sb; }
        __syncthreads();
        if (tid == 0) { int ps = 0; for (int e = 0; e < 32; ++e) { PST[e] = ps; ps += ((TOT[e] + 255) >> 8) << 8; } PST[32] = ps; }
        __syncthreads();
        if (tid < 128) { const int tok = chunk * 128 + tid; const unsigned w = tokE[tok]; const int e0 = w & 31, e1 = (w >> 8) & 31, r0 = (w >> 16) & 255, r1 = (w >> 24) & 255;
            const int d0 = PST[e0] + BASE[e0] + r0, d1 = PST[e1] + BASE[e1] + r1; rowtok[d0] = tok; rowtok[d1] = tok; tokD[tok * 2] = d0; tokD[tok * 2 + 1] = d1; }
        if (chunk < 32) { const int e = chunk, end = PST[e + 1] - PST[e]; for (int i = TOT[e] + tid; i < end; i += NTHREADS) rowtok[PST[e] + i] = 0; }
        if (chunk == 0) { if (tid < 32) { for (int t = PST[tid] >> 8; t < (PST[tid + 1] >> 8); ++t) tilee[t] = tid; } if (tid == 0) tilee[511] = PST[32] >> 8; }
        __syncthreads();
    }
}

DI void f_phase(const Ctx& C, const Args& a) {
    const int lane = C.lane, gw = C.vcu * NWAVES + C.wid, NGW = C.G * NWAVES;
    const bf16* Pre = (const bf16*)(C.ws + WS_ZF); const unsigned char* Y = (const unsigned char*)(C.ws + WS_Y); const int* tokD = (const int*)(C.ws + WS_TOKD); const float* tokW = (const float*)(C.ws + WS_TOKW);
    const f32x2* stats = (const f32x2*)(C.ws + WS_STATS);
    f32x4 g2[4], b2[4], g1[4], b1[4];
#pragma unroll
    for (int j = 0; j < 4; ++j) { g2[j] = *(const f32x4*)(a.in[I_LN2G] + 256 * j + 4 * lane); b2[j] = *(const f32x4*)(a.in[I_LN2B] + 256 * j + 4 * lane);
        g1[j] = *(const f32x4*)(a.in[I_LN1G] + 256 * j + 4 * lane) * DN_ALPHA; b1[j] = *(const f32x4*)(a.in[I_LN1B] + 256 * j + 4 * lane) * DN_ALPHA; }
    for (int tok = gw; tok < NTOK; tok += NGW) {
        const int d0 = tokD[tok * 2], d1 = tokD[tok * 2 + 1]; const float w0 = tokW[tok * 2] * (1.f / FP8_SY), w1 = tokW[tok * 2 + 1] * (1.f / FP8_SY); const f32x2 st = stats[tok];
        const bf16* xr = Pre + (size_t)tok * 1024 + 4 * lane; const unsigned char* y0 = Y + (size_t)d0 * 1024 + 4 * lane; const unsigned char* y1 = Y + (size_t)d1 * 1024 + 4 * lane;
        f32x4 v[4]; float s = 0.f;
#pragma unroll
        for (int j = 0; j < 4; ++j) { const u32x2 xw = *(const u32x2*)(xr + 256 * j); const f32x4 x = (f32x4){bflo(xw.x), bfhi(xw.x), bflo(xw.y), bfhi(xw.y)}; const unsigned p0 = *(const unsigned*)(y0 + 256 * j), p1 = *(const unsigned*)(y1 + 256 * j);
            v[j] = ((x - st.x) * st.y) * g1[j] + b1[j] + fp8x4_to_f32(p0) * w0 + fp8x4_to_f32(p1) * w1;
            s += (v[j][0] + v[j][1]) + (v[j][2] + v[j][3]); }
        const float mean = wave_sum(s) * (1.f / 1024.f); float s2 = 0.f;
#pragma unroll
        for (int j = 0; j < 4; ++j) { v[j] = v[j] - mean; s2 += (v[j][0] * v[j][0] + v[j][1] * v[j][1]) + (v[j][2] * v[j][2] + v[j][3] * v[j][3]); }
        const float rstd = 1.f / sqrtf(wave_sum(s2) * (1.f / 1024.f) + LN_EPS);
        float* orow = a.out + (size_t)tok * 1024 + 4 * lane;
#pragma unroll
        for (int j = 0; j < 4; ++j) *(f32x4*)(orow + 256 * j) = v[j] * rstd * g2[j] + b2[j];
    }
}

constexpr int NPH = 10;
__global__ void __launch_bounds__(NTHREADS, 2) mk_fwd(Args args) {
    extern __shared__ __attribute__((aligned(16))) unsigned char lds_raw[];
    Ctx C;
    C.lds = (LAS unsigned char*)lds_raw; C.MISC = (volatile LAS unsigned*)(C.lds + MISC_OFF);
    C.tid = threadIdx.x; C.lane = C.tid & 63; C.wid = __builtin_amdgcn_readfirstlane(C.tid >> 6);
    C.G = gridDim.x; { const int bx = blockIdx.x; C.vcu = (C.G % 8 == 0) ? (bx % 8) * (C.G / 8) + bx / 8 : bx; }
    C.ws = args.ws; C.ctl = (gu32*)(args.ws + WS_CTL);
    if (C.tid < 64) C.MISC[C.tid] = 0u;
    __syncthreads();
    XcdBarrier bar; bar.bar = (unsigned*)(C.ctl + CW_BAR); bar.x = 0; bar.st = nullptr;
    if (MK_N_LAUNCHES == 1) bar = xcd_barrier_post((unsigned*)(C.ctl + CW_BAR), C.MISC + 8);
    const int lo = args.ph_lo, hi = args.ph_hi;
#ifndef PH_MASK
#define PH_MASK 0x3ff
#endif
#define IN(k) (((PH_MASK >> (k)) & 1) && lo <= (k) && (k) < hi)
#ifndef STAMP_SEL
#define STAMP_SEL -1
#endif
#ifndef STAMP_T0
#define STAMP_T0 STAMP_SEL
#define STAMP_T1 (STAMP_SEL + 1)
#endif
#define SEAM(k) do { if (IN(k) && IN((k) + 1)) xcd_barrier(bar); STAMP((k) + 1); } while (0)
#ifndef PROBE_PHASE
#define PROBE_PHASE -1
#endif
#define REPS(k) ((PROBE_PHASE == (k)) ? 2 : 1)
#define REPSEAM(k) do { if (rep + 1 < REPS(k)) xcd_barrier(bar); } while (0)
    unsigned char* ws = args.ws;
    LAS unsigned char* ring = C.lds;

    STAMP(0);
    if (IN(0)) { _Pragma("unroll") for (int rep = 0; rep < REPS(0); ++rep) { p0_prologue(C, args); REPSEAM(0); } } SEAM(0);

    if (IN(1)) _Pragma("unroll") for (int rep = 0; rep < REPS(1); ++rep) {
        pg8::EpiIn E{(bf16*)(ws + WS_QH), (bf16*)(ws + WS_VH), (bf16*)(ws + WS_GH), (bf16*)(ws + WS_QM), (bf16*)(ws + WS_KM), (bf16*)(ws + WS_VM), (bf16*)(ws + WS_R), (bf16*)(ws + WS_GB),
                     (float*)(ws + WS_ZF), (float*)(ws + WS_KMEAN), (const float*)(ws + WS_BPERM), (bf16*)(ws + WS_KK), (const float*)(ws + WS_LB), 0};
        { pg8::DenseOrder S; S.init(ws + WS_XB, ws + WS_WIN, NTOK, 2048, 1024, C.G, (int)blockIdx.x);
          pg8::gemm_phase<pg8::EpiIn, pg8::DenseOrder, false>(ring, 1024, S, E); }
        { E.pn_off = 8; pg8::DenseOrder S; S.init((unsigned char*)args.out + 64 * MiB, ws + WS_WIN + 4 * MiB, NTOK, 3584, 512, C.G, (int)blockIdx.x);
          pg8::gemm_phase<pg8::EpiIn, pg8::DenseOrder, false, true>(ring, 512, S, E); }
        REPSEAM(1);
    } SEAM(1);

#ifndef PROBE_P2X
#define PROBE_P2X 1
#endif
    if (IN(2)) { for (int rep = 0; rep < PROBE_P2X; ++rep) { p2_mixers(C, args, rep); if (rep + 1 < PROBE_P2X) xcd_barrier(bar); } } SEAM(2);

    if (IN(3)) _Pragma("unroll") for (int rep = 0; rep < REPS(3); ++rep) {
        pg8::DenseOrder S; S.init(ws + WS_OCAT, ws + WS_WCAT, NTOK, 1024, 512, C.G, (int)blockIdx.x);
        pg8::EpiProj E{(const bf16*)(ws + WS_R), (const bf16*)(ws + WS_GB), (unsigned char*)(ws + WS_QH)};
        pg8::gemm_phase<pg8::EpiProj, pg8::DenseOrder, false, true>(ring, 512, S, E); REPSEAM(3);
    } SEAM(3);

    if (IN(4)) _Pragma("unroll") for (int rep = 0; rep < REPS(4); ++rep) {
        pg8::DenseOrder S; S.init(ws + WS_QH, ws + WS_WO, NTOK, 1024, 512, C.G, (int)blockIdx.x);
        pg8::EpiOut E{(const bf16*)(ws + WS_XB), (bf16*)(ws + WS_ZF)};
        pg8::gemm_phase<pg8::EpiOut, pg8::DenseOrder, false, true>(ring, 512, S, E);
        REPSEAM(4);
    } SEAM(4);

    if (IN(5)) { _Pragma("unroll") for (int rep = 0; rep < REPS(5); ++rep) { r1_phase(C, args); REPSEAM(5); } } STAMP(15); SEAM(5);
    if (IN(6)) { _Pragma("unroll") for (int rep = 0; rep < REPS(6); ++rep) { r2_phase(C, args); REPSEAM(6); } } SEAM(6);

    if (IN(7)) _Pragma("unroll") for (int rep = 0; rep < REPS(7); ++rep) {
        const int* tilee = (const int*)(ws + WS_TILEE);
        const int ntl = __builtin_amdgcn_readfirstlane(__hip_atomic_load(tilee + 511, __ATOMIC_RELAXED, __HIP_MEMORY_SCOPE_AGENT));
        pg8::MoeOrder S{(const char*)(ws + WS_R), (const char*)args.out, (const int*)(ws + WS_ROWTOK), tilee, 512, 1024, ntl * 4, C.G, C.vcu, true};
        pg8::EpiM1 E{(unsigned char*)(ws + WS_QH)};
        pg8::gemm_phase<pg8::EpiM1, pg8::MoeOrder, true, true>(ring, 512, S, E); REPSEAM(7);
    } SEAM(7);

    if (IN(8)) _Pragma("unroll") for (int rep = 0; rep < REPS(8); ++rep) {
        const int* tilee = (const int*)(ws + WS_TILEE);
        const int ntl = __builtin_amdgcn_readfirstlane(__hip_atomic_load(tilee + 511, __ATOMIC_RELAXED, __HIP_MEMORY_SCOPE_AGENT));
        pg8::MoeOrder S{(const char*)(ws + WS_QH), (const char*)args.out + 32 * MiB, (const int*)(ws + WS_ROWTOK), tilee, 256, 1024, ntl * 4, C.G, C.vcu, false};
        pg8::EpiM2 E{(unsigned char*)(ws + WS_Y)};
        pg8::gemm_phase<pg8::EpiM2, pg8::MoeOrder, false, true>(ring, 256, S, E); REPSEAM(8);
    } SEAM(8);

    if (IN(9)) { _Pragma("unroll") for (int rep = 0; rep < REPS(9); ++rep) { f_phase(C, args); REPSEAM(9); } }
    STAMP(10);
    if (STAMP_SEL >= 0 && blockIdx.x == 0 && C.tid == 0) {
        const unsigned long long t0 = ((unsigned long long)C.MISC[17 + 2 * (STAMP_T0)] << 32) | C.MISC[16 + 2 * (STAMP_T0)], t1 = ((unsigned long long)C.MISC[17 + 2 * (STAMP_T1)] << 32) | C.MISC[16 + 2 * (STAMP_T1)];
        const unsigned long long w0 = __builtin_amdgcn_s_memrealtime(); while (__builtin_amdgcn_s_memrealtime() - w0 < 4ull * (t1 - t0)) __builtin_amdgcn_s_sleep(8); }
#undef IN
#undef SEAM
}

extern "C" void kernel_launch(void* const* d_in, const int* in_sizes, int n_in, void* d_out, int out_size, void* d_ws, size_t ws_size, hipStream_t stream) {
    static int grid = 0;
    if (grid == 0) {
        if (n_in != 19 || in_sizes[0] != NTOK * DM || out_size != NTOK * DM || ws_size < WS_END) { fprintf(stderr, "kernel_launch: unexpected problem shape / workspace; nothing launched\n"); grid = -1; return; }
        int dev = 0, cus = 0, per_cu = 0;
        if (hipGetDevice(&dev) != hipSuccess || hipDeviceGetAttribute(&cus, hipDeviceAttributeMultiprocessorCount, dev) != hipSuccess) { grid = -1; return; }
        if (hipFuncSetAttribute((const void*)mk_fwd, hipFuncAttributeMaxDynamicSharedMemorySize, LDS_BYTES) != hipSuccess) { fprintf(stderr, "kernel_launch: hipFuncSetAttribute failed\n"); grid = -1; return; }
        if (hipOccupancyMaxActiveBlocksPerMultiprocessor(&per_cu, (const void*)mk_fwd, NTHREADS, LDS_BYTES) != hipSuccess || per_cu < 1) { fprintf(stderr, "kernel_launch: occupancy query says %d\n", per_cu); }
        (void)hipGetLastError();
        grid = cus;
    }
    if (grid < 0) return;
    (void)hipMemsetAsync((char*)d_ws + WS_CTL, 0, CTL_ZERO_BYTES, stream);
    Args a{};
    for (int i = 0; i < 19; ++i) a.in[i] = (const float*)d_in[i];
    a.out = (float*)d_out; a.ws = (unsigned char*)d_ws;
    if (MK_N_LAUNCHES == 1) { a.ph_lo = 0; a.ph_hi = NPH; hipLaunchKernelGGL(mk_fwd, dim3(grid), dim3(NTHREADS), LDS_BYTES, stream, a); }
    else for (int p = 0; p < NPH; ++p) { a.ph_lo = p; a.ph_hi = p + 1; hipLaunchKernelGGL(mk_fwd, dim3(grid), dim3(NTHREADS), LDS_BYTES, stream, a); }
}
```

```cpp
#include <hip/hip_runtime.h>
#include <cstdio>
#include <cstdint>
#ifndef MK_N_LAUNCHES
#define MK_N_LAUNCHES 1
#endif
#define DI __device__ __forceinline__
#define GAS __attribute__((address_space(1)))
#define LAS __attribute__((address_space(3)))
typedef unsigned short bf16;
typedef unsigned u32x4 __attribute__((ext_vector_type(4)));
typedef unsigned u32x2 __attribute__((ext_vector_type(2)));
typedef float f32x4 __attribute__((ext_vector_type(4)));
typedef float f32x2 __attribute__((ext_vector_type(2)));
typedef float f32x16 __attribute__((ext_vector_type(16)));
typedef short bf16x8 __attribute__((ext_vector_type(8)));
typedef short s16x4 __attribute__((ext_vector_type(4)));
typedef short v4i16_t __attribute__((ext_vector_type(4)));
typedef __bf16 bf16x2_t __attribute__((ext_vector_type(2)));
typedef GAS unsigned gu32;

constexpr int NTOK = 32768, DM = 1024, SEQ = 2048, NBATCH = 16, NIN = 5632;
constexpr int NWAVES = 8, NTHREADS = 512;
constexpr float LN_EPS = 1e-5f, DN_ALPHA = 1.189207115002721f, LOG2E = 1.4426950408889634f;
constexpr int MOE_MAXTILES = 288;

constexpr size_t MiB = 1u << 20;
constexpr size_t WS_CTL = 0, CTL_ZERO_BYTES = 65536;
constexpr size_t WS_WIN = 1 * MiB, WS_WCAT = 12 * MiB, WS_WO = 14 * MiB;
constexpr size_t WS_XB = 16 * MiB;
constexpr size_t WS_R = 80 * MiB;
constexpr size_t WS_GB = 144 * MiB;
constexpr size_t WS_QH = 208 * MiB;
constexpr size_t WS_VH = 240 * MiB;
constexpr size_t WS_GH = 272 * MiB;
constexpr size_t WS_ZF = 304 * MiB;
constexpr size_t WS_OCAT = 306 * MiB;
constexpr size_t WS_QM = 368 * MiB, WS_KM = 400 * MiB;
constexpr size_t WS_VM = 432 * MiB;
constexpr size_t WS_Y = 16 * MiB;
constexpr size_t WS_MISC = 464 * MiB;
constexpr size_t WS_KMEAN = WS_MISC;
constexpr size_t WS_BPERM = WS_MISC + 1 * MiB;
constexpr size_t WS_WRH = WS_MISC + 2 * MiB;
constexpr size_t WS_WRL = WS_WRH + 98304;
constexpr size_t WS_TOKE = WS_MISC + 3 * MiB;
constexpr size_t WS_TOKW = WS_MISC + 4 * MiB;
constexpr size_t WS_TOKD = WS_MISC + 5 * MiB;
constexpr size_t WS_WGCNT = WS_MISC + 6 * MiB;
constexpr size_t WS_ROWTOK = WS_MISC + 7 * MiB;
constexpr size_t WS_TILEE = WS_MISC + 8 * MiB;
constexpr size_t WS_STATS = WS_MISC + 9 * MiB;
constexpr size_t WS_LB = WS_MISC + 10 * MiB;
constexpr size_t WS_KK = WS_MISC + 12 * MiB;
constexpr size_t WS_END = 512 * MiB;
constexpr int CW_BAR = 4096, CW_QUEUE = 8192, CW_QUEUE2 = 8192 + 1024;

constexpr int LDS_BYTES = 163840, MISC_OFF = LDS_BYTES - 256;

DI unsigned cvtpk(float lo, float hi) { f32x2 v = {lo, hi}; bf16x2_t b = __builtin_convertvector(v, bf16x2_t); return __builtin_bit_cast(unsigned, b); }
DI float bflo(unsigned w) { return __uint_as_float(w << 16); }
DI float bfhi(unsigned w) { return __uint_as_float(w & 0xffff0000u); }
DI float bf2f(unsigned short h) { return __uint_as_float((unsigned)h << 16); }
DI float frcp(float x) { return __builtin_amdgcn_rcpf(x); }
DI float fsigmoid(float x) { return frcp(1.f + __expf(-x)); }
DI float wave_sum(float v) {
#pragma unroll
    for (int o = 1; o < 64; o <<= 1) v += __shfl_xor(v, o);
    return v;
}
typedef int v8i __attribute__((ext_vector_type(8)));
typedef int v4i __attribute__((ext_vector_type(4)));
DI unsigned cvt4_fp8(float a, float b, float c, float d) { a = __builtin_amdgcn_fmed3f(a, -448.f, 448.f); b = __builtin_amdgcn_fmed3f(b, -448.f, 448.f); c = __builtin_amdgcn_fmed3f(c, -448.f, 448.f); d = __builtin_amdgcn_fmed3f(d, -448.f, 448.f);
    int w = 0; w = __builtin_amdgcn_cvt_pk_fp8_f32(a, b, w, false); w = __builtin_amdgcn_cvt_pk_fp8_f32(c, d, w, true); return (unsigned)w; }
DI f32x4 fp8x4_to_f32(unsigned w) { const f32x2 lo = __builtin_amdgcn_cvt_pk_f32_fp8((int)w, false), hi = __builtin_amdgcn_cvt_pk_f32_fp8((int)w, true); return (f32x4){lo[0], lo[1], hi[0], hi[1]}; }
constexpr float FP8_SXI = 8.f, FP8_SX = 8.f, FP8_SW = 32.f, FP8_SH = 4.f, FP8_SO = 4.f, FP8_SU = 32.f, FP8_SY = 64.f;
DI int crow(int r, int hi) { return (r & 3) + 8 * (r >> 2) + 4 * hi; }
#define MFMA32(a, b, c) __builtin_amdgcn_mfma_f32_32x32x16_bf16((a), (b), (c), 0, 0, 0)
#define MFMA16(a, b, c) __builtin_amdgcn_mfma_f32_16x16x32_bf16((a), (b), (c), 0, 0, 0)
DI s16x4 vtr(LAS const char* p) { return __builtin_bit_cast(s16x4, __builtin_amdgcn_ds_read_tr16_b64_v4i16((LAS v4i16_t*)p)); }

#define XB_TMO      128
#define XB_XCNT(j)  (256  + 64 * (j))
#define XB_XSUB(j)  (1280 + 64 * (j))
#define XB_XGEN(j)  (2304 + 64 * (j))
#define XB_TOP      3328
#define XB_TOPGEN   3392
#define XCD_BAR_WORDS 3456
#define XB_SPIN_CAP (1u << 22)
DI unsigned xb_ld(unsigned* p)              { return __hip_atomic_load(p, __ATOMIC_RELAXED, __HIP_MEMORY_SCOPE_AGENT); }
DI unsigned xb_add(unsigned* p, unsigned v) { return __hip_atomic_fetch_add(p, v, __ATOMIC_RELAXED, __HIP_MEMORY_SCOPE_AGENT); }
DI unsigned xb_xcc_id() { return (unsigned)__builtin_amdgcn_s_getreg((3 << 11) | 20) & 0xFu; }
#define XB_SPIN(cond, bar) do { unsigned _sp = 0; while (cond) { __builtin_amdgcn_s_sleep(1); \
    if ((++_sp & 255u) == 0u) { if (xb_ld(&(bar)[XB_TMO])) break; if (_sp > XB_SPIN_CAP) { atomicAdd(&(bar)[XB_TMO], 1u); break; } } } } while (0)
struct XcdBarrier { unsigned* bar; unsigned x; volatile LAS unsigned* st; };
DI XcdBarrier xcd_barrier_post(unsigned* bar, volatile LAS unsigned* st) {
    XcdBarrier b; b.bar = bar; b.x = xb_xcc_id(); b.st = st;
    if (threadIdx.x == 0) (void)xb_add(&bar[XB_XCNT(b.x)], 1u);
    return b;
}
DI void xcd_barrier_complete(unsigned* bar, unsigned x, unsigned& nloc, unsigned& nx) {
    const unsigned G = gridDim.x * gridDim.y * gridDim.z;
    unsigned sum, cnt, mine, sp = 0u;
    for (;;) {
        sum = 0u; cnt = 0u; mine = 0u;
#pragma unroll
        for (unsigned j = 0; j < 16; ++j) { const unsigned c = xb_ld(&bar[XB_XCNT(j)]); sum += c; cnt += (c > 0u) ? 1u : 0u; mine = (j == x) ? c : mine; }
        if (sum == G) break;
        __builtin_amdgcn_s_sleep(1);
        if ((++sp & 255u) == 0u) { if (xb_ld(&bar[XB_TMO])) break; if (sp > XB_SPIN_CAP) { atomicAdd(&bar[XB_TMO], 1u); break; } }
    }
    nloc = mine > 0u ? mine : 1u; nx = cnt > 0u ? cnt : 1u;
}
DI void xcd_barrier(const XcdBarrier& b) {
    asm volatile("s_waitcnt vmcnt(0)" ::: "memory");
    __syncthreads();
    if (threadIdx.x == 0) {
        unsigned* bar = b.bar;
        __builtin_amdgcn_s_waitcnt(0);
        unsigned nloc = b.st[0], nx = b.st[1];
        if (nloc == 0u) { xcd_barrier_complete(bar, b.x, nloc, nx); b.st[0] = nloc; b.st[1] = nx; }
        const unsigned old = xb_add(&bar[XB_XSUB(b.x)], 1u);
        const unsigned gen = old / nloc;
        if (old + 1u == (gen + 1u) * nloc) {
            __builtin_amdgcn_fence(__ATOMIC_RELEASE, "agent");
            asm volatile("s_waitcnt vmcnt(0)" ::: "memory");
            const unsigned og = xb_add(&bar[XB_TOP], 1u);
            const unsigned tg = og / nx;
            if (og + 1u == (tg + 1u) * nx) xb_add(&bar[XB_TOPGEN], 1u);
            else XB_SPIN(xb_ld(&bar[XB_TOPGEN]) == tg, bar);
            __builtin_amdgcn_fence(__ATOMIC_ACQUIRE, "agent");
            xb_add(&bar[XB_XGEN(b.x)], 1u);
            asm volatile("s_waitcnt vmcnt(0)" ::: "memory");
        } else {
            XB_SPIN(xb_ld(&bar[XB_XGEN(b.x)]) == gen, bar);
            __builtin_amdgcn_fence(__ATOMIC_ACQUIRE, "agent");
            asm volatile("s_waitcnt vmcnt(0)" ::: "memory");
        }
    }
    __syncthreads();
}

namespace pg8 {
constexpr int BM = 256, BK = 64, HALF = 128, HTB = HALF * BK * 2, STAGE_BYTES = 8 * HTB, NXCD = 8, WGM = 8;
DI int lds_byte(int r, int c) { const int st = (r >> 4) * 2 + (c >> 5), rr = r & 15, cc = c & 31, ob = rr * 64 + cc * 2; return st * 1024 + (ob ^ (((ob >> 9) & 1) << 5)); }
DI void stage_rc(int b, int& R, int& C) { const int st = b / 1024, sb = b % 1024, swz = sb ^ (((sb >> 9) & 1) << 5); R = (st >> 1) * 16 + swz / 64; C = (st & 1) * 32 + (swz % 64) / 2; }
DI int perm32(int rho) { const int n = rho >> 4, i = rho & 15; return 8 * (i >> 2) + 4 * n + (i & 3); }
struct Unit { int pm, pn, e; };

struct DenseOrder {
    const char* A; const char* Bt; int K, nM, nN, nwg, G, c;
    DI void init(const void* A_, const void* Bt_, int M, int N, int K_, int G_, int c_) { A = (const char*)A_; Bt = (const char*)Bt_; K = K_; nM = M / BM; nN = N / BM; nwg = nM * nN; G = G_; c = c_; }
    DI bool next(int i, Unit& u) const {
        const long L = (long)i * G + c; if (L >= nwg) return false;
        int wgid = (int)L; { const int q = nwg / NXCD, r = nwg % NXCD, xcd = wgid % NXCD, off = wgid / NXCD; wgid = (xcd < r ? xcd * (q + 1) : r * (q + 1) + (xcd - r) * q) + off; }
        const int nig = WGM * nN, gid = wgid / nig, fm = gid * WGM, gsz = (nM - fm) < WGM ? (nM - fm) : WGM;
        u.pm = fm + ((wgid % nig) % gsz); u.pn = (wgid % nig) / gsz; u.e = 0; return true;
    }
    DI const char* a_base(const Unit& u) const { return A + (size_t)u.pm * 512 * K; }
    DI const char* b_base(const Unit& u) const { return Bt + (size_t)u.pn * 512 * K; }
    DI void gather(const Unit&, const int (&)[2], const int (&)[2], unsigned (&)[2][2]) const {}
};
struct MoeOrder {
    const char* A; const char* Bt; const int* row_tok; const int* tile_e; int K, N, nunits, G, c; bool gat;
    DI bool next(int i, Unit& u) const {
        const int L = i * G + c; if (L >= nunits) return false;
        u.pm = L >> 2; u.pn = L & 3;
        u.e = __builtin_amdgcn_readfirstlane(__hip_atomic_load(tile_e + u.pm, __ATOMIC_RELAXED, __HIP_MEMORY_SCOPE_AGENT)); return true;
    }
    DI const char* a_base(const Unit& u) const { return gat ? A : A + (size_t)u.pm * 512 * K; }
    DI const char* b_base(const Unit& u) const { return Bt + ((size_t)u.e * N + (size_t)u.pn * 256) * K * 2; }
    DI void gather(const Unit& u, const int (&Rr)[2], const int (&Cc)[2], unsigned (&o)[2][2]) const {
#pragma unroll
        for (int h = 0; h < 2; ++h)
#pragma unroll
            for (int i = 0; i < 2; ++i) { const int tok = row_tok[u.pm * 256 + h * 128 + Rr[i]]; o[h][i] = (unsigned)(tok * K + Cc[i]) * 2u; }
    }
};

template <class Epi, class Sched, bool GATHER, bool FP8 = false>
DI void gemm_phase(LAS unsigned char* lds, const int K, const Sched& S, const Epi& E) {
    const int tid = threadIdx.x, wid = __builtin_amdgcn_readfirstlane(tid >> 6), lane = tid & 63, wr = wid >> 2, wc = wid & 3, fr = lane & 15, fq = lane >> 4;
    const int nt = K / BK;
    unsigned voffB[2], vA[2][2], nvA[2][2]; int Rr[2], Cc[2];
#pragma unroll
    for (int i = 0; i < 2; ++i) { int R, C; stage_rc(tid * 16 + i * 8192, R, C); Rr[i] = R; Cc[i] = C; const int Rb = (R & ~31) + perm32(R & 31);
        voffB[i] = (unsigned)(Rb * K + C) * 2u; vA[0][i] = (unsigned)(R * K + C) * 2u; vA[1][i] = (unsigned)((R + HALF) * K + C) * 2u; nvA[0][i] = vA[0][i]; nvA[1][i] = vA[1][i]; }
    const size_t kstep = (size_t)(BK * 2);
    const size_t hstep = (size_t)HALF * K * 2;
    const unsigned ldsw = (unsigned)wid * 1024u;
    const int aoff = lds_byte(wr * 64 + fr, fq * 8), boff = lds_byte(wc * 32 + fr, fq * 8);
#define PG8_SA(b, h) (((b) * 2 + (h)) * HTB)
#define PG8_SB(b, h) ((4 + (b) * 2 + (h)) * HTB)
#define PG8_STAGE(bufoff, gbase, voff) do { _Pragma("unroll") for (int _i = 0; _i < 2; ++_i) \
        __builtin_amdgcn_global_load_lds((const unsigned*)((const char*)(gbase) + (voff)[_i]), (LAS unsigned*)(lds + (bufoff) + ldsw + _i * 8192), 16, 0, 0); } while (0)
#define PG8_LDA(dst, b, h) do { if constexpr (FP8) { _Pragma("unroll") for (int m = 0; m < 4; ++m) dst##8[m] = __builtin_shufflevector(*(const LAS v4i*)(lds + PG8_SA(b, h) + aoff + m * 2048), *(const LAS v4i*)(lds + PG8_SA(b, h) + aoff + m * 2048 + 1024), 0, 1, 2, 3, 4, 5, 6, 7); } \
        else { _Pragma("unroll") for (int m = 0; m < 4; ++m) _Pragma("unroll") for (int k = 0; k < 2; ++k) dst[m][k] = *(const LAS bf16x8*)(lds + PG8_SA(b, h) + aoff + m * 2048 + k * 1024); } } while (0)
#define PG8_LDB(dst, b, h) do { if constexpr (FP8) { _Pragma("unroll") for (int n = 0; n < 2; ++n) dst##8[n] = __builtin_shufflevector(*(const LAS v4i*)(lds + PG8_SB(b, h) + boff + n * 2048), *(const LAS v4i*)(lds + PG8_SB(b, h) + boff + n * 2048 + 1024), 0, 1, 2, 3, 4, 5, 6, 7); } \
        else { _Pragma("unroll") for (int n = 0; n < 2; ++n) _Pragma("unroll") for (int k = 0; k < 2; ++k) dst[n][k] = *(const LAS bf16x8*)(lds + PG8_SB(b, h) + boff + n * 2048 + k * 1024); } } while (0)
#define PG8_CAT(x, y) __builtin_shufflevector(__builtin_bit_cast(v4i, (x)), __builtin_bit_cast(v4i, (y)), 0, 1, 2, 3, 4, 5, 6, 7)
#define PG8_MMA(ai, bj, At, Bt) do { __builtin_amdgcn_s_setprio(1); if constexpr (FP8) { _Pragma("unroll") for (int m = 0; m < 4; ++m) _Pragma("unroll") for (int n = 0; n < 2; ++n) \
        asm volatile("v_mfma_scale_f32_16x16x128_f8f6f4 %0, %1, %2, %0, %3, %3 op_sel_hi:[0,0,0]" : "+v"(acc[ai][bj][m][n]) : "v"(Bt##8[n]), "v"(At##8[m]), "v"(fp8_unit_scale)); } else { \
        _Pragma("unroll") for (int m = 0; m < 4; ++m) _Pragma("unroll") for (int n = 0; n < 2; ++n) _Pragma("unroll") for (int k = 0; k < 2; ++k) \
        acc[ai][bj][m][n] = __builtin_amdgcn_mfma_f32_16x16x32_bf16(Bt[n][k], At[m][k], acc[ai][bj][m][n], 0, 0, 0); } __builtin_amdgcn_s_setprio(0); } while (0)
#define PG8_WAIT_V(n) asm volatile("s_waitcnt vmcnt(" #n ")" ::: "memory")
#define PG8_WAIT_L(n) asm volatile("s_waitcnt lgkmcnt(" #n ")" ::: "memory")
#define PG8_BAR __builtin_amdgcn_s_barrier()
#define PG8_SCHED __builtin_amdgcn_sched_barrier(0)
    Unit cur, nxt; int ui = 0;
    if (!S.next(0, cur)) return;
    if constexpr (GATHER) S.gather(cur, Rr, Cc, vA);
    f32x4 acc[2][2][4][2];
#pragma unroll
    for (int a = 0; a < 2; ++a)
#pragma unroll
        for (int b = 0; b < 2; ++b)
#pragma unroll
            for (int m = 0; m < 4; ++m)
#pragma unroll
                for (int n = 0; n < 2; ++n) acc[a][b][m][n] = (f32x4){0.f, 0.f, 0.f, 0.f};
    bf16x8 At[4][2], B0[2][2], B1[2][2]; v8i At8[4], B08[2], B18[2]; const int fp8_unit_scale = 0x7f7f7f7f;
    const char* cA = S.a_base(cur); const char* cB = S.b_base(cur);
    PG8_STAGE(PG8_SB(0, 0), cB, voffB); PG8_STAGE(PG8_SB(0, 1), cB + hstep, voffB); PG8_STAGE(PG8_SA(0, 0), cA, vA[0]); PG8_STAGE(PG8_SA(0, 1), cA, vA[1]);
    if (wr == 1) PG8_BAR;
    PG8_WAIT_V(2); PG8_BAR;
    PG8_STAGE(PG8_SB(1, 0), cB + kstep, voffB); PG8_STAGE(PG8_SA(1, 0), cA + kstep, vA[0]); PG8_STAGE(PG8_SB(1, 1), cB + hstep + kstep, voffB);
    PG8_WAIT_V(6); PG8_BAR;
    for (;;) {
        const bool has_next = S.next(ui + 1, nxt);
        const char* nA = has_next ? S.a_base(nxt) : cA; const char* nB = has_next ? S.b_base(nxt) : cB;
        if constexpr (GATHER) {
            if (has_next) S.gather(nxt, Rr, Cc, nvA);
            else {
#pragma unroll
                for (int h = 0; h < 2; ++h) { nvA[h][0] = vA[h][0]; nvA[h][1] = vA[h][1]; } }
        }
#pragma unroll 1
        for (int t = 0; t < nt; t += 2) {
            const bool last = (t == nt - 2);
            if constexpr (Epi::HAS_MID) { if (t == (nt >> 1)) { if constexpr (FP8) asm volatile("s_nop 15\n\ts_nop 15" ::: "memory"); E.mid(acc, cur, wr, wc, fr, fq); if constexpr (FP8) asm volatile("s_nop 7" ::: "memory"); } }
            const char* a1 = cA + (size_t)(t + 1) * kstep;
            const char* a2 = last ? nA : cA + (size_t)(t + 2) * kstep; const char* b2 = last ? nB : cB + (size_t)(t + 2) * kstep;
            const char* a3 = a2 + kstep; const char* b3 = b2 + kstep;
            unsigned o0[2], o1[2];
            if constexpr (GATHER) { o0[0] = last ? nvA[0][0] : vA[0][0]; o0[1] = last ? nvA[0][1] : vA[0][1]; o1[0] = last ? nvA[1][0] : vA[1][0]; o1[1] = last ? nvA[1][1] : vA[1][1]; }
            else { o0[0] = vA[0][0]; o0[1] = vA[0][1]; o1[0] = vA[1][0]; o1[1] = vA[1][1]; }
            PG8_LDB(B0, 0, 0); PG8_LDB(B1, 0, 1); PG8_SCHED; PG8_LDA(At, 0, 0); PG8_STAGE(PG8_SA(1, 1), a1, vA[1]);
            PG8_WAIT_V(8); PG8_WAIT_L(0); PG8_BAR; PG8_MMA(0, 0, At, B0); PG8_MMA(0, 1, At, B1); PG8_BAR; PG8_SCHED;
            PG8_LDA(At, 0, 1); PG8_STAGE(PG8_SB(0, 0), b2, voffB); PG8_STAGE(PG8_SB(0, 1), b2 + hstep, voffB); PG8_STAGE(PG8_SA(0, 0), a2, o0);
            PG8_WAIT_V(8); PG8_WAIT_L(0); PG8_BAR; PG8_MMA(1, 0, At, B0); PG8_MMA(1, 1, At, B1); PG8_BAR; PG8_SCHED;
            PG8_LDB(B0, 1, 0); PG8_LDB(B1, 1, 1); PG8_SCHED; PG8_LDA(At, 1, 0); PG8_STAGE(PG8_SA(0, 1), a2, o1);
            PG8_WAIT_V(8); PG8_WAIT_L(0); PG8_BAR; PG8_MMA(0, 0, At, B0); PG8_MMA(0, 1, At, B1); PG8_BAR; PG8_SCHED;
            PG8_LDA(At, 1, 1); PG8_STAGE(PG8_SB(1, 0), b3, voffB); PG8_STAGE(PG8_SB(1, 1), b3 + hstep, voffB); PG8_STAGE(PG8_SA(1, 0), a3, o0);
            PG8_WAIT_V(8); PG8_WAIT_L(0); PG8_BAR; PG8_MMA(1, 0, At, B0); PG8_MMA(1, 1, At, B1); PG8_BAR; PG8_SCHED;
        }
        if (wr == 0) PG8_BAR;
        if constexpr (FP8) asm volatile("s_nop 15\n\ts_nop 15" ::: "memory");
        E(acc, cur, wr, wc, fr, fq);
        if (!has_next) break;
#pragma unroll
        for (int a = 0; a < 2; ++a)
#pragma unroll
            for (int b = 0; b < 2; ++b)
#pragma unroll
                for (int m = 0; m < 4; ++m)
#pragma unroll
                    for (int n = 0; n < 2; ++n) acc[a][b][m][n] = (f32x4){0.f, 0.f, 0.f, 0.f};
        cur = nxt; cA = nA; cB = nB; ++ui;
        if constexpr (GATHER) {
#pragma unroll
            for (int h = 0; h < 2; ++h) { vA[h][0] = nvA[h][0]; vA[h][1] = nvA[h][1]; } }
        if (wr == 1) PG8_BAR;
    }
    PG8_WAIT_V(0);
    PG8_BAR;
#undef PG8_SA
#undef PG8_SB
#undef PG8_STAGE
#undef PG8_LDA
#undef PG8_LDB
#undef PG8_MMA
#undef PG8_CAT
#undef PG8_WAIT_V
#undef PG8_WAIT_L
#undef PG8_BAR
#undef PG8_SCHED
}

typedef f32x4 Acc[2][2][4][2];
DI u32x4 pack8(const f32x4 a, const f32x4 b) { u32x4 w; w.x = cvtpk(a[0], a[1]); w.y = cvtpk(a[2], a[3]); w.z = cvtpk(b[0], b[1]); w.w = cvtpk(b[2], b[3]); return w; }
DI f32x4 silu4(const f32x4 v) { f32x4 o; o[0] = v[0] * fsigmoid(v[0]); o[1] = v[1] * fsigmoid(v[1]); o[2] = v[2] * fsigmoid(v[2]); o[3] = v[3] * fsigmoid(v[3]); return o; }

struct EpiIn {
    static constexpr bool HAS_MID = false;
    bf16 *Qh, *Vh, *Gh, *Qm, *Km, *Vm, *Rr, *Gb; float *Zf, *KM; const float* bias; bf16* KK; const float* LB; int pn_off;
    DI void operator()(Acc& acc, const Unit& u, int wr, int wc, int fr, int fq) const {
        const int pn = u.pn + pn_off, row0 = u.pm * BM + wr * 64 + fr, cl = wc * 32 + 8 * fq;
        if (pn_off) {
#pragma unroll
            for (int ai = 0; ai < 2; ++ai)
#pragma unroll
                for (int bj = 0; bj < 2; ++bj)
#pragma unroll
                    for (int m = 0; m < 4; ++m) { acc[ai][bj][m][0] *= (1.f / (FP8_SXI * FP8_SW)); acc[ai][bj][m][1] *= (1.f / (FP8_SXI * FP8_SW)); } }
        f32x4 bv[2][2];
#pragma unroll
        for (int bj = 0; bj < 2; ++bj)
#pragma unroll
            for (int n = 0; n < 2; ++n) bv[bj][n] = *(const f32x4*)(bias + pn * 256 + bj * HALF + cl + 4 * n);
        if (pn < 4) {
#define EI_DPP(v, ctrl) __int_as_float(__builtin_amdgcn_update_dpp(0, __float_as_int(v), ctrl, 0xf, 0xf, true))
            const int chb = pn * 128 + cl;
#pragma unroll
            for (int ai = 0; ai < 2; ++ai)
#pragma unroll
                for (int n = 0; n < 2; ++n) { const f32x4 lbv = *(const f32x4*)(LB + chb + 4 * n); f32x4 run = (f32x4){0.f, 0.f, 0.f, 0.f}, bmid = run; f32x4 bbv[4], kkv[4];
#pragma unroll
                    for (int m = 0; m < 4; ++m) {
#pragma unroll
                        for (int j = 0; j < 4; ++j) { const float z = acc[ai][1][m][n][j] + bv[1][n][j]; const float sg = frcp(1.f + __expf(-z)); const float lf = __logf(lbv[j] + (1.f - lbv[j]) * sg); kkv[m][j] = (1.f - lbv[j]) * (1.f - sg);
                            float t = lf; t += EI_DPP(t, 0xB1); t += EI_DPP(t, 0x4E); t += EI_DPP(t, 0x141); t += EI_DPP(t, 0x140);
                            float s = lf; s += EI_DPP(s, 0x111); s += EI_DPP(s, 0x112); s += EI_DPP(s, 0x114); s += EI_DPP(s, 0x118);
                            bbv[m][j] = s + run[j]; run[j] += t; }
                        if (m == 1) bmid = run; }
#pragma unroll
                    for (int m = 0; m < 4; ++m) { f32x4 qp, kp;
#pragma unroll
                        for (int j = 0; j < 4; ++j) { const float qx = acc[ai][0][m][n][j] + bv[0][n][j]; const float e = __expf(bbv[m][j] - bmid[j]); qp[j] = qx * fsigmoid(qx) * e; kp[j] = kkv[m][j] * frcp(e); }
                        const size_t ro = (size_t)(row0 + ai * HALF + m * 16) * 512 + chb + 4 * n;
                        u32x2 qw, kw; qw.x = cvtpk(qp[0], qp[1]); qw.y = cvtpk(qp[2], qp[3]); kw.x = cvtpk(kp[0], kp[1]); kw.y = cvtpk(kp[2], kp[3]);
                        *(u32x2*)(Qh + ro) = qw; *(u32x2*)(KK + ro) = kw; }
                    if (fr == 0) { const size_t so = (size_t)(u.pm * 4 + ai * 2 + wr) * 512 + chb + 4 * n; *(f32x4*)(Zf + so) = bmid; *(f32x4*)(Zf + 262144 + so) = run; }
                    asm volatile("" ::: "memory"); }
#undef EI_DPP
        } else if (pn < 14) {
            const int seg = pn >> 1, c0 = (pn & 1) * 256 + cl;
            {
                bf16* O = seg == 2 ? Vh : seg == 3 ? Gh : seg == 4 ? Qm : seg == 5 ? Km : Vm;
                const int act = (seg == 3) ? 1 : (seg == 4 ? 2 : 0);
                if (seg == 5) {
#pragma unroll
                    for (int bj = 0; bj < 2; ++bj)
#pragma unroll
                        for (int n = 0; n < 2; ++n) { f32x4 cs = (f32x4){0.f, 0.f, 0.f, 0.f};
#pragma unroll
                            for (int ai = 0; ai < 2; ++ai)
#pragma unroll
                                for (int m = 0; m < 4; ++m) cs += acc[ai][bj][m][n] + bv[bj][n];
#pragma unroll
                            for (int j = 0; j < 4; ++j) { float s = cs[j]; s += __shfl_xor(s, 1); s += __shfl_xor(s, 2); s += __shfl_xor(s, 4); s += __shfl_xor(s, 8); cs[j] = s; }
                            if (fr == 0) *(f32x4*)(KM + (size_t)(u.pm * 2 + wr) * 512 + c0 + bj * HALF + 4 * n) = cs; }
                }
#pragma unroll
                for (int ai = 0; ai < 2; ++ai)
#pragma unroll
                    for (int m = 0; m < 4; ++m) { const int row = row0 + ai * HALF + m * 16;
                        bf16* rp = (seg >= 4) ? O + ((size_t)(row >> 11) * 8 * SEQ + (row & (SEQ - 1))) * 64 + (size_t)(c0 >> 6) * SEQ * 64 + (c0 & 63) : O + (size_t)row * 512 + c0;
                        const size_t bjs = (seg >= 4) ? (size_t)2 * SEQ * 64 : (size_t)HALF;
#pragma unroll
                        for (int bj = 0; bj < 2; ++bj) { f32x4 v0 = acc[ai][bj][m][0] + bv[bj][0], v1 = acc[ai][bj][m][1] + bv[bj][1];
                            if (act == 1) { v0 = silu4(v0); v1 = silu4(v1); } else if (act == 2) { v0 = v0 * (0.125f * LOG2E); v1 = v1 * (0.125f * LOG2E); }
                            *(u32x4*)(rp + bj * bjs) = pack8(v0, v1); }
                        asm volatile("" ::: "memory"); }
            }
        } else {
            const int c0 = (pn - 14) * 128 + cl;
#pragma unroll
            for (int ai = 0; ai < 2; ++ai)
#pragma unroll
                for (int m = 0; m < 4; ++m) { const size_t off = (size_t)(row0 + ai * HALF + m * 16) * 1024 + c0; f32x4 r[2], g[2];
#pragma unroll
                    for (int n = 0; n < 2; ++n) { const f32x4 a = acc[ai][0][m][n] + bv[0][n], b = acc[ai][1][m][n] + bv[1][n];
#pragma unroll
                        for (int j = 0; j < 4; ++j) { const float ea = __expf(-a[j]), eb = __expf(-b[j]); g[n][j] = frcp(1.f + eb); r[n][j] = (1.f + eb) * frcp(1.f + ea); } }
                    *(u32x4*)(Rr + off) = pack8(r[0], r[1]); *(u32x4*)(Gb + off) = pack8(g[0], g[1]); asm volatile("" ::: "memory"); }
        }
    }
};
struct EpiProj {
    static constexpr bool HAS_MID = true;
    const bf16 *Rr, *Gb; unsigned char* U;
    DI void scale(Acc& acc, const bf16* G, const Unit& u, int wr, int wc, int fr, int fq) const {
        int row0 = u.pm * BM + wr * 64 + fr, col0 = u.pn * BM + wc * 32 + 8 * fq;
        asm volatile("" : "+v"(row0), "+v"(col0));
#pragma unroll
        for (int ai = 0; ai < 2; ++ai)
#pragma unroll
            for (int mp = 0; mp < 2; ++mp) { u32x4 rv[2][2];
#pragma unroll
            for (int m = 0; m < 2; ++m)
#pragma unroll
                for (int bj = 0; bj < 2; ++bj) rv[m][bj] = *(const u32x4*)(G + (size_t)(row0 + ai * HALF + (2 * mp + m) * 16) * 1024 + col0 + bj * HALF);
#pragma unroll
            for (int m = 0; m < 2; ++m)
#pragma unroll
                for (int bj = 0; bj < 2; ++bj) { const u32x4 w = rv[m][bj];
                    acc[ai][bj][2 * mp + m][0] *= (f32x4){bflo(w.x), bfhi(w.x), bflo(w.y), bfhi(w.y)}; acc[ai][bj][2 * mp + m][1] *= (f32x4){bflo(w.z), bfhi(w.z), bflo(w.w), bfhi(w.w)}; }
            asm volatile("" ::: "memory"); }
    }
    DI void mid(Acc& acc, const Unit& u, int wr, int wc, int fr, int fq) const { scale(acc, Rr, u, wr, wc, fr, fq); }
    DI void operator()(Acc& acc, const Unit& u, int wr, int wc, int fr, int fq) const {
        scale(acc, Gb, u, wr, wc, fr, fq);
        const int row0 = u.pm * BM + wr * 64 + fr, col0 = u.pn * BM + wc * 32 + 8 * fq;
        constexpr float inv = FP8_SU / (FP8_SO * FP8_SW);
#pragma unroll
        for (int ai = 0; ai < 2; ++ai)
#pragma unroll
            for (int m = 0; m < 4; ++m) { unsigned char* rp = U + (size_t)(row0 + ai * HALF + m * 16) * 1024 + col0;
#pragma unroll
                for (int bj = 0; bj < 2; ++bj) { const f32x4 v0 = acc[ai][bj][m][0] * inv, v1 = acc[ai][bj][m][1] * inv; u32x2 w; w.x = cvt4_fp8(v0[0], v0[1], v0[2], v0[3]); w.y = cvt4_fp8(v1[0], v1[1], v1[2], v1[3]); *(u32x2*)(rp + bj * HALF) = w; } }
    }
};
struct EpiOut {
    static constexpr bool HAS_MID = false;
    const bf16* X; bf16* Pre;
    DI void operator()(Acc& acc, const Unit& u, int wr, int wc, int fr, int fq) const {
        int row0 = u.pm * BM + wr * 64 + fr, col0 = u.pn * BM + wc * 32 + 8 * fq;
        asm volatile("" : "+v"(row0), "+v"(col0));
        constexpr float inv = 1.f / (FP8_SU * FP8_SW);
#pragma unroll
        for (int ai = 0; ai < 2; ++ai) { u32x4 xv[4][2];
#pragma unroll
            for (int m = 0; m < 4; ++m)
#pragma unroll
                for (int bj = 0; bj < 2; ++bj) xv[m][bj] = *(const u32x4*)(X + (size_t)(row0 + ai * HALF + m * 16) * 1024 + col0 + bj * HALF);
#pragma unroll
            for (int m = 0; m < 4; ++m)
#pragma unroll
                for (int bj = 0; bj < 2; ++bj) { const u32x4 w = xv[m][bj];
                    const f32x4 v0 = (f32x4){bflo(w.x), bfhi(w.x), bflo(w.y), bfhi(w.y)} * DN_ALPHA + acc[ai][bj][m][0] * inv, v1 = (f32x4){bflo(w.z), bfhi(w.z), bflo(w.w), bfhi(w.w)} * DN_ALPHA + acc[ai][bj][m][1] * inv;
                    *(u32x4*)(Pre + (size_t)(row0 + ai * HALF + m * 16) * 1024 + col0 + bj * HALF) = pack8(v0, v1); }
            asm volatile("" ::: "memory"); }
    }
};
struct EpiM1 {
    static constexpr bool HAS_MID = false;
    unsigned char* H;
    DI void operator()(Acc& acc, const Unit& u, int wr, int wc, int fr, int fq) const {
        const int row0 = u.pm * BM + wr * 64 + fr, col0 = u.pn * 128 + wc * 32 + 8 * fq;
        constexpr float inv = 1.f / (FP8_SX * FP8_SW);
#pragma unroll
        for (int ai = 0; ai < 2; ++ai)
#pragma unroll
            for (int m = 0; m < 4; ++m) { const f32x4 h0 = silu4(acc[ai][0][m][0] * inv) * (acc[ai][1][m][0] * (inv * FP8_SH)), h1 = silu4(acc[ai][0][m][1] * inv) * (acc[ai][1][m][1] * (inv * FP8_SH));
                u32x2 w; w.x = cvt4_fp8(h0[0], h0[1], h0[2], h0[3]); w.y = cvt4_fp8(h1[0], h1[1], h1[2], h1[3]);
                *(u32x2*)(H + (size_t)(row0 + ai * HALF + m * 16) * 512 + col0) = w; }
    }
};
struct EpiM2 {
    static constexpr bool HAS_MID = false;
    unsigned char* Y;
    DI void operator()(Acc& acc, const Unit& u, int wr, int wc, int fr, int fq) const {
        const int row0 = u.pm * BM + wr * 64 + fr, col0 = u.pn * BM + wc * 32 + 8 * fq;
        constexpr float inv = FP8_SY / (FP8_SH * FP8_SW);
#pragma unroll
        for (int ai = 0; ai < 2; ++ai)
#pragma unroll
            for (int m = 0; m < 4; ++m) { unsigned char* rp = Y + (size_t)(row0 + ai * HALF + m * 16) * 1024 + col0;
#pragma unroll
                for (int bj = 0; bj < 2; ++bj) { const f32x4 v0 = acc[ai][bj][m][0] * inv, v1 = acc[ai][bj][m][1] * inv; u32x2 w; w.x = cvt4_fp8(v0[0], v0[1], v0[2], v0[3]); w.y = cvt4_fp8(v1[0], v1[1], v1[2], v1[3]); *(u32x2*)(rp + bj * HALF) = w; } }
    }
};
}

struct Args { const float* in[19]; float* out; unsigned char* ws; int ph_lo, ph_hi; };
enum { I_X = 0, I_WIN, I_BIN, I_LBL, I_HGNG, I_RELB, I_WPA, I_WPB, I_WOUT, I_LN1G, I_LN1B, I_WGRP, I_BGRP, I_WEXP, I_BEXP, I_WGU, I_WDN, I_LN2G, I_LN2B };

struct Ctx {
    LAS unsigned char* lds; volatile LAS unsigned* MISC;
    int tid, lane, wid, G, vcu;
    unsigned char* ws; gu32* ctl;
};

DI int win_drow(int n0) { if (n0 < 512) return 256 * (n0 >> 7) + (n0 & 127); if (n0 < 1024) { const int r = n0 - 512; return 256 * (r >> 7) + 128 + (r & 127); }
    if (n0 < 3584) return n0; if (n0 < 4608) { const int r = n0 - 3584; return 3584 + 256 * (r >> 7) + (r & 127); } const int r = n0 - 4608; return 3584 + 256 * (r >> 7) + 128 + (r & 127); }
DI int wgu_drow(int n0) { if (n0 < 512) return 256 * (n0 >> 7) + (n0 & 127); const int r = n0 - 512; return 256 * (r >> 7) + 128 + (r & 127); }
DI int hswz(int row, int ch16) { return 256 * row + 16 * (ch16 ^ (((row & 3) << 2) | ((row >> 2) & 3))); }
DI int htr(int r0, int c0, int lane) { const int i16 = lane & 15, q = i16 >> 2, p = i16 & 3; return hswz(r0 + q, c0 + (p >> 1)) + 8 * (p & 1); }
DI void transpose_tile256(const float* W, int N, bf16* WT, int ldk, int n0, int mode, int dk, LAS unsigned char* lds, int lane, int wid, bool f8 = false) {
    asm volatile("" : "+v"(lane));
#pragma unroll
    for (int half = 0; half < 2; ++half) { f32x4 v[16];
#pragma unroll
        for (int i = 0; i < 16; ++i) v[i] = *(const f32x4*)(W + (size_t)(128 * half + 8 * i + wid) * N + 4 * lane);
#pragma unroll
        for (int i = 0; i < 16; ++i) { const int k = 128 * half + 8 * i + wid; u32x2 w; w.x = cvtpk(v[i][0], v[i][1]); w.y = cvtpk(v[i][2], v[i][3]);
            *(LAS u32x2*)(lds + (lane >> 5) * 65536 + hswz(k, (lane & 31) >> 1) + 8 * (lane & 1)) = w; } }
    __syncthreads();
    const int g = lane >> 4, i16 = lane & 15;
#pragma unroll
    for (int nb = 0; nb < 2; ++nb) { const int nl = 32 * wid + 16 * nb + i16, n = n0 + nl; const int dr = (mode == 0) ? n : (mode == 1 ? win_drow(n) : wgu_drow(n));
        bf16* orow = WT + (size_t)dr * ldk + dk + 8 * g; const LAS unsigned char* img = lds + (wid >> 2) * 65536;
#pragma unroll
        for (int s = 0; s < 8; ++s) { const int r0 = 32 * s + 8 * g, c0 = 4 * (wid & 3) + 2 * nb;
            const s16x4 lo = vtr((LAS const char*)(img + htr(r0, c0, lane))), hh = vtr((LAS const char*)(img + htr(r0 + 4, c0, lane)));
            if (f8) { u32x2 w; w.x = cvt4_fp8(bf2f((unsigned short)lo[0]) * FP8_SW, bf2f((unsigned short)lo[1]) * FP8_SW, bf2f((unsigned short)lo[2]) * FP8_SW, bf2f((unsigned short)lo[3]) * FP8_SW);
                w.y = cvt4_fp8(bf2f((unsigned short)hh[0]) * FP8_SW, bf2f((unsigned short)hh[1]) * FP8_SW, bf2f((unsigned short)hh[2]) * FP8_SW, bf2f((unsigned short)hh[3]) * FP8_SW);
                *(u32x2*)((unsigned char*)WT + (size_t)dr * ldk + dk + 8 * g + 32 * s) = w; }
            else *(bf16x8*)(orow + 32 * s) = (bf16x8){lo[0], lo[1], lo[2], lo[3], hh[0], hh[1], hh[2], hh[3]}; } }
    __syncthreads();
}
constexpr int MOE_CVT_TILES = 32 * 16 + 32 * 8;
DI void moe_cvt_tile(const Ctx& C, const Args& a, int it) {
    unsigned char* WguT = (unsigned char*)a.out; unsigned char* WdT = (unsigned char*)a.out + 32 * MiB;
    if (it < 512) { const int e = it >> 4, kt = (it >> 2) & 3, nt = it & 3;
        transpose_tile256(a.in[I_WGU] + (size_t)e * 1024 * 1024 + (size_t)(256 * kt) * 1024 + 256 * nt, 1024, (bf16*)(WguT + (size_t)e * 1024 * 1024), 1024, 256 * nt, 2, 256 * kt, C.lds, C.lane, C.wid, true); }
    else { const int r = it - 512, e = r >> 3, kt = (r >> 2) & 1, nt = r & 3;
        transpose_tile256(a.in[I_WDN] + (size_t)e * 512 * 1024 + (size_t)(256 * kt) * 1024 + 256 * nt, 1024, (bf16*)(WdT + (size_t)e * 1024 * 512), 512, 256 * nt, 0, 256 * kt, C.lds, C.lane, C.wid, true); }
}
DI void p0_prologue(const Ctx& C, const Args& a) {
    bf16* WinT = (bf16*)(C.ws + WS_WIN); bf16* Wcat = (bf16*)(C.ws + WS_WCAT); bf16* WoT = (bf16*)(C.ws + WS_WO);
    constexpr int I_IN = 4 * 22, I_PA = 2 * 4, I_O = 4 * 4, NITEMS = I_IN + 2 * I_PA + I_O;
    for (int it = C.vcu; it < NITEMS; it += C.G) {
        int r = it;
        if (r < I_IN) { const int kt = r / 22, nt = r % 22;
            if (nt < 4) transpose_tile256(a.in[I_WIN] + (size_t)(256 * kt) * NIN + 256 * nt, NIN, WinT, 1024, 256 * nt, 1, 256 * kt, C.lds, C.lane, C.wid);
            else transpose_tile256(a.in[I_WIN] + (size_t)(256 * kt) * NIN + 256 * nt, NIN, (bf16*)(C.ws + WS_WIN + 2 * MiB - (size_t)1024 * 1024), 1024, 256 * nt, 1, 256 * kt, C.lds, C.lane, C.wid, true);
            continue; } r -= I_IN;
        if (r < I_PA) { const int kt = r / 4, nt = r % 4; transpose_tile256(a.in[I_WPA] + (size_t)(256 * kt) * 1024 + 256 * nt, 1024, Wcat, 1024, 256 * nt, 0, 256 * kt, C.lds, C.lane, C.wid, true); continue; } r -= I_PA;
        if (r < I_PA) { const int kt = r / 4, nt = r % 4; transpose_tile256(a.in[I_WPB] + (size_t)(256 * kt) * 1024 + 256 * nt, 1024, Wcat, 1024, 256 * nt, 0, 512 + 256 * kt, C.lds, C.lane, C.wid, true); continue; } r -= I_PA;
        { const int kt = r / 4, nt = r % 4; transpose_tile256(a.in[I_WOUT] + (size_t)(256 * kt) * 1024 + 256 * nt, 1024, WoT, 1024, 256 * nt, 0, 256 * kt, C.lds, C.lane, C.wid, true); }
    }
    const int gw = C.vcu * NWAVES + C.wid, NGW = C.G * NWAVES; (void)gw; (void)NGW;
    const int gt = C.vcu * NTHREADS + C.tid, NT = C.G * NTHREADS;
    { const float* x = a.in[I_X]; bf16* Xb = (bf16*)(C.ws + WS_XB);
      unsigned char* Xq = (unsigned char*)a.out + 64 * MiB;
      for (int i = gt; i < NTOK * DM / 8; i += NT) { const f32x4 v0 = *(const f32x4*)(x + (size_t)i * 8), v1 = *(const f32x4*)(x + (size_t)i * 8 + 4); *(u32x4*)(Xb + (size_t)i * 8) = pg8::pack8(v0, v1);
          u32x2 q; q.x = cvt4_fp8(v0[0] * FP8_SXI, v0[1] * FP8_SXI, v0[2] * FP8_SXI, v0[3] * FP8_SXI); q.y = cvt4_fp8(v1[0] * FP8_SXI, v1[1] * FP8_SXI, v1[2] * FP8_SXI, v1[3] * FP8_SXI); *(u32x2*)(Xq + (size_t)i * 8) = q; } }
    { float* lbp = (float*)(C.ws + WS_LB); for (int n = gt; n < 512; n += NT) lbp[n] = 1.f / (1.f + expf(a.in[I_LBL][512 + n] - a.in[I_LBL][n])); }
    { float* bp = (float*)(C.ws + WS_BPERM); const float* bin = a.in[I_BIN];
      for (int n = gt; n < NIN; n += NT) bp[win_drow(n & ~31) + (n & 31)] = bin[n]; }
    { bf16* wh = (bf16*)(C.ws + WS_WRH); bf16* wl = (bf16*)(C.ws + WS_WRL); const float* wg = a.in[I_WGRP]; const float* we = a.in[I_WEXP];
      for (int i = gt; i < 48 * 1024; i += NT) { const int j = i >> 10, k = i & 1023; float w = 0.f; if (j < 4) w = wg[k * 4 + j]; else if (j < 36) w = we[k * 32 + (j - 4)];
          const unsigned h = cvtpk(w, 0.f) & 0xffffu; const float r = w - bf2f((unsigned short)h); wh[i] = (bf16)h; wl[i] = (bf16)(cvtpk(r, 0.f) & 0xffffu); } }
}
constexpr int HG_BUF = 67072, HG_QP = 0, HG_KP = 16384, HG_V = 32768, HG_SC = 49152, HG_OB = 49664;
DI void hgrn_unit(const Ctx& C, const Args& a, int b, int h) {
    LAS unsigned char* L = C.lds;
    const int tid = C.tid, lane = C.lane, wid = C.wid;
    const int q32 = lane & 31, hi = lane >> 5, dh = (lane >> 4) & 1, dvb = wid & 3, tb = wid >> 2;
    const float* BM = (const float*)(C.ws + WS_ZF); const float* BE = BM + 262144;
    const bf16* Qh = (const bf16*)(C.ws + WS_QH); const bf16* Kh = (const bf16*)(C.ws + WS_KK); const bf16* Vh = (const bf16*)(C.ws + WS_VH); const bf16* Gh = (const bf16*)(C.ws + WS_GH);
    bf16* Ocat = (bf16*)(C.ws + WS_OCAT);
    const size_t rb = (size_t)b * SEQ;
    LAS float* NGS = (LAS float*)(L + 2 * HG_BUF);
    if (tid < 128) NGS[tid] = a.in[I_HGNG][h * 128 + tid];
    const int orow = tid >> 3, oseg = tid & 7;
    f32x16 T[4];
#pragma unroll
    for (int i = 0; i < 4; ++i)
#pragma unroll
        for (int r = 0; r < 16; ++r) T[i][r] = 0.f;
    u32x4 gr[2];
    const int drow = 8 * wid + (lane >> 4), dch = lane & 15;
#define HG_DMA(c) do { _Pragma("unroll") for (int p = 0; p < 2; ++p) { const int r_ = drow + 4 * p; const int sc_ = dch ^ (((r_ & 3) << 2) | ((r_ >> 2) & 3)); \
            const size_t g_ = (rb + (size_t)(c) * 64 + r_) * 512 + h * 128 + 8 * sc_; LAS unsigned char* d_ = L + ((c) & 1) * HG_BUF + (8 * wid + 4 * p) * 256; \
            __builtin_amdgcn_global_load_lds((const unsigned*)(Qh + g_), (LAS unsigned*)(d_ + HG_QP), 16, 0, 0); \
            __builtin_amdgcn_global_load_lds((const unsigned*)(Kh + g_), (LAS unsigned*)(d_ + HG_KP), 16, 0, 0); \
            __builtin_amdgcn_global_load_lds((const unsigned*)(Vh + g_), (LAS unsigned*)(d_ + HG_V), 16, 0, 0); } } while (0)
    float sm = 0.f, spe = 0.f, spm = 0.f;
#define HG_SCLOAD(c) do { if (tid < 128) { const size_t s_ = (size_t)(b * 32 + (c)) * 512 + h * 128 + tid; sm = BM[s_]; if ((c) > 0) { spe = BE[s_ - 512]; spm = BM[s_ - 512]; } } } while (0)
#define HG_SCALE(c) do { if (tid < 128) ((LAS float*)(L + ((c) & 1) * HG_BUF + HG_SC))[tid] = __expf(sm + (spe - spm)); } while (0)
    HG_DMA(0);
    HG_SCLOAD(0);
    HG_SCALE(0);
    asm volatile("s_waitcnt vmcnt(0)" ::: "memory");
    __syncthreads();
    for (int c = 0; c < 32; ++c) {
        const LAS unsigned char* B = L + (c & 1) * HG_BUF;
        if (c + 1 < 32) { HG_DMA(c + 1); HG_SCLOAD(c + 1); }
        int q32o = q32, hio = hi, laneo = lane; asm volatile("" : "+v"(q32o), "+v"(hio), "+v"(laneo));
        f32x16 oT;
#pragma unroll
        for (int r = 0; r < 16; ++r) oT[r] = 0.f;
        bf16x8 qb[8];
#pragma unroll
        for (int ks = 0; ks < 8; ++ks) qb[ks] = *(const LAS bf16x8*)(B + HG_QP + hswz(32 * tb + q32o, 2 * ks + hio));
#pragma unroll
        for (int sb = 0; sb < 2; ++sb) {
            if (sb <= tb) {
                bf16x8 ka[8];
#pragma unroll
                for (int ks = 0; ks < 8; ++ks) ka[ks] = *(const LAS bf16x8*)(B + HG_KP + hswz(32 * sb + q32o, 2 * ks + hio));
                s16x4 vl[2], vh[2];
#pragma unroll
                for (int s2 = 0; s2 < 2; ++s2) { const int r0 = 32 * sb + 16 * s2 + 4 * hio; vl[s2] = vtr((LAS const char*)(B + HG_V + htr(r0, 4 * dvb + 2 * dh, laneo))); vh[s2] = vtr((LAS const char*)(B + HG_V + htr(r0 + 8, 4 * dvb + 2 * dh, laneo))); }
                __builtin_amdgcn_sched_barrier(0);
                f32x16 pT;
#pragma unroll
                for (int r = 0; r < 16; ++r) pT[r] = 0.f;
#pragma unroll
                for (int ks = 0; ks < 8; ++ks) pT = MFMA32(ka[ks], qb[ks], pT);
                if (sb == tb) {
#pragma unroll
                    for (int r = 0; r < 16; ++r) if (crow(r, hi) > q32) pT[r] = 0.f;
                }
#pragma unroll
                for (int s2 = 0; s2 < 2; ++s2) { u32x4 pw; pw.x = cvtpk(pT[8 * s2 + 0], pT[8 * s2 + 1]); pw.y = cvtpk(pT[8 * s2 + 2], pT[8 * s2 + 3]); pw.z = cvtpk(pT[8 * s2 + 4], pT[8 * s2 + 5]); pw.w = cvtpk(pT[8 * s2 + 6], pT[8 * s2 + 7]);
                    oT = MFMA32(((bf16x8){vl[s2][0], vl[s2][1], vl[s2][2], vl[s2][3], vh[s2][0], vh[s2][1], vh[s2][2], vh[s2][3]}), __builtin_bit_cast(bf16x8, pw), oT); }
                __builtin_amdgcn_sched_barrier(0);
            }
        }
        { const size_t g0 = (rb + (size_t)c * 64 + orow) * 512 + h * 128 + 16 * oseg; gr[0] = *(const u32x4*)(Gh + g0); gr[1] = *(const u32x4*)(Gh + g0 + 8); }
        {
            u32x2 qq0[8], qq1[8];
            if (c > 0) {
#pragma unroll
                for (int i = 0; i < 4; ++i)
#pragma unroll
                    for (int s = 0; s < 2; ++s) { qq0[2 * i + s] = *(const LAS u32x2*)(B + HG_QP + hswz(32 * tb + q32o, 4 * i + 2 * s) + 8 * hio); qq1[2 * i + s] = *(const LAS u32x2*)(B + HG_QP + hswz(32 * tb + q32o, 4 * i + 2 * s + 1) + 8 * hio); }
            }
#pragma unroll
            for (int i = 0; i < 4; ++i)
#pragma unroll
                for (int g = 0; g < 4; ++g) { const f32x4 sc = *(const LAS f32x4*)(B + HG_SC + (32 * i + 8 * g + 4 * hio) * 4);
#pragma unroll
                    for (int j = 0; j < 4; ++j) T[i][4 * g + j] *= sc[j]; }
            __builtin_amdgcn_sched_barrier(0);
            if (c > 0) {
#pragma unroll
                for (int i = 0; i < 4; ++i)
#pragma unroll
                    for (int s = 0; s < 2; ++s) { u32x4 tw; tw.x = cvtpk(T[i][8 * s + 0], T[i][8 * s + 1]); tw.y = cvtpk(T[i][8 * s + 2], T[i][8 * s + 3]); tw.z = cvtpk(T[i][8 * s + 4], T[i][8 * s + 5]); tw.w = cvtpk(T[i][8 * s + 6], T[i][8 * s + 7]);
                        const u32x4 qw = (u32x4){qq0[2 * i + s].x, qq0[2 * i + s].y, qq1[2 * i + s].x, qq1[2 * i + s].y};
                        oT = MFMA32(__builtin_bit_cast(bf16x8, tw), __builtin_bit_cast(bf16x8, qw), oT); }
            }
        }
        { LAS unsigned char* OBp = L + (c & 1) * HG_BUF + HG_OB;
#pragma unroll
          for (int g = 0; g < 4; ++g) { u32x2 w; w.x = cvtpk(oT[4 * g], oT[4 * g + 1]); w.y = cvtpk(oT[4 * g + 2], oT[4 * g + 3]); *(LAS u32x2*)(OBp + (32 * tb + q32o) * 272 + (32 * dvb + 8 * g + 4 * hio) * 2) = w; } }
#pragma unroll
        for (int sp = 0; sp < 2; ++sp) {
            s16x4 vl[2], vh[2], kl[2][4], kh[2][4];
#pragma unroll
            for (int u = 0; u < 2; ++u) { const int r0 = 16 * (2 * sp + u) + 8 * hio;
                vl[u] = vtr((LAS const char*)(B + HG_V + htr(r0, 4 * dvb + 2 * dh, laneo))); vh[u] = vtr((LAS const char*)(B + HG_V + htr(r0 + 4, 4 * dvb + 2 * dh, laneo)));
#pragma unroll
                for (int i = 0; i < 4; ++i) { kl[u][i] = vtr((LAS const char*)(B + HG_KP + htr(r0, 4 * i + 2 * dh, laneo))); kh[u][i] = vtr((LAS const char*)(B + HG_KP + htr(r0 + 4, 4 * i + 2 * dh, laneo))); } }
            __builtin_amdgcn_sched_barrier(0);
#pragma unroll
            for (int u = 0; u < 2; ++u) { const bf16x8 vb = (bf16x8){vl[u][0], vl[u][1], vl[u][2], vl[u][3], vh[u][0], vh[u][1], vh[u][2], vh[u][3]};
#pragma unroll
                for (int i = 0; i < 4; ++i) T[i] = MFMA32(((bf16x8){kl[u][i][0], kl[u][i][1], kl[u][i][2], kl[u][i][3], kh[u][i][0], kh[u][i][1], kh[u][i][2], kh[u][i][3]}), vb, T[i]); }
            __builtin_amdgcn_sched_barrier(0);
        }
        if (c + 1 < 32) HG_SCALE(c + 1);
        asm volatile("s_waitcnt vmcnt(0)" ::: "memory");
        __syncthreads();
        { const LAS unsigned char* OBp = L + (c & 1) * HG_BUF + HG_OB + orow * 272 + oseg * 32;
          const u32x4 o0 = *(const LAS u32x4*)OBp, o1 = *(const LAS u32x4*)(OBp + 16);
          float ov[16];
          ov[0] = bflo(o0.x); ov[1] = bfhi(o0.x); ov[2] = bflo(o0.y); ov[3] = bfhi(o0.y); ov[4] = bflo(o0.z); ov[5] = bfhi(o0.z); ov[6] = bflo(o0.w); ov[7] = bfhi(o0.w);
          ov[8] = bflo(o1.x); ov[9] = bfhi(o1.x); ov[10] = bflo(o1.y); ov[11] = bfhi(o1.y); ov[12] = bflo(o1.z); ov[13] = bfhi(o1.z); ov[14] = bflo(o1.w); ov[15] = bfhi(o1.w);
          float ss = 0.f;
#pragma unroll
          for (int j = 0; j < 16; ++j) ss += ov[j] * ov[j];
          ss += __int_as_float(__builtin_amdgcn_update_dpp(0, __float_as_int(ss), 0xB1, 0xf, 0xf, true));
          ss += __int_as_float(__builtin_amdgcn_update_dpp(0, __float_as_int(ss), 0x4E, 0xf, 0xf, true));
          ss += __int_as_float(__builtin_amdgcn_update_dpp(0, __float_as_int(ss), 0x141, 0xf, 0xf, true));
          const float rs = __builtin_amdgcn_rsqf(ss * (1.f / 128.f) + LN_EPS);
          float ng[16];
#pragma unroll
          for (int i = 0; i < 4; ++i) { const f32x4 n_ = *(const LAS f32x4*)(NGS + 16 * oseg + 4 * i); ng[4 * i] = n_[0]; ng[4 * i + 1] = n_[1]; ng[4 * i + 2] = n_[2]; ng[4 * i + 3] = n_[3]; }
          float gvv[16];
          gvv[0] = bflo(gr[0].x); gvv[1] = bfhi(gr[0].x); gvv[2] = bflo(gr[0].y); gvv[3] = bfhi(gr[0].y); gvv[4] = bflo(gr[0].z); gvv[5] = bfhi(gr[0].z); gvv[6] = bflo(gr[0].w); gvv[7] = bfhi(gr[0].w);
          gvv[8] = bflo(gr[1].x); gvv[9] = bfhi(gr[1].x); gvv[10] = bflo(gr[1].y); gvv[11] = bfhi(gr[1].y); gvv[12] = bflo(gr[1].z); gvv[13] = bfhi(gr[1].z); gvv[14] = bflo(gr[1].w); gvv[15] = bfhi(gr[1].w);
          float rv[16];
#pragma unroll
          for (int j = 0; j < 16; ++j) rv[j] = ov[j] * (rs * FP8_SO) * ng[j] * gvv[j];
          u32x4 w0; w0.x = cvt4_fp8(rv[0], rv[1], rv[2], rv[3]); w0.y = cvt4_fp8(rv[4], rv[5], rv[6], rv[7]); w0.z = cvt4_fp8(rv[8], rv[9], rv[10], rv[11]); w0.w = cvt4_fp8(rv[12], rv[13], rv[14], rv[15]);
          unsigned char* op = (unsigned char*)Ocat + (rb + (size_t)c * 64 + orow) * 1024 + h * 128 + 16 * oseg;
          *(u32x4*)op = w0; }
    }
    __syncthreads();
#undef HG_DMA
#undef HG_SCALE
#undef HG_SCLOAD
}

constexpr int AT_NST = 4, AT_K = 0, AT_V = AT_NST * 8192, AT_KM = 2 * AT_NST * 8192, AT_TAB = AT_KM + 1792;
DI int t5_bucket(int d) { if (d < 16) return d; const int v = 16 + (int)(logf((float)d * (1.f / 16.f)) / logf(8.f) * 16.f); return v < 31 ? v : 31; }
DI void glds16(const void* gsrc, unsigned lds_dst) { unsigned keep;
    asm volatile("s_mov_b32 %0, m0\n\ts_mov_b32 m0, %2\n\ts_nop 0\n\tglobal_load_lds_dwordx4 %1, off\n\ts_mov_b32 m0, %0" : "=&s"(keep) : "v"(gsrc), "s"(lds_dst) : "memory"); }
DI float max3f(float a, float b, float c) { float r; asm("v_max3_f32 %0, %1, %2, %3" : "=v"(r) : "v"(a), "v"(b), "v"(c)); return r; }
DI void attn_unit(const Ctx& C, const Args& a, int b, int h, int jq) {
    LAS unsigned char* L = C.lds;
    const int tid = C.tid, lane = C.lane, wid = C.wid, q32 = lane & 31, hi = lane >> 5;
    const bf16* Qm = (const bf16*)(C.ws + WS_QM); const bf16* Km = (const bf16*)(C.ws + WS_KM); const bf16* Vm = (const bf16*)(C.ws + WS_VM); const float* KM = (const float*)(C.ws + WS_KMEAN);
    bf16* Ocat = (bf16*)(C.ws + WS_OCAT);
    const int tq = jq * 256 + wid * 32 + q32;
    const size_t hb = (size_t)(b * 8 + h) * SEQ;
    bf16x8 qf[4];
#pragma unroll
    for (int ks = 0; ks < 4; ++ks) qf[ks] = *(const bf16x8*)(Qm + (hb + tq) * 64 + 16 * ks + 8 * hi);
    LAS float* kml = (LAS float*)(L + AT_KM); LAS float* tab = (LAS float*)(L + AT_TAB);
    if (tid < jq * 64) { const int n = tid >> 6, d = tid & 63; kml[tid] = KM[(size_t)((b * 8 + n) * 2 + 0) * 512 + h * 64 + d] + KM[(size_t)((b * 8 + n) * 2 + 1) * 512 + h * 64 + d]; }
    if (tid < 129) tab[tid] = (a.in[I_RELB][t5_bucket(tid) * 8 + h] - a.in[I_RELB][31 * 8 + h]) * LOG2E;
    const int drow = 8 * wid + (lane >> 3), dch = lane & 7;
    const bf16* ksrc = Km + (hb + drow) * 64 + 8 * (dch ^ ((drow >> 1) & 7));
    const bf16* vsrc = Vm + (hb + drow) * 64 + 8 * (dch ^ (((drow >> 1) & 1) << 2));
    const unsigned kdst = (unsigned)__builtin_amdgcn_readfirstlane((int)(unsigned)(size_t)(L + AT_K + wid * 1024)), vdst = (unsigned)__builtin_amdgcn_readfirstlane((int)(unsigned)(size_t)(L + AT_V + wid * 1024));
    const int nt = 4 * jq + 4;
#define AT_ISSUE(t) do { glds16(ksrc + (size_t)(t) * 4096, kdst + ((t) & 3) * 8192); glds16(vsrc + (size_t)(t) * 4096, vdst + ((t) & 3) * 8192); } while (0)
    AT_ISSUE(0); AT_ISSUE(1); AT_ISSUE(2);
    __syncthreads();
    unsigned sel = 0;
    {
        float g[7];
#pragma unroll
        for (int n = 0; n < 7; ++n) { g[n] = 0.f;
            if (n < jq) { float s = 0.f;
#pragma unroll
                for (int ks = 0; ks < 4; ++ks)
#pragma unroll
                    for (int j = 0; j < 8; ++j) s += bf2f((unsigned short)qf[ks][j]) * kml[n * 64 + 16 * ks + 8 * hi + j];
                s += __shfl_xor(s, 32); g[n] = s; } }
#pragma unroll
        for (int n = 0; n < 7; ++n) if (n < jq) { int rank = 0;
#pragma unroll
            for (int m = 0; m < 7; ++m) if (m != n && m < jq) rank += (g[m] > g[n] || (g[m] == g[n] && m < n)) ? 1 : 0;
            if (rank < 3) sel |= 1u << n; }
    }
    const float c31 = a.in[I_RELB][31 * 8 + h] * LOG2E;
    f32x16 lacc;
#pragma unroll
    for (int r = 0; r < 16; ++r) lacc[r] = 0.f;
    const bf16x8 ones8 = (bf16x8){0x3F80, 0x3F80, 0x3F80, 0x3F80, 0x3F80, 0x3F80, 0x3F80, 0x3F80};
    f32x16 negm;
#pragma unroll
    for (int r = 0; r < 16; ++r) negm[r] = c31;
    f32x16 o0, o1;
#pragma unroll
    for (int r = 0; r < 16; ++r) { o0[r] = 0.f; o1[r] = 0.f; }
    const int i16 = lane & 15, qq = i16 >> 2, pp = i16 & 3, dh = (lane >> 4) & 1, xsw = (qq >> 1) & 1;
    const int vb0 = (4 * hi + qq) * 128 + 64 * (0 ^ xsw) + 32 * dh + 8 * pp, vb1 = (4 * hi + qq) * 128 + 64 * (1 ^ xsw) + 32 * dh + 8 * pp;
    const int kxs = (q32 >> 1) & 7;
    for (int kt = 0; kt < nt; ++kt) {
        if (kt + 2 < nt) asm volatile("s_waitcnt vmcnt(4)" ::: "memory"); else if (kt + 1 < nt) asm volatile("s_waitcnt vmcnt(2)" ::: "memory"); else asm volatile("s_waitcnt vmcnt(0)" ::: "memory");
        __builtin_amdgcn_s_barrier();
        asm volatile("" ::: "memory");
        if (kt + 3 < nt) AT_ISSUE(kt + 3);
        const int blk = kt >> 2; const bool own = (blk == jq);
        const bool active = !own || ((kt & 3) * 64 <= wid * 32 + 31);
        if (active) {
            const LAS unsigned char* Kc = L + AT_K + (kt & 3) * 8192; const LAS unsigned char* Vc = L + AT_V + (kt & 3) * 8192;
            bf16x8 kf[8];
#pragma unroll
            for (int ks = 0; ks < 4; ++ks) { const int ko = (((2 * ks + hi) ^ kxs) << 4); kf[2 * ks] = *(const LAS bf16x8*)(Kc + q32 * 128 + ko); kf[2 * ks + 1] = *(const LAS bf16x8*)(Kc + (32 + q32) * 128 + ko); }
            __builtin_amdgcn_sched_barrier(0);
            f32x16 s0 = negm, s1 = negm;
#pragma unroll
            for (int ks = 0; ks < 4; ++ks) { s0 = MFMA32(kf[2 * ks], qf[ks], s0); s1 = MFMA32(kf[2 * ks + 1], qf[ks], s1); }
            __builtin_amdgcn_sched_barrier(0);
            s16x4 vf[2][4][2];
#pragma unroll
            for (int j = 0; j < 4; ++j) { const int ro = 16 * j * 128;
                vf[0][j][0] = vtr((LAS const char*)(Vc + vb0 + ro)); vf[0][j][1] = vtr((LAS const char*)(Vc + vb0 + ro + 8 * 128));
                vf[1][j][0] = vtr((LAS const char*)(Vc + vb1 + ro)); vf[1][j][1] = vtr((LAS const char*)(Vc + vb1 + ro + 8 * 128)); }
            __builtin_amdgcn_sched_barrier(0);
            const bool near = (jq * 256 + wid * 32 - 64 * kt - 63) < 128;
            if (near) {
                const int dist0 = tq - 64 * kt - 4 * hi;
#pragma unroll
                for (int r = 0; r < 16; ++r) { const int d0 = dist0 - ((r & 3) + 8 * (r >> 2)), d1 = d0 - 32;
                    const int i0 = d0 < 0 ? 0 : (d0 > 128 ? 128 : d0), i1 = d1 < 0 ? 0 : (d1 > 128 ? 128 : d1);
                    const float t0 = tab[i0], t1 = tab[i1]; s0[r] += t0; s1[r] += t1; s0[r] = d0 < 0 ? -INFINITY : s0[r]; s1[r] = d1 < 0 ? -INFINITY : s1[r]; }
            }
            const bool lsel = own || ((sel >> blk) & 1u);
            float mx = max3f(s0[0], s1[0], s0[1]), mx2 = max3f(s1[1], s0[2], s1[2]);
#pragma unroll
            for (int r = 3; r < 15; r += 2) { mx = max3f(mx, s0[r], s1[r]); mx2 = max3f(mx2, s0[r + 1], s1[r + 1]); }
            mx = max3f(mx, s0[15], s1[15]); mx = fmaxf(mx, mx2);
            mx = lsel ? mx : -INFINITY;
            mx = fmaxf(mx, __shfl_xor(mx, 32));
            if (__any(mx > 4.0f)) {
                const float delta = fmaxf(mx, 0.f), alpha = __builtin_amdgcn_exp2f(-delta);
#pragma unroll
                for (int r = 0; r < 16; ++r) { o0[r] *= alpha; o1[r] *= alpha; lacc[r] *= alpha; negm[r] -= delta; s0[r] -= delta; s1[r] -= delta; }
            }
#pragma unroll
            for (int r = 0; r < 16; ++r) { s0[r] = __builtin_amdgcn_exp2f(s0[r]); s1[r] = __builtin_amdgcn_exp2f(s1[r]); }
            const unsigned pmask = lsel ? 0xffffffffu : 0u;
#pragma unroll
            for (int kb = 0; kb < 2; ++kb)
#pragma unroll
                for (int s2 = 0; s2 < 2; ++s2) {
                    u32x4 pw;
                    if (kb == 0) { pw.x = cvtpk(s0[8 * s2 + 0], s0[8 * s2 + 1]); pw.y = cvtpk(s0[8 * s2 + 2], s0[8 * s2 + 3]); pw.z = cvtpk(s0[8 * s2 + 4], s0[8 * s2 + 5]); pw.w = cvtpk(s0[8 * s2 + 6], s0[8 * s2 + 7]); }
                    else         { pw.x = cvtpk(s1[8 * s2 + 0], s1[8 * s2 + 1]); pw.y = cvtpk(s1[8 * s2 + 2], s1[8 * s2 + 3]); pw.z = cvtpk(s1[8 * s2 + 4], s1[8 * s2 + 5]); pw.w = cvtpk(s1[8 * s2 + 6], s1[8 * s2 + 7]); }
                    pw.x &= pmask; pw.y &= pmask; pw.z &= pmask; pw.w &= pmask;
                    const bf16x8 pf = __builtin_bit_cast(bf16x8, pw);
                    const s16x4 a0l = vf[0][2 * kb + s2][0], a0h = vf[0][2 * kb + s2][1], a1l = vf[1][2 * kb + s2][0], a1h = vf[1][2 * kb + s2][1];
                    o0 = MFMA32(((bf16x8){a0l[0], a0l[1], a0l[2], a0l[3], a0h[0], a0h[1], a0h[2], a0h[3]}), pf, o0);
                    o1 = MFMA32(((bf16x8){a1l[0], a1l[1], a1l[2], a1l[3], a1h[0], a1h[1], a1h[2], a1h[3]}), pf, o1);
                    lacc = MFMA32(ones8, pf, lacc);
                }
        }
    }
    const float linv = 1.f / lacc[0];
    unsigned char* op = (unsigned char*)Ocat + ((size_t)b * SEQ + tq) * 1024 + 512 + h * 64;
    const float lsc = linv * FP8_SO;
#pragma unroll
    for (int g = 0; g < 4; ++g) { *(unsigned*)(op + 8 * g + 4 * hi) = cvt4_fp8(o0[4 * g] * lsc, o0[4 * g + 1] * lsc, o0[4 * g + 2] * lsc, o0[4 * g + 3] * lsc);
        *(unsigned*)(op + 32 + 8 * g + 4 * hi) = cvt4_fp8(o1[4 * g] * lsc, o1[4 * g + 1] * lsc, o1[4 * g + 2] * lsc, o1[4 * g + 3] * lsc); }
    __syncthreads();
#undef AT_ISSUE
}

#ifndef PROBE_HGX
#define PROBE_HGX 1
#endif
#ifndef PROBE_ATX
#define PROBE_ATX 1
#endif
#ifndef STAMP_SEL
#define STAMP_SEL -1
#endif
#ifndef STAMP_BLK
#define STAMP_BLK 0
#endif
#define STAMP(i) do { if (STAMP_SEL >= 0 && blockIdx.x == STAMP_BLK && C.tid == 0) { const unsigned long long t_ = __builtin_amdgcn_s_memrealtime(); C.MISC[16 + 2 * (i)] = (unsigned)t_; C.MISC[17 + 2 * (i)] = (unsigned)(t_ >> 32); } } while (0)
DI void p2_mixers(const Ctx& C, const Args& a, int rep) {
    for (int hx = 0; hx < PROBE_HGX; ++hx)
    for (int u = blockIdx.x; u < 64; u += C.G) hgrn_unit(C, a, u >> 2, u & 3);
    STAMP(11);
    unsigned* QA = (unsigned*)(C.ctl + CW_QUEUE + 64 * rep); unsigned* QC = (unsigned*)(C.ctl + CW_QUEUE2 + 64 * rep);
    constexpr int NA = 1024 * PROBE_ATX, NC = MOE_CVT_TILES;
    if (C.tid == 0) { C.MISC[0] = __hip_atomic_fetch_add(QA, 1u, __ATOMIC_RELAXED, __HIP_MEMORY_SCOPE_AGENT); C.MISC[1] = (rep == 0) ? __hip_atomic_fetch_add(QC, 1u, __ATOMIC_RELAXED, __HIP_MEMORY_SCOPE_AGENT) : (unsigned)NC; }
    __syncthreads();
    int qa = (int)C.MISC[0], qc = (int)C.MISC[1];
    __syncthreads();
    for (;;) {
        const bool doa = qa < NA, doc = qc < NC;
        if (!doa && !doc) break;
        unsigned na = (unsigned)NA, nc = (unsigned)NC;
        if (C.tid == 0) { if (doa) na = __hip_atomic_fetch_add(QA, 1u, __ATOMIC_RELAXED, __HIP_MEMORY_SCOPE_AGENT); if (doc) nc = __hip_atomic_fetch_add(QC, 1u, __ATOMIC_RELAXED, __HIP_MEMORY_SCOPE_AGENT); }
#ifdef STAMP_ACC
        unsigned long long ta_ = 0, tb_ = 0, tc_ = 0; if (C.tid == 0) ta_ = __builtin_amdgcn_s_memrealtime();
#endif
        if (doa) { const int q = qa / PROBE_ATX; attn_unit(C, a, (q & 127) >> 3, q & 7, 7 - (q >> 7)); }
#ifdef STAMP_ACC
        if (C.tid == 0) tb_ = __builtin_amdgcn_s_memrealtime();
#endif
        if (doc) moe_cvt_tile(C, a, qc);
#ifdef STAMP_ACC
        if (C.tid == 0 && blockIdx.x == 100) { tc_ = __builtin_amdgcn_s_memrealtime(); const unsigned long long d_ = (STAMP_ACC == 0) ? (tb_ - ta_) : (tc_ - tb_);
            const unsigned long long o_ = ((unsigned long long)C.MISC[45] << 32) | C.MISC[44]; const unsigned long long n_ = o_ + d_; C.MISC[44] = (unsigned)n_; C.MISC[45] = (unsigned)(n_ >> 32); }
#endif
        if (C.tid == 0) { C.MISC[0] = na; C.MISC[1] = nc; }
        __syncthreads();
        qa = (int)C.MISC[0]; qc = (int)C.MISC[1];
        __syncthreads();
    }
    STAMP(12);
#ifdef STAMP_ACC
    if (C.tid == 0 && blockIdx.x == 100) { const unsigned long long n_ = ((unsigned long long)C.MISC[45] << 32) | C.MISC[44]; const unsigned long long w0 = __builtin_amdgcn_s_memrealtime(); while (__builtin_amdgcn_s_memrealtime() - w0 < 4ull * n_) __builtin_amdgcn_s_sleep(8); }
#endif
}

DI void r1_phase(const Ctx& C, const Args& a) {
    LAS unsigned char* L = C.lds;
    const int tid = C.tid, lane = C.lane, wid = C.wid;
    LAS float* LG = (LAS float*)L + wid * 16 * 48;
    LAS int* CNT = (LAS int*)(L + 32768);
    LAS float* G1 = (LAS float*)(L + 33024); LAS float* B1 = (LAS float*)(L + 37120);
    const bf16* Pre = (const bf16*)(C.ws + WS_ZF); unsigned char* X1q = (unsigned char*)(C.ws + WS_R); f32x2* stats = (f32x2*)(C.ws + WS_STATS);
    const bf16* WrH = (const bf16*)(C.ws + WS_WRH); const bf16* WrL = (const bf16*)(C.ws + WS_WRL);
    unsigned* tokE = (unsigned*)(C.ws + WS_TOKE); float* tokW = (float*)(C.ws + WS_TOKW); int* wgcnt = (int*)(C.ws + WS_WGCNT);
    for (int i = tid; i < 1024; i += NTHREADS) { G1[i] = a.in[I_LN1G][i]; B1[i] = a.in[I_LN1B][i]; }
    LAS unsigned char* WL = L + 45056;
    for (int i = tid; i < 48 * 128; i += NTHREADS) { const int r = i >> 7, c = i & 127; *(LAS u32x4*)(WL + r * 2064 + c * 16) = *(const u32x4*)(WrH + (size_t)r * 1024 + c * 8); }
    LAS float* RB = (LAS float*)(L + 41216);
    if (tid < 4) RB[tid] = a.in[I_BGRP][tid]; else if (tid < 36) RB[tid] = a.in[I_BEXP][tid - 4];
    const int m16 = lane & 15, kq = lane >> 4;
    for (int chunk = blockIdx.x; chunk < NTOK / 128; chunk += C.G) {
        if (tid < 32) CNT[tid] = 0;
        __syncthreads();
        const int tok0 = chunk * 128 + wid * 16;
        const bf16* xrow = Pre + (size_t)(tok0 + m16) * 1024 + 8 * kq;
        float s = 0.f, s2 = 0.f;
#pragma unroll 8
        for (int k0 = 0; k0 < 1024; k0 += 32) { const u32x4 w = *(const u32x4*)(xrow + k0); const f32x4 xa = (f32x4){bflo(w.x), bfhi(w.x), bflo(w.y), bfhi(w.y)}, xc = (f32x4){bflo(w.z), bfhi(w.z), bflo(w.w), bfhi(w.w)};
            s += (xa[0] + xa[1]) + (xa[2] + xa[3]) + (xc[0] + xc[1]) + (xc[2] + xc[3]);
            s2 += (xa[0] * xa[0] + xa[1] * xa[1]) + (xa[2] * xa[2] + xa[3] * xa[3]) + (xc[0] * xc[0] + xc[1] * xc[1]) + (xc[2] * xc[2] + xc[3] * xc[3]); }
        s += __shfl_xor(s, 16); s += __shfl_xor(s, 32); s2 += __shfl_xor(s2, 16); s2 += __shfl_xor(s2, 32);
        const float mean = s * (1.f / 1024.f); const float var = fmaxf(s2 * (1.f / 1024.f) - mean * mean, 0.f); const float rstd = 1.f / sqrtf(var + LN_EPS);
        if (kq == 0) stats[tok0 + m16] = (f32x2){mean, rstd};
        STAMP(13);
        f32x4 acc[3];
#pragma unroll
        for (int nb = 0; nb < 3; ++nb) acc[nb] = (f32x4){0.f, 0.f, 0.f, 0.f};
        unsigned char* xb = X1q + (size_t)(tok0 + m16) * 1024 + 8 * kq;
        const LAS unsigned char* wlp = WL + m16 * 2064 + 16 * kq;
#pragma unroll 1
        for (int kb = 0; kb < 4; ++kb) {
            u32x4 xw[8];
#pragma unroll
            for (int j = 0; j < 8; ++j) xw[j] = *(const u32x4*)(xrow + kb * 256 + 32 * j);
#pragma unroll
            for (int j = 0; j < 8; ++j) { const int k0 = kb * 256 + 32 * j;
                bf16x8 wh[3];
#pragma unroll
                for (int nb = 0; nb < 3; ++nb) wh[nb] = *(const LAS bf16x8*)(wlp + nb * 16 * 2064 + k0 * 2);
                const f32x4 xaj = (f32x4){bflo(xw[j].x), bfhi(xw[j].x), bflo(xw[j].y), bfhi(xw[j].y)}, xcj = (f32x4){bflo(xw[j].z), bfhi(xw[j].z), bflo(xw[j].w), bfhi(xw[j].w)};
                const f32x4 ya = (xaj - mean) * rstd * *(const LAS f32x4*)(G1 + k0 + 8 * kq) + *(const LAS f32x4*)(B1 + k0 + 8 * kq);
                const f32x4 yc = (xcj - mean) * rstd * *(const LAS f32x4*)(G1 + k0 + 8 * kq + 4) + *(const LAS f32x4*)(B1 + k0 + 8 * kq + 4);
                u32x4 hw; hw.x = cvtpk(ya[0], ya[1]); hw.y = cvtpk(ya[2], ya[3]); hw.z = cvtpk(yc[0], yc[1]); hw.w = cvtpk(yc[2], yc[3]);
                { u32x2 qw; qw.x = cvt4_fp8(ya[0] * FP8_SX, ya[1] * FP8_SX, ya[2] * FP8_SX, ya[3] * FP8_SX); qw.y = cvt4_fp8(yc[0] * FP8_SX, yc[1] * FP8_SX, yc[2] * FP8_SX, yc[3] * FP8_SX); *(u32x2*)(xb + k0) = qw; }
                u32x4 lw; lw.x = cvtpk(ya[0] - bflo(hw.x), ya[1] - bfhi(hw.x)); lw.y = cvtpk(ya[2] - bflo(hw.y), ya[3] - bfhi(hw.y)); lw.z = cvtpk(yc[0] - bflo(hw.z), yc[1] - bfhi(hw.z)); lw.w = cvtpk(yc[2] - bflo(hw.w), yc[3] - bfhi(hw.w));
                const bf16x8 xh = __builtin_bit_cast(bf16x8, hw), xl = __builtin_bit_cast(bf16x8, lw);
#pragma unroll
                for (int nb = 0; nb < 3; ++nb) { acc[nb] = MFMA16(wh[nb], xh, acc[nb]); acc[nb] = MFMA16(wh[nb], xl, acc[nb]); }
            }
        }
        STAMP(14);
#pragma unroll
        for (int nb = 0; nb < 3; ++nb)
#pragma unroll
            for (int r = 0; r < 4; ++r) LG[m16 * 48 + nb * 16 + 4 * kq + r] = acc[nb][r];
        asm volatile("s_waitcnt lgkmcnt(0)" ::: "memory");
        if (lane < 16) {
            const LAS float* lg = LG + lane * 48;
            float gl[4];
#pragma unroll
            for (int j = 0; j < 4; ++j) gl[j] = lg[j] + RB[j];
            int grp = 0; float gm = gl[0];
#pragma unroll
            for (int j = 1; j < 4; ++j) if (gl[j] > gm) { gm = gl[j]; grp = j; }
            float se = 0.f;
#pragma unroll
            for (int j = 0; j < 4; ++j) se += __expf(gl[j] - gm);
            const float pg = 1.f / se;
            float el[8];
#pragma unroll
            for (int j = 0; j < 8; ++j) el[j] = lg[4 + grp * 8 + j] + RB[4 + grp * 8 + j];
            int i0 = 0; float v0 = el[0];
#pragma unroll
            for (int j = 1; j < 8; ++j) if (el[j] > v0) { v0 = el[j]; i0 = j; }
            int i1 = -1; float v1 = -INFINITY;
#pragma unroll
            for (int j = 0; j < 8; ++j) if (j != i0 && el[j] > v1) { v1 = el[j]; i1 = j; }
            const float w0 = 1.f / (1.f + __expf(v1 - v0)), w1 = 1.f - w0;
            const int e0 = grp * 8 + i0, e1 = grp * 8 + i1;
            const int r0 = __hip_atomic_fetch_add(CNT + e0, 1, __ATOMIC_RELAXED, __HIP_MEMORY_SCOPE_WORKGROUP), r1 = __hip_atomic_fetch_add(CNT + e1, 1, __ATOMIC_RELAXED, __HIP_MEMORY_SCOPE_WORKGROUP);
            const int tok = tok0 + lane;
            tokE[tok] = (unsigned)e0 | ((unsigned)e1 << 8) | ((unsigned)r0 << 16) | ((unsigned)r1 << 24);
            tokW[tok * 2] = w0 * pg; tokW[tok * 2 + 1] = w1 * pg;
        }
        __syncthreads();
        if (tid < 32) wgcnt[chunk * 32 + tid] = CNT[tid];
        __syncthreads();
    }
}

DI void r2_phase(const Ctx& C, const Args& a) {
    LAS int* PA = (LAS int*)C.lds;
    LAS int* PB = PA + 512;
    LAS int* TOT = PB + 512; LAS int* BASE = TOT + 32; LAS int* PST = BASE + 32;
    const int tid = C.tid;
    const int* wgcnt = (const int*)(C.ws + WS_WGCNT); const unsigned* tokE = (const unsigned*)(C.ws + WS_TOKE);
    int* tokD = (int*)(C.ws + WS_TOKD); int* rowtok = (int*)(C.ws + WS_ROWTOK); int* tilee = (int*)(C.ws + WS_TILEE);
    for (int chunk = blockIdx.x; chunk < NTOK / 128; chunk += C.G) {
        { const int e = tid & 31, part = tid >> 5; int sa = 0, sb = 0;
          for (int c = part * 16; c < part * 16 + 16; ++c) { const int v = wgcnt[c * 32 + e]; sa += v; sb += (c < chunk) ? v : 0; }
          PA[part * 32 + e] = sa; PB[part * 32 + e] = sb; }
        __syncthreads();
        if (tid < 32) { int sa = 0, sb = 0; for (int p = 0; p < 16; ++p) { sa += PA[p * 32 + tid]; sb += PB[p * 32 + tid]; } TOT[tid] = sa; BASE[tid] = sb; }
        __syncthreads();
        if (tid == 0) { int ps = 0; for (int e = 0; e < 32; ++e) { PST[e] = ps; ps += ((TOT[e] + 255) >> 8) << 8; } PST[32] = ps; }
        __syncthreads();
        if (tid < 128) { const int tok = chunk * 128 + tid; const unsigned w = tokE[tok]; const int e0 = w & 31, e1 = (w >> 8) & 31, r0 = (w >> 16) & 255, r1 = (w >> 24) & 255;
            const int d0 = PST[e0] + BASE[e0] + r0, d1 = PST[e1] + BASE[e1] + r1; rowtok[d0] = tok; rowtok[d1] = tok; tokD[tok * 2] = d0; tokD[tok * 2 + 1] = d1; }
        if (chunk < 32) { const int e = chunk, end = PST[e + 1] - PST[e]; for (int i = TOT[e] + tid; i < end; i += NTHREADS) rowtok[PST[e] + i] = 0; }
        if (chunk == 0) { if (tid < 32) { for (int t = PST[tid] >> 8; t < (PST[tid + 1] >> 8); ++t) tilee[t] = tid; } if (tid == 0) tilee[511] = PST[32] >> 8; }
        __syncthreads();
    }
}

DI void f_phase(const Ctx& C, const Args& a) {
    const int lane = C.lane, gw = C.vcu * NWAVES + C.wid, NGW = C.G * NWAVES;
    const bf16* Pre = (const bf16*)(C.ws + WS_ZF); const unsigned char* Y = (const unsigned char*)(C.ws + WS_Y); const int* tokD = (const int*)(C.ws + WS_TOKD); const float* tokW = (const float*)(C.ws + WS_TOKW);
    const f32x2* stats = (const f32x2*)(C.ws + WS_STATS);
    f32x4 g2[4], b2[4], g1[4], b1[4];
#pragma unroll
    for (int j = 0; j < 4; ++j) { g2[j] = *(const f32x4*)(a.in[I_LN2G] + 256 * j + 4 * lane); b2[j] = *(const f32x4*)(a.in[I_LN2B] + 256 * j + 4 * lane);
        g1[j] = *(const f32x4*)(a.in[I_LN1G] + 256 * j + 4 * lane) * DN_ALPHA; b1[j] = *(const f32x4*)(a.in[I_LN1B] + 256 * j + 4 * lane) * DN_ALPHA; }
    for (int tok = gw; tok < NTOK; tok += NGW) {
        const int d0 = tokD[tok * 2], d1 = tokD[tok * 2 + 1]; const float w0 = tokW[tok * 2] * (1.f / FP8_SY), w1 = tokW[tok * 2 + 1] * (1.f / FP8_SY); const f32x2 st = stats[tok];
        const bf16* xr = Pre + (size_t)tok * 1024 + 4 * lane; const unsigned char* y0 = Y + (size_t)d0 * 1024 + 4 * lane; const unsigned char* y1 = Y + (size_t)d1 * 1024 + 4 * lane;
        f32x4 v[4]; float s = 0.f;
#pragma unroll
        for (int j = 0; j < 4; ++j) { const u32x2 xw = *(const u32x2*)(xr + 256 * j); const f32x4 x = (f32x4){bflo(xw.x), bfhi(xw.x), bflo(xw.y), bfhi(xw.y)}; const unsigned p0 = *(const unsigned*)(y0 + 256 * j), p1 = *(const unsigned*)(y1 + 256 * j);
            v[j] = ((x - st.x) * st.y) * g1[j] + b1[j] + fp8x4_to_f32(p0) * w0 + fp8x4_to_f32(p1) * w1;
            s += (v[j][0] + v[j][1]) + (v[j][2] + v[j][3]); }
        const float mean = wave_sum(s) * (1.f / 1024.f); float s2 = 0.f;
#pragma unroll
        for (int j = 0; j < 4; ++j) { v[j] = v[j] - mean; s2 += (v[j][0] * v[j][0] + v[j][1] * v[j][1]) + (v[j][2] * v[j][2] + v[j][3] * v[j][3]); }
        const float rstd = 1.f / sqrtf(wave_sum(s2) * (1.f / 1024.f) + LN_EPS);
        float* orow = a.out + (size_t)tok * 1024 + 4 * lane;
#pragma unroll
        for (int j = 0; j < 4; ++j) *(f32x4*)(orow + 256 * j) = v[j] * rstd * g2[j] + b2[j];
    }
}

constexpr int NPH = 10;
__global__ void __launch_bounds__(NTHREADS, 2) mk_fwd(Args args) {
    extern __shared__ __attribute__((aligned(16))) unsigned char lds_raw[];
    Ctx C;
    C.lds = (LAS unsigned char*)lds_raw; C.MISC = (volatile LAS unsigned*)(C.lds + MISC_OFF);
    C.tid = threadIdx.x; C.lane = C.tid & 63; C.wid = __builtin_amdgcn_readfirstlane(C.tid >> 6);
    C.G = gridDim.x; { const int bx = blockIdx.x; C.vcu = (C.G % 8 == 0) ? (bx % 8) * (C.G / 8) + bx / 8 : bx; }
    C.ws = args.ws; C.ctl = (gu32*)(args.ws + WS_CTL);
    if (C.tid < 64) C.MISC[C.tid] = 0u;
    __syncthreads();
    XcdBarrier bar; bar.bar = (unsigned*)(C.ctl + CW_BAR); bar.x = 0; bar.st = nullptr;
    if (MK_N_LAUNCHES == 1) bar = xcd_barrier_post((unsigned*)(C.ctl + CW_BAR), C.MISC + 8);
    const int lo = args.ph_lo, hi = args.ph_hi;
#ifndef PH_MASK
#define PH_MASK 0x3ff
#endif
#define IN(k) (((PH_MASK >> (k)) & 1) && lo <= (k) && (k) < hi)
#ifndef STAMP_SEL
#define STAMP_SEL -1
#endif
#ifndef STAMP_T0
#define STAMP_T0 STAMP_SEL
#define STAMP_T1 (STAMP_SEL + 1)
#endif
#define SEAM(k) do { if (IN(k) && IN((k) + 1)) xcd_barrier(bar); STAMP((k) + 1); } while (0)
#ifndef PROBE_PHASE
#define PROBE_PHASE -1
#endif
#define REPS(k) ((PROBE_PHASE == (k)) ? 2 : 1)
#define REPSEAM(k) do { if (rep + 1 < REPS(k)) xcd_barrier(bar); } while (0)
    unsigned char* ws = args.ws;
    LAS unsigned char* ring = C.lds;

    STAMP(0);
    if (IN(0)) { _Pragma("unroll") for (int rep = 0; rep < REPS(0); ++rep) { p0_prologue(C, args); REPSEAM(0); } } SEAM(0);

    if (IN(1)) _Pragma("unroll") for (int rep = 0; rep < REPS(1); ++rep) {
        pg8::EpiIn E{(bf16*)(ws + WS_QH), (bf16*)(ws + WS_VH), (bf16*)(ws + WS_GH), (bf16*)(ws + WS_QM), (bf16*)(ws + WS_KM), (bf16*)(ws + WS_VM), (bf16*)(ws + WS_R), (bf16*)(ws + WS_GB),
                     (float*)(ws + WS_ZF), (float*)(ws + WS_KMEAN), (const float*)(ws + WS_BPERM), (bf16*)(ws + WS_KK), (const float*)(ws + WS_LB), 0};
        { pg8::DenseOrder S; S.init(ws + WS_XB, ws + WS_WIN, NTOK, 1024, 1024, C.G, (int)blockIdx.x);
          pg8::gemm_phase<pg8::EpiIn, pg8::DenseOrder, false>(ring, 1024, S, E); }
        { E.pn_off = 4; pg8::DenseOrder S; S.init((unsigned char*)args.out + 64 * MiB, ws + WS_WIN + 2 * MiB, NTOK, 4608, 512, C.G, (int)blockIdx.x);
          pg8::gemm_phase<pg8::EpiIn, pg8::DenseOrder, false, true>(ring, 512, S, E); }
        REPSEAM(1);
    } SEAM(1);

#ifndef PROBE_P2X
#define PROBE_P2X 1
#endif
    if (IN(2)) { for (int rep = 0; rep < PROBE_P2X; ++rep) { p2_mixers(C, args, rep); if (rep + 1 < PROBE_P2X) xcd_barrier(bar); } } SEAM(2);

    if (IN(3)) _Pragma("unroll") for (int rep = 0; rep < REPS(3); ++rep) {
        pg8::DenseOrder S; S.init(ws + WS_OCAT, ws + WS_WCAT, NTOK, 1024, 512, C.G, (int)blockIdx.x);
        pg8::EpiProj E{(const bf16*)(ws + WS_R), (const bf16*)(ws + WS_GB), (unsigned char*)(ws + WS_QH)};
        pg8::gemm_phase<pg8::EpiProj, pg8::DenseOrder, false, true>(ring, 512, S, E); REPSEAM(3);
    } SEAM(3);

    if (IN(4)) _Pragma("unroll") for (int rep = 0; rep < REPS(4); ++rep) {
        pg8::DenseOrder S; S.init(ws + WS_QH, ws + WS_WO, NTOK, 1024, 512, C.G, (int)blockIdx.x);
        pg8::EpiOut E{(const bf16*)(ws + WS_XB), (bf16*)(ws + WS_ZF)};
        pg8::gemm_phase<pg8::EpiOut, pg8::DenseOrder, false, true>(ring, 512, S, E);
        REPSEAM(4);
    } SEAM(4);

    if (IN(5)) { _Pragma("unroll") for (int rep = 0; rep < REPS(5); ++rep) { r1_phase(C, args); REPSEAM(5); } } STAMP(15); SEAM(5);
    if (IN(6)) { _Pragma("unroll") for (int rep = 0; rep < REPS(6); ++rep) { r2_phase(C, args); REPSEAM(6); } } SEAM(6);

    if (IN(7)) _Pragma("unroll") for (int rep = 0; rep < REPS(7); ++rep) {
        const int* tilee = (const int*)(ws + WS_TILEE);
        const int ntl = __builtin_amdgcn_readfirstlane(__hip_atomic_load(tilee + 511, __ATOMIC_RELAXED, __HIP_MEMORY_SCOPE_AGENT));
        pg8::MoeOrder S{(const char*)(ws + WS_R), (const char*)args.out, (const int*)(ws + WS_ROWTOK), tilee, 512, 1024, ntl * 4, C.G, C.vcu, true};
        pg8::EpiM1 E{(unsigned char*)(ws + WS_QH)};
        pg8::gemm_phase<pg8::EpiM1, pg8::MoeOrder, true, true>(ring, 512, S, E); REPSEAM(7);
    } SEAM(7);

    if (IN(8)) _Pragma("unroll") for (int rep = 0; rep < REPS(8); ++rep) {
        const int* tilee = (const int*)(ws + WS_TILEE);
        const int ntl = __builtin_amdgcn_readfirstlane(__hip_atomic_load(tilee + 511, __ATOMIC_RELAXED, __HIP_MEMORY_SCOPE_AGENT));
        pg8::MoeOrder S{(const char*)(ws + WS_QH), (const char*)args.out + 32 * MiB, (const int*)(ws + WS_ROWTOK), tilee, 256, 1024, ntl * 4, C.G, C.vcu, false};
        pg8::EpiM2 E{(unsigned char*)(ws + WS_Y)};
        pg8::gemm_phase<pg8::EpiM2, pg8::MoeOrder, false, true>(ring, 256, S, E); REPSEAM(8);
    } SEAM(8);

    if (IN(9)) { _Pragma("unroll") for (int rep = 0; rep < REPS(9); ++rep) { f_phase(C, args); REPSEAM(9); } }
    STAMP(10);
    if (STAMP_SEL >= 0 && blockIdx.x == STAMP_BLK && C.tid == 0) {
        const unsigned long long t0 = ((unsigned long long)C.MISC[17 + 2 * (STAMP_T0)] << 32) | C.MISC[16 + 2 * (STAMP_T0)], t1 = ((unsigned long long)C.MISC[17 + 2 * (STAMP_T1)] << 32) | C.MISC[16 + 2 * (STAMP_T1)];
        const unsigned long long w0 = __builtin_amdgcn_s_memrealtime(); while (__builtin_amdgcn_s_memrealtime() - w0 < 4ull * (t1 - t0)) __builtin_amdgcn_s_sleep(8); }
#undef IN
#undef SEAM
}

extern "C" void kernel_launch(void* const* d_in, const int* in_sizes, int n_in, void* d_out, int out_size, void* d_ws, size_t ws_size, hipStream_t stream) {
    static int grid = 0;
    if (grid == 0) {
        if (n_in != 19 || in_sizes[0] != NTOK * DM || out_size != NTOK * DM || ws_size < WS_END) { fprintf(stderr, "kernel_launch: unexpected problem shape / workspace; nothing launched\n"); grid = -1; return; }
        int dev = 0, cus = 0, per_cu = 0;
        if (hipGetDevice(&dev) != hipSuccess || hipDeviceGetAttribute(&cus, hipDeviceAttributeMultiprocessorCount, dev) != hipSuccess) { grid = -1; return; }
        if (hipFuncSetAttribute((const void*)mk_fwd, hipFuncAttributeMaxDynamicSharedMemorySize, LDS_BYTES) != hipSuccess) { fprintf(stderr, "kernel_launch: hipFuncSetAttribute failed\n"); grid = -1; return; }
        if (hipOccupancyMaxActiveBlocksPerMultiprocessor(&per_cu, (const void*)mk_fwd, NTHREADS, LDS_BYTES) != hipSuccess || per_cu < 1) { fprintf(stderr, "kernel_launch: occupancy query says %d\n", per_cu); }
        (void)hipGetLastError();
        grid = cus;
    }
    if (grid < 0) return;
    (void)hipMemsetAsync((char*)d_ws + WS_CTL, 0, CTL_ZERO_BYTES, stream);
    Args a{};
    for (int i = 0; i < 19; ++i) a.in[i] = (const float*)d_in[i];
    a.out = (float*)d_out; a.ws = (unsigned char*)d_ws;
    if (MK_N_LAUNCHES == 1) { a.ph_lo = 0; a.ph_hi = NPH; hipLaunchKernelGGL(mk_fwd, dim3(grid), dim3(NTHREADS), LDS_BYTES, stream, a); }
    else for (int p = 0; p < NPH; ++p) { a.ph_lo = p; a.ph_hi = p + 1; hipLaunchKernelGGL(mk_fwd, dim3(grid), dim3(NTHREADS), LDS_BYTES, stream, a); }
}
```

```cpp
#include <hip/hip_runtime.h>
#include <cstdio>
#include <cstdint>
#ifndef MK_N_LAUNCHES
#define MK_N_LAUNCHES 1
#endif
#define DI __device__ __forceinline__
#define GAS __attribute__((address_space(1)))
#define LAS __attribute__((address_space(3)))
typedef unsigned short bf16;
typedef unsigned u32x4 __attribute__((ext_vector_type(4)));
typedef unsigned u32x2 __attribute__((ext_vector_type(2)));
typedef float f32x4 __attribute__((ext_vector_type(4)));
typedef float f32x2 __attribute__((ext_vector_type(2)));
typedef float f32x16 __attribute__((ext_vector_type(16)));
typedef short bf16x8 __attribute__((ext_vector_type(8)));
typedef short s16x4 __attribute__((ext_vector_type(4)));
typedef short v4i16_t __attribute__((ext_vector_type(4)));
typedef __bf16 bf16x2_t __attribute__((ext_vector_type(2)));
typedef GAS unsigned gu32;

constexpr int NTOK = 32768, DM = 1024, SEQ = 2048, NBATCH = 16, NIN = 5632;
constexpr int NWAVES = 8, NTHREADS = 512;
constexpr float LN_EPS = 1e-5f, DN_ALPHA = 1.189207115002721f, LOG2E = 1.4426950408889634f;
constexpr int MOE_MAXTILES = 288;

constexpr size_t MiB = 1u << 20;
constexpr size_t WS_CTL = 0, CTL_ZERO_BYTES = 65536;
constexpr size_t WS_WIN = 1 * MiB, WS_WCAT = 12 * MiB, WS_WO = 14 * MiB;
constexpr size_t WS_XB = 16 * MiB;
constexpr size_t WS_R = 80 * MiB;
constexpr size_t WS_GB = 144 * MiB;
constexpr size_t WS_QH = 208 * MiB;
constexpr size_t WS_VH = 240 * MiB;
constexpr size_t WS_GH = 272 * MiB;
constexpr size_t WS_ZF = 304 * MiB;
constexpr size_t WS_OCAT = 306 * MiB;
constexpr size_t WS_QM = 368 * MiB, WS_KM = 400 * MiB;
constexpr size_t WS_VM = 432 * MiB;
constexpr size_t WS_Y = 16 * MiB;
constexpr size_t WS_MISC = 464 * MiB;
constexpr size_t WS_KMEAN = WS_MISC;
constexpr size_t WS_BPERM = WS_MISC + 1 * MiB;
constexpr size_t WS_WRH = WS_MISC + 2 * MiB;
constexpr size_t WS_WRL = WS_WRH + 98304;
constexpr size_t WS_TOKE = WS_MISC + 3 * MiB;
constexpr size_t WS_TOKW = WS_MISC + 4 * MiB;
constexpr size_t WS_TOKD = WS_MISC + 5 * MiB;
constexpr size_t WS_WGCNT = WS_MISC + 6 * MiB;
constexpr size_t WS_ROWTOK = WS_MISC + 7 * MiB;
constexpr size_t WS_TILEE = WS_MISC + 8 * MiB;
constexpr size_t WS_STATS = WS_MISC + 9 * MiB;
constexpr size_t WS_LB = WS_MISC + 10 * MiB;
constexpr size_t WS_KK = WS_MISC + 12 * MiB;
constexpr size_t WS_END = 512 * MiB;
constexpr int CW_BAR = 4096, CW_QUEUE = 8192, CW_QUEUE2 = 8192 + 1024;

constexpr int LDS_BYTES = 163840, MISC_OFF = LDS_BYTES - 256;

DI unsigned cvtpk(float lo, float hi) { f32x2 v = {lo, hi}; bf16x2_t b = __builtin_convertvector(v, bf16x2_t); return __builtin_bit_cast(unsigned, b); }
DI float bflo(unsigned w) { return __uint_as_float(w << 16); }
DI float bfhi(unsigned w) { return __uint_as_float(w & 0xffff0000u); }
DI float bf2f(unsigned short h) { return __uint_as_float((unsigned)h << 16); }
DI float frcp(float x) { return __builtin_amdgcn_rcpf(x); }
DI float fsigmoid(float x) { return frcp(1.f + __expf(-x)); }
DI float wave_sum(float v) {
#pragma unroll
    for (int o = 1; o < 64; o <<= 1) v += __shfl_xor(v, o);
    return v;
}
typedef int v8i __attribute__((ext_vector_type(8)));
typedef int v4i __attribute__((ext_vector_type(4)));
DI unsigned cvt4_fp8(float a, float b, float c, float d) { a = __builtin_amdgcn_fmed3f(a, -448.f, 448.f); b = __builtin_amdgcn_fmed3f(b, -448.f, 448.f); c = __builtin_amdgcn_fmed3f(c, -448.f, 448.f); d = __builtin_amdgcn_fmed3f(d, -448.f, 448.f);
    int w = 0; w = __builtin_amdgcn_cvt_pk_fp8_f32(a, b, w, false); w = __builtin_amdgcn_cvt_pk_fp8_f32(c, d, w, true); return (unsigned)w; }
DI f32x4 fp8x4_to_f32(unsigned w) { const f32x2 lo = __builtin_amdgcn_cvt_pk_f32_fp8((int)w, false), hi = __builtin_amdgcn_cvt_pk_f32_fp8((int)w, true); return (f32x4){lo[0], lo[1], hi[0], hi[1]}; }
constexpr float FP8_SXI = 8.f, FP8_SX = 8.f, FP8_SW = 32.f, FP8_SH = 4.f, FP8_SO = 4.f, FP8_SU = 32.f, FP8_SY = 64.f;
DI int crow(int r, int hi) { return (r & 3) + 8 * (r >> 2) + 4 * hi; }
#define MFMA32(a, b, c) __builtin_amdgcn_mfma_f32_32x32x16_bf16((a), (b), (c), 0, 0, 0)
#define MFMA16(a, b, c) __builtin_amdgcn_mfma_f32_16x16x32_bf16((a), (b), (c), 0, 0, 0)
DI s16x4 vtr(LAS const char* p) { return __builtin_bit_cast(s16x4, __builtin_amdgcn_ds_read_tr16_b64_v4i16((LAS v4i16_t*)p)); }

#define XB_TMO      128
#define XB_XCNT(j)  (256  + 64 * (j))
#define XB_XSUB(j)  (1280 + 64 * (j))
#define XB_XGEN(j)  (2304 + 64 * (j))
#define XB_TOP      3328
#define XB_TOPGEN   3392
#define XCD_BAR_WORDS 3456
#define XB_SPIN_CAP (1u << 22)
DI unsigned xb_ld(unsigned* p)              { return __hip_atomic_load(p, __ATOMIC_RELAXED, __HIP_MEMORY_SCOPE_AGENT); }
DI unsigned xb_add(unsigned* p, unsigned v) { return __hip_atomic_fetch_add(p, v, __ATOMIC_RELAXED, __HIP_MEMORY_SCOPE_AGENT); }
DI unsigned xb_xcc_id() { return (unsigned)__builtin_amdgcn_s_getreg((3 << 11) | 20) & 0xFu; }
#define XB_SPIN(cond, bar) do { unsigned _sp = 0; while (cond) { __builtin_amdgcn_s_sleep(1); \
    if ((++_sp & 255u) == 0u) { if (xb_ld(&(bar)[XB_TMO])) break; if (_sp > XB_SPIN_CAP) { atomicAdd(&(bar)[XB_TMO], 1u); break; } } } } while (0)
struct XcdBarrier { unsigned* bar; unsigned x; volatile LAS unsigned* st; };
DI XcdBarrier xcd_barrier_post(unsigned* bar, volatile LAS unsigned* st) {
    XcdBarrier b; b.bar = bar; b.x = xb_xcc_id(); b.st = st;
    if (threadIdx.x == 0) (void)xb_add(&bar[XB_XCNT(b.x)], 1u);
    return b;
}
DI void xcd_barrier_complete(unsigned* bar, unsigned x, unsigned& nloc, unsigned& nx) {
    const unsigned G = gridDim.x * gridDim.y * gridDim.z;
    unsigned sum, cnt, mine, sp = 0u;
    for (;;) {
        sum = 0u; cnt = 0u; mine = 0u;
#pragma unroll
        for (unsigned j = 0; j < 16; ++j) { const unsigned c = xb_ld(&bar[XB_XCNT(j)]); sum += c; cnt += (c > 0u) ? 1u : 0u; mine = (j == x) ? c : mine; }
        if (sum == G) break;
        __builtin_amdgcn_s_sleep(1);
        if ((++sp & 255u) == 0u) { if (xb_ld(&bar[XB_TMO])) break; if (sp > XB_SPIN_CAP) { atomicAdd(&bar[XB_TMO], 1u); break; } }
    }
    nloc = mine > 0u ? mine : 1u; nx = cnt > 0u ? cnt : 1u;
}
DI void xcd_barrier(const XcdBarrier& b) {
    asm volatile("s_waitcnt vmcnt(0)" ::: "memory");
    __syncthreads();
    if (threadIdx.x == 0) {
        unsigned* bar = b.bar;
        __builtin_amdgcn_s_waitcnt(0);
        unsigned nloc = b.st[0], nx = b.st[1];
        if (nloc == 0u) { xcd_barrier_complete(bar, b.x, nloc, nx); b.st[0] = nloc; b.st[1] = nx; }
        const unsigned old = xb_add(&bar[XB_XSUB(b.x)], 1u);
        const unsigned gen = old / nloc;
        if (old + 1u == (gen + 1u) * nloc) {
            __builtin_amdgcn_fence(__ATOMIC_RELEASE, "agent");
            asm volatile("s_waitcnt vmcnt(0)" ::: "memory");
            const unsigned og = xb_add(&bar[XB_TOP], 1u);
            const unsigned tg = og / nx;
            if (og + 1u == (tg + 1u) * nx) xb_add(&bar[XB_TOPGEN], 1u);
            else XB_SPIN(xb_ld(&bar[XB_TOPGEN]) == tg, bar);
            __builtin_amdgcn_fence(__ATOMIC_ACQUIRE, "agent");
            xb_add(&bar[XB_XGEN(b.x)], 1u);
            asm volatile("s_waitcnt vmcnt(0)" ::: "memory");
        } else {
            XB_SPIN(xb_ld(&bar[XB_XGEN(b.x)]) == gen, bar);
            __builtin_amdgcn_fence(__ATOMIC_ACQUIRE, "agent");
            asm volatile("s_waitcnt vmcnt(0)" ::: "memory");
        }
    }
    __syncthreads();
}

namespace pg8 {
constexpr int BM = 256, BK = 64, HALF = 128, HTB = HALF * BK * 2, STAGE_BYTES = 8 * HTB, NXCD = 8, WGM = 8;
DI int lds_byte(int r, int c) { const int st = (r >> 4) * 2 + (c >> 5), rr = r & 15, cc = c & 31, ob = rr * 64 + cc * 2; return st * 1024 + (ob ^ (((ob >> 9) & 1) << 5)); }
DI void stage_rc(int b, int& R, int& C) { const int st = b / 1024, sb = b % 1024, swz = sb ^ (((sb >> 9) & 1) << 5); R = (st >> 1) * 16 + swz / 64; C = (st & 1) * 32 + (swz % 64) / 2; }
DI int perm32(int rho) { const int n = rho >> 4, i = rho & 15; return 8 * (i >> 2) + 4 * n + (i & 3); }
struct Unit { int pm, pn, e; };

struct DenseOrder {
    const char* A; const char* Bt; int K, nM, nN, nwg, G, c;
    DI void init(const void* A_, const void* Bt_, int M, int N, int K_, int G_, int c_) { A = (const char*)A_; Bt = (const char*)Bt_; K = K_; nM = M / BM; nN = N / BM; nwg = nM * nN; G = G_; c = c_; }
    DI bool next(int i, Unit& u) const {
        const long L = (long)i * G + c; if (L >= nwg) return false;
        int wgid = (int)L; { const int q = nwg / NXCD, r = nwg % NXCD, xcd = wgid % NXCD, off = wgid / NXCD; wgid = (xcd < r ? xcd * (q + 1) : r * (q + 1) + (xcd - r) * q) + off; }
        const int nig = WGM * nN, gid = wgid / nig, fm = gid * WGM, gsz = (nM - fm) < WGM ? (nM - fm) : WGM;
        u.pm = fm + ((wgid % nig) % gsz); u.pn = (wgid % nig) / gsz; u.e = 0; return true;
    }
    DI const char* a_base(const Unit& u) const { return A + (size_t)u.pm * 512 * K; }
    DI const char* b_base(const Unit& u) const { return Bt + (size_t)u.pn * 512 * K; }
    DI void gather(const Unit&, const int (&)[2], const int (&)[2], unsigned (&)[2][2]) const {}
};
struct MoeOrder {
    const char* A; const char* Bt; const int* row_tok; const int* tile_e; int K, N, nunits, G, c; bool gat;
    DI bool next(int i, Unit& u) const {
        const int L = i * G + c; if (L >= nunits) return false;
        u.pm = L >> 2; u.pn = L & 3;
        u.e = __builtin_amdgcn_readfirstlane(__hip_atomic_load(tile_e + u.pm, __ATOMIC_RELAXED, __HIP_MEMORY_SCOPE_AGENT)); return true;
    }
    DI const char* a_base(const Unit& u) const { return gat ? A : A + (size_t)u.pm * 512 * K; }
    DI const char* b_base(const Unit& u) const { return Bt + ((size_t)u.e * N + (size_t)u.pn * 256) * K * 2; }
    DI void gather(const Unit& u, const int (&Rr)[2], const int (&Cc)[2], unsigned (&o)[2][2]) const {
#pragma unroll
        for (int h = 0; h < 2; ++h)
#pragma unroll
            for (int i = 0; i < 2; ++i) { const int tok = row_tok[u.pm * 256 + h * 128 + Rr[i]]; o[h][i] = (unsigned)(tok * K + Cc[i]) * 2u; }
    }
};

template <class Epi, class Sched, bool GATHER, bool FP8 = false>
DI void gemm_phase(LAS unsigned char* lds, const int K, const Sched& S, const Epi& E) {
    const int tid = threadIdx.x, wid = __builtin_amdgcn_readfirstlane(tid >> 6), lane = tid & 63, wr = wid >> 2, wc = wid & 3, fr = lane & 15, fq = lane >> 4;
    const int nt = K / BK;
    unsigned voffB[2], vA[2][2], nvA[2][2]; int Rr[2], Cc[2];
#pragma unroll
    for (int i = 0; i < 2; ++i) { int R, C; stage_rc(tid * 16 + i * 8192, R, C); Rr[i] = R; Cc[i] = C; const int Rb = (R & ~31) + perm32(R & 31);
        voffB[i] = (unsigned)(Rb * K + C) * 2u; vA[0][i] = (unsigned)(R * K + C) * 2u; vA[1][i] = (unsigned)((R + HALF) * K + C) * 2u; nvA[0][i] = vA[0][i]; nvA[1][i] = vA[1][i]; }
    const size_t kstep = (size_t)(BK * 2);
    const size_t hstep = (size_t)HALF * K * 2;
    const unsigned ldsw = (unsigned)wid * 1024u;
    const int aoff = lds_byte(wr * 64 + fr, fq * 8), boff = lds_byte(wc * 32 + fr, fq * 8);
#define PG8_SA(b, h) (((b) * 2 + (h)) * HTB)
#define PG8_SB(b, h) ((4 + (b) * 2 + (h)) * HTB)
#define PG8_STAGE(bufoff, gbase, voff) do { _Pragma("unroll") for (int _i = 0; _i < 2; ++_i) \
        __builtin_amdgcn_global_load_lds((const unsigned*)((const char*)(gbase) + (voff)[_i]), (LAS unsigned*)(lds + (bufoff) + ldsw + _i * 8192), 16, 0, 0); } while (0)
#define PG8_LDA(dst, b, h) do { if constexpr (FP8) { _Pragma("unroll") for (int m = 0; m < 4; ++m) dst##8[m] = __builtin_shufflevector(*(const LAS v4i*)(lds + PG8_SA(b, h) + aoff + m * 2048), *(const LAS v4i*)(lds + PG8_SA(b, h) + aoff + m * 2048 + 1024), 0, 1, 2, 3, 4, 5, 6, 7); } \
        else { _Pragma("unroll") for (int m = 0; m < 4; ++m) _Pragma("unroll") for (int k = 0; k < 2; ++k) dst[m][k] = *(const LAS bf16x8*)(lds + PG8_SA(b, h) + aoff + m * 2048 + k * 1024); } } while (0)
#define PG8_LDB(dst, b, h) do { if constexpr (FP8) { _Pragma("unroll") for (int n = 0; n < 2; ++n) dst##8[n] = __builtin_shufflevector(*(const LAS v4i*)(lds + PG8_SB(b, h) + boff + n * 2048), *(const LAS v4i*)(lds + PG8_SB(b, h) + boff + n * 2048 + 1024), 0, 1, 2, 3, 4, 5, 6, 7); } \
        else { _Pragma("unroll") for (int n = 0; n < 2; ++n) _Pragma("unroll") for (int k = 0; k < 2; ++k) dst[n][k] = *(const LAS bf16x8*)(lds + PG8_SB(b, h) + boff + n * 2048 + k * 1024); } } while (0)
#define PG8_CAT(x, y) __builtin_shufflevector(__builtin_bit_cast(v4i, (x)), __builtin_bit_cast(v4i, (y)), 0, 1, 2, 3, 4, 5, 6, 7)
#define PG8_MMA(ai, bj, At, Bt) do { __builtin_amdgcn_s_setprio(1); if constexpr (FP8) { _Pragma("unroll") for (int m = 0; m < 4; ++m) _Pragma("unroll") for (int n = 0; n < 2; ++n) \
        asm volatile("v_mfma_scale_f32_16x16x128_f8f6f4 %0, %1, %2, %0, %3, %3 op_sel_hi:[0,0,0]" : "+v"(acc[ai][bj][m][n]) : "v"(Bt##8[n]), "v"(At##8[m]), "v"(fp8_unit_scale)); } else { \
        _Pragma("unroll") for (int m = 0; m < 4; ++m) _Pragma("unroll") for (int n = 0; n < 2; ++n) _Pragma("unroll") for (int k = 0; k < 2; ++k) \
        acc[ai][bj][m][n] = __builtin_amdgcn_mfma_f32_16x16x32_bf16(Bt[n][k], At[m][k], acc[ai][bj][m][n], 0, 0, 0); } __builtin_amdgcn_s_setprio(0); } while (0)
#define PG8_WAIT_V(n) asm volatile("s_waitcnt vmcnt(" #n ")" ::: "memory")
#define PG8_WAIT_L(n) asm volatile("s_waitcnt lgkmcnt(" #n ")" ::: "memory")
#define PG8_BAR __builtin_amdgcn_s_barrier()
#define PG8_SCHED __builtin_amdgcn_sched_barrier(0)
    Unit cur, nxt; int ui = 0;
    if (!S.next(0, cur)) return;
    if constexpr (GATHER) S.gather(cur, Rr, Cc, vA);
    f32x4 acc[2][2][4][2];
#pragma unroll
    for (int a = 0; a < 2; ++a)
#pragma unroll
        for (int b = 0; b < 2; ++b)
#pragma unroll
            for (int m = 0; m < 4; ++m)
#pragma unroll
                for (int n = 0; n < 2; ++n) acc[a][b][m][n] = (f32x4){0.f, 0.f, 0.f, 0.f};
    bf16x8 At[4][2], B0[2][2], B1[2][2]; v8i At8[4], B08[2], B18[2]; const int fp8_unit_scale = 0x7f7f7f7f;
    const char* cA = S.a_base(cur); const char* cB = S.b_base(cur);
    PG8_STAGE(PG8_SB(0, 0), cB, voffB); PG8_STAGE(PG8_SB(0, 1), cB + hstep, voffB); PG8_STAGE(PG8_SA(0, 0), cA, vA[0]); PG8_STAGE(PG8_SA(0, 1), cA, vA[1]);
    if (wr == 1) PG8_BAR;
    PG8_WAIT_V(2); PG8_BAR;
    PG8_STAGE(PG8_SB(1, 0), cB + kstep, voffB); PG8_STAGE(PG8_SA(1, 0), cA + kstep, vA[0]); PG8_STAGE(PG8_SB(1, 1), cB + hstep + kstep, voffB);
    PG8_WAIT_V(6); PG8_BAR;
    for (;;) {
        const bool has_next = S.next(ui + 1, nxt);
        const char* nA = has_next ? S.a_base(nxt) : cA; const char* nB = has_next ? S.b_base(nxt) : cB;
        if constexpr (GATHER) {
            if (has_next) S.gather(nxt, Rr, Cc, nvA);
            else {
#pragma unroll
                for (int h = 0; h < 2; ++h) { nvA[h][0] = vA[h][0]; nvA[h][1] = vA[h][1]; } }
        }
#pragma unroll 1
        for (int t = 0; t < nt; t += 2) {
            const bool last = (t == nt - 2);
            if constexpr (Epi::HAS_MID) { if (t == (nt >> 1)) { if constexpr (FP8) asm volatile("s_nop 15\n\ts_nop 15" ::: "memory"); E.mid(acc, cur, wr, wc, fr, fq); if constexpr (FP8) asm volatile("s_nop 7" ::: "memory"); } }
            const char* a1 = cA + (size_t)(t + 1) * kstep;
            const char* a2 = last ? nA : cA + (size_t)(t + 2) * kstep; const char* b2 = last ? nB : cB + (size_t)(t + 2) * kstep;
            const char* a3 = a2 + kstep; const char* b3 = b2 + kstep;
            unsigned o0[2], o1[2];
            if constexpr (GATHER) { o0[0] = last ? nvA[0][0] : vA[0][0]; o0[1] = last ? nvA[0][1] : vA[0][1]; o1[0] = last ? nvA[1][0] : vA[1][0]; o1[1] = last ? nvA[1][1] : vA[1][1]; }
            else { o0[0] = vA[0][0]; o0[1] = vA[0][1]; o1[0] = vA[1][0]; o1[1] = vA[1][1]; }
            PG8_LDB(B0, 0, 0); PG8_LDB(B1, 0, 1); PG8_SCHED; PG8_LDA(At, 0, 0); PG8_STAGE(PG8_SA(1, 1), a1, vA[1]);
            PG8_WAIT_V(8); PG8_WAIT_L(0); PG8_BAR; PG8_MMA(0, 0, At, B0); PG8_MMA(0, 1, At, B1); PG8_BAR; PG8_SCHED;
            PG8_LDA(At, 0, 1); PG8_STAGE(PG8_SB(0, 0), b2, voffB); PG8_STAGE(PG8_SB(0, 1), b2 + hstep, voffB); PG8_STAGE(PG8_SA(0, 0), a2, o0);
            PG8_WAIT_V(8); PG8_WAIT_L(0); PG8_BAR; PG8_MMA(1, 0, At, B0); PG8_MMA(1, 1, At, B1); PG8_BAR; PG8_SCHED;
            PG8_LDB(B0, 1, 0); PG8_LDB(B1, 1, 1); PG8_SCHED; PG8_LDA(At, 1, 0); PG8_STAGE(PG8_SA(0, 1), a2, o1);
            PG8_WAIT_V(8); PG8_WAIT_L(0); PG8_BAR; PG8_MMA(0, 0, At, B0); PG8_MMA(0, 1, At, B1); PG8_BAR; PG8_SCHED;
            PG8_LDA(At, 1, 1); PG8_STAGE(PG8_SB(1, 0), b3, voffB); PG8_STAGE(PG8_SB(1, 1), b3 + hstep, voffB); PG8_STAGE(PG8_SA(1, 0), a3, o0);
            PG8_WAIT_V(8); PG8_WAIT_L(0); PG8_BAR; PG8_MMA(1, 0, At, B0); PG8_MMA(1, 1, At, B1); PG8_BAR; PG8_SCHED;
        }
        if (wr == 0) PG8_BAR;
        if constexpr (FP8) asm volatile("s_nop 15\n\ts_nop 15" ::: "memory");
        E(acc, cur, wr, wc, fr, fq);
        if (!has_next) break;
#pragma unroll
        for (int a = 0; a < 2; ++a)
#pragma unroll
            for (int b = 0; b < 2; ++b)
#pragma unroll
                for (int m = 0; m < 4; ++m)
#pragma unroll
                    for (int n = 0; n < 2; ++n) acc[a][b][m][n] = (f32x4){0.f, 0.f, 0.f, 0.f};
        cur = nxt; cA = nA; cB = nB; ++ui;
        if constexpr (GATHER) {
#pragma unroll
            for (int h = 0; h < 2; ++h) { vA[h][0] = nvA[h][0]; vA[h][1] = nvA[h][1]; } }
        if (wr == 1) PG8_BAR;
    }
    PG8_WAIT_V(0);
    PG8_BAR;
#undef PG8_SA
#undef PG8_SB
#undef PG8_STAGE
#undef PG8_LDA
#undef PG8_LDB
#undef PG8_MMA
#undef PG8_CAT
#undef PG8_WAIT_V
#undef PG8_WAIT_L
#undef PG8_BAR
#undef PG8_SCHED
}

typedef f32x4 Acc[2][2][4][2];
DI u32x4 pack8(const f32x4 a, const f32x4 b) { u32x4 w; w.x = cvtpk(a[0], a[1]); w.y = cvtpk(a[2], a[3]); w.z = cvtpk(b[0], b[1]); w.w = cvtpk(b[2], b[3]); return w; }
DI f32x4 silu4(const f32x4 v) { f32x4 o; o[0] = v[0] * fsigmoid(v[0]); o[1] = v[1] * fsigmoid(v[1]); o[2] = v[2] * fsigmoid(v[2]); o[3] = v[3] * fsigmoid(v[3]); return o; }

struct EpiIn {
    static constexpr bool HAS_MID = false;
    bf16 *Qh, *Vh, *Gh, *Qm, *Km, *Vm, *Rr, *Gb; float *Zf, *KM; const float* bias; bf16* KK; const float* LB; int pn_off;
    DI void operator()(Acc& acc, const Unit& u, int wr, int wc, int fr, int fq) const {
        const int pn = u.pn + pn_off, row0 = u.pm * BM + wr * 64 + fr, cl = wc * 32 + 8 * fq;
        if (pn_off) {
#pragma unroll
            for (int ai = 0; ai < 2; ++ai)
#pragma unroll
                for (int bj = 0; bj < 2; ++bj)
#pragma unroll
                    for (int m = 0; m < 4; ++m) { acc[ai][bj][m][0] *= (1.f / (FP8_SXI * FP8_SW)); acc[ai][bj][m][1] *= (1.f / (FP8_SXI * FP8_SW)); } }
        f32x4 bv[2][2];
#pragma unroll
        for (int bj = 0; bj < 2; ++bj)
#pragma unroll
            for (int n = 0; n < 2; ++n) bv[bj][n] = *(const f32x4*)(bias + pn * 256 + bj * HALF + cl + 4 * n);
        if (pn < 4) {
#define EI_DPP(v, ctrl) __int_as_float(__builtin_amdgcn_update_dpp(0, __float_as_int(v), ctrl, 0xf, 0xf, true))
            const int chb = pn * 128 + cl;
#pragma unroll
            for (int ai = 0; ai < 2; ++ai)
#pragma unroll
                for (int n = 0; n < 2; ++n) { const f32x4 lbv = *(const f32x4*)(LB + chb + 4 * n); f32x4 run = (f32x4){0.f, 0.f, 0.f, 0.f}, bmid = run; f32x4 bbv[4], kkv[4];
#pragma unroll
                    for (int m = 0; m < 4; ++m) {
#pragma unroll
                        for (int j = 0; j < 4; ++j) { const float z = acc[ai][1][m][n][j] + bv[1][n][j]; const float sg = frcp(1.f + __expf(-z)); const float lf = __logf(lbv[j] + (1.f - lbv[j]) * sg); kkv[m][j] = (1.f - lbv[j]) * (1.f - sg);
                            float t = lf; t += EI_DPP(t, 0xB1); t += EI_DPP(t, 0x4E); t += EI_DPP(t, 0x141); t += EI_DPP(t, 0x140);
                            float s = lf; s += EI_DPP(s, 0x111); s += EI_DPP(s, 0x112); s += EI_DPP(s, 0x114); s += EI_DPP(s, 0x118);
                            bbv[m][j] = s + run[j]; run[j] += t; }
                        if (m == 1) bmid = run; }
#pragma unroll
                    for (int m = 0; m < 4; ++m) { f32x4 qp, kp;
#pragma unroll
                        for (int j = 0; j < 4; ++j) { const float qx = acc[ai][0][m][n][j] + bv[0][n][j]; const float e = __expf(__builtin_amdgcn_fmed3f(bbv[m][j] - bmid[j], -60.f, 60.f)); qp[j] = qx * fsigmoid(qx) * e; kp[j] = kkv[m][j] * frcp(e); }
                        const size_t ro = (size_t)(row0 + ai * HALF + m * 16) * 512 + chb + 4 * n;
                        u32x2 qw, kw; qw.x = cvtpk(qp[0], qp[1]); qw.y = cvtpk(qp[2], qp[3]); kw.x = cvtpk(kp[0], kp[1]); kw.y = cvtpk(kp[2], kp[3]);
                        *(u32x2*)(Qh + ro) = qw; *(u32x2*)(KK + ro) = kw; }
                    if (fr == 0) { const size_t so = (size_t)(u.pm * 4 + ai * 2 + wr) * 512 + chb + 4 * n; *(f32x4*)(Zf + so) = bmid; *(f32x4*)(Zf + 262144 + so) = run; }
                    asm volatile("" ::: "memory"); }
#undef EI_DPP
        } else if (pn < 14) {
            const int seg = pn >> 1, c0 = (pn & 1) * 256 + cl;
            {
                bf16* O = seg == 2 ? Vh : seg == 3 ? Gh : seg == 4 ? Qm : seg == 5 ? Km : Vm;
                const int act = (seg == 3) ? 1 : (seg == 4 ? 2 : 0);
                if (seg == 5) {
#pragma unroll
                    for (int bj = 0; bj < 2; ++bj)
#pragma unroll
                        for (int n = 0; n < 2; ++n) { f32x4 cs = (f32x4){0.f, 0.f, 0.f, 0.f};
#pragma unroll
                            for (int ai = 0; ai < 2; ++ai)
#pragma unroll
                                for (int m = 0; m < 4; ++m) cs += acc[ai][bj][m][n] + bv[bj][n];
#pragma unroll
                            for (int j = 0; j < 4; ++j) { float s = cs[j]; s += __shfl_xor(s, 1); s += __shfl_xor(s, 2); s += __shfl_xor(s, 4); s += __shfl_xor(s, 8); cs[j] = s; }
                            if (fr == 0) *(f32x4*)(KM + (size_t)(u.pm * 2 + wr) * 512 + c0 + bj * HALF + 4 * n) = cs; }
                }
#pragma unroll
                for (int ai = 0; ai < 2; ++ai)
#pragma unroll
                    for (int m = 0; m < 4; ++m) { const int row = row0 + ai * HALF + m * 16;
                        bf16* rp = (seg >= 4) ? O + ((size_t)(row >> 11) * 8 * SEQ + (row & (SEQ - 1))) * 64 + (size_t)(c0 >> 6) * SEQ * 64 + (c0 & 63) : O + (size_t)row * 512 + c0;
                        const size_t bjs = (seg >= 4) ? (size_t)2 * SEQ * 64 : (size_t)HALF;
#pragma unroll
                        for (int bj = 0; bj < 2; ++bj) { f32x4 v0 = acc[ai][bj][m][0] + bv[bj][0], v1 = acc[ai][bj][m][1] + bv[bj][1];
                            if (act == 1) { v0 = silu4(v0); v1 = silu4(v1); } else if (act == 2) { v0 = v0 * (0.125f * LOG2E); v1 = v1 * (0.125f * LOG2E); }
                            *(u32x4*)(rp + bj * bjs) = pack8(v0, v1); }
                        asm volatile("" ::: "memory"); }
            }
        } else {
            const int c0 = (pn - 14) * 128 + cl;
#pragma unroll
            for (int ai = 0; ai < 2; ++ai)
#pragma unroll
                for (int m = 0; m < 4; ++m) { const size_t off = (size_t)(row0 + ai * HALF + m * 16) * 1024 + c0; f32x4 r[2], g[2];
#pragma unroll
                    for (int n = 0; n < 2; ++n) { const f32x4 a = acc[ai][0][m][n] + bv[0][n], b = acc[ai][1][m][n] + bv[1][n];
#pragma unroll
                        for (int j = 0; j < 4; ++j) { const float ea = __expf(-a[j]), eb = __expf(-b[j]); g[n][j] = frcp(1.f + eb); r[n][j] = (1.f + eb) * frcp(1.f + ea); } }
                    *(u32x4*)(Rr + off) = pack8(r[0], r[1]); *(u32x4*)(Gb + off) = pack8(g[0], g[1]); asm volatile("" ::: "memory"); }
        }
    }
};
struct EpiProj {
    static constexpr bool HAS_MID = true;
    const bf16 *Rr, *Gb; unsigned char* U;
    DI void scale(Acc& acc, const bf16* G, const Unit& u, int wr, int wc, int fr, int fq) const {
        int row0 = u.pm * BM + wr * 64 + fr, col0 = u.pn * BM + wc * 32 + 8 * fq;
        asm volatile("" : "+v"(row0), "+v"(col0));
#pragma unroll
        for (int ai = 0; ai < 2; ++ai)
#pragma unroll
            for (int mp = 0; mp < 2; ++mp) { u32x4 rv[2][2];
#pragma unroll
            for (int m = 0; m < 2; ++m)
#pragma unroll
                for (int bj = 0; bj < 2; ++bj) rv[m][bj] = *(const u32x4*)(G + (size_t)(row0 + ai * HALF + (2 * mp + m) * 16) * 1024 + col0 + bj * HALF);
#pragma unroll
            for (int m = 0; m < 2; ++m)
#pragma unroll
                for (int bj = 0; bj < 2; ++bj) { const u32x4 w = rv[m][bj];
                    acc[ai][bj][2 * mp + m][0] *= (f32x4){bflo(w.x), bfhi(w.x), bflo(w.y), bfhi(w.y)}; acc[ai][bj][2 * mp + m][1] *= (f32x4){bflo(w.z), bfhi(w.z), bflo(w.w), bfhi(w.w)}; }
            asm volatile("" ::: "memory"); }
    }
    DI void mid(Acc& acc, const Unit& u, int wr, int wc, int fr, int fq) const { scale(acc, Rr, u, wr, wc, fr, fq); }
    DI void operator()(Acc& acc, const Unit& u, int wr, int wc, int fr, int fq) const {
        scale(acc, Gb, u, wr, wc, fr, fq);
        const int row0 = u.pm * BM + wr * 64 + fr, col0 = u.pn * BM + wc * 32 + 8 * fq;
        constexpr float inv = FP8_SU / (FP8_SO * FP8_SW);
#pragma unroll
        for (int ai = 0; ai < 2; ++ai)
#pragma unroll
            for (int m = 0; m < 4; ++m) { unsigned char* rp = U + (size_t)(row0 + ai * HALF + m * 16) * 1024 + col0;
#pragma unroll
                for (int bj = 0; bj < 2; ++bj) { const f32x4 v0 = acc[ai][bj][m][0] * inv, v1 = acc[ai][bj][m][1] * inv; u32x2 w; w.x = cvt4_fp8(v0[0], v0[1], v0[2], v0[3]); w.y = cvt4_fp8(v1[0], v1[1], v1[2], v1[3]); *(u32x2*)(rp + bj * HALF) = w; } }
    }
};
struct EpiOut {
    static constexpr bool HAS_MID = false;
    const bf16* X; bf16* Pre;
    DI void operator()(Acc& acc, const Unit& u, int wr, int wc, int fr, int fq) const {
        int row0 = u.pm * BM + wr * 64 + fr, col0 = u.pn * BM + wc * 32 + 8 * fq;
        asm volatile("" : "+v"(row0), "+v"(col0));
        constexpr float inv = 1.f / (FP8_SU * FP8_SW);
#pragma unroll
        for (int ai = 0; ai < 2; ++ai) { u32x4 xv[4][2];
#pragma unroll
            for (int m = 0; m < 4; ++m)
#pragma unroll
                for (int bj = 0; bj < 2; ++bj) xv[m][bj] = *(const u32x4*)(X + (size_t)(row0 + ai * HALF + m * 16) * 1024 + col0 + bj * HALF);
#pragma unroll
            for (int m = 0; m < 4; ++m)
#pragma unroll
                for (int bj = 0; bj < 2; ++bj) { const u32x4 w = xv[m][bj];
                    const f32x4 v0 = (f32x4){bflo(w.x), bfhi(w.x), bflo(w.y), bfhi(w.y)} * DN_ALPHA + acc[ai][bj][m][0] * inv, v1 = (f32x4){bflo(w.z), bfhi(w.z), bflo(w.w), bfhi(w.w)} * DN_ALPHA + acc[ai][bj][m][1] * inv;
                    *(u32x4*)(Pre + (size_t)(row0 + ai * HALF + m * 16) * 1024 + col0 + bj * HALF) = pack8(v0, v1); }
            asm volatile("" ::: "memory"); }
    }
};
struct EpiM1 {
    static constexpr bool HAS_MID = false;
    unsigned char* H;
    DI void operator()(Acc& acc, const Unit& u, int wr, int wc, int fr, int fq) const {
        const int row0 = u.pm * BM + wr * 64 + fr, col0 = u.pn * 128 + wc * 32 + 8 * fq;
        constexpr float inv = 1.f / (FP8_SX * FP8_SW);
#pragma unroll
        for (int ai = 0; ai < 2; ++ai)
#pragma unroll
            for (int m = 0; m < 4; ++m) { const f32x4 h0 = silu4(acc[ai][0][m][0] * inv) * (acc[ai][1][m][0] * (inv * FP8_SH)), h1 = silu4(acc[ai][0][m][1] * inv) * (acc[ai][1][m][1] * (inv * FP8_SH));
                u32x2 w; w.x = cvt4_fp8(h0[0], h0[1], h0[2], h0[3]); w.y = cvt4_fp8(h1[0], h1[1], h1[2], h1[3]);
                *(u32x2*)(H + (size_t)(row0 + ai * HALF + m * 16) * 512 + col0) = w; }
    }
};
struct EpiM2 {
    static constexpr bool HAS_MID = false;
    unsigned char* Y;
    DI void operator()(Acc& acc, const Unit& u, int wr, int wc, int fr, int fq) const {
        const int row0 = u.pm * BM + wr * 64 + fr, col0 = u.pn * BM + wc * 32 + 8 * fq;
        constexpr float inv = FP8_SY / (FP8_SH * FP8_SW);
#pragma unroll
        for (int ai = 0; ai < 2; ++ai)
#pragma unroll
            for (int m = 0; m < 4; ++m) { unsigned char* rp = Y + (size_t)(row0 + ai * HALF + m * 16) * 1024 + col0;
#pragma unroll
                for (int bj = 0; bj < 2; ++bj) { const f32x4 v0 = acc[ai][bj][m][0] * inv, v1 = acc[ai][bj][m][1] * inv; u32x2 w; w.x = cvt4_fp8(v0[0], v0[1], v0[2], v0[3]); w.y = cvt4_fp8(v1[0], v1[1], v1[2], v1[3]); *(u32x2*)(rp + bj * HALF) = w; } }
    }
};
}

struct Args { const float* in[19]; float* out; unsigned char* ws; int ph_lo, ph_hi; };
enum { I_X = 0, I_WIN, I_BIN, I_LBL, I_HGNG, I_RELB, I_WPA, I_WPB, I_WOUT, I_LN1G, I_LN1B, I_WGRP, I_BGRP, I_WEXP, I_BEXP, I_WGU, I_WDN, I_LN2G, I_LN2B };

struct Ctx {
    LAS unsigned char* lds; volatile LAS unsigned* MISC;
    int tid, lane, wid, G, vcu;
    unsigned char* ws; gu32* ctl;
};

DI int win_drow(int n0) { if (n0 < 512) return 256 * (n0 >> 7) + (n0 & 127); if (n0 < 1024) { const int r = n0 - 512; return 256 * (r >> 7) + 128 + (r & 127); }
    if (n0 < 3584) return n0; if (n0 < 4608) { const int r = n0 - 3584; return 3584 + 256 * (r >> 7) + (r & 127); } const int r = n0 - 4608; return 3584 + 256 * (r >> 7) + 128 + (r & 127); }
DI int wgu_drow(int n0) { if (n0 < 512) return 256 * (n0 >> 7) + (n0 & 127); const int r = n0 - 512; return 256 * (r >> 7) + 128 + (r & 127); }
DI int hswz(int row, int ch16) { return 256 * row + 16 * (ch16 ^ (((row & 3) << 2) | ((row >> 2) & 3))); }
DI int htr(int r0, int c0, int lane) { const int i16 = lane & 15, q = i16 >> 2, p = i16 & 3; return hswz(r0 + q, c0 + (p >> 1)) + 8 * (p & 1); }
DI void transpose_tile256(const float* W, int N, bf16* WT, int ldk, int n0, int mode, int dk, LAS unsigned char* lds, int lane, int wid, bool f8 = false) {
    asm volatile("" : "+v"(lane));
#pragma unroll
    for (int half = 0; half < 2; ++half) { f32x4 v[16];
#pragma unroll
        for (int i = 0; i < 16; ++i) v[i] = *(const f32x4*)(W + (size_t)(128 * half + 8 * i + wid) * N + 4 * lane);
#pragma unroll
        for (int i = 0; i < 16; ++i) { const int k = 128 * half + 8 * i + wid; u32x2 w; w.x = cvtpk(v[i][0], v[i][1]); w.y = cvtpk(v[i][2], v[i][3]);
            *(LAS u32x2*)(lds + (lane >> 5) * 65536 + hswz(k, (lane & 31) >> 1) + 8 * (lane & 1)) = w; } }
    __syncthreads();
    const int g = lane >> 4, i16 = lane & 15;
#pragma unroll
    for (int nb = 0; nb < 2; ++nb) { const int nl = 32 * wid + 16 * nb + i16, n = n0 + nl; const int dr = (mode == 0) ? n : (mode == 1 ? win_drow(n) : wgu_drow(n));
        bf16* orow = WT + (size_t)dr * ldk + dk + 8 * g; const LAS unsigned char* img = lds + (wid >> 2) * 65536;
#pragma unroll
        for (int s = 0; s < 8; ++s) { const int r0 = 32 * s + 8 * g, c0 = 4 * (wid & 3) + 2 * nb;
            const s16x4 lo = vtr((LAS const char*)(img + htr(r0, c0, lane))), hh = vtr((LAS const char*)(img + htr(r0 + 4, c0, lane)));
            if (f8) { u32x2 w; w.x = cvt4_fp8(bf2f((unsigned short)lo[0]) * FP8_SW, bf2f((unsigned short)lo[1]) * FP8_SW, bf2f((unsigned short)lo[2]) * FP8_SW, bf2f((unsigned short)lo[3]) * FP8_SW);
                w.y = cvt4_fp8(bf2f((unsigned short)hh[0]) * FP8_SW, bf2f((unsigned short)hh[1]) * FP8_SW, bf2f((unsigned short)hh[2]) * FP8_SW, bf2f((unsigned short)hh[3]) * FP8_SW);
                *(u32x2*)((unsigned char*)WT + (size_t)dr * ldk + dk + 8 * g + 32 * s) = w; }
            else *(bf16x8*)(orow + 32 * s) = (bf16x8){lo[0], lo[1], lo[2], lo[3], hh[0], hh[1], hh[2], hh[3]}; } }
    __syncthreads();
}
constexpr int MOE_CVT_TILES = 32 * 16 + 32 * 8;
DI void moe_cvt_tile(const Ctx& C, const Args& a, int it) {
    unsigned char* WguT = (unsigned char*)a.out; unsigned char* WdT = (unsigned char*)a.out + 32 * MiB;
    if (it < 512) { const int e = it >> 4, kt = (it >> 2) & 3, nt = it & 3;
        transpose_tile256(a.in[I_WGU] + (size_t)e * 1024 * 1024 + (size_t)(256 * kt) * 1024 + 256 * nt, 1024, (bf16*)(WguT + (size_t)e * 1024 * 1024), 1024, 256 * nt, 2, 256 * kt, C.lds, C.lane, C.wid, true); }
    else { const int r = it - 512, e = r >> 3, kt = (r >> 2) & 1, nt = r & 3;
        transpose_tile256(a.in[I_WDN] + (size_t)e * 512 * 1024 + (size_t)(256 * kt) * 1024 + 256 * nt, 1024, (bf16*)(WdT + (size_t)e * 1024 * 512), 512, 256 * nt, 0, 256 * kt, C.lds, C.lane, C.wid, true); }
}
DI void p0_prologue(const Ctx& C, const Args& a) {
    bf16* WinT = (bf16*)(C.ws + WS_WIN); bf16* Wcat = (bf16*)(C.ws + WS_WCAT); bf16* WoT = (bf16*)(C.ws + WS_WO);
    constexpr int I_IN = 4 * 22, I_PA = 2 * 4, I_O = 4 * 4, NITEMS = I_IN + 2 * I_PA + I_O;
    for (int it = C.vcu; it < NITEMS; it += C.G) {
        int r = it;
        if (r < I_IN) { const int kt = r / 22, nt = r % 22;
            if (nt < 4) transpose_tile256(a.in[I_WIN] + (size_t)(256 * kt) * NIN + 256 * nt, NIN, WinT, 1024, 256 * nt, 1, 256 * kt, C.lds, C.lane, C.wid);
            else transpose_tile256(a.in[I_WIN] + (size_t)(256 * kt) * NIN + 256 * nt, NIN, (bf16*)(C.ws + WS_WIN + 2 * MiB - (size_t)1024 * 1024), 1024, 256 * nt, 1, 256 * kt, C.lds, C.lane, C.wid, true);
            continue; } r -= I_IN;
        if (r < I_PA) { const int kt = r / 4, nt = r % 4; transpose_tile256(a.in[I_WPA] + (size_t)(256 * kt) * 1024 + 256 * nt, 1024, Wcat, 1024, 256 * nt, 0, 256 * kt, C.lds, C.lane, C.wid, true); continue; } r -= I_PA;
        if (r < I_PA) { const int kt = r / 4, nt = r % 4; transpose_tile256(a.in[I_WPB] + (size_t)(256 * kt) * 1024 + 256 * nt, 1024, Wcat, 1024, 256 * nt, 0, 512 + 256 * kt, C.lds, C.lane, C.wid, true); continue; } r -= I_PA;
        { const int kt = r / 4, nt = r % 4; transpose_tile256(a.in[I_WOUT] + (size_t)(256 * kt) * 1024 + 256 * nt, 1024, WoT, 1024, 256 * nt, 0, 256 * kt, C.lds, C.lane, C.wid, true); }
    }
    const int gw = C.vcu * NWAVES + C.wid, NGW = C.G * NWAVES; (void)gw; (void)NGW;
    const int gt = C.vcu * NTHREADS + C.tid, NT = C.G * NTHREADS;
    { const float* x = a.in[I_X]; bf16* Xb = (bf16*)(C.ws + WS_XB);
      unsigned char* Xq = (unsigned char*)a.out + 64 * MiB;
      int i0, i1;
      if (C.G == 256) { if (C.vcu < NITEMS) { i0 = C.vcu * 24; i1 = i0 + 24; } else { const int r = C.vcu - NITEMS, base = NITEMS * 24, rest = 8192 - base, per = rest / (256 - NITEMS), extra = rest % (256 - NITEMS); i0 = base + r * per + (r < extra ? r : extra); i1 = i0 + per + (r < extra ? 1 : 0); } }
      else { i0 = (int)((long)8192 * C.vcu / C.G); i1 = (int)((long)8192 * (C.vcu + 1) / C.G); }
      for (int it = i0; it < i1; ++it) { const size_t i = (size_t)it * 512 + C.tid; const f32x4 v0 = *(const f32x4*)(x + i * 8), v1 = *(const f32x4*)(x + i * 8 + 4); *(u32x4*)(Xb + i * 8) = pg8::pack8(v0, v1);
          u32x2 q; q.x = cvt4_fp8(v0[0] * FP8_SXI, v0[1] * FP8_SXI, v0[2] * FP8_SXI, v0[3] * FP8_SXI); q.y = cvt4_fp8(v1[0] * FP8_SXI, v1[1] * FP8_SXI, v1[2] * FP8_SXI, v1[3] * FP8_SXI); *(u32x2*)(Xq + i * 8) = q; } }
    { float* lbp = (float*)(C.ws + WS_LB); for (int n = gt; n < 512; n += NT) lbp[n] = 1.f / (1.f + expf(a.in[I_LBL][512 + n] - a.in[I_LBL][n])); }
    { float* bp = (float*)(C.ws + WS_BPERM); const float* bin = a.in[I_BIN];
      for (int n = gt; n < NIN; n += NT) bp[win_drow(n & ~31) + (n & 31)] = bin[n]; }
    { bf16* wh = (bf16*)(C.ws + WS_WRH); bf16* wl = (bf16*)(C.ws + WS_WRL); const float* wg = a.in[I_WGRP]; const float* we = a.in[I_WEXP];
      for (int i = gt; i < 48 * 1024; i += NT) { const int j = i >> 10, k = i & 1023; float w = 0.f; if (j < 4) w = wg[k * 4 + j]; else if (j < 36) w = we[k * 32 + (j - 4)];
          const unsigned h = cvtpk(w, 0.f) & 0xffffu; const float r = w - bf2f((unsigned short)h); wh[i] = (bf16)h; wl[i] = (bf16)(cvtpk(r, 0.f) & 0xffffu); } }
}
constexpr int HG_BUF = 67072, HG_QP = 0, HG_KP = 16384, HG_V = 32768, HG_SC = 49152, HG_OB = 49664;
DI void hgrn_unit(const Ctx& C, const Args& a, int b, int h) {
    LAS unsigned char* L = C.lds;
    const int tid = C.tid, lane = C.lane, wid = C.wid;
    const int q32 = lane & 31, hi = lane >> 5, dh = (lane >> 4) & 1, dvb = wid & 3, tb = wid >> 2;
    const float* BM = (const float*)(C.ws + WS_ZF); const float* BE = BM + 262144;
    const bf16* Qh = (const bf16*)(C.ws + WS_QH); const bf16* Kh = (const bf16*)(C.ws + WS_KK); const bf16* Vh = (const bf16*)(C.ws + WS_VH); const bf16* Gh = (const bf16*)(C.ws + WS_GH);
    bf16* Ocat = (bf16*)(C.ws + WS_OCAT);
    const size_t rb = (size_t)b * SEQ;
    LAS float* NGS = (LAS float*)(L + 2 * HG_BUF);
    if (tid < 128) NGS[tid] = a.in[I_HGNG][h * 128 + tid];
    const int orow = tid >> 3, oseg = tid & 7;
    f32x16 T[4];
#pragma unroll
    for (int i = 0; i < 4; ++i)
#pragma unroll
        for (int r = 0; r < 16; ++r) T[i][r] = 0.f;
    u32x4 gr[2];
    const int drow = 8 * wid + (lane >> 4), dch = lane & 15;
#define HG_DMA(c) do { _Pragma("unroll") for (int p = 0; p < 2; ++p) { const int r_ = drow + 4 * p; const int sc_ = dch ^ (((r_ & 3) << 2) | ((r_ >> 2) & 3)); \
            const size_t g_ = (rb + (size_t)(c) * 64 + r_) * 512 + h * 128 + 8 * sc_; LAS unsigned char* d_ = L + ((c) & 1) * HG_BUF + (8 * wid + 4 * p) * 256; \
            __builtin_amdgcn_global_load_lds((const unsigned*)(Qh + g_), (LAS unsigned*)(d_ + HG_QP), 16, 0, 0); \
            __builtin_amdgcn_global_load_lds((const unsigned*)(Kh + g_), (LAS unsigned*)(d_ + HG_KP), 16, 0, 0); \
            __builtin_amdgcn_global_load_lds((const unsigned*)(Vh + g_), (LAS unsigned*)(d_ + HG_V), 16, 0, 0); } } while (0)
    float sm = 0.f, spe = 0.f, spm = 0.f;
#define HG_SCLOAD(c) do { if (tid < 128) { const size_t s_ = (size_t)(b * 32 + (c)) * 512 + h * 128 + tid; sm = BM[s_]; if ((c) > 0) { spe = BE[s_ - 512]; spm = BM[s_ - 512]; } } } while (0)
#define HG_SCALE(c) do { if (tid < 128) ((LAS float*)(L + ((c) & 1) * HG_BUF + HG_SC))[tid] = __expf(sm + (spe - spm)); } while (0)
    HG_DMA(0);
    HG_SCLOAD(0);
    HG_SCALE(0);
    asm volatile("s_waitcnt vmcnt(0)" ::: "memory");
    __syncthreads();
    for (int c = 0; c < 32; ++c) {
        const LAS unsigned char* B = L + (c & 1) * HG_BUF;
        if (c + 1 < 32) { HG_DMA(c + 1); HG_SCLOAD(c + 1); }
        int q32o = q32, hio = hi, laneo = lane; asm volatile("" : "+v"(q32o), "+v"(hio), "+v"(laneo));
        f32x16 oT;
#pragma unroll
        for (int r = 0; r < 16; ++r) oT[r] = 0.f;
        bf16x8 qb[8];
#pragma unroll
        for (int ks = 0; ks < 8; ++ks) qb[ks] = *(const LAS bf16x8*)(B + HG_QP + hswz(32 * tb + q32o, 2 * ks + hio));
#pragma unroll
        for (int sb = 0; sb < 2; ++sb) {
            if (sb <= tb) {
                bf16x8 ka[8];
#pragma unroll
                for (int ks = 0; ks < 8; ++ks) ka[ks] = *(const LAS bf16x8*)(B + HG_KP + hswz(32 * sb + q32o, 2 * ks + hio));
                s16x4 vl[2], vh[2];
#pragma unroll
                for (int s2 = 0; s2 < 2; ++s2) { const int r0 = 32 * sb + 16 * s2 + 4 * hio; vl[s2] = vtr((LAS const char*)(B + HG_V + htr(r0, 4 * dvb + 2 * dh, laneo))); vh[s2] = vtr((LAS const char*)(B + HG_V + htr(r0 + 8, 4 * dvb + 2 * dh, laneo))); }
                __builtin_amdgcn_sched_barrier(0);
                f32x16 pT;
#pragma unroll
                for (int r = 0; r < 16; ++r) pT[r] = 0.f;
#pragma unroll
                for (int ks = 0; ks < 8; ++ks) pT = MFMA32(ka[ks], qb[ks], pT);
                if (sb == tb) {
#pragma unroll
                    for (int r = 0; r < 16; ++r) if (crow(r, hi) > q32) pT[r] = 0.f;
                }
#pragma unroll
                for (int s2 = 0; s2 < 2; ++s2) { u32x4 pw; pw.x = cvtpk(pT[8 * s2 + 0], pT[8 * s2 + 1]); pw.y = cvtpk(pT[8 * s2 + 2], pT[8 * s2 + 3]); pw.z = cvtpk(pT[8 * s2 + 4], pT[8 * s2 + 5]); pw.w = cvtpk(pT[8 * s2 + 6], pT[8 * s2 + 7]);
                    oT = MFMA32(((bf16x8){vl[s2][0], vl[s2][1], vl[s2][2], vl[s2][3], vh[s2][0], vh[s2][1], vh[s2][2], vh[s2][3]}), __builtin_bit_cast(bf16x8, pw), oT); }
                __builtin_amdgcn_sched_barrier(0);
            }
        }
        { const size_t g0 = (rb + (size_t)c * 64 + orow) * 512 + h * 128 + 16 * oseg; gr[0] = *(const u32x4*)(Gh + g0); gr[1] = *(const u32x4*)(Gh + g0 + 8); }
        {
            u32x2 qq0[8], qq1[8];
            if (c > 0) {
#pragma unroll
                for (int i = 0; i < 4; ++i)
#pragma unroll
                    for (int s = 0; s < 2; ++s) { qq0[2 * i + s] = *(const LAS u32x2*)(B + HG_QP + hswz(32 * tb + q32o, 4 * i + 2 * s) + 8 * hio); qq1[2 * i + s] = *(const LAS u32x2*)(B + HG_QP + hswz(32 * tb + q32o, 4 * i + 2 * s + 1) + 8 * hio); }
            }
#pragma unroll
            for (int i = 0; i < 4; ++i)
#pragma unroll
                for (int g = 0; g < 4; ++g) { const f32x4 sc = *(const LAS f32x4*)(B + HG_SC + (32 * i + 8 * g + 4 * hio) * 4);
#pragma unroll
                    for (int j = 0; j < 4; ++j) T[i][4 * g + j] *= sc[j]; }
            __builtin_amdgcn_sched_barrier(0);
            if (c > 0) {
#pragma unroll
                for (int i = 0; i < 4; ++i)
#pragma unroll
                    for (int s = 0; s < 2; ++s) { u32x4 tw; tw.x = cvtpk(T[i][8 * s + 0], T[i][8 * s + 1]); tw.y = cvtpk(T[i][8 * s + 2], T[i][8 * s + 3]); tw.z = cvtpk(T[i][8 * s + 4], T[i][8 * s + 5]); tw.w = cvtpk(T[i][8 * s + 6], T[i][8 * s + 7]);
                        const u32x4 qw = (u32x4){qq0[2 * i + s].x, qq0[2 * i + s].y, qq1[2 * i + s].x, qq1[2 * i + s].y};
                        oT = MFMA32(__builtin_bit_cast(bf16x8, tw), __builtin_bit_cast(bf16x8, qw), oT); }
            }
        }
        { LAS unsigned char* OBp = L + (c & 1) * HG_BUF + HG_OB;
#pragma unroll
          for (int g = 0; g < 4; ++g) { u32x2 w; w.x = cvtpk(oT[4 * g], oT[4 * g + 1]); w.y = cvtpk(oT[4 * g + 2], oT[4 * g + 3]); *(LAS u32x2*)(OBp + (32 * tb + q32o) * 272 + (32 * dvb + 8 * g + 4 * hio) * 2) = w; } }
#pragma unroll
        for (int sp = 0; sp < 2; ++sp) {
            s16x4 vl[2], vh[2], kl[2][4], kh[2][4];
#pragma unroll
            for (int u = 0; u < 2; ++u) { const int r0 = 16 * (2 * sp + u) + 8 * hio;
                vl[u] = vtr((LAS const char*)(B + HG_V + htr(r0, 4 * dvb + 2 * dh, laneo))); vh[u] = vtr((LAS const char*)(B + HG_V + htr(r0 + 4, 4 * dvb + 2 * dh, laneo)));
#pragma unroll
                for (int i = 0; i < 4; ++i) { kl[u][i] = vtr((LAS const char*)(B + HG_KP + htr(r0, 4 * i + 2 * dh, laneo))); kh[u][i] = vtr((LAS const char*)(B + HG_KP + htr(r0 + 4, 4 * i + 2 * dh, laneo))); } }
            __builtin_amdgcn_sched_barrier(0);
#pragma unroll
            for (int u = 0; u < 2; ++u) { const bf16x8 vb = (bf16x8){vl[u][0], vl[u][1], vl[u][2], vl[u][3], vh[u][0], vh[u][1], vh[u][2], vh[u][3]};
#pragma unroll
                for (int i = 0; i < 4; ++i) T[i] = MFMA32(((bf16x8){kl[u][i][0], kl[u][i][1], kl[u][i][2], kl[u][i][3], kh[u][i][0], kh[u][i][1], kh[u][i][2], kh[u][i][3]}), vb, T[i]); }
            __builtin_amdgcn_sched_barrier(0);
        }
        if (c + 1 < 32) HG_SCALE(c + 1);
        asm volatile("s_waitcnt vmcnt(0)" ::: "memory");
        __syncthreads();
        { const LAS unsigned char* OBp = L + (c & 1) * HG_BUF + HG_OB + orow * 272 + oseg * 32;
          const u32x4 o0 = *(const LAS u32x4*)OBp, o1 = *(const LAS u32x4*)(OBp + 16);
          float ov[16];
          ov[0] = bflo(o0.x); ov[1] = bfhi(o0.x); ov[2] = bflo(o0.y); ov[3] = bfhi(o0.y); ov[4] = bflo(o0.z); ov[5] = bfhi(o0.z); ov[6] = bflo(o0.w); ov[7] = bfhi(o0.w);
          ov[8] = bflo(o1.x); ov[9] = bfhi(o1.x); ov[10] = bflo(o1.y); ov[11] = bfhi(o1.y); ov[12] = bflo(o1.z); ov[13] = bfhi(o1.z); ov[14] = bflo(o1.w); ov[15] = bfhi(o1.w);
          float ss = 0.f;
#pragma unroll
          for (int j = 0; j < 16; ++j) ss += ov[j] * ov[j];
          ss += __int_as_float(__builtin_amdgcn_update_dpp(0, __float_as_int(ss), 0xB1, 0xf, 0xf, true));
          ss += __int_as_float(__builtin_amdgcn_update_dpp(0, __float_as_int(ss), 0x4E, 0xf, 0xf, true));
          ss += __int_as_float(__builtin_amdgcn_update_dpp(0, __float_as_int(ss), 0x141, 0xf, 0xf, true));
          const float rs = __builtin_amdgcn_rsqf(ss * (1.f / 128.f) + LN_EPS);
          float ng[16];
#pragma unroll
          for (int i = 0; i < 4; ++i) { const f32x4 n_ = *(const LAS f32x4*)(NGS + 16 * oseg + 4 * i); ng[4 * i] = n_[0]; ng[4 * i + 1] = n_[1]; ng[4 * i + 2] = n_[2]; ng[4 * i + 3] = n_[3]; }
          float gvv[16];
          gvv[0] = bflo(gr[0].x); gvv[1] = bfhi(gr[0].x); gvv[2] = bflo(gr[0].y); gvv[3] = bfhi(gr[0].y); gvv[4] = bflo(gr[0].z); gvv[5] = bfhi(gr[0].z); gvv[6] = bflo(gr[0].w); gvv[7] = bfhi(gr[0].w);
          gvv[8] = bflo(gr[1].x); gvv[9] = bfhi(gr[1].x); gvv[10] = bflo(gr[1].y); gvv[11] = bfhi(gr[1].y); gvv[12] = bflo(gr[1].z); gvv[13] = bfhi(gr[1].z); gvv[14] = bflo(gr[1].w); gvv[15] = bfhi(gr[1].w);
          float rv[16];
#pragma unroll
          for (int j = 0; j < 16; ++j) rv[j] = ov[j] * (rs * FP8_SO) * ng[j] * gvv[j];
          u32x4 w0; w0.x = cvt4_fp8(rv[0], rv[1], rv[2], rv[3]); w0.y = cvt4_fp8(rv[4], rv[5], rv[6], rv[7]); w0.z = cvt4_fp8(rv[8], rv[9], rv[10], rv[11]); w0.w = cvt4_fp8(rv[12], rv[13], rv[14], rv[15]);
          unsigned char* op = (unsigned char*)Ocat + (rb + (size_t)c * 64 + orow) * 1024 + h * 128 + 16 * oseg;
          *(u32x4*)op = w0; }
    }
    __syncthreads();
#undef HG_DMA
#undef HG_SCALE
#undef HG_SCLOAD
}

constexpr int AT_NST = 4, AT_K = 0, AT_V = AT_NST * 8192, AT_KM = 2 * AT_NST * 8192, AT_TAB = AT_KM + 1792;
DI int t5_bucket(int d) { if (d < 16) return d; const int v = 16 + (int)(logf((float)d * (1.f / 16.f)) / logf(8.f) * 16.f); return v < 31 ? v : 31; }
DI void glds16(const void* gsrc, unsigned lds_dst) { unsigned keep;
    asm volatile("s_mov_b32 %0, m0\n\ts_mov_b32 m0, %2\n\ts_nop 0\n\tglobal_load_lds_dwordx4 %1, off\n\ts_mov_b32 m0, %0" : "=&s"(keep) : "v"(gsrc), "s"(lds_dst) : "memory"); }
DI float max3f(float a, float b, float c) { float r; asm("v_max3_f32 %0, %1, %2, %3" : "=v"(r) : "v"(a), "v"(b), "v"(c)); return r; }
DI void attn_unit(const Ctx& C, const Args& a, int b, int h, int jq) {
    LAS unsigned char* L = C.lds;
    const int tid = C.tid, lane = C.lane, wid = C.wid, q32 = lane & 31, hi = lane >> 5;
    const bf16* Qm = (const bf16*)(C.ws + WS_QM); const bf16* Km = (const bf16*)(C.ws + WS_KM); const bf16* Vm = (const bf16*)(C.ws + WS_VM); const float* KM = (const float*)(C.ws + WS_KMEAN);
    bf16* Ocat = (bf16*)(C.ws + WS_OCAT);
    const int tq = jq * 256 + wid * 32 + q32;
    const size_t hb = (size_t)(b * 8 + h) * SEQ;
    bf16x8 qf[4];
#pragma unroll
    for (int ks = 0; ks < 4; ++ks) qf[ks] = *(const bf16x8*)(Qm + (hb + tq) * 64 + 16 * ks + 8 * hi);
    LAS float* kml = (LAS float*)(L + AT_KM); LAS float* tab = (LAS float*)(L + AT_TAB);
    if (tid < jq * 64) { const int n = tid >> 6, d = tid & 63; kml[tid] = KM[(size_t)((b * 8 + n) * 2 + 0) * 512 + h * 64 + d] + KM[(size_t)((b * 8 + n) * 2 + 1) * 512 + h * 64 + d]; }
    if (tid < 129) tab[tid] = (a.in[I_RELB][t5_bucket(tid) * 8 + h] - a.in[I_RELB][31 * 8 + h]) * LOG2E;
    const int drow = 8 * wid + (lane >> 3), dch = lane & 7;
    const bf16* ksrc = Km + (hb + drow) * 64 + 8 * (dch ^ ((drow >> 1) & 7));
    const bf16* vsrc = Vm + (hb + drow) * 64 + 8 * (dch ^ (((drow >> 1) & 1) << 2));
    const unsigned kdst = (unsigned)__builtin_amdgcn_readfirstlane((int)(unsigned)(size_t)(L + AT_K + wid * 1024)), vdst = (unsigned)__builtin_amdgcn_readfirstlane((int)(unsigned)(size_t)(L + AT_V + wid * 1024));
    const int nt = 4 * jq + 4;
#define AT_ISSUE(t) do { glds16(ksrc + (size_t)(t) * 4096, kdst + ((t) & 3) * 8192); glds16(vsrc + (size_t)(t) * 4096, vdst + ((t) & 3) * 8192); } while (0)
    AT_ISSUE(0); AT_ISSUE(1); AT_ISSUE(2);
    __syncthreads();
    unsigned sel = 0;
    {
        float g[7];
#pragma unroll
        for (int n = 0; n < 7; ++n) { g[n] = 0.f;
            if (n < jq) { float s = 0.f;
#pragma unroll
                for (int ks = 0; ks < 4; ++ks)
#pragma unroll
                    for (int j = 0; j < 8; ++j) s += bf2f((unsigned short)qf[ks][j]) * kml[n * 64 + 16 * ks + 8 * hi + j];
                s += __shfl_xor(s, 32); g[n] = s; } }
#pragma unroll
        for (int n = 0; n < 7; ++n) if (n < jq) { int rank = 0;
#pragma unroll
            for (int m = 0; m < 7; ++m) if (m != n && m < jq) rank += (g[m] > g[n] || (g[m] == g[n] && m < n)) ? 1 : 0;
            if (rank < 3) sel |= 1u << n; }
    }
    const float c31 = a.in[I_RELB][31 * 8 + h] * LOG2E;
    f32x16 lacc;
#pragma unroll
    for (int r = 0; r < 16; ++r) lacc[r] = 0.f;
    const bf16x8 ones8 = (bf16x8){0x3F80, 0x3F80, 0x3F80, 0x3F80, 0x3F80, 0x3F80, 0x3F80, 0x3F80};
    f32x16 negm;
#pragma unroll
    for (int r = 0; r < 16; ++r) negm[r] = c31;
    f32x16 o0, o1;
#pragma unroll
    for (int r = 0; r < 16; ++r) { o0[r] = 0.f; o1[r] = 0.f; }
    const int i16 = lane & 15, qq = i16 >> 2, pp = i16 & 3, dh = (lane >> 4) & 1, xsw = (qq >> 1) & 1;
    const int vb0 = (4 * hi + qq) * 128 + 64 * (0 ^ xsw) + 32 * dh + 8 * pp, vb1 = (4 * hi + qq) * 128 + 64 * (1 ^ xsw) + 32 * dh + 8 * pp;
    const int kxs = (q32 >> 1) & 7;
    for (int kt = 0; kt < nt; ++kt) {
        if (kt + 2 < nt) asm volatile("s_waitcnt vmcnt(4)" ::: "memory"); else if (kt + 1 < nt) asm volatile("s_waitcnt vmcnt(2)" ::: "memory"); else asm volatile("s_waitcnt vmcnt(0)" ::: "memory");
        __builtin_amdgcn_s_barrier();
        asm volatile("" ::: "memory");
        if (kt + 3 < nt) AT_ISSUE(kt + 3);
        const int blk = kt >> 2; const bool own = (blk == jq);
        const bool active = !own || ((kt & 3) * 64 <= wid * 32 + 31);
        if (active) {
            const LAS unsigned char* Kc = L + AT_K + (kt & 3) * 8192; const LAS unsigned char* Vc = L + AT_V + (kt & 3) * 8192;
            bf16x8 kf[8];
#pragma unroll
            for (int ks = 0; ks < 4; ++ks) { const int ko = (((2 * ks + hi) ^ kxs) << 4); kf[2 * ks] = *(const LAS bf16x8*)(Kc + q32 * 128 + ko); kf[2 * ks + 1] = *(const LAS bf16x8*)(Kc + (32 + q32) * 128 + ko); }
            __builtin_amdgcn_sched_barrier(0);
            f32x16 s0 = negm, s1 = negm;
#pragma unroll
            for (int ks = 0; ks < 4; ++ks) { s0 = MFMA32(kf[2 * ks], qf[ks], s0); s1 = MFMA32(kf[2 * ks + 1], qf[ks], s1); }
            __builtin_amdgcn_sched_barrier(0);
            s16x4 vf[2][4][2];
#pragma unroll
            for (int j = 0; j < 4; ++j) { const int ro = 16 * j * 128;
                vf[0][j][0] = vtr((LAS const char*)(Vc + vb0 + ro)); vf[0][j][1] = vtr((LAS const char*)(Vc + vb0 + ro + 8 * 128));
                vf[1][j][0] = vtr((LAS const char*)(Vc + vb1 + ro)); vf[1][j][1] = vtr((LAS const char*)(Vc + vb1 + ro + 8 * 128)); }
            __builtin_amdgcn_sched_barrier(0);
            const bool near = (jq * 256 + wid * 32 - 64 * kt - 63) < 128;
            if (near) {
                const int dist0 = tq - 64 * kt - 4 * hi;
#pragma unroll
                for (int r = 0; r < 16; ++r) { const int d0 = dist0 - ((r & 3) + 8 * (r >> 2)), d1 = d0 - 32;
                    const int i0 = d0 < 0 ? 0 : (d0 > 128 ? 128 : d0), i1 = d1 < 0 ? 0 : (d1 > 128 ? 128 : d1);
                    const float t0 = tab[i0], t1 = tab[i1]; s0[r] += t0; s1[r] += t1; s0[r] = d0 < 0 ? -INFINITY : s0[r]; s1[r] = d1 < 0 ? -INFINITY : s1[r]; }
            }
            const bool lsel = own || ((sel >> blk) & 1u);
            float mx = max3f(s0[0], s1[0], s0[1]), mx2 = max3f(s1[1], s0[2], s1[2]);
#pragma unroll
            for (int r = 3; r < 15; r += 2) { mx = max3f(mx, s0[r], s1[r]); mx2 = max3f(mx2, s0[r + 1], s1[r + 1]); }
            mx = max3f(mx, s0[15], s1[15]); mx = fmaxf(mx, mx2);
            mx = lsel ? mx : -INFINITY;
            mx = fmaxf(mx, __shfl_xor(mx, 32));
            if (__any(mx > 4.0f)) {
                const float delta = fmaxf(mx, 0.f), alpha = __builtin_amdgcn_exp2f(-delta);
#pragma unroll
                for (int r = 0; r < 16; ++r) { o0[r] *= alpha; o1[r] *= alpha; lacc[r] *= alpha; negm[r] -= delta; s0[r] -= delta; s1[r] -= delta; }
            }
#pragma unroll
            for (int r = 0; r < 16; ++r) { s0[r] = __builtin_amdgcn_exp2f(s0[r]); s1[r] = __builtin_amdgcn_exp2f(s1[r]); }
            const unsigned pmask = lsel ? 0xffffffffu : 0u;
#pragma unroll
            for (int kb = 0; kb < 2; ++kb)
#pragma unroll
                for (int s2 = 0; s2 < 2; ++s2) {
                    u32x4 pw;
                    if (kb == 0) { pw.x = cvtpk(s0[8 * s2 + 0], s0[8 * s2 + 1]); pw.y = cvtpk(s0[8 * s2 + 2], s0[8 * s2 + 3]); pw.z = cvtpk(s0[8 * s2 + 4], s0[8 * s2 + 5]); pw.w = cvtpk(s0[8 * s2 + 6], s0[8 * s2 + 7]); }
                    else         { pw.x = cvtpk(s1[8 * s2 + 0], s1[8 * s2 + 1]); pw.y = cvtpk(s1[8 * s2 + 2], s1[8 * s2 + 3]); pw.z = cvtpk(s1[8 * s2 + 4], s1[8 * s2 + 5]); pw.w = cvtpk(s1[8 * s2 + 6], s1[8 * s2 + 7]); }
                    pw.x &= pmask; pw.y &= pmask; pw.z &= pmask; pw.w &= pmask;
                    const bf16x8 pf = __builtin_bit_cast(bf16x8, pw);
                    const s16x4 a0l = vf[0][2 * kb + s2][0], a0h = vf[0][2 * kb + s2][1], a1l = vf[1][2 * kb + s2][0], a1h = vf[1][2 * kb + s2][1];
                    o0 = MFMA32(((bf16x8){a0l[0], a0l[1], a0l[2], a0l[3], a0h[0], a0h[1], a0h[2], a0h[3]}), pf, o0);
                    o1 = MFMA32(((bf16x8){a1l[0], a1l[1], a1l[2], a1l[3], a1h[0], a1h[1], a1h[2], a1h[3]}), pf, o1);
                    lacc = MFMA32(ones8, pf, lacc);
                }
        }
    }
    const float linv = 1.f / lacc[0];
    unsigned char* op = (unsigned char*)Ocat + ((size_t)b * SEQ + tq) * 1024 + 512 + h * 64;
    const float lsc = linv * FP8_SO;
#pragma unroll
    for (int g = 0; g < 4; ++g) { *(unsigned*)(op + 8 * g + 4 * hi) = cvt4_fp8(o0[4 * g] * lsc, o0[4 * g + 1] * lsc, o0[4 * g + 2] * lsc, o0[4 * g + 3] * lsc);
        *(unsigned*)(op + 32 + 8 * g + 4 * hi) = cvt4_fp8(o1[4 * g] * lsc, o1[4 * g + 1] * lsc, o1[4 * g + 2] * lsc, o1[4 * g + 3] * lsc); }
    __syncthreads();
#undef AT_ISSUE
}

#ifndef PROBE_HGX
#define PROBE_HGX 1
#endif
#ifndef PROBE_ATX
#define PROBE_ATX 1
#endif
#ifndef STAMP_SEL
#define STAMP_SEL -1
#endif
#ifndef STAMP_BLK
#define STAMP_BLK 0
#endif
#define STAMP(i) do { if (STAMP_SEL >= 0 && blockIdx.x == STAMP_BLK && C.tid == 0) { const unsigned long long t_ = __builtin_amdgcn_s_memrealtime(); C.MISC[16 + 2 * (i)] = (unsigned)t_; C.MISC[17 + 2 * (i)] = (unsigned)(t_ >> 32); } } while (0)
DI void p2_mixers(const Ctx& C, const Args& a, int rep) {
    for (int hx = 0; hx < PROBE_HGX; ++hx)
    for (int u = blockIdx.x; u < 64; u += C.G) hgrn_unit(C, a, u >> 2, u & 3);
    STAMP(11);
    unsigned* QA = (unsigned*)(C.ctl + CW_QUEUE + 64 * rep); unsigned* QC = (unsigned*)(C.ctl + CW_QUEUE2 + 64 * rep);
    constexpr int NA = 1024 * PROBE_ATX, NC = MOE_CVT_TILES;
    if (C.tid == 0) { C.MISC[0] = __hip_atomic_fetch_add(QA, 1u, __ATOMIC_RELAXED, __HIP_MEMORY_SCOPE_AGENT); C.MISC[1] = (rep == 0) ? __hip_atomic_fetch_add(QC, 1u, __ATOMIC_RELAXED, __HIP_MEMORY_SCOPE_AGENT) : (unsigned)NC; }
    __syncthreads();
    int qa = (int)C.MISC[0], qc = (int)C.MISC[1];
    __syncthreads();
    for (;;) {
        const bool doa = qa < NA, doc = qc < NC;
        if (!doa && !doc) break;
        unsigned na = (unsigned)NA, nc = (unsigned)NC;
        if (C.tid == 0) { if (doa) na = __hip_atomic_fetch_add(QA, 1u, __ATOMIC_RELAXED, __HIP_MEMORY_SCOPE_AGENT); if (doc) nc = __hip_atomic_fetch_add(QC, 1u, __ATOMIC_RELAXED, __HIP_MEMORY_SCOPE_AGENT); }
#ifdef STAMP_ACC
        unsigned long long ta_ = 0, tb_ = 0, tc_ = 0; if (C.tid == 0) ta_ = __builtin_amdgcn_s_memrealtime();
#endif
        if (doa) { const int q = qa / PROBE_ATX; attn_unit(C, a, (q & 127) >> 3, q & 7, 7 - (q >> 7)); }
#ifdef STAMP_ACC
        if (C.tid == 0) tb_ = __builtin_amdgcn_s_memrealtime();
#endif
        if (doc) moe_cvt_tile(C, a, qc);
#ifdef STAMP_ACC
        if (C.tid == 0 && blockIdx.x == 100) { tc_ = __builtin_amdgcn_s_memrealtime(); const unsigned long long d_ = (STAMP_ACC == 0) ? (tb_ - ta_) : (tc_ - tb_);
            const unsigned long long o_ = ((unsigned long long)C.MISC[45] << 32) | C.MISC[44]; const unsigned long long n_ = o_ + d_; C.MISC[44] = (unsigned)n_; C.MISC[45] = (unsigned)(n_ >> 32); }
#endif
        if (C.tid == 0) { C.MISC[0] = na; C.MISC[1] = nc; }
        __syncthreads();
        qa = (int)C.MISC[0]; qc = (int)C.MISC[1];
        __syncthreads();
    }
    STAMP(12);
#ifdef STAMP_ACC
    if (C.tid == 0 && blockIdx.x == 100) { const unsigned long long n_ = ((unsigned long long)C.MISC[45] << 32) | C.MISC[44]; const unsigned long long w0 = __builtin_amdgcn_s_memrealtime(); while (__builtin_amdgcn_s_memrealtime() - w0 < 4ull * n_) __builtin_amdgcn_s_sleep(8); }
#endif
}

DI void r1_phase(const Ctx& C, const Args& a) {
    LAS unsigned char* L = C.lds;
    const int tid = C.tid, lane = C.lane, wid = C.wid;
    LAS float* LG = (LAS float*)L + wid * 16 * 48;
    LAS int* CNT = (LAS int*)(L + 32768);
    LAS float* G1 = (LAS float*)(L + 33024); LAS float* B1 = (LAS float*)(L + 37120);
    const bf16* Pre = (const bf16*)(C.ws + WS_ZF); unsigned char* X1q = (unsigned char*)(C.ws + WS_R); f32x2* stats = (f32x2*)(C.ws + WS_STATS);
    const bf16* WrH = (const bf16*)(C.ws + WS_WRH); const bf16* WrL = (const bf16*)(C.ws + WS_WRL);
    unsigned* tokE = (unsigned*)(C.ws + WS_TOKE); float* tokW = (float*)(C.ws + WS_TOKW); int* wgcnt = (int*)(C.ws + WS_WGCNT);
    for (int i = tid; i < 1024; i += NTHREADS) { G1[i] = a.in[I_LN1G][i]; B1[i] = a.in[I_LN1B][i]; }
    LAS unsigned char* WL = L + 45056;
    for (int i = tid; i < 48 * 128; i += NTHREADS) { const int r = i >> 7, c = i & 127; *(LAS u32x4*)(WL + r * 2064 + c * 16) = *(const u32x4*)(WrH + (size_t)r * 1024 + c * 8); }
    LAS float* RB = (LAS float*)(L + 41216);
    if (tid < 4) RB[tid] = a.in[I_BGRP][tid]; else if (tid < 36) RB[tid] = a.in[I_BEXP][tid - 4];
    const int m16 = lane & 15, kq = lane >> 4;
    for (int chunk = blockIdx.x; chunk < NTOK / 128; chunk += C.G) {
        if (tid < 32) CNT[tid] = 0;
        __syncthreads();
        const int tok0 = chunk * 128 + wid * 16;
        const bf16* xrow = Pre + (size_t)(tok0 + m16) * 1024 + 8 * kq;
        float s = 0.f, s2 = 0.f;
#pragma unroll 8
        for (int k0 = 0; k0 < 1024; k0 += 32) { const u32x4 w = *(const u32x4*)(xrow + k0); const f32x4 xa = (f32x4){bflo(w.x), bfhi(w.x), bflo(w.y), bfhi(w.y)}, xc = (f32x4){bflo(w.z), bfhi(w.z), bflo(w.w), bfhi(w.w)};
            s += (xa[0] + xa[1]) + (xa[2] + xa[3]) + (xc[0] + xc[1]) + (xc[2] + xc[3]);
            s2 += (xa[0] * xa[0] + xa[1] * xa[1]) + (xa[2] * xa[2] + xa[3] * xa[3]) + (xc[0] * xc[0] + xc[1] * xc[1]) + (xc[2] * xc[2] + xc[3] * xc[3]); }
        s += __shfl_xor(s, 16); s += __shfl_xor(s, 32); s2 += __shfl_xor(s2, 16); s2 += __shfl_xor(s2, 32);
        const float mean = s * (1.f / 1024.f); const float var = fmaxf(s2 * (1.f / 1024.f) - mean * mean, 0.f); const float rstd = 1.f / sqrtf(var + LN_EPS);
        if (kq == 0) stats[tok0 + m16] = (f32x2){mean, rstd};
        STAMP(13);
        f32x4 acc[3];
#pragma unroll
        for (int nb = 0; nb < 3; ++nb) acc[nb] = (f32x4){0.f, 0.f, 0.f, 0.f};
        unsigned char* xb = X1q + (size_t)(tok0 + m16) * 1024 + 8 * kq;
        const LAS unsigned char* wlp = WL + m16 * 2064 + 16 * kq;
#pragma unroll 1
        for (int kb = 0; kb < 4; ++kb) {
            u32x4 xw[8];
#pragma unroll
            for (int j = 0; j < 8; ++j) xw[j] = *(const u32x4*)(xrow + kb * 256 + 32 * j);
#pragma unroll
            for (int j = 0; j < 8; ++j) { const int k0 = kb * 256 + 32 * j;
                bf16x8 wh[3];
#pragma unroll
                for (int nb = 0; nb < 3; ++nb) wh[nb] = *(const LAS bf16x8*)(wlp + nb * 16 * 2064 + k0 * 2);
                const f32x4 xaj = (f32x4){bflo(xw[j].x), bfhi(xw[j].x), bflo(xw[j].y), bfhi(xw[j].y)}, xcj = (f32x4){bflo(xw[j].z), bfhi(xw[j].z), bflo(xw[j].w), bfhi(xw[j].w)};
                const f32x4 ya = (xaj - mean) * rstd * *(const LAS f32x4*)(G1 + k0 + 8 * kq) + *(const LAS f32x4*)(B1 + k0 + 8 * kq);
                const f32x4 yc = (xcj - mean) * rstd * *(const LAS f32x4*)(G1 + k0 + 8 * kq + 4) + *(const LAS f32x4*)(B1 + k0 + 8 * kq + 4);
                u32x4 hw; hw.x = cvtpk(ya[0], ya[1]); hw.y = cvtpk(ya[2], ya[3]); hw.z = cvtpk(yc[0], yc[1]); hw.w = cvtpk(yc[2], yc[3]);
                { u32x2 qw; qw.x = cvt4_fp8(ya[0] * FP8_SX, ya[1] * FP8_SX, ya[2] * FP8_SX, ya[3] * FP8_SX); qw.y = cvt4_fp8(yc[0] * FP8_SX, yc[1] * FP8_SX, yc[2] * FP8_SX, yc[3] * FP8_SX); *(u32x2*)(xb + k0) = qw; }
                u32x4 lw; lw.x = cvtpk(ya[0] - bflo(hw.x), ya[1] - bfhi(hw.x)); lw.y = cvtpk(ya[2] - bflo(hw.y), ya[3] - bfhi(hw.y)); lw.z = cvtpk(yc[0] - bflo(hw.z), yc[1] - bfhi(hw.z)); lw.w = cvtpk(yc[2] - bflo(hw.w), yc[3] - bfhi(hw.w));
                const bf16x8 xh = __builtin_bit_cast(bf16x8, hw), xl = __builtin_bit_cast(bf16x8, lw);
#pragma unroll
                for (int nb = 0; nb < 3; ++nb) { acc[nb] = MFMA16(wh[nb], xh, acc[nb]); acc[nb] = MFMA16(wh[nb], xl, acc[nb]); }
            }
        }
        STAMP(14);
#pragma unroll
        for (int nb = 0; nb < 3; ++nb)
#pragma unroll
            for (int r = 0; r < 4; ++r) LG[m16 * 48 + nb * 16 + 4 * kq + r] = acc[nb][r];
        asm volatile("s_waitcnt lgkmcnt(0)" ::: "memory");
        if (lane < 16) {
            const LAS float* lg = LG + lane * 48;
            float gl[4];
#pragma unroll
            for (int j = 0; j < 4; ++j) gl[j] = lg[j] + RB[j];
            int grp = 0; float gm = gl[0];
#pragma unroll
            for (int j = 1; j < 4; ++j) if (gl[j] > gm) { gm = gl[j]; grp = j; }
            float se = 0.f;
#pragma unroll
            for (int j = 0; j < 4; ++j) se += __expf(gl[j] - gm);
            const float pg = 1.f / se;
            float el[8];
#pragma unroll
            for (int j = 0; j < 8; ++j) el[j] = lg[4 + grp * 8 + j] + RB[4 + grp * 8 + j];
            int i0 = 0; float v0 = el[0];
#pragma unroll
            for (int j = 1; j < 8; ++j) if (el[j] > v0) { v0 = el[j]; i0 = j; }
            int i1 = -1; float v1 = -INFINITY;
#pragma unroll
            for (int j = 0; j < 8; ++j) if (j != i0 && el[j] > v1) { v1 = el[j]; i1 = j; }
            const float w0 = 1.f / (1.f + __expf(v1 - v0)), w1 = 1.f - w0;
            const int e0 = grp * 8 + i0, e1 = grp * 8 + i1;
            const int r0 = __hip_atomic_fetch_add(CNT + e0, 1, __ATOMIC_RELAXED, __HIP_MEMORY_SCOPE_WORKGROUP), r1 = __hip_atomic_fetch_add(CNT + e1, 1, __ATOMIC_RELAXED, __HIP_MEMORY_SCOPE_WORKGROUP);
            const int tok = tok0 + lane;
            tokE[tok] = (unsigned)e0 | ((unsigned)e1 << 8) | ((unsigned)r0 << 16) | ((unsigned)r1 << 24);
            tokW[tok * 2] = w0 * pg; tokW[tok * 2 + 1] = w1 * pg;
        }
        __syncthreads();
        if (tid < 32) wgcnt[chunk * 32 + tid] = CNT[tid];
        __syncthreads();
    }
}

DI void r2_phase(const Ctx& C, const Args& a) {
    LAS int* PA = (LAS int*)C.lds;
    LAS int* PB = PA + 512;
    LAS int* TOT = PB + 512; LAS int* BASE = TOT + 32; LAS int* PST = BASE + 32;
    const int tid = C.tid;
    const int* wgcnt = (const int*)(C.ws + WS_WGCNT); const unsigned* tokE = (const unsigned*)(C.ws + WS_TOKE);
    int* tokD = (int*)(C.ws + WS_TOKD); int* rowtok = (int*)(C.ws + WS_ROWTOK); int* tilee = (int*)(C.ws + WS_TILEE);
    for (int chunk = blockIdx.x; chunk < NTOK / 128; chunk += C.G) {
        { const int e = tid & 31, part = tid >> 5; int sa = 0, sb = 0;
          for (int c = part * 16; c < part * 16 + 16; ++c) { const int v = wgcnt[c * 32 + e]; sa += v; sb += (c < chunk) ? v : 0; }
          PA[part * 32 + e] = sa; PB[part * 32 + e] = sb; }
        __syncthreads();
        if (tid < 32) { int sa = 0, sb = 0; for (int p = 0; p < 16; ++p) { sa += PA[p * 32 + tid]; sb += PB[p * 32 + tid]; } TOT[tid] = sa; BASE[tid] = sb; }
        __syncthreads();
        if (tid == 0) { int ps = 0; for (int e = 0; e < 32; ++e) { PST[e] = ps; ps += ((TOT[e] + 255) >> 8) << 8; } PST[32] = ps; }
        __syncthreads();
        if (tid < 128) { const int tok = chunk * 128 + tid; const unsigned w = tokE[tok]; const int e0 = w & 31, e1 = (w >> 8) & 31, r0 = (w >> 16) & 255, r1 = (w >> 24) & 255;
            const int d0 = PST[e0] + BASE[e0] + r0, d1 = PST[e1] + BASE[e1] + r1; rowtok[d0] = tok; rowtok[d1] = tok; tokD[tok * 2] = d0; tokD[tok * 2 + 1] = d1; }
        if (chunk < 32) { const int e = chunk, end = PST[e + 1] - PST[e]; for (int i = TOT[e] + tid; i < end; i += NTHREADS) rowtok[PST[e] + i] = 0; }
        if (chunk == 0) { if (tid < 32) { for (int t = PST[tid] >> 8; t < (PST[tid + 1] >> 8); ++t) tilee[t] = tid; } if (tid == 0) tilee[511] = PST[32] >> 8; }
        __syncthreads();
    }
}

DI void f_phase(const Ctx& C, const Args& a) {
    const int lane = C.lane, gw = C.vcu * NWAVES + C.wid, NGW = C.G * NWAVES;
    const bf16* Pre = (const bf16*)(C.ws + WS_ZF); const unsigned char* Y = (const unsigned char*)(C.ws + WS_Y); const int* tokD = (const int*)(C.ws + WS_TOKD); const float* tokW = (const float*)(C.ws + WS_TOKW);
    const f32x2* stats = (const f32x2*)(C.ws + WS_STATS);
    f32x4 g2[4], b2[4], g1[4], b1[4];
#pragma unroll
    for (int j = 0; j < 4; ++j) { g2[j] = *(const f32x4*)(a.in[I_LN2G] + 256 * j + 4 * lane); b2[j] = *(const f32x4*)(a.in[I_LN2B] + 256 * j + 4 * lane);
        g1[j] = *(const f32x4*)(a.in[I_LN1G] + 256 * j + 4 * lane) * DN_ALPHA; b1[j] = *(const f32x4*)(a.in[I_LN1B] + 256 * j + 4 * lane) * DN_ALPHA; }
    for (int tok = gw; tok < NTOK; tok += NGW) {
        const int d0 = tokD[tok * 2], d1 = tokD[tok * 2 + 1]; const float w0 = tokW[tok * 2] * (1.f / FP8_SY), w1 = tokW[tok * 2 + 1] * (1.f / FP8_SY); const f32x2 st = stats[tok];
        const bf16* xr = Pre + (size_t)tok * 1024 + 4 * lane; const unsigned char* y0 = Y + (size_t)d0 * 1024 + 4 * lane; const unsigned char* y1 = Y + (size_t)d1 * 1024 + 4 * lane;
        f32x4 v[4]; float s = 0.f;
#pragma unroll
        for (int j = 0; j < 4; ++j) { const u32x2 xw = *(const u32x2*)(xr + 256 * j); const f32x4 x = (f32x4){bflo(xw.x), bfhi(xw.x), bflo(xw.y), bfhi(xw.y)}; const unsigned p0 = *(const unsigned*)(y0 + 256 * j), p1 = *(const unsigned*)(y1 + 256 * j);
            v[j] = ((x - st.x) * st.y) * g1[j] + b1[j] + fp8x4_to_f32(p0) * w0 + fp8x4_to_f32(p1) * w1;
            s += (v[j][0] + v[j][1]) + (v[j][2] + v[j][3]); }
        const float mean = wave_sum(s) * (1.f / 1024.f); float s2 = 0.f;
#pragma unroll
        for (int j = 0; j < 4; ++j) { v[j] = v[j] - mean; s2 += (v[j][0] * v[j][0] + v[j][1] * v[j][1]) + (v[j][2] * v[j][2] + v[j][3] * v[j][3]); }
        const float rstd = 1.f / sqrtf(wave_sum(s2) * (1.f / 1024.f) + LN_EPS);
        float* orow = a.out + (size_t)tok * 1024 + 4 * lane;
#pragma unroll
        for (int j = 0; j < 4; ++j) *(f32x4*)(orow + 256 * j) = v[j] * rstd * g2[j] + b2[j];
    }
}

constexpr int NPH = 10;
__global__ void __launch_bounds__(NTHREADS, 2) mk_fwd(Args args) {
    extern __shared__ __attribute__((aligned(16))) unsigned char lds_raw[];
    Ctx C;
    C.lds = (LAS unsigned char*)lds_raw; C.MISC = (volatile LAS unsigned*)(C.lds + MISC_OFF);
    C.tid = threadIdx.x; C.lane = C.tid & 63; C.wid = __builtin_amdgcn_readfirstlane(C.tid >> 6);
    C.G = gridDim.x; { const int bx = blockIdx.x; C.vcu = (C.G % 8 == 0) ? (bx % 8) * (C.G / 8) + bx / 8 : bx; }
    C.ws = args.ws; C.ctl = (gu32*)(args.ws + WS_CTL);
    if (C.tid < 64) C.MISC[C.tid] = 0u;
    __syncthreads();
    XcdBarrier bar; bar.bar = (unsigned*)(C.ctl + CW_BAR); bar.x = 0; bar.st = nullptr;
    if (MK_N_LAUNCHES == 1) bar = xcd_barrier_post((unsigned*)(C.ctl + CW_BAR), C.MISC + 8);
    const int lo = args.ph_lo, hi = args.ph_hi;
#ifndef PH_MASK
#define PH_MASK 0x3ff
#endif
#define IN(k) (((PH_MASK >> (k)) & 1) && lo <= (k) && (k) < hi)
#ifndef STAMP_SEL
#define STAMP_SEL -1
#endif
#ifndef STAMP_T0
#define STAMP_T0 STAMP_SEL
#define STAMP_T1 (STAMP_SEL + 1)
#endif
#define SEAM(k) do { if (IN(k) && IN((k) + 1)) xcd_barrier(bar); STAMP((k) + 1); } while (0)
#ifndef PROBE_PHASE
#define PROBE_PHASE -1
#endif
#define REPS(k) ((PROBE_PHASE == (k)) ? 2 : 1)
#define REPSEAM(k) do { if (rep + 1 < REPS(k)) xcd_barrier(bar); } while (0)
    unsigned char* ws = args.ws;
    LAS unsigned char* ring = C.lds;

    STAMP(0);
    if (IN(0)) { _Pragma("unroll") for (int rep = 0; rep < REPS(0); ++rep) { p0_prologue(C, args); REPSEAM(0); } } SEAM(0);

    if (IN(1)) _Pragma("unroll") for (int rep = 0; rep < REPS(1); ++rep) {
        pg8::EpiIn E{(bf16*)(ws + WS_QH), (bf16*)(ws + WS_VH), (bf16*)(ws + WS_GH), (bf16*)(ws + WS_QM), (bf16*)(ws + WS_KM), (bf16*)(ws + WS_VM), (bf16*)(ws + WS_R), (bf16*)(ws + WS_GB),
                     (float*)(ws + WS_ZF), (float*)(ws + WS_KMEAN), (const float*)(ws + WS_BPERM), (bf16*)(ws + WS_KK), (const float*)(ws + WS_LB), 0};
        { pg8::DenseOrder S; S.init(ws + WS_XB, ws + WS_WIN, NTOK, 1024, 1024, C.G, (int)blockIdx.x);
          pg8::gemm_phase<pg8::EpiIn, pg8::DenseOrder, false>(ring, 1024, S, E); }
        { E.pn_off = 4; pg8::DenseOrder S; S.init((unsigned char*)args.out + 64 * MiB, ws + WS_WIN + 2 * MiB, NTOK, 4608, 512, C.G, (int)blockIdx.x);
          pg8::gemm_phase<pg8::EpiIn, pg8::DenseOrder, false, true>(ring, 512, S, E); }
        REPSEAM(1);
    } SEAM(1);

#ifndef PROBE_P2X
#define PROBE_P2X 1
#endif
    if (IN(2)) { for (int rep = 0; rep < PROBE_P2X; ++rep) { p2_mixers(C, args, rep); if (rep + 1 < PROBE_P2X) xcd_barrier(bar); } } SEAM(2);

    if (IN(3)) _Pragma("unroll") for (int rep = 0; rep < REPS(3); ++rep) {
        pg8::DenseOrder S; S.init(ws + WS_OCAT, ws + WS_WCAT, NTOK, 1024, 512, C.G, (int)blockIdx.x);
        pg8::EpiProj E{(const bf16*)(ws + WS_R), (const bf16*)(ws + WS_GB), (unsigned char*)(ws + WS_QH)};
        pg8::gemm_phase<pg8::EpiProj, pg8::DenseOrder, false, true>(ring, 512, S, E); REPSEAM(3);
    } SEAM(3);

    if (IN(4)) _Pragma("unroll") for (int rep = 0; rep < REPS(4); ++rep) {
        pg8::DenseOrder S; S.init(ws + WS_QH, ws + WS_WO, NTOK, 1024, 512, C.G, (int)blockIdx.x);
        pg8::EpiOut E{(const bf16*)(ws + WS_XB), (bf16*)(ws + WS_ZF)};
        pg8::gemm_phase<pg8::EpiOut, pg8::DenseOrder, false, true>(ring, 512, S, E);
        REPSEAM(4);
    } SEAM(4);

    if (IN(5)) { _Pragma("unroll") for (int rep = 0; rep < REPS(5); ++rep) { r1_phase(C, args); REPSEAM(5); } } STAMP(15); SEAM(5);
    if (IN(6)) { _Pragma("unroll") for (int rep = 0; rep < REPS(6); ++rep) { r2_phase(C, args); REPSEAM(6); } } SEAM(6);

    if (IN(7)) _Pragma("unroll") for (int rep = 0; rep < REPS(7); ++rep) {
        const int* tilee = (const int*)(ws + WS_TILEE);
        const int ntl = __builtin_amdgcn_readfirstlane(__hip_atomic_load(tilee + 511, __ATOMIC_RELAXED, __HIP_MEMORY_SCOPE_AGENT));
        pg8::MoeOrder S{(const char*)(ws + WS_R), (const char*)args.out, (const int*)(ws + WS_ROWTOK), tilee, 512, 1024, ntl * 4, C.G, C.vcu, true};
        pg8::EpiM1 E{(unsigned char*)(ws + WS_QH)};
        pg8::gemm_phase<pg8::EpiM1, pg8::MoeOrder, true, true>(ring, 512, S, E); REPSEAM(7);
    } SEAM(7);

    if (IN(8)) _Pragma("unroll") for (int rep = 0; rep < REPS(8); ++rep) {
        const int* tilee = (const int*)(ws + WS_TILEE);
        const int ntl = __builtin_amdgcn_readfirstlane(__hip_atomic_load(tilee + 511, __ATOMIC_RELAXED, __HIP_MEMORY_SCOPE_AGENT));
        pg8::MoeOrder S{(const char*)(ws + WS_QH), (const char*)args.out + 32 * MiB, (const int*)(ws + WS_ROWTOK), tilee, 256, 1024, ntl * 4, C.G, C.vcu, false};
        pg8::EpiM2 E{(unsigned char*)(ws + WS_Y)};
        pg8::gemm_phase<pg8::EpiM2, pg8::MoeOrder, false, true>(ring, 256, S, E); REPSEAM(8);
    } SEAM(8);

    if (IN(9)) { _Pragma("unroll") for (int rep = 0; rep < REPS(9); ++rep) { f_phase(C, args); REPSEAM(9); } }
    STAMP(10);
    if (STAMP_SEL >= 0 && blockIdx.x == STAMP_BLK && C.tid == 0) {
        const unsigned long long t0 = ((unsigned long long)C.MISC[17 + 2 * (STAMP_T0)] << 32) | C.MISC[16 + 2 * (STAMP_T0)], t1 = ((unsigned long long)C.MISC[17 + 2 * (STAMP_T1)] << 32) | C.MISC[16 + 2 * (STAMP_T1)];
        const unsigned long long w0 = __builtin_amdgcn_s_memrealtime(); while (__builtin_amdgcn_s_memrealtime() - w0 < 4ull * (t1 - t0)) __builtin_amdgcn_s_sleep(8); }
#undef IN
#undef SEAM
}

extern "C" void kernel_launch(void* const* d_in, const int* in_sizes, int n_in, void* d_out, int out_size, void* d_ws, size_t ws_size, hipStream_t stream) {
    static int grid = 0;
    if (grid == 0) {
        if (n_in != 19 || in_sizes[0] != NTOK * DM || out_size != NTOK * DM || ws_size < WS_END) { fprintf(stderr, "kernel_launch: unexpected problem shape / workspace; nothing launched\n"); grid = -1; return; }
        int dev = 0, cus = 0, per_cu = 0;
        if (hipGetDevice(&dev) != hipSuccess || hipDeviceGetAttribute(&cus, hipDeviceAttributeMultiprocessorCount, dev) != hipSuccess) { grid = -1; return; }
        if (hipFuncSetAttribute((const void*)mk_fwd, hipFuncAttributeMaxDynamicSharedMemorySize, LDS_BYTES) != hipSuccess) { fprintf(stderr, "kernel_launch: hipFuncSetAttribute failed\n"); grid = -1; return; }
        if (hipOccupancyMaxActiveBlocksPerMultiprocessor(&per_cu, (const void*)mk_fwd, NTHREADS, LDS_BYTES) != hipSuccess || per_cu < 1) { fprintf(stderr, "kernel_launch: occupancy query says %d\n", per_cu); }
        (void)hipGetLastError();
        grid = cus;
    }
    if (grid < 0) return;
    (void)hipMemsetAsync((char*)d_ws + WS_CTL, 0, CTL_ZERO_BYTES, stream);
    Args a{};
    for (int i = 0; i < 19; ++i) a.in[i] = (const float*)d_in[i];
    a.out = (float*)d_out; a.ws = (unsigned char*)d_ws;
    if (MK_N_LAUNCHES == 1) { a.ph_lo = 0; a.ph_hi = NPH; hipLaunchKernelGGL(mk_fwd, dim3(grid), dim3(NTHREADS), LDS_BYTES, stream, a); }
    else for (int p = 0; p < NPH; ++p) { a.ph_lo = p; a.ph_hi = p + 1; hipLaunchKernelGGL(mk_fwd, dim3(grid), dim3(NTHREADS), LDS_BYTES, stream, a); }
}
```

```cpp
#include <hip/hip_runtime.h>
#include <cstdio>
#include <cstdint>
#ifndef MK_N_LAUNCHES
#define MK_N_LAUNCHES 1
#endif
#define DI __device__ __forceinline__
#define GAS __attribute__((address_space(1)))
#define LAS __attribute__((address_space(3)))
typedef unsigned short bf16;
typedef unsigned u32x4 __attribute__((ext_vector_type(4)));
typedef unsigned u32x2 __attribute__((ext_vector_type(2)));
typedef float f32x4 __attribute__((ext_vector_type(4)));
typedef float f32x2 __attribute__((ext_vector_type(2)));
typedef float f32x16 __attribute__((ext_vector_type(16)));
typedef short bf16x8 __attribute__((ext_vector_type(8)));
typedef short s16x4 __attribute__((ext_vector_type(4)));
typedef short v4i16_t __attribute__((ext_vector_type(4)));
typedef __bf16 bf16x2_t __attribute__((ext_vector_type(2)));
typedef GAS unsigned gu32;

constexpr int NTOK = 32768, DM = 1024, SEQ = 2048, NBATCH = 16, NIN = 5632;
constexpr int NWAVES = 8, NTHREADS = 512;
constexpr float LN_EPS = 1e-5f, DN_ALPHA = 1.189207115002721f, LOG2E = 1.4426950408889634f;
constexpr int MOE_MAXTILES = 288;

constexpr size_t MiB = 1u << 20;
constexpr size_t WS_CTL = 0, CTL_ZERO_BYTES = 65536;
constexpr size_t WS_WIN = 1 * MiB, WS_WCAT = 12 * MiB, WS_WO = 14 * MiB;
constexpr size_t WS_XB = 16 * MiB;
constexpr size_t WS_R = 80 * MiB;
constexpr size_t WS_GB = 144 * MiB;
constexpr size_t WS_QH = 208 * MiB;
constexpr size_t WS_VH = 240 * MiB;
constexpr size_t WS_GH = 272 * MiB;
constexpr size_t WS_ZF = 304 * MiB;
constexpr size_t WS_OCAT = 306 * MiB;
constexpr size_t WS_QM = 368 * MiB, WS_KM = 400 * MiB;
constexpr size_t WS_VM = 432 * MiB;
constexpr size_t WS_Y = 16 * MiB;
constexpr size_t WS_MISC = 464 * MiB;
constexpr size_t WS_KMEAN = WS_MISC;
constexpr size_t WS_BPERM = WS_MISC + 1 * MiB;
constexpr size_t WS_WRH = WS_MISC + 2 * MiB;
constexpr size_t WS_WRL = WS_WRH + 98304;
constexpr size_t WS_TOKE = WS_MISC + 3 * MiB;
constexpr size_t WS_TOKW = WS_MISC + 4 * MiB;
constexpr size_t WS_TOKD = WS_MISC + 5 * MiB;
constexpr size_t WS_WGCNT = WS_MISC + 6 * MiB;
constexpr size_t WS_ROWTOK = WS_MISC + 7 * MiB;
constexpr size_t WS_TILEE = WS_MISC + 8 * MiB;
constexpr size_t WS_STATS = WS_MISC + 9 * MiB;
constexpr size_t WS_LB = WS_MISC + 10 * MiB;
constexpr size_t WS_KK = WS_MISC + 12 * MiB;
constexpr size_t WS_END = 512 * MiB;
constexpr int CW_BAR = 4096, CW_QUEUE = 8192, CW_QUEUE2 = 8192 + 1024;

constexpr int LDS_BYTES = 163840, MISC_OFF = LDS_BYTES - 256;

DI unsigned cvtpk(float lo, float hi) { f32x2 v = {lo, hi}; bf16x2_t b = __builtin_convertvector(v, bf16x2_t); return __builtin_bit_cast(unsigned, b); }
DI float bflo(unsigned w) { return __uint_as_float(w << 16); }
DI float bfhi(unsigned w) { return __uint_as_float(w & 0xffff0000u); }
DI float bf2f(unsigned short h) { return __uint_as_float((unsigned)h << 16); }
DI float frcp(float x) { return __builtin_amdgcn_rcpf(x); }
DI float fsigmoid(float x) { return frcp(1.f + __expf(-x)); }
DI float wave_sum(float v) {
#pragma unroll
    for (int o = 1; o < 64; o <<= 1) v += __shfl_xor(v, o);
    return v;
}
typedef int v8i __attribute__((ext_vector_type(8)));
typedef int v4i __attribute__((ext_vector_type(4)));
DI unsigned cvt4_fp8(float a, float b, float c, float d) { a = __builtin_amdgcn_fmed3f(a, -448.f, 448.f); b = __builtin_amdgcn_fmed3f(b, -448.f, 448.f); c = __builtin_amdgcn_fmed3f(c, -448.f, 448.f); d = __builtin_amdgcn_fmed3f(d, -448.f, 448.f);
    int w = 0; w = __builtin_amdgcn_cvt_pk_fp8_f32(a, b, w, false); w = __builtin_amdgcn_cvt_pk_fp8_f32(c, d, w, true); return (unsigned)w; }
DI f32x4 fp8x4_to_f32(unsigned w) { const f32x2 lo = __builtin_amdgcn_cvt_pk_f32_fp8((int)w, false), hi = __builtin_amdgcn_cvt_pk_f32_fp8((int)w, true); return (f32x4){lo[0], lo[1], hi[0], hi[1]}; }
constexpr float FP8_SXI = 8.f, FP8_SX = 8.f, FP8_SW = 32.f, FP8_SH = 4.f, FP8_SO = 4.f, FP8_SU = 32.f, FP8_SY = 64.f;
DI int crow(int r, int hi) { return (r & 3) + 8 * (r >> 2) + 4 * hi; }
#define MFMA32(a, b, c) __builtin_amdgcn_mfma_f32_32x32x16_bf16((a), (b), (c), 0, 0, 0)
#define MFMA16(a, b, c) __builtin_amdgcn_mfma_f32_16x16x32_bf16((a), (b), (c), 0, 0, 0)
DI s16x4 vtr(LAS const char* p) { return __builtin_bit_cast(s16x4, __builtin_amdgcn_ds_read_tr16_b64_v4i16((LAS v4i16_t*)p)); }

#define XB_TMO      128
#define XB_XCNT(j)  (256  + 64 * (j))
#define XB_XSUB(j)  (1280 + 64 * (j))
#define XB_XGEN(j)  (2304 + 64 * (j))
#define XB_TOP      3328
#define XB_TOPGEN   3392
#define XCD_BAR_WORDS 3456
#define XB_SPIN_CAP (1u << 22)
DI unsigned xb_ld(unsigned* p)              { return __hip_atomic_load(p, __ATOMIC_RELAXED, __HIP_MEMORY_SCOPE_AGENT); }
DI unsigned xb_add(unsigned* p, unsigned v) { return __hip_atomic_fetch_add(p, v, __ATOMIC_RELAXED, __HIP_MEMORY_SCOPE_AGENT); }
DI unsigned xb_xcc_id() { return (unsigned)__builtin_amdgcn_s_getreg((3 << 11) | 20) & 0xFu; }
#define XB_SPIN(cond, bar) do { unsigned _sp = 0; while (cond) { __builtin_amdgcn_s_sleep(1); \
    if ((++_sp & 255u) == 0u) { if (xb_ld(&(bar)[XB_TMO])) break; if (_sp > XB_SPIN_CAP) { atomicAdd(&(bar)[XB_TMO], 1u); break; } } } } while (0)
struct XcdBarrier { unsigned* bar; unsigned x; volatile LAS unsigned* st; };
DI XcdBarrier xcd_barrier_post(unsigned* bar, volatile LAS unsigned* st) {
    XcdBarrier b; b.bar = bar; b.x = xb_xcc_id(); b.st = st;
    if (threadIdx.x == 0) (void)xb_add(&bar[XB_XCNT(b.x)], 1u);
    return b;
}
DI void xcd_barrier_complete(unsigned* bar, unsigned x, unsigned& nloc, unsigned& nx) {
    const unsigned G = gridDim.x * gridDim.y * gridDim.z;
    unsigned sum, cnt, mine, sp = 0u;
    for (;;) {
        sum = 0u; cnt = 0u; mine = 0u;
#pragma unroll
        for (unsigned j = 0; j < 16; ++j) { const unsigned c = xb_ld(&bar[XB_XCNT(j)]); sum += c; cnt += (c > 0u) ? 1u : 0u; mine = (j == x) ? c : mine; }
        if (sum == G) break;
        __builtin_amdgcn_s_sleep(1);
        if ((++sp & 255u) == 0u) { if (xb_ld(&bar[XB_TMO])) break; if (sp > XB_SPIN_CAP) { atomicAdd(&bar[XB_TMO], 1u); break; } }
    }
    nloc = mine > 0u ? mine : 1u; nx = cnt > 0u ? cnt : 1u;
}
DI void xcd_barrier(const XcdBarrier& b) {
    asm volatile("s_waitcnt vmcnt(0)" ::: "memory");
    __syncthreads();
    if (threadIdx.x == 0) {
        unsigned* bar = b.bar;
        __builtin_amdgcn_s_waitcnt(0);
        unsigned nloc = b.st[0], nx = b.st[1];
        if (nloc == 0u) { xcd_barrier_complete(bar, b.x, nloc, nx); b.st[0] = nloc; b.st[1] = nx; }
        const unsigned old = xb_add(&bar[XB_XSUB(b.x)], 1u);
        const unsigned gen = old / nloc;
        if (old + 1u == (gen + 1u) * nloc) {
            __builtin_amdgcn_fence(__ATOMIC_RELEASE, "agent");
            asm volatile("s_waitcnt vmcnt(0)" ::: "memory");
            const unsigned og = xb_add(&bar[XB_TOP], 1u);
            const unsigned tg = og / nx;
            if (og + 1u == (tg + 1u) * nx) xb_add(&bar[XB_TOPGEN], 1u);
            else XB_SPIN(xb_ld(&bar[XB_TOPGEN]) == tg, bar);
            __builtin_amdgcn_fence(__ATOMIC_ACQUIRE, "agent");
            xb_add(&bar[XB_XGEN(b.x)], 1u);
            asm volatile("s_waitcnt vmcnt(0)" ::: "memory");
        } else {
            XB_SPIN(xb_ld(&bar[XB_XGEN(b.x)]) == gen, bar);
            __builtin_amdgcn_fence(__ATOMIC_ACQUIRE, "agent");
            asm volatile("s_waitcnt vmcnt(0)" ::: "memory");
        }
    }
    __syncthreads();
}

namespace pg8 {
constexpr int BM = 256, BK = 64, HALF = 128, HTB = HALF * BK * 2, STAGE_BYTES = 8 * HTB, NXCD = 8, WGM = 8;
DI int lds_byte(int r, int c) { const int st = (r >> 4) * 2 + (c >> 5), rr = r & 15, cc = c & 31, ob = rr * 64 + cc * 2; return st * 1024 + (ob ^ (((ob >> 9) & 1) << 5)); }
DI void stage_rc(int b, int& R, int& C) { const int st = b / 1024, sb = b % 1024, swz = sb ^ (((sb >> 9) & 1) << 5); R = (st >> 1) * 16 + swz / 64; C = (st & 1) * 32 + (swz % 64) / 2; }
DI int perm32(int rho) { const int n = rho >> 4, i = rho & 15; return 8 * (i >> 2) + 4 * n + (i & 3); }
struct Unit { int pm, pn, e; };

struct DenseOrder {
    const char* A; const char* Bt; int K, nM, nN, nwg, G, c;
    DI void init(const void* A_, const void* Bt_, int M, int N, int K_, int G_, int c_) { A = (const char*)A_; Bt = (const char*)Bt_; K = K_; nM = M / BM; nN = N / BM; nwg = nM * nN; G = G_; c = c_; }
    DI bool next(int i, Unit& u) const {
        const long L = (long)i * G + c; if (L >= nwg) return false;
        int wgid = (int)L; { const int q = nwg / NXCD, r = nwg % NXCD, xcd = wgid % NXCD, off = wgid / NXCD; wgid = (xcd < r ? xcd * (q + 1) : r * (q + 1) + (xcd - r) * q) + off; }
        const int nig = WGM * nN, gid = wgid / nig, fm = gid * WGM, gsz = (nM - fm) < WGM ? (nM - fm) : WGM;
        u.pm = fm + ((wgid % nig) % gsz); u.pn = (wgid % nig) / gsz; u.e = 0; return true;
    }
    DI const char* a_base(const Unit& u) const { return A + (size_t)u.pm * 512 * K; }
    DI const char* b_base(const Unit& u) const { return Bt + (size_t)u.pn * 512 * K; }
    DI void gather(const Unit&, const int (&)[2], const int (&)[2], unsigned (&)[2][2]) const {}
};
struct MoeOrder {
    const char* A; const char* Bt; const int* row_tok; const int* tile_e; int K, N, nunits, G, c; bool gat;
    DI bool next(int i, Unit& u) const {
        const int L = i * G + c; if (L >= nunits) return false;
        u.pm = L >> 2; u.pn = L & 3;
        u.e = __builtin_amdgcn_readfirstlane(__hip_atomic_load(tile_e + u.pm, __ATOMIC_RELAXED, __HIP_MEMORY_SCOPE_AGENT)); return true;
    }
    DI const char* a_base(const Unit& u) const { return gat ? A : A + (size_t)u.pm * 512 * K; }
    DI const char* b_base(const Unit& u) const { return Bt + ((size_t)u.e * N + (size_t)u.pn * 256) * K * 2; }
    DI void gather(const Unit& u, const int (&Rr)[2], const int (&Cc)[2], unsigned (&o)[2][2]) const {
#pragma unroll
        for (int h = 0; h < 2; ++h)
#pragma unroll
            for (int i = 0; i < 2; ++i) { const int tok = row_tok[u.pm * 256 + h * 128 + Rr[i]]; o[h][i] = (unsigned)(tok * K + Cc[i]) * 2u; }
    }
};

template <class Epi, class Sched, bool GATHER, bool FP8 = false>
DI void gemm_phase(LAS unsigned char* lds, const int K, const Sched& S, const Epi& E) {
    const int tid = threadIdx.x, wid = __builtin_amdgcn_readfirstlane(tid >> 6), lane = tid & 63, wr = wid >> 2, wc = wid & 3, fr = lane & 15, fq = lane >> 4;
    const int nt = K / BK;
    unsigned voffB[2], vA[2][2], nvA[2][2]; int Rr[2], Cc[2];
#pragma unroll
    for (int i = 0; i < 2; ++i) { int R, C; stage_rc(tid * 16 + i * 8192, R, C); Rr[i] = R; Cc[i] = C; const int Rb = (R & ~31) + perm32(R & 31);
        voffB[i] = (unsigned)(Rb * K + C) * 2u; vA[0][i] = (unsigned)(R * K + C) * 2u; vA[1][i] = (unsigned)((R + HALF) * K + C) * 2u; nvA[0][i] = vA[0][i]; nvA[1][i] = vA[1][i]; }
    const size_t kstep = (size_t)(BK * 2);
    const size_t hstep = (size_t)HALF * K * 2;
    const unsigned ldsw = (unsigned)wid * 1024u;
    const int aoff = lds_byte(wr * 64 + fr, fq * 8), boff = lds_byte(wc * 32 + fr, fq * 8);
#define PG8_SA(b, h) (((b) * 2 + (h)) * HTB)
#define PG8_SB(b, h) ((4 + (b) * 2 + (h)) * HTB)
#define PG8_STAGE(bufoff, gbase, voff) do { _Pragma("unroll") for (int _i = 0; _i < 2; ++_i) \
        __builtin_amdgcn_global_load_lds((const unsigned*)((const char*)(gbase) + (voff)[_i]), (LAS unsigned*)(lds + (bufoff) + ldsw + _i * 8192), 16, 0, 0); } while (0)
#define PG8_LDA(dst, b, h) do { if constexpr (FP8) { _Pragma("unroll") for (int m = 0; m < 4; ++m) dst##8[m] = __builtin_shufflevector(*(const LAS v4i*)(lds + PG8_SA(b, h) + aoff + m * 2048), *(const LAS v4i*)(lds + PG8_SA(b, h) + aoff + m * 2048 + 1024), 0, 1, 2, 3, 4, 5, 6, 7); } \
        else { _Pragma("unroll") for (int m = 0; m < 4; ++m) _Pragma("unroll") for (int k = 0; k < 2; ++k) dst[m][k] = *(const LAS bf16x8*)(lds + PG8_SA(b, h) + aoff + m * 2048 + k * 1024); } } while (0)
#define PG8_LDB(dst, b, h) do { if constexpr (FP8) { _Pragma("unroll") for (int n = 0; n < 2; ++n) dst##8[n] = __builtin_shufflevector(*(const LAS v4i*)(lds + PG8_SB(b, h) + boff + n * 2048), *(const LAS v4i*)(lds + PG8_SB(b, h) + boff + n * 2048 + 1024), 0, 1, 2, 3, 4, 5, 6, 7); } \
        else { _Pragma("unroll") for (int n = 0; n < 2; ++n) _Pragma("unroll") for (int k = 0; k < 2; ++k) dst[n][k] = *(const LAS bf16x8*)(lds + PG8_SB(b, h) + boff + n * 2048 + k * 1024); } } while (0)
#define PG8_CAT(x, y) __builtin_shufflevector(__builtin_bit_cast(v4i, (x)), __builtin_bit_cast(v4i, (y)), 0, 1, 2, 3, 4, 5, 6, 7)
#define PG8_MMA(ai, bj, At, Bt) do { __builtin_amdgcn_s_setprio(1); if constexpr (FP8) { _Pragma("unroll") for (int m = 0; m < 4; ++m) _Pragma("unroll") for (int n = 0; n < 2; ++n) \
        asm volatile("v_mfma_scale_f32_16x16x128_f8f6f4 %0, %1, %2, %0, %3, %3 op_sel_hi:[0,0,0]" : "+v"(acc[ai][bj][m][n]) : "v"(Bt##8[n]), "v"(At##8[m]), "v"(fp8_unit_scale)); } else { \
        _Pragma("unroll") for (int m = 0; m < 4; ++m) _Pragma("unroll") for (int n = 0; n < 2; ++n) _Pragma("unroll") for (int k = 0; k < 2; ++k) \
        acc[ai][bj][m][n] = __builtin_amdgcn_mfma_f32_16x16x32_bf16(Bt[n][k], At[m][k], acc[ai][bj][m][n], 0, 0, 0); } __builtin_amdgcn_s_setprio(0); } while (0)
#define PG8_WAIT_V(n) asm volatile("s_waitcnt vmcnt(" #n ")" ::: "memory")
#define PG8_WAIT_L(n) asm volatile("s_waitcnt lgkmcnt(" #n ")" ::: "memory")
#define PG8_BAR __builtin_amdgcn_s_barrier()
#define PG8_SCHED __builtin_amdgcn_sched_barrier(0)
    Unit cur, nxt; int ui = 0;
    if (!S.next(0, cur)) return;
    if constexpr (GATHER) S.gather(cur, Rr, Cc, vA);
    f32x4 acc[2][2][4][2];
#pragma unroll
    for (int a = 0; a < 2; ++a)
#pragma unroll
        for (int b = 0; b < 2; ++b)
#pragma unroll
            for (int m = 0; m < 4; ++m)
#pragma unroll
                for (int n = 0; n < 2; ++n) acc[a][b][m][n] = (f32x4){0.f, 0.f, 0.f, 0.f};
    bf16x8 At[4][2], B0[2][2], B1[2][2]; v8i At8[4], B08[2], B18[2]; const int fp8_unit_scale = 0x7f7f7f7f;
    const char* cA = S.a_base(cur); const char* cB = S.b_base(cur);
    PG8_STAGE(PG8_SB(0, 0), cB, voffB); PG8_STAGE(PG8_SB(0, 1), cB + hstep, voffB); PG8_STAGE(PG8_SA(0, 0), cA, vA[0]); PG8_STAGE(PG8_SA(0, 1), cA, vA[1]);
    if (wr == 1) PG8_BAR;
    PG8_WAIT_V(2); PG8_BAR;
    PG8_STAGE(PG8_SB(1, 0), cB + kstep, voffB); PG8_STAGE(PG8_SA(1, 0), cA + kstep, vA[0]); PG8_STAGE(PG8_SB(1, 1), cB + hstep + kstep, voffB);
    PG8_WAIT_V(6); PG8_BAR;
    for (;;) {
        const bool has_next = S.next(ui + 1, nxt);
        const char* nA = has_next ? S.a_base(nxt) : cA; const char* nB = has_next ? S.b_base(nxt) : cB;
        if constexpr (GATHER) {
            if (has_next) S.gather(nxt, Rr, Cc, nvA);
            else {
#pragma unroll
                for (int h = 0; h < 2; ++h) { nvA[h][0] = vA[h][0]; nvA[h][1] = vA[h][1]; } }
        }
#pragma unroll 1
        for (int t = 0; t < nt; t += 2) {
            const bool last = (t == nt - 2);
            if constexpr (Epi::HAS_MID) { if (t == (nt >> 1)) { if constexpr (FP8) asm volatile("s_nop 15\n\ts_nop 15" ::: "memory"); E.mid(acc, cur, wr, wc, fr, fq); if constexpr (FP8) asm volatile("s_nop 7" ::: "memory"); } }
            const char* a1 = cA + (size_t)(t + 1) * kstep;
            const char* a2 = last ? nA : cA + (size_t)(t + 2) * kstep; const char* b2 = last ? nB : cB + (size_t)(t + 2) * kstep;
            const char* a3 = a2 + kstep; const char* b3 = b2 + kstep;
            unsigned o0[2], o1[2];
            if constexpr (GATHER) { o0[0] = last ? nvA[0][0] : vA[0][0]; o0[1] = last ? nvA[0][1] : vA[0][1]; o1[0] = last ? nvA[1][0] : vA[1][0]; o1[1] = last ? nvA[1][1] : vA[1][1]; }
            else { o0[0] = vA[0][0]; o0[1] = vA[0][1]; o1[0] = vA[1][0]; o1[1] = vA[1][1]; }
            PG8_LDB(B0, 0, 0); PG8_LDB(B1, 0, 1); PG8_SCHED; PG8_LDA(At, 0, 0); PG8_STAGE(PG8_SA(1, 1), a1, vA[1]);
            PG8_WAIT_V(8); PG8_WAIT_L(0); PG8_BAR; PG8_MMA(0, 0, At, B0); PG8_MMA(0, 1, At, B1); PG8_BAR; PG8_SCHED;
            PG8_LDA(At, 0, 1); PG8_STAGE(PG8_SB(0, 0), b2, voffB); PG8_STAGE(PG8_SB(0, 1), b2 + hstep, voffB); PG8_STAGE(PG8_SA(0, 0), a2, o0);
            PG8_WAIT_V(8); PG8_WAIT_L(0); PG8_BAR; PG8_MMA(1, 0, At, B0); PG8_MMA(1, 1, At, B1); PG8_BAR; PG8_SCHED;
            PG8_LDB(B0, 1, 0); PG8_LDB(B1, 1, 1); PG8_SCHED; PG8_LDA(At, 1, 0); PG8_STAGE(PG8_SA(0, 1), a2, o1);
            PG8_WAIT_V(8); PG8_WAIT_L(0); PG8_BAR; PG8_MMA(0, 0, At, B0); PG8_MMA(0, 1, At, B1); PG8_BAR; PG8_SCHED;
            PG8_LDA(At, 1, 1); PG8_STAGE(PG8_SB(1, 0), b3, voffB); PG8_STAGE(PG8_SB(1, 1), b3 + hstep, voffB); PG8_STAGE(PG8_SA(1, 0), a3, o0);
            PG8_WAIT_V(8); PG8_WAIT_L(0); PG8_BAR; PG8_MMA(1, 0, At, B0); PG8_MMA(1, 1, At, B1); PG8_BAR; PG8_SCHED;
        }
        if (wr == 0) PG8_BAR;
        if constexpr (FP8) asm volatile("s_nop 15\n\ts_nop 15" ::: "memory");
        E(acc, cur, wr, wc, fr, fq);
        if (!has_next) break;
#pragma unroll
        for (int a = 0; a < 2; ++a)
#pragma unroll
            for (int b = 0; b < 2; ++b)
#pragma unroll
                for (int m = 0; m < 4; ++m)
#pragma unroll
                    for (int n = 0; n < 2; ++n) acc[a][b][m][n] = (f32x4){0.f, 0.f, 0.f, 0.f};
        cur = nxt; cA = nA; cB = nB; ++ui;
        if constexpr (GATHER) {
#pragma unroll
            for (int h = 0; h < 2; ++h) { vA[h][0] = nvA[h][0]; vA[h][1] = nvA[h][1]; } }
        if (wr == 1) PG8_BAR;
    }
    PG8_WAIT_V(0);
    PG8_BAR;
#undef PG8_SA
#undef PG8_SB
#undef PG8_STAGE
#undef PG8_LDA
#undef PG8_LDB
#undef PG8_MMA
#undef PG8_CAT
#undef PG8_WAIT_V
#undef PG8_WAIT_L
#undef PG8_BAR
#undef PG8_SCHED
}

typedef f32x4 Acc[2][2][4][2];
DI u32x4 pack8(const f32x4 a, const f32x4 b) { u32x4 w; w.x = cvtpk(a[0], a[1]); w.y = cvtpk(a[2], a[3]); w.z = cvtpk(b[0], b[1]); w.w = cvtpk(b[2], b[3]); return w; }
DI f32x4 silu4(const f32x4 v) { f32x4 o; o[0] = v[0] * fsigmoid(v[0]); o[1] = v[1] * fsigmoid(v[1]); o[2] = v[2] * fsigmoid(v[2]); o[3] = v[3] * fsigmoid(v[3]); return o; }

struct EpiIn {
    static constexpr bool HAS_MID = false;
    bf16 *Qh, *Vh, *Gh, *Qm, *Km, *Vm, *Rr, *Gb; float *Zf, *KM; const float* bias; bf16* KK; const float* LB; int pn_off;
    DI void operator()(Acc& acc, const Unit& u, int wr, int wc, int fr, int fq) const {
        const int pn = u.pn + pn_off, row0 = u.pm * BM + wr * 64 + fr, cl = wc * 32 + 8 * fq;
        if (pn_off) {
#pragma unroll
            for (int ai = 0; ai < 2; ++ai)
#pragma unroll
                for (int bj = 0; bj < 2; ++bj)
#pragma unroll
                    for (int m = 0; m < 4; ++m) { acc[ai][bj][m][0] *= (1.f / (FP8_SXI * FP8_SW)); acc[ai][bj][m][1] *= (1.f / (FP8_SXI * FP8_SW)); } }
        f32x4 bv[2][2];
#pragma unroll
        for (int bj = 0; bj < 2; ++bj)
#pragma unroll
            for (int n = 0; n < 2; ++n) bv[bj][n] = *(const f32x4*)(bias + pn * 256 + bj * HALF + cl + 4 * n);
        if (pn < 4) {
#define EI_DPP(v, ctrl) __int_as_float(__builtin_amdgcn_update_dpp(0, __float_as_int(v), ctrl, 0xf, 0xf, true))
            const int chb = pn * 128 + cl;
#pragma unroll
            for (int ai = 0; ai < 2; ++ai)
#pragma unroll
                for (int n = 0; n < 2; ++n) { const f32x4 lbv = *(const f32x4*)(LB + chb + 4 * n); f32x4 run = (f32x4){0.f, 0.f, 0.f, 0.f}, bmid = run; f32x4 bbv[4], kkv[4];
#pragma unroll
                    for (int m = 0; m < 4; ++m) {
#pragma unroll
                        for (int j = 0; j < 4; ++j) { const float z = acc[ai][1][m][n][j] + bv[1][n][j]; const float sg = frcp(1.f + __expf(-z)); const float lf = __logf(lbv[j] + (1.f - lbv[j]) * sg); kkv[m][j] = (1.f - lbv[j]) * (1.f - sg);
                            float t = lf; t += EI_DPP(t, 0xB1); t += EI_DPP(t, 0x4E); t += EI_DPP(t, 0x141); t += EI_DPP(t, 0x140);
                            float s = lf; s += EI_DPP(s, 0x111); s += EI_DPP(s, 0x112); s += EI_DPP(s, 0x114); s += EI_DPP(s, 0x118);
                            bbv[m][j] = s + run[j]; run[j] += t; }
                        if (m == 1) bmid = run; }
#pragma unroll
                    for (int m = 0; m < 4; ++m) { f32x4 qp, kp;
#pragma unroll
                        for (int j = 0; j < 4; ++j) { const float qx = acc[ai][0][m][n][j] + bv[0][n][j]; const float e = __expf(__builtin_amdgcn_fmed3f(bbv[m][j] - bmid[j], -60.f, 60.f)); qp[j] = qx * fsigmoid(qx) * e; kp[j] = kkv[m][j] * frcp(e); }
                        const size_t ro = (size_t)(row0 + ai * HALF + m * 16) * 512 + chb + 4 * n;
                        u32x2 qw, kw; qw.x = cvtpk(qp[0], qp[1]); qw.y = cvtpk(qp[2], qp[3]); kw.x = cvtpk(kp[0], kp[1]); kw.y = cvtpk(kp[2], kp[3]);
                        *(u32x2*)(Qh + ro) = qw; *(u32x2*)(KK + ro) = kw; }
                    if (fr == 0) { const size_t so = (size_t)(u.pm * 4 + ai * 2 + wr) * 512 + chb + 4 * n; *(f32x4*)(Zf + so) = bmid; *(f32x4*)(Zf + 262144 + so) = run; }
                    asm volatile("" ::: "memory"); }
#undef EI_DPP
        } else if (pn < 14) {
            const int seg = pn >> 1, c0 = (pn & 1) * 256 + cl;
            {
                bf16* O = seg == 2 ? Vh : seg == 3 ? Gh : seg == 4 ? Qm : seg == 5 ? Km : Vm;
                const int act = (seg == 3) ? 1 : (seg == 4 ? 2 : 0);
                if (seg == 5) {
#pragma unroll
                    for (int bj = 0; bj < 2; ++bj)
#pragma unroll
                        for (int n = 0; n < 2; ++n) { f32x4 cs = (f32x4){0.f, 0.f, 0.f, 0.f};
#pragma unroll
                            for (int ai = 0; ai < 2; ++ai)
#pragma unroll
                                for (int m = 0; m < 4; ++m) cs += acc[ai][bj][m][n] + bv[bj][n];
#pragma unroll
                            for (int j = 0; j < 4; ++j) { float s = cs[j]; s += __shfl_xor(s, 1); s += __shfl_xor(s, 2); s += __shfl_xor(s, 4); s += __shfl_xor(s, 8); cs[j] = s; }
                            if (fr == 0) *(f32x4*)(KM + (size_t)(u.pm * 2 + wr) * 512 + c0 + bj * HALF + 4 * n) = cs; }
                }
#pragma unroll
                for (int ai = 0; ai < 2; ++ai)
#pragma unroll
                    for (int m = 0; m < 4; ++m) { const int row = row0 + ai * HALF + m * 16;
                        bf16* rp = (seg >= 4) ? O + ((size_t)(row >> 11) * 8 * SEQ + (row & (SEQ - 1))) * 64 + (size_t)(c0 >> 6) * SEQ * 64 + (c0 & 63) : O + (size_t)row * 512 + c0;
                        const size_t bjs = (seg >= 4) ? (size_t)2 * SEQ * 64 : (size_t)HALF;
#pragma unroll
                        for (int bj = 0; bj < 2; ++bj) { f32x4 v0 = acc[ai][bj][m][0] + bv[bj][0], v1 = acc[ai][bj][m][1] + bv[bj][1];
                            if (act == 1) { v0 = silu4(v0); v1 = silu4(v1); } else if (act == 2) { v0 = v0 * (0.125f * LOG2E); v1 = v1 * (0.125f * LOG2E); }
                            *(u32x4*)(rp + bj * bjs) = pack8(v0, v1); }
                        asm volatile("" ::: "memory"); }
            }
        } else {
            const int c0 = (pn - 14) * 128 + cl;
#pragma unroll
            for (int ai = 0; ai < 2; ++ai)
#pragma unroll
                for (int m = 0; m < 4; ++m) { const size_t off = (size_t)(row0 + ai * HALF + m * 16) * 1024 + c0; f32x4 r[2], g[2];
#pragma unroll
                    for (int n = 0; n < 2; ++n) { const f32x4 a = acc[ai][0][m][n] + bv[0][n], b = acc[ai][1][m][n] + bv[1][n];
#pragma unroll
                        for (int j = 0; j < 4; ++j) { const float ea = __expf(-a[j]), eb = __expf(-b[j]); g[n][j] = frcp(1.f + eb); r[n][j] = (1.f + eb) * frcp(1.f + ea); } }
                    *(u32x4*)(Rr + off) = pack8(r[0], r[1]); *(u32x4*)(Gb + off) = pack8(g[0], g[1]); asm volatile("" ::: "memory"); }
        }
    }
};
struct EpiProj {
    static constexpr bool HAS_MID = true;
    const bf16 *Rr, *Gb; unsigned char* U;
    DI void scale(Acc& acc, const bf16* G, const Unit& u, int wr, int wc, int fr, int fq) const {
        int row0 = u.pm * BM + wr * 64 + fr, col0 = u.pn * BM + wc * 32 + 8 * fq;
        asm volatile("" : "+v"(row0), "+v"(col0));
#pragma unroll
        for (int ai = 0; ai < 2; ++ai)
#pragma unroll
            for (int mp = 0; mp < 2; ++mp) { u32x4 rv[2][2];
#pragma unroll
            for (int m = 0; m < 2; ++m)
#pragma unroll
                for (int bj = 0; bj < 2; ++bj) rv[m][bj] = *(const u32x4*)(G + (size_t)(row0 + ai * HALF + (2 * mp + m) * 16) * 1024 + col0 + bj * HALF);
#pragma unroll
            for (int m = 0; m < 2; ++m)
#pragma unroll
                for (int bj = 0; bj < 2; ++bj) { const u32x4 w = rv[m][bj];
                    acc[ai][bj][2 * mp + m][0] *= (f32x4){bflo(w.x), bfhi(w.x), bflo(w.y), bfhi(w.y)}; acc[ai][bj][2 * mp + m][1] *= (f32x4){bflo(w.z), bfhi(w.z), bflo(w.w), bfhi(w.w)}; }
            asm volatile("" ::: "memory"); }
    }
    DI void mid(Acc& acc, const Unit& u, int wr, int wc, int fr, int fq) const { scale(acc, Rr, u, wr, wc, fr, fq); }
    DI void operator()(Acc& acc, const Unit& u, int wr, int wc, int fr, int fq) const {
        scale(acc, Gb, u, wr, wc, fr, fq);
        const int row0 = u.pm * BM + wr * 64 + fr, col0 = u.pn * BM + wc * 32 + 8 * fq;
        constexpr float inv = FP8_SU / (FP8_SO * FP8_SW);
#pragma unroll
        for (int ai = 0; ai < 2; ++ai)
#pragma unroll
            for (int m = 0; m < 4; ++m) { unsigned char* rp = U + (size_t)(row0 + ai * HALF + m * 16) * 1024 + col0;
#pragma unroll
                for (int bj = 0; bj < 2; ++bj) { const f32x4 v0 = acc[ai][bj][m][0] * inv, v1 = acc[ai][bj][m][1] * inv; u32x2 w; w.x = cvt4_fp8(v0[0], v0[1], v0[2], v0[3]); w.y = cvt4_fp8(v1[0], v1[1], v1[2], v1[3]); *(u32x2*)(rp + bj * HALF) = w; } }
    }
};
struct EpiOut {
    static constexpr bool HAS_MID = false;
    const bf16* X; bf16* Pre;
    DI void operator()(Acc& acc, const Unit& u, int wr, int wc, int fr, int fq) const {
        int row0 = u.pm * BM + wr * 64 + fr, col0 = u.pn * BM + wc * 32 + 8 * fq;
        asm volatile("" : "+v"(row0), "+v"(col0));
        constexpr float inv = 1.f / (FP8_SU * FP8_SW);
#pragma unroll
        for (int ai = 0; ai < 2; ++ai) { u32x4 xv[4][2];
#pragma unroll
            for (int m = 0; m < 4; ++m)
#pragma unroll
                for (int bj = 0; bj < 2; ++bj) xv[m][bj] = *(const u32x4*)(X + (size_t)(row0 + ai * HALF + m * 16) * 1024 + col0 + bj * HALF);
#pragma unroll
            for (int m = 0; m < 4; ++m)
#pragma unroll
                for (int bj = 0; bj < 2; ++bj) { const u32x4 w = xv[m][bj];
                    const f32x4 v0 = (f32x4){bflo(w.x), bfhi(w.x), bflo(w.y), bfhi(w.y)} * DN_ALPHA + acc[ai][bj][m][0] * inv, v1 = (f32x4){bflo(w.z), bfhi(w.z), bflo(w.w), bfhi(w.w)} * DN_ALPHA + acc[ai][bj][m][1] * inv;
                    *(u32x4*)(Pre + (size_t)(row0 + ai * HALF + m * 16) * 1024 + col0 + bj * HALF) = pack8(v0, v1); }
            asm volatile("" ::: "memory"); }
    }
};
struct EpiM1 {
    static constexpr bool HAS_MID = false;
    unsigned char* H;
    DI void operator()(Acc& acc, const Unit& u, int wr, int wc, int fr, int fq) const {
        const int row0 = u.pm * BM + wr * 64 + fr, col0 = u.pn * 128 + wc * 32 + 8 * fq;
        constexpr float inv = 1.f / (FP8_SX * FP8_SW);
#pragma unroll
        for (int ai = 0; ai < 2; ++ai)
#pragma unroll
            for (int m = 0; m < 4; ++m) { const f32x4 h0 = silu4(acc[ai][0][m][0] * inv) * (acc[ai][1][m][0] * (inv * FP8_SH)), h1 = silu4(acc[ai][0][m][1] * inv) * (acc[ai][1][m][1] * (inv * FP8_SH));
                u32x2 w; w.x = cvt4_fp8(h0[0], h0[1], h0[2], h0[3]); w.y = cvt4_fp8(h1[0], h1[1], h1[2], h1[3]);
                *(u32x2*)(H + (size_t)(row0 + ai * HALF + m * 16) * 512 + col0) = w; }
    }
};
struct EpiM2 {
    static constexpr bool HAS_MID = false;
    unsigned char* Y;
    DI void operator()(Acc& acc, const Unit& u, int wr, int wc, int fr, int fq) const {
        const int row0 = u.pm * BM + wr * 64 + fr, col0 = u.pn * BM + wc * 32 + 8 * fq;
        constexpr float inv = FP8_SY / (FP8_SH * FP8_SW);
#pragma unroll
        for (int ai = 0; ai < 2; ++ai)
#pragma unroll
            for (int m = 0; m < 4; ++m) { unsigned char* rp = Y + (size_t)(row0 + ai * HALF + m * 16) * 1024 + col0;
#pragma unroll
                for (int bj = 0; bj < 2; ++bj) { const f32x4 v0 = acc[ai][bj][m][0] * inv, v1 = acc[ai][bj][m][1] * inv; u32x2 w; w.x = cvt4_fp8(v0[0], v0[1], v0[2], v0[3]); w.y = cvt4_fp8(v1[0], v1[1], v1[2], v1[3]); *(u32x2*)(rp + bj * HALF) = w; } }
    }
};
}

struct Args { const float* in[19]; float* out; unsigned char* ws; int ph_lo, ph_hi; };
enum { I_X = 0, I_WIN, I_BIN, I_LBL, I_HGNG, I_RELB, I_WPA, I_WPB, I_WOUT, I_LN1G, I_LN1B, I_WGRP, I_BGRP, I_WEXP, I_BEXP, I_WGU, I_WDN, I_LN2G, I_LN2B };

struct Ctx {
    LAS unsigned char* lds; volatile LAS unsigned* MISC;
    int tid, lane, wid, G, vcu;
    unsigned char* ws; gu32* ctl;
};

DI int win_drow(int n0) { if (n0 < 512) return 256 * (n0 >> 7) + (n0 & 127); if (n0 < 1024) { const int r = n0 - 512; return 256 * (r >> 7) + 128 + (r & 127); }
    if (n0 < 3584) return n0; if (n0 < 4608) { const int r = n0 - 3584; return 3584 + 256 * (r >> 7) + (r & 127); } const int r = n0 - 4608; return 3584 + 256 * (r >> 7) + 128 + (r & 127); }
DI int wgu_drow(int n0) { if (n0 < 512) return 256 * (n0 >> 7) + (n0 & 127); const int r = n0 - 512; return 256 * (r >> 7) + 128 + (r & 127); }
DI int hswz(int row, int ch16) { return 256 * row + 16 * (ch16 ^ (((row & 3) << 2) | ((row >> 2) & 3))); }
DI int htr(int r0, int c0, int lane) { const int i16 = lane & 15, q = i16 >> 2, p = i16 & 3; return hswz(r0 + q, c0 + (p >> 1)) + 8 * (p & 1); }
DI void transpose_tile256(const float* W, int N, bf16* WT, int ldk, int n0, int mode, int dk, LAS unsigned char* lds, int lane, int wid, bool f8 = false) {
    asm volatile("" : "+v"(lane));
#pragma unroll
    for (int half = 0; half < 2; ++half) { f32x4 v[16];
#pragma unroll
        for (int i = 0; i < 16; ++i) v[i] = *(const f32x4*)(W + (size_t)(128 * half + 8 * i + wid) * N + 4 * lane);
#pragma unroll
        for (int i = 0; i < 16; ++i) { const int k = 128 * half + 8 * i + wid; u32x2 w; w.x = cvtpk(v[i][0], v[i][1]); w.y = cvtpk(v[i][2], v[i][3]);
            *(LAS u32x2*)(lds + (lane >> 5) * 65536 + hswz(k, (lane & 31) >> 1) + 8 * (lane & 1)) = w; } }
    __syncthreads();
    const int g = lane >> 4, i16 = lane & 15;
#pragma unroll
    for (int nb = 0; nb < 2; ++nb) { const int nl = 32 * wid + 16 * nb + i16, n = n0 + nl; const int dr = (mode == 0) ? n : (mode == 1 ? win_drow(n) : wgu_drow(n));
        bf16* orow = WT + (size_t)dr * ldk + dk + 8 * g; const LAS unsigned char* img = lds + (wid >> 2) * 65536;
#pragma unroll
        for (int s = 0; s < 8; ++s) { const int r0 = 32 * s + 8 * g, c0 = 4 * (wid & 3) + 2 * nb;
            const s16x4 lo = vtr((LAS const char*)(img + htr(r0, c0, lane))), hh = vtr((LAS const char*)(img + htr(r0 + 4, c0, lane)));
            if (f8) { u32x2 w; w.x = cvt4_fp8(bf2f((unsigned short)lo[0]) * FP8_SW, bf2f((unsigned short)lo[1]) * FP8_SW, bf2f((unsigned short)lo[2]) * FP8_SW, bf2f((unsigned short)lo[3]) * FP8_SW);
                w.y = cvt4_fp8(bf2f((unsigned short)hh[0]) * FP8_SW, bf2f((unsigned short)hh[1]) * FP8_SW, bf2f((unsigned short)hh[2]) * FP8_SW, bf2f((unsigned short)hh[3]) * FP8_SW);
                *(u32x2*)((unsigned char*)WT + (size_t)dr * ldk + dk + 8 * g + 32 * s) = w; }
            else *(bf16x8*)(orow + 32 * s) = (bf16x8){lo[0], lo[1], lo[2], lo[3], hh[0], hh[1], hh[2], hh[3]}; } }
    __syncthreads();
}
constexpr int MOE_CVT_TILES = 32 * 16 + 32 * 8;
DI void moe_cvt_tile(const Ctx& C, const Args& a, int it) {
    unsigned char* WguT = (unsigned char*)a.out; unsigned char* WdT = (unsigned char*)a.out + 32 * MiB;
    if (it < 512) { const int e = it >> 4, kt = (it >> 2) & 3, nt = it & 3;
        transpose_tile256(a.in[I_WGU] + (size_t)e * 1024 * 1024 + (size_t)(256 * kt) * 1024 + 256 * nt, 1024, (bf16*)(WguT + (size_t)e * 1024 * 1024), 1024, 256 * nt, 2, 256 * kt, C.lds, C.lane, C.wid, true); }
    else { const int r = it - 512, e = r >> 3, kt = (r >> 2) & 1, nt = r & 3;
        transpose_tile256(a.in[I_WDN] + (size_t)e * 512 * 1024 + (size_t)(256 * kt) * 1024 + 256 * nt, 1024, (bf16*)(WdT + (size_t)e * 1024 * 512), 512, 256 * nt, 0, 256 * kt, C.lds, C.lane, C.wid, true); }
}
DI void p0_prologue(const Ctx& C, const Args& a) {
    bf16* WinT = (bf16*)(C.ws + WS_WIN); bf16* Wcat = (bf16*)(C.ws + WS_WCAT); bf16* WoT = (bf16*)(C.ws + WS_WO);
    constexpr int I_IN = 4 * 22, I_PA = 2 * 4, I_O = 4 * 4, NITEMS = I_IN + 2 * I_PA + I_O;
    for (int it = C.vcu; it < NITEMS; it += C.G) {
        int r = it;
        if (r < I_IN) { const int kt = r / 22, nt = r % 22;
            if (nt < 4) transpose_tile256(a.in[I_WIN] + (size_t)(256 * kt) * NIN + 256 * nt, NIN, WinT, 1024, 256 * nt, 1, 256 * kt, C.lds, C.lane, C.wid);
            else transpose_tile256(a.in[I_WIN] + (size_t)(256 * kt) * NIN + 256 * nt, NIN, (bf16*)(C.ws + WS_WIN + 2 * MiB - (size_t)1024 * 1024), 1024, 256 * nt, 1, 256 * kt, C.lds, C.lane, C.wid, true);
            continue; } r -= I_IN;
        if (r < I_PA) { const int kt = r / 4, nt = r % 4; transpose_tile256(a.in[I_WPA] + (size_t)(256 * kt) * 1024 + 256 * nt, 1024, Wcat, 1024, 256 * nt, 0, 256 * kt, C.lds, C.lane, C.wid, true); continue; } r -= I_PA;
        if (r < I_PA) { const int kt = r / 4, nt = r % 4; transpose_tile256(a.in[I_WPB] + (size_t)(256 * kt) * 1024 + 256 * nt, 1024, Wcat, 1024, 256 * nt, 0, 512 + 256 * kt, C.lds, C.lane, C.wid, true); continue; } r -= I_PA;
        { const int kt = r / 4, nt = r % 4; transpose_tile256(a.in[I_WOUT] + (size_t)(256 * kt) * 1024 + 256 * nt, 1024, WoT, 1024, 256 * nt, 0, 256 * kt, C.lds, C.lane, C.wid, true); }
    }
    const int gw = C.vcu * NWAVES + C.wid, NGW = C.G * NWAVES; (void)gw; (void)NGW;
    const int gt = C.vcu * NTHREADS + C.tid, NT = C.G * NTHREADS;
    { const float* x = a.in[I_X]; bf16* Xb = (bf16*)(C.ws + WS_XB);
      unsigned char* Xq = (unsigned char*)a.out + 64 * MiB;
      for (int i = gt; i < NTOK * DM / 8; i += NT) { const f32x4 v0 = *(const f32x4*)(x + (size_t)i * 8), v1 = *(const f32x4*)(x + (size_t)i * 8 + 4); *(u32x4*)(Xb + (size_t)i * 8) = pg8::pack8(v0, v1);
          u32x2 q; q.x = cvt4_fp8(v0[0] * FP8_SXI, v0[1] * FP8_SXI, v0[2] * FP8_SXI, v0[3] * FP8_SXI); q.y = cvt4_fp8(v1[0] * FP8_SXI, v1[1] * FP8_SXI, v1[2] * FP8_SXI, v1[3] * FP8_SXI); *(u32x2*)(Xq + (size_t)i * 8) = q; } }
    { float* lbp = (float*)(C.ws + WS_LB); for (int n = gt; n < 512; n += NT) lbp[n] = 1.f / (1.f + expf(a.in[I_LBL][512 + n] - a.in[I_LBL][n])); }
    { float* bp = (float*)(C.ws + WS_BPERM); const float* bin = a.in[I_BIN];
      for (int n = gt; n < NIN; n += NT) bp[win_drow(n & ~31) + (n & 31)] = bin[n]; }
    { bf16* wh = (bf16*)(C.ws + WS_WRH); bf16* wl = (bf16*)(C.ws + WS_WRL); const float* wg = a.in[I_WGRP]; const float* we = a.in[I_WEXP];
      for (int i = gt; i < 48 * 1024; i += NT) { const int j = i >> 10, k = i & 1023; float w = 0.f; if (j < 4) w = wg[k * 4 + j]; else if (j < 36) w = we[k * 32 + (j - 4)];
          const unsigned h = cvtpk(w, 0.f) & 0xffffu; const float r = w - bf2f((unsigned short)h); wh[i] = (bf16)h; wl[i] = (bf16)(cvtpk(r, 0.f) & 0xffffu); } }
}
constexpr int HG_BUF = 67072, HG_QP = 0, HG_KP = 16384, HG_V = 32768, HG_SC = 49152, HG_OB = 49664;
DI void hgrn_unit(const Ctx& C, const Args& a, int b, int h) {
    LAS unsigned char* L = C.lds;
    const int tid = C.tid, lane = C.lane, wid = C.wid;
    const int q32 = lane & 31, hi = lane >> 5, dh = (lane >> 4) & 1, dvb = wid & 3, tb = wid >> 2;
    const float* BM = (const float*)(C.ws + WS_ZF); const float* BE = BM + 262144;
    const bf16* Qh = (const bf16*)(C.ws + WS_QH); const bf16* Kh = (const bf16*)(C.ws + WS_KK); const bf16* Vh = (const bf16*)(C.ws + WS_VH); const bf16* Gh = (const bf16*)(C.ws + WS_GH);
    bf16* Ocat = (bf16*)(C.ws + WS_OCAT);
    const size_t rb = (size_t)b * SEQ;
    LAS float* NGS = (LAS float*)(L + 2 * HG_BUF);
    if (tid < 128) NGS[tid] = a.in[I_HGNG][h * 128 + tid];
    const int orow = tid >> 3, oseg = tid & 7;
    f32x16 T[4];
#pragma unroll
    for (int i = 0; i < 4; ++i)
#pragma unroll
        for (int r = 0; r < 16; ++r) T[i][r] = 0.f;
    u32x4 gr[2];
    const int drow = 8 * wid + (lane >> 4), dch = lane & 15;
#define HG_DMA(c) do { _Pragma("unroll") for (int p = 0; p < 2; ++p) { const int r_ = drow + 4 * p; const int sc_ = dch ^ (((r_ & 3) << 2) | ((r_ >> 2) & 3)); \
            const size_t g_ = (rb + (size_t)(c) * 64 + r_) * 512 + h * 128 + 8 * sc_; LAS unsigned char* d_ = L + ((c) & 1) * HG_BUF + (8 * wid + 4 * p) * 256; \
            __builtin_amdgcn_global_load_lds((const unsigned*)(Qh + g_), (LAS unsigned*)(d_ + HG_QP), 16, 0, 0); \
            __builtin_amdgcn_global_load_lds((const unsigned*)(Kh + g_), (LAS unsigned*)(d_ + HG_KP), 16, 0, 0); \
            __builtin_amdgcn_global_load_lds((const unsigned*)(Vh + g_), (LAS unsigned*)(d_ + HG_V), 16, 0, 0); } } while (0)
    float sm = 0.f, spe = 0.f, spm = 0.f;
#define HG_SCLOAD(c) do { if (tid < 128) { const size_t s_ = (size_t)(b * 32 + (c)) * 512 + h * 128 + tid; sm = BM[s_]; if ((c) > 0) { spe = BE[s_ - 512]; spm = BM[s_ - 512]; } } } while (0)
#define HG_SCALE(c) do { if (tid < 128) ((LAS float*)(L + ((c) & 1) * HG_BUF + HG_SC))[tid] = __expf(sm + (spe - spm)); } while (0)
    HG_DMA(0);
    HG_SCLOAD(0);
    HG_SCALE(0);
    asm volatile("s_waitcnt vmcnt(0)" ::: "memory");
    __syncthreads();
    for (int c = 0; c < 32; ++c) {
        const LAS unsigned char* B = L + (c & 1) * HG_BUF;
        if (c + 1 < 32) { HG_DMA(c + 1); HG_SCLOAD(c + 1); }
        int q32o = q32, hio = hi, laneo = lane; asm volatile("" : "+v"(q32o), "+v"(hio), "+v"(laneo));
        f32x16 oT;
#pragma unroll
        for (int r = 0; r < 16; ++r) oT[r] = 0.f;
        bf16x8 qb[8];
#pragma unroll
        for (int ks = 0; ks < 8; ++ks) qb[ks] = *(const LAS bf16x8*)(B + HG_QP + hswz(32 * tb + q32o, 2 * ks + hio));
#pragma unroll
        for (int sb = 0; sb < 2; ++sb) {
            if (sb <= tb) {
                bf16x8 ka[8];
#pragma unroll
                for (int ks = 0; ks < 8; ++ks) ka[ks] = *(const LAS bf16x8*)(B + HG_KP + hswz(32 * sb + q32o, 2 * ks + hio));
                s16x4 vl[2], vh[2];
#pragma unroll
                for (int s2 = 0; s2 < 2; ++s2) { const int r0 = 32 * sb + 16 * s2 + 4 * hio; vl[s2] = vtr((LAS const char*)(B + HG_V + htr(r0, 4 * dvb + 2 * dh, laneo))); vh[s2] = vtr((LAS const char*)(B + HG_V + htr(r0 + 8, 4 * dvb + 2 * dh, laneo))); }
                __builtin_amdgcn_sched_barrier(0);
                f32x16 pT;
#pragma unroll
                for (int r = 0; r < 16; ++r) pT[r] = 0.f;
#pragma unroll
                for (int ks = 0; ks < 8; ++ks) pT = MFMA32(ka[ks], qb[ks], pT);
                if (sb == tb) {
#pragma unroll
                    for (int r = 0; r < 16; ++r) if (crow(r, hi) > q32) pT[r] = 0.f;
                }
#pragma unroll
                for (int s2 = 0; s2 < 2; ++s2) { u32x4 pw; pw.x = cvtpk(pT[8 * s2 + 0], pT[8 * s2 + 1]); pw.y = cvtpk(pT[8 * s2 + 2], pT[8 * s2 + 3]); pw.z = cvtpk(pT[8 * s2 + 4], pT[8 * s2 + 5]); pw.w = cvtpk(pT[8 * s2 + 6], pT[8 * s2 + 7]);
                    oT = MFMA32(((bf16x8){vl[s2][0], vl[s2][1], vl[s2][2], vl[s2][3], vh[s2][0], vh[s2][1], vh[s2][2], vh[s2][3]}), __builtin_bit_cast(bf16x8, pw), oT); }
                __builtin_amdgcn_sched_barrier(0);
            }
        }
        { const size_t g0 = (rb + (size_t)c * 64 + orow) * 512 + h * 128 + 16 * oseg; gr[0] = *(const u32x4*)(Gh + g0); gr[1] = *(const u32x4*)(Gh + g0 + 8); }
        {
            u32x2 qq0[8], qq1[8];
            if (c > 0) {
#pragma unroll
                for (int i = 0; i < 4; ++i)
#pragma unroll
                    for (int s = 0; s < 2; ++s) { qq0[2 * i + s] = *(const LAS u32x2*)(B + HG_QP + hswz(32 * tb + q32o, 4 * i + 2 * s) + 8 * hio); qq1[2 * i + s] = *(const LAS u32x2*)(B + HG_QP + hswz(32 * tb + q32o, 4 * i + 2 * s + 1) + 8 * hio); }
            }
#pragma unroll
            for (int i = 0; i < 4; ++i)
#pragma unroll
                for (int g = 0; g < 4; ++g) { const f32x4 sc = *(const LAS f32x4*)(B + HG_SC + (32 * i + 8 * g + 4 * hio) * 4);
#pragma unroll
                    for (int j = 0; j < 4; ++j) T[i][4 * g + j] *= sc[j]; }
            __builtin_amdgcn_sched_barrier(0);
            if (c > 0) {
#pragma unroll
                for (int i = 0; i < 4; ++i)
#pragma unroll
                    for (int s = 0; s < 2; ++s) { u32x4 tw; tw.x = cvtpk(T[i][8 * s + 0], T[i][8 * s + 1]); tw.y = cvtpk(T[i][8 * s + 2], T[i][8 * s + 3]); tw.z = cvtpk(T[i][8 * s + 4], T[i][8 * s + 5]); tw.w = cvtpk(T[i][8 * s + 6], T[i][8 * s + 7]);
                        const u32x4 qw = (u32x4){qq0[2 * i + s].x, qq0[2 * i + s].y, qq1[2 * i + s].x, qq1[2 * i + s].y};
                        oT = MFMA32(__builtin_bit_cast(bf16x8, tw), __builtin_bit_cast(bf16x8, qw), oT); }
            }
        }
        { LAS unsigned char* OBp = L + (c & 1) * HG_BUF + HG_OB;
#pragma unroll
          for (int g = 0; g < 4; ++g) { u32x2 w; w.x = cvtpk(oT[4 * g], oT[4 * g + 1]); w.y = cvtpk(oT[4 * g + 2], oT[4 * g + 3]); *(LAS u32x2*)(OBp + (32 * tb + q32o) * 272 + (32 * dvb + 8 * g + 4 * hio) * 2) = w; } }
#pragma unroll
        for (int sp = 0; sp < 2; ++sp) {
            s16x4 vl[2], vh[2], kl[2][4], kh[2][4];
#pragma unroll
            for (int u = 0; u < 2; ++u) { const int r0 = 16 * (2 * sp + u) + 8 * hio;
                vl[u] = vtr((LAS const char*)(B + HG_V + htr(r0, 4 * dvb + 2 * dh, laneo))); vh[u] = vtr((LAS const char*)(B + HG_V + htr(r0 + 4, 4 * dvb + 2 * dh, laneo)));
#pragma unroll
                for (int i = 0; i < 4; ++i) { kl[u][i] = vtr((LAS const char*)(B + HG_KP + htr(r0, 4 * i + 2 * dh, laneo))); kh[u][i] = vtr((LAS const char*)(B + HG_KP + htr(r0 + 4, 4 * i + 2 * dh, laneo))); } }
            __builtin_amdgcn_sched_barrier(0);
#pragma unroll
            for (int u = 0; u < 2; ++u) { const bf16x8 vb = (bf16x8){vl[u][0], vl[u][1], vl[u][2], vl[u][3], vh[u][0], vh[u][1], vh[u][2], vh[u][3]};
#pragma unroll
                for (int i = 0; i < 4; ++i) T[i] = MFMA32(((bf16x8){kl[u][i][0], kl[u][i][1], kl[u][i][2], kl[u][i][3], kh[u][i][0], kh[u][i][1], kh[u][i][2], kh[u][i][3]}), vb, T[i]); }
            __builtin_amdgcn_sched_barrier(0);
        }
        if (c + 1 < 32) HG_SCALE(c + 1);
        asm volatile("s_waitcnt vmcnt(0)" ::: "memory");
        __syncthreads();
        { const LAS unsigned char* OBp = L + (c & 1) * HG_BUF + HG_OB + orow * 272 + oseg * 32;
          const u32x4 o0 = *(const LAS u32x4*)OBp, o1 = *(const LAS u32x4*)(OBp + 16);
          float ov[16];
          ov[0] = bflo(o0.x); ov[1] = bfhi(o0.x); ov[2] = bflo(o0.y); ov[3] = bfhi(o0.y); ov[4] = bflo(o0.z); ov[5] = bfhi(o0.z); ov[6] = bflo(o0.w); ov[7] = bfhi(o0.w);
          ov[8] = bflo(o1.x); ov[9] = bfhi(o1.x); ov[10] = bflo(o1.y); ov[11] = bfhi(o1.y); ov[12] = bflo(o1.z); ov[13] = bfhi(o1.z); ov[14] = bflo(o1.w); ov[15] = bfhi(o1.w);
          float ss = 0.f;
#pragma unroll
          for (int j = 0; j < 16; ++j) ss += ov[j] * ov[j];
          ss += __int_as_float(__builtin_amdgcn_update_dpp(0, __float_as_int(ss), 0xB1, 0xf, 0xf, true));
          ss += __int_as_float(__builtin_amdgcn_update_dpp(0, __float_as_int(ss), 0x4E, 0xf, 0xf, true));
          ss += __int_as_float(__builtin_amdgcn_update_dpp(0, __float_as_int(ss), 0x141, 0xf, 0xf, true));
          const float rs = __builtin_amdgcn_rsqf(ss * (1.f / 128.f) + LN_EPS);
          float ng[16];
#pragma unroll
          for (int i = 0; i < 4; ++i) { const f32x4 n_ = *(const LAS f32x4*)(NGS + 16 * oseg + 4 * i); ng[4 * i] = n_[0]; ng[4 * i + 1] = n_[1]; ng[4 * i + 2] = n_[2]; ng[4 * i + 3] = n_[3]; }
          float gvv[16];
          gvv[0] = bflo(gr[0].x); gvv[1] = bfhi(gr[0].x); gvv[2] = bflo(gr[0].y); gvv[3] = bfhi(gr[0].y); gvv[4] = bflo(gr[0].z); gvv[5] = bfhi(gr[0].z); gvv[6] = bflo(gr[0].w); gvv[7] = bfhi(gr[0].w);
          gvv[8] = bflo(gr[1].x); gvv[9] = bfhi(gr[1].x); gvv[10] = bflo(gr[1].y); gvv[11] = bfhi(gr[1].y); gvv[12] = bflo(gr[1].z); gvv[13] = bfhi(gr[1].z); gvv[14] = bflo(gr[1].w); gvv[15] = bfhi(gr[1].w);
          float rv[16];
#pragma unroll
          for (int j = 0; j < 16; ++j) rv[j] = ov[j] * (rs * FP8_SO) * ng[j] * gvv[j];
          u32x4 w0; w0.x = cvt4_fp8(rv[0], rv[1], rv[2], rv[3]); w0.y = cvt4_fp8(rv[4], rv[5], rv[6], rv[7]); w0.z = cvt4_fp8(rv[8], rv[9], rv[10], rv[11]); w0.w = cvt4_fp8(rv[12], rv[13], rv[14], rv[15]);
          unsigned char* op = (unsigned char*)Ocat + (rb + (size_t)c * 64 + orow) * 1024 + h * 128 + 16 * oseg;
          *(u32x4*)op = w0; }
    }
    __syncthreads();
#undef HG_DMA
#undef HG_SCALE
#undef HG_SCLOAD
}

constexpr int AT_NST = 4, AT_K = 0, AT_V = AT_NST * 8192, AT_KM = 2 * AT_NST * 8192, AT_TAB = AT_KM + 1792;
DI int t5_bucket(int d) { if (d < 16) return d; const int v = 16 + (int)(logf((float)d * (1.f / 16.f)) / logf(8.f) * 16.f); return v < 31 ? v : 31; }
DI void glds16(const void* gsrc, unsigned lds_dst) { unsigned keep;
    asm volatile("s_mov_b32 %0, m0\n\ts_mov_b32 m0, %2\n\ts_nop 0\n\tglobal_load_lds_dwordx4 %1, off\n\ts_mov_b32 m0, %0" : "=&s"(keep) : "v"(gsrc), "s"(lds_dst) : "memory"); }
DI float max3f(float a, float b, float c) { float r; asm("v_max3_f32 %0, %1, %2, %3" : "=v"(r) : "v"(a), "v"(b), "v"(c)); return r; }
DI void attn_unit(const Ctx& C, const Args& a, int b, int h, int jq) {
    LAS unsigned char* L = C.lds;
    const int tid = C.tid, lane = C.lane, wid = C.wid, q32 = lane & 31, hi = lane >> 5;
    const bf16* Qm = (const bf16*)(C.ws + WS_QM); const bf16* Km = (const bf16*)(C.ws + WS_KM); const bf16* Vm = (const bf16*)(C.ws + WS_VM); const float* KM = (const float*)(C.ws + WS_KMEAN);
    bf16* Ocat = (bf16*)(C.ws + WS_OCAT);
    const int tq = jq * 256 + wid * 32 + q32;
    const size_t hb = (size_t)(b * 8 + h) * SEQ;
    bf16x8 qf[4];
#pragma unroll
    for (int ks = 0; ks < 4; ++ks) qf[ks] = *(const bf16x8*)(Qm + (hb + tq) * 64 + 16 * ks + 8 * hi);
    LAS float* kml = (LAS float*)(L + AT_KM); LAS float* tab = (LAS float*)(L + AT_TAB);
    if (tid < jq * 64) { const int n = tid >> 6, d = tid & 63; kml[tid] = KM[(size_t)((b * 8 + n) * 2 + 0) * 512 + h * 64 + d] + KM[(size_t)((b * 8 + n) * 2 + 1) * 512 + h * 64 + d]; }
    if (tid < 129) tab[tid] = (a.in[I_RELB][t5_bucket(tid) * 8 + h] - a.in[I_RELB][31 * 8 + h]) * LOG2E;
    const int drow = 8 * wid + (lane >> 3), dch = lane & 7;
    const bf16* ksrc = Km + (hb + drow) * 64 + 8 * (dch ^ ((drow >> 1) & 7));
    const bf16* vsrc = Vm + (hb + drow) * 64 + 8 * (dch ^ (((drow >> 1) & 1) << 2));
    const unsigned kdst = (unsigned)__builtin_amdgcn_readfirstlane((int)(unsigned)(size_t)(L + AT_K + wid * 1024)), vdst = (unsigned)__builtin_amdgcn_readfirstlane((int)(unsigned)(size_t)(L + AT_V + wid * 1024));
    const int nt = 4 * jq + 4;
#define AT_ISSUE(t) do { glds16(ksrc + (size_t)(t) * 4096, kdst + ((t) & 3) * 8192); glds16(vsrc + (size_t)(t) * 4096, vdst + ((t) & 3) * 8192); } while (0)
    AT_ISSUE(0); AT_ISSUE(1); AT_ISSUE(2);
    __syncthreads();
    unsigned sel = 0;
    {
        float g[7];
#pragma unroll
        for (int n = 0; n < 7; ++n) { g[n] = 0.f;
            if (n < jq) { float s = 0.f;
#pragma unroll
                for (int ks = 0; ks < 4; ++ks)
#pragma unroll
                    for (int j = 0; j < 8; ++j) s += bf2f((unsigned short)qf[ks][j]) * kml[n * 64 + 16 * ks + 8 * hi + j];
                s += __shfl_xor(s, 32); g[n] = s; } }
#pragma unroll
        for (int n = 0; n < 7; ++n) if (n < jq) { int rank = 0;
#pragma unroll
            for (int m = 0; m < 7; ++m) if (m != n && m < jq) rank += (g[m] > g[n] || (g[m] == g[n] && m < n)) ? 1 : 0;
            if (rank < 3) sel |= 1u << n; }
    }
    const float c31 = a.in[I_RELB][31 * 8 + h] * LOG2E;
    f32x16 lacc;
#pragma unroll
    for (int r = 0; r < 16; ++r) lacc[r] = 0.f;
    const bf16x8 ones8 = (bf16x8){0x3F80, 0x3F80, 0x3F80, 0x3F80, 0x3F80, 0x3F80, 0x3F80, 0x3F80};
    f32x16 negm;
#pragma unroll
    for (int r = 0; r < 16; ++r) negm[r] = c31;
    f32x16 o0, o1;
#pragma unroll
    for (int r = 0; r < 16; ++r) { o0[r] = 0.f; o1[r] = 0.f; }
    const int i16 = lane & 15, qq = i16 >> 2, pp = i16 & 3, dh = (lane >> 4) & 1, xsw = (qq >> 1) & 1;
    const int vb0 = (4 * hi + qq) * 128 + 64 * (0 ^ xsw) + 32 * dh + 8 * pp, vb1 = (4 * hi + qq) * 128 + 64 * (1 ^ xsw) + 32 * dh + 8 * pp;
    const int kxs = (q32 >> 1) & 7;
    for (int kt = 0; kt < nt; ++kt) {
        if (kt + 2 < nt) asm volatile("s_waitcnt vmcnt(4)" ::: "memory"); else if (kt + 1 < nt) asm volatile("s_waitcnt vmcnt(2)" ::: "memory"); else asm volatile("s_waitcnt vmcnt(0)" ::: "memory");
        __builtin_amdgcn_s_barrier();
        asm volatile("" ::: "memory");
        if (kt + 3 < nt) AT_ISSUE(kt + 3);
        const int blk = kt >> 2; const bool own = (blk == jq);
        const bool active = !own || ((kt & 3) * 64 <= wid * 32 + 31);
        if (active) {
            const LAS unsigned char* Kc = L + AT_K + (kt & 3) * 8192; const LAS unsigned char* Vc = L + AT_V + (kt & 3) * 8192;
            bf16x8 kf[8];
#pragma unroll
            for (int ks = 0; ks < 4; ++ks) { const int ko = (((2 * ks + hi) ^ kxs) << 4); kf[2 * ks] = *(const LAS bf16x8*)(Kc + q32 * 128 + ko); kf[2 * ks + 1] = *(const LAS bf16x8*)(Kc + (32 + q32) * 128 + ko); }
            __builtin_amdgcn_sched_barrier(0);
            f32x16 s0 = negm, s1 = negm;
#pragma unroll
            for (int ks = 0; ks < 4; ++ks) { s0 = MFMA32(kf[2 * ks], qf[ks], s0); s1 = MFMA32(kf[2 * ks + 1], qf[ks], s1); }
            __builtin_amdgcn_sched_barrier(0);
            s16x4 vf[2][4][2];
#pragma unroll
            for (int j = 0; j < 4; ++j) { const int ro = 16 * j * 128;
                vf[0][j][0] = vtr((LAS const char*)(Vc + vb0 + ro)); vf[0][j][1] = vtr((LAS const char*)(Vc + vb0 + ro + 8 * 128));
                vf[1][j][0] = vtr((LAS const char*)(Vc + vb1 + ro)); vf[1][j][1] = vtr((LAS const char*)(Vc + vb1 + ro + 8 * 128)); }
            __builtin_amdgcn_sched_barrier(0);
            const bool near = (jq * 256 + wid * 32 - 64 * kt - 63) < 128;
            if (near) {
                const int dist0 = tq - 64 * kt - 4 * hi;
#pragma unroll
                for (int r = 0; r < 16; ++r) { const int d0 = dist0 - ((r & 3) + 8 * (r >> 2)), d1 = d0 - 32;
                    const int i0 = d0 < 0 ? 0 : (d0 > 128 ? 128 : d0), i1 = d1 < 0 ? 0 : (d1 > 128 ? 128 : d1);
                    const float t0 = tab[i0], t1 = tab[i1]; s0[r] += t0; s1[r] += t1; s0[r] = d0 < 0 ? -INFINITY : s0[r]; s1[r] = d1 < 0 ? -INFINITY : s1[r]; }
            }
            const bool lsel = own || ((sel >> blk) & 1u);
            float mx = max3f(s0[0], s1[0], s0[1]), mx2 = max3f(s1[1], s0[2], s1[2]);
#pragma unroll
            for (int r = 3; r < 15; r += 2) { mx = max3f(mx, s0[r], s1[r]); mx2 = max3f(mx2, s0[r + 1], s1[r + 1]); }
            mx = max3f(mx, s0[15], s1[15]); mx = fmaxf(mx, mx2);
            mx = lsel ? mx : -INFINITY;
            mx = fmaxf(mx, __shfl_xor(mx, 32));
            if (__any(mx > 4.0f)) {
                const float delta = fmaxf(mx, 0.f), alpha = __builtin_amdgcn_exp2f(-delta);
#pragma unroll
                for (int r = 0; r < 16; ++r) { o0[r] *= alpha; o1[r] *= alpha; lacc[r] *= alpha; negm[r] -= delta; s0[r] -= delta; s1[r] -= delta; }
            }
#pragma unroll
            for (int r = 0; r < 16; ++r) { s0[r] = __builtin_amdgcn_exp2f(s0[r]); s1[r] = __builtin_amdgcn_exp2f(s1[r]); }
            const unsigned pmask = lsel ? 0xffffffffu : 0u;
#pragma unroll
            for (int kb = 0; kb < 2; ++kb)
#pragma unroll
                for (int s2 = 0; s2 < 2; ++s2) {
                    u32x4 pw;
                    if (kb == 0) { pw.x = cvtpk(s0[8 * s2 + 0], s0[8 * s2 + 1]); pw.y = cvtpk(s0[8 * s2 + 2], s0[8 * s2 + 3]); pw.z = cvtpk(s0[8 * s2 + 4], s0[8 * s2 + 5]); pw.w = cvtpk(s0[8 * s2 + 6], s0[8 * s2 + 7]); }
                    else         { pw.x = cvtpk(s1[8 * s2 + 0], s1[8 * s2 + 1]); pw.y = cvtpk(s1[8 * s2 + 2], s1[8 * s2 + 3]); pw.z = cvtpk(s1[8 * s2 + 4], s1[8 * s2 + 5]); pw.w = cvtpk(s1[8 * s2 + 6], s1[8 * s2 + 7]); }
                    pw.x &= pmask; pw.y &= pmask; pw.z &= pmask; pw.w &= pmask;
                    const bf16x8 pf = __builtin_bit_cast(bf16x8, pw);
                    const s16x4 a0l = vf[0][2 * kb + s2][0], a0h = vf[0][2 * kb + s2][1], a1l = vf[1][2 * kb + s2][0], a1h = vf[1][2 * kb + s2][1];
                    o0 = MFMA32(((bf16x8){a0l[0], a0l[1], a0l[2], a0l[3], a0h[0], a0h[1], a0h[2], a0h[3]}), pf, o0);
                    o1 = MFMA32(((bf16x8){a1l[0], a1l[1], a1l[2], a1l[3], a1h[0], a1h[1], a1h[2], a1h[3]}), pf, o1);
                    lacc = MFMA32(ones8, pf, lacc);
                }
        }
    }
    const float linv = 1.f / lacc[0];
    unsigned char* op = (unsigned char*)Ocat + ((size_t)b * SEQ + tq) * 1024 + 512 + h * 64;
    const float lsc = linv * FP8_SO;
#pragma unroll
    for (int g = 0; g < 4; ++g) { *(unsigned*)(op + 8 * g + 4 * hi) = cvt4_fp8(o0[4 * g] * lsc, o0[4 * g + 1] * lsc, o0[4 * g + 2] * lsc, o0[4 * g + 3] * lsc);
        *(unsigned*)(op + 32 + 8 * g + 4 * hi) = cvt4_fp8(o1[4 * g] * lsc, o1[4 * g + 1] * lsc, o1[4 * g + 2] * lsc, o1[4 * g + 3] * lsc); }
    __syncthreads();
#undef AT_ISSUE
}

#ifndef PROBE_HGX
#define PROBE_HGX 1
#endif
#ifndef PROBE_ATX
#define PROBE_ATX 1
#endif
#ifndef STAMP_SEL
#define STAMP_SEL -1
#endif
#ifndef STAMP_BLK
#define STAMP_BLK 0
#endif
#define STAMP(i) do { if (STAMP_SEL >= 0 && blockIdx.x == STAMP_BLK && C.tid == 0) { const unsigned long long t_ = __builtin_amdgcn_s_memrealtime(); C.MISC[16 + 2 * (i)] = (unsigned)t_; C.MISC[17 + 2 * (i)] = (unsigned)(t_ >> 32); } } while (0)
DI void p2_mixers(const Ctx& C, const Args& a, int rep) {
    for (int hx = 0; hx < PROBE_HGX; ++hx)
    for (int u = blockIdx.x; u < 64; u += C.G) hgrn_unit(C, a, u >> 2, u & 3);
    STAMP(11);
    unsigned* QA = (unsigned*)(C.ctl + CW_QUEUE + 64 * rep); unsigned* QC = (unsigned*)(C.ctl + CW_QUEUE2 + 64 * rep);
    constexpr int NA = 1024 * PROBE_ATX, NC = MOE_CVT_TILES;
    if (C.tid == 0) { C.MISC[0] = __hip_atomic_fetch_add(QA, 1u, __ATOMIC_RELAXED, __HIP_MEMORY_SCOPE_AGENT); C.MISC[1] = (rep == 0) ? __hip_atomic_fetch_add(QC, 1u, __ATOMIC_RELAXED, __HIP_MEMORY_SCOPE_AGENT) : (unsigned)NC; }
    __syncthreads();
    int qa = (int)C.MISC[0], qc = (int)C.MISC[1];
    __syncthreads();
    for (;;) {
        const bool doa = qa < NA, doc = qc < NC;
        if (!doa && !doc) break;
        unsigned na = (unsigned)NA, nc = (unsigned)NC;
        if (C.tid == 0) { if (doa) na = __hip_atomic_fetch_add(QA, 1u, __ATOMIC_RELAXED, __HIP_MEMORY_SCOPE_AGENT); if (doc) nc = __hip_atomic_fetch_add(QC, 1u, __ATOMIC_RELAXED, __HIP_MEMORY_SCOPE_AGENT); }
#ifdef STAMP_ACC
        unsigned long long ta_ = 0, tb_ = 0, tc_ = 0; if (C.tid == 0) ta_ = __builtin_amdgcn_s_memrealtime();
#endif
        if (doa) { const int q = qa / PROBE_ATX; attn_unit(C, a, (q & 127) >> 3, q & 7, 7 - (q >> 7)); }
#ifdef STAMP_ACC
        if (C.tid == 0) tb_ = __builtin_amdgcn_s_memrealtime();
#endif
        if (doc) moe_cvt_tile(C, a, qc);
#ifdef STAMP_ACC
        if (C.tid == 0 && blockIdx.x == 100) { tc_ = __builtin_amdgcn_s_memrealtime(); const unsigned long long d_ = (STAMP_ACC == 0) ? (tb_ - ta_) : (tc_ - tb_);
            const unsigned long long o_ = ((unsigned long long)C.MISC[45] << 32) | C.MISC[44]; const unsigned long long n_ = o_ + d_; C.MISC[44] = (unsigned)n_; C.MISC[45] = (unsigned)(n_ >> 32); }
#endif
        if (C.tid == 0) { C.MISC[0] = na; C.MISC[1] = nc; }
        __syncthreads();
        qa = (int)C.MISC[0]; qc = (int)C.MISC[1];
        __syncthreads();
    }
    STAMP(12);
#ifdef STAMP_ACC
    if (C.tid == 0 && blockIdx.x == 100) { const unsigned long long n_ = ((unsigned long long)C.MISC[45] << 32) | C.MISC[44]; const unsigned long long w0 = __builtin_amdgcn_s_memrealtime(); while (__builtin_amdgcn_s_memrealtime() - w0 < 4ull * n_) __builtin_amdgcn_s_sleep(8); }
#endif
}

DI void r1_phase(const Ctx& C, const Args& a) {
    LAS unsigned char* L = C.lds;
    const int tid = C.tid, lane = C.lane, wid = C.wid;
    LAS float* LG = (LAS float*)L + wid * 16 * 48;
    LAS int* CNT = (LAS int*)(L + 32768);
    LAS float* G1 = (LAS float*)(L + 33024); LAS float* B1 = (LAS float*)(L + 37120);
    const bf16* Pre = (const bf16*)(C.ws + WS_ZF); unsigned char* X1q = (unsigned char*)(C.ws + WS_R); f32x2* stats = (f32x2*)(C.ws + WS_STATS);
    const bf16* WrH = (const bf16*)(C.ws + WS_WRH); const bf16* WrL = (const bf16*)(C.ws + WS_WRL);
    unsigned* tokE = (unsigned*)(C.ws + WS_TOKE); float* tokW = (float*)(C.ws + WS_TOKW); int* wgcnt = (int*)(C.ws + WS_WGCNT);
    for (int i = tid; i < 1024; i += NTHREADS) { G1[i] = a.in[I_LN1G][i]; B1[i] = a.in[I_LN1B][i]; }
    LAS unsigned char* WL = L + 45056;
    for (int i = tid; i < 48 * 128; i += NTHREADS) { const int r = i >> 7, c = i & 127; *(LAS u32x4*)(WL + r * 2064 + c * 16) = *(const u32x4*)(WrH + (size_t)r * 1024 + c * 8); }
    LAS float* RB = (LAS float*)(L + 41216);
    if (tid < 4) RB[tid] = a.in[I_BGRP][tid]; else if (tid < 36) RB[tid] = a.in[I_BEXP][tid - 4];
    const int m16 = lane & 15, kq = lane >> 4;
    for (int chunk = blockIdx.x; chunk < NTOK / 128; chunk += C.G) {
        if (tid < 32) CNT[tid] = 0;
        __syncthreads();
        const int tok0 = chunk * 128 + wid * 16;
        const bf16* xrow = Pre + (size_t)(tok0 + m16) * 1024 + 8 * kq;
        float s = 0.f, s2 = 0.f;
#pragma unroll 8
        for (int k0 = 0; k0 < 1024; k0 += 32) { const u32x4 w = *(const u32x4*)(xrow + k0); const f32x4 xa = (f32x4){bflo(w.x), bfhi(w.x), bflo(w.y), bfhi(w.y)}, xc = (f32x4){bflo(w.z), bfhi(w.z), bflo(w.w), bfhi(w.w)};
            s += (xa[0] + xa[1]) + (xa[2] + xa[3]) + (xc[0] + xc[1]) + (xc[2] + xc[3]);
            s2 += (xa[0] * xa[0] + xa[1] * xa[1]) + (xa[2] * xa[2] + xa[3] * xa[3]) + (xc[0] * xc[0] + xc[1] * xc[1]) + (xc[2] * xc[2] + xc[3] * xc[3]); }
        s += __shfl_xor(s, 16); s += __shfl_xor(s, 32); s2 += __shfl_xor(s2, 16); s2 += __shfl_xor(s2, 32);
        const float mean = s * (1.f / 1024.f); const float var = fmaxf(s2 * (1.f / 1024.f) - mean * mean, 0.f); const float rstd = 1.f / sqrtf(var + LN_EPS);
        if (kq == 0) stats[tok0 + m16] = (f32x2){mean, rstd};
        STAMP(13);
        f32x4 acc[3];
#pragma unroll
        for (int nb = 0; nb < 3; ++nb) acc[nb] = (f32x4){0.f, 0.f, 0.f, 0.f};
        unsigned char* xb = X1q + (size_t)(tok0 + m16) * 1024 + 8 * kq;
        const LAS unsigned char* wlp = WL + m16 * 2064 + 16 * kq;
#pragma unroll 1
        for (int kb = 0; kb < 4; ++kb) {
            u32x4 xw[8];
#pragma unroll
            for (int j = 0; j < 8; ++j) xw[j] = *(const u32x4*)(xrow + kb * 256 + 32 * j);
#pragma unroll
            for (int j = 0; j < 8; ++j) { const int k0 = kb * 256 + 32 * j;
                bf16x8 wh[3];
#pragma unroll
                for (int nb = 0; nb < 3; ++nb) wh[nb] = *(const LAS bf16x8*)(wlp + nb * 16 * 2064 + k0 * 2);
                const f32x4 xaj = (f32x4){bflo(xw[j].x), bfhi(xw[j].x), bflo(xw[j].y), bfhi(xw[j].y)}, xcj = (f32x4){bflo(xw[j].z), bfhi(xw[j].z), bflo(xw[j].w), bfhi(xw[j].w)};
                const f32x4 ya = (xaj - mean) * rstd * *(const LAS f32x4*)(G1 + k0 + 8 * kq) + *(const LAS f32x4*)(B1 + k0 + 8 * kq);
                const f32x4 yc = (xcj - mean) * rstd * *(const LAS f32x4*)(G1 + k0 + 8 * kq + 4) + *(const LAS f32x4*)(B1 + k0 + 8 * kq + 4);
                u32x4 hw; hw.x = cvtpk(ya[0], ya[1]); hw.y = cvtpk(ya[2], ya[3]); hw.z = cvtpk(yc[0], yc[1]); hw.w = cvtpk(yc[2], yc[3]);
                { u32x2 qw; qw.x = cvt4_fp8(ya[0] * FP8_SX, ya[1] * FP8_SX, ya[2] * FP8_SX, ya[3] * FP8_SX); qw.y = cvt4_fp8(yc[0] * FP8_SX, yc[1] * FP8_SX, yc[2] * FP8_SX, yc[3] * FP8_SX); *(u32x2*)(xb + k0) = qw; }
                u32x4 lw; lw.x = cvtpk(ya[0] - bflo(hw.x), ya[1] - bfhi(hw.x)); lw.y = cvtpk(ya[2] - bflo(hw.y), ya[3] - bfhi(hw.y)); lw.z = cvtpk(yc[0] - bflo(hw.z), yc[1] - bfhi(hw.z)); lw.w = cvtpk(yc[2] - bflo(hw.w), yc[3] - bfhi(hw.w));
                const bf16x8 xh = __builtin_bit_cast(bf16x8, hw), xl = __builtin_bit_cast(bf16x8, lw);
#pragma unroll
                for (int nb = 0; nb < 3; ++nb) { acc[nb] = MFMA16(wh[nb], xh, acc[nb]); acc[nb] = MFMA16(wh[nb], xl, acc[nb]); }
            }
        }
        STAMP(14);
#pragma unroll
        for (int nb = 0; nb < 3; ++nb)
#pragma unroll
            for (int r = 0; r < 4; ++r) LG[m16 * 48 + nb * 16 + 4 * kq + r] = acc[nb][r];
        asm volatile("s_waitcnt lgkmcnt(0)" ::: "memory");
        if (lane < 16) {
            const LAS float* lg = LG + lane * 48;
            float gl[4];
#pragma unroll
            for (int j = 0; j < 4; ++j) gl[j] = lg[j] + RB[j];
            int grp = 0; float gm = gl[0];
#pragma unroll
            for (int j = 1; j < 4; ++j) if (gl[j] > gm) { gm = gl[j]; grp = j; }
            float se = 0.f;
#pragma unroll
            for (int j = 0; j < 4; ++j) se += __expf(gl[j] - gm);
            const float pg = 1.f / se;
            float el[8];
#pragma unroll
            for (int j = 0; j < 8; ++j) el[j] = lg[4 + grp * 8 + j] + RB[4 + grp * 8 + j];
            int i0 = 0; float v0 = el[0];
#pragma unroll
            for (int j = 1; j < 8; ++j) if (el[j] > v0) { v0 = el[j]; i0 = j; }
            int i1 = -1; float v1 = -INFINITY;
#pragma unroll
            for (int j = 0; j < 8; ++j) if (j != i0 && el[j] > v1) { v1 = el[j]; i1 = j; }
            const float w0 = 1.f / (1.f + __expf(v1 - v0)), w1 = 1.f - w0;
            const int e0 = grp * 8 + i0, e1 = grp * 8 + i1;
            const int r0 = __hip_atomic_fetch_add(CNT + e0, 1, __ATOMIC_RELAXED, __HIP_MEMORY_SCOPE_WORKGROUP), r1 = __hip_atomic_fetch_add(CNT + e1, 1, __ATOMIC_RELAXED, __HIP_MEMORY_SCOPE_WORKGROUP);
            const int tok = tok0 + lane;
            tokE[tok] = (unsigned)e0 | ((unsigned)e1 << 8) | ((unsigned)r0 << 16) | ((unsigned)r1 << 24);
            tokW[tok * 2] = w0 * pg; tokW[tok * 2 + 1] = w1 * pg;
        }
        __syncthreads();
        if (tid < 32) wgcnt[chunk * 32 + tid] = CNT[tid];
        __syncthreads();
    }
}

DI void r2_phase(const Ctx& C, const Args& a) {
    LAS int* PA = (LAS int*)C.lds;
    LAS int* PB = PA + 512;
    LAS int* TOT = PB + 512; LAS int* BASE = TOT + 32; LAS int* PST = BASE + 32;
    const int tid = C.tid;
    const int* wgcnt = (const int*)(C.ws + WS_WGCNT); const unsigned* tokE = (const unsigned*)(C.ws + WS_TOKE);
    int* tokD = (int*)(C.ws + WS_TOKD); int* rowtok = (int*)(C.ws + WS_ROWTOK); int* tilee = (int*)(C.ws + WS_TILEE);
    for (int chunk = blockIdx.x; chunk < NTOK / 128; chunk += C.G) {
        { const int e = tid & 31, part = tid >> 5; int sa = 0, sb = 0;
          for (int c = part * 16; c < part * 16 + 16; ++c) { const int v = wgcnt[c * 32 + e]; sa += v; sb += (c < chunk) ? v : 0; }
          PA[part * 32 + e] = sa; PB[part * 32 + e] = sb; }
        __syncthreads();
        if (tid < 32) { int sa = 0, sb = 0; for (int p = 0; p < 16; ++p) { sa += PA[p * 32 + tid]; sb += PB[p * 32 + tid]; } TOT[tid] = sa; BASE[tid] = sb; }
        __syncthreads();
        if (tid == 0) { int ps = 0; for (int e = 0; e < 32; ++e) { PST[e] = ps; ps += ((TOT[e] + 255) >> 8) << 8; } PST[32] = ps; }
        __syncthreads();
        if (tid < 128) { const int tok = chunk * 128 + tid; const unsigned w = tokE[tok]; const int e0 = w & 31, e1 = (w >> 8) & 31, r0 = (w >> 16) & 255, r1 = (w >> 24) & 255;
            const int d0 = PST[e0] + BASE[e0] + r0, d1 = PST[e1] + BASE[e1] + r1; rowtok[d0] = tok; rowtok[d1] = tok; tokD[tok * 2] = d0; tokD[tok * 2 + 1] = d1; }
        if (chunk < 32) { const int e = chunk, end = PST[e + 1] - PST[e]; for (int i = TOT[e] + tid; i < end; i += NTHREADS) rowtok[PST[e] + i] = 0; }
        if (chunk == 0) { if (tid < 32) { for (int t = PST[tid] >> 8; t < (PST[tid + 1] >> 8); ++t) tilee[t] = tid; } if (tid == 0) tilee[511] = PST[32] >> 8; }
        __syncthreads();
    }
}

DI void f_phase(const Ctx& C, const Args& a) {
    const int lane = C.lane, gw = C.vcu * NWAVES + C.wid, NGW = C.G * NWAVES;
    const bf16* Pre = (const bf16*)(C.ws + WS_ZF); const unsigned char* Y = (const unsigned char*)(C.ws + WS_Y); const int* tokD = (const int*)(C.ws + WS_TOKD); const float* tokW = (const float*)(C.ws + WS_TOKW);
    const f32x2* stats = (const f32x2*)(C.ws + WS_STATS);
    f32x4 g2[4], b2[4], g1[4], b1[4];
#pragma unroll
    for (int j = 0; j < 4; ++j) { g2[j] = *(const f32x4*)(a.in[I_LN2G] + 256 * j + 4 * lane); b2[j] = *(const f32x4*)(a.in[I_LN2B] + 256 * j + 4 * lane);
        g1[j] = *(const f32x4*)(a.in[I_LN1G] + 256 * j + 4 * lane) * DN_ALPHA; b1[j] = *(const f32x4*)(a.in[I_LN1B] + 256 * j + 4 * lane) * DN_ALPHA; }
    for (int tok = gw; tok < NTOK; tok += NGW) {
        const int d0 = tokD[tok * 2], d1 = tokD[tok * 2 + 1]; const float w0 = tokW[tok * 2] * (1.f / FP8_SY), w1 = tokW[tok * 2 + 1] * (1.f / FP8_SY); const f32x2 st = stats[tok];
        const bf16* xr = Pre + (size_t)tok * 1024 + 4 * lane; const unsigned char* y0 = Y + (size_t)d0 * 1024 + 4 * lane; const unsigned char* y1 = Y + (size_t)d1 * 1024 + 4 * lane;
        f32x4 v[4]; float s = 0.f;
#pragma unroll
        for (int j = 0; j < 4; ++j) { const u32x2 xw = *(const u32x2*)(xr + 256 * j); const f32x4 x = (f32x4){bflo(xw.x), bfhi(xw.x), bflo(xw.y), bfhi(xw.y)}; const unsigned p0 = *(const unsigned*)(y0 + 256 * j), p1 = *(const unsigned*)(y1 + 256 * j);
            v[j] = ((x - st.x) * st.y) * g1[j] + b1[j] + fp8x4_to_f32(p0) * w0 + fp8x4_to_f32(p1) * w1;
            s += (v[j][0] + v[j][1]) + (v[j][2] + v[j][3]); }
        const float mean = wave_sum(s) * (1.f / 1024.f); float s2 = 0.f;
#pragma unroll
        for (int j = 0; j < 4; ++j) { v[j] = v[j] - mean; s2 += (v[j][0] * v[j][0] + v[j][1] * v[j][1]) + (v[j][2] * v[j][2] + v[j][3] * v[j][3]); }
        const float rstd = 1.f / sqrtf(wave_sum(s2) * (1.f / 1024.f) + LN_EPS);
        float* orow = a.out + (size_t)tok * 1024 + 4 * lane;
#pragma unroll
        for (int j = 0; j < 4; ++j) *(f32x4*)(orow + 256 * j) = v[j] * rstd * g2[j] + b2[j];
    }
}

constexpr int NPH = 10;
__global__ void __launch_bounds__(NTHREADS, 2) mk_fwd(Args args) {
    extern __shared__ __attribute__((aligned(16))) unsigned char lds_raw[];
    Ctx C;
    C.lds = (LAS unsigned char*)lds_raw; C.MISC = (volatile LAS unsigned*)(C.lds + MISC_OFF);
    C.tid = threadIdx.x; C.lane = C.tid & 63; C.wid = __builtin_amdgcn_readfirstlane(C.tid >> 6);
    C.G = gridDim.x; { const int bx = blockIdx.x; C.vcu = (C.G % 8 == 0) ? (bx % 8) * (C.G / 8) + bx / 8 : bx; }
    C.ws = args.ws; C.ctl = (gu32*)(args.ws + WS_CTL);
    if (C.tid < 64) C.MISC[C.tid] = 0u;
    __syncthreads();
    XcdBarrier bar; bar.bar = (unsigned*)(C.ctl + CW_BAR); bar.x = 0; bar.st = nullptr;
    if (MK_N_LAUNCHES == 1) bar = xcd_barrier_post((unsigned*)(C.ctl + CW_BAR), C.MISC + 8);
    const int lo = args.ph_lo, hi = args.ph_hi;
#ifndef PH_MASK
#define PH_MASK 0x3ff
#endif
#define IN(k) (((PH_MASK >> (k)) & 1) && lo <= (k) && (k) < hi)
#ifndef STAMP_SEL
#define STAMP_SEL -1
#endif
#ifndef STAMP_T0
#define STAMP_T0 STAMP_SEL
#define STAMP_T1 (STAMP_SEL + 1)
#endif
#define SEAM(k) do { if (IN(k) && IN((k) + 1)) xcd_barrier(bar); STAMP((k) + 1); } while (0)
#ifndef PROBE_PHASE
#define PROBE_PHASE -1
#endif
#define REPS(k) ((PROBE_PHASE == (k)) ? 2 : 1)
#define REPSEAM(k) do { if (rep + 1 < REPS(k)) xcd_barrier(bar); } while (0)
    unsigned char* ws = args.ws;
    LAS unsigned char* ring = C.lds;

    STAMP(0);
    if (IN(0)) { _Pragma("unroll") for (int rep = 0; rep < REPS(0); ++rep) { p0_prologue(C, args); REPSEAM(0); } } SEAM(0);

    if (IN(1)) _Pragma("unroll") for (int rep = 0; rep < REPS(1); ++rep) {
        pg8::EpiIn E{(bf16*)(ws + WS_QH), (bf16*)(ws + WS_VH), (bf16*)(ws + WS_GH), (bf16*)(ws + WS_QM), (bf16*)(ws + WS_KM), (bf16*)(ws + WS_VM), (bf16*)(ws + WS_R), (bf16*)(ws + WS_GB),
                     (float*)(ws + WS_ZF), (float*)(ws + WS_KMEAN), (const float*)(ws + WS_BPERM), (bf16*)(ws + WS_KK), (const float*)(ws + WS_LB), 0};
        { pg8::DenseOrder S; S.init(ws + WS_XB, ws + WS_WIN, NTOK, 1024, 1024, C.G, (int)blockIdx.x);
          pg8::gemm_phase<pg8::EpiIn, pg8::DenseOrder, false>(ring, 1024, S, E); }
        { E.pn_off = 4; pg8::DenseOrder S; S.init((unsigned char*)args.out + 64 * MiB, ws + WS_WIN + 2 * MiB, NTOK, 4608, 512, C.G, (int)blockIdx.x);
          pg8::gemm_phase<pg8::EpiIn, pg8::DenseOrder, false, true>(ring, 512, S, E); }
        REPSEAM(1);
    } SEAM(1);

#ifndef PROBE_P2X
#define PROBE_P2X 1
#endif
    if (IN(2)) { for (int rep = 0; rep < PROBE_P2X; ++rep) { p2_mixers(C, args, rep); if (rep + 1 < PROBE_P2X) xcd_barrier(bar); } } SEAM(2);

    if (IN(3)) _Pragma("unroll") for (int rep = 0; rep < REPS(3); ++rep) {
        pg8::DenseOrder S; S.init(ws + WS_OCAT, ws + WS_WCAT, NTOK, 1024, 512, C.G, (int)blockIdx.x);
        pg8::EpiProj E{(const bf16*)(ws + WS_R), (const bf16*)(ws + WS_GB), (unsigned char*)(ws + WS_QH)};
        pg8::gemm_phase<pg8::EpiProj, pg8::DenseOrder, false, true>(ring, 512, S, E); REPSEAM(3);
    } SEAM(3);

    if (IN(4)) _Pragma("unroll") for (int rep = 0; rep < REPS(4); ++rep) {
        pg8::DenseOrder S; S.init(ws + WS_QH, ws + WS_WO, NTOK, 1024, 512, C.G, (int)blockIdx.x);
        pg8::EpiOut E{(const bf16*)(ws + WS_XB), (bf16*)(ws + WS_ZF)};
        pg8::gemm_phase<pg8::EpiOut, pg8::DenseOrder, false, true>(ring, 512, S, E);
        REPSEAM(4);
    } SEAM(4);

    if (IN(5)) { _Pragma("unroll") for (int rep = 0; rep < REPS(5); ++rep) { r1_phase(C, args); REPSEAM(5); } } STAMP(15); SEAM(5);
    if (IN(6)) { _Pragma("unroll") for (int rep = 0; rep < REPS(6); ++rep) { r2_phase(C, args); REPSEAM(6); } } SEAM(6);

    if (IN(7)) _Pragma("unroll") for (int rep = 0; rep < REPS(7); ++rep) {
        const int* tilee = (const int*)(ws + WS_TILEE);
        const int ntl = __builtin_amdgcn_readfirstlane(__hip_atomic_load(tilee + 511, __ATOMIC_RELAXED, __HIP_MEMORY_SCOPE_AGENT));
        pg8::MoeOrder S{(const char*)(ws + WS_R), (const char*)args.out, (const int*)(ws + WS_ROWTOK), tilee, 512, 1024, ntl * 4, C.G, C.vcu, true};
        pg8::EpiM1 E{(unsigned char*)(ws + WS_QH)};
        pg8::gemm_phase<pg8::EpiM1, pg8::MoeOrder, true, true>(ring, 512, S, E); REPSEAM(7);
    } SEAM(7);

    if (IN(8)) _Pragma("unroll") for (int rep = 0; rep < REPS(8); ++rep) {
        const int* tilee = (const int*)(ws + WS_TILEE);
        const int ntl = __builtin_amdgcn_readfirstlane(__hip_atomic_load(tilee + 511, __ATOMIC_RELAXED, __HIP_MEMORY_SCOPE_AGENT));
        pg8::MoeOrder S{(const char*)(ws + WS_QH), (const char*)args.out + 32 * MiB, (const int*)(ws + WS_ROWTOK), tilee, 256, 1024, ntl * 4, C.G, C.vcu, false};
        pg8::EpiM2 E{(unsigned char*)(ws + WS_Y)};
        pg8::gemm_phase<pg8::EpiM2, pg8::MoeOrder, false, true>(ring, 256, S, E); REPSEAM(8);
    } SEAM(8);

    if (IN(9)) { _Pragma("unroll") for (int rep = 0; rep < REPS(9); ++rep) { f_phase(C, args); REPSEAM(9); } }
    STAMP(10);
    if (STAMP_SEL >= 0 && blockIdx.x == STAMP_BLK && C.tid == 0) {
        const unsigned long long t0 = ((unsigned long long)C.MISC[17 + 2 * (STAMP_T0)] << 32) | C.MISC[16 + 2 * (STAMP_T0)], t1 = ((unsigned long long)C.MISC[17 + 2 * (STAMP_T1)] << 32) | C.MISC[16 + 2 * (STAMP_T1)];
        const unsigned long long w0 = __builtin_amdgcn_s_memrealtime(); while (__builtin_amdgcn_s_memrealtime() - w0 < 4ull * (t1 - t0)) __builtin_amdgcn_s_sleep(8); }
#undef IN
#undef SEAM
}

extern "C" void kernel_launch(void* const* d_in, const int* in_sizes, int n_in, void* d_out, int out_size, void* d_ws, size_t ws_size, hipStream_t stream) {
    static int grid = 0;
    if (grid == 0) {
        if (n_in != 19 || in_sizes[0] != NTOK * DM || out_size != NTOK * DM || ws_size < WS_END) { fprintf(stderr, "kernel_launch: unexpected problem shape / workspace; nothing launched\n"); grid = -1; return; }
        int dev = 0, cus = 0, per_cu = 0;
        if (hipGetDevice(&dev) != hipSuccess || hipDeviceGetAttribute(&cus, hipDeviceAttributeMultiprocessorCount, dev) != hipSuccess) { grid = -1; return; }
        if (hipFuncSetAttribute((const void*)mk_fwd, hipFuncAttributeMaxDynamicSharedMemorySize, LDS_BYTES) != hipSuccess) { fprintf(stderr, "kernel_launch: hipFuncSetAttribute failed\n"); grid = -1; return; }
        if (hipOccupancyMaxActiveBlocksPerMultiprocessor(&per_cu, (const void*)mk_fwd, NTHREADS, LDS_BYTES) != hipSuccess || per_cu < 1) { fprintf(stderr, "kernel_launch: occupancy query says %d\n", per_cu); }
        (void)hipGetLastError();
        grid = cus;
    }
    if (grid < 0) return;
    (void)hipMemsetAsync((char*)d_ws + WS_CTL, 0, CTL_ZERO_BYTES, stream);
    Args a{};
    for (int i = 0; i < 19; ++i) a.in[i] = (const float*)d_in[i];
    a.out = (float*)d_out; a.ws = (unsigned char*)d_ws;
    if (MK_N_LAUNCHES == 1) { a.ph_lo = 0; a.ph_hi = NPH; hipLaunchKernelGGL(mk_fwd, dim3(grid), dim3(NTHREADS), LDS_BYTES, stream, a); }
    else for (int p = 0; p < NPH; ++p) { a.ph_lo = p; a.ph_hi = p + 1; hipLaunchKernelGGL(mk_fwd, dim3(grid), dim3(NTHREADS), LDS_BYTES, stream, a); }
}
```

```cpp
#include <hip/hip_runtime.h>
#include <cstdio>
#include <cstdint>
#ifndef MK_N_LAUNCHES
#define MK_N_LAUNCHES 1
#endif
#define DI __device__ __forceinline__
#define GAS __attribute__((address_space(1)))
#define LAS __attribute__((address_space(3)))
typedef unsigned short bf16;
typedef unsigned u32x4 __attribute__((ext_vector_type(4)));
typedef unsigned u32x2 __attribute__((ext_vector_type(2)));
typedef float f32x4 __attribute__((ext_vector_type(4)));
typedef float f32x2 __attribute__((ext_vector_type(2)));
typedef float f32x16 __attribute__((ext_vector_type(16)));
typedef short bf16x8 __attribute__((ext_vector_type(8)));
typedef short s16x4 __attribute__((ext_vector_type(4)));
typedef short v4i16_t __attribute__((ext_vector_type(4)));
typedef __bf16 bf16x2_t __attribute__((ext_vector_type(2)));
typedef GAS unsigned gu32;

constexpr int NTOK = 32768, DM = 1024, SEQ = 2048, NBATCH = 16, NIN = 5632;
constexpr int NWAVES = 8, NTHREADS = 512;
constexpr float LN_EPS = 1e-5f, DN_ALPHA = 1.189207115002721f, LOG2E = 1.4426950408889634f;
constexpr int MOE_MAXTILES = 288;

constexpr size_t MiB = 1u << 20;
constexpr size_t WS_CTL = 0, CTL_ZERO_BYTES = 65536;
constexpr size_t WS_WIN = 1 * MiB, WS_WCAT = 12 * MiB, WS_WO = 14 * MiB;
constexpr size_t WS_XB = 16 * MiB;
constexpr size_t WS_R = 80 * MiB;
constexpr size_t WS_GB = 144 * MiB;
constexpr size_t WS_QH = 208 * MiB;
constexpr size_t WS_VH = 240 * MiB;
constexpr size_t WS_GH = 272 * MiB;
constexpr size_t WS_ZF = 304 * MiB;
constexpr size_t WS_OCAT = 306 * MiB;
constexpr size_t WS_QM = 368 * MiB, WS_KM = 400 * MiB;
constexpr size_t WS_VM = 432 * MiB;
constexpr size_t WS_Y = 16 * MiB;
constexpr size_t WS_MISC = 464 * MiB;
constexpr size_t WS_KMEAN = WS_MISC;
constexpr size_t WS_BPERM = WS_MISC + 1 * MiB;
constexpr size_t WS_WRH = WS_MISC + 2 * MiB;
constexpr size_t WS_WRL = WS_WRH + 98304;
constexpr size_t WS_TOKE = WS_MISC + 3 * MiB;
constexpr size_t WS_TOKW = WS_MISC + 4 * MiB;
constexpr size_t WS_TOKD = WS_MISC + 5 * MiB;
constexpr size_t WS_WGCNT = WS_MISC + 6 * MiB;
constexpr size_t WS_ROWTOK = WS_MISC + 7 * MiB;
constexpr size_t WS_TILEE = WS_MISC + 8 * MiB;
constexpr size_t WS_STATS = WS_MISC + 9 * MiB;
constexpr size_t WS_LB = WS_MISC + 10 * MiB;
constexpr size_t WS_KK = WS_MISC + 12 * MiB;
constexpr size_t WS_END = 512 * MiB;
constexpr int CW_BAR = 4096, CW_QUEUE = 8192, CW_QUEUE2 = 8192 + 1024;

constexpr int LDS_BYTES = 163840, MISC_OFF = LDS_BYTES - 256;

DI unsigned cvtpk(float lo, float hi) { f32x2 v = {lo, hi}; bf16x2_t b = __builtin_convertvector(v, bf16x2_t); return __builtin_bit_cast(unsigned, b); }
DI float bflo(unsigned w) { return __uint_as_float(w << 16); }
DI float bfhi(unsigned w) { return __uint_as_float(w & 0xffff0000u); }
DI float bf2f(unsigned short h) { return __uint_as_float((unsigned)h << 16); }
DI float frcp(float x) { return __builtin_amdgcn_rcpf(x); }
DI float fsigmoid(float x) { return frcp(1.f + __expf(-x)); }
DI float wave_sum(float v) {
#pragma unroll
    for (int o = 1; o < 64; o <<= 1) v += __shfl_xor(v, o);
    return v;
}
typedef int v8i __attribute__((ext_vector_type(8)));
typedef int v4i __attribute__((ext_vector_type(4)));
DI unsigned cvt4_fp8(float a, float b, float c, float d) { a = __builtin_amdgcn_fmed3f(a, -448.f, 448.f); b = __builtin_amdgcn_fmed3f(b, -448.f, 448.f); c = __builtin_amdgcn_fmed3f(c, -448.f, 448.f); d = __builtin_amdgcn_fmed3f(d, -448.f, 448.f);
    int w = 0; w = __builtin_amdgcn_cvt_pk_fp8_f32(a, b, w, false); w = __builtin_amdgcn_cvt_pk_fp8_f32(c, d, w, true); return (unsigned)w; }
DI f32x4 fp8x4_to_f32(unsigned w) { const f32x2 lo = __builtin_amdgcn_cvt_pk_f32_fp8((int)w, false), hi = __builtin_amdgcn_cvt_pk_f32_fp8((int)w, true); return (f32x4){lo[0], lo[1], hi[0], hi[1]}; }
constexpr float FP8_SXI = 8.f, FP8_SX = 8.f, FP8_SW = 32.f, FP8_SH = 4.f, FP8_SO = 4.f, FP8_SU = 32.f, FP8_SY = 64.f;
DI int crow(int r, int hi) { return (r & 3) + 8 * (r >> 2) + 4 * hi; }
#define MFMA32(a, b, c) __builtin_amdgcn_mfma_f32_32x32x16_bf16((a), (b), (c), 0, 0, 0)
#define MFMA16(a, b, c) __builtin_amdgcn_mfma_f32_16x16x32_bf16((a), (b), (c), 0, 0, 0)
DI s16x4 vtr(LAS const char* p) { return __builtin_bit_cast(s16x4, __builtin_amdgcn_ds_read_tr16_b64_v4i16((LAS v4i16_t*)p)); }

#define XB_TMO      128
#define XB_XCNT(j)  (256  + 64 * (j))
#define XB_XSUB(j)  (1280 + 64 * (j))
#define XB_XGEN(j)  (2304 + 64 * (j))
#define XB_TOP      3328
#define XB_TOPGEN   3392
#define XCD_BAR_WORDS 3456
#define XB_SPIN_CAP (1u << 22)
DI unsigned xb_ld(unsigned* p)              { return __hip_atomic_load(p, __ATOMIC_RELAXED, __HIP_MEMORY_SCOPE_AGENT); }
DI unsigned xb_add(unsigned* p, unsigned v) { return __hip_atomic_fetch_add(p, v, __ATOMIC_RELAXED, __HIP_MEMORY_SCOPE_AGENT); }
DI unsigned xb_xcc_id() { return (unsigned)__builtin_amdgcn_s_getreg((3 << 11) | 20) & 0xFu; }
#define XB_SPIN(cond, bar) do { unsigned _sp = 0; while (cond) { __builtin_amdgcn_s_sleep(1); \
    if ((++_sp & 255u) == 0u) { if (xb_ld(&(bar)[XB_TMO])) break; if (_sp > XB_SPIN_CAP) { atomicAdd(&(bar)[XB_TMO], 1u); break; } } } } while (0)
struct XcdBarrier { unsigned* bar; unsigned x; volatile LAS unsigned* st; };
DI XcdBarrier xcd_barrier_post(unsigned* bar, volatile LAS unsigned* st) {
    XcdBarrier b; b.bar = bar; b.x = xb_xcc_id(); b.st = st;
    if (threadIdx.x == 0) (void)xb_add(&bar[XB_XCNT(b.x)], 1u);
    return b;
}
DI void xcd_barrier_complete(unsigned* bar, unsigned x, unsigned& nloc, unsigned& nx) {
    const unsigned G = gridDim.x * gridDim.y * gridDim.z;
    unsigned sum, cnt, mine, sp = 0u;
    for (;;) {
        sum = 0u; cnt = 0u; mine = 0u;
#pragma unroll
        for (unsigned j = 0; j < 16; ++j) { const unsigned c = xb_ld(&bar[XB_XCNT(j)]); sum += c; cnt += (c > 0u) ? 1u : 0u; mine = (j == x) ? c : mine; }
        if (sum == G) break;
        __builtin_amdgcn_s_sleep(1);
        if ((++sp & 255u) == 0u) { if (xb_ld(&bar[XB_TMO])) break; if (sp > XB_SPIN_CAP) { atomicAdd(&bar[XB_TMO], 1u); break; } }
    }
    nloc = mine > 0u ? mine : 1u; nx = cnt > 0u ? cnt : 1u;
}
DI void xcd_barrier(const XcdBarrier& b) {
    asm volatile("s_waitcnt vmcnt(0)" ::: "memory");
    __syncthreads();
    if (threadIdx.x == 0) {
        unsigned* bar = b.bar;
        __builtin_amdgcn_s_waitcnt(0);
        unsigned nloc = b.st[0], nx = b.st[1];
        if (nloc == 0u) { xcd_barrier_complete(bar, b.x, nloc, nx); b.st[0] = nloc; b.st[1] = nx; }
        const unsigned old = xb_add(&bar[XB_XSUB(b.x)], 1u);
        const unsigned gen = old / nloc;
        if (old + 1u == (gen + 1u) * nloc) {
            __builtin_amdgcn_fence(__ATOMIC_RELEASE, "agent");
            asm volatile("s_waitcnt vmcnt(0)" ::: "memory");
            const unsigned og = xb_add(&bar[XB_TOP], 1u);
            const unsigned tg = og / nx;
            if (og + 1u == (tg + 1u) * nx) xb_add(&bar[XB_TOPGEN], 1u);
            else XB_SPIN(xb_ld(&bar[XB_TOPGEN]) == tg, bar);
            __builtin_amdgcn_fence(__ATOMIC_ACQUIRE, "agent");
            xb_add(&bar[XB_XGEN(b.x)], 1u);
            asm volatile("s_waitcnt vmcnt(0)" ::: "memory");
        } else {
            XB_SPIN(xb_ld(&bar[XB_XGEN(b.x)]) == gen, bar);
            __builtin_amdgcn_fence(__ATOMIC_ACQUIRE, "agent");
            asm volatile("s_waitcnt vmcnt(0)" ::: "memory");
        }
    }
    __syncthreads();
}

namespace pg8 {
constexpr int BM = 256, BK = 64, HALF = 128, HTB = HALF * BK * 2, STAGE_BYTES = 8 * HTB, NXCD = 8, WGM = 8;
DI int lds_byte(int r, int c) { const int st = (r >> 4) * 2 + (c >> 5), rr = r & 15, cc = c & 31, ob = rr * 64 + cc * 2; return st * 1024 + (ob ^ (((ob >> 9) & 1) << 5)); }
DI void stage_rc(int b, int& R, int& C) { const int st = b / 1024, sb = b % 1024, swz = sb ^ (((sb >> 9) & 1) << 5); R = (st >> 1) * 16 + swz / 64; C = (st & 1) * 32 + (swz % 64) / 2; }
DI int perm32(int rho) { const int n = rho >> 4, i = rho & 15; return 8 * (i >> 2) + 4 * n + (i & 3); }
struct Unit { int pm, pn, e; };

struct DenseOrder {
    const char* A; const char* Bt; int K, nM, nN, nwg, G, c;
    DI void init(const void* A_, const void* Bt_, int M, int N, int K_, int G_, int c_) { A = (const char*)A_; Bt = (const char*)Bt_; K = K_; nM = M / BM; nN = N / BM; nwg = nM * nN; G = G_; c = c_; }
    DI bool next(int i, Unit& u) const {
        const long L = (long)i * G + c; if (L >= nwg) return false;
        int wgid = (int)L; { const int q = nwg / NXCD, r = nwg % NXCD, xcd = wgid % NXCD, off = wgid / NXCD; wgid = (xcd < r ? xcd * (q + 1) : r * (q + 1) + (xcd - r) * q) + off; }
        const int nig = WGM * nN, gid = wgid / nig, fm = gid * WGM, gsz = (nM - fm) < WGM ? (nM - fm) : WGM;
        u.pm = fm + ((wgid % nig) % gsz); u.pn = (wgid % nig) / gsz; u.e = 0; return true;
    }
    DI const char* a_base(const Unit& u) const { return A + (size_t)u.pm * 512 * K; }
    DI const char* b_base(const Unit& u) const { return Bt + (size_t)u.pn * 512 * K; }
    DI void gather(const Unit&, const int (&)[2], const int (&)[2], unsigned (&)[2][2]) const {}
};
struct MoeOrder {
    const char* A; const char* Bt; const int* row_tok; const int* tile_e; int K, N, nunits, G, c; bool gat;
    DI bool next(int i, Unit& u) const {
        const int L = i * G + c; if (L >= nunits) return false;
        u.pm = L >> 2; u.pn = L & 3;
        u.e = __builtin_amdgcn_readfirstlane(__hip_atomic_load(tile_e + u.pm, __ATOMIC_RELAXED, __HIP_MEMORY_SCOPE_AGENT)); return true;
    }
    DI const char* a_base(const Unit& u) const { return gat ? A : A + (size_t)u.pm * 512 * K; }
    DI const char* b_base(const Unit& u) const { return Bt + ((size_t)u.e * N + (size_t)u.pn * 256) * K * 2; }
    DI void gather(const Unit& u, const int (&Rr)[2], const int (&Cc)[2], unsigned (&o)[2][2]) const {
#pragma unroll
        for (int h = 0; h < 2; ++h)
#pragma unroll
            for (int i = 0; i < 2; ++i) { const int tok = row_tok[u.pm * 256 + h * 128 + Rr[i]]; o[h][i] = (unsigned)(tok * K + Cc[i]) * 2u; }
    }
};

template <class Epi, class Sched, bool GATHER, bool FP8 = false>
DI void gemm_phase(LAS unsigned char* lds, const int K, const Sched& S, const Epi& E) {
    const int tid = threadIdx.x, wid = __builtin_amdgcn_readfirstlane(tid >> 6), lane = tid & 63, wr = wid >> 2, wc = wid & 3, fr = lane & 15, fq = lane >> 4;
    const int nt = K / BK;
    unsigned voffB[2], vA[2][2], nvA[2][2]; int Rr[2], Cc[2];
#pragma unroll
    for (int i = 0; i < 2; ++i) { int R, C; stage_rc(tid * 16 + i * 8192, R, C); Rr[i] = R; Cc[i] = C; const int Rb = (R & ~31) + perm32(R & 31);
        voffB[i] = (unsigned)(Rb * K + C) * 2u; vA[0][i] = (unsigned)(R * K + C) * 2u; vA[1][i] = (unsigned)((R + HALF) * K + C) * 2u; nvA[0][i] = vA[0][i]; nvA[1][i] = vA[1][i]; }
    const size_t kstep = (size_t)(BK * 2);
    const size_t hstep = (size_t)HALF * K * 2;
    const unsigned ldsw = (unsigned)wid * 1024u;
    const int aoff = lds_byte(wr * 64 + fr, fq * 8), boff = lds_byte(wc * 32 + fr, fq * 8);
#define PG8_SA(b, h) (((b) * 2 + (h)) * HTB)
#define PG8_SB(b, h) ((4 + (b) * 2 + (h)) * HTB)
#define PG8_STAGE(bufoff, gbase, voff) do { _Pragma("unroll") for (int _i = 0; _i < 2; ++_i) \
        __builtin_amdgcn_global_load_lds((const unsigned*)((const char*)(gbase) + (voff)[_i]), (LAS unsigned*)(lds + (bufoff) + ldsw + _i * 8192), 16, 0, 0); } while (0)
#define PG8_LDA(dst, b, h) do { if constexpr (FP8) { _Pragma("unroll") for (int m = 0; m < 4; ++m) dst##8[m] = __builtin_shufflevector(*(const LAS v4i*)(lds + PG8_SA(b, h) + aoff + m * 2048), *(const LAS v4i*)(lds + PG8_SA(b, h) + aoff + m * 2048 + 1024), 0, 1, 2, 3, 4, 5, 6, 7); } \
        else { _Pragma("unroll") for (int m = 0; m < 4; ++m) _Pragma("unroll") for (int k = 0; k < 2; ++k) dst[m][k] = *(const LAS bf16x8*)(lds + PG8_SA(b, h) + aoff + m * 2048 + k * 1024); } } while (0)
#define PG8_LDB(dst, b, h) do { if constexpr (FP8) { _Pragma("unroll") for (int n = 0; n < 2; ++n) dst##8[n] = __builtin_shufflevector(*(const LAS v4i*)(lds + PG8_SB(b, h) + boff + n * 2048), *(const LAS v4i*)(lds + PG8_SB(b, h) + boff + n * 2048 + 1024), 0, 1, 2, 3, 4, 5, 6, 7); } \
        else { _Pragma("unroll") for (int n = 0; n < 2; ++n) _Pragma("unroll") for (int k = 0; k < 2; ++k) dst[n][k] = *(const LAS bf16x8*)(lds + PG8_SB(b, h) + boff + n * 2048 + k * 1024); } } while (0)
#define PG8_CAT(x, y) __builtin_shufflevector(__builtin_bit_cast(v4i, (x)), __builtin_bit_cast(v4i, (y)), 0, 1, 2, 3, 4, 5, 6, 7)
#define PG8_MMA(ai, bj, At, Bt) do { __builtin_amdgcn_s_setprio(1); if constexpr (FP8) { _Pragma("unroll") for (int m = 0; m < 4; ++m) _Pragma("unroll") for (int n = 0; n < 2; ++n) \
        asm volatile("v_mfma_scale_f32_16x16x128_f8f6f4 %0, %1, %2, %0, %3, %3 op_sel_hi:[0,0,0]" : "+v"(acc[ai][bj][m][n]) : "v"(Bt##8[n]), "v"(At##8[m]), "v"(fp8_unit_scale)); } else { \
        _Pragma("unroll") for (int m = 0; m < 4; ++m) _Pragma("unroll") for (int n = 0; n < 2; ++n) _Pragma("unroll") for (int k = 0; k < 2; ++k) \
        acc[ai][bj][m][n] = __builtin_amdgcn_mfma_f32_16x16x32_bf16(Bt[n][k], At[m][k], acc[ai][bj][m][n], 0, 0, 0); } __builtin_amdgcn_s_setprio(0); } while (0)
#define PG8_WAIT_V(n) asm volatile("s_waitcnt vmcnt(" #n ")" ::: "memory")
#define PG8_WAIT_L(n) asm volatile("s_waitcnt lgkmcnt(" #n ")" ::: "memory")
#define PG8_BAR __builtin_amdgcn_s_barrier()
#define PG8_SCHED __builtin_amdgcn_sched_barrier(0)
    Unit cur, nxt; int ui = 0;
    if (!S.next(0, cur)) return;
    if constexpr (GATHER) S.gather(cur, Rr, Cc, vA);
    f32x4 acc[2][2][4][2];
#pragma unroll
    for (int a = 0; a < 2; ++a)
#pragma unroll
        for (int b = 0; b < 2; ++b)
#pragma unroll
            for (int m = 0; m < 4; ++m)
#pragma unroll
                for (int n = 0; n < 2; ++n) acc[a][b][m][n] = (f32x4){0.f, 0.f, 0.f, 0.f};
    bf16x8 At[4][2], B0[2][2], B1[2][2]; v8i At8[4], B08[2], B18[2]; const int fp8_unit_scale = 0x7f7f7f7f;
    const char* cA = S.a_base(cur); const char* cB = S.b_base(cur);
    PG8_STAGE(PG8_SB(0, 0), cB, voffB); PG8_STAGE(PG8_SB(0, 1), cB + hstep, voffB); PG8_STAGE(PG8_SA(0, 0), cA, vA[0]); PG8_STAGE(PG8_SA(0, 1), cA, vA[1]);
    if (wr == 1) PG8_BAR;
    PG8_WAIT_V(2); PG8_BAR;
    PG8_STAGE(PG8_SB(1, 0), cB + kstep, voffB); PG8_STAGE(PG8_SA(1, 0), cA + kstep, vA[0]); PG8_STAGE(PG8_SB(1, 1), cB + hstep + kstep, voffB);
    PG8_WAIT_V(6); PG8_BAR;
    for (;;) {
        const bool has_next = S.next(ui + 1, nxt);
        const char* nA = has_next ? S.a_base(nxt) : cA; const char* nB = has_next ? S.b_base(nxt) : cB;
        if constexpr (GATHER) {
            if (has_next) S.gather(nxt, Rr, Cc, nvA);
            else {
#pragma unroll
                for (int h = 0; h < 2; ++h) { nvA[h][0] = vA[h][0]; nvA[h][1] = vA[h][1]; } }
        }
#pragma unroll 1
        for (int t = 0; t < nt; t += 2) {
            const bool last = (t == nt - 2);
            if constexpr (Epi::HAS_MID) { if (t == (nt >> 1)) { if constexpr (FP8) asm volatile("s_nop 15\n\ts_nop 15" ::: "memory"); E.mid(acc, cur, wr, wc, fr, fq); if constexpr (FP8) asm volatile("s_nop 7" ::: "memory"); } }
            const char* a1 = cA + (size_t)(t + 1) * kstep;
            const char* a2 = last ? nA : cA + (size_t)(t + 2) * kstep; const char* b2 = last ? nB : cB + (size_t)(t + 2) * kstep;
            const char* a3 = a2 + kstep; const char* b3 = b2 + kstep;
            unsigned o0[2], o1[2];
            if constexpr (GATHER) { o0[0] = last ? nvA[0][0] : vA[0][0]; o0[1] = last ? nvA[0][1] : vA[0][1]; o1[0] = last ? nvA[1][0] : vA[1][0]; o1[1] = last ? nvA[1][1] : vA[1][1]; }
            else { o0[0] = vA[0][0]; o0[1] = vA[0][1]; o1[0] = vA[1][0]; o1[1] = vA[1][1]; }
            PG8_LDB(B0, 0, 0); PG8_LDB(B1, 0, 1); PG8_SCHED; PG8_LDA(At, 0, 0); PG8_STAGE(PG8_SA(1, 1), a1, vA[1]);
            PG8_WAIT_V(8); PG8_WAIT_L(0); PG8_BAR; PG8_MMA(0, 0, At, B0); PG8_MMA(0, 1, At, B1); PG8_BAR; PG8_SCHED;
            PG8_LDA(At, 0, 1); PG8_STAGE(PG8_SB(0, 0), b2, voffB); PG8_STAGE(PG8_SB(0, 1), b2 + hstep, voffB); PG8_STAGE(PG8_SA(0, 0), a2, o0);
            PG8_WAIT_V(8); PG8_WAIT_L(0); PG8_BAR; PG8_MMA(1, 0, At, B0); PG8_MMA(1, 1, At, B1); PG8_BAR; PG8_SCHED;
            PG8_LDB(B0, 1, 0); PG8_LDB(B1, 1, 1); PG8_SCHED; PG8_LDA(At, 1, 0); PG8_STAGE(PG8_SA(0, 1), a2, o1);
            PG8_WAIT_V(8); PG8_WAIT_L(0); PG8_BAR; PG8_MMA(0, 0, At, B0); PG8_MMA(0, 1, At, B1); PG8_BAR; PG8_SCHED;
            PG8_LDA(At, 1, 1); PG8_STAGE(PG8_SB(1, 0), b3, voffB); PG8_STAGE(PG8_SB(1, 1), b3 + hstep, voffB); PG8_STAGE(PG8_SA(1, 0), a3, o0);
            PG8_WAIT_V(8); PG8_WAIT_L(0); PG8_BAR; PG8_MMA(1, 0, At, B0); PG8_MMA(1, 1, At, B1); PG8_BAR; PG8_SCHED;
        }
        if (wr == 0) PG8_BAR;
        if constexpr (FP8) asm volatile("s_nop 15\n\ts_nop 15" ::: "memory");
        E(acc, cur, wr, wc, fr, fq);
        if (!has_next) break;
#pragma unroll
        for (int a = 0; a < 2; ++a)
#pragma unroll
            for (int b = 0; b < 2; ++b)
#pragma unroll
                for (int m = 0; m < 4; ++m)
#pragma unroll
                    for (int n = 0; n < 2; ++n) acc[a][b][m][n] = (f32x4){0.f, 0.f, 0.f, 0.f};
        cur = nxt; cA = nA; cB = nB; ++ui;
        if constexpr (GATHER) {
#pragma unroll
            for (int h = 0; h < 2; ++h) { vA[h][0] = nvA[h][0]; vA[h][1] = nvA[h][1]; } }
        if (wr == 1) PG8_BAR;
    }
    PG8_WAIT_V(0);
    PG8_BAR;
#undef PG8_SA
#undef PG8_SB
#undef PG8_STAGE
#undef PG8_LDA
#undef PG8_LDB
#undef PG8_MMA
#undef PG8_CAT
#undef PG8_WAIT_V
#undef PG8_WAIT_L
#undef PG8_BAR
#undef PG8_SCHED
}

typedef f32x4 Acc[2][2][4][2];
DI u32x4 pack8(const f32x4 a, const f32x4 b) { u32x4 w; w.x = cvtpk(a[0], a[1]); w.y = cvtpk(a[2], a[3]); w.z = cvtpk(b[0], b[1]); w.w = cvtpk(b[2], b[3]); return w; }
DI f32x4 silu4(const f32x4 v) { f32x4 o; o[0] = v[0] * fsigmoid(v[0]); o[1] = v[1] * fsigmoid(v[1]); o[2] = v[2] * fsigmoid(v[2]); o[3] = v[3] * fsigmoid(v[3]); return o; }

struct EpiIn {
    static constexpr bool HAS_MID = false;
    bf16 *Qh, *Vh, *Gh, *Qm, *Km, *Vm, *Rr, *Gb; float *Zf, *KM; const float* bias; bf16* KK; const float* LB; int pn_off;
    DI void operator()(Acc& acc, const Unit& u, int wr, int wc, int fr, int fq) const {
        const int pn = u.pn + pn_off, row0 = u.pm * BM + wr * 64 + fr, cl = wc * 32 + 8 * fq;
        if (pn_off) {
#pragma unroll
            for (int ai = 0; ai < 2; ++ai)
#pragma unroll
                for (int bj = 0; bj < 2; ++bj)
#pragma unroll
                    for (int m = 0; m < 4; ++m) { acc[ai][bj][m][0] *= (1.f / (FP8_SXI * FP8_SW)); acc[ai][bj][m][1] *= (1.f / (FP8_SXI * FP8_SW)); } }
        f32x4 bv[2][2];
#pragma unroll
        for (int bj = 0; bj < 2; ++bj)
#pragma unroll
            for (int n = 0; n < 2; ++n) bv[bj][n] = *(const f32x4*)(bias + pn * 256 + bj * HALF + cl + 4 * n);
        if (pn < 4) {
#define EI_DPP(v, ctrl) __int_as_float(__builtin_amdgcn_update_dpp(0, __float_as_int(v), ctrl, 0xf, 0xf, true))
            const int chb = pn * 128 + cl;
#pragma unroll
            for (int ai = 0; ai < 2; ++ai)
#pragma unroll
                for (int n = 0; n < 2; ++n) { const f32x4 lbv = *(const f32x4*)(LB + chb + 4 * n); f32x4 run = (f32x4){0.f, 0.f, 0.f, 0.f}, bmid = run; f32x4 bbv[4], kkv[4];
#pragma unroll
                    for (int m = 0; m < 4; ++m) {
#pragma unroll
                        for (int j = 0; j < 4; ++j) { const float z = acc[ai][1][m][n][j] + bv[1][n][j]; const float sg = frcp(1.f + __expf(-z)); const float lf = __logf(lbv[j] + (1.f - lbv[j]) * sg); kkv[m][j] = (1.f - lbv[j]) * (1.f - sg);
                            float t = lf; t += EI_DPP(t, 0xB1); t += EI_DPP(t, 0x4E); t += EI_DPP(t, 0x141); t += EI_DPP(t, 0x140);
                            float s = lf; s += EI_DPP(s, 0x111); s += EI_DPP(s, 0x112); s += EI_DPP(s, 0x114); s += EI_DPP(s, 0x118);
                            bbv[m][j] = s + run[j]; run[j] += t; }
                        if (m == 1) bmid = run; }
#pragma unroll
                    for (int m = 0; m < 4; ++m) { f32x4 qp, kp;
#pragma unroll
                        for (int j = 0; j < 4; ++j) { const float qx = acc[ai][0][m][n][j] + bv[0][n][j]; const float e = __expf(__builtin_amdgcn_fmed3f(bbv[m][j] - bmid[j], -60.f, 60.f)); qp[j] = qx * fsigmoid(qx) * e; kp[j] = kkv[m][j] * frcp(e); }
                        const size_t ro = (size_t)(row0 + ai * HALF + m * 16) * 512 + chb + 4 * n;
                        u32x2 qw, kw; qw.x = cvtpk(qp[0], qp[1]); qw.y = cvtpk(qp[2], qp[3]); kw.x = cvtpk(kp[0], kp[1]); kw.y = cvtpk(kp[2], kp[3]);
                        *(u32x2*)(Qh + ro) = qw; *(u32x2*)(KK + ro) = kw; }
                    if (fr == 0) { const size_t so = (size_t)(u.pm * 4 + ai * 2 + wr) * 512 + chb + 4 * n; *(f32x4*)(Zf + so) = bmid; *(f32x4*)(Zf + 262144 + so) = run; }
                    asm volatile("" ::: "memory"); }
#undef EI_DPP
        } else if (pn < 14) {
            const int seg = pn >> 1, c0 = (pn & 1) * 256 + cl;
            {
                bf16* O = seg == 2 ? Vh : seg == 3 ? Gh : seg == 4 ? Qm : seg == 5 ? Km : Vm;
                const int act = (seg == 3) ? 1 : (seg == 4 ? 2 : 0);
                if (seg == 5) {
#pragma unroll
                    for (int bj = 0; bj < 2; ++bj)
#pragma unroll
                        for (int n = 0; n < 2; ++n) { f32x4 cs = (f32x4){0.f, 0.f, 0.f, 0.f};
#pragma unroll
                            for (int ai = 0; ai < 2; ++ai)
#pragma unroll
                                for (int m = 0; m < 4; ++m) cs += acc[ai][bj][m][n] + bv[bj][n];
#pragma unroll
                            for (int j = 0; j < 4; ++j) { float s = cs[j]; s += __shfl_xor(s, 1); s += __shfl_xor(s, 2); s += __shfl_xor(s, 4); s += __shfl_xor(s, 8); cs[j] = s; }
                            if (fr == 0) *(f32x4*)(KM + (size_t)(u.pm * 2 + wr) * 512 + c0 + bj * HALF + 4 * n) = cs; }
                }
#pragma unroll
                for (int ai = 0; ai < 2; ++ai)
#pragma unroll
                    for (int m = 0; m < 4; ++m) { const int row = row0 + ai * HALF + m * 16;
                        bf16* rp = (seg >= 4) ? O + ((size_t)(row >> 11) * 8 * SEQ + (row & (SEQ - 1))) * 64 + (size_t)(c0 >> 6) * SEQ * 64 + (c0 & 63) : O + (size_t)row * 512 + c0;
                        const size_t bjs = (seg >= 4) ? (size_t)2 * SEQ * 64 : (size_t)HALF;
#pragma unroll
                        for (int bj = 0; bj < 2; ++bj) { f32x4 v0 = acc[ai][bj][m][0] + bv[bj][0], v1 = acc[ai][bj][m][1] + bv[bj][1];
                            if (act == 1) { v0 = silu4(v0); v1 = silu4(v1); } else if (act == 2) { v0 = v0 * (0.125f * LOG2E); v1 = v1 * (0.125f * LOG2E); }
                            *(u32x4*)(rp + bj * bjs) = pack8(v0, v1); }
                        asm volatile("" ::: "memory"); }
            }
        } else {
            const int c0 = (pn - 14) * 128 + cl;
#pragma unroll
            for (int ai = 0; ai < 2; ++ai)
#pragma unroll
                for (int m = 0; m < 4; ++m) { const size_t off = (size_t)(row0 + ai * HALF + m * 16) * 1024 + c0; f32x4 r[2], g[2];
#pragma unroll
                    for (int n = 0; n < 2; ++n) { const f32x4 a = acc[ai][0][m][n] + bv[0][n], b = acc[ai][1][m][n] + bv[1][n];
#pragma unroll
                        for (int j = 0; j < 4; ++j) { const float ea = __expf(-a[j]), eb = __expf(-b[j]); g[n][j] = frcp(1.f + eb); r[n][j] = (1.f + eb) * frcp(1.f + ea); } }
                    *(u32x4*)(Rr + off) = pack8(r[0], r[1]); *(u32x4*)(Gb + off) = pack8(g[0], g[1]); asm volatile("" ::: "memory"); }
        }
    }
};
struct EpiProj {
    static constexpr bool HAS_MID = true;
    const bf16 *Rr, *Gb; unsigned char* U;
    DI void scale(Acc& acc, const bf16* G, const Unit& u, int wr, int wc, int fr, int fq) const {
        int row0 = u.pm * BM + wr * 64 + fr, col0 = u.pn * BM + wc * 32 + 8 * fq;
        asm volatile("" : "+v"(row0), "+v"(col0));
#pragma unroll
        for (int ai = 0; ai < 2; ++ai)
#pragma unroll
            for (int mp = 0; mp < 2; ++mp) { u32x4 rv[2][2];
#pragma unroll
            for (int m = 0; m < 2; ++m)
#pragma unroll
                for (int bj = 0; bj < 2; ++bj) rv[m][bj] = *(const u32x4*)(G + (size_t)(row0 + ai * HALF + (2 * mp + m) * 16) * 1024 + col0 + bj * HALF);
#pragma unroll
            for (int m = 0; m < 2; ++m)
#pragma unroll
                for (int bj = 0; bj < 2; ++bj) { const u32x4 w = rv[m][bj];
                    acc[ai][bj][2 * mp + m][0] *= (f32x4){bflo(w.x), bfhi(w.x), bflo(w.y), bfhi(w.y)}; acc[ai][bj][2 * mp + m][1] *= (f32x4){bflo(w.z), bfhi(w.z), bflo(w.w), bfhi(w.w)}; }
            asm volatile("" ::: "memory"); }
    }
    DI void mid(Acc& acc, const Unit& u, int wr, int wc, int fr, int fq) const { scale(acc, Rr, u, wr, wc, fr, fq); }
    DI void operator()(Acc& acc, const Unit& u, int wr, int wc, int fr, int fq) const {
        scale(acc, Gb, u, wr, wc, fr, fq);
        const int row0 = u.pm * BM + wr * 64 + fr, col0 = u.pn * BM + wc * 32 + 8 * fq;
        constexpr float inv = FP8_SU / (FP8_SO * FP8_SW);
#pragma unroll
        for (int ai = 0; ai < 2; ++ai)
#pragma unroll
            for (int m = 0; m < 4; ++m) { unsigned char* rp = U + (size_t)(row0 + ai * HALF + m * 16) * 1024 + col0;
#pragma unroll
                for (int bj = 0; bj < 2; ++bj) { const f32x4 v0 = acc[ai][bj][m][0] * inv, v1 = acc[ai][bj][m][1] * inv; u32x2 w; w.x = cvt4_fp8(v0[0], v0[1], v0[2], v0[3]); w.y = cvt4_fp8(v1[0], v1[1], v1[2], v1[3]); *(u32x2*)(rp + bj * HALF) = w; } }
    }
};
struct EpiOut {
    static constexpr bool HAS_MID = false;
    const bf16* X; bf16* Pre;
    DI void operator()(Acc& acc, const Unit& u, int wr, int wc, int fr, int fq) const {
        int row0 = u.pm * BM + wr * 64 + fr, col0 = u.pn * BM + wc * 32 + 8 * fq;
        asm volatile("" : "+v"(row0), "+v"(col0));
        constexpr float inv = 1.f / (FP8_SU * FP8_SW);
#pragma unroll
        for (int ai = 0; ai < 2; ++ai) { u32x4 xv[4][2];
#pragma unroll
            for (int m = 0; m < 4; ++m)
#pragma unroll
                for (int bj = 0; bj < 2; ++bj) xv[m][bj] = *(const u32x4*)(X + (size_t)(row0 + ai * HALF + m * 16) * 1024 + col0 + bj * HALF);
#pragma unroll
            for (int m = 0; m < 4; ++m)
#pragma unroll
                for (int bj = 0; bj < 2; ++bj) { const u32x4 w = xv[m][bj];
                    const f32x4 v0 = (f32x4){bflo(w.x), bfhi(w.x), bflo(w.y), bfhi(w.y)} * DN_ALPHA + acc[ai][bj][m][0] * inv, v1 = (f32x4){bflo(w.z), bfhi(w.z), bflo(w.w), bfhi(w.w)} * DN_ALPHA + acc[ai][bj][m][1] * inv;
                    *(u32x4*)(Pre + (size_t)(row0 + ai * HALF + m * 16) * 1024 + col0 + bj * HALF) = pack8(v0, v1); }
            asm volatile("" ::: "memory"); }
    }
};
struct EpiM1 {
    static constexpr bool HAS_MID = false;
    unsigned char* H;
    DI void operator()(Acc& acc, const Unit& u, int wr, int wc, int fr, int fq) const {
        const int row0 = u.pm * BM + wr * 64 + fr, col0 = u.pn * 128 + wc * 32 + 8 * fq;
        constexpr float inv = 1.f / (FP8_SX * FP8_SW);
#pragma unroll
        for (int ai = 0; ai < 2; ++ai)
#pragma unroll
            for (int m = 0; m < 4; ++m) { const f32x4 h0 = silu4(acc[ai][0][m][0] * inv) * (acc[ai][1][m][0] * (inv * FP8_SH)), h1 = silu4(acc[ai][0][m][1] * inv) * (acc[ai][1][m][1] * (inv * FP8_SH));
                u32x2 w; w.x = cvt4_fp8(h0[0], h0[1], h0[2], h0[3]); w.y = cvt4_fp8(h1[0], h1[1], h1[2], h1[3]);
                *(u32x2*)(H + (size_t)(row0 + ai * HALF + m * 16) * 512 + col0) = w; }
    }
};
struct EpiM2 {
    static constexpr bool HAS_MID = false;
    unsigned char* Y;
    DI void operator()(Acc& acc, const Unit& u, int wr, int wc, int fr, int fq) const {
        const int row0 = u.pm * BM + wr * 64 + fr, col0 = u.pn * BM + wc * 32 + 8 * fq;
        constexpr float inv = FP8_SY / (FP8_SH * FP8_SW);
#pragma unroll
        for (int ai = 0; ai < 2; ++ai)
#pragma unroll
            for (int m = 0; m < 4; ++m) { unsigned char* rp = Y + (size_t)(row0 + ai * HALF + m * 16) * 1024 + col0;
#pragma unroll
                for (int bj = 0; bj < 2; ++bj) { const f32x4 v0 = acc[ai][bj][m][0] * inv, v1 = acc[ai][bj][m][1] * inv; u32x2 w; w.x = cvt4_fp8(v0[0], v0[1], v0[2], v0[3]); w.y = cvt4_fp8(v1[0], v1[1], v1[2], v1[3]); *(u32x2*)(rp + bj * HALF) = w; } }
    }
};
}

struct Args { const float* in[19]; float* out; unsigned char* ws; int ph_lo, ph_hi; };
enum { I_X = 0, I_WIN, I_BIN, I_LBL, I_HGNG, I_RELB, I_WPA, I_WPB, I_WOUT, I_LN1G, I_LN1B, I_WGRP, I_BGRP, I_WEXP, I_BEXP, I_WGU, I_WDN, I_LN2G, I_LN2B };

struct Ctx {
    LAS unsigned char* lds; volatile LAS unsigned* MISC;
    int tid, lane, wid, G, vcu;
    unsigned char* ws; gu32* ctl;
};

DI int win_drow(int n0) { if (n0 < 512) return 256 * (n0 >> 7) + (n0 & 127); if (n0 < 1024) { const int r = n0 - 512; return 256 * (r >> 7) + 128 + (r & 127); }
    if (n0 < 3584) return n0; if (n0 < 4608) { const int r = n0 - 3584; return 3584 + 256 * (r >> 7) + (r & 127); } const int r = n0 - 4608; return 3584 + 256 * (r >> 7) + 128 + (r & 127); }
DI int wgu_drow(int n0) { if (n0 < 512) return 256 * (n0 >> 7) + (n0 & 127); const int r = n0 - 512; return 256 * (r >> 7) + 128 + (r & 127); }
DI int hswz(int row, int ch16) { return 256 * row + 16 * (ch16 ^ (((row & 3) << 2) | ((row >> 2) & 3))); }
DI int htr(int r0, int c0, int lane) { const int i16 = lane & 15, q = i16 >> 2, p = i16 & 3; return hswz(r0 + q, c0 + (p >> 1)) + 8 * (p & 1); }
DI void transpose_tile256(const float* W, int N, bf16* WT, int ldk, int n0, int mode, int dk, LAS unsigned char* lds, int lane, int wid, bool f8 = false) {
    asm volatile("" : "+v"(lane));
#pragma unroll
    for (int half = 0; half < 2; ++half) { f32x4 v[16];
#pragma unroll
        for (int i = 0; i < 16; ++i) v[i] = *(const f32x4*)(W + (size_t)(128 * half + 8 * i + wid) * N + 4 * lane);
#pragma unroll
        for (int i = 0; i < 16; ++i) { const int k = 128 * half + 8 * i + wid; u32x2 w; w.x = cvtpk(v[i][0], v[i][1]); w.y = cvtpk(v[i][2], v[i][3]);
            *(LAS u32x2*)(lds + (lane >> 5) * 65536 + hswz(k, (lane & 31) >> 1) + 8 * (lane & 1)) = w; } }
    __syncthreads();
    const int g = lane >> 4, i16 = lane & 15;
#pragma unroll
    for (int nb = 0; nb < 2; ++nb) { const int nl = 32 * wid + 16 * nb + i16, n = n0 + nl; const int dr = (mode == 0) ? n : (mode == 1 ? win_drow(n) : wgu_drow(n));
        bf16* orow = WT + (size_t)dr * ldk + dk + 8 * g; const LAS unsigned char* img = lds + (wid >> 2) * 65536;
#pragma unroll
        for (int s = 0; s < 8; ++s) { const int r0 = 32 * s + 8 * g, c0 = 4 * (wid & 3) + 2 * nb;
            const s16x4 lo = vtr((LAS const char*)(img + htr(r0, c0, lane))), hh = vtr((LAS const char*)(img + htr(r0 + 4, c0, lane)));
            if (f8) { u32x2 w; w.x = cvt4_fp8(bf2f((unsigned short)lo[0]) * FP8_SW, bf2f((unsigned short)lo[1]) * FP8_SW, bf2f((unsigned short)lo[2]) * FP8_SW, bf2f((unsigned short)lo[3]) * FP8_SW);
                w.y = cvt4_fp8(bf2f((unsigned short)hh[0]) * FP8_SW, bf2f((unsigned short)hh[1]) * FP8_SW, bf2f((unsigned short)hh[2]) * FP8_SW, bf2f((unsigned short)hh[3]) * FP8_SW);
                *(u32x2*)((unsigned char*)WT + (size_t)dr * ldk + dk + 8 * g + 32 * s) = w; }
            else *(bf16x8*)(orow + 32 * s) = (bf16x8){lo[0], lo[1], lo[2], lo[3], hh[0], hh[1], hh[2], hh[3]}; } }
    __syncthreads();
}
constexpr int MOE_CVT_TILES = 32 * 16 + 32 * 8;
DI void moe_cvt_tile(const Ctx& C, const Args& a, int it) {
    unsigned char* WguT = (unsigned char*)a.out; unsigned char* WdT = (unsigned char*)a.out + 32 * MiB;
    if (it < 512) { const int e = it >> 4, kt = (it >> 2) & 3, nt = it & 3;
        transpose_tile256(a.in[I_WGU] + (size_t)e * 1024 * 1024 + (size_t)(256 * kt) * 1024 + 256 * nt, 1024, (bf16*)(WguT + (size_t)e * 1024 * 1024), 1024, 256 * nt, 2, 256 * kt, C.lds, C.lane, C.wid, true); }
    else { const int r = it - 512, e = r >> 3, kt = (r >> 2) & 1, nt = r & 3;
        transpose_tile256(a.in[I_WDN] + (size_t)e * 512 * 1024 + (size_t)(256 * kt) * 1024 + 256 * nt, 1024, (bf16*)(WdT + (size_t)e * 1024 * 512), 512, 256 * nt, 0, 256 * kt, C.lds, C.lane, C.wid, true); }
}
DI void p0_prologue(const Ctx& C, const Args& a) {
    bf16* WinT = (bf16*)(C.ws + WS_WIN); bf16* Wcat = (bf16*)(C.ws + WS_WCAT); bf16* WoT = (bf16*)(C.ws + WS_WO);
    constexpr int I_IN = 4 * 22, I_PA = 2 * 4, I_O = 4 * 4, NITEMS = I_IN + 2 * I_PA + I_O;
    for (int it = C.vcu; it < NITEMS; it += C.G) {
        int r = it;
        if (r < I_IN) { const int kt = r / 22, nt = r % 22;
            if (nt < 4) transpose_tile256(a.in[I_WIN] + (size_t)(256 * kt) * NIN + 256 * nt, NIN, WinT, 1024, 256 * nt, 1, 256 * kt, C.lds, C.lane, C.wid);
            else transpose_tile256(a.in[I_WIN] + (size_t)(256 * kt) * NIN + 256 * nt, NIN, (bf16*)(C.ws + WS_WIN + 2 * MiB - (size_t)1024 * 1024), 1024, 256 * nt, 1, 256 * kt, C.lds, C.lane, C.wid, true);
            continue; } r -= I_IN;
        if (r < I_PA) { const int kt = r / 4, nt = r % 4; transpose_tile256(a.in[I_WPA] + (size_t)(256 * kt) * 1024 + 256 * nt, 1024, Wcat, 1024, 256 * nt, 0, 256 * kt, C.lds, C.lane, C.wid, true); continue; } r -= I_PA;
        if (r < I_PA) { const int kt = r / 4, nt = r % 4; transpose_tile256(a.in[I_WPB] + (size_t)(256 * kt) * 1024 + 256 * nt, 1024, Wcat, 1024, 256 * nt, 0, 512 + 256 * kt, C.lds, C.lane, C.wid, true); continue; } r -= I_PA;
        { const int kt = r / 4, nt = r % 4; transpose_tile256(a.in[I_WOUT] + (size_t)(256 * kt) * 1024 + 256 * nt, 1024, WoT, 1024, 256 * nt, 0, 256 * kt, C.lds, C.lane, C.wid, true); }
    }
    const int gw = C.vcu * NWAVES + C.wid, NGW = C.G * NWAVES; (void)gw; (void)NGW;
    const int gt = C.vcu * NTHREADS + C.tid, NT = C.G * NTHREADS;
    { const float* x = a.in[I_X]; bf16* Xb = (bf16*)(C.ws + WS_XB);
      unsigned char* Xq = (unsigned char*)a.out + 64 * MiB;
      for (int i = gt; i < NTOK * DM / 8; i += NT) { const f32x4 v0 = *(const f32x4*)(x + (size_t)i * 8), v1 = *(const f32x4*)(x + (size_t)i * 8 + 4); *(u32x4*)(Xb + (size_t)i * 8) = pg8::pack8(v0, v1);
          u32x2 q; q.x = cvt4_fp8(v0[0] * FP8_SXI, v0[1] * FP8_SXI, v0[2] * FP8_SXI, v0[3] * FP8_SXI); q.y = cvt4_fp8(v1[0] * FP8_SXI, v1[1] * FP8_SXI, v1[2] * FP8_SXI, v1[3] * FP8_SXI); *(u32x2*)(Xq + (size_t)i * 8) = q; } }
    { float* lbp = (float*)(C.ws + WS_LB); for (int n = gt; n < 512; n += NT) lbp[n] = 1.f / (1.f + expf(a.in[I_LBL][512 + n] - a.in[I_LBL][n])); }
    { float* bp = (float*)(C.ws + WS_BPERM); const float* bin = a.in[I_BIN];
      for (int n = gt; n < NIN; n += NT) bp[win_drow(n & ~31) + (n & 31)] = bin[n]; }
    { bf16* wh = (bf16*)(C.ws + WS_WRH); bf16* wl = (bf16*)(C.ws + WS_WRL); const float* wg = a.in[I_WGRP]; const float* we = a.in[I_WEXP];
      for (int i = gt; i < 48 * 1024; i += NT) { const int j = i >> 10, k = i & 1023; float w = 0.f; if (j < 4) w = wg[k * 4 + j]; else if (j < 36) w = we[k * 32 + (j - 4)];
          const unsigned h = cvtpk(w, 0.f) & 0xffffu; const float r = w - bf2f((unsigned short)h); wh[i] = (bf16)h; wl[i] = (bf16)(cvtpk(r, 0.f) & 0xffffu); } }
}
constexpr int HG_BUF = 67072, HG_QP = 0, HG_KP = 16384, HG_V = 32768, HG_SC = 49152, HG_OB = 49664;
DI void hgrn_unit(const Ctx& C, const Args& a, int b, int h) {
    LAS unsigned char* L = C.lds;
    const int tid = C.tid, lane = C.lane, wid = C.wid;
    const int q32 = lane & 31, hi = lane >> 5, dh = (lane >> 4) & 1, dvb = wid & 3, tb = wid >> 2;
    const float* BM = (const float*)(C.ws + WS_ZF); const float* BE = BM + 262144;
    const bf16* Qh = (const bf16*)(C.ws + WS_QH); const bf16* Kh = (const bf16*)(C.ws + WS_KK); const bf16* Vh = (const bf16*)(C.ws + WS_VH); const bf16* Gh = (const bf16*)(C.ws + WS_GH);
    bf16* Ocat = (bf16*)(C.ws + WS_OCAT);
    const size_t rb = (size_t)b * SEQ;
    LAS float* NGS = (LAS float*)(L + 2 * HG_BUF);
    if (tid < 128) NGS[tid] = a.in[I_HGNG][h * 128 + tid];
    const int orow = tid >> 3, oseg = tid & 7;
    f32x16 T[4];
#pragma unroll
    for (int i = 0; i < 4; ++i)
#pragma unroll
        for (int r = 0; r < 16; ++r) T[i][r] = 0.f;
    u32x4 gr[2];
    const int drow = 8 * wid + (lane >> 4), dch = lane & 15;
#define HG_DMA(c) do { _Pragma("unroll") for (int p = 0; p < 2; ++p) { const int r_ = drow + 4 * p; const int sc_ = dch ^ (((r_ & 3) << 2) | ((r_ >> 2) & 3)); \
            const size_t g_ = (rb + (size_t)(c) * 64 + r_) * 512 + h * 128 + 8 * sc_; LAS unsigned char* d_ = L + ((c) & 1) * HG_BUF + (8 * wid + 4 * p) * 256; \
            __builtin_amdgcn_global_load_lds((const unsigned*)(Qh + g_), (LAS unsigned*)(d_ + HG_QP), 16, 0, 0); \
            __builtin_amdgcn_global_load_lds((const unsigned*)(Kh + g_), (LAS unsigned*)(d_ + HG_KP), 16, 0, 0); \
            __builtin_amdgcn_global_load_lds((const unsigned*)(Vh + g_), (LAS unsigned*)(d_ + HG_V), 16, 0, 0); } } while (0)
    float sm = 0.f, spe = 0.f, spm = 0.f;
#define HG_SCLOAD(c) do { if (tid < 128) { const size_t s_ = (size_t)(b * 32 + (c)) * 512 + h * 128 + tid; sm = BM[s_]; if ((c) > 0) { spe = BE[s_ - 512]; spm = BM[s_ - 512]; } } } while (0)
#define HG_SCALE(c) do { if (tid < 128) ((LAS float*)(L + ((c) & 1) * HG_BUF + HG_SC))[tid] = __expf(sm + (spe - spm)); } while (0)
    HG_DMA(0);
    HG_SCLOAD(0);
    HG_SCALE(0);
    asm volatile("s_waitcnt vmcnt(0)" ::: "memory");
    __syncthreads();
    for (int c = 0; c < 32; ++c) {
        const LAS unsigned char* B = L + (c & 1) * HG_BUF;
        if (c + 1 < 32) { HG_DMA(c + 1); HG_SCLOAD(c + 1); }
        int q32o = q32, hio = hi, laneo = lane; asm volatile("" : "+v"(q32o), "+v"(hio), "+v"(laneo));
        f32x16 oT;
#pragma unroll
        for (int r = 0; r < 16; ++r) oT[r] = 0.f;
        bf16x8 qb[8];
#pragma unroll
        for (int ks = 0; ks < 8; ++ks) qb[ks] = *(const LAS bf16x8*)(B + HG_QP + hswz(32 * tb + q32o, 2 * ks + hio));
#pragma unroll
        for (int sb = 0; sb < 2; ++sb) {
            if (sb <= tb) {
                bf16x8 ka[8];
#pragma unroll
                for (int ks = 0; ks < 8; ++ks) ka[ks] = *(const LAS bf16x8*)(B + HG_KP + hswz(32 * sb + q32o, 2 * ks + hio));
                s16x4 vl[2], vh[2];
#pragma unroll
                for (int s2 = 0; s2 < 2; ++s2) { const int r0 = 32 * sb + 16 * s2 + 4 * hio; vl[s2] = vtr((LAS const char*)(B + HG_V + htr(r0, 4 * dvb + 2 * dh, laneo))); vh[s2] = vtr((LAS const char*)(B + HG_V + htr(r0 + 8, 4 * dvb + 2 * dh, laneo))); }
                __builtin_amdgcn_sched_barrier(0);
                f32x16 pT;
#pragma unroll
                for (int r = 0; r < 16; ++r) pT[r] = 0.f;
#pragma unroll
                for (int ks = 0; ks < 8; ++ks) pT = MFMA32(ka[ks], qb[ks], pT);
                if (sb == tb) {
#pragma unroll
                    for (int r = 0; r < 16; ++r) if (crow(r, hi) > q32) pT[r] = 0.f;
                }
#pragma unroll
                for (int s2 = 0; s2 < 2; ++s2) { u32x4 pw; pw.x = cvtpk(pT[8 * s2 + 0], pT[8 * s2 + 1]); pw.y = cvtpk(pT[8 * s2 + 2], pT[8 * s2 + 3]); pw.z = cvtpk(pT[8 * s2 + 4], pT[8 * s2 + 5]); pw.w = cvtpk(pT[8 * s2 + 6], pT[8 * s2 + 7]);
                    oT = MFMA32(((bf16x8){vl[s2][0], vl[s2][1], vl[s2][2], vl[s2][3], vh[s2][0], vh[s2][1], vh[s2][2], vh[s2][3]}), __builtin_bit_cast(bf16x8, pw), oT); }
                __builtin_amdgcn_sched_barrier(0);
            }
        }
        { const size_t g0 = (rb + (size_t)c * 64 + orow) * 512 + h * 128 + 16 * oseg; gr[0] = *(const u32x4*)(Gh + g0); gr[1] = *(const u32x4*)(Gh + g0 + 8); }
        {
            u32x2 qq0[8], qq1[8];
            if (c > 0) {
#pragma unroll
                for (int i = 0; i < 4; ++i)
#pragma unroll
                    for (int s = 0; s < 2; ++s) { qq0[2 * i + s] = *(const LAS u32x2*)(B + HG_QP + hswz(32 * tb + q32o, 4 * i + 2 * s) + 8 * hio); qq1[2 * i + s] = *(const LAS u32x2*)(B + HG_QP + hswz(32 * tb + q32o, 4 * i + 2 * s + 1) + 8 * hio); }
            }
#pragma unroll
            for (int i = 0; i < 4; ++i)
#pragma unroll
                for (int g = 0; g < 4; ++g) { const f32x4 sc = *(const LAS f32x4*)(B + HG_SC + (32 * i + 8 * g + 4 * hio) * 4);
#pragma unroll
                    for (int j = 0; j < 4; ++j) T[i][4 * g + j] *= sc[j]; }
            __builtin_amdgcn_sched_barrier(0);
            if (c > 0) {
#pragma unroll
                for (int i = 0; i < 4; ++i)
#pragma unroll
                    for (int s = 0; s < 2; ++s) { u32x4 tw; tw.x = cvtpk(T[i][8 * s + 0], T[i][8 * s + 1]); tw.y = cvtpk(T[i][8 * s + 2], T[i][8 * s + 3]); tw.z = cvtpk(T[i][8 * s + 4], T[i][8 * s + 5]); tw.w = cvtpk(T[i][8 * s + 6], T[i][8 * s + 7]);
                        const u32x4 qw = (u32x4){qq0[2 * i + s].x, qq0[2 * i + s].y, qq1[2 * i + s].x, qq1[2 * i + s].y};
                        oT = MFMA32(__builtin_bit_cast(bf16x8, tw), __builtin_bit_cast(bf16x8, qw), oT); }
            }
        }
        { LAS unsigned char* OBp = L + (c & 1) * HG_BUF + HG_OB;
#pragma unroll
          for (int g = 0; g < 4; ++g) { u32x2 w; w.x = cvtpk(oT[4 * g], oT[4 * g + 1]); w.y = cvtpk(oT[4 * g + 2], oT[4 * g + 3]); *(LAS u32x2*)(OBp + (32 * tb + q32o) * 272 + (32 * dvb + 8 * g + 4 * hio) * 2) = w; } }
#pragma unroll
        for (int sp = 0; sp < 2; ++sp) {
            s16x4 vl[2], vh[2], kl[2][4], kh[2][4];
#pragma unroll
            for (int u = 0; u < 2; ++u) { const int r0 = 16 * (2 * sp + u) + 8 * hio;
                vl[u] = vtr((LAS const char*)(B + HG_V + htr(r0, 4 * dvb + 2 * dh, laneo))); vh[u] = vtr((LAS const char*)(B + HG_V + htr(r0 + 4, 4 * dvb + 2 * dh, laneo)));
#pragma unroll
                for (int i = 0; i < 4; ++i) { kl[u][i] = vtr((LAS const char*)(B + HG_KP + htr(r0, 4 * i + 2 * dh, laneo))); kh[u][i] = vtr((LAS const char*)(B + HG_KP + htr(r0 + 4, 4 * i + 2 * dh, laneo))); } }
            __builtin_amdgcn_sched_barrier(0);
#pragma unroll
            for (int u = 0; u < 2; ++u) { const bf16x8 vb = (bf16x8){vl[u][0], vl[u][1], vl[u][2], vl[u][3], vh[u][0], vh[u][1], vh[u][2], vh[u][3]};
#pragma unroll
                for (int i = 0; i < 4; ++i) T[i] = MFMA32(((bf16x8){kl[u][i][0], kl[u][i][1], kl[u][i][2], kl[u][i][3], kh[u][i][0], kh[u][i][1], kh[u][i][2], kh[u][i][3]}), vb, T[i]); }
            __builtin_amdgcn_sched_barrier(0);
        }
        if (c + 1 < 32) HG_SCALE(c + 1);
        asm volatile("s_waitcnt vmcnt(0)" ::: "memory");
        __syncthreads();
        { const LAS unsigned char* OBp = L + (c & 1) * HG_BUF + HG_OB + orow * 272 + oseg * 32;
          const u32x4 o0 = *(const LAS u32x4*)OBp, o1 = *(const LAS u32x4*)(OBp + 16);
          float ov[16];
          ov[0] = bflo(o0.x); ov[1] = bfhi(o0.x); ov[2] = bflo(o0.y); ov[3] = bfhi(o0.y); ov[4] = bflo(o0.z); ov[5] = bfhi(o0.z); ov[6] = bflo(o0.w); ov[7] = bfhi(o0.w);
          ov[8] = bflo(o1.x); ov[9] = bfhi(o1.x); ov[10] = bflo(o1.y); ov[11] = bfhi(o1.y); ov[12] = bflo(o1.z); ov[13] = bfhi(o1.z); ov[14] = bflo(o1.w); ov[15] = bfhi(o1.w);
          float ss = 0.f;
#pragma unroll
          for (int j = 0; j < 16; ++j) ss += ov[j] * ov[j];
          ss += __int_as_float(__builtin_amdgcn_update_dpp(0, __float_as_int(ss), 0xB1, 0xf, 0xf, true));
          ss += __int_as_float(__builtin_amdgcn_update_dpp(0, __float_as_int(ss), 0x4E, 0xf, 0xf, true));
          ss += __int_as_float(__builtin_amdgcn_update_dpp(0, __float_as_int(ss), 0x141, 0xf, 0xf, true));
          const float rs = __builtin_amdgcn_rsqf(ss * (1.f / 128.f) + LN_EPS);
          float ng[16];
#pragma unroll
          for (int i = 0; i < 4; ++i) { const f32x4 n_ = *(const LAS f32x4*)(NGS + 16 * oseg + 4 * i); ng[4 * i] = n_[0]; ng[4 * i + 1] = n_[1]; ng[4 * i + 2] = n_[2]; ng[4 * i + 3] = n_[3]; }
          float gvv[16];
          gvv[0] = bflo(gr[0].x); gvv[1] = bfhi(gr[0].x); gvv[2] = bflo(gr[0].y); gvv[3] = bfhi(gr[0].y); gvv[4] = bflo(gr[0].z); gvv[5] = bfhi(gr[0].z); gvv[6] = bflo(gr[0].w); gvv[7] = bfhi(gr[0].w);
          gvv[8] = bflo(gr[1].x); gvv[9] = bfhi(gr[1].x); gvv[10] = bflo(gr[1].y); gvv[11] = bfhi(gr[1].y); gvv[12] = bflo(gr[1].z); gvv[13] = bfhi(gr[1].z); gvv[14] = bflo(gr[1].w); gvv[15] = bfhi(gr[1].w);
          float rv[16];
#pragma unroll
          for (int j = 0; j < 16; ++j) rv[j] = ov[j] * (rs * FP8_SO) * ng[j] * gvv[j];
          u32x4 w0; w0.x = cvt4_fp8(rv[0], rv[1], rv[2], rv[3]); w0.y = cvt4_fp8(rv[4], rv[5], rv[6], rv[7]); w0.z = cvt4_fp8(rv[8], rv[9], rv[10], rv[11]); w0.w = cvt4_fp8(rv[12], rv[13], rv[14], rv[15]);
          unsigned char* op = (unsigned char*)Ocat + (rb + (size_t)c * 64 + orow) * 1024 + h * 128 + 16 * oseg;
          *(u32x4*)op = w0; }
    }
    __syncthreads();
#undef HG_DMA
#undef HG_SCALE
#undef HG_SCLOAD
}

constexpr int AT_NST = 8, AT_K = 0, AT_V = AT_NST * 8192, AT_KM = 2 * AT_NST * 8192, AT_TAB = AT_KM + 1792;
DI int t5_bucket(int d) { if (d < 16) return d; const int v = 16 + (int)(logf((float)d * (1.f / 16.f)) / logf(8.f) * 16.f); return v < 31 ? v : 31; }
DI void glds16(const void* gsrc, unsigned lds_dst) { unsigned keep;
    asm volatile("s_mov_b32 %0, m0\n\ts_mov_b32 m0, %2\n\ts_nop 0\n\tglobal_load_lds_dwordx4 %1, off\n\ts_mov_b32 m0, %0" : "=&s"(keep) : "v"(gsrc), "s"(lds_dst) : "memory"); }
DI float max3f(float a, float b, float c) { float r; asm("v_max3_f32 %0, %1, %2, %3" : "=v"(r) : "v"(a), "v"(b), "v"(c)); return r; }
DI void attn_unit(const Ctx& C, const Args& a, int b, int h, int jq) {
    LAS unsigned char* L = C.lds;
    const int tid = C.tid, lane = C.lane, wid = C.wid, q32 = lane & 31, hi = lane >> 5;
    const bf16* Qm = (const bf16*)(C.ws + WS_QM); const bf16* Km = (const bf16*)(C.ws + WS_KM); const bf16* Vm = (const bf16*)(C.ws + WS_VM); const float* KM = (const float*)(C.ws + WS_KMEAN);
    bf16* Ocat = (bf16*)(C.ws + WS_OCAT);
    const int tq = jq * 256 + wid * 32 + q32;
    const size_t hb = (size_t)(b * 8 + h) * SEQ;
    bf16x8 qf[4];
#pragma unroll
    for (int ks = 0; ks < 4; ++ks) qf[ks] = *(const bf16x8*)(Qm + (hb + tq) * 64 + 16 * ks + 8 * hi);
    LAS float* kml = (LAS float*)(L + AT_KM); LAS float* tab = (LAS float*)(L + AT_TAB);
    if (tid < jq * 64) { const int n = tid >> 6, d = tid & 63; kml[tid] = KM[(size_t)((b * 8 + n) * 2 + 0) * 512 + h * 64 + d] + KM[(size_t)((b * 8 + n) * 2 + 1) * 512 + h * 64 + d]; }
    if (tid < 129) tab[tid] = (a.in[I_RELB][t5_bucket(tid) * 8 + h] - a.in[I_RELB][31 * 8 + h]) * LOG2E;
    const int drow = 8 * wid + (lane >> 3), dch = lane & 7;
    const bf16* ksrc = Km + (hb + drow) * 64 + 8 * (dch ^ ((drow >> 1) & 7));
    const bf16* vsrc = Vm + (hb + drow) * 64 + 8 * (dch ^ (((drow >> 1) & 1) << 2));
    const unsigned kdst = (unsigned)__builtin_amdgcn_readfirstlane((int)(unsigned)(size_t)(L + AT_K + wid * 1024)), vdst = (unsigned)__builtin_amdgcn_readfirstlane((int)(unsigned)(size_t)(L + AT_V + wid * 1024));
    const int nt = 4 * jq + 4;
#define AT_ISSUE(t) do { glds16(ksrc + (size_t)(t) * 4096, kdst + ((t) & 7) * 8192); glds16(vsrc + (size_t)(t) * 4096, vdst + ((t) & 7) * 8192); } while (0)
    AT_ISSUE(0); AT_ISSUE(1); AT_ISSUE(2); AT_ISSUE(3);
    __syncthreads();
    unsigned sel = 0;
    {
        float g[7];
#pragma unroll
        for (int n = 0; n < 7; ++n) { g[n] = 0.f;
            if (n < jq) { float s = 0.f;
#pragma unroll
                for (int ks = 0; ks < 4; ++ks)
#pragma unroll
                    for (int j = 0; j < 8; ++j) s += bf2f((unsigned short)qf[ks][j]) * kml[n * 64 + 16 * ks + 8 * hi + j];
                s += __shfl_xor(s, 32); g[n] = s; } }
#pragma unroll
        for (int n = 0; n < 7; ++n) if (n < jq) { int rank = 0;
#pragma unroll
            for (int m = 0; m < 7; ++m) if (m != n && m < jq) rank += (g[m] > g[n] || (g[m] == g[n] && m < n)) ? 1 : 0;
            if (rank < 3) sel |= 1u << n; }
    }
    const float c31 = a.in[I_RELB][31 * 8 + h] * LOG2E;
    f32x16 lacc;
#pragma unroll
    for (int r = 0; r < 16; ++r) lacc[r] = 0.f;
    const bf16x8 ones8 = (bf16x8){0x3F80, 0x3F80, 0x3F80, 0x3F80, 0x3F80, 0x3F80, 0x3F80, 0x3F80};
    f32x16 negm;
#pragma unroll
    for (int r = 0; r < 16; ++r) negm[r] = c31;
    f32x16 o0, o1;
#pragma unroll
    for (int r = 0; r < 16; ++r) { o0[r] = 0.f; o1[r] = 0.f; }
    const int i16 = lane & 15, qq = i16 >> 2, pp = i16 & 3, dh = (lane >> 4) & 1, xsw = (qq >> 1) & 1;
    const int vb0 = (4 * hi + qq) * 128 + 64 * (0 ^ xsw) + 32 * dh + 8 * pp, vb1 = (4 * hi + qq) * 128 + 64 * (1 ^ xsw) + 32 * dh + 8 * pp;
    const int kxs = (q32 >> 1) & 7;
#if defined(STAMP_ACC) && STAMP_ACC == 2
    unsigned long long tl0_ = 0; if (tid == 0) tl0_ = __builtin_amdgcn_s_memrealtime();
#endif
    for (int kt = 0; kt < nt; ++kt) {
        if ((kt & 3) == 0) {
            asm volatile("s_waitcnt vmcnt(0)" ::: "memory");
            __builtin_amdgcn_s_barrier();
            asm volatile("" ::: "memory");
            if (kt + 4 < nt) { AT_ISSUE(kt + 4); AT_ISSUE(kt + 5); AT_ISSUE(kt + 6); AT_ISSUE(kt + 7); }
        }
        const int blk = kt >> 2; const bool own = (blk == jq);
        const bool active = !own || ((kt & 3) * 64 <= wid * 32 + 31);
        if (active) {
            const LAS unsigned char* Kc = L + AT_K + (kt & 7) * 8192; const LAS unsigned char* Vc = L + AT_V + (kt & 7) * 8192;
            bf16x8 kf[8];
#pragma unroll
            for (int ks = 0; ks < 4; ++ks) { const int ko = (((2 * ks + hi) ^ kxs) << 4); kf[2 * ks] = *(const LAS bf16x8*)(Kc + q32 * 128 + ko); kf[2 * ks + 1] = *(const LAS bf16x8*)(Kc + (32 + q32) * 128 + ko); }
            __builtin_amdgcn_sched_barrier(0);
            f32x16 s0 = negm, s1 = negm;
#pragma unroll
            for (int ks = 0; ks < 4; ++ks) { s0 = MFMA32(kf[2 * ks], qf[ks], s0); s1 = MFMA32(kf[2 * ks + 1], qf[ks], s1); }
            __builtin_amdgcn_sched_barrier(0);
            s16x4 vf[2][4][2];
#pragma unroll
            for (int j = 0; j < 4; ++j) { const int ro = 16 * j * 128;
                vf[0][j][0] = vtr((LAS const char*)(Vc + vb0 + ro)); vf[0][j][1] = vtr((LAS const char*)(Vc + vb0 + ro + 8 * 128));
                vf[1][j][0] = vtr((LAS const char*)(Vc + vb1 + ro)); vf[1][j][1] = vtr((LAS const char*)(Vc + vb1 + ro + 8 * 128)); }
            __builtin_amdgcn_sched_barrier(0);
            const bool near = (jq * 256 + wid * 32 - 64 * kt - 63) < 128;
            if (near) {
                const int dist0 = tq - 64 * kt - 4 * hi;
#pragma unroll
                for (int r = 0; r < 16; ++r) { const int d0 = dist0 - ((r & 3) + 8 * (r >> 2)), d1 = d0 - 32;
                    const int i0 = d0 < 0 ? 0 : (d0 > 128 ? 128 : d0), i1 = d1 < 0 ? 0 : (d1 > 128 ? 128 : d1);
                    const float t0 = tab[i0], t1 = tab[i1]; s0[r] += t0; s1[r] += t1; s0[r] = d0 < 0 ? -INFINITY : s0[r]; s1[r] = d1 < 0 ? -INFINITY : s1[r]; }
            }
            const bool lsel = own || ((sel >> blk) & 1u);
            float mx = max3f(s0[0], s1[0], s0[1]), mx2 = max3f(s1[1], s0[2], s1[2]);
#pragma unroll
            for (int r = 3; r < 15; r += 2) { mx = max3f(mx, s0[r], s1[r]); mx2 = max3f(mx2, s0[r + 1], s1[r + 1]); }
            mx = max3f(mx, s0[15], s1[15]); mx = fmaxf(mx, mx2);
            mx = lsel ? mx : -INFINITY;
            mx = fmaxf(mx, __shfl_xor(mx, 32));
            if (__any(mx > 4.0f)) {
                const float delta = fmaxf(mx, 0.f), alpha = __builtin_amdgcn_exp2f(-delta);
#pragma unroll
                for (int r = 0; r < 16; ++r) { o0[r] *= alpha; o1[r] *= alpha; lacc[r] *= alpha; negm[r] -= delta; s0[r] -= delta; s1[r] -= delta; }
            }
#pragma unroll
            for (int r = 0; r < 16; ++r) { s0[r] = __builtin_amdgcn_exp2f(s0[r]); s1[r] = __builtin_amdgcn_exp2f(s1[r]); }
            const unsigned pmask = lsel ? 0xffffffffu : 0u;
#pragma unroll
            for (int kb = 0; kb < 2; ++kb)
#pragma unroll
                for (int s2 = 0; s2 < 2; ++s2) {
                    u32x4 pw;
                    if (kb == 0) { pw.x = cvtpk(s0[8 * s2 + 0], s0[8 * s2 + 1]); pw.y = cvtpk(s0[8 * s2 + 2], s0[8 * s2 + 3]); pw.z = cvtpk(s0[8 * s2 + 4], s0[8 * s2 + 5]); pw.w = cvtpk(s0[8 * s2 + 6], s0[8 * s2 + 7]); }
                    else         { pw.x = cvtpk(s1[8 * s2 + 0], s1[8 * s2 + 1]); pw.y = cvtpk(s1[8 * s2 + 2], s1[8 * s2 + 3]); pw.z = cvtpk(s1[8 * s2 + 4], s1[8 * s2 + 5]); pw.w = cvtpk(s1[8 * s2 + 6], s1[8 * s2 + 7]); }
                    pw.x &= pmask; pw.y &= pmask; pw.z &= pmask; pw.w &= pmask;
                    const bf16x8 pf = __builtin_bit_cast(bf16x8, pw);
                    const s16x4 a0l = vf[0][2 * kb + s2][0], a0h = vf[0][2 * kb + s2][1], a1l = vf[1][2 * kb + s2][0], a1h = vf[1][2 * kb + s2][1];
                    o0 = MFMA32(((bf16x8){a0l[0], a0l[1], a0l[2], a0l[3], a0h[0], a0h[1], a0h[2], a0h[3]}), pf, o0);
                    o1 = MFMA32(((bf16x8){a1l[0], a1l[1], a1l[2], a1l[3], a1h[0], a1h[1], a1h[2], a1h[3]}), pf, o1);
                    lacc = MFMA32(ones8, pf, lacc);
                }
        }
    }
#if defined(STAMP_ACC) && STAMP_ACC == 2
    if (tid == 0 && blockIdx.x == 100) { const unsigned long long d_ = __builtin_amdgcn_s_memrealtime() - tl0_; const unsigned long long o_ = ((unsigned long long)C.MISC[45] << 32) | C.MISC[44]; const unsigned long long n_ = o_ + d_; C.MISC[44] = (unsigned)n_; C.MISC[45] = (unsigned)(n_ >> 32); }
#endif
    const float linv = 1.f / lacc[0];
    unsigned char* op = (unsigned char*)Ocat + ((size_t)b * SEQ + tq) * 1024 + 512 + h * 64;
    const float lsc = linv * FP8_SO;
#pragma unroll
    for (int g = 0; g < 4; ++g) { *(unsigned*)(op + 8 * g + 4 * hi) = cvt4_fp8(o0[4 * g] * lsc, o0[4 * g + 1] * lsc, o0[4 * g + 2] * lsc, o0[4 * g + 3] * lsc);
        *(unsigned*)(op + 32 + 8 * g + 4 * hi) = cvt4_fp8(o1[4 * g] * lsc, o1[4 * g + 1] * lsc, o1[4 * g + 2] * lsc, o1[4 * g + 3] * lsc); }
    __syncthreads();
#undef AT_ISSUE
}

#ifndef PROBE_HGX
#define PROBE_HGX 1
#endif
#ifndef PROBE_ATX
#define PROBE_ATX 1
#endif
#ifndef STAMP_SEL
#define STAMP_SEL -1
#endif
#ifndef STAMP_BLK
#define STAMP_BLK 0
#endif
#define STAMP(i) do { if (STAMP_SEL >= 0 && blockIdx.x == STAMP_BLK && C.tid == 0) { const unsigned long long t_ = __builtin_amdgcn_s_memrealtime(); C.MISC[16 + 2 * (i)] = (unsigned)t_; C.MISC[17 + 2 * (i)] = (unsigned)(t_ >> 32); } } while (0)
DI void p2_mixers(const Ctx& C, const Args& a, int rep) {
    for (int hx = 0; hx < PROBE_HGX; ++hx)
    for (int u = blockIdx.x; u < 64; u += C.G) hgrn_unit(C, a, u >> 2, u & 3);
    STAMP(11);
    unsigned* QA = (unsigned*)(C.ctl + CW_QUEUE + 64 * rep); unsigned* QC = (unsigned*)(C.ctl + CW_QUEUE2 + 64 * rep);
    constexpr int NA = 1024 * PROBE_ATX, NC = MOE_CVT_TILES;
    if (C.tid == 0) { C.MISC[0] = __hip_atomic_fetch_add(QA, 1u, __ATOMIC_RELAXED, __HIP_MEMORY_SCOPE_AGENT); C.MISC[1] = (rep == 0) ? __hip_atomic_fetch_add(QC, 1u, __ATOMIC_RELAXED, __HIP_MEMORY_SCOPE_AGENT) : (unsigned)NC; }
    __syncthreads();
    int qa = (int)C.MISC[0], qc = (int)C.MISC[1];
    __syncthreads();
    for (;;) {
        const bool doa = qa < NA, doc = qc < NC;
        if (!doa && !doc) break;
        unsigned na = (unsigned)NA, nc = (unsigned)NC;
        if (C.tid == 0) { if (doa) na = __hip_atomic_fetch_add(QA, 1u, __ATOMIC_RELAXED, __HIP_MEMORY_SCOPE_AGENT); if (doc) nc = __hip_atomic_fetch_add(QC, 1u, __ATOMIC_RELAXED, __HIP_MEMORY_SCOPE_AGENT); }
#ifdef STAMP_ACC
        unsigned long long ta_ = 0, tb_ = 0, tc_ = 0; if (C.tid == 0) ta_ = __builtin_amdgcn_s_memrealtime();
#endif
        if (doa) { const int q = qa / PROBE_ATX; attn_unit(C, a, (q & 127) >> 3, q & 7, 7 - (q >> 7)); }
#ifdef STAMP_ACC
        if (C.tid == 0) tb_ = __builtin_amdgcn_s_memrealtime();
#endif
        if (doc) moe_cvt_tile(C, a, qc);
#ifdef STAMP_ACC
        if (C.tid == 0 && blockIdx.x == 100) { tc_ = __builtin_amdgcn_s_memrealtime(); const unsigned long long d_ = (STAMP_ACC == 0) ? (tb_ - ta_) : (STAMP_ACC == 1 ? (tc_ - tb_) : 0ull);
            const unsigned long long o_ = ((unsigned long long)C.MISC[45] << 32) | C.MISC[44]; const unsigned long long n_ = o_ + d_; C.MISC[44] = (unsigned)n_; C.MISC[45] = (unsigned)(n_ >> 32); }
#endif
        if (C.tid == 0) { C.MISC[0] = na; C.MISC[1] = nc; }
        __syncthreads();
        qa = (int)C.MISC[0]; qc = (int)C.MISC[1];
        __syncthreads();
    }
    STAMP(12);
#ifdef STAMP_ACC
    if (C.tid == 0 && blockIdx.x == 100) { const unsigned long long n_ = ((unsigned long long)C.MISC[45] << 32) | C.MISC[44]; const unsigned long long w0 = __builtin_amdgcn_s_memrealtime(); while (__builtin_amdgcn_s_memrealtime() - w0 < 4ull * n_) __builtin_amdgcn_s_sleep(8); }
#endif
}

DI void r1_phase(const Ctx& C, const Args& a) {
    LAS unsigned char* L = C.lds;
    const int tid = C.tid, lane = C.lane, wid = C.wid;
    LAS float* LG = (LAS float*)L + wid * 16 * 48;
    LAS int* CNT = (LAS int*)(L + 32768);
    LAS float* G1 = (LAS float*)(L + 33024); LAS float* B1 = (LAS float*)(L + 37120);
    const bf16* Pre = (const bf16*)(C.ws + WS_ZF); unsigned char* X1q = (unsigned char*)(C.ws + WS_R); f32x2* stats = (f32x2*)(C.ws + WS_STATS);
    const bf16* WrH = (const bf16*)(C.ws + WS_WRH); const bf16* WrL = (const bf16*)(C.ws + WS_WRL);
    unsigned* tokE = (unsigned*)(C.ws + WS_TOKE); float* tokW = (float*)(C.ws + WS_TOKW); int* wgcnt = (int*)(C.ws + WS_WGCNT);
    for (int i = tid; i < 1024; i += NTHREADS) { G1[i] = a.in[I_LN1G][i]; B1[i] = a.in[I_LN1B][i]; }
    LAS unsigned char* WL = L + 45056;
    for (int i = tid; i < 48 * 128; i += NTHREADS) { const int r = i >> 7, c = i & 127; *(LAS u32x4*)(WL + r * 2064 + c * 16) = *(const u32x4*)(WrH + (size_t)r * 1024 + c * 8); }
    LAS float* RB = (LAS float*)(L + 41216);
    if (tid < 4) RB[tid] = a.in[I_BGRP][tid]; else if (tid < 36) RB[tid] = a.in[I_BEXP][tid - 4];
    const int m16 = lane & 15, kq = lane >> 4;
    for (int chunk = blockIdx.x; chunk < NTOK / 128; chunk += C.G) {
        if (tid < 32) CNT[tid] = 0;
        __syncthreads();
        const int tok0 = chunk * 128 + wid * 16;
        const bf16* xrow = Pre + (size_t)(tok0 + m16) * 1024 + 8 * kq;
        float s = 0.f, s2 = 0.f;
#pragma unroll 8
        for (int k0 = 0; k0 < 1024; k0 += 32) { const u32x4 w = *(const u32x4*)(xrow + k0); const f32x4 xa = (f32x4){bflo(w.x), bfhi(w.x), bflo(w.y), bfhi(w.y)}, xc = (f32x4){bflo(w.z), bfhi(w.z), bflo(w.w), bfhi(w.w)};
            s += (xa[0] + xa[1]) + (xa[2] + xa[3]) + (xc[0] + xc[1]) + (xc[2] + xc[3]);
            s2 += (xa[0] * xa[0] + xa[1] * xa[1]) + (xa[2] * xa[2] + xa[3] * xa[3]) + (xc[0] * xc[0] + xc[1] * xc[1]) + (xc[2] * xc[2] + xc[3] * xc[3]); }
        s += __shfl_xor(s, 16); s += __shfl_xor(s, 32); s2 += __shfl_xor(s2, 16); s2 += __shfl_xor(s2, 32);
        const float mean = s * (1.f / 1024.f); const float var = fmaxf(s2 * (1.f / 1024.f) - mean * mean, 0.f); const float rstd = 1.f / sqrtf(var + LN_EPS);
        if (kq == 0) stats[tok0 + m16] = (f32x2){mean, rstd};
        STAMP(13);
        f32x4 acc[3];
#pragma unroll
        for (int nb = 0; nb < 3; ++nb) acc[nb] = (f32x4){0.f, 0.f, 0.f, 0.f};
        unsigned char* xb = X1q + (size_t)(tok0 + m16) * 1024 + 8 * kq;
        const LAS unsigned char* wlp = WL + m16 * 2064 + 16 * kq;
#pragma unroll 1
        for (int kb = 0; kb < 4; ++kb) {
            u32x4 xw[8];
#pragma unroll
            for (int j = 0; j < 8; ++j) xw[j] = *(const u32x4*)(xrow + kb * 256 + 32 * j);
#pragma unroll
            for (int j = 0; j < 8; ++j) { const int k0 = kb * 256 + 32 * j;
                bf16x8 wh[3];
#pragma unroll
                for (int nb = 0; nb < 3; ++nb) wh[nb] = *(const LAS bf16x8*)(wlp + nb * 16 * 2064 + k0 * 2);
                const f32x4 xaj = (f32x4){bflo(xw[j].x), bfhi(xw[j].x), bflo(xw[j].y), bfhi(xw[j].y)}, xcj = (f32x4){bflo(xw[j].z), bfhi(xw[j].z), bflo(xw[j].w), bfhi(xw[j].w)};
                const f32x4 ya = (xaj - mean) * rstd * *(const LAS f32x4*)(G1 + k0 + 8 * kq) + *(const LAS f32x4*)(B1 + k0 + 8 * kq);
                const f32x4 yc = (xcj - mean) * rstd * *(const LAS f32x4*)(G1 + k0 + 8 * kq + 4) + *(const LAS f32x4*)(B1 + k0 + 8 * kq + 4);
                u32x4 hw; hw.x = cvtpk(ya[0], ya[1]); hw.y = cvtpk(ya[2], ya[3]); hw.z = cvtpk(yc[0], yc[1]); hw.w = cvtpk(yc[2], yc[3]);
                { u32x2 qw; qw.x = cvt4_fp8(ya[0] * FP8_SX, ya[1] * FP8_SX, ya[2] * FP8_SX, ya[3] * FP8_SX); qw.y = cvt4_fp8(yc[0] * FP8_SX, yc[1] * FP8_SX, yc[2] * FP8_SX, yc[3] * FP8_SX); *(u32x2*)(xb + k0) = qw; }
                u32x4 lw; lw.x = cvtpk(ya[0] - bflo(hw.x), ya[1] - bfhi(hw.x)); lw.y = cvtpk(ya[2] - bflo(hw.y), ya[3] - bfhi(hw.y)); lw.z = cvtpk(yc[0] - bflo(hw.z), yc[1] - bfhi(hw.z)); lw.w = cvtpk(yc[2] - bflo(hw.w), yc[3] - bfhi(hw.w));
                const bf16x8 xh = __builtin_bit_cast(bf16x8, hw), xl = __builtin_bit_cast(bf16x8, lw);
#pragma unroll
                for (int nb = 0; nb < 3; ++nb) { acc[nb] = MFMA16(wh[nb], xh, acc[nb]); acc[nb] = MFMA16(wh[nb], xl, acc[nb]); }
            }
        }
        STAMP(14);
#pragma unroll
        for (int nb = 0; nb < 3; ++nb)
#pragma unroll
            for (int r = 0; r < 4; ++r) LG[m16 * 48 + nb * 16 + 4 * kq + r] = acc[nb][r];
        asm volatile("s_waitcnt lgkmcnt(0)" ::: "memory");
        if (lane < 16) {
            const LAS float* lg = LG + lane * 48;
            float gl[4];
#pragma unroll
            for (int j = 0; j < 4; ++j) gl[j] = lg[j] + RB[j];
            int grp = 0; float gm = gl[0];
#pragma unroll
            for (int j = 1; j < 4; ++j) if (gl[j] > gm) { gm = gl[j]; grp = j; }
            float se = 0.f;
#pragma unroll
            for (int j = 0; j < 4; ++j) se += __expf(gl[j] - gm);
            const float pg = 1.f / se;
            float el[8];
#pragma unroll
            for (int j = 0; j < 8; ++j) el[j] = lg[4 + grp * 8 + j] + RB[4 + grp * 8 + j];
            int i0 = 0; float v0 = el[0];
#pragma unroll
            for (int j = 1; j < 8; ++j) if (el[j] > v0) { v0 = el[j]; i0 = j; }
            int i1 = -1; float v1 = -INFINITY;
#pragma unroll
            for (int j = 0; j < 8; ++j) if (j != i0 && el[j] > v1) { v1 = el[j]; i1 = j; }
            const float w0 = 1.f / (1.f + __expf(v1 - v0)), w1 = 1.f - w0;
            const int e0 = grp * 8 + i0, e1 = grp * 8 + i1;
            const int r0 = __hip_atomic_fetch_add(CNT + e0, 1, __ATOMIC_RELAXED, __HIP_MEMORY_SCOPE_WORKGROUP), r1 = __hip_atomic_fetch_add(CNT + e1, 1, __ATOMIC_RELAXED, __HIP_MEMORY_SCOPE_WORKGROUP);
            const int tok = tok0 + lane;
            tokE[tok] = (unsigned)e0 | ((unsigned)e1 << 8) | ((unsigned)r0 << 16) | ((unsigned)r1 << 24);
            tokW[tok * 2] = w0 * pg; tokW[tok * 2 + 1] = w1 * pg;
        }
        __syncthreads();
        if (tid < 32) wgcnt[chunk * 32 + tid] = CNT[tid];
        __syncthreads();
    }
}

DI void r2_phase(const Ctx& C, const Args& a) {
    LAS int* PA = (LAS int*)C.lds;
    LAS int* PB = PA + 512;
    LAS int* TOT = PB + 512; LAS int* BASE = TOT + 32; LAS int* PST = BASE + 32;
    const int tid = C.tid;
    const int* wgcnt = (const int*)(C.ws + WS_WGCNT); const unsigned* tokE = (const unsigned*)(C.ws + WS_TOKE);
    int* tokD = (int*)(C.ws + WS_TOKD); int* rowtok = (int*)(C.ws + WS_ROWTOK); int* tilee = (int*)(C.ws + WS_TILEE);
    for (int chunk = blockIdx.x; chunk < NTOK / 128; chunk += C.G) {
        { const int e = tid & 31, part = tid >> 5; int sa = 0, sb = 0;
          for (int c = part * 16; c < part * 16 + 16; ++c) { const int v = wgcnt[c * 32 + e]; sa += v; sb += (c < chunk) ? v : 0; }
          PA[part * 32 + e] = sa; PB[part * 32 + e] = sb; }
        __syncthreads();
        if (tid < 32) { int sa = 0, sb = 0; for (int p = 0; p < 16; ++p) { sa += PA[p * 32 + tid]; sb += PB[p * 32 + tid]; } TOT[tid] = sa; BASE[tid] = sb; }
        __syncthreads();
        if (tid == 0) { int ps = 0; for (int e = 0; e < 32; ++e) { PST[e] = ps; ps += ((TOT[e] + 255) >> 8) << 8; } PST[32] = ps; }
        __syncthreads();
        if (tid < 128) { const int tok = chunk * 128 + tid; const unsigned w = tokE[tok]; const int e0 = w & 31, e1 = (w >> 8) & 31, r0 = (w >> 16) & 255, r1 = (w >> 24) & 255;
            const int d0 = PST[e0] + BASE[e0] + r0, d1 = PST[e1] + BASE[e1] + r1; rowtok[d0] = tok; rowtok[d1] = tok; tokD[tok * 2] = d0; tokD[tok * 2 + 1] = d1; }
        if (chunk < 32) { const int e = chunk, end = PST[e + 1] - PST[e]; for (int i = TOT[e] + tid; i < end; i += NTHREADS) rowtok[PST[e] + i] = 0; }
        if (chunk == 0) { if (tid < 32) { for (int t = PST[tid] >> 8; t < (PST[tid + 1] >> 8); ++t) tilee[t] = tid; } if (tid == 0) tilee[511] = PST[32] >> 8; }
        __syncthreads();
    }
}

DI void f_phase(const Ctx& C, const Args& a) {
    const int lane = C.lane, gw = C.vcu * NWAVES + C.wid, NGW = C.G * NWAVES;
    const bf16* Pre = (const bf16*)(C.ws + WS_ZF); const unsigned char* Y = (const unsigned char*)(C.ws + WS_Y); const int* tokD = (const int*)(C.ws + WS_TOKD); const float* tokW = (const float*)(C.ws + WS_TOKW);
    const f32x2* stats = (const f32x2*)(C.ws + WS_STATS);
    f32x4 g2[4], b2[4], g1[4], b1[4];
#pragma unroll
    for (int j = 0; j < 4; ++j) { g2[j] = *(const f32x4*)(a.in[I_LN2G] + 256 * j + 4 * lane); b2[j] = *(const f32x4*)(a.in[I_LN2B] + 256 * j + 4 * lane);
        g1[j] = *(const f32x4*)(a.in[I_LN1G] + 256 * j + 4 * lane) * DN_ALPHA; b1[j] = *(const f32x4*)(a.in[I_LN1B] + 256 * j + 4 * lane) * DN_ALPHA; }
    for (int tok = gw; tok < NTOK; tok += NGW) {
        const int d0 = tokD[tok * 2], d1 = tokD[tok * 2 + 1]; const float w0 = tokW[tok * 2] * (1.f / FP8_SY), w1 = tokW[tok * 2 + 1] * (1.f / FP8_SY); const f32x2 st = stats[tok];
        const bf16* xr = Pre + (size_t)tok * 1024 + 4 * lane; const unsigned char* y0 = Y + (size_t)d0 * 1024 + 4 * lane; const unsigned char* y1 = Y + (size_t)d1 * 1024 + 4 * lane;
        f32x4 v[4]; float s = 0.f;
#pragma unroll
        for (int j = 0; j < 4; ++j) { const u32x2 xw = *(const u32x2*)(xr + 256 * j); const f32x4 x = (f32x4){bflo(xw.x), bfhi(xw.x), bflo(xw.y), bfhi(xw.y)}; const unsigned p0 = *(const unsigned*)(y0 + 256 * j), p1 = *(const unsigned*)(y1 + 256 * j);
            v[j] = ((x - st.x) * st.y) * g1[j] + b1[j] + fp8x4_to_f32(p0) * w0 + fp8x4_to_f32(p1) * w1;
            s += (v[j][0] + v[j][1]) + (v[j][2] + v[j][3]); }
        const float mean = wave_sum(s) * (1.f / 1024.f); float s2 = 0.f;
#pragma unroll
        for (int j = 0; j < 4; ++j) { v[j] = v[j] - mean; s2 += (v[j][0] * v[j][0] + v[j][1] * v[j][1]) + (v[j][2] * v[j][2] + v[j][3] * v[j][3]); }
        const float rstd = 1.f / sqrtf(wave_sum(s2) * (1.f / 1024.f) + LN_EPS);
        float* orow = a.out + (size_t)tok * 1024 + 4 * lane;
#pragma unroll
        for (int j = 0; j < 4; ++j) *(f32x4*)(orow + 256 * j) = v[j] * rstd * g2[j] + b2[j];
    }
}

constexpr int NPH = 10;
__global__ void __launch_bounds__(NTHREADS, 2) mk_fwd(Args args) {
    extern __shared__ __attribute__((aligned(16))) unsigned char lds_raw[];
    Ctx C;
    C.lds = (LAS unsigned char*)lds_raw; C.MISC = (volatile LAS unsigned*)(C.lds + MISC_OFF);
    C.tid = threadIdx.x; C.lane = C.tid & 63; C.wid = __builtin_amdgcn_readfirstlane(C.tid >> 6);
    C.G = gridDim.x; { const int bx = blockIdx.x; C.vcu = (C.G % 8 == 0) ? (bx % 8) * (C.G / 8) + bx / 8 : bx; }
    C.ws = args.ws; C.ctl = (gu32*)(args.ws + WS_CTL);
    if (C.tid < 64) C.MISC[C.tid] = 0u;
    __syncthreads();
    XcdBarrier bar; bar.bar = (unsigned*)(C.ctl + CW_BAR); bar.x = 0; bar.st = nullptr;
    if (MK_N_LAUNCHES == 1) bar = xcd_barrier_post((unsigned*)(C.ctl + CW_BAR), C.MISC + 8);
    const int lo = args.ph_lo, hi = args.ph_hi;
#ifndef PH_MASK
#define PH_MASK 0x3ff
#endif
#define IN(k) (((PH_MASK >> (k)) & 1) && lo <= (k) && (k) < hi)
#ifndef STAMP_SEL
#define STAMP_SEL -1
#endif
#ifndef STAMP_T0
#define STAMP_T0 STAMP_SEL
#define STAMP_T1 (STAMP_SEL + 1)
#endif
#define SEAM(k) do { if (IN(k) && IN((k) + 1)) xcd_barrier(bar); STAMP((k) + 1); } while (0)
#ifndef PROBE_PHASE
#define PROBE_PHASE -1
#endif
#define REPS(k) ((PROBE_PHASE == (k)) ? 2 : 1)
#define REPSEAM(k) do { if (rep + 1 < REPS(k)) xcd_barrier(bar); } while (0)
    unsigned char* ws = args.ws;
    LAS unsigned char* ring = C.lds;

    STAMP(0);
    if (IN(0)) { _Pragma("unroll") for (int rep = 0; rep < REPS(0); ++rep) { p0_prologue(C, args); REPSEAM(0); } } SEAM(0);

    if (IN(1)) _Pragma("unroll") for (int rep = 0; rep < REPS(1); ++rep) {
        pg8::EpiIn E{(bf16*)(ws + WS_QH), (bf16*)(ws + WS_VH), (bf16*)(ws + WS_GH), (bf16*)(ws + WS_QM), (bf16*)(ws + WS_KM), (bf16*)(ws + WS_VM), (bf16*)(ws + WS_R), (bf16*)(ws + WS_GB),
                     (float*)(ws + WS_ZF), (float*)(ws + WS_KMEAN), (const float*)(ws + WS_BPERM), (bf16*)(ws + WS_KK), (const float*)(ws + WS_LB), 0};
        { pg8::DenseOrder S; S.init(ws + WS_XB, ws + WS_WIN, NTOK, 1024, 1024, C.G, (int)blockIdx.x);
          pg8::gemm_phase<pg8::EpiIn, pg8::DenseOrder, false>(ring, 1024, S, E); }
        { E.pn_off = 4; pg8::DenseOrder S; S.init((unsigned char*)args.out + 64 * MiB, ws + WS_WIN + 2 * MiB, NTOK, 4608, 512, C.G, (int)blockIdx.x);
          pg8::gemm_phase<pg8::EpiIn, pg8::DenseOrder, false, true>(ring, 512, S, E); }
        REPSEAM(1);
    } SEAM(1);

#ifndef PROBE_P2X
#define PROBE_P2X 1
#endif
    if (IN(2)) { for (int rep = 0; rep < PROBE_P2X; ++rep) { p2_mixers(C, args, rep); if (rep + 1 < PROBE_P2X) xcd_barrier(bar); } } SEAM(2);

    if (IN(3)) _Pragma("unroll") for (int rep = 0; rep < REPS(3); ++rep) {
        pg8::DenseOrder S; S.init(ws + WS_OCAT, ws + WS_WCAT, NTOK, 1024, 512, C.G, (int)blockIdx.x);
        pg8::EpiProj E{(const bf16*)(ws + WS_R), (const bf16*)(ws + WS_GB), (unsigned char*)(ws + WS_QH)};
        pg8::gemm_phase<pg8::EpiProj, pg8::DenseOrder, false, true>(ring, 512, S, E); REPSEAM(3);
    } SEAM(3);

    if (IN(4)) _Pragma("unroll") for (int rep = 0; rep < REPS(4); ++rep) {
        pg8::DenseOrder S; S.init(ws + WS_QH, ws + WS_WO, NTOK, 1024, 512, C.G, (int)blockIdx.x);
        pg8::EpiOut E{(const bf16*)(ws + WS_XB), (bf16*)(ws + WS_ZF)};
        pg8::gemm_phase<pg8::EpiOut, pg8::DenseOrder, false, true>(ring, 512, S, E);
        REPSEAM(4);
    } SEAM(4);

    if (IN(5)) { _Pragma("unroll") for (int rep = 0; rep < REPS(5); ++rep) { r1_phase(C, args); REPSEAM(5); } } STAMP(15); SEAM(5);
    if (IN(6)) { _Pragma("unroll") for (int rep = 0; rep < REPS(6); ++rep) { r2_phase(C, args); REPSEAM(6); } } SEAM(6);

    if (IN(7)) _Pragma("unroll") for (int rep = 0; rep < REPS(7); ++rep) {
        const int* tilee = (const int*)(ws + WS_TILEE);
        const int ntl = __builtin_amdgcn_readfirstlane(__hip_atomic_load(tilee + 511, __ATOMIC_RELAXED, __HIP_MEMORY_SCOPE_AGENT));
        pg8::MoeOrder S{(const char*)(ws + WS_R), (const char*)args.out, (const int*)(ws + WS_ROWTOK), tilee, 512, 1024, ntl * 4, C.G, C.vcu, true};
        pg8::EpiM1 E{(unsigned char*)(ws + WS_QH)};
        pg8::gemm_phase<pg8::EpiM1, pg8::MoeOrder, true, true>(ring, 512, S, E); REPSEAM(7);
    } SEAM(7);

    if (IN(8)) _Pragma("unroll") for (int rep = 0; rep < REPS(8); ++rep) {
        const int* tilee = (const int*)(ws + WS_TILEE);
        const int ntl = __builtin_amdgcn_readfirstlane(__hip_atomic_load(tilee + 511, __ATOMIC_RELAXED, __HIP_MEMORY_SCOPE_AGENT));
        pg8::MoeOrder S{(const char*)(ws + WS_QH), (const char*)args.out + 32 * MiB, (const int*)(ws + WS_ROWTOK), tilee, 256, 1024, ntl * 4, C.G, C.vcu, false};
        pg8::EpiM2 E{(unsigned char*)(ws + WS_Y)};
        pg8::gemm_phase<pg8::EpiM2, pg8::MoeOrder, false, true>(ring, 256, S, E); REPSEAM(8);
    } SEAM(8);

    if (IN(9)) { _Pragma("unroll") for (int rep = 0; rep < REPS(9); ++rep) { f_phase(C, args); REPSEAM(9); } }
    STAMP(10);
    if (STAMP_SEL >= 0 && blockIdx.x == STAMP_BLK && C.tid == 0) {
        const unsigned long long t0 = ((unsigned long long)C.MISC[17 + 2 * (STAMP_T0)] << 32) | C.MISC[16 + 2 * (STAMP_T0)], t1 = ((unsigned long long)C.MISC[17 + 2 * (STAMP_T1)] << 32) | C.MISC[16 + 2 * (STAMP_T1)];
        const unsigned long long w0 = __builtin_amdgcn_s_memrealtime(); while (__builtin_amdgcn_s_memrealtime() - w0 < 4ull * (t1 - t0)) __builtin_amdgcn_s_sleep(8); }
#undef IN
#undef SEAM
}

extern "C" void kernel_launch(void* const* d_in, const int* in_sizes, int n_in, void* d_out, int out_size, void* d_ws, size_t ws_size, hipStream_t stream) {
    static int grid = 0;
    if (grid == 0) {
        if (n_in != 19 || in_sizes[0] != NTOK * DM || out_size != NTOK * DM || ws_size < WS_END) { fprintf(stderr, "kernel_launch: unexpected problem shape / workspace; nothing launched\n"); grid = -1; return; }
        int dev = 0, cus = 0, per_cu = 0;
        if (hipGetDevice(&dev) != hipSuccess || hipDeviceGetAttribute(&cus, hipDeviceAttributeMultiprocessorCount, dev) != hipSuccess) { grid = -1; return; }
        if (hipFuncSetAttribute((const void*)mk_fwd, hipFuncAttributeMaxDynamicSharedMemorySize, LDS_BYTES) != hipSuccess) { fprintf(stderr, "kernel_launch: hipFuncSetAttribute failed\n"); grid = -1; return; }
        if (hipOccupancyMaxActiveBlocksPerMultiprocessor(&per_cu, (const void*)mk_fwd, NTHREADS, LDS_BYTES) != hipSuccess || per_cu < 1) { fprintf(stderr, "kernel_launch: occupancy query says %d\n", per_cu); }
        (void)hipGetLastError();
        grid = cus;
    }
    if (grid < 0) return;
    (void)hipMemsetAsync((char*)d_ws + WS_CTL, 0, CTL_ZERO_BYTES, stream);
    Args a{};
    for (int i = 0; i < 19; ++i) a.in[i] = (const float*)d_in[i];
    a.out = (float*)d_out; a.ws = (unsigned char*)d_ws;
    if (MK_N_LAUNCHES == 1) { a.ph_lo = 0; a.ph_hi = NPH; hipLaunchKernelGGL(mk_fwd, dim3(grid), dim3(NTHREADS), LDS_BYTES, stream, a); }
    else for (int p = 0; p < NPH; ++p) { a.ph_lo = p; a.ph_hi = p + 1; hipLaunchKernelGGL(mk_fwd, dim3(grid), dim3(NTHREADS), LDS_BYTES, stream, a); }
}
```

```cpp
#include <hip/hip_runtime.h>
#include <cstdio>
#include <cstdint>
#ifndef MK_N_LAUNCHES
#define MK_N_LAUNCHES 1
#endif
#define DI __device__ __forceinline__
#define GAS __attribute__((address_space(1)))
#define LAS __attribute__((address_space(3)))
typedef unsigned short bf16;
typedef unsigned u32x4 __attribute__((ext_vector_type(4)));
typedef unsigned u32x2 __attribute__((ext_vector_type(2)));
typedef float f32x4 __attribute__((ext_vector_type(4)));
typedef float f32x2 __attribute__((ext_vector_type(2)));
typedef float f32x16 __attribute__((ext_vector_type(16)));
typedef short bf16x8 __attribute__((ext_vector_type(8)));
typedef short s16x4 __attribute__((ext_vector_type(4)));
typedef short v4i16_t __attribute__((ext_vector_type(4)));
typedef __bf16 bf16x2_t __attribute__((ext_vector_type(2)));
typedef GAS unsigned gu32;

constexpr int NTOK = 32768, DM = 1024, SEQ = 2048, NBATCH = 16, NIN = 5632;
constexpr int NWAVES = 8, NTHREADS = 512;
constexpr float LN_EPS = 1e-5f, DN_ALPHA = 1.189207115002721f, LOG2E = 1.4426950408889634f;
constexpr int MOE_MAXTILES = 288;

constexpr size_t MiB = 1u << 20;
constexpr size_t WS_CTL = 0, CTL_ZERO_BYTES = 65536;
constexpr size_t WS_WIN = 1 * MiB, WS_WCAT = 12 * MiB, WS_WO = 14 * MiB;
constexpr size_t WS_XB = 16 * MiB;
constexpr size_t WS_R = 80 * MiB;
constexpr size_t WS_GB = 144 * MiB;
constexpr size_t WS_QH = 208 * MiB;
constexpr size_t WS_VH = 240 * MiB;
constexpr size_t WS_GH = 272 * MiB;
constexpr size_t WS_ZF = 304 * MiB;
constexpr size_t WS_OCAT = 306 * MiB;
constexpr size_t WS_QM = 368 * MiB, WS_KM = 400 * MiB;
constexpr size_t WS_VM = 432 * MiB;
constexpr size_t WS_Y = 16 * MiB;
constexpr size_t WS_MISC = 464 * MiB;
constexpr size_t WS_KMEAN = WS_MISC;
constexpr size_t WS_BPERM = WS_MISC + 1 * MiB;
constexpr size_t WS_WRH = WS_MISC + 2 * MiB;
constexpr size_t WS_WRL = WS_WRH + 98304;
constexpr size_t WS_TOKE = WS_MISC + 3 * MiB;
constexpr size_t WS_TOKW = WS_MISC + 4 * MiB;
constexpr size_t WS_TOKD = WS_MISC + 5 * MiB;
constexpr size_t WS_WGCNT = WS_MISC + 6 * MiB;
constexpr size_t WS_ROWTOK = WS_MISC + 7 * MiB;
constexpr size_t WS_TILEE = WS_MISC + 8 * MiB;
constexpr size_t WS_STATS = WS_MISC + 9 * MiB;
constexpr size_t WS_TABG = WS_MISC + 11 * MiB;
constexpr size_t WS_LB = WS_MISC + 10 * MiB;
constexpr size_t WS_KK = WS_MISC + 12 * MiB;
constexpr size_t WS_END = 512 * MiB;
constexpr int CW_BAR = 4096, CW_QUEUE = 8192, CW_QUEUE2 = 8192 + 1024;

constexpr int LDS_BYTES = 163840, MISC_OFF = LDS_BYTES - 256;

DI unsigned cvtpk(float lo, float hi) { f32x2 v = {lo, hi}; bf16x2_t b = __builtin_convertvector(v, bf16x2_t); return __builtin_bit_cast(unsigned, b); }
DI float bflo(unsigned w) { return __uint_as_float(w << 16); }
DI float bfhi(unsigned w) { return __uint_as_float(w & 0xffff0000u); }
DI float bf2f(unsigned short h) { return __uint_as_float((unsigned)h << 16); }
DI float frcp(float x) { return __builtin_amdgcn_rcpf(x); }
DI float fsigmoid(float x) { return frcp(1.f + __expf(-x)); }
DI float wave_sum(float v) {
#pragma unroll
    for (int o = 1; o < 64; o <<= 1) v += __shfl_xor(v, o);
    return v;
}
typedef int v8i __attribute__((ext_vector_type(8)));
typedef int v4i __attribute__((ext_vector_type(4)));
DI unsigned cvt4_fp8(float a, float b, float c, float d) { a = __builtin_amdgcn_fmed3f(a, -448.f, 448.f); b = __builtin_amdgcn_fmed3f(b, -448.f, 448.f); c = __builtin_amdgcn_fmed3f(c, -448.f, 448.f); d = __builtin_amdgcn_fmed3f(d, -448.f, 448.f);
    int w = 0; w = __builtin_amdgcn_cvt_pk_fp8_f32(a, b, w, false); w = __builtin_amdgcn_cvt_pk_fp8_f32(c, d, w, true); return (unsigned)w; }
DI f32x4 fp8x4_to_f32(unsigned w) { const f32x2 lo = __builtin_amdgcn_cvt_pk_f32_fp8((int)w, false), hi = __builtin_amdgcn_cvt_pk_f32_fp8((int)w, true); return (f32x4){lo[0], lo[1], hi[0], hi[1]}; }
constexpr float FP8_SXI = 8.f, FP8_SX = 8.f, FP8_SW = 32.f, FP8_SH = 4.f, FP8_SO = 4.f, FP8_SU = 32.f, FP8_SY = 64.f;
DI int crow(int r, int hi) { return (r & 3) + 8 * (r >> 2) + 4 * hi; }
#define MFMA32(a, b, c) __builtin_amdgcn_mfma_f32_32x32x16_bf16((a), (b), (c), 0, 0, 0)
#define MFMA16(a, b, c) __builtin_amdgcn_mfma_f32_16x16x32_bf16((a), (b), (c), 0, 0, 0)
DI s16x4 vtr(LAS const char* p) { return __builtin_bit_cast(s16x4, __builtin_amdgcn_ds_read_tr16_b64_v4i16((LAS v4i16_t*)p)); }

#define XB_TMO      128
#define XB_XCNT(j)  (256  + 64 * (j))
#define XB_XSUB(j)  (1280 + 64 * (j))
#define XB_XGEN(j)  (2304 + 64 * (j))
#define XB_TOP      3328
#define XB_TOPGEN   3392
#define XCD_BAR_WORDS 3456
#define XB_SPIN_CAP (1u << 22)
DI unsigned xb_ld(unsigned* p)              { return __hip_atomic_load(p, __ATOMIC_RELAXED, __HIP_MEMORY_SCOPE_AGENT); }
DI unsigned xb_add(unsigned* p, unsigned v) { return __hip_atomic_fetch_add(p, v, __ATOMIC_RELAXED, __HIP_MEMORY_SCOPE_AGENT); }
DI unsigned xb_xcc_id() { return (unsigned)__builtin_amdgcn_s_getreg((3 << 11) | 20) & 0xFu; }
#define XB_SPIN(cond, bar) do { unsigned _sp = 0; while (cond) { __builtin_amdgcn_s_sleep(1); \
    if ((++_sp & 255u) == 0u) { if (xb_ld(&(bar)[XB_TMO])) break; if (_sp > XB_SPIN_CAP) { atomicAdd(&(bar)[XB_TMO], 1u); break; } } } } while (0)
struct XcdBarrier { unsigned* bar; unsigned x; volatile LAS unsigned* st; };
DI XcdBarrier xcd_barrier_post(unsigned* bar, volatile LAS unsigned* st) {
    XcdBarrier b; b.bar = bar; b.x = xb_xcc_id(); b.st = st;
    if (threadIdx.x == 0) (void)xb_add(&bar[XB_XCNT(b.x)], 1u);
    return b;
}
DI void xcd_barrier_complete(unsigned* bar, unsigned x, unsigned& nloc, unsigned& nx) {
    const unsigned G = gridDim.x * gridDim.y * gridDim.z;
    unsigned sum, cnt, mine, sp = 0u;
    for (;;) {
        sum = 0u; cnt = 0u; mine = 0u;
#pragma unroll
        for (unsigned j = 0; j < 16; ++j) { const unsigned c = xb_ld(&bar[XB_XCNT(j)]); sum += c; cnt += (c > 0u) ? 1u : 0u; mine = (j == x) ? c : mine; }
        if (sum == G) break;
        __builtin_amdgcn_s_sleep(1);
        if ((++sp & 255u) == 0u) { if (xb_ld(&bar[XB_TMO])) break; if (sp > XB_SPIN_CAP) { atomicAdd(&bar[XB_TMO], 1u); break; } }
    }
    nloc = mine > 0u ? mine : 1u; nx = cnt > 0u ? cnt : 1u;
}
DI void xcd_barrier(const XcdBarrier& b) {
    asm volatile("s_waitcnt vmcnt(0)" ::: "memory");
    __syncthreads();
    if (threadIdx.x == 0) {
        unsigned* bar = b.bar;
        __builtin_amdgcn_s_waitcnt(0);
        unsigned nloc = b.st[0], nx = b.st[1];
        if (nloc == 0u) { xcd_barrier_complete(bar, b.x, nloc, nx); b.st[0] = nloc; b.st[1] = nx; }
        const unsigned old = xb_add(&bar[XB_XSUB(b.x)], 1u);
        const unsigned gen = old / nloc;
        if (old + 1u == (gen + 1u) * nloc) {
            __builtin_amdgcn_fence(__ATOMIC_RELEASE, "agent");
            asm volatile("s_waitcnt vmcnt(0)" ::: "memory");
            const unsigned og = xb_add(&bar[XB_TOP], 1u);
            const unsigned tg = og / nx;
            if (og + 1u == (tg + 1u) * nx) xb_add(&bar[XB_TOPGEN], 1u);
            else XB_SPIN(xb_ld(&bar[XB_TOPGEN]) == tg, bar);
            __builtin_amdgcn_fence(__ATOMIC_ACQUIRE, "agent");
            xb_add(&bar[XB_XGEN(b.x)], 1u);
            asm volatile("s_waitcnt vmcnt(0)" ::: "memory");
        } else {
            XB_SPIN(xb_ld(&bar[XB_XGEN(b.x)]) == gen, bar);
            __builtin_amdgcn_fence(__ATOMIC_ACQUIRE, "agent");
            asm volatile("s_waitcnt vmcnt(0)" ::: "memory");
        }
    }
    __syncthreads();
}

namespace pg8 {
constexpr int BM = 256, BK = 64, HALF = 128, HTB = HALF * BK * 2, STAGE_BYTES = 8 * HTB, NXCD = 8, WGM = 8;
DI int lds_byte(int r, int c) { const int st = (r >> 4) * 2 + (c >> 5), rr = r & 15, cc = c & 31, ob = rr * 64 + cc * 2; return st * 1024 + (ob ^ (((ob >> 9) & 1) << 5)); }
DI void stage_rc(int b, int& R, int& C) { const int st = b / 1024, sb = b % 1024, swz = sb ^ (((sb >> 9) & 1) << 5); R = (st >> 1) * 16 + swz / 64; C = (st & 1) * 32 + (swz % 64) / 2; }
DI int perm32(int rho) { const int n = rho >> 4, i = rho & 15; return 8 * (i >> 2) + 4 * n + (i & 3); }
struct Unit { int pm, pn, e; };

struct DenseOrder {
    const char* A; const char* Bt; int K, nM, nN, nwg, G, c;
    DI void init(const void* A_, const void* Bt_, int M, int N, int K_, int G_, int c_) { A = (const char*)A_; Bt = (const char*)Bt_; K = K_; nM = M / BM; nN = N / BM; nwg = nM * nN; G = G_; c = c_; }
    DI bool next(int i, Unit& u) const {
        const long L = (long)i * G + c; if (L >= nwg) return false;
        int wgid = (int)L; { const int q = nwg / NXCD, r = nwg % NXCD, xcd = wgid % NXCD, off = wgid / NXCD; wgid = (xcd < r ? xcd * (q + 1) : r * (q + 1) + (xcd - r) * q) + off; }
        const int nig = WGM * nN, gid = wgid / nig, fm = gid * WGM, gsz = (nM - fm) < WGM ? (nM - fm) : WGM;
        u.pm = fm + ((wgid % nig) % gsz); u.pn = (wgid % nig) / gsz; u.e = 0; return true;
    }
    DI const char* a_base(const Unit& u) const { return A + (size_t)u.pm * 512 * K; }
    DI const char* b_base(const Unit& u) const { return Bt + (size_t)u.pn * 512 * K; }
    DI void gather(const Unit&, const int (&)[2], const int (&)[2], unsigned (&)[2][2]) const {}
};
struct MoeOrder {
    const char* A; const char* Bt; const int* row_tok; const int* tile_e; int K, N, nunits, G, c; bool gat;
    DI bool next(int i, Unit& u) const {
        const int L = i * G + c; if (L >= nunits) return false;
        u.pm = L >> 2; u.pn = L & 3;
        u.e = __builtin_amdgcn_readfirstlane(__hip_atomic_load(tile_e + u.pm, __ATOMIC_RELAXED, __HIP_MEMORY_SCOPE_AGENT)); return true;
    }
    DI const char* a_base(const Unit& u) const { return gat ? A : A + (size_t)u.pm * 512 * K; }
    DI const char* b_base(const Unit& u) const { return Bt + ((size_t)u.e * N + (size_t)u.pn * 256) * K * 2; }
    DI void gather(const Unit& u, const int (&Rr)[2], const int (&Cc)[2], unsigned (&o)[2][2]) const {
#pragma unroll
        for (int h = 0; h < 2; ++h)
#pragma unroll
            for (int i = 0; i < 2; ++i) { const int tok = row_tok[u.pm * 256 + h * 128 + Rr[i]]; o[h][i] = (unsigned)(tok * K + Cc[i]) * 2u; }
    }
};

template <class Epi, class Sched, bool GATHER, bool FP8 = false>
DI void gemm_phase(LAS unsigned char* lds, const int K, const Sched& S, const Epi& E) {
    const int tid = threadIdx.x, wid = __builtin_amdgcn_readfirstlane(tid >> 6), lane = tid & 63, wr = wid >> 2, wc = wid & 3, fr = lane & 15, fq = lane >> 4;
    const int nt = K / BK;
    unsigned voffB[2], vA[2][2], nvA[2][2]; int Rr[2], Cc[2];
#pragma unroll
    for (int i = 0; i < 2; ++i) { int R, C; stage_rc(tid * 16 + i * 8192, R, C); Rr[i] = R; Cc[i] = C; const int Rb = (R & ~31) + perm32(R & 31);
        voffB[i] = (unsigned)(Rb * K + C) * 2u; vA[0][i] = (unsigned)(R * K + C) * 2u; vA[1][i] = (unsigned)((R + HALF) * K + C) * 2u; nvA[0][i] = vA[0][i]; nvA[1][i] = vA[1][i]; }
    const size_t kstep = (size_t)(BK * 2);
    const size_t hstep = (size_t)HALF * K * 2;
    const unsigned ldsw = (unsigned)wid * 1024u;
    const int aoff = lds_byte(wr * 64 + fr, fq * 8), boff = lds_byte(wc * 32 + fr, fq * 8);
#define PG8_SA(b, h) (((b) * 2 + (h)) * HTB)
#define PG8_SB(b, h) ((4 + (b) * 2 + (h)) * HTB)
#define PG8_STAGE(bufoff, gbase, voff) do { _Pragma("unroll") for (int _i = 0; _i < 2; ++_i) \
        __builtin_amdgcn_global_load_lds((const unsigned*)((const char*)(gbase) + (voff)[_i]), (LAS unsigned*)(lds + (bufoff) + ldsw + _i * 8192), 16, 0, 0); } while (0)
#define PG8_LDA(dst, b, h) do { if constexpr (FP8) { _Pragma("unroll") for (int m = 0; m < 4; ++m) dst##8[m] = __builtin_shufflevector(*(const LAS v4i*)(lds + PG8_SA(b, h) + aoff + m * 2048), *(const LAS v4i*)(lds + PG8_SA(b, h) + aoff + m * 2048 + 1024), 0, 1, 2, 3, 4, 5, 6, 7); } \
        else { _Pragma("unroll") for (int m = 0; m < 4; ++m) _Pragma("unroll") for (int k = 0; k < 2; ++k) dst[m][k] = *(const LAS bf16x8*)(lds + PG8_SA(b, h) + aoff + m * 2048 + k * 1024); } } while (0)
#define PG8_LDB(dst, b, h) do { if constexpr (FP8) { _Pragma("unroll") for (int n = 0; n < 2; ++n) dst##8[n] = __builtin_shufflevector(*(const LAS v4i*)(lds + PG8_SB(b, h) + boff + n * 2048), *(const LAS v4i*)(lds + PG8_SB(b, h) + boff + n * 2048 + 1024), 0, 1, 2, 3, 4, 5, 6, 7); } \
        else { _Pragma("unroll") for (int n = 0; n < 2; ++n) _Pragma("unroll") for (int k = 0; k < 2; ++k) dst[n][k] = *(const LAS bf16x8*)(lds + PG8_SB(b, h) + boff + n * 2048 + k * 1024); } } while (0)
#define PG8_CAT(x, y) __builtin_shufflevector(__builtin_bit_cast(v4i, (x)), __builtin_bit_cast(v4i, (y)), 0, 1, 2, 3, 4, 5, 6, 7)
#define PG8_MMA(ai, bj, At, Bt) do { __builtin_amdgcn_s_setprio(1); if constexpr (FP8) { _Pragma("unroll") for (int m = 0; m < 4; ++m) _Pragma("unroll") for (int n = 0; n < 2; ++n) \
        asm volatile("v_mfma_scale_f32_16x16x128_f8f6f4 %0, %1, %2, %0, %3, %3 op_sel_hi:[0,0,0]" : "+v"(acc[ai][bj][m][n]) : "v"(Bt##8[n]), "v"(At##8[m]), "v"(fp8_unit_scale)); } else { \
        _Pragma("unroll") for (int m = 0; m < 4; ++m) _Pragma("unroll") for (int n = 0; n < 2; ++n) _Pragma("unroll") for (int k = 0; k < 2; ++k) \
        acc[ai][bj][m][n] = __builtin_amdgcn_mfma_f32_16x16x32_bf16(Bt[n][k], At[m][k], acc[ai][bj][m][n], 0, 0, 0); } __builtin_amdgcn_s_setprio(0); } while (0)
#define PG8_WAIT_V(n) asm volatile("s_waitcnt vmcnt(" #n ")" ::: "memory")
#define PG8_WAIT_L(n) asm volatile("s_waitcnt lgkmcnt(" #n ")" ::: "memory")
#define PG8_BAR __builtin_amdgcn_s_barrier()
#define PG8_SCHED __builtin_amdgcn_sched_barrier(0)
    Unit cur, nxt; int ui = 0;
    if (!S.next(0, cur)) return;
    if constexpr (GATHER) S.gather(cur, Rr, Cc, vA);
    f32x4 acc[2][2][4][2];
#pragma unroll
    for (int a = 0; a < 2; ++a)
#pragma unroll
        for (int b = 0; b < 2; ++b)
#pragma unroll
            for (int m = 0; m < 4; ++m)
#pragma unroll
                for (int n = 0; n < 2; ++n) acc[a][b][m][n] = (f32x4){0.f, 0.f, 0.f, 0.f};
    bf16x8 At[4][2], B0[2][2], B1[2][2]; v8i At8[4], B08[2], B18[2]; const int fp8_unit_scale = 0x7f7f7f7f;
    const char* cA = S.a_base(cur); const char* cB = S.b_base(cur);
    PG8_STAGE(PG8_SB(0, 0), cB, voffB); PG8_STAGE(PG8_SB(0, 1), cB + hstep, voffB); PG8_STAGE(PG8_SA(0, 0), cA, vA[0]); PG8_STAGE(PG8_SA(0, 1), cA, vA[1]);
    if (wr == 1) PG8_BAR;
    PG8_WAIT_V(2); PG8_BAR;
    PG8_STAGE(PG8_SB(1, 0), cB + kstep, voffB); PG8_STAGE(PG8_SA(1, 0), cA + kstep, vA[0]); PG8_STAGE(PG8_SB(1, 1), cB + hstep + kstep, voffB);
    PG8_WAIT_V(6); PG8_BAR;
    for (;;) {
        const bool has_next = S.next(ui + 1, nxt);
        const char* nA = has_next ? S.a_base(nxt) : cA; const char* nB = has_next ? S.b_base(nxt) : cB;
        if constexpr (GATHER) {
            if (has_next) S.gather(nxt, Rr, Cc, nvA);
            else {
#pragma unroll
                for (int h = 0; h < 2; ++h) { nvA[h][0] = vA[h][0]; nvA[h][1] = vA[h][1]; } }
        }
#pragma unroll 1
        for (int t = 0; t < nt; t += 2) {
            const bool last = (t == nt - 2);
            if constexpr (Epi::HAS_MID) { if (t == (nt >> 1)) { if constexpr (FP8) asm volatile("s_nop 15\n\ts_nop 15" ::: "memory"); E.mid(acc, cur, wr, wc, fr, fq); if constexpr (FP8) asm volatile("s_nop 7" ::: "memory"); } }
            const char* a1 = cA + (size_t)(t + 1) * kstep;
            const char* a2 = last ? nA : cA + (size_t)(t + 2) * kstep; const char* b2 = last ? nB : cB + (size_t)(t + 2) * kstep;
            const char* a3 = a2 + kstep; const char* b3 = b2 + kstep;
            unsigned o0[2], o1[2];
            if constexpr (GATHER) { o0[0] = last ? nvA[0][0] : vA[0][0]; o0[1] = last ? nvA[0][1] : vA[0][1]; o1[0] = last ? nvA[1][0] : vA[1][0]; o1[1] = last ? nvA[1][1] : vA[1][1]; }
            else { o0[0] = vA[0][0]; o0[1] = vA[0][1]; o1[0] = vA[1][0]; o1[1] = vA[1][1]; }
            PG8_LDB(B0, 0, 0); PG8_LDB(B1, 0, 1); PG8_SCHED; PG8_LDA(At, 0, 0); PG8_STAGE(PG8_SA(1, 1), a1, vA[1]);
            PG8_WAIT_V(8); PG8_WAIT_L(0); PG8_BAR; PG8_MMA(0, 0, At, B0); PG8_MMA(0, 1, At, B1); PG8_BAR; PG8_SCHED;
            PG8_LDA(At, 0, 1); PG8_STAGE(PG8_SB(0, 0), b2, voffB); PG8_STAGE(PG8_SB(0, 1), b2 + hstep, voffB); PG8_STAGE(PG8_SA(0, 0), a2, o0);
            PG8_WAIT_V(8); PG8_WAIT_L(0); PG8_BAR; PG8_MMA(1, 0, At, B0); PG8_MMA(1, 1, At, B1); PG8_BAR; PG8_SCHED;
            PG8_LDB(B0, 1, 0); PG8_LDB(B1, 1, 1); PG8_SCHED; PG8_LDA(At, 1, 0); PG8_STAGE(PG8_SA(0, 1), a2, o1);
            PG8_WAIT_V(8); PG8_WAIT_L(0); PG8_BAR; PG8_MMA(0, 0, At, B0); PG8_MMA(0, 1, At, B1); PG8_BAR; PG8_SCHED;
            PG8_LDA(At, 1, 1); PG8_STAGE(PG8_SB(1, 0), b3, voffB); PG8_STAGE(PG8_SB(1, 1), b3 + hstep, voffB); PG8_STAGE(PG8_SA(1, 0), a3, o0);
            PG8_WAIT_V(8); PG8_WAIT_L(0); PG8_BAR; PG8_MMA(1, 0, At, B0); PG8_MMA(1, 1, At, B1); PG8_BAR; PG8_SCHED;
        }
        if (wr == 0) PG8_BAR;
        if constexpr (FP8) asm volatile("s_nop 15\n\ts_nop 15" ::: "memory");
        E(acc, cur, wr, wc, fr, fq);
        if (!has_next) break;
#pragma unroll
        for (int a = 0; a < 2; ++a)
#pragma unroll
            for (int b = 0; b < 2; ++b)
#pragma unroll
                for (int m = 0; m < 4; ++m)
#pragma unroll
                    for (int n = 0; n < 2; ++n) acc[a][b][m][n] = (f32x4){0.f, 0.f, 0.f, 0.f};
        cur = nxt; cA = nA; cB = nB; ++ui;
        if constexpr (GATHER) {
#pragma unroll
            for (int h = 0; h < 2; ++h) { vA[h][0] = nvA[h][0]; vA[h][1] = nvA[h][1]; } }
        if (wr == 1) PG8_BAR;
    }
    PG8_WAIT_V(0);
    PG8_BAR;
#undef PG8_SA
#undef PG8_SB
#undef PG8_STAGE
#undef PG8_LDA
#undef PG8_LDB
#undef PG8_MMA
#undef PG8_CAT
#undef PG8_WAIT_V
#undef PG8_WAIT_L
#undef PG8_BAR
#undef PG8_SCHED
}

typedef f32x4 Acc[2][2][4][2];
DI u32x4 pack8(const f32x4 a, const f32x4 b) { u32x4 w; w.x = cvtpk(a[0], a[1]); w.y = cvtpk(a[2], a[3]); w.z = cvtpk(b[0], b[1]); w.w = cvtpk(b[2], b[3]); return w; }
DI f32x4 silu4(const f32x4 v) { f32x4 o; o[0] = v[0] * fsigmoid(v[0]); o[1] = v[1] * fsigmoid(v[1]); o[2] = v[2] * fsigmoid(v[2]); o[3] = v[3] * fsigmoid(v[3]); return o; }

struct EpiIn {
    static constexpr bool HAS_MID = false;
    bf16 *Qh, *Vh, *Gh, *Qm, *Km, *Vm, *Rr, *Gb; float *Zf, *KM; const float* bias; bf16* KK; const float* LB; int pn_off;
    DI void operator()(Acc& acc, const Unit& u, int wr, int wc, int fr, int fq) const {
        const int pn = u.pn + pn_off, row0 = u.pm * BM + wr * 64 + fr, cl = wc * 32 + 8 * fq;
        if (pn_off) {
#pragma unroll
            for (int ai = 0; ai < 2; ++ai)
#pragma unroll
                for (int bj = 0; bj < 2; ++bj)
#pragma unroll
                    for (int m = 0; m < 4; ++m) { acc[ai][bj][m][0] *= (1.f / (FP8_SXI * FP8_SW)); acc[ai][bj][m][1] *= (1.f / (FP8_SXI * FP8_SW)); } }
        f32x4 bv[2][2];
#pragma unroll
        for (int bj = 0; bj < 2; ++bj)
#pragma unroll
            for (int n = 0; n < 2; ++n) bv[bj][n] = *(const f32x4*)(bias + pn * 256 + bj * HALF + cl + 4 * n);
        if (pn < 4) {
#define EI_DPP(v, ctrl) __int_as_float(__builtin_amdgcn_update_dpp(0, __float_as_int(v), ctrl, 0xf, 0xf, true))
            const int chb = pn * 128 + cl;
#pragma unroll
            for (int ai = 0; ai < 2; ++ai)
#pragma unroll
                for (int n = 0; n < 2; ++n) { const f32x4 lbv = *(const f32x4*)(LB + chb + 4 * n); f32x4 run = (f32x4){0.f, 0.f, 0.f, 0.f}, bmid = run; f32x4 bbv[4], kkv[4];
#pragma unroll
                    for (int m = 0; m < 4; ++m) {
#pragma unroll
                        for (int j = 0; j < 4; ++j) { const float z = acc[ai][1][m][n][j] + bv[1][n][j]; const float sg = frcp(1.f + __expf(-z)); const float lf = __logf(lbv[j] + (1.f - lbv[j]) * sg); kkv[m][j] = (1.f - lbv[j]) * (1.f - sg);
                            float t = lf; t += EI_DPP(t, 0xB1); t += EI_DPP(t, 0x4E); t += EI_DPP(t, 0x141); t += EI_DPP(t, 0x140);
                            float s = lf; s += EI_DPP(s, 0x111); s += EI_DPP(s, 0x112); s += EI_DPP(s, 0x114); s += EI_DPP(s, 0x118);
                            bbv[m][j] = s + run[j]; run[j] += t; }
                        if (m == 1) bmid = run; }
#pragma unroll
                    for (int m = 0; m < 4; ++m) { f32x4 qp, kp;
#pragma unroll
                        for (int j = 0; j < 4; ++j) { const float qx = acc[ai][0][m][n][j] + bv[0][n][j]; const float e = __expf(__builtin_amdgcn_fmed3f(bbv[m][j] - bmid[j], -60.f, 60.f)); qp[j] = qx * fsigmoid(qx) * e; kp[j] = kkv[m][j] * frcp(e); }
                        const size_t ro = (size_t)(row0 + ai * HALF + m * 16) * 512 + chb + 4 * n;
                        u32x2 qw, kw; qw.x = cvtpk(qp[0], qp[1]); qw.y = cvtpk(qp[2], qp[3]); kw.x = cvtpk(kp[0], kp[1]); kw.y = cvtpk(kp[2], kp[3]);
                        *(u32x2*)(Qh + ro) = qw; *(u32x2*)(KK + ro) = kw; }
                    if (fr == 0) { const size_t so = (size_t)(u.pm * 4 + ai * 2 + wr) * 512 + chb + 4 * n; *(f32x4*)(Zf + so) = bmid; *(f32x4*)(Zf + 262144 + so) = run; }
                    asm volatile("" ::: "memory"); }
#undef EI_DPP
        } else if (pn < 14) {
            const int seg = pn >> 1, c0 = (pn & 1) * 256 + cl;
            {
                bf16* O = seg == 2 ? Vh : seg == 3 ? Gh : seg == 4 ? Qm : seg == 5 ? Km : Vm;
                const int act = (seg == 3) ? 1 : (seg == 4 ? 2 : 0);
                if (seg == 5) {
#pragma unroll
                    for (int bj = 0; bj < 2; ++bj)
#pragma unroll
                        for (int n = 0; n < 2; ++n) { f32x4 cs = (f32x4){0.f, 0.f, 0.f, 0.f};
#pragma unroll
                            for (int ai = 0; ai < 2; ++ai)
#pragma unroll
                                for (int m = 0; m < 4; ++m) cs += acc[ai][bj][m][n] + bv[bj][n];
#pragma unroll
                            for (int j = 0; j < 4; ++j) { float s = cs[j]; s += __shfl_xor(s, 1); s += __shfl_xor(s, 2); s += __shfl_xor(s, 4); s += __shfl_xor(s, 8); cs[j] = s; }
                            if (fr == 0) *(f32x4*)(KM + (size_t)(u.pm * 2 + wr) * 512 + c0 + bj * HALF + 4 * n) = cs; }
                }
#pragma unroll
                for (int ai = 0; ai < 2; ++ai)
#pragma unroll
                    for (int m = 0; m < 4; ++m) { const int row = row0 + ai * HALF + m * 16;
                        bf16* rp = (seg >= 4) ? O + ((size_t)(row >> 11) * 8 * SEQ + (row & (SEQ - 1))) * 64 + (size_t)(c0 >> 6) * SEQ * 64 + (c0 & 63) : O + (size_t)row * 512 + c0;
                        const size_t bjs = (seg >= 4) ? (size_t)2 * SEQ * 64 : (size_t)HALF;
#pragma unroll
                        for (int bj = 0; bj < 2; ++bj) { f32x4 v0 = acc[ai][bj][m][0] + bv[bj][0], v1 = acc[ai][bj][m][1] + bv[bj][1];
                            if (act == 1) { v0 = silu4(v0); v1 = silu4(v1); } else if (act == 2) { v0 = v0 * (0.125f * LOG2E); v1 = v1 * (0.125f * LOG2E); }
                            *(u32x4*)(rp + bj * bjs) = pack8(v0, v1); }
                        asm volatile("" ::: "memory"); }
            }
        } else {
            const int c0 = (pn - 14) * 128 + cl;
#pragma unroll
            for (int ai = 0; ai < 2; ++ai)
#pragma unroll
                for (int m = 0; m < 4; ++m) { const size_t off = (size_t)(row0 + ai * HALF + m * 16) * 1024 + c0; f32x4 r[2], g[2];
#pragma unroll
                    for (int n = 0; n < 2; ++n) { const f32x4 a = acc[ai][0][m][n] + bv[0][n], b = acc[ai][1][m][n] + bv[1][n];
#pragma unroll
                        for (int j = 0; j < 4; ++j) { const float ea = __expf(-a[j]), eb = __expf(-b[j]); g[n][j] = frcp(1.f + eb); r[n][j] = (1.f + eb) * frcp(1.f + ea); } }
                    *(u32x4*)(Rr + off) = pack8(r[0], r[1]); *(u32x4*)(Gb + off) = pack8(g[0], g[1]); asm volatile("" ::: "memory"); }
        }
    }
};
struct EpiProj {
    static constexpr bool HAS_MID = true;
    const bf16 *Rr, *Gb; unsigned char* U;
    DI void scale(Acc& acc, const bf16* G, const Unit& u, int wr, int wc, int fr, int fq) const {
        int row0 = u.pm * BM + wr * 64 + fr, col0 = u.pn * BM + wc * 32 + 8 * fq;
        asm volatile("" : "+v"(row0), "+v"(col0));
#pragma unroll
        for (int ai = 0; ai < 2; ++ai)
#pragma unroll
            for (int mp = 0; mp < 2; ++mp) { u32x4 rv[2][2];
#pragma unroll
            for (int m = 0; m < 2; ++m)
#pragma unroll
                for (int bj = 0; bj < 2; ++bj) rv[m][bj] = *(const u32x4*)(G + (size_t)(row0 + ai * HALF + (2 * mp + m) * 16) * 1024 + col0 + bj * HALF);
#pragma unroll
            for (int m = 0; m < 2; ++m)
#pragma unroll
                for (int bj = 0; bj < 2; ++bj) { const u32x4 w = rv[m][bj];
                    acc[ai][bj][2 * mp + m][0] *= (f32x4){bflo(w.x), bfhi(w.x), bflo(w.y), bfhi(w.y)}; acc[ai][bj][2 * mp + m][1] *= (f32x4){bflo(w.z), bfhi(w.z), bflo(w.w), bfhi(w.w)}; }
            asm volatile("" ::: "memory"); }
    }
    DI void mid(Acc& acc, const Unit& u, int wr, int wc, int fr, int fq) const { scale(acc, Rr, u, wr, wc, fr, fq); }
    DI void operator()(Acc& acc, const Unit& u, int wr, int wc, int fr, int fq) const {
        scale(acc, Gb, u, wr, wc, fr, fq);
        const int row0 = u.pm * BM + wr * 64 + fr, col0 = u.pn * BM + wc * 32 + 8 * fq;
        constexpr float inv = FP8_SU / (FP8_SO * FP8_SW);
#pragma unroll
        for (int ai = 0; ai < 2; ++ai)
#pragma unroll
            for (int m = 0; m < 4; ++m) { unsigned char* rp = U + (size_t)(row0 + ai * HALF + m * 16) * 1024 + col0;
#pragma unroll
                for (int bj = 0; bj < 2; ++bj) { const f32x4 v0 = acc[ai][bj][m][0] * inv, v1 = acc[ai][bj][m][1] * inv; u32x2 w; w.x = cvt4_fp8(v0[0], v0[1], v0[2], v0[3]); w.y = cvt4_fp8(v1[0], v1[1], v1[2], v1[3]); *(u32x2*)(rp + bj * HALF) = w; } }
    }
};
struct EpiOut {
    static constexpr bool HAS_MID = false;
    const bf16* X; bf16* Pre;
    DI void operator()(Acc& acc, const Unit& u, int wr, int wc, int fr, int fq) const {
        int row0 = u.pm * BM + wr * 64 + fr, col0 = u.pn * BM + wc * 32 + 8 * fq;
        asm volatile("" : "+v"(row0), "+v"(col0));
        constexpr float inv = 1.f / (FP8_SU * FP8_SW);
#pragma unroll
        for (int ai = 0; ai < 2; ++ai) { u32x4 xv[4][2];
#pragma unroll
            for (int m = 0; m < 4; ++m)
#pragma unroll
                for (int bj = 0; bj < 2; ++bj) xv[m][bj] = *(const u32x4*)(X + (size_t)(row0 + ai * HALF + m * 16) * 1024 + col0 + bj * HALF);
#pragma unroll
            for (int m = 0; m < 4; ++m)
#pragma unroll
                for (int bj = 0; bj < 2; ++bj) { const u32x4 w = xv[m][bj];
                    const f32x4 v0 = (f32x4){bflo(w.x), bfhi(w.x), bflo(w.y), bfhi(w.y)} * DN_ALPHA + acc[ai][bj][m][0] * inv, v1 = (f32x4){bflo(w.z), bfhi(w.z), bflo(w.w), bfhi(w.w)} * DN_ALPHA + acc[ai][bj][m][1] * inv;
                    *(u32x4*)(Pre + (size_t)(row0 + ai * HALF + m * 16) * 1024 + col0 + bj * HALF) = pack8(v0, v1); }
            asm volatile("" ::: "memory"); }
    }
};
struct EpiM1 {
    static constexpr bool HAS_MID = false;
    unsigned char* H;
    DI void operator()(Acc& acc, const Unit& u, int wr, int wc, int fr, int fq) const {
        const int row0 = u.pm * BM + wr * 64 + fr, col0 = u.pn * 128 + wc * 32 + 8 * fq;
        constexpr float inv = 1.f / (FP8_SX * FP8_SW);
#pragma unroll
        for (int ai = 0; ai < 2; ++ai)
#pragma unroll
            for (int m = 0; m < 4; ++m) { const f32x4 h0 = silu4(acc[ai][0][m][0] * inv) * (acc[ai][1][m][0] * (inv * FP8_SH)), h1 = silu4(acc[ai][0][m][1] * inv) * (acc[ai][1][m][1] * (inv * FP8_SH));
                u32x2 w; w.x = cvt4_fp8(h0[0], h0[1], h0[2], h0[3]); w.y = cvt4_fp8(h1[0], h1[1], h1[2], h1[3]);
                *(u32x2*)(H + (size_t)(row0 + ai * HALF + m * 16) * 512 + col0) = w; }
    }
};
struct EpiM2 {
    static constexpr bool HAS_MID = false;
    unsigned char* Y;
    DI void operator()(Acc& acc, const Unit& u, int wr, int wc, int fr, int fq) const {
        const int row0 = u.pm * BM + wr * 64 + fr, col0 = u.pn * BM + wc * 32 + 8 * fq;
        constexpr float inv = FP8_SY / (FP8_SH * FP8_SW);
#pragma unroll
        for (int ai = 0; ai < 2; ++ai)
#pragma unroll
            for (int m = 0; m < 4; ++m) { unsigned char* rp = Y + (size_t)(row0 + ai * HALF + m * 16) * 1024 + col0;
#pragma unroll
                for (int bj = 0; bj < 2; ++bj) { const f32x4 v0 = acc[ai][bj][m][0] * inv, v1 = acc[ai][bj][m][1] * inv; u32x2 w; w.x = cvt4_fp8(v0[0], v0[1], v0[2], v0[3]); w.y = cvt4_fp8(v1[0], v1[1], v1[2], v1[3]); *(u32x2*)(rp + bj * HALF) = w; } }
    }
};
}

struct Args { const float* in[19]; float* out; unsigned char* ws; int ph_lo, ph_hi; };
enum { I_X = 0, I_WIN, I_BIN, I_LBL, I_HGNG, I_RELB, I_WPA, I_WPB, I_WOUT, I_LN1G, I_LN1B, I_WGRP, I_BGRP, I_WEXP, I_BEXP, I_WGU, I_WDN, I_LN2G, I_LN2B };

struct Ctx {
    LAS unsigned char* lds; volatile LAS unsigned* MISC;
    int tid, lane, wid, G, vcu;
    unsigned char* ws; gu32* ctl;
};

DI int t5_bucket(int d) { if (d < 16) return d; const int v = 16 + (int)(logf((float)d * (1.f / 16.f)) / logf(8.f) * 16.f); return v < 31 ? v : 31; }
DI int win_drow(int n0) { if (n0 < 512) return 256 * (n0 >> 7) + (n0 & 127); if (n0 < 1024) { const int r = n0 - 512; return 256 * (r >> 7) + 128 + (r & 127); }
    if (n0 < 3584) return n0; if (n0 < 4608) { const int r = n0 - 3584; return 3584 + 256 * (r >> 7) + (r & 127); } const int r = n0 - 4608; return 3584 + 256 * (r >> 7) + 128 + (r & 127); }
DI int wgu_drow(int n0) { if (n0 < 512) return 256 * (n0 >> 7) + (n0 & 127); const int r = n0 - 512; return 256 * (r >> 7) + 128 + (r & 127); }
DI int hswz(int row, int ch16) { return 256 * row + 16 * (ch16 ^ (((row & 3) << 2) | ((row >> 2) & 3))); }
DI int htr(int r0, int c0, int lane) { const int i16 = lane & 15, q = i16 >> 2, p = i16 & 3; return hswz(r0 + q, c0 + (p >> 1)) + 8 * (p & 1); }
DI void transpose_tile256(const float* W, int N, bf16* WT, int ldk, int n0, int mode, int dk, LAS unsigned char* lds, int lane, int wid, bool f8 = false) {
    asm volatile("" : "+v"(lane));
#pragma unroll
    for (int half = 0; half < 2; ++half) { f32x4 v[16];
#pragma unroll
        for (int i = 0; i < 16; ++i) v[i] = *(const f32x4*)(W + (size_t)(128 * half + 8 * i + wid) * N + 4 * lane);
#pragma unroll
        for (int i = 0; i < 16; ++i) { const int k = 128 * half + 8 * i + wid; u32x2 w; w.x = cvtpk(v[i][0], v[i][1]); w.y = cvtpk(v[i][2], v[i][3]);
            *(LAS u32x2*)(lds + (lane >> 5) * 65536 + hswz(k, (lane & 31) >> 1) + 8 * (lane & 1)) = w; } }
    __syncthreads();
    const int g = lane >> 4, i16 = lane & 15;
#pragma unroll
    for (int nb = 0; nb < 2; ++nb) { const int nl = 32 * wid + 16 * nb + i16, n = n0 + nl; const int dr = (mode == 0) ? n : (mode == 1 ? win_drow(n) : wgu_drow(n));
        bf16* orow = WT + (size_t)dr * ldk + dk + 8 * g; const LAS unsigned char* img = lds + (wid >> 2) * 65536;
#pragma unroll
        for (int s = 0; s < 8; ++s) { const int r0 = 32 * s + 8 * g, c0 = 4 * (wid & 3) + 2 * nb;
            const s16x4 lo = vtr((LAS const char*)(img + htr(r0, c0, lane))), hh = vtr((LAS const char*)(img + htr(r0 + 4, c0, lane)));
            if (f8) { u32x2 w; w.x = cvt4_fp8(bf2f((unsigned short)lo[0]) * FP8_SW, bf2f((unsigned short)lo[1]) * FP8_SW, bf2f((unsigned short)lo[2]) * FP8_SW, bf2f((unsigned short)lo[3]) * FP8_SW);
                w.y = cvt4_fp8(bf2f((unsigned short)hh[0]) * FP8_SW, bf2f((unsigned short)hh[1]) * FP8_SW, bf2f((unsigned short)hh[2]) * FP8_SW, bf2f((unsigned short)hh[3]) * FP8_SW);
                *(u32x2*)((unsigned char*)WT + (size_t)dr * ldk + dk + 8 * g + 32 * s) = w; }
            else *(bf16x8*)(orow + 32 * s) = (bf16x8){lo[0], lo[1], lo[2], lo[3], hh[0], hh[1], hh[2], hh[3]}; } }
    __syncthreads();
}
constexpr int MOE_CVT_TILES = 32 * 16 + 32 * 8;
DI void moe_cvt_tile(const Ctx& C, const Args& a, int it) {
    unsigned char* WguT = (unsigned char*)a.out; unsigned char* WdT = (unsigned char*)a.out + 32 * MiB;
    if (it < 512) { const int e = it >> 4, kt = (it >> 2) & 3, nt = it & 3;
        transpose_tile256(a.in[I_WGU] + (size_t)e * 1024 * 1024 + (size_t)(256 * kt) * 1024 + 256 * nt, 1024, (bf16*)(WguT + (size_t)e * 1024 * 1024), 1024, 256 * nt, 2, 256 * kt, C.lds, C.lane, C.wid, true); }
    else { const int r = it - 512, e = r >> 3, kt = (r >> 2) & 1, nt = r & 3;
        transpose_tile256(a.in[I_WDN] + (size_t)e * 512 * 1024 + (size_t)(256 * kt) * 1024 + 256 * nt, 1024, (bf16*)(WdT + (size_t)e * 1024 * 512), 512, 256 * nt, 0, 256 * kt, C.lds, C.lane, C.wid, true); }
}
DI void p0_prologue(const Ctx& C, const Args& a) {
    bf16* WinT = (bf16*)(C.ws + WS_WIN); bf16* Wcat = (bf16*)(C.ws + WS_WCAT); bf16* WoT = (bf16*)(C.ws + WS_WO);
    constexpr int I_IN = 4 * 22, I_PA = 2 * 4, I_O = 4 * 4, NITEMS = I_IN + 2 * I_PA + I_O;
    for (int it = C.vcu; it < NITEMS; it += C.G) {
        int r = it;
        if (r < I_IN) { const int kt = r / 22, nt = r % 22;
            if (nt < 4) transpose_tile256(a.in[I_WIN] + (size_t)(256 * kt) * NIN + 256 * nt, NIN, WinT, 1024, 256 * nt, 1, 256 * kt, C.lds, C.lane, C.wid);
            else transpose_tile256(a.in[I_WIN] + (size_t)(256 * kt) * NIN + 256 * nt, NIN, (bf16*)(C.ws + WS_WIN + 2 * MiB - (size_t)1024 * 1024), 1024, 256 * nt, 1, 256 * kt, C.lds, C.lane, C.wid, true);
            continue; } r -= I_IN;
        if (r < I_PA) { const int kt = r / 4, nt = r % 4; transpose_tile256(a.in[I_WPA] + (size_t)(256 * kt) * 1024 + 256 * nt, 1024, Wcat, 1024, 256 * nt, 0, 256 * kt, C.lds, C.lane, C.wid, true); continue; } r -= I_PA;
        if (r < I_PA) { const int kt = r / 4, nt = r % 4; transpose_tile256(a.in[I_WPB] + (size_t)(256 * kt) * 1024 + 256 * nt, 1024, Wcat, 1024, 256 * nt, 0, 512 + 256 * kt, C.lds, C.lane, C.wid, true); continue; } r -= I_PA;
        { const int kt = r / 4, nt = r % 4; transpose_tile256(a.in[I_WOUT] + (size_t)(256 * kt) * 1024 + 256 * nt, 1024, WoT, 1024, 256 * nt, 0, 256 * kt, C.lds, C.lane, C.wid, true); }
    }
    const int gw = C.vcu * NWAVES + C.wid, NGW = C.G * NWAVES; (void)gw; (void)NGW;
    const int gt = C.vcu * NTHREADS + C.tid, NT = C.G * NTHREADS;
    { const float* x = a.in[I_X]; bf16* Xb = (bf16*)(C.ws + WS_XB);
      unsigned char* Xq = (unsigned char*)a.out + 64 * MiB;
      for (int i = gt; i < NTOK * DM / 8; i += NT) { const f32x4 v0 = *(const f32x4*)(x + (size_t)i * 8), v1 = *(const f32x4*)(x + (size_t)i * 8 + 4); *(u32x4*)(Xb + (size_t)i * 8) = pg8::pack8(v0, v1);
          u32x2 q; q.x = cvt4_fp8(v0[0] * FP8_SXI, v0[1] * FP8_SXI, v0[2] * FP8_SXI, v0[3] * FP8_SXI); q.y = cvt4_fp8(v1[0] * FP8_SXI, v1[1] * FP8_SXI, v1[2] * FP8_SXI, v1[3] * FP8_SXI); *(u32x2*)(Xq + (size_t)i * 8) = q; } }
    { float* tg = (float*)(C.ws + WS_TABG); for (int i = gt; i < 8 * 129; i += NT) { const int hh = i / 129, d = i % 129; tg[hh * 132 + d] = (a.in[I_RELB][t5_bucket(d) * 8 + hh] - a.in[I_RELB][31 * 8 + hh]) * LOG2E; } }
    { float* lbp = (float*)(C.ws + WS_LB); for (int n = gt; n < 512; n += NT) lbp[n] = 1.f / (1.f + expf(a.in[I_LBL][512 + n] - a.in[I_LBL][n])); }
    { float* bp = (float*)(C.ws + WS_BPERM); const float* bin = a.in[I_BIN];
      for (int n = gt; n < NIN; n += NT) bp[win_drow(n & ~31) + (n & 31)] = bin[n]; }
    { bf16* wh = (bf16*)(C.ws + WS_WRH); bf16* wl = (bf16*)(C.ws + WS_WRL); const float* wg = a.in[I_WGRP]; const float* we = a.in[I_WEXP];
      for (int i = gt; i < 48 * 1024; i += NT) { const int j = i >> 10, k = i & 1023; float w = 0.f; if (j < 4) w = wg[k * 4 + j]; else if (j < 36) w = we[k * 32 + (j - 4)];
          const unsigned h = cvtpk(w, 0.f) & 0xffffu; const float r = w - bf2f((unsigned short)h); wh[i] = (bf16)h; wl[i] = (bf16)(cvtpk(r, 0.f) & 0xffffu); } }
}
constexpr int HG_BUF = 67072, HG_QP = 0, HG_KP = 16384, HG_V = 32768, HG_SC = 49152, HG_OB = 49664;
DI void hgrn_unit(const Ctx& C, const Args& a, int b, int h) {
    LAS unsigned char* L = C.lds;
    const int tid = C.tid, lane = C.lane, wid = C.wid;
    const int q32 = lane & 31, hi = lane >> 5, dh = (lane >> 4) & 1, dvb = wid & 3, tb = wid >> 2;
    const float* BM = (const float*)(C.ws + WS_ZF); const float* BE = BM + 262144;
    const bf16* Qh = (const bf16*)(C.ws + WS_QH); const bf16* Kh = (const bf16*)(C.ws + WS_KK); const bf16* Vh = (const bf16*)(C.ws + WS_VH); const bf16* Gh = (const bf16*)(C.ws + WS_GH);
    bf16* Ocat = (bf16*)(C.ws + WS_OCAT);
    const size_t rb = (size_t)b * SEQ;
    LAS float* NGS = (LAS float*)(L + 2 * HG_BUF);
    if (tid < 128) NGS[tid] = a.in[I_HGNG][h * 128 + tid];
    const int orow = tid >> 3, oseg = tid & 7;
    f32x16 T[4];
#pragma unroll
    for (int i = 0; i < 4; ++i)
#pragma unroll
        for (int r = 0; r < 16; ++r) T[i][r] = 0.f;
    u32x4 gr[2];
    const int drow = 8 * wid + (lane >> 4), dch = lane & 15;
#define HG_DMA(c) do { _Pragma("unroll") for (int p = 0; p < 2; ++p) { const int r_ = drow + 4 * p; const int sc_ = dch ^ (((r_ & 3) << 2) | ((r_ >> 2) & 3)); \
            const size_t g_ = (rb + (size_t)(c) * 64 + r_) * 512 + h * 128 + 8 * sc_; LAS unsigned char* d_ = L + ((c) & 1) * HG_BUF + (8 * wid + 4 * p) * 256; \
            __builtin_amdgcn_global_load_lds((const unsigned*)(Qh + g_), (LAS unsigned*)(d_ + HG_QP), 16, 0, 0); \
            __builtin_amdgcn_global_load_lds((const unsigned*)(Kh + g_), (LAS unsigned*)(d_ + HG_KP), 16, 0, 0); \
            __builtin_amdgcn_global_load_lds((const unsigned*)(Vh + g_), (LAS unsigned*)(d_ + HG_V), 16, 0, 0); } } while (0)
    float sm = 0.f, spe = 0.f, spm = 0.f;
#define HG_SCLOAD(c) do { if (tid < 128) { const size_t s_ = (size_t)(b * 32 + (c)) * 512 + h * 128 + tid; sm = BM[s_]; if ((c) > 0) { spe = BE[s_ - 512]; spm = BM[s_ - 512]; } } } while (0)
#define HG_SCALE(c) do { if (tid < 128) ((LAS float*)(L + ((c) & 1) * HG_BUF + HG_SC))[tid] = __expf(sm + (spe - spm)); } while (0)
    HG_DMA(0);
    HG_SCLOAD(0);
    HG_SCALE(0);
    asm volatile("s_waitcnt vmcnt(0)" ::: "memory");
    __syncthreads();
    for (int c = 0; c < 32; ++c) {
        const LAS unsigned char* B = L + (c & 1) * HG_BUF;
        if (c + 1 < 32) { HG_DMA(c + 1); HG_SCLOAD(c + 1); }
        int q32o = q32, hio = hi, laneo = lane; asm volatile("" : "+v"(q32o), "+v"(hio), "+v"(laneo));
        f32x16 oT;
#pragma unroll
        for (int r = 0; r < 16; ++r) oT[r] = 0.f;
        bf16x8 qb[8];
#pragma unroll
        for (int ks = 0; ks < 8; ++ks) qb[ks] = *(const LAS bf16x8*)(B + HG_QP + hswz(32 * tb + q32o, 2 * ks + hio));
#pragma unroll
        for (int sb = 0; sb < 2; ++sb) {
            if (sb <= tb) {
                bf16x8 ka[8];
#pragma unroll
                for (int ks = 0; ks < 8; ++ks) ka[ks] = *(const LAS bf16x8*)(B + HG_KP + hswz(32 * sb + q32o, 2 * ks + hio));
                s16x4 vl[2], vh[2];
#pragma unroll
                for (int s2 = 0; s2 < 2; ++s2) { const int r0 = 32 * sb + 16 * s2 + 4 * hio; vl[s2] = vtr((LAS const char*)(B + HG_V + htr(r0, 4 * dvb + 2 * dh, laneo))); vh[s2] = vtr((LAS const char*)(B + HG_V + htr(r0 + 8, 4 * dvb + 2 * dh, laneo))); }
                __builtin_amdgcn_sched_barrier(0);
                f32x16 pT;
#pragma unroll
                for (int r = 0; r < 16; ++r) pT[r] = 0.f;
#pragma unroll
                for (int ks = 0; ks < 8; ++ks) pT = MFMA32(ka[ks], qb[ks], pT);
                if (sb == tb) {
#pragma unroll
                    for (int r = 0; r < 16; ++r) if (crow(r, hi) > q32) pT[r] = 0.f;
                }
#pragma unroll
                for (int s2 = 0; s2 < 2; ++s2) { u32x4 pw; pw.x = cvtpk(pT[8 * s2 + 0], pT[8 * s2 + 1]); pw.y = cvtpk(pT[8 * s2 + 2], pT[8 * s2 + 3]); pw.z = cvtpk(pT[8 * s2 + 4], pT[8 * s2 + 5]); pw.w = cvtpk(pT[8 * s2 + 6], pT[8 * s2 + 7]);
                    oT = MFMA32(((bf16x8){vl[s2][0], vl[s2][1], vl[s2][2], vl[s2][3], vh[s2][0], vh[s2][1], vh[s2][2], vh[s2][3]}), __builtin_bit_cast(bf16x8, pw), oT); }
                __builtin_amdgcn_sched_barrier(0);
            }
        }
        { const size_t g0 = (rb + (size_t)c * 64 + orow) * 512 + h * 128 + 16 * oseg; gr[0] = *(const u32x4*)(Gh + g0); gr[1] = *(const u32x4*)(Gh + g0 + 8); }
        {
            u32x2 qq0[8], qq1[8];
            if (c > 0) {
#pragma unroll
                for (int i = 0; i < 4; ++i)
#pragma unroll
                    for (int s = 0; s < 2; ++s) { qq0[2 * i + s] = *(const LAS u32x2*)(B + HG_QP + hswz(32 * tb + q32o, 4 * i + 2 * s) + 8 * hio); qq1[2 * i + s] = *(const LAS u32x2*)(B + HG_QP + hswz(32 * tb + q32o, 4 * i + 2 * s + 1) + 8 * hio); }
            }
#pragma unroll
            for (int i = 0; i < 4; ++i)
#pragma unroll
                for (int g = 0; g < 4; ++g) { const f32x4 sc = *(const LAS f32x4*)(B + HG_SC + (32 * i + 8 * g + 4 * hio) * 4);
#pragma unroll
                    for (int j = 0; j < 4; ++j) T[i][4 * g + j] *= sc[j]; }
            __builtin_amdgcn_sched_barrier(0);
            if (c > 0) {
#pragma unroll
                for (int i = 0; i < 4; ++i)
#pragma unroll
                    for (int s = 0; s < 2; ++s) { u32x4 tw; tw.x = cvtpk(T[i][8 * s + 0], T[i][8 * s + 1]); tw.y = cvtpk(T[i][8 * s + 2], T[i][8 * s + 3]); tw.z = cvtpk(T[i][8 * s + 4], T[i][8 * s + 5]); tw.w = cvtpk(T[i][8 * s + 6], T[i][8 * s + 7]);
                        const u32x4 qw = (u32x4){qq0[2 * i + s].x, qq0[2 * i + s].y, qq1[2 * i + s].x, qq1[2 * i + s].y};
                        oT = MFMA32(__builtin_bit_cast(bf16x8, tw), __builtin_bit_cast(bf16x8, qw), oT); }
            }
        }
        { LAS unsigned char* OBp = L + (c & 1) * HG_BUF + HG_OB;
#pragma unroll
          for (int g = 0; g < 4; ++g) { u32x2 w; w.x = cvtpk(oT[4 * g], oT[4 * g + 1]); w.y = cvtpk(oT[4 * g + 2], oT[4 * g + 3]); *(LAS u32x2*)(OBp + (32 * tb + q32o) * 272 + (32 * dvb + 8 * g + 4 * hio) * 2) = w; } }
#pragma unroll
        for (int sp = 0; sp < 2; ++sp) {
            s16x4 vl[2], vh[2], kl[2][4], kh[2][4];
#pragma unroll
            for (int u = 0; u < 2; ++u) { const int r0 = 16 * (2 * sp + u) + 8 * hio;
                vl[u] = vtr((LAS const char*)(B + HG_V + htr(r0, 4 * dvb + 2 * dh, laneo))); vh[u] = vtr((LAS const char*)(B + HG_V + htr(r0 + 4, 4 * dvb + 2 * dh, laneo)));
#pragma unroll
                for (int i = 0; i < 4; ++i) { kl[u][i] = vtr((LAS const char*)(B + HG_KP + htr(r0, 4 * i + 2 * dh, laneo))); kh[u][i] = vtr((LAS const char*)(B + HG_KP + htr(r0 + 4, 4 * i + 2 * dh, laneo))); } }
            __builtin_amdgcn_sched_barrier(0);
#pragma unroll
            for (int u = 0; u < 2; ++u) { const bf16x8 vb = (bf16x8){vl[u][0], vl[u][1], vl[u][2], vl[u][3], vh[u][0], vh[u][1], vh[u][2], vh[u][3]};
#pragma unroll
                for (int i = 0; i < 4; ++i) T[i] = MFMA32(((bf16x8){kl[u][i][0], kl[u][i][1], kl[u][i][2], kl[u][i][3], kh[u][i][0], kh[u][i][1], kh[u][i][2], kh[u][i][3]}), vb, T[i]); }
            __builtin_amdgcn_sched_barrier(0);
        }
        if (c + 1 < 32) HG_SCALE(c + 1);
        asm volatile("s_waitcnt vmcnt(0)" ::: "memory");
        __syncthreads();
        { const LAS unsigned char* OBp = L + (c & 1) * HG_BUF + HG_OB + orow * 272 + oseg * 32;
          const u32x4 o0 = *(const LAS u32x4*)OBp, o1 = *(const LAS u32x4*)(OBp + 16);
          float ov[16];
          ov[0] = bflo(o0.x); ov[1] = bfhi(o0.x); ov[2] = bflo(o0.y); ov[3] = bfhi(o0.y); ov[4] = bflo(o0.z); ov[5] = bfhi(o0.z); ov[6] = bflo(o0.w); ov[7] = bfhi(o0.w);
          ov[8] = bflo(o1.x); ov[9] = bfhi(o1.x); ov[10] = bflo(o1.y); ov[11] = bfhi(o1.y); ov[12] = bflo(o1.z); ov[13] = bfhi(o1.z); ov[14] = bflo(o1.w); ov[15] = bfhi(o1.w);
          float ss = 0.f;
#pragma unroll
          for (int j = 0; j < 16; ++j) ss += ov[j] * ov[j];
          ss += __int_as_float(__builtin_amdgcn_update_dpp(0, __float_as_int(ss), 0xB1, 0xf, 0xf, true));
          ss += __int_as_float(__builtin_amdgcn_update_dpp(0, __float_as_int(ss), 0x4E, 0xf, 0xf, true));
          ss += __int_as_float(__builtin_amdgcn_update_dpp(0, __float_as_int(ss), 0x141, 0xf, 0xf, true));
          const float rs = __builtin_amdgcn_rsqf(ss * (1.f / 128.f) + LN_EPS);
          float ng[16];
#pragma unroll
          for (int i = 0; i < 4; ++i) { const f32x4 n_ = *(const LAS f32x4*)(NGS + 16 * oseg + 4 * i); ng[4 * i] = n_[0]; ng[4 * i + 1] = n_[1]; ng[4 * i + 2] = n_[2]; ng[4 * i + 3] = n_[3]; }
          float gvv[16];
          gvv[0] = bflo(gr[0].x); gvv[1] = bfhi(gr[0].x); gvv[2] = bflo(gr[0].y); gvv[3] = bfhi(gr[0].y); gvv[4] = bflo(gr[0].z); gvv[5] = bfhi(gr[0].z); gvv[6] = bflo(gr[0].w); gvv[7] = bfhi(gr[0].w);
          gvv[8] = bflo(gr[1].x); gvv[9] = bfhi(gr[1].x); gvv[10] = bflo(gr[1].y); gvv[11] = bfhi(gr[1].y); gvv[12] = bflo(gr[1].z); gvv[13] = bfhi(gr[1].z); gvv[14] = bflo(gr[1].w); gvv[15] = bfhi(gr[1].w);
          float rv[16];
#pragma unroll
          for (int j = 0; j < 16; ++j) rv[j] = ov[j] * (rs * FP8_SO) * ng[j] * gvv[j];
          u32x4 w0; w0.x = cvt4_fp8(rv[0], rv[1], rv[2], rv[3]); w0.y = cvt4_fp8(rv[4], rv[5], rv[6], rv[7]); w0.z = cvt4_fp8(rv[8], rv[9], rv[10], rv[11]); w0.w = cvt4_fp8(rv[12], rv[13], rv[14], rv[15]);
          unsigned char* op = (unsigned char*)Ocat + (rb + (size_t)c * 64 + orow) * 1024 + h * 128 + 16 * oseg;
          *(u32x4*)op = w0; }
    }
    __syncthreads();
#undef HG_DMA
#undef HG_SCALE
#undef HG_SCLOAD
}

constexpr int AT_NST = 8, AT_K = 0, AT_V = AT_NST * 8192, AT_KM = 2 * AT_NST * 8192, AT_TAB = AT_KM + 1792;
DI void glds16(const void* gsrc, unsigned lds_dst) { unsigned keep;
    asm volatile("s_mov_b32 %0, m0\n\ts_mov_b32 m0, %2\n\ts_nop 0\n\tglobal_load_lds_dwordx4 %1, off\n\ts_mov_b32 m0, %0" : "=&s"(keep) : "v"(gsrc), "s"(lds_dst) : "memory"); }
DI float max3f(float a, float b, float c) { float r; asm("v_max3_f32 %0, %1, %2, %3" : "=v"(r) : "v"(a), "v"(b), "v"(c)); return r; }
DI void attn_unit(const Ctx& C, const Args& a, int b, int h, int jq) {
    LAS unsigned char* L = C.lds;
    const int tid = C.tid, lane = C.lane, wid = C.wid, q32 = lane & 31, hi = lane >> 5;
    const bf16* Qm = (const bf16*)(C.ws + WS_QM); const bf16* Km = (const bf16*)(C.ws + WS_KM); const bf16* Vm = (const bf16*)(C.ws + WS_VM); const float* KM = (const float*)(C.ws + WS_KMEAN);
    bf16* Ocat = (bf16*)(C.ws + WS_OCAT);
    const int tq = jq * 256 + wid * 32 + q32;
    const size_t hb = (size_t)(b * 8 + h) * SEQ;
    const int drow = 8 * wid + (lane >> 3), dch = lane & 7;
    const bf16* ksrc = Km + (hb + drow) * 64 + 8 * (dch ^ ((drow >> 1) & 7));
    const bf16* vsrc = Vm + (hb + drow) * 64 + 8 * (dch ^ (((drow >> 1) & 1) << 2));
    const unsigned kdst = (unsigned)__builtin_amdgcn_readfirstlane((int)(unsigned)(size_t)(L + AT_K + wid * 1024)), vdst = (unsigned)__builtin_amdgcn_readfirstlane((int)(unsigned)(size_t)(L + AT_V + wid * 1024));
    const int nt = 4 * jq + 4;
#define AT_ISSUE(t) do { glds16(ksrc + (size_t)(t) * 4096, kdst + ((t) & 7) * 8192); glds16(vsrc + (size_t)(t) * 4096, vdst + ((t) & 7) * 8192); } while (0)
    AT_ISSUE(0); AT_ISSUE(1); AT_ISSUE(2); AT_ISSUE(3);
    bf16x8 qf[4];
#pragma unroll
    for (int ks = 0; ks < 4; ++ks) qf[ks] = *(const bf16x8*)(Qm + (hb + tq) * 64 + 16 * ks + 8 * hi);
    LAS float* kml = (LAS float*)(L + AT_KM); LAS float* tab = (LAS float*)(L + AT_TAB);
    if (tid < jq * 64) { const int n = tid >> 6, d = tid & 63; kml[tid] = KM[(size_t)((b * 8 + n) * 2 + 0) * 512 + h * 64 + d] + KM[(size_t)((b * 8 + n) * 2 + 1) * 512 + h * 64 + d]; }
    if (tid < 129) tab[tid] = ((const float*)(C.ws + WS_TABG))[h * 132 + tid];
    __syncthreads();
    unsigned sel = 0;
    {
        float g[7];
#pragma unroll
        for (int n = 0; n < 7; ++n) { g[n] = 0.f;
            if (n < jq) { float s = 0.f;
#pragma unroll
                for (int ks = 0; ks < 4; ++ks)
#pragma unroll
                    for (int j = 0; j < 8; ++j) s += bf2f((unsigned short)qf[ks][j]) * kml[n * 64 + 16 * ks + 8 * hi + j];
                s += __shfl_xor(s, 32); g[n] = s; } }
#pragma unroll
        for (int n = 0; n < 7; ++n) if (n < jq) { int rank = 0;
#pragma unroll
            for (int m = 0; m < 7; ++m) if (m != n && m < jq) rank += (g[m] > g[n] || (g[m] == g[n] && m < n)) ? 1 : 0;
            if (rank < 3) sel |= 1u << n; }
    }
    const float c31 = a.in[I_RELB][31 * 8 + h] * LOG2E;
    f32x16 lacc;
#pragma unroll
    for (int r = 0; r < 16; ++r) lacc[r] = 0.f;
    const bf16x8 ones8 = (bf16x8){0x3F80, 0x3F80, 0x3F80, 0x3F80, 0x3F80, 0x3F80, 0x3F80, 0x3F80};
    f32x16 negm;
#pragma unroll
    for (int r = 0; r < 16; ++r) negm[r] = c31;
    f32x16 o0, o1;
#pragma unroll
    for (int r = 0; r < 16; ++r) { o0[r] = 0.f; o1[r] = 0.f; }
    const int i16 = lane & 15, qq = i16 >> 2, pp = i16 & 3, dh = (lane >> 4) & 1, xsw = (qq >> 1) & 1;
    const int vb0 = (4 * hi + qq) * 128 + 64 * (0 ^ xsw) + 32 * dh + 8 * pp, vb1 = (4 * hi + qq) * 128 + 64 * (1 ^ xsw) + 32 * dh + 8 * pp;
    const int kxs = (q32 >> 1) & 7;
#if defined(STAMP_ACC) && STAMP_ACC == 2
    unsigned long long tl0_ = 0; if (tid == 0) tl0_ = __builtin_amdgcn_s_memrealtime();
#endif
    for (int kt = 0; kt < nt; ++kt) {
        if ((kt & 3) == 0) {
            asm volatile("s_waitcnt vmcnt(0)" ::: "memory");
            __builtin_amdgcn_s_barrier();
            asm volatile("" ::: "memory");
            if (kt + 4 < nt) { AT_ISSUE(kt + 4); AT_ISSUE(kt + 5); AT_ISSUE(kt + 6); AT_ISSUE(kt + 7); }
        }
        const int blk = kt >> 2; const bool own = (blk == jq);
        const bool active = !own || ((kt & 3) * 64 <= wid * 32 + 31);
        if (active) {
            const LAS unsigned char* Kc = L + AT_K + (kt & 7) * 8192; const LAS unsigned char* Vc = L + AT_V + (kt & 7) * 8192;
            bf16x8 kf[8];
#pragma unroll
            for (int ks = 0; ks < 4; ++ks) { const int ko = (((2 * ks + hi) ^ kxs) << 4); kf[2 * ks] = *(const LAS bf16x8*)(Kc + q32 * 128 + ko); kf[2 * ks + 1] = *(const LAS bf16x8*)(Kc + (32 + q32) * 128 + ko); }
            __builtin_amdgcn_sched_barrier(0);
            f32x16 s0 = negm, s1 = negm;
#pragma unroll
            for (int ks = 0; ks < 4; ++ks) { s0 = MFMA32(kf[2 * ks], qf[ks], s0); s1 = MFMA32(kf[2 * ks + 1], qf[ks], s1); }
            __builtin_amdgcn_sched_barrier(0);
            s16x4 vf[2][4][2];
#pragma unroll
            for (int j = 0; j < 4; ++j) { const int ro = 16 * j * 128;
                vf[0][j][0] = vtr((LAS const char*)(Vc + vb0 + ro)); vf[0][j][1] = vtr((LAS const char*)(Vc + vb0 + ro + 8 * 128));
                vf[1][j][0] = vtr((LAS const char*)(Vc + vb1 + ro)); vf[1][j][1] = vtr((LAS const char*)(Vc + vb1 + ro + 8 * 128)); }
            __builtin_amdgcn_sched_barrier(0);
            const bool near = (jq * 256 + wid * 32 - 64 * kt - 63) < 128;
            if (near) {
                const int dist0 = tq - 64 * kt - 4 * hi;
#pragma unroll
                for (int r = 0; r < 16; ++r) { const int d0 = dist0 - ((r & 3) + 8 * (r >> 2)), d1 = d0 - 32;
                    const int i0 = d0 < 0 ? 0 : (d0 > 128 ? 128 : d0), i1 = d1 < 0 ? 0 : (d1 > 128 ? 128 : d1);
                    const float t0 = tab[i0], t1 = tab[i1]; s0[r] += t0; s1[r] += t1; s0[r] = d0 < 0 ? -INFINITY : s0[r]; s1[r] = d1 < 0 ? -INFINITY : s1[r]; }
            }
            const bool lsel = own || ((sel >> blk) & 1u);
            float mx = max3f(s0[0], s1[0], s0[1]), mx2 = max3f(s1[1], s0[2], s1[2]);
#pragma unroll
            for (int r = 3; r < 15; r += 2) { mx = max3f(mx, s0[r], s1[r]); mx2 = max3f(mx2, s0[r + 1], s1[r + 1]); }
            mx = max3f(mx, s0[15], s1[15]); mx = fmaxf(mx, mx2);
            mx = lsel ? mx : -INFINITY;
            mx = fmaxf(mx, __shfl_xor(mx, 32));
            if (__any(mx > 4.0f)) {
                const float delta = fmaxf(mx, 0.f), alpha = __builtin_amdgcn_exp2f(-delta);
#pragma unroll
                for (int r = 0; r < 16; ++r) { o0[r] *= alpha; o1[r] *= alpha; lacc[r] *= alpha; negm[r] -= delta; s0[r] -= delta; s1[r] -= delta; }
            }
#pragma unroll
            for (int r = 0; r < 16; ++r) { s0[r] = __builtin_amdgcn_exp2f(s0[r]); s1[r] = __builtin_amdgcn_exp2f(s1[r]); }
            const unsigned pmask = lsel ? 0xffffffffu : 0u;
#pragma unroll
            for (int kb = 0; kb < 2; ++kb)
#pragma unroll
                for (int s2 = 0; s2 < 2; ++s2) {
                    u32x4 pw;
                    if (kb == 0) { pw.x = cvtpk(s0[8 * s2 + 0], s0[8 * s2 + 1]); pw.y = cvtpk(s0[8 * s2 + 2], s0[8 * s2 + 3]); pw.z = cvtpk(s0[8 * s2 + 4], s0[8 * s2 + 5]); pw.w = cvtpk(s0[8 * s2 + 6], s0[8 * s2 + 7]); }
                    else         { pw.x = cvtpk(s1[8 * s2 + 0], s1[8 * s2 + 1]); pw.y = cvtpk(s1[8 * s2 + 2], s1[8 * s2 + 3]); pw.z = cvtpk(s1[8 * s2 + 4], s1[8 * s2 + 5]); pw.w = cvtpk(s1[8 * s2 + 6], s1[8 * s2 + 7]); }
                    pw.x &= pmask; pw.y &= pmask; pw.z &= pmask; pw.w &= pmask;
                    const bf16x8 pf = __builtin_bit_cast(bf16x8, pw);
                    const s16x4 a0l = vf[0][2 * kb + s2][0], a0h = vf[0][2 * kb + s2][1], a1l = vf[1][2 * kb + s2][0], a1h = vf[1][2 * kb + s2][1];
                    o0 = MFMA32(((bf16x8){a0l[0], a0l[1], a0l[2], a0l[3], a0h[0], a0h[1], a0h[2], a0h[3]}), pf, o0);
                    o1 = MFMA32(((bf16x8){a1l[0], a1l[1], a1l[2], a1l[3], a1h[0], a1h[1], a1h[2], a1h[3]}), pf, o1);
                    lacc = MFMA32(ones8, pf, lacc);
                }
        }
    }
#if defined(STAMP_ACC) && STAMP_ACC == 2
    if (tid == 0 && blockIdx.x == 100) { const unsigned long long d_ = __builtin_amdgcn_s_memrealtime() - tl0_; const unsigned long long o_ = ((unsigned long long)C.MISC[45] << 32) | C.MISC[44]; const unsigned long long n_ = o_ + d_; C.MISC[44] = (unsigned)n_; C.MISC[45] = (unsigned)(n_ >> 32); }
#endif
    const float linv = 1.f / lacc[0];
    unsigned char* op = (unsigned char*)Ocat + ((size_t)b * SEQ + tq) * 1024 + 512 + h * 64;
    const float lsc = linv * FP8_SO;
#pragma unroll
    for (int g = 0; g < 4; ++g) { *(unsigned*)(op + 8 * g + 4 * hi) = cvt4_fp8(o0[4 * g] * lsc, o0[4 * g + 1] * lsc, o0[4 * g + 2] * lsc, o0[4 * g + 3] * lsc);
        *(unsigned*)(op + 32 + 8 * g + 4 * hi) = cvt4_fp8(o1[4 * g] * lsc, o1[4 * g + 1] * lsc, o1[4 * g + 2] * lsc, o1[4 * g + 3] * lsc); }
    __syncthreads();
#undef AT_ISSUE
}

#ifndef PROBE_HGX
#define PROBE_HGX 1
#endif
#ifndef PROBE_ATX
#define PROBE_ATX 1
#endif
#ifndef STAMP_SEL
#define STAMP_SEL -1
#endif
#ifndef STAMP_BLK
#define STAMP_BLK 0
#endif
#define STAMP(i) do { if (STAMP_SEL >= 0 && blockIdx.x == STAMP_BLK && C.tid == 0) { const unsigned long long t_ = __builtin_amdgcn_s_memrealtime(); C.MISC[16 + 2 * (i)] = (unsigned)t_; C.MISC[17 + 2 * (i)] = (unsigned)(t_ >> 32); } } while (0)
DI void p2_mixers(const Ctx& C, const Args& a, int rep) {
    for (int hx = 0; hx < PROBE_HGX; ++hx)
    for (int u = blockIdx.x; u < 64; u += C.G) hgrn_unit(C, a, u >> 2, u & 3);
    STAMP(11);
    unsigned* QA = (unsigned*)(C.ctl + CW_QUEUE + 64 * rep); unsigned* QC = (unsigned*)(C.ctl + CW_QUEUE2 + 64 * rep);
    constexpr int NA = 1024 * PROBE_ATX, NC = MOE_CVT_TILES;
    if (C.tid == 0) { C.MISC[0] = __hip_atomic_fetch_add(QA, 1u, __ATOMIC_RELAXED, __HIP_MEMORY_SCOPE_AGENT); C.MISC[1] = (rep == 0) ? __hip_atomic_fetch_add(QC, 1u, __ATOMIC_RELAXED, __HIP_MEMORY_SCOPE_AGENT) : (unsigned)NC; }
    __syncthreads();
    int qa = (int)C.MISC[0], qc = (int)C.MISC[1];
    __syncthreads();
    for (;;) {
        const bool doa = qa < NA, doc = qc < NC;
        if (!doa && !doc) break;
        unsigned na = (unsigned)NA, nc = (unsigned)NC;
        if (C.tid == 0) { if (doa) na = __hip_atomic_fetch_add(QA, 1u, __ATOMIC_RELAXED, __HIP_MEMORY_SCOPE_AGENT); if (doc) nc = __hip_atomic_fetch_add(QC, 1u, __ATOMIC_RELAXED, __HIP_MEMORY_SCOPE_AGENT); }
#ifdef STAMP_ACC
        unsigned long long ta_ = 0, tb_ = 0, tc_ = 0; if (C.tid == 0) ta_ = __builtin_amdgcn_s_memrealtime();
#endif
        if (doa) { const int q = qa / PROBE_ATX; attn_unit(C, a, (q & 127) >> 3, q & 7, 7 - (q >> 7)); }
#ifdef STAMP_ACC
        if (C.tid == 0) tb_ = __builtin_amdgcn_s_memrealtime();
#endif
        if (doc) moe_cvt_tile(C, a, qc);
#ifdef STAMP_ACC
        if (C.tid == 0 && blockIdx.x == 100) { tc_ = __builtin_amdgcn_s_memrealtime(); const unsigned long long d_ = (STAMP_ACC == 0) ? (tb_ - ta_) : (STAMP_ACC == 1 ? (tc_ - tb_) : 0ull);
            const unsigned long long o_ = ((unsigned long long)C.MISC[45] << 32) | C.MISC[44]; const unsigned long long n_ = o_ + d_; C.MISC[44] = (unsigned)n_; C.MISC[45] = (unsigned)(n_ >> 32); }
#endif
        if (C.tid == 0) { C.MISC[0] = na; C.MISC[1] = nc; }
        __syncthreads();
        qa = (int)C.MISC[0]; qc = (int)C.MISC[1];
        __syncthreads();
    }
    STAMP(12);
#ifdef STAMP_ACC
    if (C.tid == 0 && blockIdx.x == 100) { const unsigned long long n_ = ((unsigned long long)C.MISC[45] << 32) | C.MISC[44]; const unsigned long long w0 = __builtin_amdgcn_s_memrealtime(); while (__builtin_amdgcn_s_memrealtime() - w0 < 4ull * n_) __builtin_amdgcn_s_sleep(8); }
#endif
}

DI void r1_phase(const Ctx& C, const Args& a) {
    LAS unsigned char* L = C.lds;
    const int tid = C.tid, lane = C.lane, wid = C.wid;
    LAS float* LG = (LAS float*)L + wid * 16 * 48;
    LAS int* CNT = (LAS int*)(L + 32768);
    LAS float* G1 = (LAS float*)(L + 33024); LAS float* B1 = (LAS float*)(L + 37120);
    const bf16* Pre = (const bf16*)(C.ws + WS_ZF); unsigned char* X1q = (unsigned char*)(C.ws + WS_R); f32x2* stats = (f32x2*)(C.ws + WS_STATS);
    const bf16* WrH = (const bf16*)(C.ws + WS_WRH); const bf16* WrL = (const bf16*)(C.ws + WS_WRL);
    unsigned* tokE = (unsigned*)(C.ws + WS_TOKE); float* tokW = (float*)(C.ws + WS_TOKW); int* wgcnt = (int*)(C.ws + WS_WGCNT);
    for (int i = tid; i < 1024; i += NTHREADS) { G1[i] = a.in[I_LN1G][i]; B1[i] = a.in[I_LN1B][i]; }
    LAS unsigned char* WL = L + 45056;
    for (int i = tid; i < 48 * 128; i += NTHREADS) { const int r = i >> 7, c = i & 127; *(LAS u32x4*)(WL + r * 2064 + c * 16) = *(const u32x4*)(WrH + (size_t)r * 1024 + c * 8); }
    LAS float* RB = (LAS float*)(L + 41216);
    if (tid < 4) RB[tid] = a.in[I_BGRP][tid]; else if (tid < 36) RB[tid] = a.in[I_BEXP][tid - 4];
    const int m16 = lane & 15, kq = lane >> 4;
    for (int chunk = blockIdx.x; chunk < NTOK / 128; chunk += C.G) {
        if (tid < 32) CNT[tid] = 0;
        __syncthreads();
        const int tok0 = chunk * 128 + wid * 16;
        const bf16* xrow = Pre + (size_t)(tok0 + m16) * 1024 + 8 * kq;
        float s = 0.f, s2 = 0.f;
#pragma unroll 8
        for (int k0 = 0; k0 < 1024; k0 += 32) { const u32x4 w = *(const u32x4*)(xrow + k0); const f32x4 xa = (f32x4){bflo(w.x), bfhi(w.x), bflo(w.y), bfhi(w.y)}, xc = (f32x4){bflo(w.z), bfhi(w.z), bflo(w.w), bfhi(w.w)};
            s += (xa[0] + xa[1]) + (xa[2] + xa[3]) + (xc[0] + xc[1]) + (xc[2] + xc[3]);
            s2 += (xa[0] * xa[0] + xa[1] * xa[1]) + (xa[2] * xa[2] + xa[3] * xa[3]) + (xc[0] * xc[0] + xc[1] * xc[1]) + (xc[2] * xc[2] + xc[3] * xc[3]); }
        s += __shfl_xor(s, 16); s += __shfl_xor(s, 32); s2 += __shfl_xor(s2, 16); s2 += __shfl_xor(s2, 32);
        const float mean = s * (1.f / 1024.f); const float var = fmaxf(s2 * (1.f / 1024.f) - mean * mean, 0.f); const float rstd = 1.f / sqrtf(var + LN_EPS);
        if (kq == 0) stats[tok0 + m16] = (f32x2){mean, rstd};
        STAMP(13);
        f32x4 acc[3];
#pragma unroll
        for (int nb = 0; nb < 3; ++nb) acc[nb] = (f32x4){0.f, 0.f, 0.f, 0.f};
        unsigned char* xb = X1q + (size_t)(tok0 + m16) * 1024 + 8 * kq;
        const LAS unsigned char* wlp = WL + m16 * 2064 + 16 * kq;
#pragma unroll 1
        for (int kb = 0; kb < 4; ++kb) {
            u32x4 xw[8];
#pragma unroll
            for (int j = 0; j < 8; ++j) xw[j] = *(const u32x4*)(xrow + kb * 256 + 32 * j);
#pragma unroll
            for (int j = 0; j < 8; ++j) { const int k0 = kb * 256 + 32 * j;
                bf16x8 wh[3];
#pragma unroll
                for (int nb = 0; nb < 3; ++nb) wh[nb] = *(const LAS bf16x8*)(wlp + nb * 16 * 2064 + k0 * 2);
                const f32x4 xaj = (f32x4){bflo(xw[j].x), bfhi(xw[j].x), bflo(xw[j].y), bfhi(xw[j].y)}, xcj = (f32x4){bflo(xw[j].z), bfhi(xw[j].z), bflo(xw[j].w), bfhi(xw[j].w)};
                const f32x4 ya = (xaj - mean) * rstd * *(const LAS f32x4*)(G1 + k0 + 8 * kq) + *(const LAS f32x4*)(B1 + k0 + 8 * kq);
                const f32x4 yc = (xcj - mean) * rstd * *(const LAS f32x4*)(G1 + k0 + 8 * kq + 4) + *(const LAS f32x4*)(B1 + k0 + 8 * kq + 4);
                u32x4 hw; hw.x = cvtpk(ya[0], ya[1]); hw.y = cvtpk(ya[2], ya[3]); hw.z = cvtpk(yc[0], yc[1]); hw.w = cvtpk(yc[2], yc[3]);
                { u32x2 qw; qw.x = cvt4_fp8(ya[0] * FP8_SX, ya[1] * FP8_SX, ya[2] * FP8_SX, ya[3] * FP8_SX); qw.y = cvt4_fp8(yc[0] * FP8_SX, yc[1] * FP8_SX, yc[2] * FP8_SX, yc[3] * FP8_SX); *(u32x2*)(xb + k0) = qw; }
                u32x4 lw; lw.x = cvtpk(ya[0] - bflo(hw.x), ya[1] - bfhi(hw.x)); lw.y = cvtpk(ya[2] - bflo(hw.y), ya[3] - bfhi(hw.y)); lw.z = cvtpk(yc[0] - bflo(hw.z), yc[1] - bfhi(hw.z)); lw.w = cvtpk(yc[2] - bflo(hw.w), yc[3] - bfhi(hw.w));
                const bf16x8 xh = __builtin_bit_cast(bf16x8, hw), xl = __builtin_bit_cast(bf16x8, lw);
#pragma unroll
                for (int nb = 0; nb < 3; ++nb) { acc[nb] = MFMA16(wh[nb], xh, acc[nb]); acc[nb] = MFMA16(wh[nb], xl, acc[nb]); }
            }
        }
        STAMP(14);
#pragma unroll
        for (int nb = 0; nb < 3; ++nb)
#pragma unroll
            for (int r = 0; r < 4; ++r) LG[m16 * 48 + nb * 16 + 4 * kq + r] = acc[nb][r];
        asm volatile("s_waitcnt lgkmcnt(0)" ::: "memory");
        if (lane < 16) {
            const LAS float* lg = LG + lane * 48;
            float gl[4];
#pragma unroll
            for (int j = 0; j < 4; ++j) gl[j] = lg[j] + RB[j];
            int grp = 0; float gm = gl[0];
#pragma unroll
            for (int j = 1; j < 4; ++j) if (gl[j] > gm) { gm = gl[j]; grp = j; }
            float se = 0.f;
#pragma unroll
            for (int j = 0; j < 4; ++j) se += __expf(gl[j] - gm);
            const float pg = 1.f / se;
            float el[8];
#pragma unroll
            for (int j = 0; j < 8; ++j) el[j] = lg[4 + grp * 8 + j] + RB[4 + grp * 8 + j];
            int i0 = 0; float v0 = el[0];
#pragma unroll
            for (int j = 1; j < 8; ++j) if (el[j] > v0) { v0 = el[j]; i0 = j; }
            int i1 = -1; float v1 = -INFINITY;
#pragma unroll
            for (int j = 0; j < 8; ++j) if (j != i0 && el[j] > v1) { v1 = el[j]; i1 = j; }
            const float w0 = 1.f / (1.f + __expf(v1 - v0)), w1 = 1.f - w0;
            const int e0 = grp * 8 + i0, e1 = grp * 8 + i1;
            const int r0 = __hip_atomic_fetch_add(CNT + e0, 1, __ATOMIC_RELAXED, __HIP_MEMORY_SCOPE_WORKGROUP), r1 = __hip_atomic_fetch_add(CNT + e1, 1, __ATOMIC_RELAXED, __HIP_MEMORY_SCOPE_WORKGROUP);
            const int tok = tok0 + lane;
            tokE[tok] = (unsigned)e0 | ((unsigned)e1 << 8) | ((unsigned)r0 << 16) | ((unsigned)r1 << 24);
            tokW[tok * 2] = w0 * pg; tokW[tok * 2 + 1] = w1 * pg;
        }
        __syncthreads();
        if (tid < 32) wgcnt[chunk * 32 + tid] = CNT[tid];
        __syncthreads();
    }
}

DI void r2_phase(const Ctx& C, const Args& a) {
    LAS int* PA = (LAS int*)C.lds;
    LAS int* PB = PA + 512;
    LAS int* TOT = PB + 512; LAS int* BASE = TOT + 32; LAS int* PST = BASE + 32;
    const int tid = C.tid;
    const int* wgcnt = (const int*)(C.ws + WS_WGCNT); const unsigned* tokE = (const unsigned*)(C.ws + WS_TOKE);
    int* tokD = (int*)(C.ws + WS_TOKD); int* rowtok = (int*)(C.ws + WS_ROWTOK); int* tilee = (int*)(C.ws + WS_TILEE);
    for (int chunk = blockIdx.x; chunk < NTOK / 128; chunk += C.G) {
        { const int e = tid & 31, part = tid >> 5; int sa = 0, sb = 0;
          for (int c = part * 16; c < part * 16 + 16; ++c) { const int v = wgcnt[c * 32 + e]; sa += v; sb += (c < chunk) ? v : 0; }
          PA[part * 32 + e] = sa; PB[part * 32 + e] = sb; }
        __syncthreads();
        if (tid < 32) { int sa = 0, sb = 0; for (int p = 0; p < 16; ++p) { sa += PA[p * 32 + tid]; sb += PB[p * 32 + tid]; } TOT[tid] = sa; BASE[tid] = sb; }
        __syncthreads();
        if (tid == 0) { int ps = 0; for (int e = 0; e < 32; ++e) { PST[e] = ps; ps += ((TOT[e] + 255) >> 8) << 8; } PST[32] = ps; }
        __syncthreads();
        if (tid < 128) { const int tok = chunk * 128 + tid; const unsigned w = tokE[tok]; const int e0 = w & 31, e1 = (w >> 8) & 31, r0 = (w >> 16) & 255, r1 = (w >> 24) & 255;
            const int d0 = PST[e0] + BASE[e0] + r0, d1 = PST[e1] + BASE[e1] + r1; rowtok[d0] = tok; rowtok[d1] = tok; tokD[tok * 2] = d0; tokD[tok * 2 + 1] = d1; }
        if (chunk < 32) { const int e = chunk, end = PST[e + 1] - PST[e]; for (int i = TOT[e] + tid; i < end; i += NTHREADS) rowtok[PST[e] + i] = 0; }
        if (chunk == 0) { if (tid < 32) { for (int t = PST[tid] >> 8; t < (PST[tid + 1] >> 8); ++t) tilee[t] = tid; } if (tid == 0) tilee[511] = PST[32] >> 8; }
        __syncthreads();
    }
}

DI void f_phase(const Ctx& C, const Args& a) {
    const int lane = C.lane, gw = C.vcu * NWAVES + C.wid, NGW = C.G * NWAVES;
    const bf16* Pre = (const bf16*)(C.ws + WS_ZF); const unsigned char* Y = (const unsigned char*)(C.ws + WS_Y); const int* tokD = (const int*)(C.ws + WS_TOKD); const float* tokW = (const float*)(C.ws + WS_TOKW);
    const f32x2* stats = (const f32x2*)(C.ws + WS_STATS);
    f32x4 g2[4], b2[4], g1[4], b1[4];
#pragma unroll
    for (int j = 0; j < 4; ++j) { g2[j] = *(const f32x4*)(a.in[I_LN2G] + 256 * j + 4 * lane); b2[j] = *(const f32x4*)(a.in[I_LN2B] + 256 * j + 4 * lane);
        g1[j] = *(const f32x4*)(a.in[I_LN1G] + 256 * j + 4 * lane) * DN_ALPHA; b1[j] = *(const f32x4*)(a.in[I_LN1B] + 256 * j + 4 * lane) * DN_ALPHA; }
    for (int tok = gw; tok < NTOK; tok += NGW) {
        const int d0 = tokD[tok * 2], d1 = tokD[tok * 2 + 1]; const float w0 = tokW[tok * 2] * (1.f / FP8_SY), w1 = tokW[tok * 2 + 1] * (1.f / FP8_SY); const f32x2 st = stats[tok];
        const bf16* xr = Pre + (size_t)tok * 1024 + 4 * lane; const unsigned char* y0 = Y + (size_t)d0 * 1024 + 4 * lane; const unsigned char* y1 = Y + (size_t)d1 * 1024 + 4 * lane;
        f32x4 v[4]; float s = 0.f;
#pragma unroll
        for (int j = 0; j < 4; ++j) { const u32x2 xw = *(const u32x2*)(xr + 256 * j); const f32x4 x = (f32x4){bflo(xw.x), bfhi(xw.x), bflo(xw.y), bfhi(xw.y)}; const unsigned p0 = *(const unsigned*)(y0 + 256 * j), p1 = *(const unsigned*)(y1 + 256 * j);
            v[j] = ((x - st.x) * st.y) * g1[j] + b1[j] + fp8x4_to_f32(p0) * w0 + fp8x4_to_f32(p1) * w1;
            s += (v[j][0] + v[j][1]) + (v[j][2] + v[j][3]); }
        const float mean = wave_sum(s) * (1.f / 1024.f); float s2 = 0.f;
#pragma unroll
        for (int j = 0; j < 4; ++j) { v[j] = v[j] - mean; s2 += (v[j][0] * v[j][0] + v[j][1] * v[j][1]) + (v[j][2] * v[j][2] + v[j][3] * v[j][3]); }
        const float rstd = 1.f / sqrtf(wave_sum(s2) * (1.f / 1024.f) + LN_EPS);
        float* orow = a.out + (size_t)tok * 1024 + 4 * lane;
#pragma unroll
        for (int j = 0; j < 4; ++j) *(f32x4*)(orow + 256 * j) = v[j] * rstd * g2[j] + b2[j];
    }
}

constexpr int NPH = 10;
__global__ void __launch_bounds__(NTHREADS, 2) mk_fwd(Args args) {
    extern __shared__ __attribute__((aligned(16))) unsigned char lds_raw[];
    Ctx C;
    C.lds = (LAS unsigned char*)lds_raw; C.MISC = (volatile LAS unsigned*)(C.lds + MISC_OFF);
    C.tid = threadIdx.x; C.lane = C.tid & 63; C.wid = __builtin_amdgcn_readfirstlane(C.tid >> 6);
    C.G = gridDim.x; { const int bx = blockIdx.x; C.vcu = (C.G % 8 == 0) ? (bx % 8) * (C.G / 8) + bx / 8 : bx; }
    C.ws = args.ws; C.ctl = (gu32*)(args.ws + WS_CTL);
    if (C.tid < 64) C.MISC[C.tid] = 0u;
    __syncthreads();
    XcdBarrier bar; bar.bar = (unsigned*)(C.ctl + CW_BAR); bar.x = 0; bar.st = nullptr;
    if (MK_N_LAUNCHES == 1) bar = xcd_barrier_post((unsigned*)(C.ctl + CW_BAR), C.MISC + 8);
    const int lo = args.ph_lo, hi = args.ph_hi;
#ifndef PH_MASK
#define PH_MASK 0x3ff
#endif
#define IN(k) (((PH_MASK >> (k)) & 1) && lo <= (k) && (k) < hi)
#ifndef STAMP_SEL
#define STAMP_SEL -1
#endif
#ifndef STAMP_T0
#define STAMP_T0 STAMP_SEL
#define STAMP_T1 (STAMP_SEL + 1)
#endif
#define SEAM(k) do { if (IN(k) && IN((k) + 1)) xcd_barrier(bar); STAMP((k) + 1); } while (0)
#ifndef PROBE_PHASE
#define PROBE_PHASE -1
#endif
#define REPS(k) ((PROBE_PHASE == (k)) ? 2 : 1)
#define REPSEAM(k) do { if (rep + 1 < REPS(k)) xcd_barrier(bar); } while (0)
    unsigned char* ws = args.ws;
    LAS unsigned char* ring = C.lds;

    STAMP(0);
    if (IN(0)) { _Pragma("unroll") for (int rep = 0; rep < REPS(0); ++rep) { p0_prologue(C, args); REPSEAM(0); } } SEAM(0);

    if (IN(1)) _Pragma("unroll") for (int rep = 0; rep < REPS(1); ++rep) {
        pg8::EpiIn E{(bf16*)(ws + WS_QH), (bf16*)(ws + WS_VH), (bf16*)(ws + WS_GH), (bf16*)(ws + WS_QM), (bf16*)(ws + WS_KM), (bf16*)(ws + WS_VM), (bf16*)(ws + WS_R), (bf16*)(ws + WS_GB),
                     (float*)(ws + WS_ZF), (float*)(ws + WS_KMEAN), (const float*)(ws + WS_BPERM), (bf16*)(ws + WS_KK), (const float*)(ws + WS_LB), 0};
        { pg8::DenseOrder S; S.init(ws + WS_XB, ws + WS_WIN, NTOK, 1024, 1024, C.G, (int)blockIdx.x);
          pg8::gemm_phase<pg8::EpiIn, pg8::DenseOrder, false>(ring, 1024, S, E); }
        { E.pn_off = 4; pg8::DenseOrder S; S.init((unsigned char*)args.out + 64 * MiB, ws + WS_WIN + 2 * MiB, NTOK, 4608, 512, C.G, (int)blockIdx.x);
          pg8::gemm_phase<pg8::EpiIn, pg8::DenseOrder, false, true>(ring, 512, S, E); }
        REPSEAM(1);
    } SEAM(1);

#ifndef PROBE_P2X
#define PROBE_P2X 1
#endif
    if (IN(2)) { for (int rep = 0; rep < PROBE_P2X; ++rep) { p2_mixers(C, args, rep); if (rep + 1 < PROBE_P2X) xcd_barrier(bar); } } SEAM(2);

    if (IN(3)) _Pragma("unroll") for (int rep = 0; rep < REPS(3); ++rep) {
        pg8::DenseOrder S; S.init(ws + WS_OCAT, ws + WS_WCAT, NTOK, 1024, 512, C.G, (int)blockIdx.x);
        pg8::EpiProj E{(const bf16*)(ws + WS_R), (const bf16*)(ws + WS_GB), (unsigned char*)(ws + WS_QH)};
        pg8::gemm_phase<pg8::EpiProj, pg8::DenseOrder, false, true>(ring, 512, S, E); REPSEAM(3);
    } SEAM(3);

    if (IN(4)) _Pragma("unroll") for (int rep = 0; rep < REPS(4); ++rep) {
        pg8::DenseOrder S; S.init(ws + WS_QH, ws + WS_WO, NTOK, 1024, 512, C.G, (int)blockIdx.x);
        pg8::EpiOut E{(const bf16*)(ws + WS_XB), (bf16*)(ws + WS_ZF)};
        pg8::gemm_phase<pg8::EpiOut, pg8::DenseOrder, false, true>(ring, 512, S, E);
        REPSEAM(4);
    } SEAM(4);

    if (IN(5)) { _Pragma("unroll") for (int rep = 0; rep < REPS(5); ++rep) { r1_phase(C, args); REPSEAM(5); } } STAMP(15); SEAM(5);
    if (IN(6)) { _Pragma("unroll") for (int rep = 0; rep < REPS(6); ++rep) { r2_phase(C, args); REPSEAM(6); } } SEAM(6);

    if (IN(7)) _Pragma("unroll") for (int rep = 0; rep < REPS(7); ++rep) {
        const int* tilee = (const int*)(ws + WS_TILEE);
        const int ntl = __builtin_amdgcn_readfirstlane(__hip_atomic_load(tilee + 511, __ATOMIC_RELAXED, __HIP_MEMORY_SCOPE_AGENT));
        pg8::MoeOrder S{(const char*)(ws + WS_R), (const char*)args.out, (const int*)(ws + WS_ROWTOK), tilee, 512, 1024, ntl * 4, C.G, C.vcu, true};
        pg8::EpiM1 E{(unsigned char*)(ws + WS_QH)};
        pg8::gemm_phase<pg8::EpiM1, pg8::MoeOrder, true, true>(ring, 512, S, E); REPSEAM(7);
    } SEAM(7);

    if (IN(8)) _Pragma("unroll") for (int rep = 0; rep < REPS(8); ++rep) {
        const int* tilee = (const int*)(ws + WS_TILEE);
        const int ntl = __builtin_amdgcn_readfirstlane(__hip_atomic_load(tilee + 511, __ATOMIC_RELAXED, __HIP_MEMORY_SCOPE_AGENT));
        pg8::MoeOrder S{(const char*)(ws + WS_QH), (const char*)args.out + 32 * MiB, (const int*)(ws + WS_ROWTOK), tilee, 256, 1024, ntl * 4, C.G, C.vcu, false};
        pg8::EpiM2 E{(unsigned char*)(ws + WS_Y)};
        pg8::gemm_phase<pg8::EpiM2, pg8::MoeOrder, false, true>(ring, 256, S, E); REPSEAM(8);
    } SEAM(8);

    if (IN(9)) { _Pragma("unroll") for (int rep = 0; rep < REPS(9); ++rep) { f_phase(C, args); REPSEAM(9); } }
    STAMP(10);
    if (STAMP_SEL >= 0 && blockIdx.x == STAMP_BLK && C.tid == 0) {
        const unsigned long long t0 = ((unsigned long long)C.MISC[17 + 2 * (STAMP_T0)] << 32) | C.MISC[16 + 2 * (STAMP_T0)], t1 = ((unsigned long long)C.MISC[17 + 2 * (STAMP_T1)] << 32) | C.MISC[16 + 2 * (STAMP_T1)];
        const unsigned long long w0 = __builtin_amdgcn_s_memrealtime(); while (__builtin_amdgcn_s_memrealtime() - w0 < 4ull * (t1 - t0)) __builtin_amdgcn_s_sleep(8); }
#undef IN
#undef SEAM
}

extern "C" void kernel_launch(void* const* d_in, const int* in_sizes, int n_in, void* d_out, int out_size, void* d_ws, size_t ws_size, hipStream_t stream) {
    static int grid = 0;
    if (grid == 0) {
        if (n_in != 19 || in_sizes[0] != NTOK * DM || out_size != NTOK * DM || ws_size < WS_END) { fprintf(stderr, "kernel_launch: unexpected problem shape / workspace; nothing launched\n"); grid = -1; return; }
        int dev = 0, cus = 0, per_cu = 0;
        if (hipGetDevice(&dev) != hipSuccess || hipDeviceGetAttribute(&cus, hipDeviceAttributeMultiprocessorCount, dev) != hipSuccess) { grid = -1; return; }
        if (hipFuncSetAttribute((const void*)mk_fwd, hipFuncAttributeMaxDynamicSharedMemorySize, LDS_BYTES) != hipSuccess) { fprintf(stderr, "kernel_launch: hipFuncSetAttribute failed\n"); grid = -1; return; }
        if (hipOccupancyMaxActiveBlocksPerMultiprocessor(&per_cu, (const void*)mk_fwd, NTHREADS, LDS_BYTES) != hipSuccess || per_cu < 1) { fprintf(stderr, "kernel_launch: occupancy query says %d\n", per_cu); }
        (void)hipGetLastError();
        grid = cus;
    }
    if (grid < 0) return;
    (void)hipMemsetAsync((char*)d_ws + WS_CTL, 0, CTL_ZERO_BYTES, stream);
    Args a{};
    for (int i = 0; i < 19; ++i) a.in[i] = (const float*)d_in[i];
    a.out = (float*)d_out; a.ws = (unsigned char*)d_ws;
    if (MK_N_LAUNCHES == 1) { a.ph_lo = 0; a.ph_hi = NPH; hipLaunchKernelGGL(mk_fwd, dim3(grid), dim3(NTHREADS), LDS_BYTES, stream, a); }
    else for (int p = 0; p < NPH; ++p) { a.ph_lo = p; a.ph_hi = p + 1; hipLaunchKernelGGL(mk_fwd, dim3(grid), dim3(NTHREADS), LDS_BYTES, stream, a); }
}
```

```cpp
#include <hip/hip_runtime.h>
#include <cstdio>
#include <cstdint>
#ifndef MK_N_LAUNCHES
#define MK_N_LAUNCHES 1
#endif
#define DI __device__ __forceinline__
#define GAS __attribute__((address_space(1)))
#define LAS __attribute__((address_space(3)))
typedef unsigned short bf16;
typedef unsigned u32x4 __attribute__((ext_vector_type(4)));
typedef unsigned u32x2 __attribute__((ext_vector_type(2)));
typedef float f32x4 __attribute__((ext_vector_type(4)));
typedef float f32x2 __attribute__((ext_vector_type(2)));
typedef float f32x16 __attribute__((ext_vector_type(16)));
typedef short bf16x8 __attribute__((ext_vector_type(8)));
typedef short s16x4 __attribute__((ext_vector_type(4)));
typedef short v4i16_t __attribute__((ext_vector_type(4)));
typedef __bf16 bf16x2_t __attribute__((ext_vector_type(2)));
typedef GAS unsigned gu32;

constexpr int NTOK = 32768, DM = 1024, SEQ = 2048, NBATCH = 16, NIN = 5632;
constexpr int NWAVES = 8, NTHREADS = 512;
constexpr float LN_EPS = 1e-5f, DN_ALPHA = 1.189207115002721f, LOG2E = 1.4426950408889634f;
constexpr int MOE_MAXTILES = 288;

constexpr size_t MiB = 1u << 20;
constexpr size_t WS_CTL = 0, CTL_ZERO_BYTES = 65536;
constexpr size_t WS_WIN = 1 * MiB, WS_WCAT = 12 * MiB, WS_WO = 14 * MiB;
constexpr size_t WS_XB = 16 * MiB;
constexpr size_t WS_R = 80 * MiB;
constexpr size_t WS_GB = 144 * MiB;
constexpr size_t WS_QH = 208 * MiB;
constexpr size_t WS_VH = 240 * MiB;
constexpr size_t WS_GH = 272 * MiB;
constexpr size_t WS_ZF = 304 * MiB;
constexpr size_t WS_OCAT = 306 * MiB;
constexpr size_t WS_QM = 368 * MiB, WS_KM = 400 * MiB;
constexpr size_t WS_VM = 432 * MiB;
constexpr size_t WS_Y = 16 * MiB;
constexpr size_t WS_MISC = 464 * MiB;
constexpr size_t WS_KMEAN = WS_MISC;
constexpr size_t WS_BPERM = WS_MISC + 1 * MiB;
constexpr size_t WS_WRH = WS_MISC + 2 * MiB;
constexpr size_t WS_WRL = WS_WRH + 98304;
constexpr size_t WS_TOKE = WS_MISC + 3 * MiB;
constexpr size_t WS_TOKW = WS_MISC + 4 * MiB;
constexpr size_t WS_TOKD = WS_MISC + 5 * MiB;
constexpr size_t WS_WGCNT = WS_MISC + 6 * MiB;
constexpr size_t WS_ROWTOK = WS_MISC + 7 * MiB;
constexpr size_t WS_TILEE = WS_MISC + 8 * MiB;
constexpr size_t WS_STATS = WS_MISC + 9 * MiB;
constexpr size_t WS_TABG = WS_MISC + 11 * MiB;
constexpr size_t WS_LB = WS_MISC + 10 * MiB;
constexpr size_t WS_KK = WS_MISC + 12 * MiB;
constexpr size_t WS_END = 512 * MiB;
constexpr int CW_BAR = 4096, CW_QUEUE = 8192, CW_QUEUE2 = 8192 + 1024;
constexpr int CW_GCNT = 12288;
constexpr size_t WS_ROWTOKE = WS_QM;
constexpr int MOE_TAB = 147456;

constexpr int LDS_BYTES = 163840, MISC_OFF = LDS_BYTES - 256;

DI unsigned cvtpk(float lo, float hi) { f32x2 v = {lo, hi}; bf16x2_t b = __builtin_convertvector(v, bf16x2_t); return __builtin_bit_cast(unsigned, b); }
DI float bflo(unsigned w) { return __uint_as_float(w << 16); }
DI float bfhi(unsigned w) { return __uint_as_float(w & 0xffff0000u); }
DI float bf2f(unsigned short h) { return __uint_as_float((unsigned)h << 16); }
DI float frcp(float x) { return __builtin_amdgcn_rcpf(x); }
DI float fsigmoid(float x) { return frcp(1.f + __expf(-x)); }
DI float wave_sum(float v) {
#define WS_DPP(x, ctrl) __int_as_float(__builtin_amdgcn_update_dpp(0, __float_as_int(x), ctrl, 0xf, 0xf, true))
    v += WS_DPP(v, 0xB1); v += WS_DPP(v, 0x4E); v += WS_DPP(v, 0x141); v += WS_DPP(v, 0x140);
#undef WS_DPP
    const int vi = __float_as_int(v);
    return (__int_as_float(__builtin_amdgcn_readlane(vi, 0)) + __int_as_float(__builtin_amdgcn_readlane(vi, 16))) + (__int_as_float(__builtin_amdgcn_readlane(vi, 32)) + __int_as_float(__builtin_amdgcn_readlane(vi, 48)));
}
typedef int v8i __attribute__((ext_vector_type(8)));
typedef int v4i __attribute__((ext_vector_type(4)));
DI unsigned cvt4_fp8(float a, float b, float c, float d) { a = __builtin_amdgcn_fmed3f(a, -448.f, 448.f); b = __builtin_amdgcn_fmed3f(b, -448.f, 448.f); c = __builtin_amdgcn_fmed3f(c, -448.f, 448.f); d = __builtin_amdgcn_fmed3f(d, -448.f, 448.f);
    int w = __float_as_int(a); w = __builtin_amdgcn_cvt_pk_fp8_f32(a, b, w, false); w = __builtin_amdgcn_cvt_pk_fp8_f32(c, d, w, true); return (unsigned)w; }
DI f32x4 fp8x4_to_f32(unsigned w) { const f32x2 lo = __builtin_amdgcn_cvt_pk_f32_fp8((int)w, false), hi = __builtin_amdgcn_cvt_pk_f32_fp8((int)w, true); return (f32x4){lo[0], lo[1], hi[0], hi[1]}; }
constexpr float FP8_SXI = 8.f, FP8_SX = 8.f, FP8_SW = 32.f, FP8_SH = 4.f, FP8_SO = 4.f, FP8_SU = 32.f, FP8_SY = 64.f;
DI int crow(int r, int hi) { return (r & 3) + 8 * (r >> 2) + 4 * hi; }
#define MFMA32(a, b, c) __builtin_amdgcn_mfma_f32_32x32x16_bf16((a), (b), (c), 0, 0, 0)
#define MFMA16(a, b, c) __builtin_amdgcn_mfma_f32_16x16x32_bf16((a), (b), (c), 0, 0, 0)
DI s16x4 vtr(LAS const char* p) { return __builtin_bit_cast(s16x4, __builtin_amdgcn_ds_read_tr16_b64_v4i16((LAS v4i16_t*)p)); }

#define XB_TMO      128
#define XB_XCNT(j)  (256  + 64 * (j))
#define XB_XSUB(j)  (1280 + 64 * (j))
#define XB_XGEN(j)  (2304 + 64 * (j))
#define XB_TOP      3328
#define XB_TOPGEN   3392
#define XCD_BAR_WORDS 3456
#define XB_SPIN_CAP (1u << 22)
DI unsigned xb_ld(unsigned* p)              { return __hip_atomic_load(p, __ATOMIC_RELAXED, __HIP_MEMORY_SCOPE_AGENT); }
DI unsigned xb_add(unsigned* p, unsigned v) { return __hip_atomic_fetch_add(p, v, __ATOMIC_RELAXED, __HIP_MEMORY_SCOPE_AGENT); }
DI unsigned xb_xcc_id() { return (unsigned)__builtin_amdgcn_s_getreg((3 << 11) | 20) & 0xFu; }
#define XB_SPIN(cond, bar) do { unsigned _sp = 0; while (cond) { __builtin_amdgcn_s_sleep(1); \
    if ((++_sp & 255u) == 0u) { if (xb_ld(&(bar)[XB_TMO])) break; if (_sp > XB_SPIN_CAP) { atomicAdd(&(bar)[XB_TMO], 1u); break; } } } } while (0)
struct XcdBarrier { unsigned* bar; unsigned x; volatile LAS unsigned* st; };
DI XcdBarrier xcd_barrier_post(unsigned* bar, volatile LAS unsigned* st) {
    XcdBarrier b; b.bar = bar; b.x = xb_xcc_id(); b.st = st;
    if (threadIdx.x == 0) (void)xb_add(&bar[XB_XCNT(b.x)], 1u);
    return b;
}
DI void xcd_barrier_complete(unsigned* bar, unsigned x, unsigned& nloc, unsigned& nx) {
    const unsigned G = gridDim.x * gridDim.y * gridDim.z;
    unsigned sum, cnt, mine, sp = 0u;
    for (;;) {
        sum = 0u; cnt = 0u; mine = 0u;
#pragma unroll
        for (unsigned j = 0; j < 16; ++j) { const unsigned c = xb_ld(&bar[XB_XCNT(j)]); sum += c; cnt += (c > 0u) ? 1u : 0u; mine = (j == x) ? c : mine; }
        if (sum == G) break;
        __builtin_amdgcn_s_sleep(1);
        if ((++sp & 255u) == 0u) { if (xb_ld(&bar[XB_TMO])) break; if (sp > XB_SPIN_CAP) { atomicAdd(&bar[XB_TMO], 1u); break; } }
    }
    nloc = mine > 0u ? mine : 1u; nx = cnt > 0u ? cnt : 1u;
}
DI void xcd_barrier(const XcdBarrier& b) {
    asm volatile("s_waitcnt vmcnt(0)" ::: "memory");
    __syncthreads();
    if (threadIdx.x == 0) {
        unsigned* bar = b.bar;
        __builtin_amdgcn_s_waitcnt(0);
        unsigned nloc = b.st[0], nx = b.st[1];
        if (nloc == 0u) { xcd_barrier_complete(bar, b.x, nloc, nx); b.st[0] = nloc; b.st[1] = nx; }
        const unsigned old = xb_add(&bar[XB_XSUB(b.x)], 1u);
        const unsigned gen = old / nloc;
        if (old + 1u == (gen + 1u) * nloc) {
            __builtin_amdgcn_fence(__ATOMIC_RELEASE, "agent");
            asm volatile("s_waitcnt vmcnt(0)" ::: "memory");
            const unsigned og = xb_add(&bar[XB_TOP], 1u);
            const unsigned tg = og / nx;
            if (og + 1u == (tg + 1u) * nx) xb_add(&bar[XB_TOPGEN], 1u);
            else XB_SPIN(xb_ld(&bar[XB_TOPGEN]) == tg, bar);
            __builtin_amdgcn_fence(__ATOMIC_ACQUIRE, "agent");
            xb_add(&bar[XB_XGEN(b.x)], 1u);
            asm volatile("s_waitcnt vmcnt(0)" ::: "memory");
        } else {
            XB_SPIN(xb_ld(&bar[XB_XGEN(b.x)]) == gen, bar);
            __builtin_amdgcn_fence(__ATOMIC_ACQUIRE, "agent");
            asm volatile("s_waitcnt vmcnt(0)" ::: "memory");
        }
    }
    __syncthreads();
}

namespace pg8 {
constexpr int BM = 256, BK = 64, HALF = 128, HTB = HALF * BK * 2, STAGE_BYTES = 8 * HTB, NXCD = 8, WGM = 8;
DI int lds_byte(int r, int c) { const int st = (r >> 4) * 2 + (c >> 5), rr = r & 15, cc = c & 31, ob = rr * 64 + cc * 2; return st * 1024 + (ob ^ (((ob >> 9) & 1) << 5)); }
DI void stage_rc(int b, int& R, int& C) { const int st = b / 1024, sb = b % 1024, swz = sb ^ (((sb >> 9) & 1) << 5); R = (st >> 1) * 16 + swz / 64; C = (st & 1) * 32 + (swz % 64) / 2; }
DI int perm32(int rho) { const int n = rho >> 4, i = rho & 15; return 8 * (i >> 2) + 4 * n + (i & 3); }
struct Unit { int pm, pn, e, hf; };

struct DenseOrder {
    static constexpr bool HALF_UNITS = false;
    const char* A; const char* Bt; int K, nM, nN, nwg, G, c;
    DI void init(const void* A_, const void* Bt_, int M, int N, int K_, int G_, int c_) { A = (const char*)A_; Bt = (const char*)Bt_; K = K_; nM = M / BM; nN = N / BM; nwg = nM * nN; G = G_; c = c_; }
    DI bool next(int i, Unit& u) const {
        const long L = (long)i * G + c; if (L >= nwg) return false;
        int wgid = (int)L; { const int q = nwg / NXCD, r = nwg % NXCD, xcd = wgid % NXCD, off = wgid / NXCD; wgid = (xcd < r ? xcd * (q + 1) : r * (q + 1) + (xcd - r) * q) + off; }
        const int nig = WGM * nN, gid = wgid / nig, fm = gid * WGM, gsz = (nM - fm) < WGM ? (nM - fm) : WGM;
        u.pm = fm + ((wgid % nig) % gsz); u.pn = (wgid % nig) / gsz; u.e = 0; u.hf = 0; return true;
    }
    DI const char* a_base(const Unit& u) const { return A + (size_t)u.pm * 512 * K; }
    DI const char* b_base(const Unit& u) const { return Bt + (size_t)u.pn * 512 * K; }
    DI void gather(const Unit&, const int (&)[2], const int (&)[2], unsigned (&)[2][2]) const {}
    DI void gather_raw(const Unit&, const int (&)[2], int (&)[2][2]) const {}
};
struct MoeOrder {
    const char* A; const char* Bt; const int* row_tok; const LAS int* tab; int K, N, nunits, G, c; bool gat;
    static constexpr bool HALF_UNITS = true;
    DI bool next(int i, Unit& u) const {
        const int full = nunits / G, T = nunits - full * G; int L; u.hf = 0;
        if (i < full) L = i * G + c;
        else if (i == full) { if (2 * T <= G) { if (c >= 2 * T) return false; L = full * G + (c >> 1); u.hf = 1 + (c & 1); } else { if (c >= T) return false; L = full * G + c; } }
        else return false;
        u.pm = L >> 2; u.pn = L & 3;
        u.e = __builtin_amdgcn_readfirstlane(tab[98 + u.pm]); return true;
    }
    DI const char* a_base(const Unit& u) const { return gat ? A : A + (size_t)u.pm * 512 * K; }
    DI const char* b_base(const Unit& u) const { return Bt + ((size_t)u.e * N + (size_t)u.pn * 256) * K * 2; }
    DI int tok_of(const Unit& u, int r) const { const int cnt = __builtin_amdgcn_readfirstlane(tab[u.e]), rl0 = (u.pm - __builtin_amdgcn_readfirstlane(tab[65 + u.e])) * 256 + r; const int rl = rl0 < cnt ? rl0 : cnt - 1; return row_tok[u.e * 32768 + rl]; }
    DI void gather(const Unit& u, const int (&Rr)[2], const int (&Cc)[2], unsigned (&o)[2][2]) const {
#pragma unroll
        for (int h = 0; h < 2; ++h)
#pragma unroll
            for (int i = 0; i < 2; ++i) { const int tok = tok_of(u, h * 128 + Rr[i]); o[h][i] = (unsigned)(tok * K + Cc[i]) * 2u; }
    }
    DI void gather_raw(const Unit& u, const int (&Rr)[2], int (&t)[2][2]) const {
#pragma unroll
        for (int h = 0; h < 2; ++h)
#pragma unroll
            for (int i = 0; i < 2; ++i) t[h][i] = tok_of(u, h * 128 + Rr[i]);
    }
};

template <class Epi, class Sched, bool GATHER, bool FP8 = false>
DI void gemm_phase(LAS unsigned char* lds, const int K, const Sched& S, const Epi& E, const int pid = -1) {
#ifdef PROBE_GEMM
    unsigned long long pk_ = 0, pm_ = 0, pe_ = 0, pt0_ = 0, pt1_ = 0, pv_ = 0; unsigned pun_ = 0;
#define PG8_NOW() __builtin_amdgcn_s_memrealtime()
#endif
    const int tid = threadIdx.x, wid = __builtin_amdgcn_readfirstlane(tid >> 6), lane = tid & 63, wr = wid >> 2, wc = wid & 3, fr = lane & 15, fq = lane >> 4;
    const int nt = K / BK;
    unsigned voffB[2], vA[2][2], nvA[2][2]; int Rr[2], Cc[2];
#pragma unroll
    for (int i = 0; i < 2; ++i) { int R, C; stage_rc(tid * 16 + i * 8192, R, C); Rr[i] = R; Cc[i] = C; const int Rb = (R & ~31) + perm32(R & 31);
        voffB[i] = (unsigned)(Rb * K + C) * 2u; vA[0][i] = (unsigned)(R * K + C) * 2u; vA[1][i] = (unsigned)((R + HALF) * K + C) * 2u; nvA[0][i] = vA[0][i]; nvA[1][i] = vA[1][i]; }
    const size_t kstep = (size_t)(BK * 2);
    const size_t hstep = (size_t)HALF * K * 2;
    const unsigned ldsw = (unsigned)wid * 1024u;
    const int aoff = lds_byte(wr * 64 + fr, fq * 8), boff = lds_byte(wc * 32 + fr, fq * 8);
#define PG8_SA(b, h) (((b) * 2 + (h)) * HTB)
#define PG8_SB(b, h) ((4 + (b) * 2 + (h)) * HTB)
#define PG8_STAGE(bufoff, gbase, voff) do { _Pragma("unroll") for (int _i = 0; _i < 2; ++_i) \
        __builtin_amdgcn_global_load_lds((const unsigned*)((const char*)(gbase) + (voff)[_i]), (LAS unsigned*)(lds + (bufoff) + ldsw + _i * 8192), 16, 0, 0); } while (0)
#define PG8_LDA(dst, b, h) do { if constexpr (FP8) { _Pragma("unroll") for (int m = 0; m < 4; ++m) dst##8[m] = __builtin_shufflevector(*(const LAS v4i*)(lds + PG8_SA(b, h) + aoff + m * 2048), *(const LAS v4i*)(lds + PG8_SA(b, h) + aoff + m * 2048 + 1024), 0, 1, 2, 3, 4, 5, 6, 7); } \
        else { _Pragma("unroll") for (int m = 0; m < 4; ++m) _Pragma("unroll") for (int k = 0; k < 2; ++k) dst[m][k] = *(const LAS bf16x8*)(lds + PG8_SA(b, h) + aoff + m * 2048 + k * 1024); } } while (0)
#define PG8_LDB(dst, b, h) do { if constexpr (FP8) { _Pragma("unroll") for (int n = 0; n < 2; ++n) dst##8[n] = __builtin_shufflevector(*(const LAS v4i*)(lds + PG8_SB(b, h) + boff + n * 2048), *(const LAS v4i*)(lds + PG8_SB(b, h) + boff + n * 2048 + 1024), 0, 1, 2, 3, 4, 5, 6, 7); } \
        else { _Pragma("unroll") for (int n = 0; n < 2; ++n) _Pragma("unroll") for (int k = 0; k < 2; ++k) dst[n][k] = *(const LAS bf16x8*)(lds + PG8_SB(b, h) + boff + n * 2048 + k * 1024); } } while (0)
#define PG8_CAT(x, y) __builtin_shufflevector(__builtin_bit_cast(v4i, (x)), __builtin_bit_cast(v4i, (y)), 0, 1, 2, 3, 4, 5, 6, 7)
#define PG8_MMA(ai, bj, At, Bt) do { __builtin_amdgcn_s_setprio(1); if constexpr (FP8) { _Pragma("unroll") for (int m = 0; m < 4; ++m) _Pragma("unroll") for (int n = 0; n < 2; ++n) \
        asm volatile("v_mfma_f32_16x16x128_f8f6f4 %0, %1, %2, %0" : "+v"(acc[ai][bj][m][n]) : "v"(Bt##8[n]), "v"(At##8[m])); } else { \
        _Pragma("unroll") for (int m = 0; m < 4; ++m) _Pragma("unroll") for (int n = 0; n < 2; ++n) _Pragma("unroll") for (int k = 0; k < 2; ++k) \
        acc[ai][bj][m][n] = __builtin_amdgcn_mfma_f32_16x16x32_bf16(Bt[n][k], At[m][k], acc[ai][bj][m][n], 0, 0, 0); } __builtin_amdgcn_s_setprio(0); } while (0)
#define PG8_WAIT_V(n) asm volatile("s_waitcnt vmcnt(" #n ")" ::: "memory")
#define PG8_WAIT_L(n) asm volatile("s_waitcnt lgkmcnt(" #n ")" ::: "memory")
#define PG8_BAR __builtin_amdgcn_s_barrier()
#define PG8_SCHED __builtin_amdgcn_sched_barrier(0)
#ifdef PROBE_GEMM
#define PG8_MIDHOOK do { const unsigned long long ma_ = PG8_NOW(); if constexpr (FP8) asm volatile("s_nop 15\n\ts_nop 15" ::: "memory"); E.mid(acc, cur, wr, wc, fr, fq); if constexpr (FP8) asm volatile("s_nop 7" ::: "memory"); pm_ += PG8_NOW() - ma_; } while (0)
#else
#define PG8_MIDHOOK do { if constexpr (FP8) asm volatile("s_nop 15\n\ts_nop 15" ::: "memory"); E.mid(acc, cur, wr, wc, fr, fq); if constexpr (FP8) asm volatile("s_nop 7" ::: "memory"); } while (0)
#endif
#define PG8_MMAX(ai, bj, At, Bt, Z) do { if constexpr ((Z) == 0) { PG8_MMA(ai, bj, At, Bt); } else { __builtin_amdgcn_s_setprio(1); if constexpr (FP8) { _Pragma("unroll") for (int m = 0; m < 4; ++m) _Pragma("unroll") for (int n = 0; n < 2; ++n) \
        asm volatile("v_mfma_f32_16x16x128_f8f6f4 %0, %1, %2, 0" : "=&v"(acc[ai][bj][m][n]) : "v"(Bt##8[n]), "v"(At##8[m])); } else { \
        _Pragma("unroll") for (int m = 0; m < 4; ++m) _Pragma("unroll") for (int n = 0; n < 2; ++n) { \
        acc[ai][bj][m][n] = __builtin_amdgcn_mfma_f32_16x16x32_bf16(Bt[n][0], At[m][0], (f32x4){0.f, 0.f, 0.f, 0.f}, 0, 0, 0); acc[ai][bj][m][n] = __builtin_amdgcn_mfma_f32_16x16x32_bf16(Bt[n][1], At[m][1], acc[ai][bj][m][n], 0, 0, 0); } } __builtin_amdgcn_s_setprio(0); } } while (0)
#define PG8_WAITX(Z) do { if constexpr ((Z) == 0) { PG8_WAIT_V(8); } else { if (ui) { if constexpr (Epi::MIN_STORES >= 32) asm volatile("s_waitcnt vmcnt(40)" ::: "memory"); else if constexpr (Epi::MIN_STORES >= 16) asm volatile("s_waitcnt vmcnt(24)" ::: "memory"); \
        else if constexpr (Epi::MIN_STORES >= 8) asm volatile("s_waitcnt vmcnt(16)" ::: "memory"); else PG8_WAIT_V(8); } else PG8_WAIT_V(8); } } while (0)
#define PG8_KITER(Z) \
            const bool last = (t == nt - 2); const bool do0 = !(Sched::HALF_UNITS && cur.hf == 2), do1 = !(Sched::HALF_UNITS && cur.hf == 1); \
            if constexpr (Epi::HAS_MID) { if (t == (nt >> 1)) PG8_MIDHOOK; } \
            const char* a1 = cA + (size_t)(t + 1) * kstep; \
            const char* a2 = last ? nA : cA + (size_t)(t + 2) * kstep; const char* b2 = last ? nB : cB + (size_t)(t + 2) * kstep; \
            const char* a3 = a2 + kstep; const char* b3 = b2 + kstep; \
            unsigned o0[2], o1[2]; \
            o0[0] = vA[0][0]; o0[1] = vA[0][1]; o1[0] = vA[1][0]; o1[1] = vA[1][1]; \
            if constexpr (GATHER) { if (last && has_next) {     \
                _Pragma("unroll") for (int i = 0; i < 2; ++i) { nvA[0][i] = (unsigned)(ntok[0][i] * K + Cc[i]) * 2u; nvA[1][i] = (unsigned)(ntok[1][i] * K + Cc[i]) * 2u; o0[i] = nvA[0][i]; o1[i] = nvA[1][i]; } } } \
              \
            PG8_LDB(B0, 0, 0); PG8_LDB(B1, 0, 1); PG8_SCHED; if (do0) PG8_LDA(At, 0, 0); PG8_STAGE(PG8_SA(1, 1), a1, vA[1]); \
            PG8_WAITX(Z); PG8_WAIT_L(0); PG8_BAR; if (do0) { PG8_MMAX(0, 0, At, B0, Z); PG8_MMAX(0, 1, At, B1, Z); } PG8_BAR; PG8_SCHED; \
              \
            if (do1) PG8_LDA(At, 0, 1); PG8_STAGE(PG8_SB(0, 0), b2, voffB); PG8_STAGE(PG8_SB(0, 1), b2 + hstep, voffB); PG8_STAGE(PG8_SA(0, 0), a2, o0); \
            PG8_WAITX(Z); PG8_WAIT_L(0); PG8_BAR; if (do1) { PG8_MMAX(1, 0, At, B0, Z); PG8_MMAX(1, 1, At, B1, Z); } PG8_BAR; PG8_SCHED; \
              \
            PG8_LDB(B0, 1, 0); PG8_LDB(B1, 1, 1); PG8_SCHED; if (do0) PG8_LDA(At, 1, 0); PG8_STAGE(PG8_SA(0, 1), a2, o1); \
            PG8_WAIT_V(8); PG8_WAIT_L(0); PG8_BAR; if (do0) { PG8_MMA(0, 0, At, B0); PG8_MMA(0, 1, At, B1); } PG8_BAR; PG8_SCHED; \
              \
            if (do1) PG8_LDA(At, 1, 1); PG8_STAGE(PG8_SB(1, 0), b3, voffB); PG8_STAGE(PG8_SB(1, 1), b3 + hstep, voffB); PG8_STAGE(PG8_SA(1, 0), a3, o0); \
            PG8_WAIT_V(8); PG8_WAIT_L(0); PG8_BAR; if (do1) { PG8_MMA(1, 0, At, B0); PG8_MMA(1, 1, At, B1); } PG8_BAR; PG8_SCHED;
    constexpr bool PEEL = FP8;
    Unit cur, nxt; int ui = 0;
    if (!S.next(0, cur)) return;
    if constexpr (GATHER) S.gather(cur, Rr, Cc, vA);
    f32x4 acc[2][2][4][2];
#define PG8_ZERO_ACC do { if constexpr (!PEEL) { _Pragma("unroll") for (int a = 0; a < 2; ++a) _Pragma("unroll") for (int b = 0; b < 2; ++b) _Pragma("unroll") for (int m = 0; m < 4; ++m) _Pragma("unroll") for (int n = 0; n < 2; ++n) acc[a][b][m][n] = (f32x4){0.f, 0.f, 0.f, 0.f}; } } while (0)
    PG8_ZERO_ACC;
    bf16x8 At[4][2], B0[2][2], B1[2][2]; v8i At8[4], B08[2], B18[2]; const int fp8_unit_scale = 0x7f7f7f7f;
    const char* cA = S.a_base(cur); const char* cB = S.b_base(cur);
    PG8_STAGE(PG8_SB(0, 0), cB, voffB); PG8_STAGE(PG8_SB(0, 1), cB + hstep, voffB); PG8_STAGE(PG8_SA(0, 0), cA, vA[0]); PG8_STAGE(PG8_SA(0, 1), cA, vA[1]);
    if (wr == 1) PG8_BAR;
    PG8_WAIT_V(2); PG8_BAR;
    PG8_STAGE(PG8_SB(1, 0), cB + kstep, voffB); PG8_STAGE(PG8_SA(1, 0), cA + kstep, vA[0]); PG8_STAGE(PG8_SB(1, 1), cB + hstep + kstep, voffB);
    PG8_WAIT_V(6); PG8_BAR;
    for (;;) {
        const bool has_next = S.next(ui + 1, nxt);
        const char* nA = has_next ? S.a_base(nxt) : cA; const char* nB = has_next ? S.b_base(nxt) : cB;
        int ntok[2][2] = {{0, 0}, {0, 0}};
        if constexpr (GATHER) { if (has_next) S.gather_raw(nxt, Rr, ntok); }
#ifdef PROBE_GEMM
        pt0_ = PG8_NOW(); if (pun_) pe_ += pt0_ - pt1_;
#endif
        if constexpr (PEEL) {
            { const int t = 0; PG8_KITER(1) }
#pragma unroll 1
            for (int t = 2; t < nt; t += 2) { PG8_KITER(0) }
        } else {
#pragma unroll 1
            for (int t = 0; t < nt; t += 2) { PG8_KITER(0) }
        }
#ifdef PROBE_GEMM
        pt1_ = PG8_NOW(); pk_ += pt1_ - pt0_; ++pun_;
#endif
        if (wr == 0) PG8_BAR;
        if constexpr (FP8) asm volatile("s_nop 15\n\ts_nop 15" ::: "memory");
        E(acc, cur, wr, wc, fr, fq);
#ifdef PROBE_GEMM
        if ((cur.pn | 1) == (PROBE_GPN | 1)) pv_ += PG8_NOW() - pt1_;
#endif
        if (!has_next) break;
        PG8_ZERO_ACC;
        cur = nxt; cA = nA; cB = nB; ++ui;
        if constexpr (GATHER) {
#pragma unroll
            for (int h = 0; h < 2; ++h) { vA[h][0] = nvA[h][0]; vA[h][1] = nvA[h][1]; } }
        if (wr == 1) PG8_BAR;
    }
    PG8_WAIT_V(0);
    PG8_BAR;
#ifdef PROBE_GEMM
    pe_ += PG8_NOW() - pt1_;
    if (pid == PROBE_GEMM && blockIdx.x == PROBE_GBLK && tid == 0) {
        const unsigned long long x_ = (PROBE_GSEL == 0) ? (pk_ - pm_) : (PROBE_GSEL == 1) ? pm_ : (PROBE_GSEL == 2) ? pe_ : (PROBE_GSEL == 3) ? pv_ : (unsigned long long)pun_ * 1000ull;
        volatile LAS unsigned* M_ = (volatile LAS unsigned*)(lds + MISC_OFF);
        M_[60] = (unsigned)x_; M_[61] = (unsigned)(x_ >> 32); }
#endif
#undef PG8_SA
#undef PG8_SB
#undef PG8_STAGE
#undef PG8_LDA
#undef PG8_LDB
#undef PG8_MMA
#undef PG8_MMAX
#undef PG8_ZERO_ACC
#undef PG8_WAITX
#undef PG8_KITER
#undef PG8_MIDHOOK
#undef PG8_CAT
#undef PG8_WAIT_V
#undef PG8_WAIT_L
#undef PG8_BAR
#undef PG8_SCHED
}

typedef f32x4 Acc[2][2][4][2];
DI u32x4 widen16(u32x2 a, u32x2 b) { const auto rx = __builtin_amdgcn_permlane16_swap(a.x, b.x, false, false), ry = __builtin_amdgcn_permlane16_swap(a.y, b.y, false, false); return (u32x4){rx[0], ry[0], rx[1], ry[1]}; }
DI u32x4 pack8(const f32x4 a, const f32x4 b) { u32x4 w; w.x = cvtpk(a[0], a[1]); w.y = cvtpk(a[2], a[3]); w.z = cvtpk(b[0], b[1]); w.w = cvtpk(b[2], b[3]); return w; }
DI f32x4 silu4(const f32x4 v) { f32x4 o; o[0] = v[0] * fsigmoid(v[0]); o[1] = v[1] * fsigmoid(v[1]); o[2] = v[2] * fsigmoid(v[2]); o[3] = v[3] * fsigmoid(v[3]); return o; }

struct EpiIn {
    static constexpr bool HAS_MID = false; static constexpr int MIN_STORES = 8;
    bf16 *Qh, *Vh, *Gh, *Qm, *Km, *Vm, *Rr, *Gb; float *Zf, *KM; const float* bias; bf16* KK; const float* LB; int pn_off; unsigned char *Q8, *K8, *VT8;
    DI void operator()(Acc& acc, const Unit& u, int wr, int wc, int fr, int fq) const {
        const int pn = u.pn + pn_off, row0 = u.pm * BM + wr * 64 + fr, cl = wc * 32 + 8 * fq;
        constexpr float SC8 = 1.f / (FP8_SXI * FP8_SW);
        f32x4 bv[2][2];
#pragma unroll
        for (int bj = 0; bj < 2; ++bj)
#pragma unroll
            for (int n = 0; n < 2; ++n) bv[bj][n] = *(const f32x4*)(bias + pn * 256 + bj * HALF + cl + 4 * n);
        if (pn < 4) {
#define EI_DPP(v, ctrl) __int_as_float(__builtin_amdgcn_update_dpp(0, __float_as_int(v), ctrl, 0xf, 0xf, true))
            const int chb = pn * 128 + cl;
#pragma unroll
            for (int ai = 0; ai < 2; ++ai) { u32x2 qh0[4], kh0[4];
#pragma unroll
                for (int n = 0; n < 2; ++n) { const f32x4 lbv = *(const f32x4*)(LB + chb + 4 * n); f32x4 run = (f32x4){0.f, 0.f, 0.f, 0.f}, bmid = run; f32x4 bbv[4], kkv[4];
#pragma unroll
                    for (int m = 0; m < 4; ++m) {
#pragma unroll
                        for (int j = 0; j < 4; ++j) { const float z = acc[ai][1][m][n][j] + bv[1][n][j]; const float sg = frcp(1.f + __expf(-z)); const float lf = __builtin_amdgcn_logf(lbv[j] + (1.f - lbv[j]) * sg); kkv[m][j] = (1.f - lbv[j]) * (1.f - sg);
                            float s = lf; s += EI_DPP(s, 0x111); s += EI_DPP(s, 0x112); s += EI_DPP(s, 0x114); s += EI_DPP(s, 0x118);
                            const float t = EI_DPP(s, 0x15F);
                            bbv[m][j] = s + run[j]; run[j] += t; }
                        if (m == 1) bmid = run; }
#pragma unroll
                    for (int m = 0; m < 4; ++m) { f32x4 qp, kp;
#pragma unroll
                        for (int j = 0; j < 4; ++j) { const float qx = acc[ai][0][m][n][j] + bv[0][n][j]; const float e = __builtin_amdgcn_exp2f(__builtin_amdgcn_fmed3f(bbv[m][j] - bmid[j], -86.f, 86.f)); qp[j] = qx * fsigmoid(qx) * e; kp[j] = kkv[m][j] * frcp(e); }
                        const size_t ro = (size_t)(row0 + ai * HALF + m * 16) * 512 + chb;
                        u32x2 qw, kw; qw.x = cvtpk(qp[0], qp[1]); qw.y = cvtpk(qp[2], qp[3]); kw.x = cvtpk(kp[0], kp[1]); kw.y = cvtpk(kp[2], kp[3]);
                        if (n == 0) { qh0[m] = qw; kh0[m] = kw; }
                        else { *(u32x4*)(Qh + ro) = (u32x4){qh0[m].x, qh0[m].y, qw.x, qw.y}; *(u32x4*)(KK + ro) = (u32x4){kh0[m].x, kh0[m].y, kw.x, kw.y}; } }
                    if (fr == 0) { const size_t so = (size_t)(u.pm * 4 + ai * 2 + wr) * 512 + chb + 4 * n; *(f32x4*)(Zf + so) = bmid * 0.69314718056f; *(f32x4*)(Zf + 262144 + so) = run * 0.69314718056f; }
                    asm volatile("" ::: "memory"); } }
#undef EI_DPP
        } else if (pn < 14) {
            const int seg = pn >> 1, c0 = (pn & 1) * 256 + cl;
            {
                if (seg == 6) {
                    int fro = fr; asm volatile("" : "+v"(fro));
                    const unsigned sel1 = (fro & 1) ? 0x03070105u : 0x06020400u, sel2 = (fro & 2) ? 0x03020706u : 0x05040100u;
                    f32x4 bv8[2][2];
#pragma unroll
                    for (int bj = 0; bj < 2; ++bj)
#pragma unroll
                        for (int n = 0; n < 2; ++n) bv8[bj][n] = bv[bj][n] * 8.f;
#pragma unroll
                    for (int ai = 0; ai < 2; ++ai)
#pragma unroll
                        for (int m = 0; m < 4; ++m) { const int row = u.pm * BM + wr * 64 + fro + ai * HALF + m * 16;
                            const int pq = 32 * ((fro >> 2) & 1) + 4 * (fro >> 3) + 8 * m;
#pragma unroll
                            for (int bj = 0; bj < 2; ++bj) { const f32x4 v0 = acc[ai][bj][m][0] * (8.f * SC8) + bv8[bj][0], v1 = acc[ai][bj][m][1] * (8.f * SC8) + bv8[bj][1];
                                unsigned char* vp = VT8 + ((size_t)(((row >> 11) * 8 + ((c0 + bj * HALF) >> 6)) * 32 + ((row & (SEQ - 1)) >> 6)) * 64 + (c0 & 63) + (fro & 3)) * 64 + pq;
                                unsigned w[2]; w[0] = cvt4_fp8(v0[0], v0[1], v0[2], v0[3]); w[1] = cvt4_fp8(v1[0], v1[1], v1[2], v1[3]);
#pragma unroll
                                for (int q = 0; q < 2; ++q) {
                                    const unsigned x1 = (unsigned)__builtin_amdgcn_update_dpp(0, (int)w[q], 0xB1, 0xf, 0xf, true);
                                    const unsigned a1 = __builtin_amdgcn_perm(x1, w[q], sel1);
                                    const unsigned y1 = (unsigned)__builtin_amdgcn_update_dpp(0, (int)a1, 0x4E, 0xf, 0xf, true);
                                    *(unsigned*)(vp + q * 256) = __builtin_amdgcn_perm(y1, a1, sel2); } }
                            asm volatile("" ::: "memory"); }
                    return;
                }
                bf16* O = seg == 2 ? Vh : seg == 3 ? Gh : seg == 4 ? Qm : seg == 5 ? Km : Vm;
                const int act = (seg == 3) ? 1 : (seg == 4 ? 2 : 0);
                if (seg == 5) {
#pragma unroll
                    for (int bj = 0; bj < 2; ++bj)
#pragma unroll
                        for (int n = 0; n < 2; ++n) { f32x4 cs = (f32x4){0.f, 0.f, 0.f, 0.f};
#pragma unroll
                            for (int ai = 0; ai < 2; ++ai)
#pragma unroll
                                for (int m = 0; m < 4; ++m) cs += acc[ai][bj][m][n] * SC8 + bv[bj][n];
#pragma unroll
                            for (int j = 0; j < 4; ++j) { float s = cs[j];
#define EK_DPP(v, ctrl) __int_as_float(__builtin_amdgcn_update_dpp(0, __float_as_int(v), ctrl, 0xf, 0xf, true))
                                s += EK_DPP(s, 0xB1); s += EK_DPP(s, 0x4E); s += EK_DPP(s, 0x141); s += EK_DPP(s, 0x140); cs[j] = s; }
#undef EK_DPP
                            if (fr == 0) *(f32x4*)(KM + (size_t)(u.pm * 2 + wr) * 512 + c0 + bj * HALF + 4 * n) = cs; }
                }
#pragma unroll
                for (int ai = 0; ai < 2; ++ai)
#pragma unroll
                    for (int m = 0; m < 4; ++m) { const int row = row0 + ai * HALF + m * 16;
                        const size_t hm = ((size_t)(row >> 11) * 8 * SEQ + (row & (SEQ - 1))) * 64 + (size_t)(c0 >> 6) * SEQ * 64 + (c0 & 63);
                        bf16* rp = (seg >= 4) ? O + hm : O + (size_t)row * 512 + c0;
                        const size_t bjs = (seg >= 4) ? (size_t)2 * SEQ * 64 : (size_t)HALF;
                        u32x2 q8[2];
#pragma unroll
                        for (int bj = 0; bj < 2; ++bj) { f32x4 v0 = acc[ai][bj][m][0] * SC8 + bv[bj][0], v1 = acc[ai][bj][m][1] * SC8 + bv[bj][1];
                            if (act == 1) { v0 = silu4(v0); v1 = silu4(v1); } else if (act == 2) { v0 = v0 * (0.125f * LOG2E); v1 = v1 * (0.125f * LOG2E); }
                            if (seg <= 4) *(u32x4*)(rp + bj * bjs) = pack8(v0, v1);
                            if (seg == 4) { q8[bj].x = cvt4_fp8(v0[0] * 16.f, v0[1] * 16.f, v0[2] * 16.f, v0[3] * 16.f); q8[bj].y = cvt4_fp8(v1[0] * 16.f, v1[1] * 16.f, v1[2] * 16.f, v1[3] * 16.f); }
                            if (seg == 5) { q8[bj].x = cvt4_fp8(v0[0] * 8.f, v0[1] * 8.f, v0[2] * 8.f, v0[3] * 8.f); q8[bj].y = cvt4_fp8(v1[0] * 8.f, v1[1] * 8.f, v1[2] * 8.f, v1[3] * 8.f); }
                        }
                        if (seg == 4 || seg == 5) *(u32x4*)((seg == 4 ? Q8 : K8) + hm + ((fq & 1) ? bjs - 8 : (size_t)0)) = widen16(q8[0], q8[1]);
                        asm volatile("" ::: "memory"); }
            }
        } else {
            int ln = fq * 16 + fr; asm volatile("" : "+v"(ln));
            f32x4 nbv[2][2];
#pragma unroll
            for (int bj = 0; bj < 2; ++bj)
#pragma unroll
                for (int n = 0; n < 2; ++n) nbv[bj][n] = bv[bj][n] * (-LOG2E);
#pragma unroll
            for (int ai = 0; ai < 2; ++ai)
#pragma unroll
                for (int m = 0; m < 4; ++m) { const size_t off = ((size_t)((((u.pm * 8 + (pn - 14)) * 8 + wr * 4 + wc) * 8 + ai * 4 + m) * 64 + ln)) * 8; f32x4 r[2], g[2];
#pragma unroll
                    for (int n = 0; n < 2; ++n) {
#pragma unroll
                        for (int j = 0; j < 4; ++j) { const float ea = __builtin_amdgcn_exp2f(acc[ai][0][m][n][j] * (-LOG2E / (FP8_SXI * FP8_SW)) + nbv[0][n][j]), eb = __builtin_amdgcn_exp2f(acc[ai][1][m][n][j] * (-LOG2E / (FP8_SXI * FP8_SW)) + nbv[1][n][j]);
                            g[n][j] = frcp(1.f + eb); r[n][j] = (1.f + eb) * frcp(1.f + ea); } }
                    __builtin_nontemporal_store(pack8(r[0], r[1]), (u32x4*)(Rr + off)); __builtin_nontemporal_store(pack8(g[0], g[1]), (u32x4*)(Gb + off)); asm volatile("" ::: "memory"); }
        }
    }
};
struct EpiProj {
    static constexpr bool HAS_MID = true; static constexpr int MIN_STORES = 8;
    const bf16 *Rr, *Gb; unsigned char* U;
    DI void scale(Acc& acc, const bf16* G, const Unit& u, int wr, int wc, int fr, int fq) const {
        int wv = wr * 4 + wc, ln = fq * 16 + fr;
        asm volatile("" : "+v"(ln));
#pragma unroll
        for (int ai = 0; ai < 2; ++ai)
#pragma unroll
            for (int mp = 0; mp < 2; ++mp) { u32x4 rv[2][2];
#pragma unroll
            for (int m = 0; m < 2; ++m)
#pragma unroll
                for (int bj = 0; bj < 2; ++bj) rv[m][bj] = __builtin_nontemporal_load((const u32x4*)(G + ((size_t)((((u.pm * 8 + 2 * u.pn + bj) * 8 + wv) * 8 + ai * 4 + 2 * mp + m) * 64 + ln)) * 8));
#pragma unroll
            for (int m = 0; m < 2; ++m)
#pragma unroll
                for (int bj = 0; bj < 2; ++bj) { const u32x4 w = rv[m][bj];
                    acc[ai][bj][2 * mp + m][0] *= (f32x4){bflo(w.x), bfhi(w.x), bflo(w.y), bfhi(w.y)}; acc[ai][bj][2 * mp + m][1] *= (f32x4){bflo(w.z), bfhi(w.z), bflo(w.w), bfhi(w.w)}; }
            asm volatile("" ::: "memory"); }
    }
    DI void mid(Acc& acc, const Unit& u, int wr, int wc, int fr, int fq) const { scale(acc, Rr, u, wr, wc, fr, fq); }
    DI void operator()(Acc& acc, const Unit& u, int wr, int wc, int fr, int fq) const {
        scale(acc, Gb, u, wr, wc, fr, fq);
        const int row0 = u.pm * BM + wr * 64 + fr, col0 = u.pn * BM + wc * 32 + 8 * fq;
        constexpr float inv = FP8_SU / (FP8_SO * FP8_SW);
#pragma unroll
        for (int ai = 0; ai < 2; ++ai)
#pragma unroll
            for (int m = 0; m < 4; ++m) { unsigned char* rp = U + (size_t)(row0 + ai * HALF + m * 16) * 1024 + col0;
                u32x2 w[2];
#pragma unroll
                for (int bj = 0; bj < 2; ++bj) { const f32x4 v0 = acc[ai][bj][m][0] * inv, v1 = acc[ai][bj][m][1] * inv; w[bj].x = cvt4_fp8(v0[0], v0[1], v0[2], v0[3]); w[bj].y = cvt4_fp8(v1[0], v1[1], v1[2], v1[3]); }
                *(u32x4*)(rp + ((fq & 1) ? HALF - 8 : 0)) = widen16(w[0], w[1]); }
    }
};
struct EpiOut {
    static constexpr bool HAS_MID = false; static constexpr int MIN_STORES = 16;
    const bf16* X; bf16* Pre;
    DI void operator()(Acc& acc, const Unit& u, int wr, int wc, int fr, int fq) const {
        int row0 = u.pm * BM + wr * 64 + fr, col0 = u.pn * BM + wc * 32 + 8 * fq;
        asm volatile("" : "+v"(row0), "+v"(col0));
        constexpr float inv = 1.f / (FP8_SU * FP8_SW);
#pragma unroll
        for (int ai = 0; ai < 2; ++ai) { u32x4 xv[4][2];
#pragma unroll
            for (int m = 0; m < 4; ++m)
#pragma unroll
                for (int bj = 0; bj < 2; ++bj) xv[m][bj] = *(const u32x4*)(X + (size_t)(row0 + ai * HALF + m * 16) * 1024 + col0 + bj * HALF);
#pragma unroll
            for (int m = 0; m < 4; ++m)
#pragma unroll
                for (int bj = 0; bj < 2; ++bj) { const u32x4 w = xv[m][bj];
                    const f32x4 v0 = (f32x4){bflo(w.x), bfhi(w.x), bflo(w.y), bfhi(w.y)} * DN_ALPHA + acc[ai][bj][m][0] * inv, v1 = (f32x4){bflo(w.z), bfhi(w.z), bflo(w.w), bfhi(w.w)} * DN_ALPHA + acc[ai][bj][m][1] * inv;
                    *(u32x4*)(Pre + (size_t)(row0 + ai * HALF + m * 16) * 1024 + col0 + bj * HALF) = pack8(v0, v1); }
            asm volatile("" ::: "memory"); }
    }
};
struct EpiM1 {
    static constexpr bool HAS_MID = false; static constexpr int MIN_STORES = 4;
    unsigned char* H;
    DI void operator()(Acc& acc, const Unit& u, int wr, int wc, int fr, int fq) const {
        const int row0 = u.pm * BM + wr * 64 + fr, col0 = u.pn * 128 + wc * 32 + 8 * fq;
        constexpr float inv = 1.f / (FP8_SX * FP8_SW);
#pragma unroll
        for (int ai = 0; ai < 2; ++ai) if (u.hf == 0 || u.hf == ai + 1)
#pragma unroll
            for (int mp = 0; mp < 2; ++mp) { u32x2 w[2];
#pragma unroll
                for (int q = 0; q < 2; ++q) { const int m = 2 * mp + q; const f32x4 h0 = silu4(acc[ai][0][m][0] * inv) * (acc[ai][1][m][0] * (inv * FP8_SH)), h1 = silu4(acc[ai][0][m][1] * inv) * (acc[ai][1][m][1] * (inv * FP8_SH));
                    w[q].x = cvt4_fp8(h0[0], h0[1], h0[2], h0[3]); w[q].y = cvt4_fp8(h1[0], h1[1], h1[2], h1[3]); }
                *(u32x4*)(H + (size_t)(row0 + ai * HALF + (2 * mp + (fq & 1)) * 16) * 512 + col0 - 8 * (fq & 1)) = widen16(w[0], w[1]); }
    }
};
struct EpiM2 {
    static constexpr bool HAS_MID = false; static constexpr int MIN_STORES = 8;
    unsigned char* Y;
    DI void operator()(Acc& acc, const Unit& u, int wr, int wc, int fr, int fq) const {
        const int row0 = u.pm * BM + wr * 64 + fr, col0 = u.pn * BM + wc * 32 + 8 * fq;
        constexpr float inv = FP8_SY / (FP8_SH * FP8_SW);
#pragma unroll
        for (int ai = 0; ai < 2; ++ai) if (u.hf == 0 || u.hf == ai + 1)
#pragma unroll
            for (int m = 0; m < 4; ++m) { unsigned char* rp = Y + (size_t)(row0 + ai * HALF + m * 16) * 1024 + col0; u32x2 w[2];
#pragma unroll
                for (int bj = 0; bj < 2; ++bj) { const f32x4 v0 = acc[ai][bj][m][0] * inv, v1 = acc[ai][bj][m][1] * inv; w[bj].x = cvt4_fp8(v0[0], v0[1], v0[2], v0[3]); w[bj].y = cvt4_fp8(v1[0], v1[1], v1[2], v1[3]); }
                *(u32x4*)(rp + ((fq & 1) ? HALF - 8 : 0)) = widen16(w[0], w[1]); }
    }
};
}

struct Args { const float* in[19]; float* out; unsigned char* ws; int ph_lo, ph_hi; };
enum { I_X = 0, I_WIN, I_BIN, I_LBL, I_HGNG, I_RELB, I_WPA, I_WPB, I_WOUT, I_LN1G, I_LN1B, I_WGRP, I_BGRP, I_WEXP, I_BEXP, I_WGU, I_WDN, I_LN2G, I_LN2B };

struct Ctx {
    LAS unsigned char* lds; volatile LAS unsigned* MISC;
    int tid, lane, wid, G, vcu;
    unsigned char* ws; gu32* ctl;
};

DI int t5_bucket(int d) { if (d < 16) return d; const int v = 16 + (int)(logf((float)d * (1.f / 16.f)) / logf(8.f) * 16.f); return v < 31 ? v : 31; }
DI int win_drow(int n0) { if (n0 < 512) return 256 * (n0 >> 7) + (n0 & 127); if (n0 < 1024) { const int r = n0 - 512; return 256 * (r >> 7) + 128 + (r & 127); }
    if (n0 < 3584) return n0; if (n0 < 4608) { const int r = n0 - 3584; return 3584 + 256 * (r >> 7) + (r & 127); } const int r = n0 - 4608; return 3584 + 256 * (r >> 7) + 128 + (r & 127); }
DI int wgu_drow(int n0) { if (n0 < 512) return 256 * (n0 >> 7) + (n0 & 127); const int r = n0 - 512; return 256 * (r >> 7) + 128 + (r & 127); }
DI int hswz(int row, int ch16) { return 256 * row + 16 * (ch16 ^ (((row & 3) << 2) | ((row >> 2) & 3))); }
DI int htr(int r0, int c0, int lane) { const int i16 = lane & 15, q = i16 >> 2, p = i16 & 3; return hswz(r0 + q, c0 + (p >> 1)) + 8 * (p & 1); }
DI void transpose_tile256(const float* W, int N, bf16* WT, int ldk, int n0, int mode, int dk, LAS unsigned char* lds, int lane, int wid, bool f8 = false) {
    asm volatile("" : "+v"(lane));
    { f32x4 v[32];
#pragma unroll
        for (int i = 0; i < 32; ++i) v[i] = __builtin_nontemporal_load((const f32x4*)(W + (size_t)(8 * i + wid) * N + 4 * lane));
#pragma unroll
        for (int i = 0; i < 32; ++i) { const int k = 8 * i + wid; u32x2 w; w.x = cvtpk(v[i][0], v[i][1]); w.y = cvtpk(v[i][2], v[i][3]);
            *(LAS u32x2*)(lds + (lane >> 5) * 65536 + hswz(k, (lane & 31) >> 1) + 8 * (lane & 1)) = w; } }
    __syncthreads();
    const int g = lane >> 4, i16 = lane & 15;
#pragma unroll
    for (int nb = 0; nb < 2; ++nb) { const int nl = 32 * wid + 16 * nb + i16, n = n0 + nl; const int dr = (mode == 0) ? n : (mode == 1 ? win_drow(n) : wgu_drow(n));
        bf16* orow = WT + (size_t)dr * ldk + dk + 8 * g; const LAS unsigned char* img = lds + (wid >> 2) * 65536;
#pragma unroll
        for (int s = 0; s < 8; ++s) { const int r0 = 32 * s + 8 * g, c0 = 4 * (wid & 3) + 2 * nb;
            const s16x4 lo = vtr((LAS const char*)(img + htr(r0, c0, lane))), hh = vtr((LAS const char*)(img + htr(r0 + 4, c0, lane)));
            if (f8) { u32x2 w; w.x = cvt4_fp8(bf2f((unsigned short)lo[0]) * FP8_SW, bf2f((unsigned short)lo[1]) * FP8_SW, bf2f((unsigned short)lo[2]) * FP8_SW, bf2f((unsigned short)lo[3]) * FP8_SW);
                w.y = cvt4_fp8(bf2f((unsigned short)hh[0]) * FP8_SW, bf2f((unsigned short)hh[1]) * FP8_SW, bf2f((unsigned short)hh[2]) * FP8_SW, bf2f((unsigned short)hh[3]) * FP8_SW);
                *(u32x2*)((unsigned char*)WT + (size_t)dr * ldk + dk + 8 * g + 32 * s) = w; }
            else *(bf16x8*)(orow + 32 * s) = (bf16x8){lo[0], lo[1], lo[2], lo[3], hh[0], hh[1], hh[2], hh[3]}; } }
    __syncthreads();
}
constexpr int MOE_CVT_TILES = 32 * 16 + 32 * 8;
DI void moe_cvt_tile(const Ctx& C, const Args& a, int it) {
    unsigned char* WguT = (unsigned char*)a.out; unsigned char* WdT = (unsigned char*)a.out + 32 * MiB;
    if (it < 512) { const int e = it >> 4, kt = (it >> 2) & 3, nt = it & 3;
        transpose_tile256(a.in[I_WGU] + (size_t)e * 1024 * 1024 + (size_t)(256 * kt) * 1024 + 256 * nt, 1024, (bf16*)(WguT + (size_t)e * 1024 * 1024), 1024, 256 * nt, 2, 256 * kt, C.lds, C.lane, C.wid, true); }
    else { const int r = it - 512, e = r >> 3, kt = (r >> 2) & 1, nt = r & 3;
        transpose_tile256(a.in[I_WDN] + (size_t)e * 512 * 1024 + (size_t)(256 * kt) * 1024 + 256 * nt, 1024, (bf16*)(WdT + (size_t)e * 1024 * 512), 512, 256 * nt, 0, 256 * kt, C.lds, C.lane, C.wid, true); }
}
DI void p0_prologue(const Ctx& C, const Args& a) {
    bf16* WinT = (bf16*)(C.ws + WS_WIN); bf16* Wcat = (bf16*)(C.ws + WS_WCAT); bf16* WoT = (bf16*)(C.ws + WS_WO);
    constexpr int I_IN = 4 * 22, I_PA = 2 * 4, I_O = 4 * 4, NITEMS = I_IN + 2 * I_PA + I_O;
    for (int it = C.vcu; it < NITEMS; it += C.G) {
        int r = it;
        if (r < I_IN) { const int kt = r / 22, nt = r % 22;
            if (nt < 4) transpose_tile256(a.in[I_WIN] + (size_t)(256 * kt) * NIN + 256 * nt, NIN, WinT, 1024, 256 * nt, 1, 256 * kt, C.lds, C.lane, C.wid);
            else transpose_tile256(a.in[I_WIN] + (size_t)(256 * kt) * NIN + 256 * nt, NIN, (bf16*)(C.ws + WS_WIN + 2 * MiB - (size_t)1024 * 1024), 1024, 256 * nt, 1, 256 * kt, C.lds, C.lane, C.wid, true);
            continue; } r -= I_IN;
        if (r < I_PA) { const int kt = r / 4, nt = r % 4; transpose_tile256(a.in[I_WPA] + (size_t)(256 * kt) * 1024 + 256 * nt, 1024, Wcat, 1024, 256 * nt, 0, 256 * kt, C.lds, C.lane, C.wid, true); continue; } r -= I_PA;
        if (r < I_PA) { const int kt = r / 4, nt = r % 4; transpose_tile256(a.in[I_WPB] + (size_t)(256 * kt) * 1024 + 256 * nt, 1024, Wcat, 1024, 256 * nt, 0, 512 + 256 * kt, C.lds, C.lane, C.wid, true); continue; } r -= I_PA;
        { const int kt = r / 4, nt = r % 4; transpose_tile256(a.in[I_WOUT] + (size_t)(256 * kt) * 1024 + 256 * nt, 1024, WoT, 1024, 256 * nt, 0, 256 * kt, C.lds, C.lane, C.wid, true); }
    }
    const int gw = C.vcu * NWAVES + C.wid, NGW = C.G * NWAVES; (void)gw; (void)NGW;
    const int gt = C.vcu * NTHREADS + C.tid, NT = C.G * NTHREADS;
    { const float* x = a.in[I_X]; bf16* Xb = (bf16*)(C.ws + WS_XB);
      unsigned char* Xq = (unsigned char*)a.out + 64 * MiB;
      for (int i = gt; i < NTOK * DM / 8; i += NT) { const f32x4 v0 = __builtin_nontemporal_load((const f32x4*)(x + (size_t)i * 8)), v1 = __builtin_nontemporal_load((const f32x4*)(x + (size_t)i * 8 + 4));   *(u32x4*)(Xb + (size_t)i * 8) = pg8::pack8(v0, v1);
          u32x2 q; q.x = cvt4_fp8(v0[0] * FP8_SXI, v0[1] * FP8_SXI, v0[2] * FP8_SXI, v0[3] * FP8_SXI); q.y = cvt4_fp8(v1[0] * FP8_SXI, v1[1] * FP8_SXI, v1[2] * FP8_SXI, v1[3] * FP8_SXI); *(u32x2*)(Xq + (size_t)i * 8) = q; } }
    { float* tg = (float*)(C.ws + WS_TABG); for (int i = gt; i < 8 * 129; i += NT) { const int hh = i / 129, d = i % 129; tg[hh * 132 + d] = (a.in[I_RELB][t5_bucket(d) * 8 + hh] - a.in[I_RELB][31 * 8 + hh]) * LOG2E; } }
    { float* lbp = (float*)(C.ws + WS_LB); for (int n = gt; n < 512; n += NT) lbp[n] = 1.f / (1.f + expf(a.in[I_LBL][512 + n] - a.in[I_LBL][n])); }
    { float* bp = (float*)(C.ws + WS_BPERM); const float* bin = a.in[I_BIN];
      for (int n = gt; n < NIN; n += NT) bp[win_drow(n & ~31) + (n & 31)] = bin[n]; }
    { bf16* wh = (bf16*)(C.ws + WS_WRH); bf16* wl = (bf16*)(C.ws + WS_WRL); const float* wg = a.in[I_WGRP]; const float* we = a.in[I_WEXP];
      for (int i = gt; i < 48 * 1024; i += NT) { const int j = i >> 10, k = i & 1023; float w = 0.f; if (j < 4) w = wg[k * 4 + j]; else if (j < 36) w = we[k * 32 + (j - 4)];
          const unsigned h = cvtpk(w, 0.f) & 0xffffu; const float r = w - bf2f((unsigned short)h); wh[i] = (bf16)h; wl[i] = (bf16)(cvtpk(r, 0.f) & 0xffffu); } }
}
DI unsigned claim_add(unsigned* p) { unsigned long long a = (unsigned long long)p; asm volatile("" : "+v"(a)); return __hip_atomic_fetch_add((GAS unsigned*)a, 1u, __ATOMIC_RELAXED, __HIP_MEMORY_SCOPE_AGENT); }
DI void glds16(const void* gsrc, unsigned lds_dst) { unsigned keep;
    asm volatile("s_mov_b32 %0, m0\n\ts_mov_b32 m0, %2\n\ts_nop 0\n\tglobal_load_lds_dwordx4 %1, off\n\ts_mov_b32 m0, %0" : "=&s"(keep) : "v"(gsrc), "s"(lds_dst) : "memory"); }
DI void glds16nt(const void* gsrc, unsigned lds_dst) { unsigned keep;
    asm volatile("s_mov_b32 %0, m0\n\ts_mov_b32 m0, %2\n\ts_nop 0\n\tglobal_load_lds_dwordx4 %1, off nt\n\ts_mov_b32 m0, %0" : "=&s"(keep) : "v"(gsrc), "s"(lds_dst) : "memory"); }
constexpr int HG_BUF = 67072, HG_QP = 0, HG_KP = 16384, HG_V = 32768, HG_SC = 49152, HG_OB = 49664;
DI void hgrn_unit(const Ctx& C, const Args& a, int b, int h) {
    LAS unsigned char* L = C.lds;
    const int tid = C.tid, lane = C.lane, wid = C.wid;
    const int q32 = lane & 31, hi = lane >> 5, dh = (lane >> 4) & 1, dvb = wid & 3, tb = wid >> 2;
    const float* BM = (const float*)(C.ws + WS_ZF); const float* BE = BM + 262144;
    const bf16* Qh = (const bf16*)(C.ws + WS_QH); const bf16* Kh = (const bf16*)(C.ws + WS_KK); const bf16* Vh = (const bf16*)(C.ws + WS_VH); const bf16* Gh = (const bf16*)(C.ws + WS_GH);
    bf16* Ocat = (bf16*)(C.ws + WS_OCAT);
    const size_t rb = (size_t)b * SEQ;
    LAS float* NGS = (LAS float*)(L + 2 * HG_BUF);
    if (tid < 128) NGS[tid] = a.in[I_HGNG][h * 128 + tid];
    const int orow = tid >> 3, oseg = tid & 7;
    f32x16 T[4];
#pragma unroll
    for (int i = 0; i < 4; ++i)
#pragma unroll
        for (int r = 0; r < 16; ++r) T[i][r] = 0.f;
    u32x4 gr[2];
    const int drow = 8 * wid + (lane >> 4), dch = lane & 15;
#define HG_DMA(c) do { _Pragma("unroll") for (int p = 0; p < 2; ++p) { const int r_ = drow + 4 * p; const int sc_ = dch ^ (((r_ & 3) << 2) | ((r_ >> 2) & 3)); \
            const size_t g_ = (rb + (size_t)(c) * 64 + r_) * 512 + h * 128 + 8 * sc_; LAS unsigned char* d_ = L + ((c) & 1) * HG_BUF + (8 * wid + 4 * p) * 256; \
            const unsigned dl_ = (unsigned)__builtin_amdgcn_readfirstlane((int)(unsigned)(size_t)d_); \
            glds16(Qh + g_, dl_ + HG_QP); glds16(Kh + g_, dl_ + HG_KP); glds16(Vh + g_, dl_ + HG_V); } } while (0)
    float sm = 0.f, spe = 0.f, spm = 0.f;
#define HG_SCLOAD(c) do { if (tid < 128) { const size_t s_ = (size_t)(b * 32 + (c)) * 512 + h * 128 + tid; sm = BM[s_]; if ((c) > 0) { spe = BE[s_ - 512]; spm = BM[s_ - 512]; } } } while (0)
#define HG_SCALE(c) do { if (tid < 128) ((LAS float*)(L + ((c) & 1) * HG_BUF + HG_SC))[tid] = __expf(sm + (spe - spm)); } while (0)
    HG_DMA(0);
    HG_SCLOAD(0);
    HG_SCALE(0);
    asm volatile("s_waitcnt vmcnt(0)" ::: "memory");
    __syncthreads();
    for (int c = 0; c < 32; ++c) {
        const LAS unsigned char* B = L + (c & 1) * HG_BUF;
        if (c + 1 < 32) { HG_DMA(c + 1); HG_SCLOAD(c + 1); }
        int q32o = q32, hio = hi, laneo = lane; asm volatile("" : "+v"(q32o), "+v"(hio), "+v"(laneo));
        f32x16 oT;
#pragma unroll
        for (int r = 0; r < 16; ++r) oT[r] = 0.f;
        bf16x8 qb[8];
#pragma unroll
        for (int ks = 0; ks < 8; ++ks) qb[ks] = *(const LAS bf16x8*)(B + HG_QP + hswz(32 * tb + q32o, 2 * ks + hio));
#pragma unroll
        for (int sb = 0; sb < 2; ++sb) {
            if (sb <= tb) {
                bf16x8 ka[8];
#pragma unroll
                for (int ks = 0; ks < 8; ++ks) ka[ks] = *(const LAS bf16x8*)(B + HG_KP + hswz(32 * sb + q32o, 2 * ks + hio));
                s16x4 vl[2], vh[2];
#pragma unroll
                for (int s2 = 0; s2 < 2; ++s2) { const int r0 = 32 * sb + 16 * s2 + 4 * hio; vl[s2] = vtr((LAS const char*)(B + HG_V + htr(r0, 4 * dvb + 2 * dh, laneo))); vh[s2] = vtr((LAS const char*)(B + HG_V + htr(r0 + 8, 4 * dvb + 2 * dh, laneo))); }
                __builtin_amdgcn_sched_barrier(0);
                f32x16 pT;
#pragma unroll
                for (int r = 0; r < 16; ++r) pT[r] = 0.f;
#pragma unroll
                for (int ks = 0; ks < 8; ++ks) pT = MFMA32(ka[ks], qb[ks], pT);
                if (sb == tb) {
#pragma unroll
                    for (int r = 0; r < 16; ++r) if (crow(r, hi) > q32) pT[r] = 0.f;
                }
#pragma unroll
                for (int s2 = 0; s2 < 2; ++s2) { u32x4 pw; pw.x = cvtpk(pT[8 * s2 + 0], pT[8 * s2 + 1]); pw.y = cvtpk(pT[8 * s2 + 2], pT[8 * s2 + 3]); pw.z = cvtpk(pT[8 * s2 + 4], pT[8 * s2 + 5]); pw.w = cvtpk(pT[8 * s2 + 6], pT[8 * s2 + 7]);
                    oT = MFMA32(((bf16x8){vl[s2][0], vl[s2][1], vl[s2][2], vl[s2][3], vh[s2][0], vh[s2][1], vh[s2][2], vh[s2][3]}), __builtin_bit_cast(bf16x8, pw), oT); }
                __builtin_amdgcn_sched_barrier(0);
            }
        }
        { const size_t g0 = (rb + (size_t)c * 64 + orow) * 512 + h * 128 + 16 * oseg; gr[0] = *(const u32x4*)(Gh + g0); gr[1] = *(const u32x4*)(Gh + g0 + 8); }
        {
            u32x2 qq0[8], qq1[8];
            if (c > 0) {
#pragma unroll
                for (int i = 0; i < 4; ++i)
#pragma unroll
                    for (int s = 0; s < 2; ++s) { qq0[2 * i + s] = *(const LAS u32x2*)(B + HG_QP + hswz(32 * tb + q32o, 4 * i + 2 * s) + 8 * hio); qq1[2 * i + s] = *(const LAS u32x2*)(B + HG_QP + hswz(32 * tb + q32o, 4 * i + 2 * s + 1) + 8 * hio); }
            }
#pragma unroll
            for (int ip = 0; ip < 2; ++ip) { f32x4 sc[2][4];
#pragma unroll
                for (int i = 0; i < 2; ++i)
#pragma unroll
                    for (int g = 0; g < 4; ++g) sc[i][g] = *(const LAS f32x4*)(B + HG_SC + (32 * (2 * ip + i) + 8 * g + 4 * hio) * 4);
                __builtin_amdgcn_sched_barrier(0);
#pragma unroll
                for (int i = 0; i < 2; ++i)
#pragma unroll
                    for (int g = 0; g < 4; ++g)
#pragma unroll
                        for (int j = 0; j < 4; ++j) T[2 * ip + i][4 * g + j] *= sc[i][g][j];
                __builtin_amdgcn_sched_barrier(0); }
            if (c > 0) {
#pragma unroll
                for (int i = 0; i < 4; ++i)
#pragma unroll
                    for (int s = 0; s < 2; ++s) { u32x4 tw; tw.x = cvtpk(T[i][8 * s + 0], T[i][8 * s + 1]); tw.y = cvtpk(T[i][8 * s + 2], T[i][8 * s + 3]); tw.z = cvtpk(T[i][8 * s + 4], T[i][8 * s + 5]); tw.w = cvtpk(T[i][8 * s + 6], T[i][8 * s + 7]);
                        const u32x4 qw = (u32x4){qq0[2 * i + s].x, qq0[2 * i + s].y, qq1[2 * i + s].x, qq1[2 * i + s].y};
                        oT = MFMA32(__builtin_bit_cast(bf16x8, tw), __builtin_bit_cast(bf16x8, qw), oT); }
            }
        }
        { LAS unsigned char* OBp = L + (c & 1) * HG_BUF + HG_OB;
#pragma unroll
          for (int g = 0; g < 4; ++g) { u32x2 w; w.x = cvtpk(oT[4 * g], oT[4 * g + 1]); w.y = cvtpk(oT[4 * g + 2], oT[4 * g + 3]); *(LAS u32x2*)(OBp + (32 * tb + q32o) * 272 + (32 * dvb + 8 * g + 4 * hio) * 2) = w; } }
#pragma unroll
        for (int sp = 0; sp < 2; ++sp) {
            s16x4 vl[2], vh[2], kl[2][4], kh[2][4];
#pragma unroll
            for (int u = 0; u < 2; ++u) { const int r0 = 16 * (2 * sp + u) + 8 * hio;
                vl[u] = vtr((LAS const char*)(B + HG_V + htr(r0, 4 * dvb + 2 * dh, laneo))); vh[u] = vtr((LAS const char*)(B + HG_V + htr(r0 + 4, 4 * dvb + 2 * dh, laneo)));
#pragma unroll
                for (int i = 0; i < 4; ++i) { kl[u][i] = vtr((LAS const char*)(B + HG_KP + htr(r0, 4 * i + 2 * dh, laneo))); kh[u][i] = vtr((LAS const char*)(B + HG_KP + htr(r0 + 4, 4 * i + 2 * dh, laneo))); } }
            __builtin_amdgcn_sched_barrier(0);
#pragma unroll
            for (int u = 0; u < 2; ++u) { const bf16x8 vb = (bf16x8){vl[u][0], vl[u][1], vl[u][2], vl[u][3], vh[u][0], vh[u][1], vh[u][2], vh[u][3]};
#pragma unroll
                for (int i = 0; i < 4; ++i) T[i] = MFMA32(((bf16x8){kl[u][i][0], kl[u][i][1], kl[u][i][2], kl[u][i][3], kh[u][i][0], kh[u][i][1], kh[u][i][2], kh[u][i][3]}), vb, T[i]); }
            __builtin_amdgcn_sched_barrier(0);
        }
        if (c + 1 < 32) HG_SCALE(c + 1);
        asm volatile("s_waitcnt vmcnt(0)" ::: "memory");
        __syncthreads();
        { const LAS unsigned char* OBp = L + (c & 1) * HG_BUF + HG_OB + orow * 272 + oseg * 32;
          const u32x4 o0 = *(const LAS u32x4*)OBp, o1 = *(const LAS u32x4*)(OBp + 16);
          float ov[16];
          ov[0] = bflo(o0.x); ov[1] = bfhi(o0.x); ov[2] = bflo(o0.y); ov[3] = bfhi(o0.y); ov[4] = bflo(o0.z); ov[5] = bfhi(o0.z); ov[6] = bflo(o0.w); ov[7] = bfhi(o0.w);
          ov[8] = bflo(o1.x); ov[9] = bfhi(o1.x); ov[10] = bflo(o1.y); ov[11] = bfhi(o1.y); ov[12] = bflo(o1.z); ov[13] = bfhi(o1.z); ov[14] = bflo(o1.w); ov[15] = bfhi(o1.w);
          float ss = 0.f;
#pragma unroll
          for (int j = 0; j < 16; ++j) ss += ov[j] * ov[j];
          ss += __int_as_float(__builtin_amdgcn_update_dpp(0, __float_as_int(ss), 0xB1, 0xf, 0xf, true));
          ss += __int_as_float(__builtin_amdgcn_update_dpp(0, __float_as_int(ss), 0x4E, 0xf, 0xf, true));
          ss += __int_as_float(__builtin_amdgcn_update_dpp(0, __float_as_int(ss), 0x141, 0xf, 0xf, true));
          const float rs = __builtin_amdgcn_rsqf(ss * (1.f / 128.f) + LN_EPS);
          float ng[16];
#pragma unroll
          for (int i = 0; i < 4; ++i) { const f32x4 n_ = *(const LAS f32x4*)(NGS + 16 * oseg + 4 * i); ng[4 * i] = n_[0]; ng[4 * i + 1] = n_[1]; ng[4 * i + 2] = n_[2]; ng[4 * i + 3] = n_[3]; }
          float gvv[16];
          gvv[0] = bflo(gr[0].x); gvv[1] = bfhi(gr[0].x); gvv[2] = bflo(gr[0].y); gvv[3] = bfhi(gr[0].y); gvv[4] = bflo(gr[0].z); gvv[5] = bfhi(gr[0].z); gvv[6] = bflo(gr[0].w); gvv[7] = bfhi(gr[0].w);
          gvv[8] = bflo(gr[1].x); gvv[9] = bfhi(gr[1].x); gvv[10] = bflo(gr[1].y); gvv[11] = bfhi(gr[1].y); gvv[12] = bflo(gr[1].z); gvv[13] = bfhi(gr[1].z); gvv[14] = bflo(gr[1].w); gvv[15] = bfhi(gr[1].w);
          float rv[16];
#pragma unroll
          for (int j = 0; j < 16; ++j) rv[j] = ov[j] * (rs * FP8_SO) * ng[j] * gvv[j];
          u32x4 w0; w0.x = cvt4_fp8(rv[0], rv[1], rv[2], rv[3]); w0.y = cvt4_fp8(rv[4], rv[5], rv[6], rv[7]); w0.z = cvt4_fp8(rv[8], rv[9], rv[10], rv[11]); w0.w = cvt4_fp8(rv[12], rv[13], rv[14], rv[15]);
          unsigned char* op = (unsigned char*)Ocat + (rb + (size_t)c * 64 + orow) * 1024 + h * 128 + 16 * oseg;
          *(u32x4*)op = w0; }
    }
    __syncthreads();
#undef HG_DMA
#undef HG_SCALE
#undef HG_SCLOAD
}

constexpr int AT_NST = 8, AT_K = 0, AT_V = AT_NST * 4096, AT_KM = 2 * AT_NST * 4096, AT_TAB = AT_KM + 1792;
DI float max3f(float a, float b, float c) { float r; asm("v_max3_f32 %0, %1, %2, %3" : "=v"(r) : "v"(a), "v"(b), "v"(c)); return r; }
#define MFMA64(a, b, c, sa, sb) __builtin_amdgcn_mfma_scale_f32_32x32x64_f8f6f4((a), (b), (c), 0, 0, 0, (sa), 0, (sb))
DI unsigned cvt4_raw(float a, float b, float c, float d) { int w = __float_as_int(a); w = __builtin_amdgcn_cvt_pk_fp8_f32(a, b, w, false); w = __builtin_amdgcn_cvt_pk_fp8_f32(c, d, w, true); return (unsigned)w; }
constexpr int CV_Z = 69632, CV_PITCH = 1056, CV_WSTRIDE = 8 * CV_PITCH, CV_NCH = 3072;
DI void cv_issue(const Ctx& C, const Args& a, int c) {
    const int nt = c & 3; const float* src;
    if (c < 2048) { const int kc = c >> 2; src = a.in[I_WGU] + (size_t)(kc >> 4) * 1024 * 1024 + (size_t)(64 * (kc & 15)) * 1024 + 256 * nt; }
    else { const int kc = (c - 2048) >> 2; src = a.in[I_WDN] + (size_t)(kc >> 3) * 512 * 1024 + (size_t)(64 * (kc & 7)) * 1024 + 256 * nt; }
    src += (size_t)(C.lane >> 3) * 1024 + 32 * C.wid + 4 * (C.lane & 7);
    const unsigned dst = (unsigned)__builtin_amdgcn_readfirstlane((int)(unsigned)(size_t)(C.lds + CV_Z + C.wid * CV_WSTRIDE));
#pragma unroll
    for (int j = 0; j < 8; ++j) glds16nt(src + (size_t)(8 * j) * 1024, dst + j * CV_PITCH);
}
DI void cv_convert(const Ctx& C, const Args& a, int c) {
    const int n = C.lane & 31, kh = C.lane >> 5, nn = 256 * (c & 3) + 32 * C.wid + n;
    const LAS unsigned char* z = C.lds + CV_Z + C.wid * CV_WSTRIDE + (4 * kh) * CV_PITCH + 4 * n;
    float v[32];
#pragma unroll
    for (int jj = 0; jj < 32; ++jj) v[jj] = *(const LAS float*)(z + (jj >> 3) * CV_PITCH + (jj & 7) * 128) * FP8_SW;
    unsigned char* dst;
    if (c < 2048) { const int kc = c >> 2; dst = (unsigned char*)a.out + (size_t)(kc >> 4) * 1024 * 1024 + (size_t)wgu_drow(nn) * 1024 + 64 * (kc & 15) + 32 * kh; }
    else { const int kc = (c - 2048) >> 2; dst = (unsigned char*)a.out + 32 * MiB + (size_t)(kc >> 3) * 1024 * 512 + (size_t)nn * 512 + 64 * (kc & 7) + 32 * kh; }
    u32x4 w0, w1;
    w0.x = cvt4_fp8(v[0], v[1], v[2], v[3]); w0.y = cvt4_fp8(v[4], v[5], v[6], v[7]); w0.z = cvt4_fp8(v[8], v[9], v[10], v[11]); w0.w = cvt4_fp8(v[12], v[13], v[14], v[15]);
    w1.x = cvt4_fp8(v[16], v[17], v[18], v[19]); w1.y = cvt4_fp8(v[20], v[21], v[22], v[23]); w1.z = cvt4_fp8(v[24], v[25], v[26], v[27]); w1.w = cvt4_fp8(v[28], v[29], v[30], v[31]);
    __builtin_nontemporal_store(w0, (u32x4*)dst); __builtin_nontemporal_store(w1, (u32x4*)(dst + 16));
}
DI void attn_unit(const Ctx& C, const Args& a, int b, int h, int jq, unsigned* QC, unsigned& cv_next) {
    LAS unsigned char* L = C.lds;
    const int tid = C.tid, lane = C.lane, wid = C.wid, q32 = lane & 31, hi = lane >> 5;
    const bf16* Qm = (const bf16*)(C.ws + WS_QM); const unsigned char* Q8 = C.ws + WS_VM; const unsigned char* K8 = C.ws + WS_KM; const unsigned char* VT8 = C.ws + WS_KM + 16 * MiB; const float* KM = (const float*)(C.ws + WS_KMEAN);
    bf16* Ocat = (bf16*)(C.ws + WS_OCAT);
    const int tq = jq * 256 + wid * 32 + q32;
    const size_t hb = (size_t)(b * 8 + h) * SEQ;
    const int drow = 16 * (wid & 3) + (lane >> 2), dch = lane & 3, sch = dch ^ ((drow >> 2) & 3);
    const unsigned char* dsrc = (wid < 4) ? K8 + (hb + drow) * 64 + 16 * sch : VT8 + (size_t)(b * 8 + h) * 32 * 4096 + drow * 64 + 16 * sch;
    const unsigned ddst = (unsigned)__builtin_amdgcn_readfirstlane((int)(unsigned)(size_t)(L + (wid < 4 ? AT_K : AT_V) + (wid & 3) * 1024));
    const int nt = 4 * jq + 4;
#define AT_ISSUE(t) glds16(dsrc + (size_t)(t) * 4096, ddst + ((t) & 7) * 4096)
    AT_ISSUE(0); AT_ISSUE(1); AT_ISSUE(2); AT_ISSUE(3);
    const v8i qf8 = *(const v8i*)(Q8 + (hb + tq) * 64 + 32 * hi);
    bf16x8 qg[4];
#pragma unroll
    for (int ks = 0; ks < 4; ++ks) qg[ks] = *(const bf16x8*)(Qm + (hb + tq) * 64 + 16 * ks + 8 * hi);
    LAS float* kml = (LAS float*)(L + AT_KM); LAS float* tab = (LAS float*)(L + AT_TAB);
    {
        const int kt_ = (tid < jq * 64) ? tid : 0, n_ = kt_ >> 6, d_ = kt_ & 63, dd_ = tid - 64, dc_ = dd_ < 0 ? 0 : (dd_ > 128 ? 128 : dd_);
        const float k0_ = KM[(size_t)((b * 8 + n_) * 2 + 0) * 512 + h * 64 + d_], k1_ = KM[(size_t)((b * 8 + n_) * 2 + 1) * 512 + h * 64 + d_], tv_ = ((const float*)(C.ws + WS_TABG))[h * 132 + dc_];
        if (tid < jq * 64) kml[tid] = k0_ + k1_;
        if (tid < 288) tab[tid] = dd_ < 0 ? -INFINITY : (dd_ <= 128 ? tv_ : 0.f);
    }
    __syncthreads();
    unsigned sel = 0;
    {
        float g[7];
#pragma unroll
        for (int n = 0; n < 7; ++n) { g[n] = 0.f;
            if (n < jq) { float s = 0.f; f32x4 kv[4][2];
#pragma unroll
                for (int ks = 0; ks < 4; ++ks) { kv[ks][0] = *(const LAS f32x4*)(kml + n * 64 + 16 * ks + 8 * hi); kv[ks][1] = *(const LAS f32x4*)(kml + n * 64 + 16 * ks + 8 * hi + 4); }
                __builtin_amdgcn_sched_barrier(0);
#pragma unroll
                for (int ks = 0; ks < 4; ++ks)
#pragma unroll
                    for (int j = 0; j < 8; ++j) s += bf2f((unsigned short)qg[ks][j]) * kv[ks][j >> 2][j & 3];
                { const auto r_ = __builtin_amdgcn_permlane32_swap(__float_as_uint(s), __float_as_uint(s), false, false); s = __uint_as_float(r_[0]) + __uint_as_float(r_[1]); } g[n] = s; } }
#pragma unroll
        for (int n = 0; n < 7; ++n) if (n < jq) { int rank = 0;
#pragma unroll
            for (int m = 0; m < 7; ++m) if (m != n && m < jq) rank += (g[m] > g[n] || (g[m] == g[n] && m < n)) ? 1 : 0;
            if (rank < 3) sel |= 1u << n; }
    }
    const float c31 = a.in[I_RELB][31 * 8 + h] * LOG2E;
    f32x16 lacc;
#pragma unroll
    for (int r = 0; r < 16; ++r) lacc[r] = 0.f;
    v8i ones8 = (v8i){0x38383838, 0x38383838, 0x38383838, 0x38383838, 0x38383838, 0x38383838, 0x38383838, 0x38383838};
    asm volatile("" : "+v"(ones8));
    f32x16 negm;
#pragma unroll
    for (int r = 0; r < 16; ++r) negm[r] = c31;
    f32x16 o0, o1;
#pragma unroll
    for (int r = 0; r < 16; ++r) { o0[r] = 0.f; o1[r] = 0.f; }
    const int fsw = (q32 >> 2) & 3;
    const int fo0 = q32 * 64 + (((2 * hi) ^ fsw) << 4), fo1 = q32 * 64 + (((2 * hi + 1) ^ fsw) << 4);
    int cv_pend = -1, cv_nst = 0;
    for (int kt = 0; kt < nt; ++kt) {
        if ((kt & 3) == 0) {
            const bool cvb = ((kt >> 2) & 1) == 0;
            const int slot = 2 + ((kt >> 3) & 1);
            if (cvb) { if (tid == 0) C.MISC[slot] = cv_next;
                asm volatile("s_waitcnt vmcnt(0)" ::: "memory"); }
            else {
                if (cv_nst == 10) asm volatile("s_waitcnt vmcnt(10)" ::: "memory"); else if (cv_nst == 8) asm volatile("s_waitcnt vmcnt(8)" ::: "memory");
                else if (cv_nst == 2) asm volatile("s_waitcnt vmcnt(2)" ::: "memory"); else asm volatile("s_waitcnt vmcnt(0)" ::: "memory"); }
            __builtin_amdgcn_s_barrier();
            asm volatile("" ::: "memory");
            if (kt + 4 < nt) { AT_ISSUE(kt + 4); AT_ISSUE(kt + 5); AT_ISSUE(kt + 6); AT_ISSUE(kt + 7); }
            if (cvb) {
                cv_nst = 0;
                if (cv_pend >= 0) { cv_convert(C, a, cv_pend); cv_nst = 2; }
                const int cnew = __builtin_amdgcn_readfirstlane((int)C.MISC[slot]);
                cv_pend = -1;
                if (cnew < CV_NCH) { asm volatile("s_waitcnt lgkmcnt(0)" ::: "memory"); cv_issue(C, a, cnew); cv_pend = cnew; cv_nst += 8;
                    if (tid == 0) cv_next = claim_add(QC); }
            }
        }
        const int blk = kt >> 2; const bool own = (blk == jq);
        const bool active = !own || ((kt & 3) * 64 <= wid * 32 + 31);
        if (active) {
            const LAS unsigned char* Kc = L + AT_K + (kt & 7) * 4096; const LAS unsigned char* Vc = L + AT_V + (kt & 7) * 4096;
            const v8i k0 = __builtin_shufflevector(*(const LAS v4i*)(Kc + fo0), *(const LAS v4i*)(Kc + fo1), 0, 1, 2, 3, 4, 5, 6, 7);
            const v8i k1 = __builtin_shufflevector(*(const LAS v4i*)(Kc + 2048 + fo0), *(const LAS v4i*)(Kc + 2048 + fo1), 0, 1, 2, 3, 4, 5, 6, 7);
            const v8i v0f = __builtin_shufflevector(*(const LAS v4i*)(Vc + fo0), *(const LAS v4i*)(Vc + fo1), 0, 1, 2, 3, 4, 5, 6, 7);
            const v8i v1f = __builtin_shufflevector(*(const LAS v4i*)(Vc + 2048 + fo0), *(const LAS v4i*)(Vc + 2048 + fo1), 0, 1, 2, 3, 4, 5, 6, 7);
            __builtin_amdgcn_sched_barrier(0);
            f32x16 s0 = MFMA64(k0, qf8, negm, 0x7c7c7c7c, 0x7b7b7b7b), s1 = MFMA64(k1, qf8, negm, 0x7c7c7c7c, 0x7b7b7b7b);
            const bool near = (jq * 256 + wid * 32 - 64 * kt - 63) < 128;
            if (near) {
                const LAS float* tb = tab + (tq - 64 * kt - 4 * hi + 5);
                float t0[16], t1[16];
#pragma unroll
                for (int r = 0; r < 16; ++r) { t0[r] = tb[59 - ((r & 3) + 8 * (r >> 2))]; t1[r] = tb[27 - ((r & 3) + 8 * (r >> 2))]; }
#pragma unroll
                for (int r = 0; r < 16; ++r) { s0[r] += t0[r]; s1[r] += t1[r]; }
            }
            const bool lsel = own || ((sel >> blk) & 1u);
            float mx = max3f(s0[0], s1[0], s0[1]), mx2 = max3f(s1[1], s0[2], s1[2]);
#pragma unroll
            for (int r = 3; r < 15; r += 2) { mx = max3f(mx, s0[r], s1[r]); mx2 = max3f(mx2, s0[r + 1], s1[r + 1]); }
            mx = max3f(mx, s0[15], s1[15]); mx = max3f(mx, mx2, mx2);
            mx = lsel ? mx : -INFINITY;
            { const auto r_ = __builtin_amdgcn_permlane32_swap(__float_as_uint(mx), __float_as_uint(mx), false, false); mx = max3f(__uint_as_float(r_[0]), __uint_as_float(r_[1]), __uint_as_float(r_[1])); }
            if (__any(mx > 7.0f)) {
                const float delta = fmaxf(mx, 0.f), alpha = __builtin_amdgcn_exp2f(-delta);
#pragma unroll
                for (int r = 0; r < 16; ++r) { o0[r] *= alpha; o1[r] *= alpha; lacc[r] *= alpha; negm[r] -= delta; s0[r] -= delta; s1[r] -= delta; }
            }
#pragma unroll
            for (int r = 0; r < 16; ++r) { s0[r] = __builtin_amdgcn_exp2f(s0[r]); s1[r] = __builtin_amdgcn_exp2f(s1[r]); }
            const int pmask = lsel ? -1 : 0;
            v8i pb;
#pragma unroll
            for (int j = 0; j < 4; ++j) { pb[j] = (int)cvt4_raw(s0[4 * j], s0[4 * j + 1], s0[4 * j + 2], s0[4 * j + 3]) & pmask; pb[4 + j] = (int)cvt4_raw(s1[4 * j], s1[4 * j + 1], s1[4 * j + 2], s1[4 * j + 3]) & pmask; }
            o0 = MFMA64(v0f, pb, o0, 0x7c7c7c7c, 0x7f7f7f7f); o1 = MFMA64(v1f, pb, o1, 0x7c7c7c7c, 0x7f7f7f7f);
            lacc = MFMA64(ones8, pb, lacc, 0x7f7f7f7f, 0x7f7f7f7f);
        }
    }
    if (cv_pend >= 0) { asm volatile("s_waitcnt vmcnt(0)" ::: "memory"); cv_convert(C, a, cv_pend); asm volatile("s_waitcnt lgkmcnt(0)" ::: "memory"); }
    const float linv = 1.f / lacc[0];
    unsigned char* op = (unsigned char*)Ocat + ((size_t)b * SEQ + tq) * 1024 + 512 + h * 64;
    const float lsc = linv * FP8_SO;
#pragma unroll
    for (int g = 0; g < 4; ++g) { *(unsigned*)(op + 8 * g + 4 * hi) = cvt4_fp8(o0[4 * g] * lsc, o0[4 * g + 1] * lsc, o0[4 * g + 2] * lsc, o0[4 * g + 3] * lsc);
        *(unsigned*)(op + 32 + 8 * g + 4 * hi) = cvt4_fp8(o1[4 * g] * lsc, o1[4 * g + 1] * lsc, o1[4 * g + 2] * lsc, o1[4 * g + 3] * lsc); }
    __syncthreads();
#undef AT_ISSUE
}

#ifndef PROBE_HGX
#define PROBE_HGX 1
#endif
#ifndef PROBE_ATX
#define PROBE_ATX 1
#endif
#ifndef STAMP_SEL
#define STAMP_SEL -1
#endif
#ifndef STAMP_BLK
#define STAMP_BLK 0
#endif
#define STAMP(i) do { if (STAMP_SEL >= 0 && blockIdx.x == STAMP_BLK && C.tid == 0) { const unsigned long long t_ = __builtin_amdgcn_s_memrealtime(); C.MISC[16 + 2 * (i)] = (unsigned)t_; C.MISC[17 + 2 * (i)] = (unsigned)(t_ >> 32); } } while (0)
DI void p2_mixers(const Ctx& C, const Args& a, int rep) {
    for (int hx = 0; hx < PROBE_HGX; ++hx)
    for (int u = blockIdx.x; u < 64; u += C.G) hgrn_unit(C, a, u >> 2, u & 3);
    STAMP(11);
    unsigned* QA = (unsigned*)(C.ctl + CW_QUEUE + 64 * rep); unsigned* QC = (unsigned*)(C.ctl + CW_QUEUE2);
    constexpr int NA = 1024 * PROBE_ATX;
    unsigned cv_next = (unsigned)CV_NCH;
    if (C.tid == 0) { C.MISC[0] = __hip_atomic_fetch_add(QA, 1u, __ATOMIC_RELAXED, __HIP_MEMORY_SCOPE_AGENT); if (rep == 0) cv_next = claim_add(QC); }
    __syncthreads();
    int qa = (int)C.MISC[0];
    __syncthreads();
    while (qa < NA) {
        unsigned na = (unsigned)NA;
        if (C.tid == 0) na = claim_add(QA);
        { const int q = qa / PROBE_ATX; attn_unit(C, a, (q & 127) >> 3, q & 7, 7 - (q >> 7), QC, cv_next); }
        if (C.tid == 0) C.MISC[0] = na;
        __syncthreads();
        qa = (int)C.MISC[0];
        __syncthreads();
    }
    for (;;) {
        if (C.tid == 0) C.MISC[2] = cv_next;
        __syncthreads();
        const int c = __builtin_amdgcn_readfirstlane((int)C.MISC[2]);
        __syncthreads();
        if (c >= CV_NCH) break;
        if (C.tid == 0) cv_next = claim_add(QC);
        cv_issue(C, a, c);
        asm volatile("s_waitcnt vmcnt(0)" ::: "memory");
        cv_convert(C, a, c);
        asm volatile("s_waitcnt lgkmcnt(0)" ::: "memory");
    }
    STAMP(12);
#ifdef STAMP_ACC
    if (C.tid == 0 && blockIdx.x == 100) { const unsigned long long n_ = ((unsigned long long)C.MISC[45] << 32) | C.MISC[44]; const unsigned long long w0 = __builtin_amdgcn_s_memrealtime(); while (__builtin_amdgcn_s_memrealtime() - w0 < 4ull * n_) __builtin_amdgcn_s_sleep(8); }
#endif
}

DI void r1_phase(const Ctx& C, const Args& a) {
    LAS unsigned char* L = C.lds;
    const int tid = C.tid, lane = C.lane, wid = C.wid;
    LAS float* LG = (LAS float*)L + wid * 16 * 48;
    LAS int* CNT = (LAS int*)(L + 32768);
    LAS float* G1 = (LAS float*)(L + 33024); LAS float* B1 = (LAS float*)(L + 37120);
    const bf16* Pre = (const bf16*)(C.ws + WS_ZF); unsigned char* X1q = (unsigned char*)(C.ws + WS_R); f32x2* stats = (f32x2*)(C.ws + WS_STATS);
    const bf16* WrH = (const bf16*)(C.ws + WS_WRH); const bf16* WrL = (const bf16*)(C.ws + WS_WRL);
    float* tokW = (float*)(C.ws + WS_TOKW); int* tokG = (int*)(C.ws + WS_TOKD); int* rowtokE = (int*)(C.ws + WS_ROWTOKE); unsigned* gcnt = (unsigned*)(C.ctl + CW_GCNT);
    LAS unsigned* TOKL = (LAS unsigned*)(L + 41472); LAS int* BASE = (LAS int*)(L + 41984);
    LAS unsigned char* WL = L + 45056;
    LAS float* RB = (LAS float*)(L + 41216);
    const int m16 = lane & 15, kq = lane >> 4;
    for (int chunk = blockIdx.x; chunk < NTOK / 128; chunk += C.G) {
        const int tok0 = chunk * 128 + wid * 16;
        const bf16* xrow = Pre + (size_t)(tok0 + m16) * 1024 + 8 * kq;
        if (chunk == (int)blockIdx.x) {
            for (int i = tid; i < 1024; i += NTHREADS) { G1[i] = a.in[I_LN1G][i]; B1[i] = a.in[I_LN1B][i]; }
            for (int i = tid; i < 48 * 128; i += NTHREADS) { const int r = i >> 7, c = i & 127; *(LAS u32x4*)(WL + r * 2064 + c * 16) = *(const u32x4*)(WrH + (size_t)r * 1024 + c * 8); }
            if (tid < 4) RB[tid] = a.in[I_BGRP][tid]; else if (tid < 36) RB[tid] = a.in[I_BEXP][tid - 4];
        }
        u32x4 xw[32];
#pragma unroll
        for (int j = 0; j < 32; ++j) xw[j] = *(const u32x4*)(xrow + 32 * j);
        if (tid < 32) CNT[tid] = 0;
        __syncthreads();
        float s = 0.f, s2 = 0.f;
#pragma unroll
        for (int j = 0; j < 32; ++j) { const u32x4 w = xw[j]; const f32x4 xa = (f32x4){bflo(w.x), bfhi(w.x), bflo(w.y), bfhi(w.y)}, xc = (f32x4){bflo(w.z), bfhi(w.z), bflo(w.w), bfhi(w.w)};
            s += (xa[0] + xa[1]) + (xa[2] + xa[3]) + (xc[0] + xc[1]) + (xc[2] + xc[3]);
            s2 += (xa[0] * xa[0] + xa[1] * xa[1]) + (xa[2] * xa[2] + xa[3] * xa[3]) + (xc[0] * xc[0] + xc[1] * xc[1]) + (xc[2] * xc[2] + xc[3] * xc[3]); }
#pragma unroll
        for (int j = 0; j < 32; ++j) asm volatile("" : "+v"(xw[j]));
        s += __shfl_xor(s, 16); s += __shfl_xor(s, 32); s2 += __shfl_xor(s2, 16); s2 += __shfl_xor(s2, 32);
        const float mean = s * (1.f / 1024.f); const float var = fmaxf(s2 * (1.f / 1024.f) - mean * mean, 0.f); const float rstd = 1.f / sqrtf(var + LN_EPS);
        if (kq == 0) stats[tok0 + m16] = (f32x2){mean, rstd};
        STAMP(13);
        f32x4 acc[3];
#pragma unroll
        for (int nb = 0; nb < 3; ++nb) acc[nb] = (f32x4){0.f, 0.f, 0.f, 0.f};
        u32x2 qprev = (u32x2){0u, 0u};
        unsigned char* xb = X1q + (size_t)(tok0 + m16) * 1024 + 8 * kq;
        const LAS unsigned char* wlp = WL + m16 * 2064 + 16 * kq;
        {
#pragma unroll
            for (int j = 0; j < 32; ++j) { const int k0 = 32 * j;
                bf16x8 wh[3];
#pragma unroll
                for (int nb = 0; nb < 3; ++nb) wh[nb] = *(const LAS bf16x8*)(wlp + nb * 16 * 2064 + k0 * 2);
                const f32x4 xaj = (f32x4){bflo(xw[j].x), bfhi(xw[j].x), bflo(xw[j].y), bfhi(xw[j].y)}, xcj = (f32x4){bflo(xw[j].z), bfhi(xw[j].z), bflo(xw[j].w), bfhi(xw[j].w)};
                const f32x4 ya = (xaj - mean) * rstd * *(const LAS f32x4*)(G1 + k0 + 8 * kq) + *(const LAS f32x4*)(B1 + k0 + 8 * kq);
                const f32x4 yc = (xcj - mean) * rstd * *(const LAS f32x4*)(G1 + k0 + 8 * kq + 4) + *(const LAS f32x4*)(B1 + k0 + 8 * kq + 4);
                u32x4 hw; hw.x = cvtpk(ya[0], ya[1]); hw.y = cvtpk(ya[2], ya[3]); hw.z = cvtpk(yc[0], yc[1]); hw.w = cvtpk(yc[2], yc[3]);
                { u32x2 qw; qw.x = cvt4_fp8(ya[0] * FP8_SX, ya[1] * FP8_SX, ya[2] * FP8_SX, ya[3] * FP8_SX); qw.y = cvt4_fp8(yc[0] * FP8_SX, yc[1] * FP8_SX, yc[2] * FP8_SX, yc[3] * FP8_SX);
                  if ((j & 1) == 0) qprev = qw; else *(u32x4*)(xb + k0 - 32 + ((kq & 1) ? 24 : 0)) = pg8::widen16(qprev, qw); }
                u32x4 lw; lw.x = cvtpk(ya[0] - bflo(hw.x), ya[1] - bfhi(hw.x)); lw.y = cvtpk(ya[2] - bflo(hw.y), ya[3] - bfhi(hw.y)); lw.z = cvtpk(yc[0] - bflo(hw.z), yc[1] - bfhi(hw.z)); lw.w = cvtpk(yc[2] - bflo(hw.w), yc[3] - bfhi(hw.w));
                const bf16x8 xh = __builtin_bit_cast(bf16x8, hw), xl = __builtin_bit_cast(bf16x8, lw);
#pragma unroll
                for (int nb = 0; nb < 3; ++nb) { acc[nb] = MFMA16(wh[nb], xh, acc[nb]); acc[nb] = MFMA16(wh[nb], xl, acc[nb]); }
                asm volatile("" ::: "memory");
            }
        }
        STAMP(14);
#pragma unroll
        for (int nb = 0; nb < 3; ++nb)
#pragma unroll
            for (int r = 0; r < 4; ++r) LG[m16 * 48 + nb * 16 + 4 * kq + r] = acc[nb][r];
        asm volatile("s_waitcnt lgkmcnt(0)" ::: "memory");
        if (lane < 16) {
            const LAS float* lg = LG + lane * 48;
            float gl[4];
#pragma unroll
            for (int j = 0; j < 4; ++j) gl[j] = lg[j] + RB[j];
            int grp = 0; float gm = gl[0];
#pragma unroll
            for (int j = 1; j < 4; ++j) if (gl[j] > gm) { gm = gl[j]; grp = j; }
            float se = 0.f;
#pragma unroll
            for (int j = 0; j < 4; ++j) se += __expf(gl[j] - gm);
            const float pg = 1.f / se;
            float el[8];
#pragma unroll
            for (int j = 0; j < 8; ++j) el[j] = lg[4 + grp * 8 + j] + RB[4 + grp * 8 + j];
            int i0 = 0; float v0 = el[0];
#pragma unroll
            for (int j = 1; j < 8; ++j) if (el[j] > v0) { v0 = el[j]; i0 = j; }
            int i1 = -1; float v1 = -INFINITY;
#pragma unroll
            for (int j = 0; j < 8; ++j) if (j != i0 && el[j] > v1) { v1 = el[j]; i1 = j; }
            const float w0 = 1.f / (1.f + __expf(v1 - v0)), w1 = 1.f - w0;
            const int e0 = grp * 8 + i0, e1 = grp * 8 + i1;
            const int r0 = __hip_atomic_fetch_add(CNT + e0, 1, __ATOMIC_RELAXED, __HIP_MEMORY_SCOPE_WORKGROUP), r1 = __hip_atomic_fetch_add(CNT + e1, 1, __ATOMIC_RELAXED, __HIP_MEMORY_SCOPE_WORKGROUP);
            const int tok = tok0 + lane;
            TOKL[wid * 16 + lane] = (unsigned)e0 | ((unsigned)e1 << 8) | ((unsigned)r0 << 16) | ((unsigned)r1 << 24);
            tokW[tok * 2] = w0 * pg; tokW[tok * 2 + 1] = w1 * pg;
        }
        __syncthreads();
        if (tid < 32) BASE[tid] = (int)__hip_atomic_fetch_add(gcnt + 64 * tid, (unsigned)CNT[tid], __ATOMIC_RELAXED, __HIP_MEMORY_SCOPE_AGENT);
        __syncthreads();
        if (tid < 128) { const unsigned w = TOKL[tid]; const int e0 = w & 31, e1 = (w >> 8) & 31, g0 = BASE[e0] + (int)((w >> 16) & 255), g1 = BASE[e1] + (int)((w >> 24) & 255), tok = chunk * 128 + tid;
            tokG[tok * 2] = (e0 << 20) | g0; tokG[tok * 2 + 1] = (e1 << 20) | g1; rowtokE[e0 * 32768 + g0] = tok; rowtokE[e1 * 32768 + g1] = tok; }
        __syncthreads();
    }
}

DI void moe_tables(const Ctx& C) {
    LAS int* T = (LAS int*)(C.lds + MOE_TAB); const unsigned* gcnt = (const unsigned*)(C.ctl + CW_GCNT);
    if (C.wid == 0) {
        const int e = C.lane & 31;
        const int cnt = (int)__hip_atomic_load(gcnt + 64 * e, __ATOMIC_RELAXED, __HIP_MEMORY_SCOPE_AGENT), nt = (C.lane < 32) ? (cnt + 255) >> 8 : 0;
        int s = nt;
#pragma unroll
        for (int o = 1; o < 32; o <<= 1) { const int v = __shfl_up(s, o); s += (C.lane >= o) ? v : 0; }
        if (C.lane < 32) { const int t0 = s - nt; T[e] = cnt; T[32 + e] = t0 << 8; T[65 + e] = t0;
            for (int t = t0; t < s; ++t) T[98 + t] = e;
            if (e == 31) { T[64] = s << 8; T[97] = s; } }
    }
    __syncthreads();
}

DI void f_phase(const Ctx& C, const Args& a) {
    const int lane = C.lane, gw = C.vcu * NWAVES + C.wid, NGW = C.G * NWAVES;
    const bf16* Pre = (const bf16*)(C.ws + WS_ZF); const unsigned char* Y = (const unsigned char*)(C.ws + WS_Y); const int* tokD = (const int*)(C.ws + WS_TOKD); const float* tokW = (const float*)(C.ws + WS_TOKW);
    const f32x2* stats = (const f32x2*)(C.ws + WS_STATS); const LAS int* PSTL = (const LAS int*)(C.lds + MOE_TAB) + 32;
    f32x4 g2[4], b2[4], g1[4], b1[4];
#pragma unroll
    for (int j = 0; j < 4; ++j) { g2[j] = *(const f32x4*)(a.in[I_LN2G] + 256 * j + 4 * lane); b2[j] = *(const f32x4*)(a.in[I_LN2B] + 256 * j + 4 * lane);
        g1[j] = *(const f32x4*)(a.in[I_LN1G] + 256 * j + 4 * lane) * DN_ALPHA; b1[j] = *(const f32x4*)(a.in[I_LN1B] + 256 * j + 4 * lane) * DN_ALPHA; }
    for (int tk = gw; tk < NTOK; tk += 2 * NGW) {
        int tokk[2]; tokk[0] = tk; tokk[1] = (tk + NGW < NTOK) ? tk + NGW : tk;
        u32x2 xw[2][4]; unsigned p0[2][4], p1[2][4]; float w0[2], w1[2]; f32x2 st[2];
#pragma unroll
        for (int t = 0; t < 2; ++t) { const int tok = tokk[t];
            const int q0 = tokD[tok * 2], q1 = tokD[tok * 2 + 1]; const int d0 = PSTL[q0 >> 20] + (q0 & 0xfffff), d1 = PSTL[q1 >> 20] + (q1 & 0xfffff);   w0[t] = tokW[tok * 2] * (1.f / FP8_SY); w1[t] = tokW[tok * 2 + 1] * (1.f / FP8_SY); st[t] = stats[tok];
            const bf16* xr = Pre + (size_t)tok * 1024 + 4 * lane; const unsigned char* y0 = Y + (size_t)d0 * 1024 + 4 * lane; const unsigned char* y1 = Y + (size_t)d1 * 1024 + 4 * lane;
#pragma unroll
            for (int j = 0; j < 4; ++j) { xw[t][j] = __builtin_nontemporal_load((const u32x2*)(xr + 256 * j)); p0[t][j] = __builtin_nontemporal_load((const unsigned*)(y0 + 256 * j)); p1[t][j] = __builtin_nontemporal_load((const unsigned*)(y1 + 256 * j)); } }
#pragma unroll
        for (int t = 0; t < 2; ++t) {
            f32x4 v[4]; float s = 0.f;
#pragma unroll
            for (int j = 0; j < 4; ++j) { const f32x4 x = (f32x4){bflo(xw[t][j].x), bfhi(xw[t][j].x), bflo(xw[t][j].y), bfhi(xw[t][j].y)};
                v[j] = ((x - st[t].x) * st[t].y) * g1[j] + b1[j] + fp8x4_to_f32(p0[t][j]) * w0[t] + fp8x4_to_f32(p1[t][j]) * w1[t];
                s += (v[j][0] + v[j][1]) + (v[j][2] + v[j][3]); }
            const float mean = wave_sum(s) * (1.f / 1024.f); float s2 = 0.f;
#pragma unroll
            for (int j = 0; j < 4; ++j) { v[j] = v[j] - mean; s2 += (v[j][0] * v[j][0] + v[j][1] * v[j][1]) + (v[j][2] * v[j][2] + v[j][3] * v[j][3]); }
            const float rstd = 1.f / sqrtf(wave_sum(s2) * (1.f / 1024.f) + LN_EPS);
            float* orow = a.out + (size_t)tokk[t] * 1024 + 4 * lane;
#pragma unroll
            for (int j = 0; j < 4; ++j) __builtin_nontemporal_store(v[j] * rstd * g2[j] + b2[j], (f32x4*)(orow + 256 * j));
        }
    }
}

constexpr int NPH = 10;
__global__ void __launch_bounds__(NTHREADS, 2) mk_fwd(Args args) {
    extern __shared__ __attribute__((aligned(16))) unsigned char lds_raw[];
    Ctx C;
    C.lds = (LAS unsigned char*)lds_raw; C.MISC = (volatile LAS unsigned*)(C.lds + MISC_OFF);
    C.tid = threadIdx.x; C.lane = C.tid & 63; C.wid = __builtin_amdgcn_readfirstlane(C.tid >> 6);
    C.G = gridDim.x; { const int bx = blockIdx.x; C.vcu = (C.G % 8 == 0) ? (bx % 8) * (C.G / 8) + bx / 8 : bx; }
    C.ws = args.ws; C.ctl = (gu32*)(args.ws + WS_CTL);
    if (C.tid < 64) C.MISC[C.tid] = 0u;
    __syncthreads();
    XcdBarrier bar; bar.bar = (unsigned*)(C.ctl + CW_BAR); bar.x = 0; bar.st = nullptr;
    if (MK_N_LAUNCHES == 1) bar = xcd_barrier_post((unsigned*)(C.ctl + CW_BAR), C.MISC + 8);
    const int lo = args.ph_lo, hi = args.ph_hi;
#ifndef PH_MASK
#define PH_MASK 0x3ff
#endif
#define IN(k) (((PH_MASK >> (k)) & 1) && lo <= (k) && (k) < hi)
#ifndef STAMP_SEL
#define STAMP_SEL -1
#endif
#ifndef STAMP_T0
#define STAMP_T0 STAMP_SEL
#define STAMP_T1 (STAMP_SEL + 1)
#endif
#define SEAM(k) do { if (IN(k) && IN((k) + 1)) xcd_barrier(bar); STAMP((k) + 1); } while (0)
#ifndef PROBE_PHASE
#define PROBE_PHASE -1
#endif
#define REPS(k) ((PROBE_PHASE == (k)) ? 2 : 1)
#define REPSEAM(k) do { if (rep + 1 < REPS(k)) xcd_barrier(bar); } while (0)
    unsigned char* ws = args.ws;
    LAS unsigned char* ring = C.lds;

    STAMP(0);
    if (IN(0)) { _Pragma("unroll") for (int rep = 0; rep < REPS(0); ++rep) { p0_prologue(C, args); REPSEAM(0); } } SEAM(0);

    if (IN(1)) _Pragma("unroll") for (int rep = 0; rep < REPS(1); ++rep) {
        pg8::EpiIn E{(bf16*)(ws + WS_QH), (bf16*)(ws + WS_VH), (bf16*)(ws + WS_GH), (bf16*)(ws + WS_QM), (bf16*)(ws + WS_KM), (bf16*)(ws + WS_VM), (bf16*)(ws + WS_R), (bf16*)(ws + WS_GB),
                     (float*)(ws + WS_ZF), (float*)(ws + WS_KMEAN), (const float*)(ws + WS_BPERM), (bf16*)(ws + WS_KK), (const float*)(ws + WS_LB), 0, ws + WS_VM, ws + WS_KM, ws + WS_KM + 16 * MiB};
        { pg8::DenseOrder S; S.init(ws + WS_XB, ws + WS_WIN, NTOK, 1024, 1024, C.G, (int)blockIdx.x);
          pg8::gemm_phase<pg8::EpiIn, pg8::DenseOrder, false>(ring, 1024, S, E, 1); }
        { E.pn_off = 4; pg8::DenseOrder S; S.init((unsigned char*)args.out + 64 * MiB, ws + WS_WIN + 2 * MiB, NTOK, 4608, 512, C.G, (int)blockIdx.x);
          pg8::gemm_phase<pg8::EpiIn, pg8::DenseOrder, false, true>(ring, 512, S, E, 2); }
        REPSEAM(1);
    } SEAM(1);

#ifndef PROBE_P2X
#define PROBE_P2X 1
#endif
    if (IN(2)) { for (int rep = 0; rep < PROBE_P2X; ++rep) { p2_mixers(C, args, rep); if (rep + 1 < PROBE_P2X) xcd_barrier(bar); } } SEAM(2);

    if (IN(3)) _Pragma("unroll") for (int rep = 0; rep < REPS(3); ++rep) {
        pg8::DenseOrder S; S.init(ws + WS_OCAT, ws + WS_WCAT, NTOK, 1024, 512, C.G, (int)blockIdx.x);
        pg8::EpiProj E{(const bf16*)(ws + WS_R), (const bf16*)(ws + WS_GB), (unsigned char*)(ws + WS_QH)};
        pg8::gemm_phase<pg8::EpiProj, pg8::DenseOrder, false, true>(ring, 512, S, E, 3); REPSEAM(3);
    } SEAM(3);

    if (IN(4)) _Pragma("unroll") for (int rep = 0; rep < REPS(4); ++rep) {
        pg8::DenseOrder S; S.init(ws + WS_QH, ws + WS_WO, NTOK, 1024, 512, C.G, (int)blockIdx.x);
        pg8::EpiOut E{(const bf16*)(ws + WS_XB), (bf16*)(ws + WS_ZF)};
        pg8::gemm_phase<pg8::EpiOut, pg8::DenseOrder, false, true>(ring, 512, S, E, 4);
        REPSEAM(4);
    } SEAM(4);

    if (IN(5)) { _Pragma("unroll") for (int rep = 0; rep < REPS(5); ++rep) { r1_phase(C, args); REPSEAM(5); } } STAMP(15); SEAM(5);
    if (IN(7) || (IN(8) && !IN(7)) || (IN(9) && !IN(8))) moe_tables(C);

    if (IN(7)) _Pragma("unroll") for (int rep = 0; rep < REPS(7); ++rep) {
        const int ntl = __builtin_amdgcn_readfirstlane(((const LAS int*)(C.lds + MOE_TAB))[97]);
        pg8::MoeOrder S{(const char*)(ws + WS_R), (const char*)args.out, (const int*)(ws + WS_ROWTOKE), (const LAS int*)(C.lds + MOE_TAB), 512, 1024, ntl * 4, C.G, C.vcu, true};
        pg8::EpiM1 E{(unsigned char*)(ws + WS_QH)};
        pg8::gemm_phase<pg8::EpiM1, pg8::MoeOrder, true, true>(ring, 512, S, E, 7); REPSEAM(7);
    } SEAM(7);

    if (IN(8)) _Pragma("unroll") for (int rep = 0; rep < REPS(8); ++rep) {
        const int ntl = __builtin_amdgcn_readfirstlane(((const LAS int*)(C.lds + MOE_TAB))[97]);
        pg8::MoeOrder S{(const char*)(ws + WS_QH), (const char*)args.out + 32 * MiB, (const int*)(ws + WS_ROWTOKE), (const LAS int*)(C.lds + MOE_TAB), 256, 1024, ntl * 4, C.G, C.vcu, false};
        pg8::EpiM2 E{(unsigned char*)(ws + WS_Y)};
        pg8::gemm_phase<pg8::EpiM2, pg8::MoeOrder, false, true>(ring, 256, S, E, 8); REPSEAM(8);
    } SEAM(8);

    if (IN(9)) { _Pragma("unroll") for (int rep = 0; rep < REPS(9); ++rep) { f_phase(C, args); REPSEAM(9); } }
    STAMP(10);
    if (STAMP_SEL >= 0 && blockIdx.x == STAMP_BLK && C.tid == 0) {
        const unsigned long long t0 = ((unsigned long long)C.MISC[17 + 2 * (STAMP_T0)] << 32) | C.MISC[16 + 2 * (STAMP_T0)], t1 = ((unsigned long long)C.MISC[17 + 2 * (STAMP_T1)] << 32) | C.MISC[16 + 2 * (STAMP_T1)];
        const unsigned long long w0 = __builtin_amdgcn_s_memrealtime(); while (__builtin_amdgcn_s_memrealtime() - w0 < 4ull * (t1 - t0)) __builtin_amdgcn_s_sleep(8); }
#ifdef PROBE_GEMM
    if (blockIdx.x == PROBE_GBLK && C.tid == 0) {
        const unsigned long long w0 = __builtin_amdgcn_s_memrealtime(), span = 8ull * (((unsigned long long)C.MISC[61] << 32) | C.MISC[60]); while (__builtin_amdgcn_s_memrealtime() - w0 < span) __builtin_amdgcn_s_sleep(8); }
#endif
#undef IN
#undef SEAM
}

extern "C" void kernel_launch(void* const* d_in, const int* in_sizes, int n_in, void* d_out, int out_size, void* d_ws, size_t ws_size, hipStream_t stream) {
    static int grid = 0;
    if (grid == 0) {
        if (n_in != 19 || in_sizes[0] != NTOK * DM || out_size != NTOK * DM || ws_size < WS_END) { fprintf(stderr, "kernel_launch: unexpected problem shape / workspace; nothing launched\n"); grid = -1; return; }
        int dev = 0, cus = 0, per_cu = 0;
        if (hipGetDevice(&dev) != hipSuccess || hipDeviceGetAttribute(&cus, hipDeviceAttributeMultiprocessorCount, dev) != hipSuccess) { grid = -1; return; }
        if (hipFuncSetAttribute((const void*)mk_fwd, hipFuncAttributeMaxDynamicSharedMemorySize, LDS_BYTES) != hipSuccess) { fprintf(stderr, "kernel_launch: hipFuncSetAttribute failed\n"); grid = -1; return; }
        if (hipOccupancyMaxActiveBlocksPerMultiprocessor(&per_cu, (const void*)mk_fwd, NTHREADS, LDS_BYTES) != hipSuccess || per_cu < 1) { fprintf(stderr, "kernel_launch: occupancy query says %d\n", per_cu); }
        (void)hipGetLastError();
        grid = cus;
    }
    if (grid < 0) return;
    (void)hipMemsetAsync((char*)d_ws + WS_CTL, 0, CTL_ZERO_BYTES, stream);
    Args a{};
    for (int i = 0; i < 19; ++i) a.in[i] = (const float*)d_in[i];
    a.out = (float*)d_out; a.ws = (unsigned char*)d_ws;
    if (MK_N_LAUNCHES == 1) { a.ph_lo = 0; a.ph_hi = NPH; hipLaunchKernelGGL(mk_fwd, dim3(grid), dim3(NTHREADS), LDS_BYTES, stream, a); }
    else for (int p = 0; p < NPH; ++p) { a.ph_lo = p; a.ph_hi = p + 1; hipLaunchKernelGGL(mk_fwd, dim3(grid), dim3(NTHREADS), LDS_BYTES, stream, a); }
}
```
